# Optimizing an MI355X kernel written in HIP

```python
import math
import jax, jax.numpy as jnp
from jax import lax
import numpy as np

D_MODEL = 1024
BATCH = 4
SEQ = 8192
DEPTH = 2

HEAD_DIM = 64
FOX_HEADS = 8
RET_HEADS = 8
FOX_WIDTH = FOX_HEADS * HEAD_DIM
RET_WIDTH = RET_HEADS * HEAD_DIM
EVEN_MIX_WIDTH = FOX_WIDTH + RET_WIDTH
FOX_Q_BLOCK = 128
RET_CHUNK = 128
EVEN_SIZES = (FOX_WIDTH, FOX_WIDTH, FOX_WIDTH, FOX_HEADS, RET_WIDTH, RET_WIDTH, RET_WIDTH, EVEN_MIX_WIDTH)
EVEN_IN = sum(EVEN_SIZES)
EVEN_SPLITS = tuple(int(v) for v in np.cumsum(EVEN_SIZES)[:-1])
NSA_HEADS = 16
NSA_KV_GROUPS = 4
NSA_HEADS_PER_GROUP = NSA_HEADS // NSA_KV_GROUPS
NSA_WIDTH = NSA_HEADS * HEAD_DIM
NSA_KV_WIDTH = NSA_KV_GROUPS * HEAD_DIM
N_BRANCH = 3
CMP_BLOCK = 32
CMP_STRIDE = 16
CMP_HIDDEN = 256
SLC_BLOCK = 64
SLC_TOPK = 16
WINDOW = 512
NSA_Q_BLOCK = 64
ODD_SIZES = (NSA_WIDTH,) + (NSA_KV_WIDTH,) * 6 + (NSA_HEADS * N_BRANCH, NSA_WIDTH)
ODD_IN = sum(ODD_SIZES)
ODD_SPLITS = tuple(int(v) for v in np.cumsum(ODD_SIZES)[:-1])

RMS_EPS = 1e-6
GN_EPS = 1e-5
NEG = -1e30
FORCE_BONUS = 1e6

kernel_name = "fox_retnet_nsa_hybrid"


def rms_norm(x, g):
    xf = x.astype(jnp.float32)
    y = xf * lax.rsqrt(jnp.mean(xf * xf, axis=-1, keepdims=True) + RMS_EPS)
    return (y * g.astype(jnp.float32)).astype(x.dtype)


def masked_softmax(s, mask):
    s = jnp.where(mask, s, NEG)
    p = jax.nn.softmax(s, axis=-1)
    return jnp.where(mask, p, 0.0)


def alibi_slopes(n):
    return jnp.asarray(2.0 ** (-8.0 * (np.arange(n) + 1) / n), jnp.float32)


def fox_attention(q, k, v, f_logit):
    B, S, H, d = q.shape
    nb = S // FOX_Q_BLOCK
    scale = d ** -0.5
    c = jnp.cumsum(jax.nn.log_sigmoid(f_logit.astype(jnp.float32)), axis=1)
    c_h = c.transpose(0, 2, 1)
    kh = k.transpose(0, 2, 1, 3)
    vh = v.transpose(0, 2, 1, 3)
    qb = q.reshape(B, nb, FOX_Q_BLOCK, H, d).transpose(1, 0, 3, 2, 4)
    cb = c.reshape(B, nb, FOX_Q_BLOCK, H).transpose(1, 0, 3, 2)
    key_pos = jnp.arange(S)

    def block(args):
        qi, ci, bi = args
        t = bi * FOX_Q_BLOCK + jnp.arange(FOX_Q_BLOCK)
        s = jnp.einsum('bhqd,bhkd->bhqk', qi, kh).astype(jnp.float32) * scale
        s = s + ci[..., None] - c_h[:, :, None, :]
        p = masked_softmax(s, key_pos[None, :] <= t[:, None])
        return jnp.einsum('bhqk,bhkd->bhqd', p.astype(vh.dtype), vh)

    o = lax.map(block, (qb, cb, jnp.arange(nb)))
    return o.transpose(1, 0, 3, 2, 4).reshape(B, S, H, d)


def retention_decays(n_heads, chunk):
    lg = np.log(1.0 - 2.0 ** (-5.0 - np.arange(n_heads)))
    i = np.arange(chunk)
    diff = i[:, None] - i[None, :]
    inner = np.where(diff[None] >= 0, np.exp(lg[:, None, None] * np.maximum(diff, 0)[None]), 0.0)
    cross = np.exp(lg[:, None] * (i[None, :] + 1))
    kdec = np.exp(lg[:, None] * (chunk - 1 - i)[None, :])
    cdec = np.exp(lg * chunk)
    return (jnp.asarray(inner, jnp.float32), jnp.asarray(cross, jnp.float32),
            jnp.asarray(kdec, jnp.float32), jnp.asarray(cdec, jnp.float32))


def retention(q, k, v):
    B, S, H, d = q.shape
    n = S // RET_CHUNK
    inner, cross, kdec, cdec = retention_decays(H, RET_CHUNK)

    def chunks(a):
        return a.astype(jnp.float32).reshape(B, n, RET_CHUNK, H, d).transpose(1, 0, 3, 2, 4)

    qc, kc, vc = chunks(q), chunks(k) * (d ** -0.5), chunks(v)

    def step(state, xs):
        qi, ki, vi = xs
        a = jnp.einsum('bhid,bhjd->bhij', qi, ki) * inner
        o = jnp.einsum('bhij,bhje->bhie', a, vi) + jnp.einsum('bhid,bhde->bhie', qi, state) * cross[None, :, :, None]
        state = state * cdec[None, :, None, None] + jnp.einsum('bhjd,bhje->bhde', ki * kdec[None, :, :, None], vi)
        return state, o

    _, o = lax.scan(step, jnp.zeros((B, H, d, d), jnp.float32), (qc, kc, vc))
    o = o.transpose(1, 0, 3, 2, 4).reshape(B, S, H, d)
    mu = jnp.mean(o, axis=-1, keepdims=True)
    var = jnp.mean(jnp.square(o - mu), axis=-1, keepdims=True)
    return ((o - mu) * lax.rsqrt(var + GN_EPS)).reshape(B, S, H * d)


def even_layer(x, norm_g, w_in, b_f, gn_g, w_out):
    B, S, _ = x.shape
    h = rms_norm(x, norm_g)
    u = h @ w_in
    q_f, k_f, v_f, f_l, q_r, k_r, v_r, z = jnp.split(u, EVEN_SPLITS, axis=-1)
    hd = lambda a, n: a.reshape(B, S, n, HEAD_DIM)
    o_f = fox_attention(hd(q_f, FOX_HEADS), hd(k_f, FOX_HEADS), hd(v_f, FOX_HEADS), f_l + b_f)
    o_f = o_f.reshape(B, S, FOX_WIDTH)
    o_r = (retention(hd(q_r, RET_HEADS), hd(k_r, RET_HEADS), hd(v_r, RET_HEADS)) * gn_g).astype(x.dtype)
    y = jnp.concatenate([o_f, o_r], axis=-1) * jax.nn.silu(z)
    return x + y @ w_out


def compress_blocks(a, idx, pe, w1, w2):
    B = a.shape[0]
    nc, l = idx.shape
    ab = a[:, idx] + pe[None, None, :, None, :]
    ab = ab.transpose(0, 1, 3, 2, 4).reshape(B, nc, NSA_KV_GROUPS, l * HEAD_DIM)
    return jax.nn.silu(ab @ w1) @ w2


def nsa_attention(q, kc, vc, ks, vs, kw, vw, gate_logit, pe_k, pe_v, wk1, wk2, wv1, wv2):
    B, S, H, d = q.shape
    G, Hg, QB = NSA_KV_GROUPS, NSA_HEADS_PER_GROUP, NSA_Q_BLOCK
    scale = d ** -0.5
    dtype = q.dtype
    nc = (S - CMP_BLOCK) // CMP_STRIDE + 1
    idx = np.arange(nc)[:, None] * CMP_STRIDE + np.arange(CMP_BLOCK)[None, :]
    cmp_end = jnp.asarray(idx[:, -1], jnp.int32)
    k_cmp = compress_blocks(kc, idx, pe_k, wk1, wk2)
    v_cmp = compress_blocks(vc, idx, pe_v, wv1, wv2)
    ns = S // SLC_BLOCK
    topk = min(SLC_TOPK, ns)
    c0 = np.arange(nc)[:, None] * CMP_STRIDE
    s0 = np.arange(ns)[None, :] * SLC_BLOCK
    overlap = np.clip(np.minimum(c0 + CMP_BLOCK, s0 + SLC_BLOCK) - np.maximum(c0, s0), 0, None)
    cmp_to_slc = jnp.asarray(overlap / CMP_STRIDE, jnp.float32)
    slopes = alibi_slopes(H).reshape(G, Hg)[None, :, :, None, None]
    ks_g = ks.transpose(0, 2, 1, 3)
    vs_g = vs.transpose(0, 2, 1, 3)
    kw_pad = jnp.pad(kw, ((0, 0), (WINDOW, 0), (0, 0), (0, 0)))
    vw_pad = jnp.pad(vw, ((0, 0), (WINDOW, 0), (0, 0), (0, 0)))
    nqb = S // QB
    qb = q.reshape(B, nqb, QB, G, Hg, d).transpose(1, 0, 2, 3, 4, 5)
    gb = gate_logit.reshape(B, nqb, QB, G, Hg, N_BRANCH).transpose(1, 0, 2, 3, 4, 5)
    b_idx = jnp.arange(B)[:, None, None, None]
    g_idx = jnp.arange(G)[None, :, None, None]
    blk = jnp.arange(ns)

    def block(args):
        qi, gi, bi = args
        t = bi * QB + jnp.arange(QB)
        s = jnp.einsum('bqghd,bcgd->bghqc', qi, k_cmp).astype(jnp.float32) * scale
        s = s - slopes * (t[:, None] - cmp_end[None, :]).astype(jnp.float32)
        p_cmp = masked_softmax(s, cmp_end[None, :] <= t[:, None])
        o_cmp = jnp.einsum('bghqc,bcgd->bqghd', p_cmp.astype(dtype), v_cmp)
        imp = p_cmp.sum(axis=2) @ cmp_to_slc
        cur = t // SLC_BLOCK
        valid = blk[None, :] * SLC_BLOCK <= t[:, None]
        forced = (blk[None, :] == 0) | (blk[None, :] == cur[:, None]) | (blk[None, :] == cur[:, None] - 1)
        score = jnp.where(valid, imp + jnp.where(forced, FORCE_BONUS, 0.0), NEG)
        _, sel = lax.top_k(score, topk)
        tok = (sel[..., None] * SLC_BLOCK + jnp.arange(SLC_BLOCK)).reshape(B, G, QB, topk * SLC_BLOCK)
        k_sel = ks_g[b_idx, g_idx, tok]
        v_sel = vs_g[b_idx, g_idx, tok]
        s = jnp.einsum('bqghd,bgqld->bghql', qi, k_sel).astype(jnp.float32) * scale
        s = s - slopes * (t[None, None, :, None] - tok).astype(jnp.float32)[:, :, None]
        p = masked_softmax(s, (tok <= t[None, None, :, None])[:, :, None])
        o_slc = jnp.einsum('bghql,bgqld->bqghd', p.astype(dtype), v_sel)
        start = bi * QB
        k_win = lax.dynamic_slice_in_dim(kw_pad, start, QB + WINDOW, axis=1)
        v_win = lax.dynamic_slice_in_dim(vw_pad, start, QB + WINDOW, axis=1)
        sp = start - WINDOW + jnp.arange(QB + WINDOW)
        wmask = (sp[None, :] <= t[:, None]) & (sp[None, :] > t[:, None] - WINDOW) & (sp[None, :] >= 0)
        s = jnp.einsum('bqghd,bkgd->bghqk', qi, k_win).astype(jnp.float32) * scale
        s = s - slopes * (t[:, None] - sp[None, :]).astype(jnp.float32)
        p = masked_softmax(s, wmask)
        o_win = jnp.einsum('bghqk,bkgd->bqghd', p.astype(dtype), v_win)
        g = jax.nn.sigmoid(gi.astype(jnp.float32)).astype(dtype)
        return g[..., 0:1] * o_cmp + g[..., 1:2] * o_slc + g[..., 2:3] * o_win

    o = lax.map(block, (qb, gb, jnp.arange(nqb)))
    return o.transpose(1, 0, 2, 3, 4, 5).reshape(B, S, H * d)


def odd_layer(x, norm_g, w_in, b_gate, pe_k, pe_v, wk1, wk2, wv1, wv2, w_out):
    B, S, _ = x.shape
    h = rms_norm(x, norm_g)
    u = h @ w_in
    q, kc, vc, ks, vs, kw, vw, gl, z = jnp.split(u, ODD_SPLITS, axis=-1)
    kv = lambda a: a.reshape(B, S, NSA_KV_GROUPS, HEAD_DIM)
    gl = (gl + b_gate).reshape(B, S, NSA_HEADS, N_BRANCH)
    o = nsa_attention(q.reshape(B, S, NSA_HEADS, HEAD_DIM), kv(kc), kv(vc), kv(ks), kv(vs), kv(kw), kv(vw),
                      gl, pe_k, pe_v, wk1, wk2, wv1, wv2)
    return x + (o * jax.nn.silu(z)) @ w_out


def setup_inputs(seed: int = 0) -> dict:
    key = jax.random.key(seed)
    ks = jax.random.split(key, 24)
    ne = (DEPTH + 1) // 2
    no = DEPTH // 2
    nrm = lambda k, shape, sc: jax.random.normal(k, shape, jnp.float32) * sc
    fan_cmp = CMP_BLOCK * HEAD_DIM
    return {
        "x": nrm(ks[0], (BATCH, SEQ, D_MODEL), 1.0),
        "even_norm_g": 1.0 + nrm(ks[1], (ne, D_MODEL), 0.05),
        "even_w_in": nrm(ks[2], (ne, D_MODEL, EVEN_IN), D_MODEL ** -0.5),
        "even_b_f": 1.0 + nrm(ks[3], (ne, FOX_HEADS), 0.1),
        "even_gn_g": 1.0 + nrm(ks[4], (ne, RET_WIDTH), 0.05),
        "even_w_out": nrm(ks[5], (ne, EVEN_MIX_WIDTH, D_MODEL), EVEN_MIX_WIDTH ** -0.5),
        "odd_norm_g": 1.0 + nrm(ks[6], (no, D_MODEL), 0.05),
        "odd_w_in": nrm(ks[7], (no, D_MODEL, ODD_IN), D_MODEL ** -0.5),
        "odd_b_gate": nrm(ks[8], (no, NSA_HEADS * N_BRANCH), 0.1),
        "odd_pe_k": nrm(ks[9], (no, CMP_BLOCK, HEAD_DIM), 0.1),
        "odd_pe_v": nrm(ks[10], (no, CMP_BLOCK, HEAD_DIM), 0.1),
        "odd_wk1": nrm(ks[11], (no, fan_cmp, CMP_HIDDEN), fan_cmp ** -0.5),
        "odd_wk2": nrm(ks[12], (no, CMP_HIDDEN, HEAD_DIM), CMP_HIDDEN ** -0.5),
        "odd_wv1": nrm(ks[13], (no, fan_cmp, CMP_HIDDEN), fan_cmp ** -0.5),
        "odd_wv2": nrm(ks[14], (no, CMP_HIDDEN, HEAD_DIM), CMP_HIDDEN ** -0.5),
        "odd_w_out": nrm(ks[15], (no, NSA_WIDTH, D_MODEL), NSA_WIDTH ** -0.5),
        "final_g": 1.0 + nrm(ks[16], (D_MODEL,), 0.05),
    }


def reference(x, even_norm_g, even_w_in, even_b_f, even_gn_g, even_w_out,
              odd_norm_g, odd_w_in, odd_b_gate, odd_pe_k, odd_pe_v, odd_wk1, odd_wk2, odd_wv1, odd_wv2, odd_w_out,
              final_g):
    for layer in range(DEPTH):
        i = layer // 2
        if layer % 2 == 0:
            x = even_layer(x, even_norm_g[i], even_w_in[i], even_b_f[i], even_gn_g[i], even_w_out[i])
        else:
            x = odd_layer(x, odd_norm_g[i], odd_w_in[i], odd_b_gate[i], odd_pe_k[i], odd_pe_v[i],
                          odd_wk1[i], odd_wk2[i], odd_wv1[i], odd_wv2[i], odd_w_out[i])
    return rms_norm(x, final_g)
```

```cpp
#include <hip/hip_runtime.h>
#include <hip/hip_cooperative_groups.h>
#include <stdint.h>
#include <stdio.h>
namespace cg = cooperative_groups;

typedef unsigned short u16;
typedef short bf16x8 __attribute__((ext_vector_type(8)));
typedef short bf16x4 __attribute__((ext_vector_type(4)));
typedef float f32x4 __attribute__((ext_vector_type(4)));

#ifndef ONE_LAUNCH
#define ONE_LAUNCH 1
#endif

#define MTOK 32768
#define SEQ 8192
#define DM 1024
#define LDQ 3072
#define LOG2E 1.4426950408889634f
#define TS 72
#define IMPS 132
#define LDS_BYTES 73728
#define NPHASE 13

#define MiB (1024ull * 1024ull)
#define WS_HBF   (0ull)
#define WS_DS    (0ull)
#define WS_ST    (32ull * MiB)
#define WS_QK    (64ull * MiB)
#define WS_VT    (256ull * MiB)
#define WS_Y     (352ull * MiB)
#define WS_WT0   (416ull * MiB)
#define WS_WT1   (WS_WT0 + 4224ull * 1024 * 2)
#define WS_WO0   (WS_WT1 + 3712ull * 1024 * 2)
#define WS_WO1   (WS_WO0 + 1024ull * 1024 * 2)
#define WS_W1K   (WS_WO1 + 1024ull * 1024 * 2)
#define WS_W1V   (WS_W1K + 256ull * 2048 * 2)
#define WS_W2K   (WS_W1V + 256ull * 2048 * 2)
#define WS_W2V   (WS_W2K + 128ull * 256 * 2)
#define WS_FLOG  (440ull * MiB)
#define WS_CFOX  (441ull * MiB)
#define WS_GL    (442ull * MiB)
#define WS_HC    (448ull * MiB)
#define WS_KCMP  (456ull * MiB)
#define WS_VCMPT (457ull * MiB)
#define WS_PEP   (458ull * MiB)
#define WS_PEB   (WS_PEP + 65536ull)

struct Params {
  const float *x, *e_ng, *e_win, *e_bf, *e_gn, *e_wout;
  const float *o_ng, *o_win, *o_bg, *o_pek, *o_pev, *o_wk1, *o_wk2, *o_wv1, *o_wv2, *o_wout, *fin_g;
  float* out;
  unsigned char* ws;
  int ph_lo, ph_hi, coop, pad;
};

__device__ __forceinline__ u16 f2bf(float f) {
  uint32_t u = __float_as_uint(f);
  u += 0x7fffu + ((u >> 16) & 1u);
  return (u16)(u >> 16);
}
__device__ __forceinline__ float bf2f(u16 h) { return __uint_as_float(((uint32_t)h) << 16); }
__device__ __forceinline__ uint32_t pack2(float a, float b) { return (uint32_t)f2bf(a) | ((uint32_t)f2bf(b) << 16); }
__device__ __forceinline__ float silu_f(float z) { return z / (1.f + __expf(-z)); }
__device__ __forceinline__ float sigmoid_f(float z) { return 1.f / (1.f + __expf(-z)); }

__device__ __forceinline__ int opq(int v) { asm volatile("" : "+v"(v)); return v; }
__device__ __forceinline__ int opqs(int v) { asm volatile("" : "+s"(v)); return v; }
#define TIDX opq((int)threadIdx.x)
#define BIDX opqs((int)blockIdx.x)
#define MFMA(a, b, c) __builtin_amdgcn_mfma_f32_16x16x32_bf16((a), (b), (c), 0, 0, 0)

__device__ __forceinline__ void rms_rows(const float* __restrict__ x, const float* __restrict__ g, u16* __restrict__ h) {
  const int lane = TIDX & 63, wave = TIDX >> 6;
  for (int row = BIDX * 4 + wave; row < MTOK; row += gridDim.x * 4) {
    const float4* xr = (const float4*)(x + (size_t)row * DM);
    float4 v[4];
    float ss = 0.f;
#pragma unroll
    for (int i = 0; i < 4; ++i) {
      v[i] = xr[lane + 64 * i];
      ss += v[i].x * v[i].x + v[i].y * v[i].y + v[i].z * v[i].z + v[i].w * v[i].w;
    }
#pragma unroll
    for (int o = 32; o >= 1; o >>= 1) ss += __shfl_xor(ss, o);
    const float rstd = rsqrtf(ss * (1.f / DM) + 1e-6f);
#pragma unroll
    for (int i = 0; i < 4; ++i) {
      float4 gg = ((const float4*)g)[lane + 64 * i];
      uint2 o;
      o.x = pack2(v[i].x * rstd * gg.x, v[i].y * rstd * gg.y);
      o.y = pack2(v[i].z * rstd * gg.z, v[i].w * rstd * gg.w);
      *(uint2*)(h + (size_t)row * DM + (lane + 64 * i) * 4) = o;
    }
  }
}

__device__ __forceinline__ int map_col(int MAP, int n) {
  if (MAP == 0) {
    if (n < 1024) return n;
    if (n < 2048) return n + 520;
    if (n < 3072) return n + 1032;
    if (n < 3584) return n - 2048;
    if (n < 4096) return n - 1016;
    if (n < 4104) return n - 2560;
    return -1;
  } else if (MAP == 1) {
    if (n < 1792) return n;
    if (n < 2048) return n + 256;
    if (n < 3072) return n + 560;
    if (n < 3328) return n - 1280;
    if (n < 3584) return n - 1024;
    if (n < 3632) return n - 1024;
    return -1;
  } else if (MAP == 2) {
    return n;
  }
  return n;
}

__device__ __forceinline__ void conv_t(u16* __restrict__ dst, const float* __restrict__ src, int K, int nsrc, int ndst, int MAP) {
  const int total = ndst * (K >> 3);
  for (int id = BIDX * 256 + TIDX; id < total; id += gridDim.x * 256) {
    const int n = id % ndst, kc = id / ndst;
    const int sc = map_col(MAP, n);
    float v[8];
#pragma unroll
    for (int i = 0; i < 8; ++i) v[i] = (sc >= 0 && sc < nsrc) ? src[(size_t)(kc * 8 + i) * nsrc + sc] : 0.f;
    uint4 o;
    o.x = pack2(v[0], v[1]); o.y = pack2(v[2], v[3]); o.z = pack2(v[4], v[5]); o.w = pack2(v[6], v[7]);
    *(uint4*)(dst + (size_t)n * K + kc * 8) = o;
  }
}

__device__ __forceinline__ void pe_partial(const Params& p) {
  float* part = (float*)(p.ws + WS_PEP);
  for (int task = BIDX; task < 32; task += gridDim.x) {
    const int kv = task >> 4, kc = task & 15, n = TIDX;
    const float* pe = kv ? p.o_pev : p.o_pek;
    const float* w1 = kv ? p.o_wv1 : p.o_wk1;
    float acc = 0.f;
#pragma unroll 16
    for (int k = kc * 128; k < kc * 128 + 128; ++k) acc += pe[k] * w1[(size_t)k * 256 + n];
    part[(kv * 16 + kc) * 256 + n] = acc;
  }
}

__device__ __forceinline__ void gemm_mainloop(const u16* __restrict__ Ab, const uint32_t (&pa)[4], const u16* __restrict__ Bb,
                                              const uint32_t (&pb)[4], int a_kstride, int nk,
                                              u16* lds, f32x4 (&acc)[4][4], bool swapped) {
  const int tid = TIDX, lane = tid & 63, wave = tid >> 6;
  const int l16 = lane & 15, gk = lane >> 4;
  const int wx = wave >> 1, wy = wave & 1;
  int woff[4];
#pragma unroll
  for (int i = 0; i < 4; ++i) { int c = tid + 256 * i; woff[i] = (c >> 3) * TS + (c & 7) * 8; }
  uint4 ra0, ra1, ra2, ra3, rb0, rb1, rb2, rb3;
#define G_LD(Ap, Bp) ra0 = *(const uint4*)((Ap) + pa[0]); ra1 = *(const uint4*)((Ap) + pa[1]); ra2 = *(const uint4*)((Ap) + pa[2]); ra3 = *(const uint4*)((Ap) + pa[3]); \
                     rb0 = *(const uint4*)((Bp) + pb[0]); rb1 = *(const uint4*)((Bp) + pb[1]); rb2 = *(const uint4*)((Bp) + pb[2]); rb3 = *(const uint4*)((Bp) + pb[3]);
#define G_ST(D) *(uint4*)((D) + woff[0]) = ra0; *(uint4*)((D) + woff[1]) = ra1; *(uint4*)((D) + woff[2]) = ra2; *(uint4*)((D) + woff[3]) = ra3; \
                *(uint4*)((D) + 128 * TS + woff[0]) = rb0; *(uint4*)((D) + 128 * TS + woff[1]) = rb1; *(uint4*)((D) + 128 * TS + woff[2]) = rb2; *(uint4*)((D) + 128 * TS + woff[3]) = rb3;
  G_LD(Ab, Bb)
  __syncthreads();
  G_ST(lds)
  __syncthreads();
#pragma unroll
  for (int i = 0; i < 4; ++i)
#pragma unroll
    for (int j = 0; j < 4; ++j) acc[i][j] = (f32x4){0.f, 0.f, 0.f, 0.f};
#pragma unroll 1
  for (int ks = 0; ks < nk; ++ks) {
    u16* cur = lds + (ks & 1) * (256 * TS);
    const bool more = (ks + 1 < nk);
    if (more) {
      const u16* An = Ab + (size_t)(ks + 1) * a_kstride;
      const u16* Bn = Bb + (size_t)(ks + 1) * 64;
      G_LD(An, Bn)
    }
    const u16* sX = swapped ? cur + 128 * TS : cur;
    const u16* sY = swapped ? cur : cur + 128 * TS;
#pragma unroll
    for (int kk = 0; kk < 2; ++kk) {
      bf16x8 fx[4], fy[4];
#pragma unroll
      for (int i = 0; i < 4; ++i) {
        fx[i] = *(const bf16x8*)(sX + (wx * 64 + i * 16 + l16) * TS + kk * 32 + gk * 8);
        fy[i] = *(const bf16x8*)(sY + (wy * 64 + i * 16 + l16) * TS + kk * 32 + gk * 8);
      }
#pragma unroll
      for (int i = 0; i < 4; ++i)
#pragma unroll
        for (int j = 0; j < 4; ++j) acc[i][j] = MFMA(fx[i], fy[j], acc[i][j]);
    }
    if (more) {
      u16* nxt = lds + ((ks + 1) & 1) * (256 * TS);
      G_ST(nxt)
    }
    __syncthreads();
  }
#undef G_LD
#undef G_ST
}

__device__ __forceinline__ void gemm_inproj(const Params& p, int layer, u16* lds) {
  const u16* A = (const u16*)(p.ws + WS_HBF);
  const u16* Bt = (const u16*)(p.ws + (layer ? WS_WT1 : WS_WT0));
  u16* QK = (u16*)(p.ws + WS_QK);
  u16* VT = (u16*)(p.ws + WS_VT);
  float* F = (float*)(p.ws + (layer ? WS_GL : WS_FLOG));
  const int NT = layer ? 29 : 33;
  const int ntrans_end = layer ? 28 : 32;
  const int nvalidF = layer ? 48 : 8, ldf = layer ? 48 : 8;
  const int tid = TIDX, lane = tid & 63, wave = tid >> 6, l16 = lane & 15, gk = lane >> 4;
  const int wx = wave >> 1, wy = wave & 1;
  for (int tile = BIDX; tile < 256 * NT; tile += gridDim.x) {
    const int mt = tile / NT, nt = tile % NT;
    const int m0 = mt * 128, n0 = nt * 128;
    int mode;
    if (nt < 24) mode = (layer == 0 && nt >= 12 && nt < 16) ? 2 : 0;
    else if (nt < ntrans_end) mode = 1;
    else mode = 3;
    const bool swapped = (mode == 0 || mode == 3);
    uint32_t pa[4], pb[4];
#pragma unroll
    for (int i = 0; i < 4; ++i) {
      int c = tid + 256 * i, row = c >> 3, kc = c & 7;
      pa[i] = row * DM + kc * 8;
      pb[i] = row * DM + kc * 8;
    }
    f32x4 acc[4][4];
    gemm_mainloop(A + (size_t)m0 * DM, pa, Bt + (size_t)n0 * DM, pb, 64, 16, lds, acc, swapped);
    if (swapped) {
#pragma unroll
      for (int i = 0; i < 4; ++i)
#pragma unroll
        for (int j = 0; j < 4; ++j) {
          const int n = n0 + wx * 64 + i * 16 + gk * 4;
          const int m = m0 + wy * 64 + j * 16 + l16;
          if (mode == 0) {
            uint2 o; o.x = pack2(acc[i][j][0], acc[i][j][1]); o.y = pack2(acc[i][j][2], acc[i][j][3]);
            *(uint2*)(QK + (size_t)m * LDQ + n) = o;
          } else {
            const int nn = n - n0;
            if (nn < nvalidF) *(float4*)(F + (size_t)m * ldf + nn) = (float4){acc[i][j][0], acc[i][j][1], acc[i][j][2], acc[i][j][3]};
          }
        }
    } else {
#pragma unroll
      for (int i = 0; i < 4; ++i)
#pragma unroll
        for (int j = 0; j < 4; ++j) {
          const int m = m0 + wx * 64 + i * 16 + gk * 4;
          const int n = n0 + wy * 64 + j * 16 + l16;
          if (mode == 1) {
            const int trow = n - 3072;
            uint2 o; o.x = pack2(acc[i][j][0], acc[i][j][1]); o.y = pack2(acc[i][j][2], acc[i][j][3]);
            *(uint2*)(VT + (size_t)trow * MTOK + m) = o;
          } else {
            const int trow = n - 512;
            const int h = (n - 1536) >> 6;
            const float lg2 = log1pf(-exp2f(-5.f - (float)h)) * LOG2E;
            float sv[4];
#pragma unroll
            for (int r = 0; r < 4; ++r) {
              QK[(size_t)(m + r) * LDQ + n] = f2bf(acc[i][j][r]);
              sv[r] = acc[i][j][r] * 0.125f * exp2f(lg2 * (float)(127 - ((m + r) & 127)));
            }
            uint2 o; o.x = pack2(sv[0], sv[1]); o.y = pack2(sv[2], sv[3]);
            *(uint2*)(VT + (size_t)trow * MTOK + m) = o;
          }
        }
    }
  }
}

__device__ __forceinline__ void gemm_outproj(const Params& p, int layer, u16* lds) {
  const u16* A = (const u16*)(p.ws + WS_Y);
  const u16* Bt = (const u16*)(p.ws + (layer ? WS_WO1 : WS_WO0));
  const float* res = layer ? p.out : p.x;
  float* out = p.out;
  const int tid = TIDX, lane = tid & 63, wave = tid >> 6, l16 = lane & 15, gk = lane >> 4;
  const int wx = wave >> 1, wy = wave & 1;
  for (int tile = BIDX; tile < 256 * 8; tile += gridDim.x) {
    const int mt = tile >> 3, nt = tile & 7;
    const int m0 = mt * 128, n0 = nt * 128;
    uint32_t pa[4], pb[4];
#pragma unroll
    for (int i = 0; i < 4; ++i) {
      int c = tid + 256 * i, row = c >> 3, kc = c & 7;
      pa[i] = row * DM + kc * 8;
      pb[i] = row * DM + kc * 8;
    }
    f32x4 acc[4][4];
    gemm_mainloop(A + (size_t)m0 * DM, pa, Bt + (size_t)n0 * DM, pb, 64, 16, lds, acc, true);
#pragma unroll
    for (int i = 0; i < 4; ++i)
#pragma unroll
      for (int j = 0; j < 4; ++j) {
        const int n = n0 + wx * 64 + i * 16 + gk * 4;
        const int m = m0 + wy * 64 + j * 16 + l16;
        const float4 r = *(const float4*)(res + (size_t)m * DM + n);
        *(float4*)(out + (size_t)m * DM + n) = (float4){r.x + acc[i][j][0], r.y + acc[i][j][1], r.z + acc[i][j][2], r.w + acc[i][j][3]};
      }
  }
}

__device__ __forceinline__ void gemm_cmp1(const Params& p, u16* lds) {
  const u16* U = (const u16*)(p.ws + WS_QK);
  const float* peb = (const float*)(p.ws + WS_PEB);
  const int tid = TIDX, lane = tid & 63, wave = tid >> 6, l16 = lane & 15, gk = lane >> 4;
  const int wx = wave >> 1, wy = wave & 1;
  for (int tile = BIDX; tile < 2 * 64 * 2; tile += gridDim.x) {
    const int kv = tile >> 7, mt = (tile >> 1) & 63, nt = tile & 1;
    const int m0 = mt * 128, n0 = nt * 128;
    const u16* Bt = (const u16*)(p.ws + (kv ? WS_W1V : WS_W1K));
    u16* Hc = (u16*)(p.ws + WS_HC) + (size_t)kv * 8192 * 256;
    uint32_t pa[4], pb[4];
#pragma unroll
    for (int i = 0; i < 4; ++i) {
      int c = tid + 256 * i, row = c >> 3, kc = c & 7;
      const int r = m0 + row, bg = r >> 9, cc = r & 511, b = bg >> 2, g = bg & 3;
      int tok0 = cc * 16; if (tok0 > SEQ - 32) tok0 = SEQ - 32;
      pa[i] = (uint32_t)(b * SEQ + tok0) * LDQ + 1024 + kv * 256 + g * 64 + kc * 8;
      pb[i] = row * 2048 + kc * 8;
    }
    f32x4 acc[4][4];
    gemm_mainloop(U, pa, Bt + (size_t)n0 * 2048, pb, LDQ, 32, lds, acc, true);
#pragma unroll
    for (int i = 0; i < 4; ++i)
#pragma unroll
      for (int j = 0; j < 4; ++j) {
        const int n = n0 + wx * 64 + i * 16 + gk * 4;
        const int m = m0 + wy * 64 + j * 16 + l16;
        const float4 bb = *(const float4*)(peb + kv * 256 + n);
        float v0 = silu_f(acc[i][j][0] + bb.x), v1 = silu_f(acc[i][j][1] + bb.y);
        float v2 = silu_f(acc[i][j][2] + bb.z), v3 = silu_f(acc[i][j][3] + bb.w);
        if ((m & 511) == 511) { v0 = v1 = v2 = v3 = 0.f; }
        uint2 o; o.x = pack2(v0, v1); o.y = pack2(v2, v3);
        *(uint2*)(Hc + (size_t)m * 256 + n) = o;
      }
  }
}

__device__ __forceinline__ void gemm_cmp2(const Params& p, u16* lds) {
  const int tid = TIDX, lane = tid & 63, wave = tid >> 6, l16 = lane & 15, gk = lane >> 4;
  const int wx = wave >> 1, wy = wave & 1;
  for (int tile = BIDX; tile < 128; tile += gridDim.x) {
    const int kv = tile >> 6, mt = tile & 63;
    const int m0 = mt * 128;
    const u16* A = (const u16*)(p.ws + WS_HC) + (size_t)kv * 8192 * 256;
    const u16* Bt = (const u16*)(p.ws + (kv ? WS_W2V : WS_W2K));
    uint32_t pa[4], pb[4];
#pragma unroll
    for (int i = 0; i < 4; ++i) {
      int c = tid + 256 * i, row = c >> 3, kc = c & 7;
      pa[i] = row * 256 + kc * 8;
      pb[i] = row * 256 + kc * 8;
    }
    f32x4 acc[4][4];
    const bool swapped = (kv == 0);
    gemm_mainloop(A + (size_t)m0 * 256, pa, Bt, pb, 64, 4, lds, acc, swapped);
    if (swapped) {
      u16* kc_ = (u16*)(p.ws + WS_KCMP);
#pragma unroll
      for (int i = 0; i < 4; ++i)
#pragma unroll
        for (int j = 0; j < 4; ++j) {
          const int n = wx * 64 + i * 16 + gk * 4;
          const int m = m0 + wy * 64 + j * 16 + l16;
          if (n < 64) {
            uint2 o; o.x = pack2(acc[i][j][0], acc[i][j][1]); o.y = pack2(acc[i][j][2], acc[i][j][3]);
            *(uint2*)(kc_ + (size_t)m * 64 + n) = o;
          }
        }
    } else {
      u16* vt = (u16*)(p.ws + WS_VCMPT);
#pragma unroll
      for (int i = 0; i < 4; ++i)
#pragma unroll
        for (int j = 0; j < 4; ++j) {
          const int m = m0 + wx * 64 + i * 16 + gk * 4;
          const int n = wy * 64 + j * 16 + l16;
          if (n < 64) {
            uint2 o; o.x = pack2(acc[i][j][0], acc[i][j][1]); o.y = pack2(acc[i][j][2], acc[i][j][3]);
            *(uint2*)(vt + (size_t)(m >> 9) * 32768 + (size_t)n * 512 + (m & 511)) = o;
          }
        }
    }
  }
}

#define TILE_LD(R, src, stride) { const u16* s_ = (src); R##0 = *(const uint4*)(s_ + (long)(tid >> 3) * (stride) + (tid & 7) * 8); \
                                  R##1 = *(const uint4*)(s_ + (long)((tid >> 3) + 32) * (stride) + (tid & 7) * 8); }
#define TILE_ST(dst, R) { u16* d_ = (dst); *(uint4*)(d_ + (tid >> 3) * TS + (tid & 7) * 8) = R##0; \
                          *(uint4*)(d_ + ((tid >> 3) + 32) * TS + (tid & 7) * 8) = R##1; }
__device__ __forceinline__ void qk_tile(const u16* sK, const bf16x8 (&q)[2], f32x4 (&s)[4], int l16, int gk) {
#pragma unroll
  for (int kt = 0; kt < 4; ++kt) s[kt] = (f32x4){0.f, 0.f, 0.f, 0.f};
#pragma unroll
  for (int ks = 0; ks < 2; ++ks)
#pragma unroll
    for (int kt = 0; kt < 4; ++kt) {
      bf16x8 kf = *(const bf16x8*)(sK + (kt * 16 + l16) * TS + ks * 32 + gk * 8);
      s[kt] = MFMA(kf, q[ks], s[kt]);
    }
}
__device__ __forceinline__ void pv_tile(const u16* sV, const float (&pp)[4][4], f32x4 (&o)[4], int l16, int gk) {
  bf16x8 pf[2];
#pragma unroll
  for (int ks2 = 0; ks2 < 2; ++ks2) {
    uint4 t;
    t.x = pack2(pp[2 * ks2][0], pp[2 * ks2][1]); t.y = pack2(pp[2 * ks2][2], pp[2 * ks2][3]);
    t.z = pack2(pp[2 * ks2 + 1][0], pp[2 * ks2 + 1][1]); t.w = pack2(pp[2 * ks2 + 1][2], pp[2 * ks2 + 1][3]);
    pf[ks2] = *(bf16x8*)&t;
  }
#pragma unroll
  for (int dt = 0; dt < 4; ++dt)
#pragma unroll
    for (int ks2 = 0; ks2 < 2; ++ks2) {
      uint2 a0 = *(const uint2*)(sV + (dt * 16 + l16) * TS + (2 * ks2) * 16 + gk * 4);
      uint2 a1 = *(const uint2*)(sV + (dt * 16 + l16) * TS + (2 * ks2 + 1) * 16 + gk * 4);
      uint4 t; t.x = a0.x; t.y = a0.y; t.z = a1.x; t.w = a1.y;
      o[dt] = MFMA(*(bf16x8*)&t, pf[ks2], o[dt]);
    }
}

__device__ __forceinline__ void fox_phase(const Params& p, u16* lds) {
  const u16* QK = (const u16*)(p.ws + WS_QK);
  const u16* VT = (const u16*)(p.ws + WS_VT);
  const float* cf = (const float*)(p.ws + WS_CFOX);
  u16* Y = (u16*)(p.ws + WS_Y);
  const int tid = TIDX, lane = tid & 63, w = tid >> 6, l16 = lane & 15, gk = lane >> 4;
  const float scale2 = 0.125f * LOG2E;
  for (int unit = BIDX; unit < 2048; unit += gridDim.x) {
    const int bh = unit & 31, qblk = 63 - (unit >> 5), b = bh >> 3, h = bh & 7;
    const int tq0 = qblk * 128 + w * 32;
    const float* cfr = cf + (size_t)bh * SEQ;
    bf16x8 q[2][2];
    float cq2[2];
#pragma unroll
    for (int cgi = 0; cgi < 2; ++cgi) {
      const int t = tq0 + cgi * 16 + l16;
#pragma unroll
      for (int ks = 0; ks < 2; ++ks) q[cgi][ks] = *(const bf16x8*)(QK + (size_t)(b * SEQ + t) * LDQ + h * 64 + ks * 32 + gk * 8);
      cq2[cgi] = cfr[t] * LOG2E;
    }
    f32x4 o[2][4];
    float m[2], l[2];
#pragma unroll
    for (int cgi = 0; cgi < 2; ++cgi) {
      m[cgi] = -1e30f; l[cgi] = 0.f;
#pragma unroll
      for (int dt = 0; dt < 4; ++dt) o[cgi][dt] = (f32x4){0.f, 0.f, 0.f, 0.f};
    }
    const int ntiles = qblk * 2 + 2;
    const int iw = qblk * 2 + (w >> 1);
    const u16* ksrc = QK + (size_t)(b * SEQ) * LDQ + 512 + h * 64;
    const u16* vsrc = VT + (size_t)(h * 64) * MTOK + (size_t)b * SEQ;
    uint4 rk0, rk1, rv0, rv1;
    TILE_LD(rk, ksrc, LDQ); TILE_LD(rv, vsrc, MTOK);
    __syncthreads();
    TILE_ST(lds, rk); TILE_ST(lds + 64 * TS, rv);
    __syncthreads();
    for (int i = 0; i < ntiles; ++i) {
      u16* cur = lds + (i & 1) * (128 * TS);
      const bool more = (i + 1 < ntiles);
      if (more) { TILE_LD(rk, ksrc + (size_t)(i + 1) * 64 * LDQ, LDQ); TILE_LD(rv, vsrc + (i + 1) * 64, MTOK); }
      if (i <= iw) {
        const int s0 = i * 64;
        const bool diag = (i == iw);
        float ck2[4][4];
#pragma unroll
        for (int kt = 0; kt < 4; ++kt) {
          float4 c4 = *(const float4*)(cfr + s0 + kt * 16 + gk * 4);
          ck2[kt][0] = c4.x * LOG2E; ck2[kt][1] = c4.y * LOG2E; ck2[kt][2] = c4.z * LOG2E; ck2[kt][3] = c4.w * LOG2E;
        }
#pragma unroll
        for (int cgi = 0; cgi < 2; ++cgi) {
          f32x4 s[4];
          qk_tile(cur, q[cgi], s, l16, gk);
          const int t = tq0 + cgi * 16 + l16;
          float xv[4][4];
          float mx = -1e30f;
#pragma unroll
          for (int kt = 0; kt < 4; ++kt)
#pragma unroll
            for (int r = 0; r < 4; ++r) {
              float v = s[kt][r] * scale2 + cq2[cgi] - ck2[kt][r];
              if (diag && (s0 + kt * 16 + gk * 4 + r > t)) v = -1e30f;
              xv[kt][r] = v; mx = fmaxf(mx, v);
            }
          mx = fmaxf(mx, __shfl_xor(mx, 16)); mx = fmaxf(mx, __shfl_xor(mx, 32));
          const float mnew = fmaxf(m[cgi], mx);
          const float alpha = exp2f(m[cgi] - mnew);
          m[cgi] = mnew;
          const float muse = fmaxf(mnew, -1e20f);
          float rs = 0.f;
#pragma unroll
          for (int kt = 0; kt < 4; ++kt)
#pragma unroll
            for (int r = 0; r < 4; ++r) { xv[kt][r] = exp2f(xv[kt][r] - muse); rs += xv[kt][r]; }
          l[cgi] = l[cgi] * alpha + rs;
#pragma unroll
          for (int dt = 0; dt < 4; ++dt) o[cgi][dt] *= alpha;
          pv_tile(cur + 64 * TS, xv, o[cgi], l16, gk);
        }
      }
      if (more) { u16* nxt = lds + ((i + 1) & 1) * (128 * TS); TILE_ST(nxt, rk); TILE_ST(nxt + 64 * TS, rv); }
      __syncthreads();
    }
#pragma unroll
    for (int cgi = 0; cgi < 2; ++cgi) {
      float lt = l[cgi]; lt += __shfl_xor(lt, 16); lt += __shfl_xor(lt, 32);
      const float inv = lt > 0.f ? 1.f / lt : 0.f;
      const size_t mrow = (size_t)(b * SEQ + tq0 + cgi * 16 + l16);
#pragma unroll
      for (int dt = 0; dt < 4; ++dt) {
        const int col = h * 64 + dt * 16 + gk * 4;
        const uint2 zz = *(const uint2*)(QK + mrow * LDQ + 2048 + col);
        const float z0 = bf2f(zz.x & 0xffff), z1 = bf2f(zz.x >> 16), z2 = bf2f(zz.y & 0xffff), z3 = bf2f(zz.y >> 16);
        uint2 ov;
        ov.x = pack2(o[cgi][dt][0] * inv * silu_f(z0), o[cgi][dt][1] * inv * silu_f(z1));
        ov.y = pack2(o[cgi][dt][2] * inv * silu_f(z2), o[cgi][dt][3] * inv * silu_f(z3));
        *(uint2*)(Y + mrow * DM + col) = ov;
      }
    }
  }
}

__device__ __forceinline__ void fox_scan(const Params& p, float* ldsf) {
  const float* fl = (const float*)(p.ws + WS_FLOG);
  float* cf = (float*)(p.ws + WS_CFOX);
  double* sd = (double*)ldsf;
  const int tid = TIDX;
  for (int bh = BIDX; bh < 32; bh += gridDim.x) {
    const int b = bh >> 3, h = bh & 7;
    const float bf = p.e_bf[h];
    float ls[32];
    double sum = 0.0;
#pragma unroll
    for (int i = 0; i < 32; ++i) {
      const float xx = fl[(size_t)(b * SEQ + tid * 32 + i) * 8 + h] + bf;
      ls[i] = fminf(xx, 0.f) - log1pf(__expf(-fabsf(xx)));
      sum += (double)ls[i];
    }
    __syncthreads();
    sd[tid] = sum;
    __syncthreads();
    double pre = 0.0;
    for (int j = 0; j < tid; ++j) pre += sd[j];
#pragma unroll
    for (int i = 0; i < 32; ++i) { pre += (double)ls[i]; cf[(size_t)bh * SEQ + tid * 32 + i] = (float)pre; }
  }
}

__device__ __forceinline__ void ret_stepA(const Params& p) {
  const u16* VT = (const u16*)(p.ws + WS_VT);
  float* dS = (float*)(p.ws + WS_DS);
  const int lane = TIDX & 63, w = TIDX >> 6, l16 = lane & 15, gk = lane >> 4;
  for (int u = BIDX; u < 2048; u += gridDim.x) {
    const int bh = u >> 6, n = u & 63, b = bh >> 3, h = bh & 7;
    const size_t mcol = (size_t)b * SEQ + n * 128;
    f32x4 acc[4];
#pragma unroll
    for (int dt = 0; dt < 4; ++dt) acc[dt] = (f32x4){0.f, 0.f, 0.f, 0.f};
#pragma unroll
    for (int ks = 0; ks < 4; ++ks) {
      bf16x8 af = *(const bf16x8*)(VT + (size_t)(512 + h * 64 + w * 16 + l16) * MTOK + mcol + ks * 32 + gk * 8);
#pragma unroll
      for (int dt = 0; dt < 4; ++dt) {
        bf16x8 bfr = *(const bf16x8*)(VT + (size_t)(1024 + h * 64 + dt * 16 + l16) * MTOK + mcol + ks * 32 + gk * 8);
        acc[dt] = MFMA(af, bfr, acc[dt]);
      }
    }
#pragma unroll
    for (int dt = 0; dt < 4; ++dt)
#pragma unroll
      for (int r = 0; r < 4; ++r) dS[(size_t)u * 4096 + (w * 16 + gk * 4 + r) * 64 + dt * 16 + l16] = acc[dt][r];
  }
}
__device__ __forceinline__ void ret_stepB(const Params& p) {
  const float* dS = (const float*)(p.ws + WS_DS);
  u16* st = (u16*)(p.ws + WS_ST);
  for (int idx = BIDX * 256 + TIDX; idx < 32 * 4096; idx += gridDim.x * 256) {
    const int bh = idx >> 12, ed = idx & 4095, h = bh & 7;
    const float cdec = __expf(log1pf(-exp2f(-5.f - (float)h)) * 128.f);
    float s = 0.f;
#pragma unroll 8
    for (int n = 0; n < 64; ++n) {
      const size_t a = (size_t)(bh * 64 + n) * 4096 + ed;
      st[a] = f2bf(s);
      s = s * cdec + dS[a];
    }
  }
}
__device__ __forceinline__ void ret_stepC(const Params& p, u16* lds) {
  const u16* QK = (const u16*)(p.ws + WS_QK);
  const u16* VT = (const u16*)(p.ws + WS_VT);
  const u16* st = (const u16*)(p.ws + WS_ST);
  u16* Y = (u16*)(p.ws + WS_Y);
  const int tid = TIDX, lane = tid & 63, w = tid >> 6, l16 = lane & 15, gk = lane >> 4;
  for (int u = BIDX; u < 2048; u += gridDim.x) {
    const int bh = u >> 6, n = u & 63, b = bh >> 3, h = bh & 7;
    const size_t m0 = (size_t)b * SEQ + n * 128;
    const float lg2 = log1pf(-exp2f(-5.f - (float)h)) * LOG2E;
    __syncthreads();
    {
      uint4 r0, r1;
      TILE_LD(r, QK + m0 * LDQ + 1536 + h * 64, LDQ); TILE_ST(lds, r);
      TILE_LD(r, VT + (size_t)(512 + h * 64) * MTOK + m0, MTOK); TILE_ST(lds + 64 * TS, r);
      TILE_LD(r, QK + (m0 + 64) * LDQ + 1536 + h * 64, LDQ); TILE_ST(lds + 128 * TS, r);
      TILE_LD(r, VT + (size_t)(512 + h * 64) * MTOK + m0 + 64, MTOK); TILE_ST(lds + 192 * TS, r);
      TILE_LD(r, st + (size_t)u * 4096, 64); TILE_ST(lds + 256 * TS, r);
    }
    __syncthreads();
#pragma unroll
    for (int cgi = 0; cgi < 2; ++cgi) {
      const int iq = 32 * w + cgi * 16 + l16;
      const size_t mrow = m0 + iq;
      bf16x8 q[2];
#pragma unroll
      for (int ks = 0; ks < 2; ++ks) q[ks] = *(const bf16x8*)(QK + mrow * LDQ + 1024 + h * 64 + ks * 32 + gk * 8);
      f32x4 o[4];
#pragma unroll
      for (int dt = 0; dt < 4; ++dt) o[dt] = (f32x4){0.f, 0.f, 0.f, 0.f};
#pragma unroll
      for (int dt = 0; dt < 4; ++dt)
#pragma unroll
        for (int ks = 0; ks < 2; ++ks) {
          bf16x8 sf = *(const bf16x8*)(lds + 256 * TS + (dt * 16 + l16) * TS + ks * 32 + gk * 8);
          o[dt] = MFMA(sf, q[ks], o[dt]);
        }
      const float cross = exp2f(lg2 * (float)(iq + 1));
#pragma unroll
      for (int dt = 0; dt < 4; ++dt) o[dt] *= cross;
#pragma unroll
      for (int k64 = 0; k64 < 2; ++k64) {
        if (k64 * 64 <= 32 * w + 31) {
          f32x4 s[4];
          qk_tile(lds + k64 * 128 * TS, q, s, l16, gk);
          float pp[4][4];
#pragma unroll
          for (int kt = 0; kt < 4; ++kt)
#pragma unroll
            for (int r = 0; r < 4; ++r) {
              const int j = k64 * 64 + kt * 16 + gk * 4 + r;
              pp[kt][r] = (j <= iq) ? s[kt][r] * 0.125f * exp2f(lg2 * (float)(iq - j)) : 0.f;
            }
          pv_tile(lds + k64 * 128 * TS + 64 * TS, pp, o, l16, gk);
        }
      }
      float sm = 0.f;
#pragma unroll
      for (int dt = 0; dt < 4; ++dt) sm += o[dt][0] + o[dt][1] + o[dt][2] + o[dt][3];
      sm += __shfl_xor(sm, 16); sm += __shfl_xor(sm, 32);
      const float mu = sm * (1.f / 64.f);
      float vs = 0.f;
#pragma unroll
      for (int dt = 0; dt < 4; ++dt)
#pragma unroll
        for (int r = 0; r < 4; ++r) { const float d = o[dt][r] - mu; vs += d * d; }
      vs += __shfl_xor(vs, 16); vs += __shfl_xor(vs, 32);
      const float rstd = rsqrtf(vs * (1.f / 64.f) + 1e-5f);
#pragma unroll
      for (int dt = 0; dt < 4; ++dt) {
        const int col = h * 64 + dt * 16 + gk * 4;
        const float4 gg = *(const float4*)(p.e_gn + col);
        const uint2 zz = *(const uint2*)(QK + mrow * LDQ + 2048 + 512 + col);
        const float z0 = bf2f(zz.x & 0xffff), z1 = bf2f(zz.x >> 16), z2 = bf2f(zz.y & 0xffff), z3 = bf2f(zz.y >> 16);
        uint2 ov;
        ov.x = pack2((o[dt][0] - mu) * rstd * gg.x * silu_f(z0), (o[dt][1] - mu) * rstd * gg.y * silu_f(z1));
        ov.y = pack2((o[dt][2] - mu) * rstd * gg.z * silu_f(z2), (o[dt][3] - mu) * rstd * gg.w * silu_f(z3));
        *(uint2*)(Y + mrow * DM + 512 + col) = ov;
      }
    }
  }
}

template <int BR>
__device__ __forceinline__ void nsa_tile(const u16* sK, const u16* sV, const bf16x8 (&q)[4][2], f32x4 (&acc)[4][4],
                                         float (&m)[4], float (&l)[4], const float (&slope2)[4], const float (&gmul)[4],
                                         int t, int pos0, int pstride, int wl, bool lanesel,
                                         float* imp_row, int jbase, float& carry, int lane) {
  const int l16 = lane & 15, gk = lane >> 4;
  const float scale2 = 0.125f * LOG2E;
  float ps[4][4];
  if (BR == 1) {
#pragma unroll
    for (int kt = 0; kt < 4; ++kt)
#pragma unroll
      for (int r = 0; r < 4; ++r) ps[kt][r] = 0.f;
  }
#pragma unroll
  for (int cgi = 0; cgi < 4; ++cgi) {
    f32x4 s[4];
    qk_tile(sK, q[cgi], s, l16, gk);
    float xv[4][4];
    float mx = -1e30f;
#pragma unroll
    for (int kt = 0; kt < 4; ++kt)
#pragma unroll
      for (int r = 0; r < 4; ++r) {
        const int pos = pos0 + (kt * 16 + gk * 4 + r) * pstride;
        const bool valid = lanesel && (pos <= t) && (pos > t - wl);
        float v = s[kt][r] * scale2 + slope2[cgi] * (float)(pos - t);
        v = valid ? v : -1e30f;
        xv[kt][r] = v; mx = fmaxf(mx, v);
      }
    if (BR != 1) {
      mx = fmaxf(mx, __shfl_xor(mx, 16)); mx = fmaxf(mx, __shfl_xor(mx, 32));
      const float mnew = fmaxf(m[cgi], mx);
      const float alpha = exp2f(m[cgi] - mnew);
      m[cgi] = mnew;
      const float muse = fmaxf(mnew, -1e20f);
      float rs = 0.f;
#pragma unroll
      for (int kt = 0; kt < 4; ++kt)
#pragma unroll
        for (int r = 0; r < 4; ++r) { xv[kt][r] = exp2f(xv[kt][r] - muse); rs += xv[kt][r]; }
      l[cgi] = l[cgi] * alpha + rs;
      if (BR == 2) {
#pragma unroll
        for (int dt = 0; dt < 4; ++dt) acc[cgi][dt] *= alpha;
        pv_tile(sV, xv, acc[cgi], l16, gk);
      }
    } else {
      const float muse = fmaxf(m[cgi], -1e20f);
#pragma unroll
      for (int kt = 0; kt < 4; ++kt)
#pragma unroll
        for (int r = 0; r < 4; ++r) {
          const float pn = exp2f(xv[kt][r] - muse) * l[cgi];
          ps[kt][r] += pn;
          xv[kt][r] = pn * gmul[cgi];
        }
      pv_tile(sV, xv, acc[cgi], l16, gk);
    }
  }
  if (BR == 1) {
    const int srcl = (lane + 48) & 63;
#pragma unroll
    for (int kt = 0; kt < 4; ++kt) {
      const float same = __shfl(ps[kt][3], srcl);
      const float prev = __shfl(kt > 0 ? ps[kt > 0 ? kt - 1 : 0][3] : carry, srcl);
      const float pm1 = (gk == 0) ? prev : same;
      imp_row[jbase + kt * 4 + gk] = 2.f * (ps[kt][0] + ps[kt][1] + ps[kt][2]) + ps[kt][3] + pm1;
    }
    carry = ps[3][3];
  }
}

__device__ __forceinline__ void nsa_phase(const Params& p, u16* lds) {
  const u16* U = (const u16*)(p.ws + WS_QK);
  const u16* VT = (const u16*)(p.ws + WS_VT);
  const u16* KC = (const u16*)(p.ws + WS_KCMP);
  const u16* VC = (const u16*)(p.ws + WS_VCMPT);
  const float* GL = (const float*)(p.ws + WS_GL);
  u16* Y = (u16*)(p.ws + WS_Y);
  float* imp = (float*)(lds + 256 * TS);
  uint32_t* umask = (uint32_t*)(imp + 64 * IMPS);
  int* ulist = (int*)(umask + 4);
  const int tid = TIDX, lane = tid & 63, w = tid >> 6, l16 = lane & 15, gk = lane >> 4;
  uint2* totl = (uint2*)imp + (size_t)w * 1024 + lane;
  const int BIG = 1 << 30;
  for (int unit = BIDX; unit < 2048; unit += gridDim.x) {
    const int bg = unit & 15, qb = 127 - (unit >> 4), b = bg >> 2, g = bg & 3;
    const int t0 = qb * 64, t = t0 + 16 * w + l16;
    const size_t mrow = (size_t)b * SEQ + t;
    bf16x8 q[4][2];
    float slope2[4], g1[4];
#pragma unroll
    for (int cgi = 0; cgi < 4; ++cgi) {
      const int h = g * 4 + cgi;
#pragma unroll
      for (int ks = 0; ks < 2; ++ks) q[cgi][ks] = *(const bf16x8*)(U + mrow * LDQ + h * 64 + ks * 32 + gk * 8);
      slope2[cgi] = exp2f(-0.5f * (float)(h + 1)) * LOG2E;
      g1[cgi] = sigmoid_f(GL[mrow * 48 + h * 3] + p.o_bg[h * 3]);
    }
    f32x4 acc[4][4];
    float m[4], l[4];
#pragma unroll
    for (int cgi = 0; cgi < 4; ++cgi) {
      m[cgi] = -1e30f; l[cgi] = 0.f;
#pragma unroll
      for (int dt = 0; dt < 4; ++dt) acc[cgi][dt] = (f32x4){0.f, 0.f, 0.f, 0.f};
    }
    __syncthreads();
    for (int i = tid; i < 64 * IMPS; i += 256) imp[i] = 0.f;
    if (tid < 4) umask[tid] = 0u;
    float* imp_row = imp + (16 * w + l16) * IMPS;
    float carry = 0.f;
    uint4 rk0, rk1, rv0, rv1;
    const int ntc = ((4 * qb + 2) >> 6) + 1;
    const u16* kcs = KC + (size_t)bg * 512 * 64;
    const u16* vcs = VC + (size_t)bg * 32768;
#pragma unroll 1
    for (int pass = 0; pass < 2; ++pass) {
      TILE_LD(rk, kcs, 64); TILE_LD(rv, vcs, 512);
      __syncthreads();
      TILE_ST(lds, rk); TILE_ST(lds + 64 * TS, rv);
      __syncthreads();
#pragma unroll 1
      for (int i = 0; i < ntc; ++i) {
        u16* cur = lds + (i & 1) * (128 * TS);
        const bool more = (i + 1 < ntc);
        if (more) { TILE_LD(rk, kcs + (size_t)(i + 1) * 64 * 64, 64); TILE_LD(rv, vcs + (i + 1) * 64, 512); }
        if (pass == 0) nsa_tile<0>(cur, cur + 64 * TS, q, acc, m, l, slope2, g1, t, 16 * (64 * i) + 31, 16, BIG, true, imp_row, 16 * i, carry, lane);
        else nsa_tile<1>(cur, cur + 64 * TS, q, acc, m, l, slope2, g1, t, 16 * (64 * i) + 31, 16, BIG, true, imp_row, 16 * i, carry, lane);
        if (more) { u16* nxt = lds + ((i + 1) & 1) * (128 * TS); TILE_ST(nxt, rk); TILE_ST(nxt + 64 * TS, rv); }
        __syncthreads();
      }
      if (pass == 0) {
#pragma unroll
        for (int cgi = 0; cgi < 4; ++cgi) {
          float lt = l[cgi]; lt += __shfl_xor(lt, 16); lt += __shfl_xor(lt, 32);
          l[cgi] = lt > 0.f ? 1.f / lt : 0.f;
        }
      }
    }
    uint32_t selm = 0u;
    if (qb < 16) {
      if (gk == 0) selm = (1u << (qb + 1)) - 1u;
    } else {
      float val[32];
#pragma unroll
      for (int i4 = 0; i4 < 8; ++i4) {
        const float4 v4 = *(const float4*)(imp_row + 32 * gk + 4 * i4);
        val[4 * i4] = v4.x; val[4 * i4 + 1] = v4.y; val[4 * i4 + 2] = v4.z; val[4 * i4 + 3] = v4.w;
      }
#pragma unroll
      for (int i = 0; i < 32; ++i) {
        const int j = 32 * gk + i;
        const bool forced = (j == 0) || (j == qb) || (j == qb - 1);
        if (forced) selm |= (1u << i);
        if (forced || j > qb) val[i] = -1.f;
      }
#pragma unroll 1
      for (int it = 0; it < 13; ++it) {
        float best = -2.f; int bj = 0;
#pragma unroll
        for (int i = 0; i < 32; ++i) {
          const float v = ((selm >> i) & 1u) ? -1.f : val[i];
          if (v > best) { best = v; bj = 32 * gk + i; }
        }
#pragma unroll
        for (int o = 16; o <= 32; o <<= 1) {
          const float ov = __shfl_xor(best, o); const int oj = __shfl_xor(bj, o);
          if (ov > best || (ov == best && oj < bj)) { best = ov; bj = oj; }
        }
        if ((bj >> 5) == gk) selm |= (1u << (bj & 31));
      }
    }
    const uint32_t sel0 = __shfl(selm, l16), sel1 = __shfl(selm, l16 + 16), sel2 = __shfl(selm, l16 + 32), sel3 = __shfl(selm, l16 + 48);
    uint32_t wu = selm;
#pragma unroll
    for (int o = 1; o <= 8; o <<= 1) wu |= __shfl_xor(wu, o);
    const uint32_t wun0 = __shfl(wu, 0), wun1 = __shfl(wu, 16), wun2 = __shfl(wu, 32), wun3 = __shfl(wu, 48);
    if (l16 == 0) atomicOr(&umask[gk], wu);
    __syncthreads();
    int nsl = 0;
    {
      const uint32_t u0 = umask[0], u1 = umask[1], u2 = umask[2], u3 = umask[3];
      nsl = __popc(u0) + __popc(u1) + __popc(u2) + __popc(u3);
      if (tid < 128) {
        const uint32_t uw = tid < 32 ? u0 : tid < 64 ? u1 : tid < 96 ? u2 : u3;
        if ((uw >> (tid & 31)) & 1u) {
          int pos = __popc(uw & ((1u << (tid & 31)) - 1u));
          if (tid >= 32) pos += __popc(u0);
          if (tid >= 64) pos += __popc(u1);
          if (tid >= 96) pos += __popc(u2);
          ulist[pos] = tid;
        }
      }
    }
    __syncthreads();
#pragma unroll
    for (int cgi = 0; cgi < 4; ++cgi)
#pragma unroll
      for (int dt = 0; dt < 4; ++dt) {
        uint2 o2; o2.x = pack2(acc[cgi][dt][0], acc[cgi][dt][1]); o2.y = pack2(acc[cgi][dt][2], acc[cgi][dt][3]);
        totl[(cgi * 4 + dt) * 64] = o2;
      }
#pragma unroll 1
    for (int br = 1; br < 3; ++br) {
#pragma unroll
      for (int cgi = 0; cgi < 4; ++cgi) {
        m[cgi] = -1e30f; l[cgi] = 0.f;
#pragma unroll
        for (int dt = 0; dt < 4; ++dt) acc[cgi][dt] = (f32x4){0.f, 0.f, 0.f, 0.f};
      }
      const int i0w = (qb >= 8) ? 0 : 8 - qb;
      const int nt = (br == 1) ? nsl : 9 - i0w;
      const u16* kb = U + (size_t)b * SEQ * LDQ + (br == 1 ? 1536 : 1792) + g * 64;
      const u16* vb = VT + (size_t)((br == 1 ? 0 : 256) + g * 64) * MTOK + (size_t)b * SEQ;
      int s0 = (br == 1) ? ulist[0] * 64 : t0 - 512 + 64 * i0w;
      TILE_LD(rk, kb + (size_t)s0 * LDQ, LDQ); TILE_LD(rv, vb + s0, MTOK);
      __syncthreads();
      TILE_ST(lds, rk); TILE_ST(lds + 64 * TS, rv);
      __syncthreads();
#pragma unroll 1
      for (int i = 0; i < nt; ++i) {
        u16* cur = lds + (i & 1) * (128 * TS);
        const bool more = (i + 1 < nt);
        int s1 = 0;
        if (more) {
          s1 = (br == 1) ? ulist[i + 1] * 64 : s0 + 64;
          TILE_LD(rk, kb + (size_t)s1 * LDQ, LDQ); TILE_LD(rv, vb + s1, MTOK);
        }
        bool wsel = true, ls = true;
        int wl = 512;
        if (br == 1) {
          const int j = s0 >> 6, jw = j >> 5, jb = j & 31;
          const uint32_t ww = jw == 0 ? wun0 : jw == 1 ? wun1 : jw == 2 ? wun2 : wun3;
          const uint32_t sw = jw == 0 ? sel0 : jw == 1 ? sel1 : jw == 2 ? sel2 : sel3;
          wsel = (ww >> jb) & 1u; ls = (sw >> jb) & 1u; wl = BIG;
        }
        if (wsel) nsa_tile<2>(cur, cur + 64 * TS, q, acc, m, l, slope2, g1, t, s0, 1, wl, ls, imp_row, 0, carry, lane);
        if (more) { u16* nxt = lds + ((i + 1) & 1) * (128 * TS); TILE_ST(nxt, rk); TILE_ST(nxt + 64 * TS, rv); }
        s0 = s1;
        __syncthreads();
      }
#pragma unroll
      for (int cgi = 0; cgi < 4; ++cgi) {
        const int h = g * 4 + cgi;
        float lt = l[cgi]; lt += __shfl_xor(lt, 16); lt += __shfl_xor(lt, 32);
        const float gt = sigmoid_f(GL[mrow * 48 + h * 3 + br] + p.o_bg[h * 3 + br]);
        const float sc = lt > 0.f ? gt / lt : 0.f;
#pragma unroll
        for (int dt = 0; dt < 4; ++dt) {
          const uint2 pv = totl[(cgi * 4 + dt) * 64];
          const float r0 = bf2f(pv.x & 0xffff) + acc[cgi][dt][0] * sc, r1 = bf2f(pv.x >> 16) + acc[cgi][dt][1] * sc;
          const float r2 = bf2f(pv.y & 0xffff) + acc[cgi][dt][2] * sc, r3 = bf2f(pv.y >> 16) + acc[cgi][dt][3] * sc;
          if (br == 1) {
            uint2 o2; o2.x = pack2(r0, r1); o2.y = pack2(r2, r3);
            totl[(cgi * 4 + dt) * 64] = o2;
          } else {
            const int col = h * 64 + dt * 16 + gk * 4;
            const uint2 zz = *(const uint2*)(U + mrow * LDQ + 2048 + col);
            const float z0 = bf2f(zz.x & 0xffff), z1 = bf2f(zz.x >> 16), z2 = bf2f(zz.y & 0xffff), z3 = bf2f(zz.y >> 16);
            uint2 ov;
            ov.x = pack2(r0 * silu_f(z0), r1 * silu_f(z1));
            ov.y = pack2(r2 * silu_f(z2), r3 * silu_f(z3));
            *(uint2*)(Y + mrow * DM + col) = ov;
          }
        }
      }
    }
  }
}

__device__ __forceinline__ void final_norm(const Params& p) {
  const int lane = TIDX & 63, wave = TIDX >> 6;
  for (int row = BIDX * 4 + wave; row < MTOK; row += gridDim.x * 4) {
    float4* xr = (float4*)(p.out + (size_t)row * DM);
    float4 v[4];
    float ss = 0.f;
#pragma unroll
    for (int i = 0; i < 4; ++i) {
      v[i] = xr[lane + 64 * i];
      ss += v[i].x * v[i].x + v[i].y * v[i].y + v[i].z * v[i].z + v[i].w * v[i].w;
    }
#pragma unroll
    for (int o = 32; o >= 1; o >>= 1) ss += __shfl_xor(ss, o);
    const float rstd = rsqrtf(ss * (1.f / DM) + 1e-6f);
#pragma unroll
    for (int i = 0; i < 4; ++i) {
      const float4 gg = ((const float4*)p.fin_g)[lane + 64 * i];
      xr[lane + 64 * i] = (float4){v[i].x * rstd * gg.x, v[i].y * rstd * gg.y, v[i].z * rstd * gg.z, v[i].w * rstd * gg.w};
    }
  }
}

__global__ void __launch_bounds__(256, 1) mega(Params p) {
  extern __shared__ __attribute__((aligned(16))) unsigned char lds_raw[];
  u16* lds = (u16*)lds_raw;
  cg::grid_group grid = cg::this_grid();
#define PH_ON(k) (p.ph_lo <= (k) && (k) <= p.ph_hi)
#define PH_SYNC(k) if (p.coop && p.ph_lo <= (k) && (k) < p.ph_hi) grid.sync();
  if (PH_ON(0)) {
    rms_rows(p.x, p.e_ng, (u16*)(p.ws + WS_HBF));
    conv_t((u16*)(p.ws + WS_WT0), p.e_win, 1024, 4104, 4224, 0);
    conv_t((u16*)(p.ws + WS_WT1), p.o_win, 1024, 3632, 3712, 1);
    conv_t((u16*)(p.ws + WS_WO0), p.e_wout, 1024, 1024, 1024, 2);
    conv_t((u16*)(p.ws + WS_WO1), p.o_wout, 1024, 1024, 1024, 2);
    conv_t((u16*)(p.ws + WS_W1K), p.o_wk1, 2048, 256, 256, 2);
    conv_t((u16*)(p.ws + WS_W1V), p.o_wv1, 2048, 256, 256, 2);
    conv_t((u16*)(p.ws + WS_W2K), p.o_wk2, 256, 64, 128, 2);
    conv_t((u16*)(p.ws + WS_W2V), p.o_wv2, 256, 64, 128, 2);
    pe_partial(p);
  }
  PH_SYNC(0)
  if (PH_ON(1)) gemm_inproj(p, 0, lds);
  PH_SYNC(1)
  if (PH_ON(2)) { fox_scan(p, (float*)lds); ret_stepA(p); }
  PH_SYNC(2)
  if (PH_ON(3)) { ret_stepB(p); fox_phase(p, lds); }
  PH_SYNC(3)
  if (PH_ON(4)) ret_stepC(p, lds);
  PH_SYNC(4)
  if (PH_ON(5)) gemm_outproj(p, 0, lds);
  PH_SYNC(5)
  if (PH_ON(6)) {
    rms_rows(p.out, p.o_ng, (u16*)(p.ws + WS_HBF));
    if (BIDX == 0) {
      for (int i = TIDX; i < 512; i += 256) {
        const float* part = (const float*)(p.ws + WS_PEP);
        float s = 0.f;
        for (int kc = 0; kc < 16; ++kc) s += part[((i >> 8) * 16 + kc) * 256 + (i & 255)];
        ((float*)(p.ws + WS_PEB))[i] = s;
      }
    }
  }
  PH_SYNC(6)
  if (PH_ON(7)) gemm_inproj(p, 1, lds);
  PH_SYNC(7)
  if (PH_ON(8)) gemm_cmp1(p, lds);
  PH_SYNC(8)
  if (PH_ON(9)) gemm_cmp2(p, lds);
  PH_SYNC(9)
  if (PH_ON(10)) nsa_phase(p, lds);
  PH_SYNC(10)
  if (PH_ON(11)) gemm_outproj(p, 1, lds);
  PH_SYNC(11)
  if (PH_ON(12)) final_norm(p);
}

extern "C" void kernel_launch(void* const* d_in, const int* in_sizes, int n_in, void* d_out, int out_size, void* d_ws,
                              size_t ws_size, hipStream_t stream) {
  static int grid_blocks = 0;
  if (!grid_blocks) {
    int dev = 0, cus = 0, per_cu = 0;
    hipGetDevice(&dev);
    hipDeviceGetAttribute(&cus, hipDeviceAttributeMultiprocessorCount, dev);
    hipFuncSetAttribute((const void*)mega, hipFuncAttributeMaxDynamicSharedMemorySize, LDS_BYTES);
    hipOccupancyMaxActiveBlocksPerMultiprocessor(&per_cu, (const void*)mega, 256, LDS_BYTES);
    if (per_cu < 1) per_cu = 1;
    if (per_cu > 2) per_cu = 2;
    grid_blocks = cus * per_cu;
    (void)hipGetLastError();
  }
  Params p{};
  p.x = (const float*)d_in[0]; p.e_ng = (const float*)d_in[1]; p.e_win = (const float*)d_in[2];
  p.e_bf = (const float*)d_in[3]; p.e_gn = (const float*)d_in[4]; p.e_wout = (const float*)d_in[5];
  p.o_ng = (const float*)d_in[6]; p.o_win = (const float*)d_in[7]; p.o_bg = (const float*)d_in[8];
  p.o_pek = (const float*)d_in[9]; p.o_pev = (const float*)d_in[10]; p.o_wk1 = (const float*)d_in[11];
  p.o_wk2 = (const float*)d_in[12]; p.o_wv1 = (const float*)d_in[13]; p.o_wv2 = (const float*)d_in[14];
  p.o_wout = (const float*)d_in[15]; p.fin_g = (const float*)d_in[16];
  p.out = (float*)d_out; p.ws = (unsigned char*)d_ws;
#if ONE_LAUNCH
  p.ph_lo = 0; p.ph_hi = NPHASE - 1; p.coop = 1;
  void* args[] = {&p};
  hipError_t e = hipLaunchCooperativeKernel((const void*)mega, dim3(grid_blocks), dim3(256), args, LDS_BYTES, stream);
  if (e != hipSuccess) fprintf(stderr, "cooperative launch failed: %s (grid %d)\n", hipGetErrorString(e), grid_blocks);
#else
  for (int ph = 0; ph < NPHASE; ++ph) {
    p.ph_lo = ph; p.ph_hi = ph; p.coop = 0;
    hipLaunchKernelGGL(mega, dim3(grid_blocks), dim3(256), LDS_BYTES, stream, p);
  }
#endif
}
```

```cpp
#include <hip/hip_runtime.h>
#include <hip/hip_cooperative_groups.h>
#include <stdint.h>
#include <stdio.h>
namespace cg = cooperative_groups;

typedef unsigned short u16;
typedef short bf16x8 __attribute__((ext_vector_type(8)));
typedef short bf16x4 __attribute__((ext_vector_type(4)));
typedef float f32x4 __attribute__((ext_vector_type(4)));

#ifndef ONE_LAUNCH
#define ONE_LAUNCH 1
#endif

#define MTOK 32768
#define SEQ 8192
#define DM 1024
#define LDQ 3072
#define LOG2E 1.4426950408889634f
#define TS 72
#define IMPS 132
#define LDS_BYTES 73728
#define NPHASE 13

#define MiB (1024ull * 1024ull)
#define WS_HBF   (0ull)
#define WS_DS    (0ull)
#define WS_ST    (32ull * MiB)
#define WS_QK    (64ull * MiB)
#define WS_VT    (256ull * MiB)
#define WS_Y     (352ull * MiB)
#define WS_WT0   (416ull * MiB)
#define WS_WT1   (WS_WT0 + 4224ull * 1024 * 2)
#define WS_WO0   (WS_WT1 + 3712ull * 1024 * 2)
#define WS_WO1   (WS_WO0 + 1024ull * 1024 * 2)
#define WS_W1K   (WS_WO1 + 1024ull * 1024 * 2)
#define WS_W1V   (WS_W1K + 256ull * 2048 * 2)
#define WS_W2K   (WS_W1V + 256ull * 2048 * 2)
#define WS_W2V   (WS_W2K + 128ull * 256 * 2)
#define WS_FLOG  (440ull * MiB)
#define WS_CFOX  (441ull * MiB)
#define WS_GL    (442ull * MiB)
#define WS_HC    (448ull * MiB)
#define WS_KCMP  (456ull * MiB)
#define WS_VCMPT (457ull * MiB)
#define WS_PEP   (458ull * MiB)
#define WS_PEB   (WS_PEP + 65536ull)
#define WS_KMAX  (WS_PEB + 4096ull)

struct Params {
  const float *x, *e_ng, *e_win, *e_bf, *e_gn, *e_wout;
  const float *o_ng, *o_win, *o_bg, *o_pek, *o_pev, *o_wk1, *o_wk2, *o_wv1, *o_wv2, *o_wout, *fin_g;
  float* out;
  unsigned char* ws;
  int ph_lo, ph_hi, coop, pad;
};

__device__ __forceinline__ u16 f2bf(float f) {
  uint32_t u = __float_as_uint(f);
  u += 0x7fffu + ((u >> 16) & 1u);
  return (u16)(u >> 16);
}
__device__ __forceinline__ float bf2f(u16 h) { return __uint_as_float(((uint32_t)h) << 16); }
__device__ __forceinline__ uint32_t pack2(float a, float b) { return (uint32_t)f2bf(a) | ((uint32_t)f2bf(b) << 16); }
__device__ __forceinline__ float silu_f(float z) { return z / (1.f + __expf(-z)); }
__device__ __forceinline__ float sigmoid_f(float z) { return 1.f / (1.f + __expf(-z)); }

__device__ __forceinline__ int opq(int v) { asm volatile("" : "+v"(v)); return v; }
__device__ __forceinline__ int opqs(int v) { asm volatile("" : "+s"(v)); return v; }
#define TIDX opq((int)threadIdx.x)
#define BIDX opqs((int)blockIdx.x)
#define MFMA(a, b, c) __builtin_amdgcn_mfma_f32_16x16x32_bf16((a), (b), (c), 0, 0, 0)

__device__ __forceinline__ void rms_rows(const float* __restrict__ x, const float* __restrict__ g, u16* __restrict__ h) {
  const int lane = TIDX & 63, wave = TIDX >> 6;
  for (int row = BIDX * 4 + wave; row < MTOK; row += gridDim.x * 4) {
    const float4* xr = (const float4*)(x + (size_t)row * DM);
    float4 v[4];
    float ss = 0.f;
#pragma unroll
    for (int i = 0; i < 4; ++i) {
      v[i] = xr[lane + 64 * i];
      ss += v[i].x * v[i].x + v[i].y * v[i].y + v[i].z * v[i].z + v[i].w * v[i].w;
    }
#pragma unroll
    for (int o = 32; o >= 1; o >>= 1) ss += __shfl_xor(ss, o);
    const float rstd = rsqrtf(ss * (1.f / DM) + 1e-6f);
#pragma unroll
    for (int i = 0; i < 4; ++i) {
      float4 gg = ((const float4*)g)[lane + 64 * i];
      uint2 o;
      o.x = pack2(v[i].x * rstd * gg.x, v[i].y * rstd * gg.y);
      o.y = pack2(v[i].z * rstd * gg.z, v[i].w * rstd * gg.w);
      *(uint2*)(h + (size_t)row * DM + (lane + 64 * i) * 4) = o;
    }
  }
}

__device__ __forceinline__ int map_col(int MAP, int n) {
  if (MAP == 0) {
    if (n < 1024) return n;
    if (n < 2048) return n + 520;
    if (n < 3072) return n + 1032;
    if (n < 3584) return n - 2048;
    if (n < 4096) return n - 1016;
    if (n < 4104) return n - 2560;
    return -1;
  } else if (MAP == 1) {
    if (n < 1792) return n;
    if (n < 2048) return n + 256;
    if (n < 3072) return n + 560;
    if (n < 3328) return n - 1280;
    if (n < 3584) return n - 1024;
    if (n < 3632) return n - 1024;
    return -1;
  } else if (MAP == 2) {
    return n;
  }
  return n;
}

__device__ __forceinline__ void conv_t(u16* __restrict__ dst, const float* __restrict__ src, int K, int nsrc, int ndst, int MAP) {
  const int total = ndst * (K >> 3);
  for (int id = BIDX * 256 + TIDX; id < total; id += gridDim.x * 256) {
    const int n = id % ndst, kc = id / ndst;
    const int sc = map_col(MAP, n);
    float v[8];
#pragma unroll
    for (int i = 0; i < 8; ++i) v[i] = (sc >= 0 && sc < nsrc) ? src[(size_t)(kc * 8 + i) * nsrc + sc] : 0.f;
    uint4 o;
    o.x = pack2(v[0], v[1]); o.y = pack2(v[2], v[3]); o.z = pack2(v[4], v[5]); o.w = pack2(v[6], v[7]);
    *(uint4*)(dst + (size_t)n * K + kc * 8) = o;
  }
}

__device__ __forceinline__ void pe_partial(const Params& p) {
  float* part = (float*)(p.ws + WS_PEP);
  for (int task = BIDX; task < 32; task += gridDim.x) {
    const int kv = task >> 4, kc = task & 15, n = TIDX;
    const float* pe = kv ? p.o_pev : p.o_pek;
    const float* w1 = kv ? p.o_wv1 : p.o_wk1;
    float acc = 0.f;
#pragma unroll 16
    for (int k = kc * 128; k < kc * 128 + 128; ++k) acc += pe[k] * w1[(size_t)k * 256 + n];
    part[(kv * 16 + kc) * 256 + n] = acc;
  }
}

__device__ __forceinline__ void gemm_mainloop(const u16* __restrict__ Ab, const uint32_t (&pa)[4], const u16* __restrict__ Bb,
                                              const uint32_t (&pb)[4], int a_kstride, int nk,
                                              u16* lds, f32x4 (&acc)[4][4], bool swapped) {
  const int tid = TIDX, lane = tid & 63, wave = tid >> 6;
  const int l16 = lane & 15, gk = lane >> 4;
  const int wx = wave >> 1, wy = wave & 1;
  int woff[4];
#pragma unroll
  for (int i = 0; i < 4; ++i) { int c = tid + 256 * i; woff[i] = (c >> 3) * TS + (c & 7) * 8; }
  uint4 ra0, ra1, ra2, ra3, rb0, rb1, rb2, rb3;
#define G_LD(Ap, Bp) ra0 = *(const uint4*)((Ap) + pa[0]); ra1 = *(const uint4*)((Ap) + pa[1]); ra2 = *(const uint4*)((Ap) + pa[2]); ra3 = *(const uint4*)((Ap) + pa[3]); \
                     rb0 = *(const uint4*)((Bp) + pb[0]); rb1 = *(const uint4*)((Bp) + pb[1]); rb2 = *(const uint4*)((Bp) + pb[2]); rb3 = *(const uint4*)((Bp) + pb[3]);
#define G_ST(D) *(uint4*)((D) + woff[0]) = ra0; *(uint4*)((D) + woff[1]) = ra1; *(uint4*)((D) + woff[2]) = ra2; *(uint4*)((D) + woff[3]) = ra3; \
                *(uint4*)((D) + 128 * TS + woff[0]) = rb0; *(uint4*)((D) + 128 * TS + woff[1]) = rb1; *(uint4*)((D) + 128 * TS + woff[2]) = rb2; *(uint4*)((D) + 128 * TS + woff[3]) = rb3;
  G_LD(Ab, Bb)
  __syncthreads();
  G_ST(lds)
  __syncthreads();
#pragma unroll
  for (int i = 0; i < 4; ++i)
#pragma unroll
    for (int j = 0; j < 4; ++j) acc[i][j] = (f32x4){0.f, 0.f, 0.f, 0.f};
#pragma unroll 1
  for (int ks = 0; ks < nk; ++ks) {
    u16* cur = lds + (ks & 1) * (256 * TS);
    const bool more = (ks + 1 < nk);
    if (more) {
      const u16* An = Ab + (size_t)(ks + 1) * a_kstride;
      const u16* Bn = Bb + (size_t)(ks + 1) * 64;
      G_LD(An, Bn)
    }
    const u16* sX = swapped ? cur + 128 * TS : cur;
    const u16* sY = swapped ? cur : cur + 128 * TS;
#pragma unroll
    for (int kk = 0; kk < 2; ++kk) {
      bf16x8 fx[4], fy[4];
#pragma unroll
      for (int i = 0; i < 4; ++i) {
        fx[i] = *(const bf16x8*)(sX + (wx * 64 + i * 16 + l16) * TS + kk * 32 + gk * 8);
        fy[i] = *(const bf16x8*)(sY + (wy * 64 + i * 16 + l16) * TS + kk * 32 + gk * 8);
      }
#pragma unroll
      for (int i = 0; i < 4; ++i)
#pragma unroll
        for (int j = 0; j < 4; ++j) acc[i][j] = MFMA(fx[i], fy[j], acc[i][j]);
    }
    if (more) {
      u16* nxt = lds + ((ks + 1) & 1) * (256 * TS);
      G_ST(nxt)
    }
    __syncthreads();
  }
#undef G_LD
#undef G_ST
}

__device__ __forceinline__ void gemm_inproj(const Params& p, int layer, u16* lds) {
  const u16* A = (const u16*)(p.ws + WS_HBF);
  const u16* Bt = (const u16*)(p.ws + (layer ? WS_WT1 : WS_WT0));
  u16* QK = (u16*)(p.ws + WS_QK);
  u16* VT = (u16*)(p.ws + WS_VT);
  float* F = (float*)(p.ws + (layer ? WS_GL : WS_FLOG));
  const int NT = layer ? 29 : 33;
  const int ntrans_end = layer ? 28 : 32;
  const int nvalidF = layer ? 48 : 8, ldf = layer ? 48 : 8;
  const int tid = TIDX, lane = tid & 63, wave = tid >> 6, l16 = lane & 15, gk = lane >> 4;
  const int wx = wave >> 1, wy = wave & 1;
  for (int tile = BIDX; tile < 256 * NT; tile += gridDim.x) {
    const int mt = tile / NT, nt = tile % NT;
    const int m0 = mt * 128, n0 = nt * 128;
    int mode;
    if (nt < 24) mode = (layer == 0 && nt >= 12 && nt < 16) ? 2 : 0;
    else if (nt < ntrans_end) mode = 1;
    else mode = 3;
    const bool swapped = (mode == 0 || mode == 3);
    uint32_t pa[4], pb[4];
#pragma unroll
    for (int i = 0; i < 4; ++i) {
      int c = tid + 256 * i, row = c >> 3, kc = c & 7;
      pa[i] = row * DM + kc * 8;
      pb[i] = row * DM + kc * 8;
    }
    f32x4 acc[4][4];
    gemm_mainloop(A + (size_t)m0 * DM, pa, Bt + (size_t)n0 * DM, pb, 64, 16, lds, acc, swapped);
    if (swapped) {
#pragma unroll
      for (int i = 0; i < 4; ++i)
#pragma unroll
        for (int j = 0; j < 4; ++j) {
          const int n = n0 + wx * 64 + i * 16 + gk * 4;
          const int m = m0 + wy * 64 + j * 16 + l16;
          if (mode == 0) {
            uint2 o; o.x = pack2(acc[i][j][0], acc[i][j][1]); o.y = pack2(acc[i][j][2], acc[i][j][3]);
            *(uint2*)(QK + (size_t)m * LDQ + n) = o;
          } else {
            const int nn = n - n0;
            if (nn < nvalidF) *(float4*)(F + (size_t)m * ldf + nn) = (float4){acc[i][j][0], acc[i][j][1], acc[i][j][2], acc[i][j][3]};
          }
        }
    } else {
#pragma unroll
      for (int i = 0; i < 4; ++i)
#pragma unroll
        for (int j = 0; j < 4; ++j) {
          const int m = m0 + wx * 64 + i * 16 + gk * 4;
          const int n = n0 + wy * 64 + j * 16 + l16;
          if (mode == 1) {
            const int trow = n - 3072;
            uint2 o; o.x = pack2(acc[i][j][0], acc[i][j][1]); o.y = pack2(acc[i][j][2], acc[i][j][3]);
            *(uint2*)(VT + (size_t)trow * MTOK + m) = o;
          } else {
            const int trow = n - 512;
            const int h = (n - 1536) >> 6;
            const float lg2 = log1pf(-exp2f(-5.f - (float)h)) * LOG2E;
            float sv[4];
#pragma unroll
            for (int r = 0; r < 4; ++r) {
              QK[(size_t)(m + r) * LDQ + n] = f2bf(acc[i][j][r]);
              sv[r] = acc[i][j][r] * 0.125f * exp2f(lg2 * (float)(127 - ((m + r) & 127)));
            }
            uint2 o; o.x = pack2(sv[0], sv[1]); o.y = pack2(sv[2], sv[3]);
            *(uint2*)(VT + (size_t)trow * MTOK + m) = o;
          }
        }
    }
  }
}

__device__ __forceinline__ void gemm_outproj(const Params& p, int layer, u16* lds) {
  const u16* A = (const u16*)(p.ws + WS_Y);
  const u16* Bt = (const u16*)(p.ws + (layer ? WS_WO1 : WS_WO0));
  const float* res = layer ? p.out : p.x;
  float* out = p.out;
  const int tid = TIDX, lane = tid & 63, wave = tid >> 6, l16 = lane & 15, gk = lane >> 4;
  const int wx = wave >> 1, wy = wave & 1;
  for (int tile = BIDX; tile < 256 * 8; tile += gridDim.x) {
    const int mt = tile >> 3, nt = tile & 7;
    const int m0 = mt * 128, n0 = nt * 128;
    uint32_t pa[4], pb[4];
#pragma unroll
    for (int i = 0; i < 4; ++i) {
      int c = tid + 256 * i, row = c >> 3, kc = c & 7;
      pa[i] = row * DM + kc * 8;
      pb[i] = row * DM + kc * 8;
    }
    f32x4 acc[4][4];
    gemm_mainloop(A + (size_t)m0 * DM, pa, Bt + (size_t)n0 * DM, pb, 64, 16, lds, acc, true);
#pragma unroll
    for (int i = 0; i < 4; ++i)
#pragma unroll
      for (int j = 0; j < 4; ++j) {
        const int n = n0 + wx * 64 + i * 16 + gk * 4;
        const int m = m0 + wy * 64 + j * 16 + l16;
        const float4 r = *(const float4*)(res + (size_t)m * DM + n);
        *(float4*)(out + (size_t)m * DM + n) = (float4){r.x + acc[i][j][0], r.y + acc[i][j][1], r.z + acc[i][j][2], r.w + acc[i][j][3]};
      }
  }
}

__device__ __forceinline__ void gemm_cmp1(const Params& p, u16* lds) {
  const u16* U = (const u16*)(p.ws + WS_QK);
  const float* peb = (const float*)(p.ws + WS_PEB);
  const int tid = TIDX, lane = tid & 63, wave = tid >> 6, l16 = lane & 15, gk = lane >> 4;
  const int wx = wave >> 1, wy = wave & 1;
  for (int tile = BIDX; tile < 2 * 64 * 2; tile += gridDim.x) {
    const int kv = tile >> 7, mt = (tile >> 1) & 63, nt = tile & 1;
    const int m0 = mt * 128, n0 = nt * 128;
    const u16* Bt = (const u16*)(p.ws + (kv ? WS_W1V : WS_W1K));
    u16* Hc = (u16*)(p.ws + WS_HC) + (size_t)kv * 8192 * 256;
    uint32_t pa[4], pb[4];
#pragma unroll
    for (int i = 0; i < 4; ++i) {
      int c = tid + 256 * i, row = c >> 3, kc = c & 7;
      const int r = m0 + row, bg = r >> 9, cc = r & 511, b = bg >> 2, g = bg & 3;
      int tok0 = cc * 16; if (tok0 > SEQ - 32) tok0 = SEQ - 32;
      pa[i] = (uint32_t)(b * SEQ + tok0) * LDQ + 1024 + kv * 256 + g * 64 + kc * 8;
      pb[i] = row * 2048 + kc * 8;
    }
    f32x4 acc[4][4];
    gemm_mainloop(U, pa, Bt + (size_t)n0 * 2048, pb, LDQ, 32, lds, acc, true);
#pragma unroll
    for (int i = 0; i < 4; ++i)
#pragma unroll
      for (int j = 0; j < 4; ++j) {
        const int n = n0 + wx * 64 + i * 16 + gk * 4;
        const int m = m0 + wy * 64 + j * 16 + l16;
        const float4 bb = *(const float4*)(peb + kv * 256 + n);
        float v0 = silu_f(acc[i][j][0] + bb.x), v1 = silu_f(acc[i][j][1] + bb.y);
        float v2 = silu_f(acc[i][j][2] + bb.z), v3 = silu_f(acc[i][j][3] + bb.w);
        if ((m & 511) == 511) { v0 = v1 = v2 = v3 = 0.f; }
        uint2 o; o.x = pack2(v0, v1); o.y = pack2(v2, v3);
        *(uint2*)(Hc + (size_t)m * 256 + n) = o;
      }
  }
}

__device__ __forceinline__ void gemm_cmp2(const Params& p, u16* lds) {
  const int tid = TIDX, lane = tid & 63, wave = tid >> 6, l16 = lane & 15, gk = lane >> 4;
  const int wx = wave >> 1, wy = wave & 1;
  for (int tile = BIDX; tile < 128; tile += gridDim.x) {
    const int kv = tile >> 6, mt = tile & 63;
    const int m0 = mt * 128;
    const u16* A = (const u16*)(p.ws + WS_HC) + (size_t)kv * 8192 * 256;
    const u16* Bt = (const u16*)(p.ws + (kv ? WS_W2V : WS_W2K));
    uint32_t pa[4], pb[4];
#pragma unroll
    for (int i = 0; i < 4; ++i) {
      int c = tid + 256 * i, row = c >> 3, kc = c & 7;
      pa[i] = row * 256 + kc * 8;
      pb[i] = row * 256 + kc * 8;
    }
    f32x4 acc[4][4];
    const bool swapped = (kv == 0);
    gemm_mainloop(A + (size_t)m0 * 256, pa, Bt, pb, 64, 4, lds, acc, swapped);
    if (swapped) {
      u16* kc_ = (u16*)(p.ws + WS_KCMP);
#pragma unroll
      for (int i = 0; i < 4; ++i)
#pragma unroll
        for (int j = 0; j < 4; ++j) {
          const int n = wx * 64 + i * 16 + gk * 4;
          const int m = m0 + wy * 64 + j * 16 + l16;
          if (n < 64) {
            uint2 o; o.x = pack2(acc[i][j][0], acc[i][j][1]); o.y = pack2(acc[i][j][2], acc[i][j][3]);
            *(uint2*)(kc_ + (size_t)m * 64 + n) = o;
          }
        }
    } else {
      u16* vt = (u16*)(p.ws + WS_VCMPT);
#pragma unroll
      for (int i = 0; i < 4; ++i)
#pragma unroll
        for (int j = 0; j < 4; ++j) {
          const int m = m0 + wx * 64 + i * 16 + gk * 4;
          const int n = wy * 64 + j * 16 + l16;
          if (n < 64) {
            uint2 o; o.x = pack2(acc[i][j][0], acc[i][j][1]); o.y = pack2(acc[i][j][2], acc[i][j][3]);
            *(uint2*)(vt + (size_t)(m >> 9) * 32768 + (size_t)n * 512 + (m & 511)) = o;
          }
        }
    }
  }
}

#define TILE_LD(R, src, stride) { const u16* s_ = (src); R##0 = *(const uint4*)(s_ + (long)(tid >> 3) * (stride) + (tid & 7) * 8); \
                                  R##1 = *(const uint4*)(s_ + (long)((tid >> 3) + 32) * (stride) + (tid & 7) * 8); }
#define TILE_ST(dst, R) { u16* d_ = (dst); *(uint4*)(d_ + (tid >> 3) * TS + (tid & 7) * 8) = R##0; \
                          *(uint4*)(d_ + ((tid >> 3) + 32) * TS + (tid & 7) * 8) = R##1; }
__device__ __forceinline__ void qk_tile(const u16* sK, const bf16x8 (&q)[2], f32x4 (&s)[4], int l16, int gk) {
#pragma unroll
  for (int kt = 0; kt < 4; ++kt) s[kt] = (f32x4){0.f, 0.f, 0.f, 0.f};
#pragma unroll
  for (int ks = 0; ks < 2; ++ks)
#pragma unroll
    for (int kt = 0; kt < 4; ++kt) {
      bf16x8 kf = *(const bf16x8*)(sK + (kt * 16 + l16) * TS + ks * 32 + gk * 8);
      s[kt] = MFMA(kf, q[ks], s[kt]);
    }
}
__device__ __forceinline__ void pv_tile(const u16* sV, const float (&pp)[4][4], f32x4 (&o)[4], int l16, int gk) {
  bf16x8 pf[2];
#pragma unroll
  for (int ks2 = 0; ks2 < 2; ++ks2) {
    uint4 t;
    t.x = pack2(pp[2 * ks2][0], pp[2 * ks2][1]); t.y = pack2(pp[2 * ks2][2], pp[2 * ks2][3]);
    t.z = pack2(pp[2 * ks2 + 1][0], pp[2 * ks2 + 1][1]); t.w = pack2(pp[2 * ks2 + 1][2], pp[2 * ks2 + 1][3]);
    pf[ks2] = *(bf16x8*)&t;
  }
#pragma unroll
  for (int dt = 0; dt < 4; ++dt)
#pragma unroll
    for (int ks2 = 0; ks2 < 2; ++ks2) {
      uint2 a0 = *(const uint2*)(sV + (dt * 16 + l16) * TS + (2 * ks2) * 16 + gk * 4);
      uint2 a1 = *(const uint2*)(sV + (dt * 16 + l16) * TS + (2 * ks2 + 1) * 16 + gk * 4);
      uint4 t; t.x = a0.x; t.y = a0.y; t.z = a1.x; t.w = a1.y;
      o[dt] = MFMA(*(bf16x8*)&t, pf[ks2], o[dt]);
    }
}

__device__ __forceinline__ void fox_phase(const Params& p, u16* lds) {
  const u16* QK = (const u16*)(p.ws + WS_QK);
  const u16* VT = (const u16*)(p.ws + WS_VT);
  const float* cf = (const float*)(p.ws + WS_CFOX);
  u16* Y = (u16*)(p.ws + WS_Y);
  const int tid = TIDX, lane = tid & 63, w = tid >> 6, l16 = lane & 15, gk = lane >> 4;
  const float scale2 = 0.125f * LOG2E;
  for (int unit = BIDX; unit < 2048; unit += gridDim.x) {
    const int bh = unit & 31, qblk = 63 - (unit >> 5), b = bh >> 3, h = bh & 7;
    const int tq0 = qblk * 128 + w * 32;
    const float* cfr = cf + (size_t)bh * SEQ;
    bf16x8 q[2][2];
    float cq2[2];
#pragma unroll
    for (int cgi = 0; cgi < 2; ++cgi) {
      const int t = tq0 + cgi * 16 + l16;
#pragma unroll
      for (int ks = 0; ks < 2; ++ks) q[cgi][ks] = *(const bf16x8*)(QK + (size_t)(b * SEQ + t) * LDQ + h * 64 + ks * 32 + gk * 8);
      cq2[cgi] = cfr[t] * LOG2E;
    }
    f32x4 o[2][4];
    float m[2], l[2];
#pragma unroll
    for (int cgi = 0; cgi < 2; ++cgi) {
      m[cgi] = -1e30f; l[cgi] = 0.f;
#pragma unroll
      for (int dt = 0; dt < 4; ++dt) o[cgi][dt] = (f32x4){0.f, 0.f, 0.f, 0.f};
    }
    const int ntiles = qblk * 2 + 2;
    const int iw = qblk * 2 + (w >> 1);
    const u16* ksrc = QK + (size_t)(b * SEQ) * LDQ + 512 + h * 64;
    const u16* vsrc = VT + (size_t)(h * 64) * MTOK + (size_t)b * SEQ;
    float qs = 0.f;
#pragma unroll
    for (int cgi = 0; cgi < 2; ++cgi) {
      float ss = 0.f;
#pragma unroll
      for (int ks = 0; ks < 2; ++ks)
#pragma unroll
        for (int e = 0; e < 8; ++e) { const float v = bf2f((u16)q[cgi][ks][e]); ss += v * v; }
      ss += __shfl_xor(ss, 16); ss += __shfl_xor(ss, 32);
      qs = fmaxf(qs, ss);
    }
#pragma unroll
    for (int o = 1; o <= 8; o <<= 1) qs = fmaxf(qs, __shfl_xor(qs, o));
    float* red = (float*)(lds + 256 * TS);
    if (lane == 0) red[w] = qs;
    __syncthreads();
    const float qmax2 = fmaxf(fmaxf(red[0], red[1]), fmaxf(red[2], red[3]));
    const float kmax2 = __uint_as_float(((const uint32_t*)(p.ws + WS_KMAX))[h]);
    const float T2 = 2.f * scale2 * sqrtf(qmax2 * kmax2) * 1.001f + 48.f;
    const float cfirst2 = cfr[qblk * 128] * LOG2E;
    int i_lo = 0;
    for (int base = qblk * 2 - 1; base >= 0; base -= 64) {
      const int ti = base - lane;
      bool skip = false;
      if (ti >= 0) skip = (cfirst2 - cfr[ti * 64 + 63] * LOG2E) < -T2;
      const unsigned long long bal = __ballot(skip);
      if (bal) { i_lo = base - (int)__builtin_ctzll(bal) + 1; break; }
    }
    uint4 rk0, rk1, rv0, rv1;
    TILE_LD(rk, ksrc + (size_t)i_lo * 64 * LDQ, LDQ); TILE_LD(rv, vsrc + i_lo * 64, MTOK);
    TILE_ST(lds + (i_lo & 1) * (128 * TS), rk); TILE_ST(lds + (i_lo & 1) * (128 * TS) + 64 * TS, rv);
    __syncthreads();
    for (int i = i_lo; i < ntiles; ++i) {
      u16* cur = lds + (i & 1) * (128 * TS);
      const bool more = (i + 1 < ntiles);
      if (more) { TILE_LD(rk, ksrc + (size_t)(i + 1) * 64 * LDQ, LDQ); TILE_LD(rv, vsrc + (i + 1) * 64, MTOK); }
      if (i <= iw) {
        const int s0 = i * 64;
        const bool diag = (i == iw);
        float ck2[4][4];
#pragma unroll
        for (int kt = 0; kt < 4; ++kt) {
          float4 c4 = *(const float4*)(cfr + s0 + kt * 16 + gk * 4);
          ck2[kt][0] = c4.x * LOG2E; ck2[kt][1] = c4.y * LOG2E; ck2[kt][2] = c4.z * LOG2E; ck2[kt][3] = c4.w * LOG2E;
        }
#pragma unroll
        for (int cgi = 0; cgi < 2; ++cgi) {
          f32x4 s[4];
          qk_tile(cur, q[cgi], s, l16, gk);
          const int t = tq0 + cgi * 16 + l16;
          float xv[4][4];
          float mx = -1e30f;
#pragma unroll
          for (int kt = 0; kt < 4; ++kt)
#pragma unroll
            for (int r = 0; r < 4; ++r) {
              float v = s[kt][r] * scale2 + cq2[cgi] - ck2[kt][r];
              if (diag && (s0 + kt * 16 + gk * 4 + r > t)) v = -1e30f;
              xv[kt][r] = v; mx = fmaxf(mx, v);
            }
          mx = fmaxf(mx, __shfl_xor(mx, 16)); mx = fmaxf(mx, __shfl_xor(mx, 32));
          const float mnew = fmaxf(m[cgi], mx);
          const float alpha = exp2f(m[cgi] - mnew);
          m[cgi] = mnew;
          const float muse = fmaxf(mnew, -1e20f);
          float rs = 0.f;
#pragma unroll
          for (int kt = 0; kt < 4; ++kt)
#pragma unroll
            for (int r = 0; r < 4; ++r) { xv[kt][r] = exp2f(xv[kt][r] - muse); rs += xv[kt][r]; }
          l[cgi] = l[cgi] * alpha + rs;
#pragma unroll
          for (int dt = 0; dt < 4; ++dt) o[cgi][dt] *= alpha;
          pv_tile(cur + 64 * TS, xv, o[cgi], l16, gk);
        }
      }
      if (more) { u16* nxt = lds + ((i + 1) & 1) * (128 * TS); TILE_ST(nxt, rk); TILE_ST(nxt + 64 * TS, rv); }
      __syncthreads();
    }
#pragma unroll
    for (int cgi = 0; cgi < 2; ++cgi) {
      float lt = l[cgi]; lt += __shfl_xor(lt, 16); lt += __shfl_xor(lt, 32);
      const float inv = lt > 0.f ? 1.f / lt : 0.f;
      const size_t mrow = (size_t)(b * SEQ + tq0 + cgi * 16 + l16);
#pragma unroll
      for (int dt = 0; dt < 4; ++dt) {
        const int col = h * 64 + dt * 16 + gk * 4;
        const uint2 zz = *(const uint2*)(QK + mrow * LDQ + 2048 + col);
        const float z0 = bf2f(zz.x & 0xffff), z1 = bf2f(zz.x >> 16), z2 = bf2f(zz.y & 0xffff), z3 = bf2f(zz.y >> 16);
        uint2 ov;
        ov.x = pack2(o[cgi][dt][0] * inv * silu_f(z0), o[cgi][dt][1] * inv * silu_f(z1));
        ov.y = pack2(o[cgi][dt][2] * inv * silu_f(z2), o[cgi][dt][3] * inv * silu_f(z3));
        *(uint2*)(Y + mrow * DM + col) = ov;
      }
    }
  }
}

__device__ __forceinline__ void fox_knorm(const Params& p) {
  const u16* QK = (const u16*)(p.ws + WS_QK);
  uint32_t* km = (uint32_t*)(p.ws + WS_KMAX);
  const int tid = TIDX, lane = tid & 63, wave = tid >> 6;
  float mx = 0.f;
  for (int row = BIDX * 4 + wave; row < MTOK; row += gridDim.x * 4) {
    const uint4 v = *(const uint4*)(QK + (size_t)row * LDQ + 512 + lane * 8);
    const float a0 = bf2f(v.x & 0xffff), a1 = bf2f(v.x >> 16), a2 = bf2f(v.y & 0xffff), a3 = bf2f(v.y >> 16);
    const float a4 = bf2f(v.z & 0xffff), a5 = bf2f(v.z >> 16), a6 = bf2f(v.w & 0xffff), a7 = bf2f(v.w >> 16);
    float ss = a0 * a0 + a1 * a1 + a2 * a2 + a3 * a3 + a4 * a4 + a5 * a5 + a6 * a6 + a7 * a7;
    ss += __shfl_xor(ss, 1); ss += __shfl_xor(ss, 2); ss += __shfl_xor(ss, 4);
    mx = fmaxf(mx, ss);
  }
  if ((lane & 7) == 0) atomicMax(&km[lane >> 3], __float_as_uint(mx));
}

__device__ __forceinline__ void fox_scan(const Params& p, float* ldsf) {
  const float* fl = (const float*)(p.ws + WS_FLOG);
  float* cf = (float*)(p.ws + WS_CFOX);
  double* sd = (double*)ldsf;
  const int tid = TIDX;
  for (int bh = BIDX; bh < 32; bh += gridDim.x) {
    const int b = bh >> 3, h = bh & 7;
    const float bf = p.e_bf[h];
    float ls[32];
    double sum = 0.0;
#pragma unroll
    for (int i = 0; i < 32; ++i) {
      const float xx = fl[(size_t)(b * SEQ + tid * 32 + i) * 8 + h] + bf;
      ls[i] = fminf(xx, 0.f) - log1pf(__expf(-fabsf(xx)));
      sum += (double)ls[i];
    }
    __syncthreads();
    sd[tid] = sum;
    __syncthreads();
    double pre = 0.0;
    for (int j = 0; j < tid; ++j) pre += sd[j];
#pragma unroll
    for (int i = 0; i < 32; ++i) { pre += (double)ls[i]; cf[(size_t)bh * SEQ + tid * 32 + i] = (float)pre; }
  }
}

__device__ __forceinline__ void ret_stepA(const Params& p) {
  const u16* VT = (const u16*)(p.ws + WS_VT);
  float* dS = (float*)(p.ws + WS_DS);
  const int lane = TIDX & 63, w = TIDX >> 6, l16 = lane & 15, gk = lane >> 4;
  for (int u = BIDX; u < 2048; u += gridDim.x) {
    const int bh = u >> 6, n = u & 63, b = bh >> 3, h = bh & 7;
    const size_t mcol = (size_t)b * SEQ + n * 128;
    f32x4 acc[4];
#pragma unroll
    for (int dt = 0; dt < 4; ++dt) acc[dt] = (f32x4){0.f, 0.f, 0.f, 0.f};
#pragma unroll
    for (int ks = 0; ks < 4; ++ks) {
      bf16x8 af = *(const bf16x8*)(VT + (size_t)(512 + h * 64 + w * 16 + l16) * MTOK + mcol + ks * 32 + gk * 8);
#pragma unroll
      for (int dt = 0; dt < 4; ++dt) {
        bf16x8 bfr = *(const bf16x8*)(VT + (size_t)(1024 + h * 64 + dt * 16 + l16) * MTOK + mcol + ks * 32 + gk * 8);
        acc[dt] = MFMA(af, bfr, acc[dt]);
      }
    }
#pragma unroll
    for (int dt = 0; dt < 4; ++dt)
#pragma unroll
      for (int r = 0; r < 4; ++r) dS[(size_t)u * 4096 + (w * 16 + gk * 4 + r) * 64 + dt * 16 + l16] = acc[dt][r];
  }
}
__device__ __forceinline__ void ret_stepB(const Params& p) {
  const float* dS = (const float*)(p.ws + WS_DS);
  u16* st = (u16*)(p.ws + WS_ST);
  for (int idx = BIDX * 256 + TIDX; idx < 32 * 4096; idx += gridDim.x * 256) {
    const int bh = idx >> 12, ed = idx & 4095, h = bh & 7;
    const float cdec = __expf(log1pf(-exp2f(-5.f - (float)h)) * 128.f);
    float s = 0.f;
#pragma unroll 8
    for (int n = 0; n < 64; ++n) {
      const size_t a = (size_t)(bh * 64 + n) * 4096 + ed;
      st[a] = f2bf(s);
      s = s * cdec + dS[a];
    }
  }
}
__device__ __forceinline__ void ret_stepC(const Params& p, u16* lds) {
  const u16* QK = (const u16*)(p.ws + WS_QK);
  const u16* VT = (const u16*)(p.ws + WS_VT);
  const u16* st = (const u16*)(p.ws + WS_ST);
  u16* Y = (u16*)(p.ws + WS_Y);
  const int tid = TIDX, lane = tid & 63, w = tid >> 6, l16 = lane & 15, gk = lane >> 4;
  for (int u = BIDX; u < 2048; u += gridDim.x) {
    const int bh = u >> 6, n = u & 63, b = bh >> 3, h = bh & 7;
    const size_t m0 = (size_t)b * SEQ + n * 128;
    const float lg2 = log1pf(-exp2f(-5.f - (float)h)) * LOG2E;
    __syncthreads();
    {
      uint4 r0, r1;
      TILE_LD(r, QK + m0 * LDQ + 1536 + h * 64, LDQ); TILE_ST(lds, r);
      TILE_LD(r, VT + (size_t)(512 + h * 64) * MTOK + m0, MTOK); TILE_ST(lds + 64 * TS, r);
      TILE_LD(r, QK + (m0 + 64) * LDQ + 1536 + h * 64, LDQ); TILE_ST(lds + 128 * TS, r);
      TILE_LD(r, VT + (size_t)(512 + h * 64) * MTOK + m0 + 64, MTOK); TILE_ST(lds + 192 * TS, r);
      TILE_LD(r, st + (size_t)u * 4096, 64); TILE_ST(lds + 256 * TS, r);
    }
    __syncthreads();
#pragma unroll
    for (int cgi = 0; cgi < 2; ++cgi) {
      const int iq = 32 * w + cgi * 16 + l16;
      const size_t mrow = m0 + iq;
      bf16x8 q[2];
#pragma unroll
      for (int ks = 0; ks < 2; ++ks) q[ks] = *(const bf16x8*)(QK + mrow * LDQ + 1024 + h * 64 + ks * 32 + gk * 8);
      f32x4 o[4];
#pragma unroll
      for (int dt = 0; dt < 4; ++dt) o[dt] = (f32x4){0.f, 0.f, 0.f, 0.f};
#pragma unroll
      for (int dt = 0; dt < 4; ++dt)
#pragma unroll
        for (int ks = 0; ks < 2; ++ks) {
          bf16x8 sf = *(const bf16x8*)(lds + 256 * TS + (dt * 16 + l16) * TS + ks * 32 + gk * 8);
          o[dt] = MFMA(sf, q[ks], o[dt]);
        }
      const float cross = exp2f(lg2 * (float)(iq + 1));
#pragma unroll
      for (int dt = 0; dt < 4; ++dt) o[dt] *= cross;
#pragma unroll
      for (int k64 = 0; k64 < 2; ++k64) {
        if (k64 * 64 <= 32 * w + 31) {
          f32x4 s[4];
          qk_tile(lds + k64 * 128 * TS, q, s, l16, gk);
          float pp[4][4];
#pragma unroll
          for (int kt = 0; kt < 4; ++kt)
#pragma unroll
            for (int r = 0; r < 4; ++r) {
              const int j = k64 * 64 + kt * 16 + gk * 4 + r;
              pp[kt][r] = (j <= iq) ? s[kt][r] * 0.125f * exp2f(lg2 * (float)(iq - j)) : 0.f;
            }
          pv_tile(lds + k64 * 128 * TS + 64 * TS, pp, o, l16, gk);
        }
      }
      float sm = 0.f;
#pragma unroll
      for (int dt = 0; dt < 4; ++dt) sm += o[dt][0] + o[dt][1] + o[dt][2] + o[dt][3];
      sm += __shfl_xor(sm, 16); sm += __shfl_xor(sm, 32);
      const float mu = sm * (1.f / 64.f);
      float vs = 0.f;
#pragma unroll
      for (int dt = 0; dt < 4; ++dt)
#pragma unroll
        for (int r = 0; r < 4; ++r) { const float d = o[dt][r] - mu; vs += d * d; }
      vs += __shfl_xor(vs, 16); vs += __shfl_xor(vs, 32);
      const float rstd = rsqrtf(vs * (1.f / 64.f) + 1e-5f);
#pragma unroll
      for (int dt = 0; dt < 4; ++dt) {
        const int col = h * 64 + dt * 16 + gk * 4;
        const float4 gg = *(const float4*)(p.e_gn + col);
        const uint2 zz = *(const uint2*)(QK + mrow * LDQ + 2048 + 512 + col);
        const float z0 = bf2f(zz.x & 0xffff), z1 = bf2f(zz.x >> 16), z2 = bf2f(zz.y & 0xffff), z3 = bf2f(zz.y >> 16);
        uint2 ov;
        ov.x = pack2((o[dt][0] - mu) * rstd * gg.x * silu_f(z0), (o[dt][1] - mu) * rstd * gg.y * silu_f(z1));
        ov.y = pack2((o[dt][2] - mu) * rstd * gg.z * silu_f(z2), (o[dt][3] - mu) * rstd * gg.w * silu_f(z3));
        *(uint2*)(Y + mrow * DM + 512 + col) = ov;
      }
    }
  }
}

template <int BR>
__device__ __forceinline__ void nsa_tile(const u16* sK, const u16* sV, const bf16x8 (&q)[4][2], f32x4 (&acc)[4][4],
                                         float (&m)[4], float (&l)[4], const float (&slope2)[4], const float (&gmul)[4],
                                         int t, int pos0, int pstride, int wl, bool lanesel,
                                         float* imp_row, int jbase, float& carry, int lane) {
  const int l16 = lane & 15, gk = lane >> 4;
  const float scale2 = 0.125f * LOG2E;
  float ps[4][4];
  if (BR == 1) {
#pragma unroll
    for (int kt = 0; kt < 4; ++kt)
#pragma unroll
      for (int r = 0; r < 4; ++r) ps[kt][r] = 0.f;
  }
#pragma unroll
  for (int cgi = 0; cgi < 4; ++cgi) {
    f32x4 s[4];
    qk_tile(sK, q[cgi], s, l16, gk);
    float xv[4][4];
    float mx = -1e30f;
#pragma unroll
    for (int kt = 0; kt < 4; ++kt)
#pragma unroll
      for (int r = 0; r < 4; ++r) {
        const int pos = pos0 + (kt * 16 + gk * 4 + r) * pstride;
        const bool valid = lanesel && (pos <= t) && (pos > t - wl);
        float v = s[kt][r] * scale2 + slope2[cgi] * (float)(pos - t);
        v = valid ? v : -1e30f;
        xv[kt][r] = v; mx = fmaxf(mx, v);
      }
    if (BR != 1) {
      mx = fmaxf(mx, __shfl_xor(mx, 16)); mx = fmaxf(mx, __shfl_xor(mx, 32));
      const float mnew = fmaxf(m[cgi], mx);
      const float alpha = exp2f(m[cgi] - mnew);
      m[cgi] = mnew;
      const float muse = fmaxf(mnew, -1e20f);
      float rs = 0.f;
#pragma unroll
      for (int kt = 0; kt < 4; ++kt)
#pragma unroll
        for (int r = 0; r < 4; ++r) { xv[kt][r] = exp2f(xv[kt][r] - muse); rs += xv[kt][r]; }
      l[cgi] = l[cgi] * alpha + rs;
      if (BR == 2) {
#pragma unroll
        for (int dt = 0; dt < 4; ++dt) acc[cgi][dt] *= alpha;
        pv_tile(sV, xv, acc[cgi], l16, gk);
      }
    } else {
      const float muse = fmaxf(m[cgi], -1e20f);
#pragma unroll
      for (int kt = 0; kt < 4; ++kt)
#pragma unroll
        for (int r = 0; r < 4; ++r) {
          const float pn = exp2f(xv[kt][r] - muse) * l[cgi];
          ps[kt][r] += pn;
          xv[kt][r] = pn * gmul[cgi];
        }
      pv_tile(sV, xv, acc[cgi], l16, gk);
    }
  }
  if (BR == 1) {
    const int srcl = (lane + 48) & 63;
#pragma unroll
    for (int kt = 0; kt < 4; ++kt) {
      const float same = __shfl(ps[kt][3], srcl);
      const float prev = __shfl(kt > 0 ? ps[kt > 0 ? kt - 1 : 0][3] : carry, srcl);
      const float pm1 = (gk == 0) ? prev : same;
      imp_row[jbase + kt * 4 + gk] = 2.f * (ps[kt][0] + ps[kt][1] + ps[kt][2]) + ps[kt][3] + pm1;
    }
    carry = ps[3][3];
  }
}

__device__ __forceinline__ void nsa_phase(const Params& p, u16* lds) {
  const u16* U = (const u16*)(p.ws + WS_QK);
  const u16* VT = (const u16*)(p.ws + WS_VT);
  const u16* KC = (const u16*)(p.ws + WS_KCMP);
  const u16* VC = (const u16*)(p.ws + WS_VCMPT);
  const float* GL = (const float*)(p.ws + WS_GL);
  u16* Y = (u16*)(p.ws + WS_Y);
  float* imp = (float*)(lds + 256 * TS);
  uint32_t* umask = (uint32_t*)(imp + 64 * IMPS);
  int* ulist = (int*)(umask + 4);
  const int tid = TIDX, lane = tid & 63, w = tid >> 6, l16 = lane & 15, gk = lane >> 4;
  uint2* totl = (uint2*)imp + (size_t)w * 1024 + lane;
  const int BIG = 1 << 30;
  for (int unit = BIDX; unit < 2048; unit += gridDim.x) {
    const int bg = unit & 15, qb = 127 - (unit >> 4), b = bg >> 2, g = bg & 3;
    const int t0 = qb * 64, t = t0 + 16 * w + l16;
    const size_t mrow = (size_t)b * SEQ + t;
    bf16x8 q[4][2];
    float slope2[4], g1[4];
#pragma unroll
    for (int cgi = 0; cgi < 4; ++cgi) {
      const int h = g * 4 + cgi;
#pragma unroll
      for (int ks = 0; ks < 2; ++ks) q[cgi][ks] = *(const bf16x8*)(U + mrow * LDQ + h * 64 + ks * 32 + gk * 8);
      slope2[cgi] = exp2f(-0.5f * (float)(h + 1)) * LOG2E;
      g1[cgi] = sigmoid_f(GL[mrow * 48 + h * 3] + p.o_bg[h * 3]);
    }
    f32x4 acc[4][4];
    float m[4], l[4];
#pragma unroll
    for (int cgi = 0; cgi < 4; ++cgi) {
      m[cgi] = -1e30f; l[cgi] = 0.f;
#pragma unroll
      for (int dt = 0; dt < 4; ++dt) acc[cgi][dt] = (f32x4){0.f, 0.f, 0.f, 0.f};
    }
    __syncthreads();
    for (int i = tid; i < 64 * IMPS; i += 256) imp[i] = 0.f;
    if (tid < 4) umask[tid] = 0u;
    float* imp_row = imp + (16 * w + l16) * IMPS;
    float carry = 0.f;
    uint4 rk0, rk1, rv0, rv1;
    const int ntc = ((4 * qb + 2) >> 6) + 1;
    const u16* kcs = KC + (size_t)bg * 512 * 64;
    const u16* vcs = VC + (size_t)bg * 32768;
#pragma unroll 1
    for (int pass = 0; pass < 2; ++pass) {
      TILE_LD(rk, kcs, 64); TILE_LD(rv, vcs, 512);
      __syncthreads();
      TILE_ST(lds, rk); TILE_ST(lds + 64 * TS, rv);
      __syncthreads();
#pragma unroll 1
      for (int i = 0; i < ntc; ++i) {
        u16* cur = lds + (i & 1) * (128 * TS);
        const bool more = (i + 1 < ntc);
        if (more) { TILE_LD(rk, kcs + (size_t)(i + 1) * 64 * 64, 64); TILE_LD(rv, vcs + (i + 1) * 64, 512); }
        if (pass == 0) nsa_tile<0>(cur, cur + 64 * TS, q, acc, m, l, slope2, g1, t, 16 * (64 * i) + 31, 16, BIG, true, imp_row, 16 * i, carry, lane);
        else nsa_tile<1>(cur, cur + 64 * TS, q, acc, m, l, slope2, g1, t, 16 * (64 * i) + 31, 16, BIG, true, imp_row, 16 * i, carry, lane);
        if (more) { u16* nxt = lds + ((i + 1) & 1) * (128 * TS); TILE_ST(nxt, rk); TILE_ST(nxt + 64 * TS, rv); }
        __syncthreads();
      }
      if (pass == 0) {
#pragma unroll
        for (int cgi = 0; cgi < 4; ++cgi) {
          float lt = l[cgi]; lt += __shfl_xor(lt, 16); lt += __shfl_xor(lt, 32);
          l[cgi] = lt > 0.f ? 1.f / lt : 0.f;
        }
      }
    }
    uint32_t selm = 0u;
    if (qb < 16) {
      if (gk == 0) selm = (1u << (qb + 1)) - 1u;
    } else {
      float val[32];
#pragma unroll
      for (int i4 = 0; i4 < 8; ++i4) {
        const float4 v4 = *(const float4*)(imp_row + 32 * gk + 4 * i4);
        val[4 * i4] = v4.x; val[4 * i4 + 1] = v4.y; val[4 * i4 + 2] = v4.z; val[4 * i4 + 3] = v4.w;
      }
#pragma unroll
      for (int i = 0; i < 32; ++i) {
        const int j = 32 * gk + i;
        const bool forced = (j == 0) || (j == qb) || (j == qb - 1);
        if (forced) selm |= (1u << i);
        if (forced || j > qb) val[i] = -1.f;
      }
#pragma unroll 1
      for (int it = 0; it < 13; ++it) {
        float best = -2.f; int bj = 0;
#pragma unroll
        for (int i = 0; i < 32; ++i) {
          const float v = ((selm >> i) & 1u) ? -1.f : val[i];
          if (v > best) { best = v; bj = 32 * gk + i; }
        }
#pragma unroll
        for (int o = 16; o <= 32; o <<= 1) {
          const float ov = __shfl_xor(best, o); const int oj = __shfl_xor(bj, o);
          if (ov > best || (ov == best && oj < bj)) { best = ov; bj = oj; }
        }
        if ((bj >> 5) == gk) selm |= (1u << (bj & 31));
      }
    }
    const uint32_t sel0 = __shfl(selm, l16), sel1 = __shfl(selm, l16 + 16), sel2 = __shfl(selm, l16 + 32), sel3 = __shfl(selm, l16 + 48);
    uint32_t wu = selm;
#pragma unroll
    for (int o = 1; o <= 8; o <<= 1) wu |= __shfl_xor(wu, o);
    const uint32_t wun0 = __shfl(wu, 0), wun1 = __shfl(wu, 16), wun2 = __shfl(wu, 32), wun3 = __shfl(wu, 48);
    if (l16 == 0) atomicOr(&umask[gk], wu);
    __syncthreads();
    int nsl = 0;
    {
      const uint32_t u0 = umask[0], u1 = umask[1], u2 = umask[2], u3 = umask[3];
      nsl = __popc(u0) + __popc(u1) + __popc(u2) + __popc(u3);
      if (tid < 128) {
        const uint32_t uw = tid < 32 ? u0 : tid < 64 ? u1 : tid < 96 ? u2 : u3;
        if ((uw >> (tid & 31)) & 1u) {
          int pos = __popc(uw & ((1u << (tid & 31)) - 1u));
          if (tid >= 32) pos += __popc(u0);
          if (tid >= 64) pos += __popc(u1);
          if (tid >= 96) pos += __popc(u2);
          ulist[pos] = tid;
        }
      }
    }
    __syncthreads();
#pragma unroll
    for (int cgi = 0; cgi < 4; ++cgi)
#pragma unroll
      for (int dt = 0; dt < 4; ++dt) {
        uint2 o2; o2.x = pack2(acc[cgi][dt][0], acc[cgi][dt][1]); o2.y = pack2(acc[cgi][dt][2], acc[cgi][dt][3]);
        totl[(cgi * 4 + dt) * 64] = o2;
      }
#pragma unroll 1
    for (int br = 1; br < 3; ++br) {
#pragma unroll
      for (int cgi = 0; cgi < 4; ++cgi) {
        m[cgi] = -1e30f; l[cgi] = 0.f;
#pragma unroll
        for (int dt = 0; dt < 4; ++dt) acc[cgi][dt] = (f32x4){0.f, 0.f, 0.f, 0.f};
      }
      const int i0w = (qb >= 8) ? 0 : 8 - qb;
      const int nt = (br == 1) ? nsl : 9 - i0w;
      const u16* kb = U + (size_t)b * SEQ * LDQ + (br == 1 ? 1536 : 1792) + g * 64;
      const u16* vb = VT + (size_t)((br == 1 ? 0 : 256) + g * 64) * MTOK + (size_t)b * SEQ;
      int s0 = (br == 1) ? ulist[0] * 64 : t0 - 512 + 64 * i0w;
      TILE_LD(rk, kb + (size_t)s0 * LDQ, LDQ); TILE_LD(rv, vb + s0, MTOK);
      __syncthreads();
      TILE_ST(lds, rk); TILE_ST(lds + 64 * TS, rv);
      __syncthreads();
#pragma unroll 1
      for (int i = 0; i < nt; ++i) {
        u16* cur = lds + (i & 1) * (128 * TS);
        const bool more = (i + 1 < nt);
        int s1 = 0;
        if (more) {
          s1 = (br == 1) ? ulist[i + 1] * 64 : s0 + 64;
          TILE_LD(rk, kb + (size_t)s1 * LDQ, LDQ); TILE_LD(rv, vb + s1, MTOK);
        }
        bool wsel = true, ls = true;
        int wl = 512;
        if (br == 1) {
          const int j = s0 >> 6, jw = j >> 5, jb = j & 31;
          const uint32_t ww = jw == 0 ? wun0 : jw == 1 ? wun1 : jw == 2 ? wun2 : wun3;
          const uint32_t sw = jw == 0 ? sel0 : jw == 1 ? sel1 : jw == 2 ? sel2 : sel3;
          wsel = (ww >> jb) & 1u; ls = (sw >> jb) & 1u; wl = BIG;
        }
        if (wsel) nsa_tile<2>(cur, cur + 64 * TS, q, acc, m, l, slope2, g1, t, s0, 1, wl, ls, imp_row, 0, carry, lane);
        if (more) { u16* nxt = lds + ((i + 1) & 1) * (128 * TS); TILE_ST(nxt, rk); TILE_ST(nxt + 64 * TS, rv); }
        s0 = s1;
        __syncthreads();
      }
#pragma unroll
      for (int cgi = 0; cgi < 4; ++cgi) {
        const int h = g * 4 + cgi;
        float lt = l[cgi]; lt += __shfl_xor(lt, 16); lt += __shfl_xor(lt, 32);
        const float gt = sigmoid_f(GL[mrow * 48 + h * 3 + br] + p.o_bg[h * 3 + br]);
        const float sc = lt > 0.f ? gt / lt : 0.f;
#pragma unroll
        for (int dt = 0; dt < 4; ++dt) {
          const uint2 pv = totl[(cgi * 4 + dt) * 64];
          const float r0 = bf2f(pv.x & 0xffff) + acc[cgi][dt][0] * sc, r1 = bf2f(pv.x >> 16) + acc[cgi][dt][1] * sc;
          const float r2 = bf2f(pv.y & 0xffff) + acc[cgi][dt][2] * sc, r3 = bf2f(pv.y >> 16) + acc[cgi][dt][3] * sc;
          if (br == 1) {
            uint2 o2; o2.x = pack2(r0, r1); o2.y = pack2(r2, r3);
            totl[(cgi * 4 + dt) * 64] = o2;
          } else {
            const int col = h * 64 + dt * 16 + gk * 4;
            const uint2 zz = *(const uint2*)(U + mrow * LDQ + 2048 + col);
            const float z0 = bf2f(zz.x & 0xffff), z1 = bf2f(zz.x >> 16), z2 = bf2f(zz.y & 0xffff), z3 = bf2f(zz.y >> 16);
            uint2 ov;
            ov.x = pack2(r0 * silu_f(z0), r1 * silu_f(z1));
            ov.y = pack2(r2 * silu_f(z2), r3 * silu_f(z3));
            *(uint2*)(Y + mrow * DM + col) = ov;
          }
        }
      }
    }
  }
}

__device__ __forceinline__ void final_norm(const Params& p) {
  const int lane = TIDX & 63, wave = TIDX >> 6;
  for (int row = BIDX * 4 + wave; row < MTOK; row += gridDim.x * 4) {
    float4* xr = (float4*)(p.out + (size_t)row * DM);
    float4 v[4];
    float ss = 0.f;
#pragma unroll
    for (int i = 0; i < 4; ++i) {
      v[i] = xr[lane + 64 * i];
      ss += v[i].x * v[i].x + v[i].y * v[i].y + v[i].z * v[i].z + v[i].w * v[i].w;
    }
#pragma unroll
    for (int o = 32; o >= 1; o >>= 1) ss += __shfl_xor(ss, o);
    const float rstd = rsqrtf(ss * (1.f / DM) + 1e-6f);
#pragma unroll
    for (int i = 0; i < 4; ++i) {
      const float4 gg = ((const float4*)p.fin_g)[lane + 64 * i];
      xr[lane + 64 * i] = (float4){v[i].x * rstd * gg.x, v[i].y * rstd * gg.y, v[i].z * rstd * gg.z, v[i].w * rstd * gg.w};
    }
  }
}

__global__ void __launch_bounds__(256, 1) mega(Params p) {
  extern __shared__ __attribute__((aligned(16))) unsigned char lds_raw[];
  u16* lds = (u16*)lds_raw;
  cg::grid_group grid = cg::this_grid();
#define PH_ON(k) (p.ph_lo <= (k) && (k) <= p.ph_hi)
#define PH_SYNC(k) if (p.coop && p.ph_lo <= (k) && (k) < p.ph_hi) grid.sync();
  if (PH_ON(0)) {
    rms_rows(p.x, p.e_ng, (u16*)(p.ws + WS_HBF));
    conv_t((u16*)(p.ws + WS_WT0), p.e_win, 1024, 4104, 4224, 0);
    conv_t((u16*)(p.ws + WS_WT1), p.o_win, 1024, 3632, 3712, 1);
    conv_t((u16*)(p.ws + WS_WO0), p.e_wout, 1024, 1024, 1024, 2);
    conv_t((u16*)(p.ws + WS_WO1), p.o_wout, 1024, 1024, 1024, 2);
    conv_t((u16*)(p.ws + WS_W1K), p.o_wk1, 2048, 256, 256, 2);
    conv_t((u16*)(p.ws + WS_W1V), p.o_wv1, 2048, 256, 256, 2);
    conv_t((u16*)(p.ws + WS_W2K), p.o_wk2, 256, 64, 128, 2);
    conv_t((u16*)(p.ws + WS_W2V), p.o_wv2, 256, 64, 128, 2);
    pe_partial(p);
    if (BIDX == 0 && TIDX < 8) ((uint32_t*)(p.ws + WS_KMAX))[TIDX] = 0u;
  }
  PH_SYNC(0)
  if (PH_ON(1)) gemm_inproj(p, 0, lds);
  PH_SYNC(1)
  if (PH_ON(2)) { fox_scan(p, (float*)lds); ret_stepA(p); fox_knorm(p); }
  PH_SYNC(2)
  if (PH_ON(3)) { ret_stepB(p); fox_phase(p, lds); }
  PH_SYNC(3)
  if (PH_ON(4)) ret_stepC(p, lds);
  PH_SYNC(4)
  if (PH_ON(5)) gemm_outproj(p, 0, lds);
  PH_SYNC(5)
  if (PH_ON(6)) {
    rms_rows(p.out, p.o_ng, (u16*)(p.ws + WS_HBF));
    if (BIDX == 0) {
      for (int i = TIDX; i < 512; i += 256) {
        const float* part = (const float*)(p.ws + WS_PEP);
        float s = 0.f;
        for (int kc = 0; kc < 16; ++kc) s += part[((i >> 8) * 16 + kc) * 256 + (i & 255)];
        ((float*)(p.ws + WS_PEB))[i] = s;
      }
    }
  }
  PH_SYNC(6)
  if (PH_ON(7)) gemm_inproj(p, 1, lds);
  PH_SYNC(7)
  if (PH_ON(8)) gemm_cmp1(p, lds);
  PH_SYNC(8)
  if (PH_ON(9)) gemm_cmp2(p, lds);
  PH_SYNC(9)
  if (PH_ON(10)) nsa_phase(p, lds);
  PH_SYNC(10)
  if (PH_ON(11)) gemm_outproj(p, 1, lds);
  PH_SYNC(11)
  if (PH_ON(12)) final_norm(p);
}

extern "C" void kernel_launch(void* const* d_in, const int* in_sizes, int n_in, void* d_out, int out_size, void* d_ws,
                              size_t ws_size, hipStream_t stream) {
  static int grid_blocks = 0;
  if (!grid_blocks) {
    int dev = 0, cus = 0, per_cu = 0;
    hipGetDevice(&dev);
    hipDeviceGetAttribute(&cus, hipDeviceAttributeMultiprocessorCount, dev);
    hipFuncSetAttribute((const void*)mega, hipFuncAttributeMaxDynamicSharedMemorySize, LDS_BYTES);
    hipOccupancyMaxActiveBlocksPerMultiprocessor(&per_cu, (const void*)mega, 256, LDS_BYTES);
    if (per_cu < 1) per_cu = 1;
    if (per_cu > 2) per_cu = 2;
    grid_blocks = cus * per_cu;
    (void)hipGetLastError();
  }
  Params p{};
  p.x = (const float*)d_in[0]; p.e_ng = (const float*)d_in[1]; p.e_win = (const float*)d_in[2];
  p.e_bf = (const float*)d_in[3]; p.e_gn = (const float*)d_in[4]; p.e_wout = (const float*)d_in[5];
  p.o_ng = (const float*)d_in[6]; p.o_win = (const float*)d_in[7]; p.o_bg = (const float*)d_in[8];
  p.o_pek = (const float*)d_in[9]; p.o_pev = (const float*)d_in[10]; p.o_wk1 = (const float*)d_in[11];
  p.o_wk2 = (const float*)d_in[12]; p.o_wv1 = (const float*)d_in[13]; p.o_wv2 = (const float*)d_in[14];
  p.o_wout = (const float*)d_in[15]; p.fin_g = (const float*)d_in[16];
  p.out = (float*)d_out; p.ws = (unsigned char*)d_ws;
#if ONE_LAUNCH
  p.ph_lo = 0; p.ph_hi = NPHASE - 1; p.coop = 1;
  void* args[] = {&p};
  hipError_t e = hipLaunchCooperativeKernel((const void*)mega, dim3(grid_blocks), dim3(256), args, LDS_BYTES, stream);
  if (e != hipSuccess) fprintf(stderr, "cooperative launch failed: %s (grid %d)\n", hipGetErrorString(e), grid_blocks);
#else
  for (int ph = 0; ph < NPHASE; ++ph) {
    p.ph_lo = ph; p.ph_hi = ph; p.coop = 0;
    hipLaunchKernelGGL(mega, dim3(grid_blocks), dim3(256), LDS_BYTES, stream, p);
  }
#endif
}
```

```cpp
#include <hip/hip_runtime.h>
#include <hip/hip_cooperative_groups.h>
#include <stdint.h>
#include <stdio.h>
namespace cg = cooperative_groups;

typedef unsigned short u16;
typedef short bf16x8 __attribute__((ext_vector_type(8)));
typedef short bf16x4 __attribute__((ext_vector_type(4)));
typedef float f32x4 __attribute__((ext_vector_type(4)));

#ifndef ONE_LAUNCH
#define ONE_LAUNCH 1
#endif

#define MTOK 32768
#define SEQ 8192
#define DM 1024
#define LDQ 3072
#define LOG2E 1.4426950408889634f
#define TS 72
#define IMPS 132
#define LDS_BYTES 73728
#define NPHASE 13

#define MiB (1024ull * 1024ull)
#define WS_HBF   (0ull)
#define WS_DS    (0ull)
#define WS_ST    (32ull * MiB)
#define WS_QK    (64ull * MiB)
#define WS_VT    (256ull * MiB)
#define WS_Y     (352ull * MiB)
#define WS_WT0   (416ull * MiB)
#define WS_WT1   (WS_WT0 + 4224ull * 1024 * 2)
#define WS_WO0   (WS_WT1 + 3712ull * 1024 * 2)
#define WS_WO1   (WS_WO0 + 1024ull * 1024 * 2)
#define WS_W1K   (WS_WO1 + 1024ull * 1024 * 2)
#define WS_W1V   (WS_W1K + 256ull * 2048 * 2)
#define WS_W2K   (WS_W1V + 256ull * 2048 * 2)
#define WS_W2V   (WS_W2K + 128ull * 256 * 2)
#define WS_FLOG  (440ull * MiB)
#define WS_CFOX  (441ull * MiB)
#define WS_GL    (442ull * MiB)
#define WS_HC    (448ull * MiB)
#define WS_KCMP  (456ull * MiB)
#define WS_VCMPT (457ull * MiB)
#define WS_PEP   (458ull * MiB)
#define WS_PEB   (WS_PEP + 65536ull)
#define WS_KMAX  (WS_PEB + 4096ull)

struct Params {
  const float *x, *e_ng, *e_win, *e_bf, *e_gn, *e_wout;
  const float *o_ng, *o_win, *o_bg, *o_pek, *o_pev, *o_wk1, *o_wk2, *o_wv1, *o_wv2, *o_wout, *fin_g;
  float* out;
  unsigned char* ws;
  int ph_lo, ph_hi, coop, pad;
};

typedef __bf16 bf16v2 __attribute__((ext_vector_type(2)));
typedef float f32v2 __attribute__((ext_vector_type(2)));
__device__ __forceinline__ uint32_t pack2(float a, float b) {
  f32v2 v = {a, b};
  bf16v2 r = __builtin_convertvector(v, bf16v2);
  return *(uint32_t*)&r;
}
__device__ __forceinline__ u16 f2bf(float f) { return (u16)(pack2(f, 0.f) & 0xffffu); }
__device__ __forceinline__ float bf2f(u16 h) { return __uint_as_float(((uint32_t)h) << 16); }
__device__ __forceinline__ float ex2(float x) { return __builtin_amdgcn_exp2f(x); }
__device__ __forceinline__ float silu_f(float z) { return z * __builtin_amdgcn_rcpf(1.f + ex2(-z * LOG2E)); }
__device__ __forceinline__ float sigmoid_f(float z) { return __builtin_amdgcn_rcpf(1.f + ex2(-z * LOG2E)); }

__device__ __forceinline__ int opq(int v) { asm volatile("" : "+v"(v)); return v; }
__device__ __forceinline__ int opqs(int v) { asm volatile("" : "+s"(v)); return v; }
#define TIDX opq((int)threadIdx.x)
#define BIDX opqs((int)blockIdx.x)
#define MFMA(a, b, c) __builtin_amdgcn_mfma_f32_16x16x32_bf16((a), (b), (c), 0, 0, 0)

__device__ __forceinline__ void rms_rows(const float* __restrict__ x, const float* __restrict__ g, u16* __restrict__ h) {
  const int lane = TIDX & 63, wave = TIDX >> 6;
  for (int row = BIDX * 4 + wave; row < MTOK; row += gridDim.x * 4) {
    const float4* xr = (const float4*)(x + (size_t)row * DM);
    float4 v[4];
    float ss = 0.f;
#pragma unroll
    for (int i = 0; i < 4; ++i) {
      v[i] = xr[lane + 64 * i];
      ss += v[i].x * v[i].x + v[i].y * v[i].y + v[i].z * v[i].z + v[i].w * v[i].w;
    }
#pragma unroll
    for (int o = 32; o >= 1; o >>= 1) ss += __shfl_xor(ss, o);
    const float rstd = rsqrtf(ss * (1.f / DM) + 1e-6f);
#pragma unroll
    for (int i = 0; i < 4; ++i) {
      float4 gg = ((const float4*)g)[lane + 64 * i];
      uint2 o;
      o.x = pack2(v[i].x * rstd * gg.x, v[i].y * rstd * gg.y);
      o.y = pack2(v[i].z * rstd * gg.z, v[i].w * rstd * gg.w);
      *(uint2*)(h + (size_t)row * DM + (lane + 64 * i) * 4) = o;
    }
  }
}

__device__ __forceinline__ int map_col(int MAP, int n) {
  if (MAP == 0) {
    if (n < 1024) return n;
    if (n < 2048) return n + 520;
    if (n < 3072) return n + 1032;
    if (n < 3584) return n - 2048;
    if (n < 4096) return n - 1016;
    if (n < 4104) return n - 2560;
    return -1;
  } else if (MAP == 1) {
    if (n < 1792) return n;
    if (n < 2048) return n + 256;
    if (n < 3072) return n + 560;
    if (n < 3328) return n - 1280;
    if (n < 3584) return n - 1024;
    if (n < 3632) return n - 1024;
    return -1;
  } else if (MAP == 2) {
    return n;
  }
  return n;
}

__device__ __forceinline__ void conv_t(u16* __restrict__ dst, const float* __restrict__ src, int K, int nsrc, int ndst, int MAP) {
  const int total = ndst * (K >> 3);
  for (int id = BIDX * 256 + TIDX; id < total; id += gridDim.x * 256) {
    const int n = id % ndst, kc = id / ndst;
    const int sc = map_col(MAP, n);
    float v[8];
#pragma unroll
    for (int i = 0; i < 8; ++i) v[i] = (sc >= 0 && sc < nsrc) ? src[(size_t)(kc * 8 + i) * nsrc + sc] : 0.f;
    uint4 o;
    o.x = pack2(v[0], v[1]); o.y = pack2(v[2], v[3]); o.z = pack2(v[4], v[5]); o.w = pack2(v[6], v[7]);
    *(uint4*)(dst + (size_t)n * K + kc * 8) = o;
  }
}

__device__ __forceinline__ void pe_partial(const Params& p) {
  float* part = (float*)(p.ws + WS_PEP);
  for (int task = BIDX; task < 32; task += gridDim.x) {
    const int kv = task >> 4, kc = task & 15, n = TIDX;
    const float* pe = kv ? p.o_pev : p.o_pek;
    const float* w1 = kv ? p.o_wv1 : p.o_wk1;
    float acc = 0.f;
#pragma unroll 16
    for (int k = kc * 128; k < kc * 128 + 128; ++k) acc += pe[k] * w1[(size_t)k * 256 + n];
    part[(kv * 16 + kc) * 256 + n] = acc;
  }
}

__device__ __forceinline__ void gemm_mainloop(const u16* __restrict__ Ab, const uint32_t (&pa)[4], const u16* __restrict__ Bb,
                                              const uint32_t (&pb)[4], int a_kstride, int nk,
                                              u16* lds, f32x4 (&acc)[4][4], bool swapped) {
  const int tid = TIDX, lane = tid & 63, wave = tid >> 6;
  const int l16 = lane & 15, gk = lane >> 4;
  const int wx = wave >> 1, wy = wave & 1;
  int woff[4];
#pragma unroll
  for (int i = 0; i < 4; ++i) { int c = tid + 256 * i; woff[i] = (c >> 3) * TS + (c & 7) * 8; }
  uint4 ra0, ra1, ra2, ra3, rb0, rb1, rb2, rb3;
#define G_LD(Ap, Bp) ra0 = *(const uint4*)((Ap) + pa[0]); ra1 = *(const uint4*)((Ap) + pa[1]); ra2 = *(const uint4*)((Ap) + pa[2]); ra3 = *(const uint4*)((Ap) + pa[3]); \
                     rb0 = *(const uint4*)((Bp) + pb[0]); rb1 = *(const uint4*)((Bp) + pb[1]); rb2 = *(const uint4*)((Bp) + pb[2]); rb3 = *(const uint4*)((Bp) + pb[3]);
#define G_ST(D) *(uint4*)((D) + woff[0]) = ra0; *(uint4*)((D) + woff[1]) = ra1; *(uint4*)((D) + woff[2]) = ra2; *(uint4*)((D) + woff[3]) = ra3; \
                *(uint4*)((D) + 128 * TS + woff[0]) = rb0; *(uint4*)((D) + 128 * TS + woff[1]) = rb1; *(uint4*)((D) + 128 * TS + woff[2]) = rb2; *(uint4*)((D) + 128 * TS + woff[3]) = rb3;
  G_LD(Ab, Bb)
  __syncthreads();
  G_ST(lds)
  __syncthreads();
#pragma unroll
  for (int i = 0; i < 4; ++i)
#pragma unroll
    for (int j = 0; j < 4; ++j) acc[i][j] = (f32x4){0.f, 0.f, 0.f, 0.f};
#pragma unroll 1
  for (int ks = 0; ks < nk; ++ks) {
    u16* cur = lds + (ks & 1) * (256 * TS);
    const bool more = (ks + 1 < nk);
    if (more) {
      const u16* An = Ab + (size_t)(ks + 1) * a_kstride;
      const u16* Bn = Bb + (size_t)(ks + 1) * 64;
      G_LD(An, Bn)
    }
    const u16* sX = swapped ? cur + 128 * TS : cur;
    const u16* sY = swapped ? cur : cur + 128 * TS;
#pragma unroll
    for (int kk = 0; kk < 2; ++kk) {
      bf16x8 fx[4], fy[4];
#pragma unroll
      for (int i = 0; i < 4; ++i) {
        fx[i] = *(const bf16x8*)(sX + (wx * 64 + i * 16 + l16) * TS + kk * 32 + gk * 8);
        fy[i] = *(const bf16x8*)(sY + (wy * 64 + i * 16 + l16) * TS + kk * 32 + gk * 8);
      }
#pragma unroll
      for (int i = 0; i < 4; ++i)
#pragma unroll
        for (int j = 0; j < 4; ++j) acc[i][j] = MFMA(fx[i], fy[j], acc[i][j]);
    }
    if (more) {
      u16* nxt = lds + ((ks + 1) & 1) * (256 * TS);
      G_ST(nxt)
    }
    __syncthreads();
  }
#undef G_LD
#undef G_ST
}

__device__ __forceinline__ void gemm_inproj(const Params& p, int layer, u16* lds) {
  const u16* A = (const u16*)(p.ws + WS_HBF);
  const u16* Bt = (const u16*)(p.ws + (layer ? WS_WT1 : WS_WT0));
  u16* QK = (u16*)(p.ws + WS_QK);
  u16* VT = (u16*)(p.ws + WS_VT);
  float* F = (float*)(p.ws + (layer ? WS_GL : WS_FLOG));
  const int NT = layer ? 29 : 33;
  const int ntrans_end = layer ? 28 : 32;
  const int nvalidF = layer ? 48 : 8, ldf = layer ? 48 : 8;
  const int tid = TIDX, lane = tid & 63, wave = tid >> 6, l16 = lane & 15, gk = lane >> 4;
  const int wx = wave >> 1, wy = wave & 1;
  for (int tile = BIDX; tile < 256 * NT; tile += gridDim.x) {
    const int mt = tile / NT, nt = tile % NT;
    const int m0 = mt * 128, n0 = nt * 128;
    int mode;
    if (nt < 24) mode = (layer == 0 && nt >= 12 && nt < 16) ? 2 : 0;
    else if (nt < ntrans_end) mode = 1;
    else mode = 3;
    const bool swapped = (mode == 0 || mode == 3);
    uint32_t pa[4], pb[4];
#pragma unroll
    for (int i = 0; i < 4; ++i) {
      int c = tid + 256 * i, row = c >> 3, kc = c & 7;
      pa[i] = row * DM + kc * 8;
      pb[i] = row * DM + kc * 8;
    }
    f32x4 acc[4][4];
    gemm_mainloop(A + (size_t)m0 * DM, pa, Bt + (size_t)n0 * DM, pb, 64, 16, lds, acc, swapped);
    if (swapped) {
#pragma unroll
      for (int i = 0; i < 4; ++i)
#pragma unroll
        for (int j = 0; j < 4; ++j) {
          const int n = n0 + wx * 64 + i * 16 + gk * 4;
          const int m = m0 + wy * 64 + j * 16 + l16;
          if (mode == 0) {
            uint2 o; o.x = pack2(acc[i][j][0], acc[i][j][1]); o.y = pack2(acc[i][j][2], acc[i][j][3]);
            *(uint2*)(QK + (size_t)m * LDQ + n) = o;
          } else {
            const int nn = n - n0;
            if (nn < nvalidF) *(float4*)(F + (size_t)m * ldf + nn) = (float4){acc[i][j][0], acc[i][j][1], acc[i][j][2], acc[i][j][3]};
          }
        }
    } else {
#pragma unroll
      for (int i = 0; i < 4; ++i)
#pragma unroll
        for (int j = 0; j < 4; ++j) {
          const int m = m0 + wx * 64 + i * 16 + gk * 4;
          const int n = n0 + wy * 64 + j * 16 + l16;
          if (mode == 1) {
            const int trow = n - 3072;
            uint2 o; o.x = pack2(acc[i][j][0], acc[i][j][1]); o.y = pack2(acc[i][j][2], acc[i][j][3]);
            *(uint2*)(VT + (size_t)trow * MTOK + m) = o;
          } else {
            const int trow = n - 512;
            const int h = (n - 1536) >> 6;
            const float lg2 = log1pf(-exp2f(-5.f - (float)h)) * LOG2E;
            float sv[4];
#pragma unroll
            for (int r = 0; r < 4; ++r) {
              QK[(size_t)(m + r) * LDQ + n] = f2bf(acc[i][j][r]);
              sv[r] = acc[i][j][r] * 0.125f * exp2f(lg2 * (float)(127 - ((m + r) & 127)));
            }
            uint2 o; o.x = pack2(sv[0], sv[1]); o.y = pack2(sv[2], sv[3]);
            *(uint2*)(VT + (size_t)trow * MTOK + m) = o;
          }
        }
    }
  }
}

__device__ __forceinline__ void gemm_outproj(const Params& p, int layer, u16* lds) {
  const u16* A = (const u16*)(p.ws + WS_Y);
  const u16* Bt = (const u16*)(p.ws + (layer ? WS_WO1 : WS_WO0));
  const float* res = layer ? p.out : p.x;
  float* out = p.out;
  const int tid = TIDX, lane = tid & 63, wave = tid >> 6, l16 = lane & 15, gk = lane >> 4;
  const int wx = wave >> 1, wy = wave & 1;
  for (int tile = BIDX; tile < 256 * 8; tile += gridDim.x) {
    const int mt = tile >> 3, nt = tile & 7;
    const int m0 = mt * 128, n0 = nt * 128;
    uint32_t pa[4], pb[4];
#pragma unroll
    for (int i = 0; i < 4; ++i) {
      int c = tid + 256 * i, row = c >> 3, kc = c & 7;
      pa[i] = row * DM + kc * 8;
      pb[i] = row * DM + kc * 8;
    }
    f32x4 acc[4][4];
    gemm_mainloop(A + (size_t)m0 * DM, pa, Bt + (size_t)n0 * DM, pb, 64, 16, lds, acc, true);
#pragma unroll
    for (int i = 0; i < 4; ++i)
#pragma unroll
      for (int j = 0; j < 4; ++j) {
        const int n = n0 + wx * 64 + i * 16 + gk * 4;
        const int m = m0 + wy * 64 + j * 16 + l16;
        const float4 r = *(const float4*)(res + (size_t)m * DM + n);
        *(float4*)(out + (size_t)m * DM + n) = (float4){r.x + acc[i][j][0], r.y + acc[i][j][1], r.z + acc[i][j][2], r.w + acc[i][j][3]};
      }
  }
}

__device__ __forceinline__ void gemm_cmp1(const Params& p, u16* lds) {
  const u16* U = (const u16*)(p.ws + WS_QK);
  const float* peb = (const float*)(p.ws + WS_PEB);
  const int tid = TIDX, lane = tid & 63, wave = tid >> 6, l16 = lane & 15, gk = lane >> 4;
  const int wx = wave >> 1, wy = wave & 1;
  for (int tile = BIDX; tile < 2 * 64 * 2; tile += gridDim.x) {
    const int kv = tile >> 7, mt = (tile >> 1) & 63, nt = tile & 1;
    const int m0 = mt * 128, n0 = nt * 128;
    const u16* Bt = (const u16*)(p.ws + (kv ? WS_W1V : WS_W1K));
    u16* Hc = (u16*)(p.ws + WS_HC) + (size_t)kv * 8192 * 256;
    uint32_t pa[4], pb[4];
#pragma unroll
    for (int i = 0; i < 4; ++i) {
      int c = tid + 256 * i, row = c >> 3, kc = c & 7;
      const int r = m0 + row, bg = r >> 9, cc = r & 511, b = bg >> 2, g = bg & 3;
      int tok0 = cc * 16; if (tok0 > SEQ - 32) tok0 = SEQ - 32;
      pa[i] = (uint32_t)(b * SEQ + tok0) * LDQ + 1024 + kv * 256 + g * 64 + kc * 8;
      pb[i] = row * 2048 + kc * 8;
    }
    f32x4 acc[4][4];
    gemm_mainloop(U, pa, Bt + (size_t)n0 * 2048, pb, LDQ, 32, lds, acc, true);
#pragma unroll
    for (int i = 0; i < 4; ++i)
#pragma unroll
      for (int j = 0; j < 4; ++j) {
        const int n = n0 + wx * 64 + i * 16 + gk * 4;
        const int m = m0 + wy * 64 + j * 16 + l16;
        const float4 bb = *(const float4*)(peb + kv * 256 + n);
        float v0 = silu_f(acc[i][j][0] + bb.x), v1 = silu_f(acc[i][j][1] + bb.y);
        float v2 = silu_f(acc[i][j][2] + bb.z), v3 = silu_f(acc[i][j][3] + bb.w);
        if ((m & 511) == 511) { v0 = v1 = v2 = v3 = 0.f; }
        uint2 o; o.x = pack2(v0, v1); o.y = pack2(v2, v3);
        *(uint2*)(Hc + (size_t)m * 256 + n) = o;
      }
  }
}

__device__ __forceinline__ void gemm_cmp2(const Params& p, u16* lds) {
  const int tid = TIDX, lane = tid & 63, wave = tid >> 6, l16 = lane & 15, gk = lane >> 4;
  const int wx = wave >> 1, wy = wave & 1;
  for (int tile = BIDX; tile < 128; tile += gridDim.x) {
    const int kv = tile >> 6, mt = tile & 63;
    const int m0 = mt * 128;
    const u16* A = (const u16*)(p.ws + WS_HC) + (size_t)kv * 8192 * 256;
    const u16* Bt = (const u16*)(p.ws + (kv ? WS_W2V : WS_W2K));
    uint32_t pa[4], pb[4];
#pragma unroll
    for (int i = 0; i < 4; ++i) {
      int c = tid + 256 * i, row = c >> 3, kc = c & 7;
      pa[i] = row * 256 + kc * 8;
      pb[i] = row * 256 + kc * 8;
    }
    f32x4 acc[4][4];
    const bool swapped = (kv == 0);
    gemm_mainloop(A + (size_t)m0 * 256, pa, Bt, pb, 64, 4, lds, acc, swapped);
    if (swapped) {
      u16* kc_ = (u16*)(p.ws + WS_KCMP);
#pragma unroll
      for (int i = 0; i < 4; ++i)
#pragma unroll
        for (int j = 0; j < 4; ++j) {
          const int n = wx * 64 + i * 16 + gk * 4;
          const int m = m0 + wy * 64 + j * 16 + l16;
          if (n < 64) {
            uint2 o; o.x = pack2(acc[i][j][0], acc[i][j][1]); o.y = pack2(acc[i][j][2], acc[i][j][3]);
            *(uint2*)(kc_ + (size_t)m * 64 + n) = o;
          }
        }
    } else {
      u16* vt = (u16*)(p.ws + WS_VCMPT);
#pragma unroll
      for (int i = 0; i < 4; ++i)
#pragma unroll
        for (int j = 0; j < 4; ++j) {
          const int m = m0 + wx * 64 + i * 16 + gk * 4;
          const int n = wy * 64 + j * 16 + l16;
          if (n < 64) {
            uint2 o; o.x = pack2(acc[i][j][0], acc[i][j][1]); o.y = pack2(acc[i][j][2], acc[i][j][3]);
            *(uint2*)(vt + (size_t)(m >> 9) * 32768 + (size_t)n * 512 + (m & 511)) = o;
          }
        }
    }
  }
}

#define TILE_LD(R, src, stride) { const u16* s_ = (src); R##0 = *(const uint4*)(s_ + (long)(tid >> 3) * (stride) + (tid & 7) * 8); \
                                  R##1 = *(const uint4*)(s_ + (long)((tid >> 3) + 32) * (stride) + (tid & 7) * 8); }
#define TILE_ST(dst, R) { u16* d_ = (dst); *(uint4*)(d_ + (tid >> 3) * TS + (tid & 7) * 8) = R##0; \
                          *(uint4*)(d_ + ((tid >> 3) + 32) * TS + (tid & 7) * 8) = R##1; }
__device__ __forceinline__ void qk_tile(const u16* sK, const bf16x8 (&q)[2], f32x4 (&s)[4], int l16, int gk) {
#pragma unroll
  for (int kt = 0; kt < 4; ++kt) s[kt] = (f32x4){0.f, 0.f, 0.f, 0.f};
#pragma unroll
  for (int ks = 0; ks < 2; ++ks)
#pragma unroll
    for (int kt = 0; kt < 4; ++kt) {
      bf16x8 kf = *(const bf16x8*)(sK + (kt * 16 + l16) * TS + ks * 32 + gk * 8);
      s[kt] = MFMA(kf, q[ks], s[kt]);
    }
}
__device__ __forceinline__ void pv_tile(const u16* sV, const float (&pp)[4][4], f32x4 (&o)[4], int l16, int gk) {
  bf16x8 pf[2];
#pragma unroll
  for (int ks2 = 0; ks2 < 2; ++ks2) {
    uint4 t;
    t.x = pack2(pp[2 * ks2][0], pp[2 * ks2][1]); t.y = pack2(pp[2 * ks2][2], pp[2 * ks2][3]);
    t.z = pack2(pp[2 * ks2 + 1][0], pp[2 * ks2 + 1][1]); t.w = pack2(pp[2 * ks2 + 1][2], pp[2 * ks2 + 1][3]);
    pf[ks2] = *(bf16x8*)&t;
  }
#pragma unroll
  for (int dt = 0; dt < 4; ++dt)
#pragma unroll
    for (int ks2 = 0; ks2 < 2; ++ks2) {
      uint2 a0 = *(const uint2*)(sV + (dt * 16 + l16) * TS + (2 * ks2) * 16 + gk * 4);
      uint2 a1 = *(const uint2*)(sV + (dt * 16 + l16) * TS + (2 * ks2 + 1) * 16 + gk * 4);
      uint4 t; t.x = a0.x; t.y = a0.y; t.z = a1.x; t.w = a1.y;
      o[dt] = MFMA(*(bf16x8*)&t, pf[ks2], o[dt]);
    }
}

__device__ __forceinline__ void fox_phase(const Params& p, u16* lds) {
  const u16* QK = (const u16*)(p.ws + WS_QK);
  const u16* VT = (const u16*)(p.ws + WS_VT);
  const float* cf = (const float*)(p.ws + WS_CFOX);
  u16* Y = (u16*)(p.ws + WS_Y);
  const int tid = TIDX, lane = tid & 63, w = tid >> 6, l16 = lane & 15, gk = lane >> 4;
  const float scale2 = 0.125f * LOG2E;
  for (int unit = BIDX; unit < 2048; unit += gridDim.x) {
    const int bh = unit & 31, qblk = 63 - (unit >> 5), b = bh >> 3, h = bh & 7;
    const int tq0 = qblk * 128 + w * 32;
    const float* cfr = cf + (size_t)bh * SEQ;
    bf16x8 q[2][2];
    float cq2[2];
#pragma unroll
    for (int cgi = 0; cgi < 2; ++cgi) {
      const int t = tq0 + cgi * 16 + l16;
#pragma unroll
      for (int ks = 0; ks < 2; ++ks) q[cgi][ks] = *(const bf16x8*)(QK + (size_t)(b * SEQ + t) * LDQ + h * 64 + ks * 32 + gk * 8);
      cq2[cgi] = cfr[t] * LOG2E;
    }
    f32x4 o[2][4];
    float m[2], l[2];
#pragma unroll
    for (int cgi = 0; cgi < 2; ++cgi) {
      m[cgi] = -1e30f; l[cgi] = 0.f;
#pragma unroll
      for (int dt = 0; dt < 4; ++dt) o[cgi][dt] = (f32x4){0.f, 0.f, 0.f, 0.f};
    }
    const int ntiles = qblk * 2 + 2;
    const int iw = qblk * 2 + (w >> 1);
    const u16* ksrc = QK + (size_t)(b * SEQ) * LDQ + 512 + h * 64;
    const u16* vsrc = VT + (size_t)(h * 64) * MTOK + (size_t)b * SEQ;
    float qs = 0.f;
#pragma unroll
    for (int cgi = 0; cgi < 2; ++cgi) {
      float ss = 0.f;
#pragma unroll
      for (int ks = 0; ks < 2; ++ks)
#pragma unroll
        for (int e = 0; e < 8; ++e) { const float v = bf2f((u16)q[cgi][ks][e]); ss += v * v; }
      ss += __shfl_xor(ss, 16); ss += __shfl_xor(ss, 32);
      qs = fmaxf(qs, ss);
    }
#pragma unroll
    for (int o = 1; o <= 8; o <<= 1) qs = fmaxf(qs, __shfl_xor(qs, o));
    float* red = (float*)(lds + 256 * TS);
    if (lane == 0) red[w] = qs;
    __syncthreads();
    const float qmax2 = fmaxf(fmaxf(red[0], red[1]), fmaxf(red[2], red[3]));
    const float kmax2 = __uint_as_float(((const uint32_t*)(p.ws + WS_KMAX))[h]);
    const float T2 = 2.f * scale2 * sqrtf(qmax2 * kmax2) * 1.001f + 48.f;
    const float cfirst2 = cfr[qblk * 128] * LOG2E;
    int i_lo = 0;
    for (int base = qblk * 2 - 1; base >= 0; base -= 64) {
      const int ti = base - lane;
      bool skip = false;
      if (ti >= 0) skip = (cfirst2 - cfr[ti * 64 + 63] * LOG2E) < -T2;
      const unsigned long long bal = __ballot(skip);
      if (bal) { i_lo = base - (int)__builtin_ctzll(bal) + 1; break; }
    }
    uint4 rk0, rk1, rv0, rv1;
    TILE_LD(rk, ksrc + (size_t)i_lo * 64 * LDQ, LDQ); TILE_LD(rv, vsrc + i_lo * 64, MTOK);
    TILE_ST(lds + (i_lo & 1) * (128 * TS), rk); TILE_ST(lds + (i_lo & 1) * (128 * TS) + 64 * TS, rv);
    __syncthreads();
    for (int i = i_lo; i < ntiles; ++i) {
      u16* cur = lds + (i & 1) * (128 * TS);
      const bool more = (i + 1 < ntiles);
      if (more) { TILE_LD(rk, ksrc + (size_t)(i + 1) * 64 * LDQ, LDQ); TILE_LD(rv, vsrc + (i + 1) * 64, MTOK); }
      if (i <= iw) {
        const int s0 = i * 64;
        const bool diag = (i == iw);
        float ck2[4][4];
#pragma unroll
        for (int kt = 0; kt < 4; ++kt) {
          float4 c4 = *(const float4*)(cfr + s0 + kt * 16 + gk * 4);
          ck2[kt][0] = c4.x * LOG2E; ck2[kt][1] = c4.y * LOG2E; ck2[kt][2] = c4.z * LOG2E; ck2[kt][3] = c4.w * LOG2E;
        }
#pragma unroll
        for (int cgi = 0; cgi < 2; ++cgi) {
          f32x4 s[4];
          qk_tile(cur, q[cgi], s, l16, gk);
          const int t = tq0 + cgi * 16 + l16;
          float xv[4][4];
          float mx = -1e30f;
#pragma unroll
          for (int kt = 0; kt < 4; ++kt)
#pragma unroll
            for (int r = 0; r < 4; ++r) {
              float v = fmaf(s[kt][r], scale2, cq2[cgi] - ck2[kt][r]);
              if (diag && (s0 + kt * 16 + gk * 4 + r > t)) v = -1e30f;
              xv[kt][r] = v; mx = fmaxf(mx, v);
            }
          mx = fmaxf(mx, __shfl_xor(mx, 16)); mx = fmaxf(mx, __shfl_xor(mx, 32));
          const float mnew = fmaxf(m[cgi], mx);
          const float alpha = ex2(m[cgi] - mnew);
          m[cgi] = mnew;
          const float muse = fmaxf(mnew, -1e20f);
          float rs = 0.f;
#pragma unroll
          for (int kt = 0; kt < 4; ++kt)
#pragma unroll
            for (int r = 0; r < 4; ++r) { xv[kt][r] = ex2(xv[kt][r] - muse); rs += xv[kt][r]; }
          l[cgi] = l[cgi] * alpha + rs;
#pragma unroll
          for (int dt = 0; dt < 4; ++dt) o[cgi][dt] *= alpha;
          pv_tile(cur + 64 * TS, xv, o[cgi], l16, gk);
        }
      }
      if (more) { u16* nxt = lds + ((i + 1) & 1) * (128 * TS); TILE_ST(nxt, rk); TILE_ST(nxt + 64 * TS, rv); }
      __syncthreads();
    }
#pragma unroll
    for (int cgi = 0; cgi < 2; ++cgi) {
      float lt = l[cgi]; lt += __shfl_xor(lt, 16); lt += __shfl_xor(lt, 32);
      const float inv = lt > 0.f ? 1.f / lt : 0.f;
      const size_t mrow = (size_t)(b * SEQ + tq0 + cgi * 16 + l16);
#pragma unroll
      for (int dt = 0; dt < 4; ++dt) {
        const int col = h * 64 + dt * 16 + gk * 4;
        const uint2 zz = *(const uint2*)(QK + mrow * LDQ + 2048 + col);
        const float z0 = bf2f(zz.x & 0xffff), z1 = bf2f(zz.x >> 16), z2 = bf2f(zz.y & 0xffff), z3 = bf2f(zz.y >> 16);
        uint2 ov;
        ov.x = pack2(o[cgi][dt][0] * inv * silu_f(z0), o[cgi][dt][1] * inv * silu_f(z1));
        ov.y = pack2(o[cgi][dt][2] * inv * silu_f(z2), o[cgi][dt][3] * inv * silu_f(z3));
        *(uint2*)(Y + mrow * DM + col) = ov;
      }
    }
  }
}

__device__ __forceinline__ void fox_knorm(const Params& p) {
  const u16* QK = (const u16*)(p.ws + WS_QK);
  uint32_t* km = (uint32_t*)(p.ws + WS_KMAX);
  const int tid = TIDX, lane = tid & 63, wave = tid >> 6;
  float mx = 0.f;
  for (int row = BIDX * 4 + wave; row < MTOK; row += gridDim.x * 4) {
    const uint4 v = *(const uint4*)(QK + (size_t)row * LDQ + 512 + lane * 8);
    const float a0 = bf2f(v.x & 0xffff), a1 = bf2f(v.x >> 16), a2 = bf2f(v.y & 0xffff), a3 = bf2f(v.y >> 16);
    const float a4 = bf2f(v.z & 0xffff), a5 = bf2f(v.z >> 16), a6 = bf2f(v.w & 0xffff), a7 = bf2f(v.w >> 16);
    float ss = a0 * a0 + a1 * a1 + a2 * a2 + a3 * a3 + a4 * a4 + a5 * a5 + a6 * a6 + a7 * a7;
    ss += __shfl_xor(ss, 1); ss += __shfl_xor(ss, 2); ss += __shfl_xor(ss, 4);
    mx = fmaxf(mx, ss);
  }
  if ((lane & 7) == 0) atomicMax(&km[lane >> 3], __float_as_uint(mx));
}

__device__ __forceinline__ void fox_scan(const Params& p, float* ldsf) {
  const float* fl = (const float*)(p.ws + WS_FLOG);
  float* cf = (float*)(p.ws + WS_CFOX);
  double* sd = (double*)ldsf;
  const int tid = TIDX;
  for (int bh = BIDX; bh < 32; bh += gridDim.x) {
    const int b = bh >> 3, h = bh & 7;
    const float bf = p.e_bf[h];
    float ls[32];
    double sum = 0.0;
#pragma unroll
    for (int i = 0; i < 32; ++i) {
      const float xx = fl[(size_t)(b * SEQ + tid * 32 + i) * 8 + h] + bf;
      ls[i] = fminf(xx, 0.f) - log1pf(__expf(-fabsf(xx)));
      sum += (double)ls[i];
    }
    __syncthreads();
    sd[tid] = sum;
    __syncthreads();
    double pre = 0.0;
    for (int j = 0; j < tid; ++j) pre += sd[j];
#pragma unroll
    for (int i = 0; i < 32; ++i) { pre += (double)ls[i]; cf[(size_t)bh * SEQ + tid * 32 + i] = (float)pre; }
  }
}

__device__ __forceinline__ void ret_stepA(const Params& p) {
  const u16* VT = (const u16*)(p.ws + WS_VT);
  float* dS = (float*)(p.ws + WS_DS);
  const int lane = TIDX & 63, w = TIDX >> 6, l16 = lane & 15, gk = lane >> 4;
  for (int u = BIDX; u < 2048; u += gridDim.x) {
    const int bh = u >> 6, n = u & 63, b = bh >> 3, h = bh & 7;
    const size_t mcol = (size_t)b * SEQ + n * 128;
    f32x4 acc[4];
#pragma unroll
    for (int dt = 0; dt < 4; ++dt) acc[dt] = (f32x4){0.f, 0.f, 0.f, 0.f};
#pragma unroll
    for (int ks = 0; ks < 4; ++ks) {
      bf16x8 af = *(const bf16x8*)(VT + (size_t)(512 + h * 64 + w * 16 + l16) * MTOK + mcol + ks * 32 + gk * 8);
#pragma unroll
      for (int dt = 0; dt < 4; ++dt) {
        bf16x8 bfr = *(const bf16x8*)(VT + (size_t)(1024 + h * 64 + dt * 16 + l16) * MTOK + mcol + ks * 32 + gk * 8);
        acc[dt] = MFMA(af, bfr, acc[dt]);
      }
    }
#pragma unroll
    for (int dt = 0; dt < 4; ++dt)
#pragma unroll
      for (int r = 0; r < 4; ++r) dS[(size_t)u * 4096 + (w * 16 + gk * 4 + r) * 64 + dt * 16 + l16] = acc[dt][r];
  }
}
__device__ __forceinline__ void ret_stepB(const Params& p) {
  const float* dS = (const float*)(p.ws + WS_DS);
  u16* st = (u16*)(p.ws + WS_ST);
  for (int idx = BIDX * 256 + TIDX; idx < 32 * 4096; idx += gridDim.x * 256) {
    const int bh = idx >> 12, ed = idx & 4095, h = bh & 7;
    const float cdec = __expf(log1pf(-exp2f(-5.f - (float)h)) * 128.f);
    float s = 0.f;
#pragma unroll 8
    for (int n = 0; n < 64; ++n) {
      const size_t a = (size_t)(bh * 64 + n) * 4096 + ed;
      st[a] = f2bf(s);
      s = s * cdec + dS[a];
    }
  }
}
__device__ __forceinline__ void ret_stepC(const Params& p, u16* lds) {
  const u16* QK = (const u16*)(p.ws + WS_QK);
  const u16* VT = (const u16*)(p.ws + WS_VT);
  const u16* st = (const u16*)(p.ws + WS_ST);
  u16* Y = (u16*)(p.ws + WS_Y);
  const int tid = TIDX, lane = tid & 63, w = tid >> 6, l16 = lane & 15, gk = lane >> 4;
  for (int u = BIDX; u < 2048; u += gridDim.x) {
    const int bh = u >> 6, n = u & 63, b = bh >> 3, h = bh & 7;
    const size_t m0 = (size_t)b * SEQ + n * 128;
    const float lg2 = log1pf(-exp2f(-5.f - (float)h)) * LOG2E;
    __syncthreads();
    {
      uint4 r0, r1;
      TILE_LD(r, QK + m0 * LDQ + 1536 + h * 64, LDQ); TILE_ST(lds, r);
      TILE_LD(r, VT + (size_t)(512 + h * 64) * MTOK + m0, MTOK); TILE_ST(lds + 64 * TS, r);
      TILE_LD(r, QK + (m0 + 64) * LDQ + 1536 + h * 64, LDQ); TILE_ST(lds + 128 * TS, r);
      TILE_LD(r, VT + (size_t)(512 + h * 64) * MTOK + m0 + 64, MTOK); TILE_ST(lds + 192 * TS, r);
      TILE_LD(r, st + (size_t)u * 4096, 64); TILE_ST(lds + 256 * TS, r);
    }
    __syncthreads();
#pragma unroll
    for (int cgi = 0; cgi < 2; ++cgi) {
      const int iq = 32 * w + cgi * 16 + l16;
      const size_t mrow = m0 + iq;
      bf16x8 q[2];
#pragma unroll
      for (int ks = 0; ks < 2; ++ks) q[ks] = *(const bf16x8*)(QK + mrow * LDQ + 1024 + h * 64 + ks * 32 + gk * 8);
      f32x4 o[4];
#pragma unroll
      for (int dt = 0; dt < 4; ++dt) o[dt] = (f32x4){0.f, 0.f, 0.f, 0.f};
#pragma unroll
      for (int dt = 0; dt < 4; ++dt)
#pragma unroll
        for (int ks = 0; ks < 2; ++ks) {
          bf16x8 sf = *(const bf16x8*)(lds + 256 * TS + (dt * 16 + l16) * TS + ks * 32 + gk * 8);
          o[dt] = MFMA(sf, q[ks], o[dt]);
        }
      const float cross = exp2f(lg2 * (float)(iq + 1));
#pragma unroll
      for (int dt = 0; dt < 4; ++dt) o[dt] *= cross;
#pragma unroll
      for (int k64 = 0; k64 < 2; ++k64) {
        if (k64 * 64 <= 32 * w + 31) {
          f32x4 s[4];
          qk_tile(lds + k64 * 128 * TS, q, s, l16, gk);
          float pp[4][4];
#pragma unroll
          for (int kt = 0; kt < 4; ++kt)
#pragma unroll
            for (int r = 0; r < 4; ++r) {
              const int j = k64 * 64 + kt * 16 + gk * 4 + r;
              pp[kt][r] = (j <= iq) ? s[kt][r] * 0.125f * ex2(lg2 * (float)(iq - j)) : 0.f;
            }
          pv_tile(lds + k64 * 128 * TS + 64 * TS, pp, o, l16, gk);
        }
      }
      float sm = 0.f;
#pragma unroll
      for (int dt = 0; dt < 4; ++dt) sm += o[dt][0] + o[dt][1] + o[dt][2] + o[dt][3];
      sm += __shfl_xor(sm, 16); sm += __shfl_xor(sm, 32);
      const float mu = sm * (1.f / 64.f);
      float vs = 0.f;
#pragma unroll
      for (int dt = 0; dt < 4; ++dt)
#pragma unroll
        for (int r = 0; r < 4; ++r) { const float d = o[dt][r] - mu; vs += d * d; }
      vs += __shfl_xor(vs, 16); vs += __shfl_xor(vs, 32);
      const float rstd = rsqrtf(vs * (1.f / 64.f) + 1e-5f);
#pragma unroll
      for (int dt = 0; dt < 4; ++dt) {
        const int col = h * 64 + dt * 16 + gk * 4;
        const float4 gg = *(const float4*)(p.e_gn + col);
        const uint2 zz = *(const uint2*)(QK + mrow * LDQ + 2048 + 512 + col);
        const float z0 = bf2f(zz.x & 0xffff), z1 = bf2f(zz.x >> 16), z2 = bf2f(zz.y & 0xffff), z3 = bf2f(zz.y >> 16);
        uint2 ov;
        ov.x = pack2((o[dt][0] - mu) * rstd * gg.x * silu_f(z0), (o[dt][1] - mu) * rstd * gg.y * silu_f(z1));
        ov.y = pack2((o[dt][2] - mu) * rstd * gg.z * silu_f(z2), (o[dt][3] - mu) * rstd * gg.w * silu_f(z3));
        *(uint2*)(Y + mrow * DM + 512 + col) = ov;
      }
    }
  }
}

template <int BR>
__device__ __forceinline__ void nsa_tile(const u16* sK, const u16* sV, const bf16x8 (&q)[4][2], f32x4 (&acc)[4][4],
                                         float (&m)[4], float (&l)[4], const float (&slope2)[4], const float (&gmul)[4],
                                         int t, int pos0, int pstride, int wl, bool lanesel,
                                         float* imp_row, int jbase, float& carry, int lane) {
  const int l16 = lane & 15, gk = lane >> 4;
  const float scale2 = 0.125f * LOG2E;
  float ps[4][4];
  if (BR == 1) {
#pragma unroll
    for (int kt = 0; kt < 4; ++kt)
#pragma unroll
      for (int r = 0; r < 4; ++r) ps[kt][r] = 0.f;
  }
  float fd[4][4], pen[4][4];
  const unsigned wle = lanesel ? (unsigned)wl : 0u;
#pragma unroll
  for (int kt = 0; kt < 4; ++kt)
#pragma unroll
    for (int r = 0; r < 4; ++r) {
      const int dist = t - (pos0 + (kt * 16 + gk * 4 + r) * pstride);
      fd[kt][r] = (float)dist;
      pen[kt][r] = ((unsigned)dist < wle) ? 0.f : -1e30f;
    }
#pragma unroll
  for (int cgi = 0; cgi < 4; ++cgi) {
    f32x4 s[4];
    qk_tile(sK, q[cgi], s, l16, gk);
    float xv[4][4];
    float mx = -1e30f;
#pragma unroll
    for (int kt = 0; kt < 4; ++kt)
#pragma unroll
      for (int r = 0; r < 4; ++r) {
        const float v = fmaf(s[kt][r], scale2, fmaf(-slope2[cgi], fd[kt][r], pen[kt][r]));
        xv[kt][r] = v; mx = fmaxf(mx, v);
      }
    if (BR != 1) {
      mx = fmaxf(mx, __shfl_xor(mx, 16)); mx = fmaxf(mx, __shfl_xor(mx, 32));
      const float mnew = fmaxf(m[cgi], mx);
      const float alpha = ex2(m[cgi] - mnew);
      m[cgi] = mnew;
      const float muse = fmaxf(mnew, -1e20f);
      float rs = 0.f;
#pragma unroll
      for (int kt = 0; kt < 4; ++kt)
#pragma unroll
        for (int r = 0; r < 4; ++r) { xv[kt][r] = ex2(xv[kt][r] - muse); rs += xv[kt][r]; }
      l[cgi] = l[cgi] * alpha + rs;
      if (BR == 2) {
#pragma unroll
        for (int dt = 0; dt < 4; ++dt) acc[cgi][dt] *= alpha;
        pv_tile(sV, xv, acc[cgi], l16, gk);
      }
    } else {
      const float muse = fmaxf(m[cgi], -1e20f);
#pragma unroll
      for (int kt = 0; kt < 4; ++kt)
#pragma unroll
        for (int r = 0; r < 4; ++r) {
          const float pn = ex2(xv[kt][r] - muse) * l[cgi];
          ps[kt][r] += pn;
          xv[kt][r] = pn * gmul[cgi];
        }
      pv_tile(sV, xv, acc[cgi], l16, gk);
    }
  }
  if (BR == 1) {
    const int srcl = (lane + 48) & 63;
#pragma unroll
    for (int kt = 0; kt < 4; ++kt) {
      const float same = __shfl(ps[kt][3], srcl);
      const float prev = __shfl(kt > 0 ? ps[kt > 0 ? kt - 1 : 0][3] : carry, srcl);
      const float pm1 = (gk == 0) ? prev : same;
      imp_row[jbase + kt * 4 + gk] = 2.f * (ps[kt][0] + ps[kt][1] + ps[kt][2]) + ps[kt][3] + pm1;
    }
    carry = ps[3][3];
  }
}

__device__ __forceinline__ void nsa_phase(const Params& p, u16* lds) {
  const u16* U = (const u16*)(p.ws + WS_QK);
  const u16* VT = (const u16*)(p.ws + WS_VT);
  const u16* KC = (const u16*)(p.ws + WS_KCMP);
  const u16* VC = (const u16*)(p.ws + WS_VCMPT);
  const float* GL = (const float*)(p.ws + WS_GL);
  u16* Y = (u16*)(p.ws + WS_Y);
  float* imp = (float*)(lds + 256 * TS);
  uint32_t* umask = (uint32_t*)(imp + 64 * IMPS);
  int* ulist = (int*)(umask + 4);
  const int tid = TIDX, lane = tid & 63, w = tid >> 6, l16 = lane & 15, gk = lane >> 4;
  uint2* totl = (uint2*)imp + (size_t)w * 1024 + lane;
  const int BIG = 1 << 30;
  for (int unit = BIDX; unit < 2048; unit += gridDim.x) {
    const int bg = unit & 15, qb = 127 - (unit >> 4), b = bg >> 2, g = bg & 3;
    const int t0 = qb * 64, t = t0 + 16 * w + l16;
    const size_t mrow = (size_t)b * SEQ + t;
    bf16x8 q[4][2];
    float slope2[4], g1[4];
#pragma unroll
    for (int cgi = 0; cgi < 4; ++cgi) {
      const int h = g * 4 + cgi;
#pragma unroll
      for (int ks = 0; ks < 2; ++ks) q[cgi][ks] = *(const bf16x8*)(U + mrow * LDQ + h * 64 + ks * 32 + gk * 8);
      slope2[cgi] = exp2f(-0.5f * (float)(h + 1)) * LOG2E;
      g1[cgi] = sigmoid_f(GL[mrow * 48 + h * 3] + p.o_bg[h * 3]);
    }
    f32x4 acc[4][4];
    float m[4], l[4];
#pragma unroll
    for (int cgi = 0; cgi < 4; ++cgi) {
      m[cgi] = -1e30f; l[cgi] = 0.f;
#pragma unroll
      for (int dt = 0; dt < 4; ++dt) acc[cgi][dt] = (f32x4){0.f, 0.f, 0.f, 0.f};
    }
    __syncthreads();
    for (int i = tid; i < 64 * IMPS; i += 256) imp[i] = 0.f;
    if (tid < 4) umask[tid] = 0u;
    float* imp_row = imp + (16 * w + l16) * IMPS;
    float carry = 0.f;
    uint4 rk0, rk1, rv0, rv1;
    const int ntc = ((4 * qb + 2) >> 6) + 1;
    const u16* kcs = KC + (size_t)bg * 512 * 64;
    const u16* vcs = VC + (size_t)bg * 32768;
#pragma unroll 1
    for (int pass = 0; pass < 2; ++pass) {
      TILE_LD(rk, kcs, 64); TILE_LD(rv, vcs, 512);
      __syncthreads();
      TILE_ST(lds, rk); TILE_ST(lds + 64 * TS, rv);
      __syncthreads();
#pragma unroll 1
      for (int i = 0; i < ntc; ++i) {
        u16* cur = lds + (i & 1) * (128 * TS);
        const bool more = (i + 1 < ntc);
        if (more) { TILE_LD(rk, kcs + (size_t)(i + 1) * 64 * 64, 64); TILE_LD(rv, vcs + (i + 1) * 64, 512); }
        if (pass == 0) nsa_tile<0>(cur, cur + 64 * TS, q, acc, m, l, slope2, g1, t, 16 * (64 * i) + 31, 16, BIG, true, imp_row, 16 * i, carry, lane);
        else nsa_tile<1>(cur, cur + 64 * TS, q, acc, m, l, slope2, g1, t, 16 * (64 * i) + 31, 16, BIG, true, imp_row, 16 * i, carry, lane);
        if (more) { u16* nxt = lds + ((i + 1) & 1) * (128 * TS); TILE_ST(nxt, rk); TILE_ST(nxt + 64 * TS, rv); }
        __syncthreads();
      }
      if (pass == 0) {
#pragma unroll
        for (int cgi = 0; cgi < 4; ++cgi) {
          float lt = l[cgi]; lt += __shfl_xor(lt, 16); lt += __shfl_xor(lt, 32);
          l[cgi] = lt > 0.f ? 1.f / lt : 0.f;
        }
      }
    }
    uint32_t selm = 0u;
    if (qb < 16) {
      if (gk == 0) selm = (1u << (qb + 1)) - 1u;
    } else {
      float val[32];
#pragma unroll
      for (int i4 = 0; i4 < 8; ++i4) {
        const float4 v4 = *(const float4*)(imp_row + 32 * gk + 4 * i4);
        val[4 * i4] = v4.x; val[4 * i4 + 1] = v4.y; val[4 * i4 + 2] = v4.z; val[4 * i4 + 3] = v4.w;
      }
#pragma unroll
      for (int i = 0; i < 32; ++i) {
        const int j = 32 * gk + i;
        const bool forced = (j == 0) || (j == qb) || (j == qb - 1);
        if (forced) selm |= (1u << i);
        if (forced || j > qb) val[i] = -1.f;
      }
#pragma unroll 1
      for (int it = 0; it < 13; ++it) {
        float best = -2.f; int bj = 0;
#pragma unroll
        for (int i = 0; i < 32; ++i) {
          const float v = ((selm >> i) & 1u) ? -1.f : val[i];
          if (v > best) { best = v; bj = 32 * gk + i; }
        }
#pragma unroll
        for (int o = 16; o <= 32; o <<= 1) {
          const float ov = __shfl_xor(best, o); const int oj = __shfl_xor(bj, o);
          if (ov > best || (ov == best && oj < bj)) { best = ov; bj = oj; }
        }
        if ((bj >> 5) == gk) selm |= (1u << (bj & 31));
      }
    }
    const uint32_t sel0 = __shfl(selm, l16), sel1 = __shfl(selm, l16 + 16), sel2 = __shfl(selm, l16 + 32), sel3 = __shfl(selm, l16 + 48);
    uint32_t wu = selm;
#pragma unroll
    for (int o = 1; o <= 8; o <<= 1) wu |= __shfl_xor(wu, o);
    const uint32_t wun0 = __shfl(wu, 0), wun1 = __shfl(wu, 16), wun2 = __shfl(wu, 32), wun3 = __shfl(wu, 48);
    if (l16 == 0) atomicOr(&umask[gk], wu);
    __syncthreads();
    int nsl = 0;
    {
      const uint32_t u0 = umask[0], u1 = umask[1], u2 = umask[2], u3 = umask[3];
      nsl = __popc(u0) + __popc(u1) + __popc(u2) + __popc(u3);
      if (tid < 128) {
        const uint32_t uw = tid < 32 ? u0 : tid < 64 ? u1 : tid < 96 ? u2 : u3;
        if ((uw >> (tid & 31)) & 1u) {
          int pos = __popc(uw & ((1u << (tid & 31)) - 1u));
          if (tid >= 32) pos += __popc(u0);
          if (tid >= 64) pos += __popc(u1);
          if (tid >= 96) pos += __popc(u2);
          ulist[pos] = tid;
        }
      }
    }
    __syncthreads();
#pragma unroll
    for (int cgi = 0; cgi < 4; ++cgi)
#pragma unroll
      for (int dt = 0; dt < 4; ++dt) {
        uint2 o2; o2.x = pack2(acc[cgi][dt][0], acc[cgi][dt][1]); o2.y = pack2(acc[cgi][dt][2], acc[cgi][dt][3]);
        totl[(cgi * 4 + dt) * 64] = o2;
      }
#pragma unroll 1
    for (int br = 1; br < 3; ++br) {
#pragma unroll
      for (int cgi = 0; cgi < 4; ++cgi) {
        m[cgi] = -1e30f; l[cgi] = 0.f;
#pragma unroll
        for (int dt = 0; dt < 4; ++dt) acc[cgi][dt] = (f32x4){0.f, 0.f, 0.f, 0.f};
      }
      const int i0w = (qb >= 8) ? 0 : 8 - qb;
      const int nt = (br == 1) ? nsl : 9 - i0w;
      const u16* kb = U + (size_t)b * SEQ * LDQ + (br == 1 ? 1536 : 1792) + g * 64;
      const u16* vb = VT + (size_t)((br == 1 ? 0 : 256) + g * 64) * MTOK + (size_t)b * SEQ;
      int s0 = (br == 1) ? ulist[0] * 64 : t0 - 512 + 64 * i0w;
      TILE_LD(rk, kb + (size_t)s0 * LDQ, LDQ); TILE_LD(rv, vb + s0, MTOK);
      __syncthreads();
      TILE_ST(lds, rk); TILE_ST(lds + 64 * TS, rv);
      __syncthreads();
#pragma unroll 1
      for (int i = 0; i < nt; ++i) {
        u16* cur = lds + (i & 1) * (128 * TS);
        const bool more = (i + 1 < nt);
        int s1 = 0;
        if (more) {
          s1 = (br == 1) ? ulist[i + 1] * 64 : s0 + 64;
          TILE_LD(rk, kb + (size_t)s1 * LDQ, LDQ); TILE_LD(rv, vb + s1, MTOK);
        }
        bool wsel = true, ls = true;
        int wl = 512;
        if (br == 1) {
          const int j = s0 >> 6, jw = j >> 5, jb = j & 31;
          const uint32_t ww = jw == 0 ? wun0 : jw == 1 ? wun1 : jw == 2 ? wun2 : wun3;
          const uint32_t sw = jw == 0 ? sel0 : jw == 1 ? sel1 : jw == 2 ? sel2 : sel3;
          wsel = (ww >> jb) & 1u; ls = (sw >> jb) & 1u; wl = BIG;
        }
        if (wsel) nsa_tile<2>(cur, cur + 64 * TS, q, acc, m, l, slope2, g1, t, s0, 1, wl, ls, imp_row, 0, carry, lane);
        if (more) { u16* nxt = lds + ((i + 1) & 1) * (128 * TS); TILE_ST(nxt, rk); TILE_ST(nxt + 64 * TS, rv); }
        s0 = s1;
        __syncthreads();
      }
#pragma unroll
      for (int cgi = 0; cgi < 4; ++cgi) {
        const int h = g * 4 + cgi;
        float lt = l[cgi]; lt += __shfl_xor(lt, 16); lt += __shfl_xor(lt, 32);
        const float gt = sigmoid_f(GL[mrow * 48 + h * 3 + br] + p.o_bg[h * 3 + br]);
        const float sc = lt > 0.f ? gt / lt : 0.f;
#pragma unroll
        for (int dt = 0; dt < 4; ++dt) {
          const uint2 pv = totl[(cgi * 4 + dt) * 64];
          const float r0 = bf2f(pv.x & 0xffff) + acc[cgi][dt][0] * sc, r1 = bf2f(pv.x >> 16) + acc[cgi][dt][1] * sc;
          const float r2 = bf2f(pv.y & 0xffff) + acc[cgi][dt][2] * sc, r3 = bf2f(pv.y >> 16) + acc[cgi][dt][3] * sc;
          if (br == 1) {
            uint2 o2; o2.x = pack2(r0, r1); o2.y = pack2(r2, r3);
            totl[(cgi * 4 + dt) * 64] = o2;
          } else {
            const int col = h * 64 + dt * 16 + gk * 4;
            const uint2 zz = *(const uint2*)(U + mrow * LDQ + 2048 + col);
            const float z0 = bf2f(zz.x & 0xffff), z1 = bf2f(zz.x >> 16), z2 = bf2f(zz.y & 0xffff), z3 = bf2f(zz.y >> 16);
            uint2 ov;
            ov.x = pack2(r0 * silu_f(z0), r1 * silu_f(z1));
            ov.y = pack2(r2 * silu_f(z2), r3 * silu_f(z3));
            *(uint2*)(Y + mrow * DM + col) = ov;
          }
        }
      }
    }
  }
}

__device__ __forceinline__ void final_norm(const Params& p) {
  const int lane = TIDX & 63, wave = TIDX >> 6;
  for (int row = BIDX * 4 + wave; row < MTOK; row += gridDim.x * 4) {
    float4* xr = (float4*)(p.out + (size_t)row * DM);
    float4 v[4];
    float ss = 0.f;
#pragma unroll
    for (int i = 0; i < 4; ++i) {
      v[i] = xr[lane + 64 * i];
      ss += v[i].x * v[i].x + v[i].y * v[i].y + v[i].z * v[i].z + v[i].w * v[i].w;
    }
#pragma unroll
    for (int o = 32; o >= 1; o >>= 1) ss += __shfl_xor(ss, o);
    const float rstd = rsqrtf(ss * (1.f / DM) + 1e-6f);
#pragma unroll
    for (int i = 0; i < 4; ++i) {
      const float4 gg = ((const float4*)p.fin_g)[lane + 64 * i];
      xr[lane + 64 * i] = (float4){v[i].x * rstd * gg.x, v[i].y * rstd * gg.y, v[i].z * rstd * gg.z, v[i].w * rstd * gg.w};
    }
  }
}

__global__ void __launch_bounds__(256, 1) mega(Params p) {
  extern __shared__ __attribute__((aligned(16))) unsigned char lds_raw[];
  u16* lds = (u16*)lds_raw;
  cg::grid_group grid = cg::this_grid();
#define PH_ON(k) (p.ph_lo <= (k) && (k) <= p.ph_hi)
#define PH_SYNC(k) if (p.coop && p.ph_lo <= (k) && (k) < p.ph_hi) grid.sync();
  if (PH_ON(0)) {
    rms_rows(p.x, p.e_ng, (u16*)(p.ws + WS_HBF));
    conv_t((u16*)(p.ws + WS_WT0), p.e_win, 1024, 4104, 4224, 0);
    conv_t((u16*)(p.ws + WS_WT1), p.o_win, 1024, 3632, 3712, 1);
    conv_t((u16*)(p.ws + WS_WO0), p.e_wout, 1024, 1024, 1024, 2);
    conv_t((u16*)(p.ws + WS_WO1), p.o_wout, 1024, 1024, 1024, 2);
    conv_t((u16*)(p.ws + WS_W1K), p.o_wk1, 2048, 256, 256, 2);
    conv_t((u16*)(p.ws + WS_W1V), p.o_wv1, 2048, 256, 256, 2);
    conv_t((u16*)(p.ws + WS_W2K), p.o_wk2, 256, 64, 128, 2);
    conv_t((u16*)(p.ws + WS_W2V), p.o_wv2, 256, 64, 128, 2);
    pe_partial(p);
    if (BIDX == 0 && TIDX < 8) ((uint32_t*)(p.ws + WS_KMAX))[TIDX] = 0u;
  }
  PH_SYNC(0)
  if (PH_ON(1)) gemm_inproj(p, 0, lds);
  PH_SYNC(1)
  if (PH_ON(2)) { fox_scan(p, (float*)lds); ret_stepA(p); fox_knorm(p); }
  PH_SYNC(2)
  if (PH_ON(3)) { ret_stepB(p); fox_phase(p, lds); }
  PH_SYNC(3)
  if (PH_ON(4)) ret_stepC(p, lds);
  PH_SYNC(4)
  if (PH_ON(5)) gemm_outproj(p, 0, lds);
  PH_SYNC(5)
  if (PH_ON(6)) {
    rms_rows(p.out, p.o_ng, (u16*)(p.ws + WS_HBF));
    if (BIDX == 0) {
      for (int i = TIDX; i < 512; i += 256) {
        const float* part = (const float*)(p.ws + WS_PEP);
        float s = 0.f;
        for (int kc = 0; kc < 16; ++kc) s += part[((i >> 8) * 16 + kc) * 256 + (i & 255)];
        ((float*)(p.ws + WS_PEB))[i] = s;
      }
    }
  }
  PH_SYNC(6)
  if (PH_ON(7)) gemm_inproj(p, 1, lds);
  PH_SYNC(7)
  if (PH_ON(8)) gemm_cmp1(p, lds);
  PH_SYNC(8)
  if (PH_ON(9)) gemm_cmp2(p, lds);
  PH_SYNC(9)
  if (PH_ON(10)) nsa_phase(p, lds);
  PH_SYNC(10)
  if (PH_ON(11)) gemm_outproj(p, 1, lds);
  PH_SYNC(11)
  if (PH_ON(12)) final_norm(p);
}

extern "C" void kernel_launch(void* const* d_in, const int* in_sizes, int n_in, void* d_out, int out_size, void* d_ws,
                              size_t ws_size, hipStream_t stream) {
  static int grid_blocks = 0;
  if (!grid_blocks) {
    int dev = 0, cus = 0, per_cu = 0;
    hipGetDevice(&dev);
    hipDeviceGetAttribute(&cus, hipDeviceAttributeMultiprocessorCount, dev);
    hipFuncSetAttribute((const void*)mega, hipFuncAttributeMaxDynamicSharedMemorySize, LDS_BYTES);
    hipOccupancyMaxActiveBlocksPerMultiprocessor(&per_cu, (const void*)mega, 256, LDS_BYTES);
    if (per_cu < 1) per_cu = 1;
    if (per_cu > 2) per_cu = 2;
    grid_blocks = cus * per_cu;
    (void)hipGetLastError();
  }
  Params p{};
  p.x = (const float*)d_in[0]; p.e_ng = (const float*)d_in[1]; p.e_win = (const float*)d_in[2];
  p.e_bf = (const float*)d_in[3]; p.e_gn = (const float*)d_in[4]; p.e_wout = (const float*)d_in[5];
  p.o_ng = (const float*)d_in[6]; p.o_win = (const float*)d_in[7]; p.o_bg = (const float*)d_in[8];
  p.o_pek = (const float*)d_in[9]; p.o_pev = (const float*)d_in[10]; p.o_wk1 = (const float*)d_in[11];
  p.o_wk2 = (const float*)d_in[12]; p.o_wv1 = (const float*)d_in[13]; p.o_wv2 = (const float*)d_in[14];
  p.o_wout = (const float*)d_in[15]; p.fin_g = (const float*)d_in[16];
  p.out = (float*)d_out; p.ws = (unsigned char*)d_ws;
#if ONE_LAUNCH
  p.ph_lo = 0; p.ph_hi = NPHASE - 1; p.coop = 1;
  void* args[] = {&p};
  hipError_t e = hipLaunchCooperativeKernel((const void*)mega, dim3(grid_blocks), dim3(256), args, LDS_BYTES, stream);
  if (e != hipSuccess) fprintf(stderr, "cooperative launch failed: %s (grid %d)\n", hipGetErrorString(e), grid_blocks);
#else
  for (int ph = 0; ph < NPHASE; ++ph) {
    p.ph_lo = ph; p.ph_hi = ph; p.coop = 0;
    hipLaunchKernelGGL(mega, dim3(grid_blocks), dim3(256), LDS_BYTES, stream, p);
  }
#endif
}
```

```cpp
#include <hip/hip_runtime.h>
#include <hip/hip_cooperative_groups.h>
#include <stdint.h>
#include <stdio.h>
namespace cg = cooperative_groups;

typedef unsigned short u16;
typedef short bf16x8 __attribute__((ext_vector_type(8)));
typedef short bf16x4 __attribute__((ext_vector_type(4)));
typedef float f32x4 __attribute__((ext_vector_type(4)));

#ifndef ONE_LAUNCH
#define ONE_LAUNCH 1
#endif

#define MTOK 32768
#define SEQ 8192
#define DM 1024
#define LDQ 3072
#define LOG2E 1.4426950408889634f
#define TS 72
#define IMPS 132
#define LDS_BYTES 110592
#define NPHASE 13

#define MiB (1024ull * 1024ull)
#define WS_HBF   (0ull)
#define WS_DS    (0ull)
#define WS_ST    (32ull * MiB)
#define WS_QK    (64ull * MiB)
#define WS_VT    (256ull * MiB)
#define WS_Y     (352ull * MiB)
#define WS_WT0   (416ull * MiB)
#define WS_WT1   (WS_WT0 + 4224ull * 1024 * 2)
#define WS_WO0   (WS_WT1 + 3712ull * 1024 * 2)
#define WS_WO1   (WS_WO0 + 1024ull * 1024 * 2)
#define WS_W1K   (WS_WO1 + 1024ull * 1024 * 2)
#define WS_W1V   (WS_W1K + 256ull * 2048 * 2)
#define WS_W2K   (WS_W1V + 256ull * 2048 * 2)
#define WS_W2V   (WS_W2K + 128ull * 256 * 2)
#define WS_FLOG  (440ull * MiB)
#define WS_CFOX  (441ull * MiB)
#define WS_GL    (442ull * MiB)
#define WS_HC    (448ull * MiB)
#define WS_KCMP  (456ull * MiB)
#define WS_VCMPT (457ull * MiB)
#define WS_PEP   (458ull * MiB)
#define WS_PEB   (WS_PEP + 65536ull)
#define WS_KMAX  (WS_PEB + 4096ull)
#define WS_BAR   (WS_KMAX + 4096ull)

struct Params {
  const float *x, *e_ng, *e_win, *e_bf, *e_gn, *e_wout;
  const float *o_ng, *o_win, *o_bg, *o_pek, *o_pev, *o_wk1, *o_wk2, *o_wv1, *o_wv2, *o_wout, *fin_g;
  float* out;
  unsigned char* ws;
  int ph_lo, ph_hi, coop, pad;
};

typedef __bf16 bf16v2 __attribute__((ext_vector_type(2)));
typedef float f32v2 __attribute__((ext_vector_type(2)));
__device__ __forceinline__ uint32_t pack2(float a, float b) {
  f32v2 v = {a, b};
  bf16v2 r = __builtin_convertvector(v, bf16v2);
  return *(uint32_t*)&r;
}
__device__ __forceinline__ u16 f2bf(float f) { return (u16)(pack2(f, 0.f) & 0xffffu); }
__device__ __forceinline__ float bf2f(u16 h) { return __uint_as_float(((uint32_t)h) << 16); }
__device__ __forceinline__ float ex2(float x) { return __builtin_amdgcn_exp2f(x); }
__device__ __forceinline__ float silu_f(float z) { return z * __builtin_amdgcn_rcpf(1.f + ex2(-z * LOG2E)); }
__device__ __forceinline__ float sigmoid_f(float z) { return __builtin_amdgcn_rcpf(1.f + ex2(-z * LOG2E)); }

__device__ __forceinline__ int opq(int v) { asm volatile("" : "+v"(v)); return v; }
__device__ __forceinline__ int opqs(int v) { asm volatile("" : "+s"(v)); return v; }
#define TIDX opq(p.pad * 64 + (int)__lane_id())
#define BIDX opqs((int)blockIdx.x)
#define MFMA(a, b, c) __builtin_amdgcn_mfma_f32_16x16x32_bf16((a), (b), (c), 0, 0, 0)

__device__ __forceinline__ void rms_rows(const Params& p, const float* __restrict__ x, const float* __restrict__ g, u16* __restrict__ h) {
  const int lane = TIDX & 63, wave = TIDX >> 6;
  for (int row = BIDX * 4 + wave; row < MTOK; row += gridDim.x * 4) {
    const float4* xr = (const float4*)(x + (size_t)row * DM);
    float4 v[4];
    float ss = 0.f;
#pragma unroll
    for (int i = 0; i < 4; ++i) {
      v[i] = xr[lane + 64 * i];
      ss += v[i].x * v[i].x + v[i].y * v[i].y + v[i].z * v[i].z + v[i].w * v[i].w;
    }
#pragma unroll
    for (int o = 32; o >= 1; o >>= 1) ss += __shfl_xor(ss, o);
    const float rstd = rsqrtf(ss * (1.f / DM) + 1e-6f);
#pragma unroll
    for (int i = 0; i < 4; ++i) {
      float4 gg = ((const float4*)g)[lane + 64 * i];
      uint2 o;
      o.x = pack2(v[i].x * rstd * gg.x, v[i].y * rstd * gg.y);
      o.y = pack2(v[i].z * rstd * gg.z, v[i].w * rstd * gg.w);
      *(uint2*)(h + (size_t)row * DM + (lane + 64 * i) * 4) = o;
    }
  }
}

__device__ __forceinline__ int map_col(int MAP, int n) {
  if (MAP == 0) {
    if (n < 1024) return n;
    if (n < 2048) return n + 520;
    if (n < 3072) return n + 1032;
    if (n < 3584) return n - 2048;
    if (n < 4096) return n - 1016;
    if (n < 4104) return n - 2560;
    return -1;
  } else if (MAP == 1) {
    if (n < 1792) return n;
    if (n < 2048) return n + 256;
    if (n < 3072) return n + 560;
    if (n < 3328) return n - 1280;
    if (n < 3584) return n - 1024;
    if (n < 3632) return n - 1024;
    return -1;
  } else if (MAP == 2) {
    return n;
  }
  return n;
}

__device__ __forceinline__ void conv_t(const Params& p, u16* __restrict__ dst, const float* __restrict__ src, int K, int nsrc, int ndst, int MAP) {
  const int total = ndst * (K >> 3);
  for (int id = BIDX * 256 + TIDX; id < total; id += gridDim.x * 256) {
    const int n = id % ndst, kc = id / ndst;
    const int sc = map_col(MAP, n);
    float v[8];
#pragma unroll
    for (int i = 0; i < 8; ++i) v[i] = (sc >= 0 && sc < nsrc) ? src[(size_t)(kc * 8 + i) * nsrc + sc] : 0.f;
    uint4 o;
    o.x = pack2(v[0], v[1]); o.y = pack2(v[2], v[3]); o.z = pack2(v[4], v[5]); o.w = pack2(v[6], v[7]);
    *(uint4*)(dst + (size_t)n * K + kc * 8) = o;
  }
}

__device__ __forceinline__ void pe_partial(const Params& p) {
  float* part = (float*)(p.ws + WS_PEP);
  for (int task = BIDX; task < 32; task += gridDim.x) {
    const int kv = task >> 4, kc = task & 15, n = TIDX;
    const float* pe = kv ? p.o_pev : p.o_pek;
    const float* w1 = kv ? p.o_wv1 : p.o_wk1;
    float acc = 0.f;
#pragma unroll 16
    for (int k = kc * 128; k < kc * 128 + 128; ++k) acc += pe[k] * w1[(size_t)k * 256 + n];
    part[(kv * 16 + kc) * 256 + n] = acc;
  }
}

#define GST (384 * TS)
__device__ __forceinline__ void gemm_compute(const u16* cur, f32x4 (&acc)[8][4], bool swapped, int wpa, int wpb, int l16, int gk) {
  const u16* sA = cur + (wpa * 128 + l16) * TS + gk * 8;
  const u16* sB = cur + (256 + wpb * 64 + l16) * TS + gk * 8;
#pragma unroll
  for (int kk = 0; kk < 2; ++kk) {
    bf16x8 fa[8], fb[4];
#pragma unroll
    for (int i = 0; i < 8; ++i) fa[i] = *(const bf16x8*)(sA + i * 16 * TS + kk * 32);
#pragma unroll
    for (int j = 0; j < 4; ++j) fb[j] = *(const bf16x8*)(sB + j * 16 * TS + kk * 32);
    if (swapped) {
#pragma unroll
      for (int i = 0; i < 8; ++i)
#pragma unroll
        for (int j = 0; j < 4; ++j) acc[i][j] = MFMA(fb[j], fa[i], acc[i][j]);
    } else {
#pragma unroll
      for (int i = 0; i < 8; ++i)
#pragma unroll
        for (int j = 0; j < 4; ++j) acc[i][j] = MFMA(fa[i], fb[j], acc[i][j]);
    }
  }
}
__device__ __forceinline__ void gemm_mainloop(const Params& p, const u16* __restrict__ Ab, const uint32_t (&pa)[8], const u16* __restrict__ Bb,
                                              const uint32_t (&pb)[4], int a_kstride, int nk,
                                              u16* lds, f32x4 (&acc)[8][4], bool swapped) {
  const int tid = TIDX, lane = tid & 63, wave = tid >> 6;
  const int l16 = lane & 15, gk = lane >> 4;
  const int wpa = wave >> 1, wpb = wave & 1;
  const int woff = (tid >> 3) * TS + (tid & 7) * 8;
  uint4 rap0, rap1, rap2, rap3, rap4, rap5, rap6, rap7, rbp0, rbp1, rbp2, rbp3;
  uint4 raq0, raq1, raq2, raq3, raq4, raq5, raq6, raq7, rbq0, rbq1, rbq2, rbq3;
#define G_LDA(S, i, Ap) ra##S##i = *(const uint4*)((Ap) + pa[i]);
#define G_LDB(S, i, Bp) rb##S##i = *(const uint4*)((Bp) + pb[i]);
#define G_LD(S, kidx) { const u16* Ap_ = Ab + (size_t)(kidx) * a_kstride; const u16* Bp_ = Bb + (size_t)(kidx) * 64;                      \
    G_LDA(S, 0, Ap_) G_LDA(S, 1, Ap_) G_LDA(S, 2, Ap_) G_LDA(S, 3, Ap_) G_LDA(S, 4, Ap_) G_LDA(S, 5, Ap_) G_LDA(S, 6, Ap_) G_LDA(S, 7, Ap_) \
    G_LDB(S, 0, Bp_) G_LDB(S, 1, Bp_) G_LDB(S, 2, Bp_) G_LDB(S, 3, Bp_) }
#define G_STA(S, i, D) *(uint4*)((D) + woff + (i) * 32 * TS) = ra##S##i;
#define G_STB(S, i, D) *(uint4*)((D) + 256 * TS + woff + (i) * 32 * TS) = rb##S##i;
#define G_ST(S, D) { u16* D_ = (D);                                                                                                   \
    G_STA(S, 0, D_) G_STA(S, 1, D_) G_STA(S, 2, D_) G_STA(S, 3, D_) G_STA(S, 4, D_) G_STA(S, 5, D_) G_STA(S, 6, D_) G_STA(S, 7, D_)   \
    G_STB(S, 0, D_) G_STB(S, 1, D_) G_STB(S, 2, D_) G_STB(S, 3, D_) }
  G_LD(p, 0)
  G_LD(q, 1)
  __syncthreads();
  G_ST(p, lds)
  __syncthreads();
#pragma unroll
  for (int i = 0; i < 8; ++i)
#pragma unroll
    for (int j = 0; j < 4; ++j) acc[i][j] = (f32x4){0.f, 0.f, 0.f, 0.f};
#pragma unroll 1
  for (int ks = 0; ks < nk; ks += 2) {
    if (ks + 2 < nk) G_LD(p, ks + 2)
    gemm_compute(lds, acc, swapped, wpa, wpb, l16, gk);
    G_ST(q, lds + GST)
    __syncthreads();
    if (ks + 3 < nk) G_LD(q, ks + 3)
    gemm_compute(lds + GST, acc, swapped, wpa, wpb, l16, gk);
    if (ks + 2 < nk) G_ST(p, lds)
    __syncthreads();
  }
#undef G_LD
#undef G_LDA
#undef G_LDB
#undef G_ST
#undef G_STA
#undef G_STB
}
#define GEMM_OFFS(rowstrideA, rowstrideB)                                   \
  uint32_t pa[8], pb[4];                                                    \
  _Pragma("unroll") for (int i = 0; i < 8; ++i)                             \
    pa[i] = (uint32_t)((tid >> 3) + 32 * i) * (rowstrideA) + (tid & 7) * 8; \
  _Pragma("unroll") for (int i = 0; i < 4; ++i)                             \
    pb[i] = (uint32_t)((tid >> 3) + 32 * i) * (rowstrideB) + (tid & 7) * 8;

__device__ __forceinline__ void gemm_inproj(const Params& p, int layer, u16* lds) {
  const u16* A = (const u16*)(p.ws + WS_HBF);
  const u16* Bt = (const u16*)(p.ws + (layer ? WS_WT1 : WS_WT0));
  u16* QK = (u16*)(p.ws + WS_QK);
  u16* VT = (u16*)(p.ws + WS_VT);
  float* F = (float*)(p.ws + (layer ? WS_GL : WS_FLOG));
  const int NT = layer ? 29 : 33;
  const int ntrans_end = layer ? 28 : 32;
  const int nvalidF = layer ? 48 : 8, ldf = layer ? 48 : 8;
  const int tid = TIDX, lane = tid & 63, wave = tid >> 6, l16 = lane & 15, gk = lane >> 4;
  const int wpa = wave >> 1, wpb = wave & 1;
  for (int tile = BIDX; tile < 128 * NT; tile += gridDim.x) {
    const int mt = tile / NT, nt = tile % NT;
    const int m0 = mt * 256, n0 = nt * 128;
    int mode;
    if (nt < 24) mode = (layer == 0 && nt >= 12 && nt < 16) ? 2 : 0;
    else if (nt < ntrans_end) mode = 1;
    else mode = 3;
    const bool swapped = (mode == 0 || mode == 3);
    GEMM_OFFS(DM, DM)
    f32x4 acc[8][4];
    gemm_mainloop(p, A + (size_t)m0 * DM, pa, Bt + (size_t)n0 * DM, pb, 64, 16, lds, acc, swapped);
    const int mw = m0 + wpa * 128, nw = n0 + wpb * 64;
    if (swapped) {
#pragma unroll
      for (int i = 0; i < 8; ++i)
#pragma unroll
        for (int j = 0; j < 4; ++j) {
          const int n = nw + j * 16 + gk * 4;
          const int m = mw + i * 16 + l16;
          if (mode == 0) {
            uint2 o; o.x = pack2(acc[i][j][0], acc[i][j][1]); o.y = pack2(acc[i][j][2], acc[i][j][3]);
            *(uint2*)(QK + (size_t)m * LDQ + n) = o;
          } else {
            const int nn = n - n0;
            if (nn < nvalidF) *(float4*)(F + (size_t)m * ldf + nn) = (float4){acc[i][j][0], acc[i][j][1], acc[i][j][2], acc[i][j][3]};
          }
        }
    } else {
#pragma unroll
      for (int i = 0; i < 8; ++i)
#pragma unroll
        for (int j = 0; j < 4; ++j) {
          const int m = mw + i * 16 + gk * 4;
          const int n = nw + j * 16 + l16;
          if (mode == 1) {
            const int trow = n - 3072;
            uint2 o; o.x = pack2(acc[i][j][0], acc[i][j][1]); o.y = pack2(acc[i][j][2], acc[i][j][3]);
            *(uint2*)(VT + (size_t)trow * MTOK + m) = o;
          } else {
            const int trow = n - 512;
            const int h = (nw - 1536) >> 6;
            const float lg2 = log1pf(-exp2f(-5.f - (float)h)) * LOG2E;
            const float lane_dec = 0.125f * ex2(lg2 * (float)(127 - gk * 4));
            float sv[4];
#pragma unroll
            for (int r = 0; r < 4; ++r) {
              QK[(size_t)(m + r) * LDQ + n] = f2bf(acc[i][j][r]);
              sv[r] = acc[i][j][r] * lane_dec * ex2(lg2 * (float)(-(i * 16 + r)));
            }
            uint2 o; o.x = pack2(sv[0], sv[1]); o.y = pack2(sv[2], sv[3]);
            *(uint2*)(VT + (size_t)trow * MTOK + m) = o;
          }
        }
    }
  }
}

__device__ __forceinline__ void gemm_outproj(const Params& p, int layer, u16* lds) {
  const u16* A = (const u16*)(p.ws + WS_Y);
  const u16* Bt = (const u16*)(p.ws + (layer ? WS_WO1 : WS_WO0));
  const float* res = layer ? p.out : p.x;
  float* out = p.out;
  const int tid = TIDX, lane = tid & 63, wave = tid >> 6, l16 = lane & 15, gk = lane >> 4;
  const int wpa = wave >> 1, wpb = wave & 1;
  for (int tile = BIDX; tile < 128 * 8; tile += gridDim.x) {
    const int mt = tile >> 3, nt = tile & 7;
    const int m0 = mt * 256, n0 = nt * 128;
    GEMM_OFFS(DM, DM)
    f32x4 acc[8][4];
    gemm_mainloop(p, A + (size_t)m0 * DM, pa, Bt + (size_t)n0 * DM, pb, 64, 16, lds, acc, true);
    const int mw = m0 + wpa * 128, nw = n0 + wpb * 64;
#pragma unroll
    for (int i = 0; i < 8; ++i)
#pragma unroll
      for (int j = 0; j < 4; ++j) {
        const int n = nw + j * 16 + gk * 4;
        const int m = mw + i * 16 + l16;
        const float4 r = *(const float4*)(res + (size_t)m * DM + n);
        *(float4*)(out + (size_t)m * DM + n) = (float4){r.x + acc[i][j][0], r.y + acc[i][j][1], r.z + acc[i][j][2], r.w + acc[i][j][3]};
      }
  }
}

__device__ __forceinline__ void gemm_cmp1(const Params& p, u16* lds) {
  const u16* U = (const u16*)(p.ws + WS_QK);
  const float* peb = (const float*)(p.ws + WS_PEB);
  const int tid = TIDX, lane = tid & 63, wave = tid >> 6, l16 = lane & 15, gk = lane >> 4;
  const int wpa = wave >> 1, wpb = wave & 1;
  for (int tile = BIDX; tile < 128; tile += gridDim.x) {
    const int kv = tile >> 6, mt = (tile >> 1) & 31, nt = tile & 1;
    const int m0 = mt * 256, n0 = nt * 128;
    const u16* Bt = (const u16*)(p.ws + (kv ? WS_W1V : WS_W1K));
    u16* Hc = (u16*)(p.ws + WS_HC) + (size_t)kv * 8192 * 256;
    uint32_t pa[8], pb[4];
#pragma unroll
    for (int i = 0; i < 8; ++i) {
      const int row = (tid >> 3) + 32 * i, kc = tid & 7;
      const int r = m0 + row, bg = r >> 9, cc = r & 511, b = bg >> 2, g = bg & 3;
      int tok0 = cc * 16; if (tok0 > SEQ - 32) tok0 = SEQ - 32;
      pa[i] = (uint32_t)(b * SEQ + tok0) * LDQ + 1024 + kv * 256 + g * 64 + kc * 8;
    }
#pragma unroll
    for (int i = 0; i < 4; ++i) pb[i] = (uint32_t)((tid >> 3) + 32 * i) * 2048 + (tid & 7) * 8;
    f32x4 acc[8][4];
    gemm_mainloop(p, U, pa, Bt + (size_t)n0 * 2048, pb, LDQ, 32, lds, acc, true);
    const int mw = m0 + wpa * 128, nw = n0 + wpb * 64;
#pragma unroll
    for (int i = 0; i < 8; ++i)
#pragma unroll
      for (int j = 0; j < 4; ++j) {
        const int n = nw + j * 16 + gk * 4;
        const int m = mw + i * 16 + l16;
        const float4 bb = *(const float4*)(peb + kv * 256 + n);
        float v0 = silu_f(acc[i][j][0] + bb.x), v1 = silu_f(acc[i][j][1] + bb.y);
        float v2 = silu_f(acc[i][j][2] + bb.z), v3 = silu_f(acc[i][j][3] + bb.w);
        if ((m & 511) == 511) { v0 = v1 = v2 = v3 = 0.f; }
        uint2 o; o.x = pack2(v0, v1); o.y = pack2(v2, v3);
        *(uint2*)(Hc + (size_t)m * 256 + n) = o;
      }
  }
}

__device__ __forceinline__ void gemm_cmp2(const Params& p, u16* lds) {
  const int tid = TIDX, lane = tid & 63, wave = tid >> 6, l16 = lane & 15, gk = lane >> 4;
  const int wpa = wave >> 1, wpb = wave & 1;
  for (int tile = BIDX; tile < 64; tile += gridDim.x) {
    const int kv = tile >> 5, mt = tile & 31;
    const int m0 = mt * 256;
    const u16* A = (const u16*)(p.ws + WS_HC) + (size_t)kv * 8192 * 256;
    const u16* Bt = (const u16*)(p.ws + (kv ? WS_W2V : WS_W2K));
    GEMM_OFFS(256, 256)
    f32x4 acc[8][4];
    const bool swapped = (kv == 0);
    gemm_mainloop(p, A + (size_t)m0 * 256, pa, Bt, pb, 64, 4, lds, acc, swapped);
    const int mw = m0 + wpa * 128, nw = wpb * 64;
    if (swapped) {
      u16* kc_ = (u16*)(p.ws + WS_KCMP);
#pragma unroll
      for (int i = 0; i < 8; ++i)
#pragma unroll
        for (int j = 0; j < 4; ++j) {
          const int n = nw + j * 16 + gk * 4;
          const int m = mw + i * 16 + l16;
          if (n < 64) {
            uint2 o; o.x = pack2(acc[i][j][0], acc[i][j][1]); o.y = pack2(acc[i][j][2], acc[i][j][3]);
            *(uint2*)(kc_ + (size_t)m * 64 + n) = o;
          }
        }
    } else {
      u16* vt = (u16*)(p.ws + WS_VCMPT);
#pragma unroll
      for (int i = 0; i < 8; ++i)
#pragma unroll
        for (int j = 0; j < 4; ++j) {
          const int m = mw + i * 16 + gk * 4;
          const int n = nw + j * 16 + l16;
          if (n < 64) {
            uint2 o; o.x = pack2(acc[i][j][0], acc[i][j][1]); o.y = pack2(acc[i][j][2], acc[i][j][3]);
            *(uint2*)(vt + (size_t)(m >> 9) * 32768 + (size_t)n * 512 + (m & 511)) = o;
          }
        }
    }
  }
}

#define TILE_LD(R, src, stride) { const u16* s_ = (src); R##0 = *(const uint4*)(s_ + (long)(tid >> 3) * (stride) + (tid & 7) * 8); \
                                  R##1 = *(const uint4*)(s_ + (long)((tid >> 3) + 32) * (stride) + (tid & 7) * 8); }
#define TILE_ST(dst, R) { u16* d_ = (dst); *(uint4*)(d_ + (tid >> 3) * TS + (tid & 7) * 8) = R##0; \
                          *(uint4*)(d_ + ((tid >> 3) + 32) * TS + (tid & 7) * 8) = R##1; }
__device__ __forceinline__ void qk_tile(const u16* sK, const bf16x8 (&q)[2], f32x4 (&s)[4], int l16, int gk) {
#pragma unroll
  for (int kt = 0; kt < 4; ++kt) s[kt] = (f32x4){0.f, 0.f, 0.f, 0.f};
#pragma unroll
  for (int ks = 0; ks < 2; ++ks)
#pragma unroll
    for (int kt = 0; kt < 4; ++kt) {
      bf16x8 kf = *(const bf16x8*)(sK + (kt * 16 + l16) * TS + ks * 32 + gk * 8);
      s[kt] = MFMA(kf, q[ks], s[kt]);
    }
}
__device__ __forceinline__ void pv_tile(const u16* sV, const float (&pp)[4][4], f32x4 (&o)[4], int l16, int gk) {
  bf16x8 pf[2];
#pragma unroll
  for (int ks2 = 0; ks2 < 2; ++ks2) {
    uint4 t;
    t.x = pack2(pp[2 * ks2][0], pp[2 * ks2][1]); t.y = pack2(pp[2 * ks2][2], pp[2 * ks2][3]);
    t.z = pack2(pp[2 * ks2 + 1][0], pp[2 * ks2 + 1][1]); t.w = pack2(pp[2 * ks2 + 1][2], pp[2 * ks2 + 1][3]);
    pf[ks2] = *(bf16x8*)&t;
  }
#pragma unroll
  for (int dt = 0; dt < 4; ++dt)
#pragma unroll
    for (int ks2 = 0; ks2 < 2; ++ks2) {
      uint2 a0 = *(const uint2*)(sV + (dt * 16 + l16) * TS + (2 * ks2) * 16 + gk * 4);
      uint2 a1 = *(const uint2*)(sV + (dt * 16 + l16) * TS + (2 * ks2 + 1) * 16 + gk * 4);
      uint4 t; t.x = a0.x; t.y = a0.y; t.z = a1.x; t.w = a1.y;
      o[dt] = MFMA(*(bf16x8*)&t, pf[ks2], o[dt]);
    }
}

__device__ __forceinline__ void fox_phase(const Params& p, u16* lds) {
  const u16* QK = (const u16*)(p.ws + WS_QK);
  const u16* VT = (const u16*)(p.ws + WS_VT);
  const float* cf = (const float*)(p.ws + WS_CFOX);
  u16* Y = (u16*)(p.ws + WS_Y);
  const int tid = TIDX, lane = tid & 63, w = tid >> 6, l16 = lane & 15, gk = lane >> 4;
  const float scale2 = 0.125f * LOG2E;
  for (int unit = BIDX; unit < 2048; unit += gridDim.x) {
    const int bh = unit & 31, qblk = 63 - (unit >> 5), b = bh >> 3, h = bh & 7;
    const int tq0 = qblk * 128 + w * 32;
    const float* cfr = cf + (size_t)bh * SEQ;
    bf16x8 q[2][2];
    float cq2[2];
#pragma unroll
    for (int cgi = 0; cgi < 2; ++cgi) {
      const int t = tq0 + cgi * 16 + l16;
#pragma unroll
      for (int ks = 0; ks < 2; ++ks) q[cgi][ks] = *(const bf16x8*)(QK + (size_t)(b * SEQ + t) * LDQ + h * 64 + ks * 32 + gk * 8);
      cq2[cgi] = cfr[t] * LOG2E;
    }
    f32x4 o[2][4];
    float m[2], l[2];
#pragma unroll
    for (int cgi = 0; cgi < 2; ++cgi) {
      m[cgi] = -1e30f; l[cgi] = 0.f;
#pragma unroll
      for (int dt = 0; dt < 4; ++dt) o[cgi][dt] = (f32x4){0.f, 0.f, 0.f, 0.f};
    }
    const int ntiles = qblk * 2 + 2;
    const int iw = qblk * 2 + (w >> 1);
    const u16* ksrc = QK + (size_t)(b * SEQ) * LDQ + 512 + h * 64;
    const u16* vsrc = VT + (size_t)(h * 64) * MTOK + (size_t)b * SEQ;
    float qs = 0.f;
#pragma unroll
    for (int cgi = 0; cgi < 2; ++cgi) {
      float ss = 0.f;
#pragma unroll
      for (int ks = 0; ks < 2; ++ks)
#pragma unroll
        for (int e = 0; e < 8; ++e) { const float v = bf2f((u16)q[cgi][ks][e]); ss += v * v; }
      ss += __shfl_xor(ss, 16); ss += __shfl_xor(ss, 32);
      qs = fmaxf(qs, ss);
    }
#pragma unroll
    for (int o = 1; o <= 8; o <<= 1) qs = fmaxf(qs, __shfl_xor(qs, o));
    float* red = (float*)(lds + 256 * TS);
    if (lane == 0) red[w] = qs;
    __syncthreads();
    const float qmax2 = fmaxf(fmaxf(red[0], red[1]), fmaxf(red[2], red[3]));
    const float kmax2 = __uint_as_float(((const uint32_t*)(p.ws + WS_KMAX))[h]);
    const float T2 = 2.f * scale2 * sqrtf(qmax2 * kmax2) * 1.001f + 48.f;
    const float cfirst2 = cfr[qblk * 128] * LOG2E;
    int i_lo = 0;
    for (int base = qblk * 2 - 1; base >= 0; base -= 64) {
      const int ti = base - lane;
      bool skip = false;
      if (ti >= 0) skip = (cfirst2 - cfr[ti * 64 + 63] * LOG2E) < -T2;
      const unsigned long long bal = __ballot(skip);
      if (bal) { i_lo = base - (int)__builtin_ctzll(bal) + 1; break; }
    }
    uint4 rk0, rk1, rv0, rv1;
    TILE_LD(rk, ksrc + (size_t)i_lo * 64 * LDQ, LDQ); TILE_LD(rv, vsrc + i_lo * 64, MTOK);
    TILE_ST(lds + (i_lo & 1) * (128 * TS), rk); TILE_ST(lds + (i_lo & 1) * (128 * TS) + 64 * TS, rv);
    __syncthreads();
    for (int i = i_lo; i < ntiles; ++i) {
      u16* cur = lds + (i & 1) * (128 * TS);
      const bool more = (i + 1 < ntiles);
      if (more) { TILE_LD(rk, ksrc + (size_t)(i + 1) * 64 * LDQ, LDQ); TILE_LD(rv, vsrc + (i + 1) * 64, MTOK); }
      if (i <= iw) {
        const int s0 = i * 64;
        const bool diag = (i == iw);
        float ck2[4][4];
#pragma unroll
        for (int kt = 0; kt < 4; ++kt) {
          float4 c4 = *(const float4*)(cfr + s0 + kt * 16 + gk * 4);
          ck2[kt][0] = c4.x * LOG2E; ck2[kt][1] = c4.y * LOG2E; ck2[kt][2] = c4.z * LOG2E; ck2[kt][3] = c4.w * LOG2E;
        }
#pragma unroll
        for (int cgi = 0; cgi < 2; ++cgi) {
          f32x4 s[4];
          qk_tile(cur, q[cgi], s, l16, gk);
          const int t = tq0 + cgi * 16 + l16;
          float xv[4][4];
          float mx = -1e30f;
#pragma unroll
          for (int kt = 0; kt < 4; ++kt)
#pragma unroll
            for (int r = 0; r < 4; ++r) {
              float v = fmaf(s[kt][r], scale2, cq2[cgi] - ck2[kt][r]);
              if (diag && (s0 + kt * 16 + gk * 4 + r > t)) v = -1e30f;
              xv[kt][r] = v; mx = fmaxf(mx, v);
            }
          mx = fmaxf(mx, __shfl_xor(mx, 16)); mx = fmaxf(mx, __shfl_xor(mx, 32));
          const float mnew = fmaxf(m[cgi], mx);
          const float alpha = ex2(m[cgi] - mnew);
          m[cgi] = mnew;
          const float muse = fmaxf(mnew, -1e20f);
          float rs = 0.f;
#pragma unroll
          for (int kt = 0; kt < 4; ++kt)
#pragma unroll
            for (int r = 0; r < 4; ++r) { xv[kt][r] = ex2(xv[kt][r] - muse); rs += xv[kt][r]; }
          l[cgi] = l[cgi] * alpha + rs;
#pragma unroll
          for (int dt = 0; dt < 4; ++dt) o[cgi][dt] *= alpha;
          pv_tile(cur + 64 * TS, xv, o[cgi], l16, gk);
        }
      }
      if (more) { u16* nxt = lds + ((i + 1) & 1) * (128 * TS); TILE_ST(nxt, rk); TILE_ST(nxt + 64 * TS, rv); }
      __syncthreads();
    }
#pragma unroll
    for (int cgi = 0; cgi < 2; ++cgi) {
      float lt = l[cgi]; lt += __shfl_xor(lt, 16); lt += __shfl_xor(lt, 32);
      const float inv = lt > 0.f ? 1.f / lt : 0.f;
      const size_t mrow = (size_t)(b * SEQ + tq0 + cgi * 16 + l16);
#pragma unroll
      for (int dt = 0; dt < 4; ++dt) {
        const int col = h * 64 + dt * 16 + gk * 4;
        const uint2 zz = *(const uint2*)(QK + mrow * LDQ + 2048 + col);
        const float z0 = bf2f(zz.x & 0xffff), z1 = bf2f(zz.x >> 16), z2 = bf2f(zz.y & 0xffff), z3 = bf2f(zz.y >> 16);
        uint2 ov;
        ov.x = pack2(o[cgi][dt][0] * inv * silu_f(z0), o[cgi][dt][1] * inv * silu_f(z1));
        ov.y = pack2(o[cgi][dt][2] * inv * silu_f(z2), o[cgi][dt][3] * inv * silu_f(z3));
        *(uint2*)(Y + mrow * DM + col) = ov;
      }
    }
  }
}

__device__ __forceinline__ void fox_knorm(const Params& p) {
  const u16* QK = (const u16*)(p.ws + WS_QK);
  uint32_t* km = (uint32_t*)(p.ws + WS_KMAX);
  const int tid = TIDX, lane = tid & 63, wave = tid >> 6;
  float mx = 0.f;
  for (int row = BIDX * 4 + wave; row < MTOK; row += gridDim.x * 4) {
    const uint4 v = *(const uint4*)(QK + (size_t)row * LDQ + 512 + lane * 8);
    const float a0 = bf2f(v.x & 0xffff), a1 = bf2f(v.x >> 16), a2 = bf2f(v.y & 0xffff), a3 = bf2f(v.y >> 16);
    const float a4 = bf2f(v.z & 0xffff), a5 = bf2f(v.z >> 16), a6 = bf2f(v.w & 0xffff), a7 = bf2f(v.w >> 16);
    float ss = a0 * a0 + a1 * a1 + a2 * a2 + a3 * a3 + a4 * a4 + a5 * a5 + a6 * a6 + a7 * a7;
    ss += __shfl_xor(ss, 1); ss += __shfl_xor(ss, 2); ss += __shfl_xor(ss, 4);
    mx = fmaxf(mx, ss);
  }
  if ((lane & 7) == 0) atomicMax(&km[lane >> 3], __float_as_uint(mx));
}

__device__ __forceinline__ void fox_scan(const Params& p, float* ldsf) {
  const float* fl = (const float*)(p.ws + WS_FLOG);
  float* cf = (float*)(p.ws + WS_CFOX);
  double* sd = (double*)ldsf;
  const int tid = TIDX;
  for (int bh = BIDX; bh < 32; bh += gridDim.x) {
    const int b = bh >> 3, h = bh & 7;
    const float bf = p.e_bf[h];
    float ls[32];
    double sum = 0.0;
#pragma unroll
    for (int i = 0; i < 32; ++i) {
      const float xx = fl[(size_t)(b * SEQ + tid * 32 + i) * 8 + h] + bf;
      ls[i] = fminf(xx, 0.f) - log1pf(__expf(-fabsf(xx)));
      sum += (double)ls[i];
    }
    __syncthreads();
    sd[tid] = sum;
    __syncthreads();
    double pre = 0.0;
    for (int j = 0; j < tid; ++j) pre += sd[j];
#pragma unroll
    for (int i = 0; i < 32; ++i) { pre += (double)ls[i]; cf[(size_t)bh * SEQ + tid * 32 + i] = (float)pre; }
  }
}

__device__ __forceinline__ void ret_stepA(const Params& p) {
  const u16* VT = (const u16*)(p.ws + WS_VT);
  float* dS = (float*)(p.ws + WS_DS);
  const int lane = TIDX & 63, w = TIDX >> 6, l16 = lane & 15, gk = lane >> 4;
  for (int u = BIDX; u < 2048; u += gridDim.x) {
    const int bh = u >> 6, n = u & 63, b = bh >> 3, h = bh & 7;
    const size_t mcol = (size_t)b * SEQ + n * 128;
    f32x4 acc[4];
#pragma unroll
    for (int dt = 0; dt < 4; ++dt) acc[dt] = (f32x4){0.f, 0.f, 0.f, 0.f};
#pragma unroll
    for (int ks = 0; ks < 4; ++ks) {
      bf16x8 af = *(const bf16x8*)(VT + (size_t)(512 + h * 64 + w * 16 + l16) * MTOK + mcol + ks * 32 + gk * 8);
#pragma unroll
      for (int dt = 0; dt < 4; ++dt) {
        bf16x8 bfr = *(const bf16x8*)(VT + (size_t)(1024 + h * 64 + dt * 16 + l16) * MTOK + mcol + ks * 32 + gk * 8);
        acc[dt] = MFMA(af, bfr, acc[dt]);
      }
    }
#pragma unroll
    for (int dt = 0; dt < 4; ++dt)
#pragma unroll
      for (int r = 0; r < 4; ++r) dS[(size_t)u * 4096 + (w * 16 + gk * 4 + r) * 64 + dt * 16 + l16] = acc[dt][r];
  }
}
__device__ __forceinline__ void ret_stepB(const Params& p) {
  const float* dS = (const float*)(p.ws + WS_DS);
  u16* st = (u16*)(p.ws + WS_ST);
  for (int idx = BIDX * 256 + TIDX; idx < 32 * 4096; idx += gridDim.x * 256) {
    const int bh = idx >> 12, ed = idx & 4095, h = bh & 7;
    const float cdec = __expf(log1pf(-exp2f(-5.f - (float)h)) * 128.f);
    float s = 0.f;
#pragma unroll 8
    for (int n = 0; n < 64; ++n) {
      const size_t a = (size_t)(bh * 64 + n) * 4096 + ed;
      st[a] = f2bf(s);
      s = s * cdec + dS[a];
    }
  }
}
__device__ __forceinline__ void ret_stepC(const Params& p, u16* lds) {
  const u16* QK = (const u16*)(p.ws + WS_QK);
  const u16* VT = (const u16*)(p.ws + WS_VT);
  const u16* st = (const u16*)(p.ws + WS_ST);
  u16* Y = (u16*)(p.ws + WS_Y);
  const int tid = TIDX, lane = tid & 63, w = tid >> 6, l16 = lane & 15, gk = lane >> 4;
  for (int u = BIDX; u < 2048; u += gridDim.x) {
    const int bh = u >> 6, n = u & 63, b = bh >> 3, h = bh & 7;
    const size_t m0 = (size_t)b * SEQ + n * 128;
    const float lg2 = log1pf(-exp2f(-5.f - (float)h)) * LOG2E;
    __syncthreads();
    {
      uint4 r0, r1;
      TILE_LD(r, QK + m0 * LDQ + 1536 + h * 64, LDQ); TILE_ST(lds, r);
      TILE_LD(r, VT + (size_t)(512 + h * 64) * MTOK + m0, MTOK); TILE_ST(lds + 64 * TS, r);
      TILE_LD(r, QK + (m0 + 64) * LDQ + 1536 + h * 64, LDQ); TILE_ST(lds + 128 * TS, r);
      TILE_LD(r, VT + (size_t)(512 + h * 64) * MTOK + m0 + 64, MTOK); TILE_ST(lds + 192 * TS, r);
      TILE_LD(r, st + (size_t)u * 4096, 64); TILE_ST(lds + 256 * TS, r);
    }
    __syncthreads();
#pragma unroll
    for (int cgi = 0; cgi < 2; ++cgi) {
      const int iq = 32 * w + cgi * 16 + l16;
      const size_t mrow = m0 + iq;
      bf16x8 q[2];
#pragma unroll
      for (int ks = 0; ks < 2; ++ks) q[ks] = *(const bf16x8*)(QK + mrow * LDQ + 1024 + h * 64 + ks * 32 + gk * 8);
      f32x4 o[4];
#pragma unroll
      for (int dt = 0; dt < 4; ++dt) o[dt] = (f32x4){0.f, 0.f, 0.f, 0.f};
#pragma unroll
      for (int dt = 0; dt < 4; ++dt)
#pragma unroll
        for (int ks = 0; ks < 2; ++ks) {
          bf16x8 sf = *(const bf16x8*)(lds + 256 * TS + (dt * 16 + l16) * TS + ks * 32 + gk * 8);
          o[dt] = MFMA(sf, q[ks], o[dt]);
        }
      const float cross = exp2f(lg2 * (float)(iq + 1));
#pragma unroll
      for (int dt = 0; dt < 4; ++dt) o[dt] *= cross;
#pragma unroll
      for (int k64 = 0; k64 < 2; ++k64) {
        if (k64 * 64 <= 32 * w + 31) {
          f32x4 s[4];
          qk_tile(lds + k64 * 128 * TS, q, s, l16, gk);
          float pp[4][4];
#pragma unroll
          for (int kt = 0; kt < 4; ++kt)
#pragma unroll
            for (int r = 0; r < 4; ++r) {
              const int j = k64 * 64 + kt * 16 + gk * 4 + r;
              pp[kt][r] = (j <= iq) ? s[kt][r] * 0.125f * ex2(lg2 * (float)(iq - j)) : 0.f;
            }
          pv_tile(lds + k64 * 128 * TS + 64 * TS, pp, o, l16, gk);
        }
      }
      float sm = 0.f;
#pragma unroll
      for (int dt = 0; dt < 4; ++dt) sm += o[dt][0] + o[dt][1] + o[dt][2] + o[dt][3];
      sm += __shfl_xor(sm, 16); sm += __shfl_xor(sm, 32);
      const float mu = sm * (1.f / 64.f);
      float vs = 0.f;
#pragma unroll
      for (int dt = 0; dt < 4; ++dt)
#pragma unroll
        for (int r = 0; r < 4; ++r) { const float d = o[dt][r] - mu; vs += d * d; }
      vs += __shfl_xor(vs, 16); vs += __shfl_xor(vs, 32);
      const float rstd = rsqrtf(vs * (1.f / 64.f) + 1e-5f);
#pragma unroll
      for (int dt = 0; dt < 4; ++dt) {
        const int col = h * 64 + dt * 16 + gk * 4;
        const float4 gg = *(const float4*)(p.e_gn + col);
        const uint2 zz = *(const uint2*)(QK + mrow * LDQ + 2048 + 512 + col);
        const float z0 = bf2f(zz.x & 0xffff), z1 = bf2f(zz.x >> 16), z2 = bf2f(zz.y & 0xffff), z3 = bf2f(zz.y >> 16);
        uint2 ov;
        ov.x = pack2((o[dt][0] - mu) * rstd * gg.x * silu_f(z0), (o[dt][1] - mu) * rstd * gg.y * silu_f(z1));
        ov.y = pack2((o[dt][2] - mu) * rstd * gg.z * silu_f(z2), (o[dt][3] - mu) * rstd * gg.w * silu_f(z3));
        *(uint2*)(Y + mrow * DM + 512 + col) = ov;
      }
    }
  }
}

template <int BR>
__device__ __forceinline__ void nsa_tile(const u16* sK, const u16* sV, const bf16x8 (&q)[4][2], f32x4 (&acc)[4][4],
                                         float (&m)[4], float (&l)[4], const float (&slope2)[4], const float (&gmul)[4],
                                         int t, int pos0, int pstride, int wl, bool lanesel,
                                         float* imp_row, int jbase, float& carry, int lane) {
  const int l16 = lane & 15, gk = lane >> 4;
  const float scale2 = 0.125f * LOG2E;
  float ps[4][4];
  if (BR == 1) {
#pragma unroll
    for (int kt = 0; kt < 4; ++kt)
#pragma unroll
      for (int r = 0; r < 4; ++r) ps[kt][r] = 0.f;
  }
  float fd[4][4], pen[4][4];
  const unsigned wle = lanesel ? (unsigned)wl : 0u;
#pragma unroll
  for (int kt = 0; kt < 4; ++kt)
#pragma unroll
    for (int r = 0; r < 4; ++r) {
      const int dist = t - (pos0 + (kt * 16 + gk * 4 + r) * pstride);
      fd[kt][r] = (float)dist;
      pen[kt][r] = ((unsigned)dist < wle) ? 0.f : -1e30f;
    }
#pragma unroll
  for (int cgi = 0; cgi < 4; ++cgi) {
    f32x4 s[4];
    qk_tile(sK, q[cgi], s, l16, gk);
    float xv[4][4];
    float mx = -1e30f;
#pragma unroll
    for (int kt = 0; kt < 4; ++kt)
#pragma unroll
      for (int r = 0; r < 4; ++r) {
        const float v = fmaf(s[kt][r], scale2, fmaf(-slope2[cgi], fd[kt][r], pen[kt][r]));
        xv[kt][r] = v; mx = fmaxf(mx, v);
      }
    if (BR != 1) {
      mx = fmaxf(mx, __shfl_xor(mx, 16)); mx = fmaxf(mx, __shfl_xor(mx, 32));
      const float mnew = fmaxf(m[cgi], mx);
      const float alpha = ex2(m[cgi] - mnew);
      m[cgi] = mnew;
      const float muse = fmaxf(mnew, -1e20f);
      float rs = 0.f;
#pragma unroll
      for (int kt = 0; kt < 4; ++kt)
#pragma unroll
        for (int r = 0; r < 4; ++r) { xv[kt][r] = ex2(xv[kt][r] - muse); rs += xv[kt][r]; }
      l[cgi] = l[cgi] * alpha + rs;
      if (BR == 2) {
#pragma unroll
        for (int dt = 0; dt < 4; ++dt) acc[cgi][dt] *= alpha;
        pv_tile(sV, xv, acc[cgi], l16, gk);
      }
    } else {
      const float muse = fmaxf(m[cgi], -1e20f);
#pragma unroll
      for (int kt = 0; kt < 4; ++kt)
#pragma unroll
        for (int r = 0; r < 4; ++r) {
          const float pn = ex2(xv[kt][r] - muse) * l[cgi];
          ps[kt][r] += pn;
          xv[kt][r] = pn * gmul[cgi];
        }
      pv_tile(sV, xv, acc[cgi], l16, gk);
    }
  }
  if (BR == 1) {
    const int srcl = (lane + 48) & 63;
#pragma unroll
    for (int kt = 0; kt < 4; ++kt) {
      const float same = __shfl(ps[kt][3], srcl);
      const float prev = __shfl(kt > 0 ? ps[kt > 0 ? kt - 1 : 0][3] : carry, srcl);
      const float pm1 = (gk == 0) ? prev : same;
      imp_row[jbase + kt * 4 + gk] = 2.f * (ps[kt][0] + ps[kt][1] + ps[kt][2]) + ps[kt][3] + pm1;
    }
    carry = ps[3][3];
  }
}

__device__ __forceinline__ void nsa_phase(const Params& p, u16* lds) {
  const u16* U = (const u16*)(p.ws + WS_QK);
  const u16* VT = (const u16*)(p.ws + WS_VT);
  const u16* KC = (const u16*)(p.ws + WS_KCMP);
  const u16* VC = (const u16*)(p.ws + WS_VCMPT);
  const float* GL = (const float*)(p.ws + WS_GL);
  u16* Y = (u16*)(p.ws + WS_Y);
  float* imp = (float*)(lds + 256 * TS);
  uint32_t* umask = (uint32_t*)(imp + 64 * IMPS);
  int* ulist = (int*)(umask + 4);
  const int tid = TIDX, lane = tid & 63, w = tid >> 6, l16 = lane & 15, gk = lane >> 4;
  uint2* totl = (uint2*)imp + (size_t)w * 1024 + lane;
  const int BIG = 1 << 30;
  for (int unit = BIDX; unit < 2048; unit += gridDim.x) {
    const int bg = unit & 15, qb = 127 - (unit >> 4), b = bg >> 2, g = bg & 3;
    const int t0 = qb * 64, t = t0 + 16 * w + l16;
    const size_t mrow = (size_t)b * SEQ + t;
    bf16x8 q[4][2];
    float slope2[4], g1[4];
#pragma unroll
    for (int cgi = 0; cgi < 4; ++cgi) {
      const int h = g * 4 + cgi;
#pragma unroll
      for (int ks = 0; ks < 2; ++ks) q[cgi][ks] = *(const bf16x8*)(U + mrow * LDQ + h * 64 + ks * 32 + gk * 8);
      slope2[cgi] = exp2f(-0.5f * (float)(h + 1)) * LOG2E;
      g1[cgi] = sigmoid_f(GL[mrow * 48 + h * 3] + p.o_bg[h * 3]);
    }
    f32x4 acc[4][4];
    float m[4], l[4];
#pragma unroll
    for (int cgi = 0; cgi < 4; ++cgi) {
      m[cgi] = -1e30f; l[cgi] = 0.f;
#pragma unroll
      for (int dt = 0; dt < 4; ++dt) acc[cgi][dt] = (f32x4){0.f, 0.f, 0.f, 0.f};
    }
    __syncthreads();
    for (int i = tid; i < 64 * IMPS; i += 256) imp[i] = 0.f;
    if (tid < 4) umask[tid] = 0u;
    float* imp_row = imp + (16 * w + l16) * IMPS;
    float carry = 0.f;
    uint4 rk0, rk1, rv0, rv1;
    const int ntc = ((4 * qb + 2) >> 6) + 1;
    const u16* kcs = KC + (size_t)bg * 512 * 64;
    const u16* vcs = VC + (size_t)bg * 32768;
#pragma unroll 1
    for (int pass = 0; pass < 2; ++pass) {
      TILE_LD(rk, kcs, 64); TILE_LD(rv, vcs, 512);
      __syncthreads();
      TILE_ST(lds, rk); TILE_ST(lds + 64 * TS, rv);
      __syncthreads();
#pragma unroll 1
      for (int i = 0; i < ntc; ++i) {
        u16* cur = lds + (i & 1) * (128 * TS);
        const bool more = (i + 1 < ntc);
        if (more) { TILE_LD(rk, kcs + (size_t)(i + 1) * 64 * 64, 64); TILE_LD(rv, vcs + (i + 1) * 64, 512); }
        if (pass == 0) nsa_tile<0>(cur, cur + 64 * TS, q, acc, m, l, slope2, g1, t, 16 * (64 * i) + 31, 16, BIG, true, imp_row, 16 * i, carry, lane);
        else nsa_tile<1>(cur, cur + 64 * TS, q, acc, m, l, slope2, g1, t, 16 * (64 * i) + 31, 16, BIG, true, imp_row, 16 * i, carry, lane);
        if (more) { u16* nxt = lds + ((i + 1) & 1) * (128 * TS); TILE_ST(nxt, rk); TILE_ST(nxt + 64 * TS, rv); }
        __syncthreads();
      }
      if (pass == 0) {
#pragma unroll
        for (int cgi = 0; cgi < 4; ++cgi) {
          float lt = l[cgi]; lt += __shfl_xor(lt, 16); lt += __shfl_xor(lt, 32);
          l[cgi] = lt > 0.f ? 1.f / lt : 0.f;
        }
      }
    }
    uint32_t selm = 0u;
    if (qb < 16) {
      if (gk == 0) selm = (1u << (qb + 1)) - 1u;
    } else {
      float val[32];
#pragma unroll
      for (int i4 = 0; i4 < 8; ++i4) {
        const float4 v4 = *(const float4*)(imp_row + 32 * gk + 4 * i4);
        val[4 * i4] = v4.x; val[4 * i4 + 1] = v4.y; val[4 * i4 + 2] = v4.z; val[4 * i4 + 3] = v4.w;
      }
#pragma unroll
      for (int i = 0; i < 32; ++i) {
        const int j = 32 * gk + i;
        const bool forced = (j == 0) || (j == qb) || (j == qb - 1);
        if (forced) selm |= (1u << i);
        if (forced || j > qb) val[i] = -1.f;
      }
#pragma unroll 1
      for (int it = 0; it < 13; ++it) {
        float best = -2.f; int bj = 0;
#pragma unroll
        for (int i = 0; i < 32; ++i) {
          const float v = ((selm >> i) & 1u) ? -1.f : val[i];
          if (v > best) { best = v; bj = 32 * gk + i; }
        }
#pragma unroll
        for (int o = 16; o <= 32; o <<= 1) {
          const float ov = __shfl_xor(best, o); const int oj = __shfl_xor(bj, o);
          if (ov > best || (ov == best && oj < bj)) { best = ov; bj = oj; }
        }
        if ((bj >> 5) == gk) selm |= (1u << (bj & 31));
      }
    }
    const uint32_t sel0 = __shfl(selm, l16), sel1 = __shfl(selm, l16 + 16), sel2 = __shfl(selm, l16 + 32), sel3 = __shfl(selm, l16 + 48);
    uint32_t wu = selm;
#pragma unroll
    for (int o = 1; o <= 8; o <<= 1) wu |= __shfl_xor(wu, o);
    const uint32_t wun0 = __shfl(wu, 0), wun1 = __shfl(wu, 16), wun2 = __shfl(wu, 32), wun3 = __shfl(wu, 48);
    if (l16 == 0) atomicOr(&umask[gk], wu);
    __syncthreads();
    int nsl = 0;
    {
      const uint32_t u0 = umask[0], u1 = umask[1], u2 = umask[2], u3 = umask[3];
      nsl = __popc(u0) + __popc(u1) + __popc(u2) + __popc(u3);
      if (tid < 128) {
        const uint32_t uw = tid < 32 ? u0 : tid < 64 ? u1 : tid < 96 ? u2 : u3;
        if ((uw >> (tid & 31)) & 1u) {
          int pos = __popc(uw & ((1u << (tid & 31)) - 1u));
          if (tid >= 32) pos += __popc(u0);
          if (tid >= 64) pos += __popc(u1);
          if (tid >= 96) pos += __popc(u2);
          ulist[pos] = tid;
        }
      }
    }
    __syncthreads();
#pragma unroll
    for (int cgi = 0; cgi < 4; ++cgi)
#pragma unroll
      for (int dt = 0; dt < 4; ++dt) {
        uint2 o2; o2.x = pack2(acc[cgi][dt][0], acc[cgi][dt][1]); o2.y = pack2(acc[cgi][dt][2], acc[cgi][dt][3]);
        totl[(cgi * 4 + dt) * 64] = o2;
      }
#pragma unroll 1
    for (int br = 1; br < 3; ++br) {
#pragma unroll
      for (int cgi = 0; cgi < 4; ++cgi) {
        m[cgi] = -1e30f; l[cgi] = 0.f;
#pragma unroll
        for (int dt = 0; dt < 4; ++dt) acc[cgi][dt] = (f32x4){0.f, 0.f, 0.f, 0.f};
      }
      const int i0w = (qb >= 8) ? 0 : 8 - qb;
      const int nt = (br == 1) ? nsl : 9 - i0w;
      const u16* kb = U + (size_t)b * SEQ * LDQ + (br == 1 ? 1536 : 1792) + g * 64;
      const u16* vb = VT + (size_t)((br == 1 ? 0 : 256) + g * 64) * MTOK + (size_t)b * SEQ;
      int s0 = (br == 1) ? ulist[0] * 64 : t0 - 512 + 64 * i0w;
      TILE_LD(rk, kb + (size_t)s0 * LDQ, LDQ); TILE_LD(rv, vb + s0, MTOK);
      __syncthreads();
      TILE_ST(lds, rk); TILE_ST(lds + 64 * TS, rv);
      __syncthreads();
#pragma unroll 1
      for (int i = 0; i < nt; ++i) {
        u16* cur = lds + (i & 1) * (128 * TS);
        const bool more = (i + 1 < nt);
        int s1 = 0;
        if (more) {
          s1 = (br == 1) ? ulist[i + 1] * 64 : s0 + 64;
          TILE_LD(rk, kb + (size_t)s1 * LDQ, LDQ); TILE_LD(rv, vb + s1, MTOK);
        }
        bool wsel = true, ls = true;
        int wl = 512;
        if (br == 1) {
          const int j = s0 >> 6, jw = j >> 5, jb = j & 31;
          const uint32_t ww = jw == 0 ? wun0 : jw == 1 ? wun1 : jw == 2 ? wun2 : wun3;
          const uint32_t sw = jw == 0 ? sel0 : jw == 1 ? sel1 : jw == 2 ? sel2 : sel3;
          wsel = (ww >> jb) & 1u; ls = (sw >> jb) & 1u; wl = BIG;
        }
        if (wsel) nsa_tile<2>(cur, cur + 64 * TS, q, acc, m, l, slope2, g1, t, s0, 1, wl, ls, imp_row, 0, carry, lane);
        if (more) { u16* nxt = lds + ((i + 1) & 1) * (128 * TS); TILE_ST(nxt, rk); TILE_ST(nxt + 64 * TS, rv); }
        s0 = s1;
        __syncthreads();
      }
#pragma unroll
      for (int cgi = 0; cgi < 4; ++cgi) {
        const int h = g * 4 + cgi;
        float lt = l[cgi]; lt += __shfl_xor(lt, 16); lt += __shfl_xor(lt, 32);
        const float gt = sigmoid_f(GL[mrow * 48 + h * 3 + br] + p.o_bg[h * 3 + br]);
        const float sc = lt > 0.f ? gt / lt : 0.f;
#pragma unroll
        for (int dt = 0; dt < 4; ++dt) {
          const uint2 pv = totl[(cgi * 4 + dt) * 64];
          const float r0 = bf2f(pv.x & 0xffff) + acc[cgi][dt][0] * sc, r1 = bf2f(pv.x >> 16) + acc[cgi][dt][1] * sc;
          const float r2 = bf2f(pv.y & 0xffff) + acc[cgi][dt][2] * sc, r3 = bf2f(pv.y >> 16) + acc[cgi][dt][3] * sc;
          if (br == 1) {
            uint2 o2; o2.x = pack2(r0, r1); o2.y = pack2(r2, r3);
            totl[(cgi * 4 + dt) * 64] = o2;
          } else {
            const int col = h * 64 + dt * 16 + gk * 4;
            const uint2 zz = *(const uint2*)(U + mrow * LDQ + 2048 + col);
            const float z0 = bf2f(zz.x & 0xffff), z1 = bf2f(zz.x >> 16), z2 = bf2f(zz.y & 0xffff), z3 = bf2f(zz.y >> 16);
            uint2 ov;
            ov.x = pack2(r0 * silu_f(z0), r1 * silu_f(z1));
            ov.y = pack2(r2 * silu_f(z2), r3 * silu_f(z3));
            *(uint2*)(Y + mrow * DM + col) = ov;
          }
        }
      }
    }
  }
}

__device__ __forceinline__ void final_norm(const Params& p) {
  const int lane = TIDX & 63, wave = TIDX >> 6;
  for (int row = BIDX * 4 + wave; row < MTOK; row += gridDim.x * 4) {
    float4* xr = (float4*)(p.out + (size_t)row * DM);
    float4 v[4];
    float ss = 0.f;
#pragma unroll
    for (int i = 0; i < 4; ++i) {
      v[i] = xr[lane + 64 * i];
      ss += v[i].x * v[i].x + v[i].y * v[i].y + v[i].z * v[i].z + v[i].w * v[i].w;
    }
#pragma unroll
    for (int o = 32; o >= 1; o >>= 1) ss += __shfl_xor(ss, o);
    const float rstd = rsqrtf(ss * (1.f / DM) + 1e-6f);
#pragma unroll
    for (int i = 0; i < 4; ++i) {
      const float4 gg = ((const float4*)p.fin_g)[lane + 64 * i];
      xr[lane + 64 * i] = (float4){v[i].x * rstd * gg.x, v[i].y * rstd * gg.y, v[i].z * rstd * gg.z, v[i].w * rstd * gg.w};
    }
  }
}

__device__ __forceinline__ void grid_bar(const Params& p, unsigned& target) {
  __syncthreads();
  target += gridDim.x;
  if (TIDX == 0) {
    unsigned* ctr = (unsigned*)(p.ws + WS_BAR);
    __threadfence();
    __hip_atomic_fetch_add(ctr, 1u, __ATOMIC_RELAXED, __HIP_MEMORY_SCOPE_AGENT);
    while (__hip_atomic_load(ctr, __ATOMIC_RELAXED, __HIP_MEMORY_SCOPE_AGENT) < target) __builtin_amdgcn_s_sleep(1);
    __threadfence();
  }
  __syncthreads();
}

__global__ void __launch_bounds__(256, 1) mega(Params p_in) {
  Params p = p_in;
  p.pad = __builtin_amdgcn_readfirstlane((int)threadIdx.x >> 6);
  unsigned bar_target = 0u;
  extern __shared__ __attribute__((aligned(16))) unsigned char lds_raw[];
  u16* lds = (u16*)lds_raw;
  cg::grid_group grid = cg::this_grid();
  if (p_in.coop == 2) grid.sync();
#define PH_ON(k) (p.ph_lo <= (k) && (k) <= p.ph_hi)
#define PH_SYNC(k) if (p.coop && p.ph_lo <= (k) && (k) < p.ph_hi) grid_bar(p, bar_target);
  if (PH_ON(0)) {
    rms_rows(p, p.x, p.e_ng, (u16*)(p.ws + WS_HBF));
    conv_t(p, (u16*)(p.ws + WS_WT0), p.e_win, 1024, 4104, 4224, 0);
    conv_t(p, (u16*)(p.ws + WS_WT1), p.o_win, 1024, 3632, 3712, 1);
    conv_t(p, (u16*)(p.ws + WS_WO0), p.e_wout, 1024, 1024, 1024, 2);
    conv_t(p, (u16*)(p.ws + WS_WO1), p.o_wout, 1024, 1024, 1024, 2);
    conv_t(p, (u16*)(p.ws + WS_W1K), p.o_wk1, 2048, 256, 256, 2);
    conv_t(p, (u16*)(p.ws + WS_W1V), p.o_wv1, 2048, 256, 256, 2);
    conv_t(p, (u16*)(p.ws + WS_W2K), p.o_wk2, 256, 64, 128, 2);
    conv_t(p, (u16*)(p.ws + WS_W2V), p.o_wv2, 256, 64, 128, 2);
    pe_partial(p);
    if (BIDX == 0 && TIDX < 8) ((uint32_t*)(p.ws + WS_KMAX))[TIDX] = 0u;
  }
  PH_SYNC(0)
  if (PH_ON(1)) gemm_inproj(p, 0, lds);
  PH_SYNC(1)
  if (PH_ON(2)) { fox_scan(p, (float*)lds); ret_stepA(p); fox_knorm(p); }
  PH_SYNC(2)
  if (PH_ON(3)) { ret_stepB(p); fox_phase(p, lds); }
  PH_SYNC(3)
  if (PH_ON(4)) ret_stepC(p, lds);
  PH_SYNC(4)
  if (PH_ON(5)) gemm_outproj(p, 0, lds);
  PH_SYNC(5)
  if (PH_ON(6)) {
    rms_rows(p, p.out, p.o_ng, (u16*)(p.ws + WS_HBF));
    if (BIDX == 0) {
      for (int i = TIDX; i < 512; i += 256) {
        const float* part = (const float*)(p.ws + WS_PEP);
        float s = 0.f;
        for (int kc = 0; kc < 16; ++kc) s += part[((i >> 8) * 16 + kc) * 256 + (i & 255)];
        ((float*)(p.ws + WS_PEB))[i] = s;
      }
    }
  }
  PH_SYNC(6)
  if (PH_ON(7)) gemm_inproj(p, 1, lds);
  PH_SYNC(7)
  if (PH_ON(8)) gemm_cmp1(p, lds);
  PH_SYNC(8)
  if (PH_ON(9)) gemm_cmp2(p, lds);
  PH_SYNC(9)
  if (PH_ON(10)) nsa_phase(p, lds);
  PH_SYNC(10)
  if (PH_ON(11)) gemm_outproj(p, 1, lds);
  PH_SYNC(11)
  if (PH_ON(12)) final_norm(p);
}

extern "C" void kernel_launch(void* const* d_in, const int* in_sizes, int n_in, void* d_out, int out_size, void* d_ws,
                              size_t ws_size, hipStream_t stream) {
  static int grid_blocks = 0;
  if (!grid_blocks) {
    int dev = 0, cus = 0, per_cu = 0;
    hipGetDevice(&dev);
    hipDeviceGetAttribute(&cus, hipDeviceAttributeMultiprocessorCount, dev);
    hipFuncSetAttribute((const void*)mega, hipFuncAttributeMaxDynamicSharedMemorySize, LDS_BYTES);
    hipOccupancyMaxActiveBlocksPerMultiprocessor(&per_cu, (const void*)mega, 256, LDS_BYTES);
    if (per_cu < 1) per_cu = 1;
    if (per_cu > 2) per_cu = 2;
    grid_blocks = cus * per_cu;
    (void)hipGetLastError();
  }
  Params p{};
  p.x = (const float*)d_in[0]; p.e_ng = (const float*)d_in[1]; p.e_win = (const float*)d_in[2];
  p.e_bf = (const float*)d_in[3]; p.e_gn = (const float*)d_in[4]; p.e_wout = (const float*)d_in[5];
  p.o_ng = (const float*)d_in[6]; p.o_win = (const float*)d_in[7]; p.o_bg = (const float*)d_in[8];
  p.o_pek = (const float*)d_in[9]; p.o_pev = (const float*)d_in[10]; p.o_wk1 = (const float*)d_in[11];
  p.o_wk2 = (const float*)d_in[12]; p.o_wv1 = (const float*)d_in[13]; p.o_wv2 = (const float*)d_in[14];
  p.o_wout = (const float*)d_in[15]; p.fin_g = (const float*)d_in[16];
  p.out = (float*)d_out; p.ws = (unsigned char*)d_ws;
#if ONE_LAUNCH
  p.ph_lo = 0; p.ph_hi = NPHASE - 1; p.coop = 1;
  (void)hipMemsetAsync((unsigned char*)d_ws + WS_BAR, 0, 64, stream);
  void* args[] = {&p};
  hipError_t e = hipLaunchCooperativeKernel((const void*)mega, dim3(grid_blocks), dim3(256), args, LDS_BYTES, stream);
  if (e != hipSuccess) fprintf(stderr, "cooperative launch failed: %s (grid %d)\n", hipGetErrorString(e), grid_blocks);
#else
  for (int ph = 0; ph < NPHASE; ++ph) {
    p.ph_lo = ph; p.ph_hi = ph; p.coop = 0;
    hipLaunchKernelGGL(mega, dim3(grid_blocks), dim3(256), LDS_BYTES, stream, p);
  }
#endif
}
```

```cpp
#include <hip/hip_runtime.h>
#include <hip/hip_cooperative_groups.h>
#include <stdint.h>
#include <stdio.h>
namespace cg = cooperative_groups;

typedef unsigned short u16;
typedef short bf16x8 __attribute__((ext_vector_type(8)));
typedef short bf16x4 __attribute__((ext_vector_type(4)));
typedef float f32x4 __attribute__((ext_vector_type(4)));

#ifndef ONE_LAUNCH
#define ONE_LAUNCH 1
#endif

#define MTOK 32768
#define SEQ 8192
#define DM 1024
#define LDQ 3072
#define LOG2E 1.4426950408889634f
#define TS 72
#define IMPS 132
#define LDS_BYTES 110592
#define NPHASE 13

#define MiB (1024ull * 1024ull)
#define WS_HBF   (0ull)
#define WS_DS    (0ull)
#define WS_ST    (32ull * MiB)
#define WS_QK    (64ull * MiB)
#define WS_VT    (256ull * MiB)
#define WS_Y     (352ull * MiB)
#define WS_WT0   (416ull * MiB)
#define WS_WT1   (WS_WT0 + 4224ull * 1024 * 2)
#define WS_WO0   (WS_WT1 + 3712ull * 1024 * 2)
#define WS_WO1   (WS_WO0 + 1024ull * 1024 * 2)
#define WS_W1K   (WS_WO1 + 1024ull * 1024 * 2)
#define WS_W1V   (WS_W1K + 256ull * 2048 * 2)
#define WS_W2K   (WS_W1V + 256ull * 2048 * 2)
#define WS_W2V   (WS_W2K + 128ull * 256 * 2)
#define WS_FLOG  (440ull * MiB)
#define WS_CFOX  (441ull * MiB)
#define WS_GL    (442ull * MiB)
#define WS_HC    (448ull * MiB)
#define WS_KCMP  (456ull * MiB)
#define WS_VCMPT (457ull * MiB)
#define WS_PEP   (458ull * MiB)
#define WS_PEB   (WS_PEP + 65536ull)
#define WS_KMAX  (WS_PEB + 4096ull)
#define WS_BAR   (WS_KMAX + 4096ull)

struct Params {
  const float *x, *e_ng, *e_win, *e_bf, *e_gn, *e_wout;
  const float *o_ng, *o_win, *o_bg, *o_pek, *o_pev, *o_wk1, *o_wk2, *o_wv1, *o_wv2, *o_wout, *fin_g;
  float* out;
  unsigned char* ws;
  int ph_lo, ph_hi, coop, pad;
};

typedef __bf16 bf16v2 __attribute__((ext_vector_type(2)));
typedef float f32v2 __attribute__((ext_vector_type(2)));
__device__ __forceinline__ uint32_t pack2(float a, float b) {
  f32v2 v = {a, b};
  bf16v2 r = __builtin_convertvector(v, bf16v2);
  return *(uint32_t*)&r;
}
__device__ __forceinline__ u16 f2bf(float f) { return (u16)(pack2(f, 0.f) & 0xffffu); }
__device__ __forceinline__ float bf2f(u16 h) { return __uint_as_float(((uint32_t)h) << 16); }
__device__ __forceinline__ float ex2(float x) { return __builtin_amdgcn_exp2f(x); }
__device__ __forceinline__ float silu_f(float z) { return z * __builtin_amdgcn_rcpf(1.f + ex2(-z * LOG2E)); }
__device__ __forceinline__ float sigmoid_f(float z) { return __builtin_amdgcn_rcpf(1.f + ex2(-z * LOG2E)); }

__device__ __forceinline__ int opq(int v) { asm volatile("" : "+v"(v)); return v; }
__device__ __forceinline__ int opqs(int v) { asm volatile("" : "+s"(v)); return v; }
#define TIDX opq(p.pad * 64 + (int)__lane_id())
#define BIDX opqs((int)blockIdx.x)
#define MFMA(a, b, c) __builtin_amdgcn_mfma_f32_16x16x32_bf16((a), (b), (c), 0, 0, 0)

__device__ __forceinline__ void rms_rows(const Params& p, const float* __restrict__ x, const float* __restrict__ g, u16* __restrict__ h) {
  const int lane = TIDX & 63, wave = TIDX >> 6;
  for (int row = BIDX * 4 + wave; row < MTOK; row += gridDim.x * 4) {
    const float4* xr = (const float4*)(x + (size_t)row * DM);
    float4 v[4];
    float ss = 0.f;
#pragma unroll
    for (int i = 0; i < 4; ++i) {
      v[i] = xr[lane + 64 * i];
      ss += v[i].x * v[i].x + v[i].y * v[i].y + v[i].z * v[i].z + v[i].w * v[i].w;
    }
#pragma unroll
    for (int o = 32; o >= 1; o >>= 1) ss += __shfl_xor(ss, o);
    const float rstd = rsqrtf(ss * (1.f / DM) + 1e-6f);
#pragma unroll
    for (int i = 0; i < 4; ++i) {
      float4 gg = ((const float4*)g)[lane + 64 * i];
      uint2 o;
      o.x = pack2(v[i].x * rstd * gg.x, v[i].y * rstd * gg.y);
      o.y = pack2(v[i].z * rstd * gg.z, v[i].w * rstd * gg.w);
      *(uint2*)(h + (size_t)row * DM + (lane + 64 * i) * 4) = o;
    }
  }
}

__device__ __forceinline__ int map_col(int MAP, int n) {
  if (MAP == 0) {
    if (n < 1024) return n;
    if (n < 2048) return n + 520;
    if (n < 3072) return n + 1032;
    if (n < 3584) return n - 2048;
    if (n < 4096) return n - 1016;
    if (n < 4104) return n - 2560;
    return -1;
  } else if (MAP == 1) {
    if (n < 1792) return n;
    if (n < 2048) return n + 256;
    if (n < 3072) return n + 560;
    if (n < 3328) return n - 1280;
    if (n < 3584) return n - 1024;
    if (n < 3632) return n - 1024;
    return -1;
  } else if (MAP == 2) {
    return n;
  }
  return n;
}

__device__ __forceinline__ void conv_t(const Params& p, u16* __restrict__ dst, const float* __restrict__ src, int K, int nsrc, int ndst, int MAP) {
  const int total = ndst * (K >> 3);
  for (int id = BIDX * 256 + TIDX; id < total; id += gridDim.x * 256) {
    const int n = id % ndst, kc = id / ndst;
    const int sc = map_col(MAP, n);
    float v[8];
#pragma unroll
    for (int i = 0; i < 8; ++i) v[i] = (sc >= 0 && sc < nsrc) ? src[(size_t)(kc * 8 + i) * nsrc + sc] : 0.f;
    uint4 o;
    o.x = pack2(v[0], v[1]); o.y = pack2(v[2], v[3]); o.z = pack2(v[4], v[5]); o.w = pack2(v[6], v[7]);
    *(uint4*)(dst + (size_t)n * K + kc * 8) = o;
  }
}

__device__ __forceinline__ void pe_partial(const Params& p) {
  float* part = (float*)(p.ws + WS_PEP);
  for (int task = BIDX; task < 32; task += gridDim.x) {
    const int kv = task >> 4, kc = task & 15, n = TIDX;
    const float* pe = kv ? p.o_pev : p.o_pek;
    const float* w1 = kv ? p.o_wv1 : p.o_wk1;
    float acc = 0.f;
#pragma unroll 16
    for (int k = kc * 128; k < kc * 128 + 128; ++k) acc += pe[k] * w1[(size_t)k * 256 + n];
    part[(kv * 16 + kc) * 256 + n] = acc;
  }
}

#define GST (384 * TS)
__device__ __forceinline__ void gemm_compute(const u16* cur, f32x4 (&acc)[8][4], bool swapped, int wpa, int wpb, int l16, int gk) {
  const u16* sA = cur + (wpa * 128 + l16) * TS + gk * 8;
  const u16* sB = cur + (256 + wpb * 64 + l16) * TS + gk * 8;
#pragma unroll
  for (int kk = 0; kk < 2; ++kk) {
    bf16x8 fa[8], fb[4];
#pragma unroll
    for (int i = 0; i < 8; ++i) fa[i] = *(const bf16x8*)(sA + i * 16 * TS + kk * 32);
#pragma unroll
    for (int j = 0; j < 4; ++j) fb[j] = *(const bf16x8*)(sB + j * 16 * TS + kk * 32);
    if (swapped) {
#pragma unroll
      for (int i = 0; i < 8; ++i)
#pragma unroll
        for (int j = 0; j < 4; ++j) acc[i][j] = MFMA(fb[j], fa[i], acc[i][j]);
    } else {
#pragma unroll
      for (int i = 0; i < 8; ++i)
#pragma unroll
        for (int j = 0; j < 4; ++j) acc[i][j] = MFMA(fa[i], fb[j], acc[i][j]);
    }
  }
}
__device__ __forceinline__ void gemm_mainloop(const Params& p, const u16* __restrict__ Ab, const uint32_t (&pa)[8], const u16* __restrict__ Bb,
                                              const uint32_t (&pb)[4], int a_kstride, int nk,
                                              u16* lds, f32x4 (&acc)[8][4], bool swapped) {
  const int tid = TIDX, lane = tid & 63, wave = tid >> 6;
  const int l16 = lane & 15, gk = lane >> 4;
  const int wpa = wave >> 1, wpb = wave & 1;
  const int woff = (tid >> 3) * TS + (tid & 7) * 8;
  uint4 rap0, rap1, rap2, rap3, rap4, rap5, rap6, rap7, rbp0, rbp1, rbp2, rbp3;
  uint4 raq0, raq1, raq2, raq3, raq4, raq5, raq6, raq7, rbq0, rbq1, rbq2, rbq3;
#define G_LDA(S, i, Ap) ra##S##i = *(const uint4*)((Ap) + pa[i]);
#define G_LDB(S, i, Bp) rb##S##i = *(const uint4*)((Bp) + pb[i]);
#define G_LD(S, kidx) { const u16* Ap_ = Ab + (size_t)(kidx) * a_kstride; const u16* Bp_ = Bb + (size_t)(kidx) * 64;                      \
    G_LDA(S, 0, Ap_) G_LDA(S, 1, Ap_) G_LDA(S, 2, Ap_) G_LDA(S, 3, Ap_) G_LDA(S, 4, Ap_) G_LDA(S, 5, Ap_) G_LDA(S, 6, Ap_) G_LDA(S, 7, Ap_) \
    G_LDB(S, 0, Bp_) G_LDB(S, 1, Bp_) G_LDB(S, 2, Bp_) G_LDB(S, 3, Bp_) }
#define G_STA(S, i, D) *(uint4*)((D) + woff + (i) * 32 * TS) = ra##S##i;
#define G_STB(S, i, D) *(uint4*)((D) + 256 * TS + woff + (i) * 32 * TS) = rb##S##i;
#define G_ST(S, D) { u16* D_ = (D);                                                                                                   \
    G_STA(S, 0, D_) G_STA(S, 1, D_) G_STA(S, 2, D_) G_STA(S, 3, D_) G_STA(S, 4, D_) G_STA(S, 5, D_) G_STA(S, 6, D_) G_STA(S, 7, D_)   \
    G_STB(S, 0, D_) G_STB(S, 1, D_) G_STB(S, 2, D_) G_STB(S, 3, D_) }
  G_LD(p, 0)
  G_LD(q, 1)
  __syncthreads();
  G_ST(p, lds)
  __syncthreads();
#pragma unroll
  for (int i = 0; i < 8; ++i)
#pragma unroll
    for (int j = 0; j < 4; ++j) acc[i][j] = (f32x4){0.f, 0.f, 0.f, 0.f};
#pragma unroll 1
  for (int ks = 0; ks < nk; ks += 2) {
    if (ks + 2 < nk) G_LD(p, ks + 2)
    gemm_compute(lds, acc, swapped, wpa, wpb, l16, gk);
    G_ST(q, lds + GST)
    __syncthreads();
    if (ks + 3 < nk) G_LD(q, ks + 3)
    gemm_compute(lds + GST, acc, swapped, wpa, wpb, l16, gk);
    if (ks + 2 < nk) G_ST(p, lds)
    __syncthreads();
  }
#undef G_LD
#undef G_LDA
#undef G_LDB
#undef G_ST
#undef G_STA
#undef G_STB
}
#define GEMM_OFFS(rowstrideA, rowstrideB)                                   \
  uint32_t pa[8], pb[4];                                                    \
  _Pragma("unroll") for (int i = 0; i < 8; ++i)                             \
    pa[i] = (uint32_t)((tid >> 3) + 32 * i) * (rowstrideA) + (tid & 7) * 8; \
  _Pragma("unroll") for (int i = 0; i < 4; ++i)                             \
    pb[i] = (uint32_t)((tid >> 3) + 32 * i) * (rowstrideB) + (tid & 7) * 8;

__device__ __forceinline__ void gemm_inproj(const Params& p, int layer, u16* lds) {
  const u16* A = (const u16*)(p.ws + WS_HBF);
  const u16* Bt = (const u16*)(p.ws + (layer ? WS_WT1 : WS_WT0));
  u16* QK = (u16*)(p.ws + WS_QK);
  u16* VT = (u16*)(p.ws + WS_VT);
  float* F = (float*)(p.ws + (layer ? WS_GL : WS_FLOG));
  const int NT = layer ? 29 : 33;
  const int ntrans_end = layer ? 28 : 32;
  const int nvalidF = layer ? 48 : 8, ldf = layer ? 48 : 8;
  const int tid = TIDX, lane = tid & 63, wave = tid >> 6, l16 = lane & 15, gk = lane >> 4;
  const int wpa = wave >> 1, wpb = wave & 1;
  const int bid = BIDX, xcd = bid & 7, nloc = (int)gridDim.x >> 3;
  for (int q = bid >> 3; q < 16 * NT; q += nloc) {
    const int mt = xcd * 16 + q / NT, nt = q % NT;
    const int m0 = mt * 256, n0 = nt * 128;
    int mode;
    if (nt < 24) mode = (layer == 0 && nt >= 12 && nt < 16) ? 2 : 0;
    else if (nt < ntrans_end) mode = 1;
    else mode = 3;
    const bool swapped = (mode == 0 || mode == 3);
    GEMM_OFFS(DM, DM)
    f32x4 acc[8][4];
    gemm_mainloop(p, A + (size_t)m0 * DM, pa, Bt + (size_t)n0 * DM, pb, 64, 16, lds, acc, swapped);
    const int mw = m0 + wpa * 128, nw = n0 + wpb * 64;
    if (swapped) {
#pragma unroll
      for (int i = 0; i < 8; ++i)
#pragma unroll
        for (int j = 0; j < 4; ++j) {
          const int n = nw + j * 16 + gk * 4;
          const int m = mw + i * 16 + l16;
          if (mode == 0) {
            uint2 o; o.x = pack2(acc[i][j][0], acc[i][j][1]); o.y = pack2(acc[i][j][2], acc[i][j][3]);
            *(uint2*)(QK + (size_t)m * LDQ + n) = o;
          } else {
            const int nn = n - n0;
            if (nn < nvalidF) *(float4*)(F + (size_t)m * ldf + nn) = (float4){acc[i][j][0], acc[i][j][1], acc[i][j][2], acc[i][j][3]};
          }
        }
    } else {
#pragma unroll
      for (int i = 0; i < 8; ++i)
#pragma unroll
        for (int j = 0; j < 4; ++j) {
          const int m = mw + i * 16 + gk * 4;
          const int n = nw + j * 16 + l16;
          if (mode == 1) {
            const int trow = n - 3072;
            uint2 o; o.x = pack2(acc[i][j][0], acc[i][j][1]); o.y = pack2(acc[i][j][2], acc[i][j][3]);
            *(uint2*)(VT + (size_t)trow * MTOK + m) = o;
          } else {
            const int trow = n - 512;
            const int h = (nw - 1536) >> 6;
            const float lg2 = log1pf(-exp2f(-5.f - (float)h)) * LOG2E;
            const float lane_dec = 0.125f * ex2(lg2 * (float)(127 - gk * 4));
            float sv[4];
#pragma unroll
            for (int r = 0; r < 4; ++r) {
              QK[(size_t)(m + r) * LDQ + n] = f2bf(acc[i][j][r]);
              sv[r] = acc[i][j][r] * lane_dec * ex2(lg2 * (float)(-(i * 16 + r)));
            }
            uint2 o; o.x = pack2(sv[0], sv[1]); o.y = pack2(sv[2], sv[3]);
            *(uint2*)(VT + (size_t)trow * MTOK + m) = o;
          }
        }
    }
  }
}

__device__ __forceinline__ void gemm_outproj(const Params& p, int layer, u16* lds) {
  const u16* A = (const u16*)(p.ws + WS_Y);
  const u16* Bt = (const u16*)(p.ws + (layer ? WS_WO1 : WS_WO0));
  const float* res = layer ? p.out : p.x;
  float* out = p.out;
  const int tid = TIDX, lane = tid & 63, wave = tid >> 6, l16 = lane & 15, gk = lane >> 4;
  const int wpa = wave >> 1, wpb = wave & 1;
  const int bid = BIDX, xcd = bid & 7, nloc = (int)gridDim.x >> 3;
  for (int q = bid >> 3; q < 16 * 8; q += nloc) {
    const int mt = xcd * 16 + (q >> 3), nt = q & 7;
    const int m0 = mt * 256, n0 = nt * 128;
    GEMM_OFFS(DM, DM)
    f32x4 acc[8][4];
    gemm_mainloop(p, A + (size_t)m0 * DM, pa, Bt + (size_t)n0 * DM, pb, 64, 16, lds, acc, true);
    const int mw = m0 + wpa * 128, nw = n0 + wpb * 64;
#pragma unroll
    for (int i = 0; i < 8; ++i)
#pragma unroll
      for (int j = 0; j < 4; ++j) {
        const int n = nw + j * 16 + gk * 4;
        const int m = mw + i * 16 + l16;
        const float4 r = *(const float4*)(res + (size_t)m * DM + n);
        *(float4*)(out + (size_t)m * DM + n) = (float4){r.x + acc[i][j][0], r.y + acc[i][j][1], r.z + acc[i][j][2], r.w + acc[i][j][3]};
      }
  }
}

__device__ __forceinline__ void gemm_cmp1(const Params& p, u16* lds) {
  const u16* U = (const u16*)(p.ws + WS_QK);
  const float* peb = (const float*)(p.ws + WS_PEB);
  const int tid = TIDX, lane = tid & 63, wave = tid >> 6, l16 = lane & 15, gk = lane >> 4;
  const int wpa = wave >> 1, wpb = wave & 1;
  for (int tile = BIDX; tile < 128; tile += gridDim.x) {
    const int kv = tile >> 6, mt = (tile >> 1) & 31, nt = tile & 1;
    const int m0 = mt * 256, n0 = nt * 128;
    const u16* Bt = (const u16*)(p.ws + (kv ? WS_W1V : WS_W1K));
    u16* Hc = (u16*)(p.ws + WS_HC) + (size_t)kv * 8192 * 256;
    uint32_t pa[8], pb[4];
#pragma unroll
    for (int i = 0; i < 8; ++i) {
      const int row = (tid >> 3) + 32 * i, kc = tid & 7;
      const int r = m0 + row, bg = r >> 9, cc = r & 511, b = bg >> 2, g = bg & 3;
      int tok0 = cc * 16; if (tok0 > SEQ - 32) tok0 = SEQ - 32;
      pa[i] = (uint32_t)(b * SEQ + tok0) * LDQ + 1024 + kv * 256 + g * 64 + kc * 8;
    }
#pragma unroll
    for (int i = 0; i < 4; ++i) pb[i] = (uint32_t)((tid >> 3) + 32 * i) * 2048 + (tid & 7) * 8;
    f32x4 acc[8][4];
    gemm_mainloop(p, U, pa, Bt + (size_t)n0 * 2048, pb, LDQ, 32, lds, acc, true);
    const int mw = m0 + wpa * 128, nw = n0 + wpb * 64;
#pragma unroll
    for (int i = 0; i < 8; ++i)
#pragma unroll
      for (int j = 0; j < 4; ++j) {
        const int n = nw + j * 16 + gk * 4;
        const int m = mw + i * 16 + l16;
        const float4 bb = *(const float4*)(peb + kv * 256 + n);
        float v0 = silu_f(acc[i][j][0] + bb.x), v1 = silu_f(acc[i][j][1] + bb.y);
        float v2 = silu_f(acc[i][j][2] + bb.z), v3 = silu_f(acc[i][j][3] + bb.w);
        if ((m & 511) == 511) { v0 = v1 = v2 = v3 = 0.f; }
        uint2 o; o.x = pack2(v0, v1); o.y = pack2(v2, v3);
        *(uint2*)(Hc + (size_t)m * 256 + n) = o;
      }
  }
}

__device__ __forceinline__ void gemm_cmp2(const Params& p, u16* lds) {
  const int tid = TIDX, lane = tid & 63, wave = tid >> 6, l16 = lane & 15, gk = lane >> 4;
  const int wpa = wave >> 1, wpb = wave & 1;
  for (int tile = BIDX; tile < 64; tile += gridDim.x) {
    const int kv = tile >> 5, mt = tile & 31;
    const int m0 = mt * 256;
    const u16* A = (const u16*)(p.ws + WS_HC) + (size_t)kv * 8192 * 256;
    const u16* Bt = (const u16*)(p.ws + (kv ? WS_W2V : WS_W2K));
    GEMM_OFFS(256, 256)
    f32x4 acc[8][4];
    const bool swapped = (kv == 0);
    gemm_mainloop(p, A + (size_t)m0 * 256, pa, Bt, pb, 64, 4, lds, acc, swapped);
    const int mw = m0 + wpa * 128, nw = wpb * 64;
    if (swapped) {
      u16* kc_ = (u16*)(p.ws + WS_KCMP);
#pragma unroll
      for (int i = 0; i < 8; ++i)
#pragma unroll
        for (int j = 0; j < 4; ++j) {
          const int n = nw + j * 16 + gk * 4;
          const int m = mw + i * 16 + l16;
          if (n < 64) {
            uint2 o; o.x = pack2(acc[i][j][0], acc[i][j][1]); o.y = pack2(acc[i][j][2], acc[i][j][3]);
            *(uint2*)(kc_ + (size_t)m * 64 + n) = o;
          }
        }
    } else {
      u16* vt = (u16*)(p.ws + WS_VCMPT);
#pragma unroll
      for (int i = 0; i < 8; ++i)
#pragma unroll
        for (int j = 0; j < 4; ++j) {
          const int m = mw + i * 16 + gk * 4;
          const int n = nw + j * 16 + l16;
          if (n < 64) {
            uint2 o; o.x = pack2(acc[i][j][0], acc[i][j][1]); o.y = pack2(acc[i][j][2], acc[i][j][3]);
            *(uint2*)(vt + (size_t)(m >> 9) * 32768 + (size_t)n * 512 + (m & 511)) = o;
          }
        }
    }
  }
}

#define TILE_LD(R, src, stride) { const u16* s_ = (src); R##0 = *(const uint4*)(s_ + (long)(tid >> 3) * (stride) + (tid & 7) * 8); \
                                  R##1 = *(const uint4*)(s_ + (long)((tid >> 3) + 32) * (stride) + (tid & 7) * 8); }
#define TILE_ST(dst, R) { u16* d_ = (dst); *(uint4*)(d_ + (tid >> 3) * TS + (tid & 7) * 8) = R##0; \
                          *(uint4*)(d_ + ((tid >> 3) + 32) * TS + (tid & 7) * 8) = R##1; }
__device__ __forceinline__ void qk_tile(const u16* sK, const bf16x8 (&q)[2], f32x4 (&s)[4], int l16, int gk) {
#pragma unroll
  for (int kt = 0; kt < 4; ++kt) s[kt] = (f32x4){0.f, 0.f, 0.f, 0.f};
#pragma unroll
  for (int ks = 0; ks < 2; ++ks)
#pragma unroll
    for (int kt = 0; kt < 4; ++kt) {
      bf16x8 kf = *(const bf16x8*)(sK + (kt * 16 + l16) * TS + ks * 32 + gk * 8);
      s[kt] = MFMA(kf, q[ks], s[kt]);
    }
}
__device__ __forceinline__ void pv_tile(const u16* sV, const float (&pp)[4][4], f32x4 (&o)[4], int l16, int gk) {
  bf16x8 pf[2];
#pragma unroll
  for (int ks2 = 0; ks2 < 2; ++ks2) {
    uint4 t;
    t.x = pack2(pp[2 * ks2][0], pp[2 * ks2][1]); t.y = pack2(pp[2 * ks2][2], pp[2 * ks2][3]);
    t.z = pack2(pp[2 * ks2 + 1][0], pp[2 * ks2 + 1][1]); t.w = pack2(pp[2 * ks2 + 1][2], pp[2 * ks2 + 1][3]);
    pf[ks2] = *(bf16x8*)&t;
  }
#pragma unroll
  for (int dt = 0; dt < 4; ++dt)
#pragma unroll
    for (int ks2 = 0; ks2 < 2; ++ks2) {
      uint2 a0 = *(const uint2*)(sV + (dt * 16 + l16) * TS + (2 * ks2) * 16 + gk * 4);
      uint2 a1 = *(const uint2*)(sV + (dt * 16 + l16) * TS + (2 * ks2 + 1) * 16 + gk * 4);
      uint4 t; t.x = a0.x; t.y = a0.y; t.z = a1.x; t.w = a1.y;
      o[dt] = MFMA(*(bf16x8*)&t, pf[ks2], o[dt]);
    }
}

__device__ __forceinline__ void fox_phase(const Params& p, u16* lds) {
  const u16* QK = (const u16*)(p.ws + WS_QK);
  const u16* VT = (const u16*)(p.ws + WS_VT);
  const float* cf = (const float*)(p.ws + WS_CFOX);
  u16* Y = (u16*)(p.ws + WS_Y);
  const int tid = TIDX, lane = tid & 63, w = tid >> 6, l16 = lane & 15, gk = lane >> 4;
  const float scale2 = 0.125f * LOG2E;
  for (int unit = BIDX; unit < 2048; unit += gridDim.x) {
    const int bh = unit & 31, qblk = 63 - (unit >> 5), b = bh >> 3, h = bh & 7;
    const int tq0 = qblk * 128 + w * 32;
    const float* cfr = cf + (size_t)bh * SEQ;
    bf16x8 q[2][2];
    float cq2[2];
#pragma unroll
    for (int cgi = 0; cgi < 2; ++cgi) {
      const int t = tq0 + cgi * 16 + l16;
#pragma unroll
      for (int ks = 0; ks < 2; ++ks) q[cgi][ks] = *(const bf16x8*)(QK + (size_t)(b * SEQ + t) * LDQ + h * 64 + ks * 32 + gk * 8);
      cq2[cgi] = cfr[t] * LOG2E;
    }
    f32x4 o[2][4];
    float m[2], l[2];
#pragma unroll
    for (int cgi = 0; cgi < 2; ++cgi) {
      m[cgi] = -1e30f; l[cgi] = 0.f;
#pragma unroll
      for (int dt = 0; dt < 4; ++dt) o[cgi][dt] = (f32x4){0.f, 0.f, 0.f, 0.f};
    }
    const int ntiles = qblk * 2 + 2;
    const int iw = qblk * 2 + (w >> 1);
    const u16* ksrc = QK + (size_t)(b * SEQ) * LDQ + 512 + h * 64;
    const u16* vsrc = VT + (size_t)(h * 64) * MTOK + (size_t)b * SEQ;
    float qs = 0.f;
#pragma unroll
    for (int cgi = 0; cgi < 2; ++cgi) {
      float ss = 0.f;
#pragma unroll
      for (int ks = 0; ks < 2; ++ks)
#pragma unroll
        for (int e = 0; e < 8; ++e) { const float v = bf2f((u16)q[cgi][ks][e]); ss += v * v; }
      ss += __shfl_xor(ss, 16); ss += __shfl_xor(ss, 32);
      qs = fmaxf(qs, ss);
    }
#pragma unroll
    for (int o = 1; o <= 8; o <<= 1) qs = fmaxf(qs, __shfl_xor(qs, o));
    float* red = (float*)(lds + 256 * TS);
    if (lane == 0) red[w] = qs;
    __syncthreads();
    const float qmax2 = fmaxf(fmaxf(red[0], red[1]), fmaxf(red[2], red[3]));
    const float kmax2 = __uint_as_float(((const uint32_t*)(p.ws + WS_KMAX))[h]);
    const float T2 = 2.f * scale2 * sqrtf(qmax2 * kmax2) * 1.001f + 48.f;
    const float cfirst2 = cfr[qblk * 128] * LOG2E;
    int i_lo = 0;
    for (int base = qblk * 2 - 1; base >= 0; base -= 64) {
      const int ti = base - lane;
      bool skip = false;
      if (ti >= 0) skip = (cfirst2 - cfr[ti * 64 + 63] * LOG2E) < -T2;
      const unsigned long long bal = __ballot(skip);
      if (bal) { i_lo = base - (int)__builtin_ctzll(bal) + 1; break; }
    }
    uint4 rk0, rk1, rv0, rv1;
    TILE_LD(rk, ksrc + (size_t)i_lo * 64 * LDQ, LDQ); TILE_LD(rv, vsrc + i_lo * 64, MTOK);
    TILE_ST(lds + (i_lo & 1) * (128 * TS), rk); TILE_ST(lds + (i_lo & 1) * (128 * TS) + 64 * TS, rv);
    __syncthreads();
    for (int i = i_lo; i < ntiles; ++i) {
      u16* cur = lds + (i & 1) * (128 * TS);
      const bool more = (i + 1 < ntiles);
      if (more) { TILE_LD(rk, ksrc + (size_t)(i + 1) * 64 * LDQ, LDQ); TILE_LD(rv, vsrc + (i + 1) * 64, MTOK); }
      if (i <= iw) {
        const int s0 = i * 64;
        const bool diag = (i == iw);
        float ck2[4][4];
#pragma unroll
        for (int kt = 0; kt < 4; ++kt) {
          float4 c4 = *(const float4*)(cfr + s0 + kt * 16 + gk * 4);
          ck2[kt][0] = c4.x * LOG2E; ck2[kt][1] = c4.y * LOG2E; ck2[kt][2] = c4.z * LOG2E; ck2[kt][3] = c4.w * LOG2E;
        }
#pragma unroll
        for (int cgi = 0; cgi < 2; ++cgi) {
          f32x4 s[4];
          qk_tile(cur, q[cgi], s, l16, gk);
          const int t = tq0 + cgi * 16 + l16;
          float xv[4][4];
          float mx = -1e30f;
#pragma unroll
          for (int kt = 0; kt < 4; ++kt)
#pragma unroll
            for (int r = 0; r < 4; ++r) {
              float v = fmaf(s[kt][r], scale2, cq2[cgi] - ck2[kt][r]);
              if (diag && (s0 + kt * 16 + gk * 4 + r > t)) v = -1e30f;
              xv[kt][r] = v; mx = fmaxf(mx, v);
            }
          mx = fmaxf(mx, __shfl_xor(mx, 16)); mx = fmaxf(mx, __shfl_xor(mx, 32));
          const float mnew = fmaxf(m[cgi], mx);
          const float alpha = ex2(m[cgi] - mnew);
          m[cgi] = mnew;
          const float muse = fmaxf(mnew, -1e20f);
          float rs = 0.f;
#pragma unroll
          for (int kt = 0; kt < 4; ++kt)
#pragma unroll
            for (int r = 0; r < 4; ++r) { xv[kt][r] = ex2(xv[kt][r] - muse); rs += xv[kt][r]; }
          l[cgi] = l[cgi] * alpha + rs;
#pragma unroll
          for (int dt = 0; dt < 4; ++dt) o[cgi][dt] *= alpha;
          pv_tile(cur + 64 * TS, xv, o[cgi], l16, gk);
        }
      }
      if (more) { u16* nxt = lds + ((i + 1) & 1) * (128 * TS); TILE_ST(nxt, rk); TILE_ST(nxt + 64 * TS, rv); }
      __syncthreads();
    }
#pragma unroll
    for (int cgi = 0; cgi < 2; ++cgi) {
      float lt = l[cgi]; lt += __shfl_xor(lt, 16); lt += __shfl_xor(lt, 32);
      const float inv = lt > 0.f ? 1.f / lt : 0.f;
      const size_t mrow = (size_t)(b * SEQ + tq0 + cgi * 16 + l16);
#pragma unroll
      for (int dt = 0; dt < 4; ++dt) {
        const int col = h * 64 + dt * 16 + gk * 4;
        const uint2 zz = *(const uint2*)(QK + mrow * LDQ + 2048 + col);
        const float z0 = bf2f(zz.x & 0xffff), z1 = bf2f(zz.x >> 16), z2 = bf2f(zz.y & 0xffff), z3 = bf2f(zz.y >> 16);
        uint2 ov;
        ov.x = pack2(o[cgi][dt][0] * inv * silu_f(z0), o[cgi][dt][1] * inv * silu_f(z1));
        ov.y = pack2(o[cgi][dt][2] * inv * silu_f(z2), o[cgi][dt][3] * inv * silu_f(z3));
        *(uint2*)(Y + mrow * DM + col) = ov;
      }
    }
  }
}

__device__ __forceinline__ void fox_knorm(const Params& p) {
  const u16* QK = (const u16*)(p.ws + WS_QK);
  uint32_t* km = (uint32_t*)(p.ws + WS_KMAX);
  const int tid = TIDX, lane = tid & 63, wave = tid >> 6;
  float mx = 0.f;
  for (int row = BIDX * 4 + wave; row < MTOK; row += gridDim.x * 4) {
    const uint4 v = *(const uint4*)(QK + (size_t)row * LDQ + 512 + lane * 8);
    const float a0 = bf2f(v.x & 0xffff), a1 = bf2f(v.x >> 16), a2 = bf2f(v.y & 0xffff), a3 = bf2f(v.y >> 16);
    const float a4 = bf2f(v.z & 0xffff), a5 = bf2f(v.z >> 16), a6 = bf2f(v.w & 0xffff), a7 = bf2f(v.w >> 16);
    float ss = a0 * a0 + a1 * a1 + a2 * a2 + a3 * a3 + a4 * a4 + a5 * a5 + a6 * a6 + a7 * a7;
    ss += __shfl_xor(ss, 1); ss += __shfl_xor(ss, 2); ss += __shfl_xor(ss, 4);
    mx = fmaxf(mx, ss);
  }
  if ((lane & 7) == 0) atomicMax(&km[lane >> 3], __float_as_uint(mx));
}

__device__ __forceinline__ void fox_scan(const Params& p, float* ldsf) {
  const float* fl = (const float*)(p.ws + WS_FLOG);
  float* cf = (float*)(p.ws + WS_CFOX);
  double* sd = (double*)ldsf;
  const int tid = TIDX;
  for (int bh = BIDX; bh < 32; bh += gridDim.x) {
    const int b = bh >> 3, h = bh & 7;
    const float bf = p.e_bf[h];
    float ls[32];
    double sum = 0.0;
#pragma unroll
    for (int i = 0; i < 32; ++i) {
      const float xx = fl[(size_t)(b * SEQ + tid * 32 + i) * 8 + h] + bf;
      ls[i] = fminf(xx, 0.f) - log1pf(__expf(-fabsf(xx)));
      sum += (double)ls[i];
    }
    __syncthreads();
    sd[tid] = sum;
    __syncthreads();
    double pre = 0.0;
    for (int j = 0; j < tid; ++j) pre += sd[j];
#pragma unroll
    for (int i = 0; i < 32; ++i) { pre += (double)ls[i]; cf[(size_t)bh * SEQ + tid * 32 + i] = (float)pre; }
  }
}

__device__ __forceinline__ void ret_stepA(const Params& p) {
  const u16* VT = (const u16*)(p.ws + WS_VT);
  float* dS = (float*)(p.ws + WS_DS);
  const int lane = TIDX & 63, w = TIDX >> 6, l16 = lane & 15, gk = lane >> 4;
  for (int u = BIDX; u < 2048; u += gridDim.x) {
    const int bh = u >> 6, n = u & 63, b = bh >> 3, h = bh & 7;
    const size_t mcol = (size_t)b * SEQ + n * 128;
    f32x4 acc[4];
#pragma unroll
    for (int dt = 0; dt < 4; ++dt) acc[dt] = (f32x4){0.f, 0.f, 0.f, 0.f};
#pragma unroll
    for (int ks = 0; ks < 4; ++ks) {
      bf16x8 af = *(const bf16x8*)(VT + (size_t)(512 + h * 64 + w * 16 + l16) * MTOK + mcol + ks * 32 + gk * 8);
#pragma unroll
      for (int dt = 0; dt < 4; ++dt) {
        bf16x8 bfr = *(const bf16x8*)(VT + (size_t)(1024 + h * 64 + dt * 16 + l16) * MTOK + mcol + ks * 32 + gk * 8);
        acc[dt] = MFMA(af, bfr, acc[dt]);
      }
    }
#pragma unroll
    for (int dt = 0; dt < 4; ++dt)
#pragma unroll
      for (int r = 0; r < 4; ++r) dS[(size_t)u * 4096 + (w * 16 + gk * 4 + r) * 64 + dt * 16 + l16] = acc[dt][r];
  }
}
__device__ __forceinline__ void ret_stepB(const Params& p) {
  const float* dS = (const float*)(p.ws + WS_DS);
  u16* st = (u16*)(p.ws + WS_ST);
  for (int idx = BIDX * 256 + TIDX; idx < 32 * 4096; idx += gridDim.x * 256) {
    const int bh = idx >> 12, ed = idx & 4095, h = bh & 7;
    const float cdec = __expf(log1pf(-exp2f(-5.f - (float)h)) * 128.f);
    float s = 0.f;
#pragma unroll 8
    for (int n = 0; n < 64; ++n) {
      const size_t a = (size_t)(bh * 64 + n) * 4096 + ed;
      st[a] = f2bf(s);
      s = s * cdec + dS[a];
    }
  }
}
__device__ __forceinline__ void ret_stepC(const Params& p, u16* lds) {
  const u16* QK = (const u16*)(p.ws + WS_QK);
  const u16* VT = (const u16*)(p.ws + WS_VT);
  const u16* st = (const u16*)(p.ws + WS_ST);
  u16* Y = (u16*)(p.ws + WS_Y);
  const int tid = TIDX, lane = tid & 63, w = tid >> 6, l16 = lane & 15, gk = lane >> 4;
  for (int u = BIDX; u < 2048; u += gridDim.x) {
    const int bh = u >> 6, n = u & 63, b = bh >> 3, h = bh & 7;
    const size_t m0 = (size_t)b * SEQ + n * 128;
    const float lg2 = log1pf(-exp2f(-5.f - (float)h)) * LOG2E;
    __syncthreads();
    {
      uint4 r0, r1;
      TILE_LD(r, QK + m0 * LDQ + 1536 + h * 64, LDQ); TILE_ST(lds, r);
      TILE_LD(r, VT + (size_t)(512 + h * 64) * MTOK + m0, MTOK); TILE_ST(lds + 64 * TS, r);
      TILE_LD(r, QK + (m0 + 64) * LDQ + 1536 + h * 64, LDQ); TILE_ST(lds + 128 * TS, r);
      TILE_LD(r, VT + (size_t)(512 + h * 64) * MTOK + m0 + 64, MTOK); TILE_ST(lds + 192 * TS, r);
      TILE_LD(r, st + (size_t)u * 4096, 64); TILE_ST(lds + 256 * TS, r);
    }
    __syncthreads();
#pragma unroll
    for (int cgi = 0; cgi < 2; ++cgi) {
      const int iq = 32 * w + cgi * 16 + l16;
      const size_t mrow = m0 + iq;
      bf16x8 q[2];
#pragma unroll
      for (int ks = 0; ks < 2; ++ks) q[ks] = *(const bf16x8*)(QK + mrow * LDQ + 1024 + h * 64 + ks * 32 + gk * 8);
      f32x4 o[4];
#pragma unroll
      for (int dt = 0; dt < 4; ++dt) o[dt] = (f32x4){0.f, 0.f, 0.f, 0.f};
#pragma unroll
      for (int dt = 0; dt < 4; ++dt)
#pragma unroll
        for (int ks = 0; ks < 2; ++ks) {
          bf16x8 sf = *(const bf16x8*)(lds + 256 * TS + (dt * 16 + l16) * TS + ks * 32 + gk * 8);
          o[dt] = MFMA(sf, q[ks], o[dt]);
        }
      const float cross = exp2f(lg2 * (float)(iq + 1));
#pragma unroll
      for (int dt = 0; dt < 4; ++dt) o[dt] *= cross;
#pragma unroll
      for (int k64 = 0; k64 < 2; ++k64) {
        if (k64 * 64 <= 32 * w + 31) {
          f32x4 s[4];
          qk_tile(lds + k64 * 128 * TS, q, s, l16, gk);
          float pp[4][4];
#pragma unroll
          for (int kt = 0; kt < 4; ++kt)
#pragma unroll
            for (int r = 0; r < 4; ++r) {
              const int j = k64 * 64 + kt * 16 + gk * 4 + r;
              pp[kt][r] = (j <= iq) ? s[kt][r] * 0.125f * ex2(lg2 * (float)(iq - j)) : 0.f;
            }
          pv_tile(lds + k64 * 128 * TS + 64 * TS, pp, o, l16, gk);
        }
      }
      float sm = 0.f;
#pragma unroll
      for (int dt = 0; dt < 4; ++dt) sm += o[dt][0] + o[dt][1] + o[dt][2] + o[dt][3];
      sm += __shfl_xor(sm, 16); sm += __shfl_xor(sm, 32);
      const float mu = sm * (1.f / 64.f);
      float vs = 0.f;
#pragma unroll
      for (int dt = 0; dt < 4; ++dt)
#pragma unroll
        for (int r = 0; r < 4; ++r) { const float d = o[dt][r] - mu; vs += d * d; }
      vs += __shfl_xor(vs, 16); vs += __shfl_xor(vs, 32);
      const float rstd = rsqrtf(vs * (1.f / 64.f) + 1e-5f);
#pragma unroll
      for (int dt = 0; dt < 4; ++dt) {
        const int col = h * 64 + dt * 16 + gk * 4;
        const float4 gg = *(const float4*)(p.e_gn + col);
        const uint2 zz = *(const uint2*)(QK + mrow * LDQ + 2048 + 512 + col);
        const float z0 = bf2f(zz.x & 0xffff), z1 = bf2f(zz.x >> 16), z2 = bf2f(zz.y & 0xffff), z3 = bf2f(zz.y >> 16);
        uint2 ov;
        ov.x = pack2((o[dt][0] - mu) * rstd * gg.x * silu_f(z0), (o[dt][1] - mu) * rstd * gg.y * silu_f(z1));
        ov.y = pack2((o[dt][2] - mu) * rstd * gg.z * silu_f(z2), (o[dt][3] - mu) * rstd * gg.w * silu_f(z3));
        *(uint2*)(Y + mrow * DM + 512 + col) = ov;
      }
    }
  }
}

template <int BR>
__device__ __forceinline__ void nsa_tile(const u16* sK, const u16* sV, const bf16x8 (&q)[4][2], f32x4 (&acc)[4][4],
                                         float (&m)[4], float (&l)[4], const float (&slope2)[4], const float (&gmul)[4],
                                         int t, int pos0, int pstride, int wl, bool lanesel,
                                         float* imp_row, int jbase, float& carry, int lane) {
  const int l16 = lane & 15, gk = lane >> 4;
  const float scale2 = 0.125f * LOG2E;
  float ps[4][4];
  if (BR == 1) {
#pragma unroll
    for (int kt = 0; kt < 4; ++kt)
#pragma unroll
      for (int r = 0; r < 4; ++r) ps[kt][r] = 0.f;
  }
  float fd[4][4], pen[4][4];
  const unsigned wle = lanesel ? (unsigned)wl : 0u;
#pragma unroll
  for (int kt = 0; kt < 4; ++kt)
#pragma unroll
    for (int r = 0; r < 4; ++r) {
      const int dist = t - (pos0 + (kt * 16 + gk * 4 + r) * pstride);
      fd[kt][r] = (float)dist;
      pen[kt][r] = ((unsigned)dist < wle) ? 0.f : -1e30f;
    }
#pragma unroll
  for (int cgi = 0; cgi < 4; ++cgi) {
    f32x4 s[4];
    qk_tile(sK, q[cgi], s, l16, gk);
    float xv[4][4];
    float mx = -1e30f;
#pragma unroll
    for (int kt = 0; kt < 4; ++kt)
#pragma unroll
      for (int r = 0; r < 4; ++r) {
        const float v = fmaf(s[kt][r], scale2, fmaf(-slope2[cgi], fd[kt][r], pen[kt][r]));
        xv[kt][r] = v; mx = fmaxf(mx, v);
      }
    if (BR != 1) {
      mx = fmaxf(mx, __shfl_xor(mx, 16)); mx = fmaxf(mx, __shfl_xor(mx, 32));
      const float mnew = fmaxf(m[cgi], mx);
      const float alpha = ex2(m[cgi] - mnew);
      m[cgi] = mnew;
      const float muse = fmaxf(mnew, -1e20f);
      float rs = 0.f;
#pragma unroll
      for (int kt = 0; kt < 4; ++kt)
#pragma unroll
        for (int r = 0; r < 4; ++r) { xv[kt][r] = ex2(xv[kt][r] - muse); rs += xv[kt][r]; }
      l[cgi] = l[cgi] * alpha + rs;
      if (BR == 2) {
#pragma unroll
        for (int dt = 0; dt < 4; ++dt) acc[cgi][dt] *= alpha;
        pv_tile(sV, xv, acc[cgi], l16, gk);
      }
    } else {
      const float muse = fmaxf(m[cgi], -1e20f);
#pragma unroll
      for (int kt = 0; kt < 4; ++kt)
#pragma unroll
        for (int r = 0; r < 4; ++r) {
          const float pn = ex2(xv[kt][r] - muse) * l[cgi];
          ps[kt][r] += pn;
          xv[kt][r] = pn * gmul[cgi];
        }
      pv_tile(sV, xv, acc[cgi], l16, gk);
    }
  }
  if (BR == 1) {
    const int srcl = (lane + 48) & 63;
#pragma unroll
    for (int kt = 0; kt < 4; ++kt) {
      const float same = __shfl(ps[kt][3], srcl);
      const float prev = __shfl(kt > 0 ? ps[kt > 0 ? kt - 1 : 0][3] : carry, srcl);
      const float pm1 = (gk == 0) ? prev : same;
      imp_row[jbase + kt * 4 + gk] = 2.f * (ps[kt][0] + ps[kt][1] + ps[kt][2]) + ps[kt][3] + pm1;
    }
    carry = ps[3][3];
  }
}

__device__ __forceinline__ void nsa_phase(const Params& p, u16* lds) {
  const u16* U = (const u16*)(p.ws + WS_QK);
  const u16* VT = (const u16*)(p.ws + WS_VT);
  const u16* KC = (const u16*)(p.ws + WS_KCMP);
  const u16* VC = (const u16*)(p.ws + WS_VCMPT);
  const float* GL = (const float*)(p.ws + WS_GL);
  u16* Y = (u16*)(p.ws + WS_Y);
  float* imp = (float*)(lds + 256 * TS);
  uint32_t* umask = (uint32_t*)(imp + 64 * IMPS);
  int* ulist = (int*)(umask + 4);
  const int tid = TIDX, lane = tid & 63, w = tid >> 6, l16 = lane & 15, gk = lane >> 4;
  uint2* totl = (uint2*)imp + (size_t)w * 1024 + lane;
  const int BIG = 1 << 30;
  for (int unit = BIDX; unit < 2048; unit += gridDim.x) {
    const int bg = unit & 15, qb = 127 - (unit >> 4), b = bg >> 2, g = bg & 3;
    const int t0 = qb * 64, t = t0 + 16 * w + l16;
    const size_t mrow = (size_t)b * SEQ + t;
    bf16x8 q[4][2];
    float slope2[4], g1[4];
#pragma unroll
    for (int cgi = 0; cgi < 4; ++cgi) {
      const int h = g * 4 + cgi;
#pragma unroll
      for (int ks = 0; ks < 2; ++ks) q[cgi][ks] = *(const bf16x8*)(U + mrow * LDQ + h * 64 + ks * 32 + gk * 8);
      slope2[cgi] = exp2f(-0.5f * (float)(h + 1)) * LOG2E;
      g1[cgi] = sigmoid_f(GL[mrow * 48 + h * 3] + p.o_bg[h * 3]);
    }
    f32x4 acc[4][4];
    float m[4], l[4];
#pragma unroll
    for (int cgi = 0; cgi < 4; ++cgi) {
      m[cgi] = -1e30f; l[cgi] = 0.f;
#pragma unroll
      for (int dt = 0; dt < 4; ++dt) acc[cgi][dt] = (f32x4){0.f, 0.f, 0.f, 0.f};
    }
    __syncthreads();
    for (int i = tid; i < 64 * IMPS; i += 256) imp[i] = 0.f;
    if (tid < 4) umask[tid] = 0u;
    float* imp_row = imp + (16 * w + l16) * IMPS;
    float carry = 0.f;
    uint4 rk0, rk1, rv0, rv1;
    const int ntc = ((4 * qb + 2) >> 6) + 1;
    const u16* kcs = KC + (size_t)bg * 512 * 64;
    const u16* vcs = VC + (size_t)bg * 32768;
#pragma unroll 1
    for (int pass = 0; pass < 2; ++pass) {
      TILE_LD(rk, kcs, 64); TILE_LD(rv, vcs, 512);
      __syncthreads();
      TILE_ST(lds, rk); TILE_ST(lds + 64 * TS, rv);
      __syncthreads();
#pragma unroll 1
      for (int i = 0; i < ntc; ++i) {
        u16* cur = lds + (i & 1) * (128 * TS);
        const bool more = (i + 1 < ntc);
        if (more) { TILE_LD(rk, kcs + (size_t)(i + 1) * 64 * 64, 64); TILE_LD(rv, vcs + (i + 1) * 64, 512); }
        if (pass == 0) nsa_tile<0>(cur, cur + 64 * TS, q, acc, m, l, slope2, g1, t, 16 * (64 * i) + 31, 16, BIG, true, imp_row, 16 * i, carry, lane);
        else nsa_tile<1>(cur, cur + 64 * TS, q, acc, m, l, slope2, g1, t, 16 * (64 * i) + 31, 16, BIG, true, imp_row, 16 * i, carry, lane);
        if (more) { u16* nxt = lds + ((i + 1) & 1) * (128 * TS); TILE_ST(nxt, rk); TILE_ST(nxt + 64 * TS, rv); }
        __syncthreads();
      }
      if (pass == 0) {
#pragma unroll
        for (int cgi = 0; cgi < 4; ++cgi) {
          float lt = l[cgi]; lt += __shfl_xor(lt, 16); lt += __shfl_xor(lt, 32);
          l[cgi] = lt > 0.f ? 1.f / lt : 0.f;
        }
      }
    }
    uint32_t selm = 0u;
    if (qb < 16) {
      if (gk == 0) selm = (1u << (qb + 1)) - 1u;
    } else {
      float val[32];
#pragma unroll
      for (int i4 = 0; i4 < 8; ++i4) {
        const float4 v4 = *(const float4*)(imp_row + 32 * gk + 4 * i4);
        val[4 * i4] = v4.x; val[4 * i4 + 1] = v4.y; val[4 * i4 + 2] = v4.z; val[4 * i4 + 3] = v4.w;
      }
#pragma unroll
      for (int i = 0; i < 32; ++i) {
        const int j = 32 * gk + i;
        const bool forced = (j == 0) || (j == qb) || (j == qb - 1);
        if (forced) selm |= (1u << i);
        if (forced || j > qb) val[i] = -1.f;
      }
#pragma unroll 1
      for (int it = 0; it < 13; ++it) {
        float best = -2.f; int bj = 0;
#pragma unroll
        for (int i = 0; i < 32; ++i) {
          const float v = ((selm >> i) & 1u) ? -1.f : val[i];
          if (v > best) { best = v; bj = 32 * gk + i; }
        }
#pragma unroll
        for (int o = 16; o <= 32; o <<= 1) {
          const float ov = __shfl_xor(best, o); const int oj = __shfl_xor(bj, o);
          if (ov > best || (ov == best && oj < bj)) { best = ov; bj = oj; }
        }
        if ((bj >> 5) == gk) selm |= (1u << (bj & 31));
      }
    }
    const uint32_t sel0 = __shfl(selm, l16), sel1 = __shfl(selm, l16 + 16), sel2 = __shfl(selm, l16 + 32), sel3 = __shfl(selm, l16 + 48);
    uint32_t wu = selm;
#pragma unroll
    for (int o = 1; o <= 8; o <<= 1) wu |= __shfl_xor(wu, o);
    const uint32_t wun0 = __shfl(wu, 0), wun1 = __shfl(wu, 16), wun2 = __shfl(wu, 32), wun3 = __shfl(wu, 48);
    if (l16 == 0) atomicOr(&umask[gk], wu);
    __syncthreads();
    int nsl = 0;
    {
      const uint32_t u0 = umask[0], u1 = umask[1], u2 = umask[2], u3 = umask[3];
      nsl = __popc(u0) + __popc(u1) + __popc(u2) + __popc(u3);
      if (tid < 128) {
        const uint32_t uw = tid < 32 ? u0 : tid < 64 ? u1 : tid < 96 ? u2 : u3;
        if ((uw >> (tid & 31)) & 1u) {
          int pos = __popc(uw & ((1u << (tid & 31)) - 1u));
          if (tid >= 32) pos += __popc(u0);
          if (tid >= 64) pos += __popc(u1);
          if (tid >= 96) pos += __popc(u2);
          ulist[pos] = tid;
        }
      }
    }
    __syncthreads();
#pragma unroll
    for (int cgi = 0; cgi < 4; ++cgi)
#pragma unroll
      for (int dt = 0; dt < 4; ++dt) {
        uint2 o2; o2.x = pack2(acc[cgi][dt][0], acc[cgi][dt][1]); o2.y = pack2(acc[cgi][dt][2], acc[cgi][dt][3]);
        totl[(cgi * 4 + dt) * 64] = o2;
      }
#pragma unroll 1
    for (int br = 1; br < 3; ++br) {
#pragma unroll
      for (int cgi = 0; cgi < 4; ++cgi) {
        m[cgi] = -1e30f; l[cgi] = 0.f;
#pragma unroll
        for (int dt = 0; dt < 4; ++dt) acc[cgi][dt] = (f32x4){0.f, 0.f, 0.f, 0.f};
      }
      const int i0w = (qb >= 8) ? 0 : 8 - qb;
      const int nt = (br == 1) ? nsl : 9 - i0w;
      const u16* kb = U + (size_t)b * SEQ * LDQ + (br == 1 ? 1536 : 1792) + g * 64;
      const u16* vb = VT + (size_t)((br == 1 ? 0 : 256) + g * 64) * MTOK + (size_t)b * SEQ;
      int s0 = (br == 1) ? ulist[0] * 64 : t0 - 512 + 64 * i0w;
      TILE_LD(rk, kb + (size_t)s0 * LDQ, LDQ); TILE_LD(rv, vb + s0, MTOK);
      __syncthreads();
      TILE_ST(lds, rk); TILE_ST(lds + 64 * TS, rv);
      __syncthreads();
#pragma unroll 1
      for (int i = 0; i < nt; ++i) {
        u16* cur = lds + (i & 1) * (128 * TS);
        const bool more = (i + 1 < nt);
        int s1 = 0;
        if (more) {
          s1 = (br == 1) ? ulist[i + 1] * 64 : s0 + 64;
          TILE_LD(rk, kb + (size_t)s1 * LDQ, LDQ); TILE_LD(rv, vb + s1, MTOK);
        }
        bool wsel = true, ls = true;
        int wl = 512;
        if (br == 1) {
          const int j = s0 >> 6, jw = j >> 5, jb = j & 31;
          const uint32_t ww = jw == 0 ? wun0 : jw == 1 ? wun1 : jw == 2 ? wun2 : wun3;
          const uint32_t sw = jw == 0 ? sel0 : jw == 1 ? sel1 : jw == 2 ? sel2 : sel3;
          wsel = (ww >> jb) & 1u; ls = (sw >> jb) & 1u; wl = BIG;
        }
        if (wsel) nsa_tile<2>(cur, cur + 64 * TS, q, acc, m, l, slope2, g1, t, s0, 1, wl, ls, imp_row, 0, carry, lane);
        if (more) { u16* nxt = lds + ((i + 1) & 1) * (128 * TS); TILE_ST(nxt, rk); TILE_ST(nxt + 64 * TS, rv); }
        s0 = s1;
        __syncthreads();
      }
#pragma unroll
      for (int cgi = 0; cgi < 4; ++cgi) {
        const int h = g * 4 + cgi;
        float lt = l[cgi]; lt += __shfl_xor(lt, 16); lt += __shfl_xor(lt, 32);
        const float gt = sigmoid_f(GL[mrow * 48 + h * 3 + br] + p.o_bg[h * 3 + br]);
        const float sc = lt > 0.f ? gt / lt : 0.f;
#pragma unroll
        for (int dt = 0; dt < 4; ++dt) {
          const uint2 pv = totl[(cgi * 4 + dt) * 64];
          const float r0 = bf2f(pv.x & 0xffff) + acc[cgi][dt][0] * sc, r1 = bf2f(pv.x >> 16) + acc[cgi][dt][1] * sc;
          const float r2 = bf2f(pv.y & 0xffff) + acc[cgi][dt][2] * sc, r3 = bf2f(pv.y >> 16) + acc[cgi][dt][3] * sc;
          if (br == 1) {
            uint2 o2; o2.x = pack2(r0, r1); o2.y = pack2(r2, r3);
            totl[(cgi * 4 + dt) * 64] = o2;
          } else {
            const int col = h * 64 + dt * 16 + gk * 4;
            const uint2 zz = *(const uint2*)(U + mrow * LDQ + 2048 + col);
            const float z0 = bf2f(zz.x & 0xffff), z1 = bf2f(zz.x >> 16), z2 = bf2f(zz.y & 0xffff), z3 = bf2f(zz.y >> 16);
            uint2 ov;
            ov.x = pack2(r0 * silu_f(z0), r1 * silu_f(z1));
            ov.y = pack2(r2 * silu_f(z2), r3 * silu_f(z3));
            *(uint2*)(Y + mrow * DM + col) = ov;
          }
        }
      }
    }
  }
}

__device__ __forceinline__ void final_norm(const Params& p) {
  const int lane = TIDX & 63, wave = TIDX >> 6;
  for (int row = BIDX * 4 + wave; row < MTOK; row += gridDim.x * 4) {
    float4* xr = (float4*)(p.out + (size_t)row * DM);
    float4 v[4];
    float ss = 0.f;
#pragma unroll
    for (int i = 0; i < 4; ++i) {
      v[i] = xr[lane + 64 * i];
      ss += v[i].x * v[i].x + v[i].y * v[i].y + v[i].z * v[i].z + v[i].w * v[i].w;
    }
#pragma unroll
    for (int o = 32; o >= 1; o >>= 1) ss += __shfl_xor(ss, o);
    const float rstd = rsqrtf(ss * (1.f / DM) + 1e-6f);
#pragma unroll
    for (int i = 0; i < 4; ++i) {
      const float4 gg = ((const float4*)p.fin_g)[lane + 64 * i];
      xr[lane + 64 * i] = (float4){v[i].x * rstd * gg.x, v[i].y * rstd * gg.y, v[i].z * rstd * gg.z, v[i].w * rstd * gg.w};
    }
  }
}

__device__ __forceinline__ void grid_bar(const Params& p, unsigned& target) {
  __syncthreads();
  target += gridDim.x;
  if (TIDX == 0) {
    unsigned* ctr = (unsigned*)(p.ws + WS_BAR);
    __threadfence();
    __hip_atomic_fetch_add(ctr, 1u, __ATOMIC_RELAXED, __HIP_MEMORY_SCOPE_AGENT);
    while (__hip_atomic_load(ctr, __ATOMIC_RELAXED, __HIP_MEMORY_SCOPE_AGENT) < target) __builtin_amdgcn_s_sleep(1);
    __threadfence();
  }
  __syncthreads();
}

__global__ void __launch_bounds__(256, 1) mega(Params p_in) {
  Params p = p_in;
  p.pad = __builtin_amdgcn_readfirstlane((int)threadIdx.x >> 6);
  unsigned bar_target = 0u;
  extern __shared__ __attribute__((aligned(16))) unsigned char lds_raw[];
  u16* lds = (u16*)lds_raw;
  cg::grid_group grid = cg::this_grid();
  if (p_in.coop == 2) grid.sync();
#define PH_ON(k) (p.ph_lo <= (k) && (k) <= p.ph_hi)
#define PH_SYNC(k) if (p.coop && p.ph_lo <= (k) && (k) < p.ph_hi) grid_bar(p, bar_target);
  if (PH_ON(0)) {
    rms_rows(p, p.x, p.e_ng, (u16*)(p.ws + WS_HBF));
    conv_t(p, (u16*)(p.ws + WS_WT0), p.e_win, 1024, 4104, 4224, 0);
    conv_t(p, (u16*)(p.ws + WS_WT1), p.o_win, 1024, 3632, 3712, 1);
    conv_t(p, (u16*)(p.ws + WS_WO0), p.e_wout, 1024, 1024, 1024, 2);
    conv_t(p, (u16*)(p.ws + WS_WO1), p.o_wout, 1024, 1024, 1024, 2);
    conv_t(p, (u16*)(p.ws + WS_W1K), p.o_wk1, 2048, 256, 256, 2);
    conv_t(p, (u16*)(p.ws + WS_W1V), p.o_wv1, 2048, 256, 256, 2);
    conv_t(p, (u16*)(p.ws + WS_W2K), p.o_wk2, 256, 64, 128, 2);
    conv_t(p, (u16*)(p.ws + WS_W2V), p.o_wv2, 256, 64, 128, 2);
    pe_partial(p);
    if (BIDX == 0 && TIDX < 8) ((uint32_t*)(p.ws + WS_KMAX))[TIDX] = 0u;
  }
  PH_SYNC(0)
  if (PH_ON(1)) gemm_inproj(p, 0, lds);
  PH_SYNC(1)
  if (PH_ON(2)) { fox_scan(p, (float*)lds); ret_stepA(p); fox_knorm(p); }
  PH_SYNC(2)
  if (PH_ON(3)) { ret_stepB(p); fox_phase(p, lds); }
  PH_SYNC(3)
  if (PH_ON(4)) ret_stepC(p, lds);
  PH_SYNC(4)
  if (PH_ON(5)) gemm_outproj(p, 0, lds);
  PH_SYNC(5)
  if (PH_ON(6)) {
    rms_rows(p, p.out, p.o_ng, (u16*)(p.ws + WS_HBF));
    if (BIDX == 0) {
      for (int i = TIDX; i < 512; i += 256) {
        const float* part = (const float*)(p.ws + WS_PEP);
        float s = 0.f;
        for (int kc = 0; kc < 16; ++kc) s += part[((i >> 8) * 16 + kc) * 256 + (i & 255)];
        ((float*)(p.ws + WS_PEB))[i] = s;
      }
    }
  }
  PH_SYNC(6)
  if (PH_ON(7)) gemm_inproj(p, 1, lds);
  PH_SYNC(7)
  if (PH_ON(8)) gemm_cmp1(p, lds);
  PH_SYNC(8)
  if (PH_ON(9)) gemm_cmp2(p, lds);
  PH_SYNC(9)
  if (PH_ON(10)) nsa_phase(p, lds);
  PH_SYNC(10)
  if (PH_ON(11)) gemm_outproj(p, 1, lds);
  PH_SYNC(11)
  if (PH_ON(12)) final_norm(p);
}

extern "C" void kernel_launch(void* const* d_in, const int* in_sizes, int n_in, void* d_out, int out_size, void* d_ws,
                              size_t ws_size, hipStream_t stream) {
  static int grid_blocks = 0;
  if (!grid_blocks) {
    int dev = 0, cus = 0, per_cu = 0;
    hipGetDevice(&dev);
    hipDeviceGetAttribute(&cus, hipDeviceAttributeMultiprocessorCount, dev);
    hipFuncSetAttribute((const void*)mega, hipFuncAttributeMaxDynamicSharedMemorySize, LDS_BYTES);
    hipOccupancyMaxActiveBlocksPerMultiprocessor(&per_cu, (const void*)mega, 256, LDS_BYTES);
    if (per_cu < 1) per_cu = 1;
    if (per_cu > 2) per_cu = 2;
    grid_blocks = cus * per_cu;
    (void)hipGetLastError();
  }
  Params p{};
  p.x = (const float*)d_in[0]; p.e_ng = (const float*)d_in[1]; p.e_win = (const float*)d_in[2];
  p.e_bf = (const float*)d_in[3]; p.e_gn = (const float*)d_in[4]; p.e_wout = (const float*)d_in[5];
  p.o_ng = (const float*)d_in[6]; p.o_win = (const float*)d_in[7]; p.o_bg = (const float*)d_in[8];
  p.o_pek = (const float*)d_in[9]; p.o_pev = (const float*)d_in[10]; p.o_wk1 = (const float*)d_in[11];
  p.o_wk2 = (const float*)d_in[12]; p.o_wv1 = (const float*)d_in[13]; p.o_wv2 = (const float*)d_in[14];
  p.o_wout = (const float*)d_in[15]; p.fin_g = (const float*)d_in[16];
  p.out = (float*)d_out; p.ws = (unsigned char*)d_ws;
#if ONE_LAUNCH
  p.ph_lo = 0; p.ph_hi = NPHASE - 1; p.coop = 1;
  (void)hipMemsetAsync((unsigned char*)d_ws + WS_BAR, 0, 64, stream);
  void* args[] = {&p};
  hipError_t e = hipLaunchCooperativeKernel((const void*)mega, dim3(grid_blocks), dim3(256), args, LDS_BYTES, stream);
  if (e != hipSuccess) fprintf(stderr, "cooperative launch failed: %s (grid %d)\n", hipGetErrorString(e), grid_blocks);
#else
  for (int ph = 0; ph < NPHASE; ++ph) {
    p.ph_lo = ph; p.ph_hi = ph; p.coop = 0;
    hipLaunchKernelGGL(mega, dim3(grid_blocks), dim3(256), LDS_BYTES, stream, p);
  }
#endif
}
```

```cpp
#include <hip/hip_runtime.h>
#include <hip/hip_cooperative_groups.h>
#include <stdint.h>
#include <stdio.h>
namespace cg = cooperative_groups;

typedef unsigned short u16;
typedef short bf16x8 __attribute__((ext_vector_type(8)));
typedef short bf16x4 __attribute__((ext_vector_type(4)));
typedef float f32x4 __attribute__((ext_vector_type(4)));

#ifndef ONE_LAUNCH
#define ONE_LAUNCH 1
#endif

#define MTOK 32768
#define SEQ 8192
#define DM 1024
#define LDQ 3072
#define LOG2E 1.4426950408889634f
#define TS 72
#define IMPS 132
#define LDS_BYTES 147456
#define NTHR 512
#define NWAVE 8
#define NPHASE 13

#define MiB (1024ull * 1024ull)
#define WS_HBF   (0ull)
#define WS_DS    (0ull)
#define WS_ST    (32ull * MiB)
#define WS_QK    (64ull * MiB)
#define WS_VT    (256ull * MiB)
#define WS_Y     (352ull * MiB)
#define WS_WT0   (416ull * MiB)
#define WS_WT1   (WS_WT0 + 4352ull * 1024 * 2)
#define WS_WO0   (WS_WT1 + 3840ull * 1024 * 2)
#define WS_WO1   (WS_WO0 + 1024ull * 1024 * 2)
#define WS_W1K   (WS_WO1 + 1024ull * 1024 * 2)
#define WS_W1V   (WS_W1K + 256ull * 2048 * 2)
#define WS_W2K   (WS_W1V + 256ull * 2048 * 2)
#define WS_W2V   (WS_W2K + 256ull * 256 * 2)
#define WS_FLOG  (440ull * MiB)
#define WS_CFOX  (441ull * MiB)
#define WS_GL    (442ull * MiB)
#define WS_HC    (448ull * MiB)
#define WS_KCMP  (456ull * MiB)
#define WS_VCMPT (457ull * MiB)
#define WS_PEP   (458ull * MiB)
#define WS_PEB   (WS_PEP + 65536ull)
#define WS_KMAX  (WS_PEB + 4096ull)
#define WS_BAR   (WS_KMAX + 4096ull)

struct Params {
  const float *x, *e_ng, *e_win, *e_bf, *e_gn, *e_wout;
  const float *o_ng, *o_win, *o_bg, *o_pek, *o_pev, *o_wk1, *o_wk2, *o_wv1, *o_wv2, *o_wout, *fin_g;
  float* out;
  unsigned char* ws;
  int ph_lo, ph_hi, coop, pad;
};

typedef __bf16 bf16v2 __attribute__((ext_vector_type(2)));
typedef float f32v2 __attribute__((ext_vector_type(2)));
__device__ __forceinline__ uint32_t pack2(float a, float b) {
  f32v2 v = {a, b};
  bf16v2 r = __builtin_convertvector(v, bf16v2);
  return *(uint32_t*)&r;
}
__device__ __forceinline__ u16 f2bf(float f) { return (u16)(pack2(f, 0.f) & 0xffffu); }
__device__ __forceinline__ float bf2f(u16 h) { return __uint_as_float(((uint32_t)h) << 16); }
__device__ __forceinline__ float ex2(float x) { return __builtin_amdgcn_exp2f(x); }
__device__ __forceinline__ float silu_f(float z) { return z * __builtin_amdgcn_rcpf(1.f + ex2(-z * LOG2E)); }
__device__ __forceinline__ float sigmoid_f(float z) { return __builtin_amdgcn_rcpf(1.f + ex2(-z * LOG2E)); }

__device__ __forceinline__ int opq(int v) { asm volatile("" : "+v"(v)); return v; }
__device__ __forceinline__ int opqs(int v) { asm volatile("" : "+s"(v)); return v; }
#define TIDX opq(p.pad * 64 + (int)__lane_id())
#define BIDX opqs((int)blockIdx.x)
#define MFMA(a, b, c) __builtin_amdgcn_mfma_f32_16x16x32_bf16((a), (b), (c), 0, 0, 0)

__device__ __forceinline__ void rms_rows(const Params& p, const float* __restrict__ x, const float* __restrict__ g, u16* __restrict__ h) {
  const int lane = TIDX & 63, wave = TIDX >> 6;
  for (int row = BIDX * NWAVE + wave; row < MTOK; row += gridDim.x * NWAVE) {
    const float4* xr = (const float4*)(x + (size_t)row * DM);
    float4 v[4];
    float ss = 0.f;
#pragma unroll
    for (int i = 0; i < 4; ++i) {
      v[i] = xr[lane + 64 * i];
      ss += v[i].x * v[i].x + v[i].y * v[i].y + v[i].z * v[i].z + v[i].w * v[i].w;
    }
#pragma unroll
    for (int o = 32; o >= 1; o >>= 1) ss += __shfl_xor(ss, o);
    const float rstd = rsqrtf(ss * (1.f / DM) + 1e-6f);
#pragma unroll
    for (int i = 0; i < 4; ++i) {
      float4 gg = ((const float4*)g)[lane + 64 * i];
      uint2 o;
      o.x = pack2(v[i].x * rstd * gg.x, v[i].y * rstd * gg.y);
      o.y = pack2(v[i].z * rstd * gg.z, v[i].w * rstd * gg.w);
      *(uint2*)(h + (size_t)row * DM + (lane + 64 * i) * 4) = o;
    }
  }
}

__device__ __forceinline__ int map_col(int MAP, int n) {
  if (MAP == 0) {
    if (n < 1024) return n;
    if (n < 2048) return n + 520;
    if (n < 3072) return n + 1032;
    if (n < 3584) return n - 2048;
    if (n < 4096) return n - 1016;
    if (n < 4104) return n - 2560;
    return -1;
  } else if (MAP == 1) {
    if (n < 1792) return n;
    if (n < 2048) return n + 256;
    if (n < 3072) return n + 560;
    if (n < 3328) return n - 1280;
    if (n < 3584) return n - 1024;
    if (n < 3632) return n - 1024;
    return -1;
  } else if (MAP == 2) {
    return n;
  }
  return n;
}

__device__ __forceinline__ void conv_t(const Params& p, u16* __restrict__ dst, const float* __restrict__ src, int K, int nsrc, int ndst, int MAP) {
  const int total = ndst * (K >> 3);
  for (int id = BIDX * NTHR + TIDX; id < total; id += gridDim.x * NTHR) {
    const int n = id % ndst, kc = id / ndst;
    const int sc = map_col(MAP, n);
    float v[8];
#pragma unroll
    for (int i = 0; i < 8; ++i) v[i] = (sc >= 0 && sc < nsrc) ? src[(size_t)(kc * 8 + i) * nsrc + sc] : 0.f;
    uint4 o;
    o.x = pack2(v[0], v[1]); o.y = pack2(v[2], v[3]); o.z = pack2(v[4], v[5]); o.w = pack2(v[6], v[7]);
    *(uint4*)(dst + (size_t)n * K + kc * 8) = o;
  }
}

__device__ __forceinline__ void pe_partial(const Params& p) {
  float* part = (float*)(p.ws + WS_PEP);
  for (int task = BIDX; task < 32; task += gridDim.x) {
    const int kv = task >> 4, kc = task & 15, n = TIDX;
    if (n >= 256) continue;
    const float* pe = kv ? p.o_pev : p.o_pek;
    const float* w1 = kv ? p.o_wv1 : p.o_wk1;
    float acc = 0.f;
#pragma unroll 16
    for (int k = kc * 128; k < kc * 128 + 128; ++k) acc += pe[k] * w1[(size_t)k * 256 + n];
    part[(kv * 16 + kc) * 256 + n] = acc;
  }
}

#define GST (512 * TS)
template <bool swapped>
__device__ __forceinline__ void gemm_compute(const u16* cur, f32x4 (&acc)[8][4], int wpa, int wpb, int l16, int gk) {
  const u16* sA = cur + (wpa * 128 + l16) * TS + gk * 8;
  const u16* sB = cur + (256 + wpb * 64 + l16) * TS + gk * 8;
#pragma unroll 1
  for (int kk = 0; kk < 2; ++kk) {
    bf16x8 fa[8], fb[4];
#pragma unroll
    for (int i = 0; i < 8; ++i) fa[i] = *(const bf16x8*)(sA + i * 16 * TS + kk * 32);
#pragma unroll
    for (int j = 0; j < 4; ++j) fb[j] = *(const bf16x8*)(sB + j * 16 * TS + kk * 32);
    if (swapped) {
#pragma unroll
      for (int i = 0; i < 8; ++i)
#pragma unroll
        for (int j = 0; j < 4; ++j) acc[i][j] = MFMA(fb[j], fa[i], acc[i][j]);
    } else {
#pragma unroll
      for (int i = 0; i < 8; ++i)
#pragma unroll
        for (int j = 0; j < 4; ++j) acc[i][j] = MFMA(fa[i], fb[j], acc[i][j]);
    }
  }
}
template <bool swapped>
__device__ __forceinline__ void gemm_mainloop(const Params& p, const u16* __restrict__ Ab, const uint32_t (&pa)[4], const u16* __restrict__ Bb,
                                              const uint32_t (&pb)[4], int a_kstride, int nk,
                                              u16* lds, f32x4 (&acc)[8][4]) {
  const int tid = TIDX, lane = tid & 63, wave = tid >> 6;
  const int l16 = lane & 15, gk = lane >> 4;
  const int wpa = wave >> 2, wpb = wave & 3;
  const int woff = (tid >> 3) * TS + (tid & 7) * 8;
  uint4 ra0, ra1, ra2, ra3, rb0, rb1, rb2, rb3;
#define G_LD(kidx) { const u16* Ap_ = Ab + (size_t)(kidx) * a_kstride; const u16* Bp_ = Bb + (size_t)(kidx) * 64;   \
    ra0 = *(const uint4*)(Ap_ + pa[0]); ra1 = *(const uint4*)(Ap_ + pa[1]); ra2 = *(const uint4*)(Ap_ + pa[2]); ra3 = *(const uint4*)(Ap_ + pa[3]); \
    rb0 = *(const uint4*)(Bp_ + pb[0]); rb1 = *(const uint4*)(Bp_ + pb[1]); rb2 = *(const uint4*)(Bp_ + pb[2]); rb3 = *(const uint4*)(Bp_ + pb[3]); }
#define G_ST(D) { u16* D_ = (D) + woff;                                                                               \
    *(uint4*)(D_) = ra0; *(uint4*)(D_ + 64 * TS) = ra1; *(uint4*)(D_ + 128 * TS) = ra2; *(uint4*)(D_ + 192 * TS) = ra3;  \
    *(uint4*)(D_ + 256 * TS) = rb0; *(uint4*)(D_ + 320 * TS) = rb1; *(uint4*)(D_ + 384 * TS) = rb2; *(uint4*)(D_ + 448 * TS) = rb3; }
  G_LD(0)
  __syncthreads();
  G_ST(lds)
  __syncthreads();
#pragma unroll
  for (int i = 0; i < 8; ++i)
#pragma unroll
    for (int j = 0; j < 4; ++j) acc[i][j] = (f32x4){0.f, 0.f, 0.f, 0.f};
#pragma unroll 1
  for (int ks = 0; ks < nk; ++ks) {
    const bool more = (ks + 1 < nk);
    if (more) G_LD(ks + 1)
    gemm_compute<swapped>(lds + (ks & 1) * GST, acc, wpa, wpb, l16, gk);
    if (more) G_ST(lds + ((ks + 1) & 1) * GST)
    __syncthreads();
  }
#undef G_LD
#undef G_ST
}
#define GEMM_OFFS(rowstrideA, rowstrideB)                                   \
  uint32_t pa[4], pb[4];                                                    \
  _Pragma("unroll") for (int i = 0; i < 4; ++i) {                           \
    pa[i] = (uint32_t)((tid >> 3) + 64 * i) * (rowstrideA) + (tid & 7) * 8; \
    pb[i] = (uint32_t)((tid >> 3) + 64 * i) * (rowstrideB) + (tid & 7) * 8; \
  }

__device__ __forceinline__ void gemm_inproj(const Params& p, int layer, u16* lds) {
  const u16* A = (const u16*)(p.ws + WS_HBF);
  const u16* Bt = (const u16*)(p.ws + (layer ? WS_WT1 : WS_WT0));
  u16* QK = (u16*)(p.ws + WS_QK);
  u16* VT = (u16*)(p.ws + WS_VT);
  float* F = (float*)(p.ws + (layer ? WS_GL : WS_FLOG));
  const int NT = layer ? 15 : 17;
  const int seg_trans_end = layer ? 28 : 32;
  const int nvalidF = layer ? 48 : 8, ldf = layer ? 48 : 8;
  const int tid = TIDX, lane = tid & 63, wave = tid >> 6, l16 = lane & 15, gk = lane >> 4;
  const int wpa = wave >> 2, wpb = wave & 3;
  const int bid = BIDX, xcd = bid & 7, nloc = (int)gridDim.x >> 3;
  for (int q = bid >> 3; q < 16 * NT; q += nloc) {
    const int mt = xcd * 16 + q / NT, nt = q % NT;
    const int m0 = mt * 256, n0 = nt * 256;
    const int mw = m0 + wpa * 128, nw = n0 + wpb * 64;
    const int seg = nw >> 7;
    int mode;
    if (seg < 24) mode = (layer == 0 && seg >= 12 && seg < 16) ? 2 : 0;
    else if (seg < seg_trans_end) mode = 1;
    else if (seg == seg_trans_end) mode = 3;
    else mode = 4;
    const int seg0 = nt * 2;
    const bool swapped = !((seg0 >= 24 && seg0 < seg_trans_end) || (layer == 0 && seg0 >= 12 && seg0 < 16));
    GEMM_OFFS(DM, DM)
    f32x4 acc[8][4];
    if (swapped) gemm_mainloop<true>(p, A + (size_t)m0 * DM, pa, Bt + (size_t)n0 * DM, pb, 64, 16, lds, acc);
    else gemm_mainloop<false>(p, A + (size_t)m0 * DM, pa, Bt + (size_t)n0 * DM, pb, 64, 16, lds, acc);
    if (mode == 0 || mode == 3) {
#pragma unroll
      for (int i = 0; i < 8; ++i)
#pragma unroll
        for (int j = 0; j < 4; ++j) {
          const int n = nw + j * 16 + gk * 4;
          const int m = mw + i * 16 + l16;
          if (mode == 0) {
            uint2 o; o.x = pack2(acc[i][j][0], acc[i][j][1]); o.y = pack2(acc[i][j][2], acc[i][j][3]);
            *(uint2*)(QK + (size_t)m * LDQ + n) = o;
          } else {
            const int nn = n - seg * 128;
            if (nn < nvalidF) *(float4*)(F + (size_t)m * ldf + nn) = (float4){acc[i][j][0], acc[i][j][1], acc[i][j][2], acc[i][j][3]};
          }
        }
    } else if (mode == 1 || mode == 2) {
#pragma unroll
      for (int i = 0; i < 8; ++i)
#pragma unroll
        for (int j = 0; j < 4; ++j) {
          const int m = mw + i * 16 + gk * 4;
          const int n = nw + j * 16 + l16;
          if (mode == 1) {
            const int trow = n - 3072;
            uint2 o; o.x = pack2(acc[i][j][0], acc[i][j][1]); o.y = pack2(acc[i][j][2], acc[i][j][3]);
            *(uint2*)(VT + (size_t)trow * MTOK + m) = o;
          } else {
            const int trow = n - 512;
            const int h = (nw - 1536) >> 6;
            const float lg2 = log1pf(-exp2f(-5.f - (float)h)) * LOG2E;
            const float lane_dec = 0.125f * ex2(lg2 * (float)(127 - gk * 4));
            float sv[4];
#pragma unroll
            for (int r = 0; r < 4; ++r) {
              QK[(size_t)(m + r) * LDQ + n] = f2bf(acc[i][j][r]);
              sv[r] = acc[i][j][r] * lane_dec * ex2(lg2 * (float)(-(i * 16 + r)));
            }
            uint2 o; o.x = pack2(sv[0], sv[1]); o.y = pack2(sv[2], sv[3]);
            *(uint2*)(VT + (size_t)trow * MTOK + m) = o;
          }
        }
    }
  }
}

__device__ __forceinline__ void gemm_outproj(const Params& p, int layer, u16* lds) {
  const u16* A = (const u16*)(p.ws + WS_Y);
  const u16* Bt = (const u16*)(p.ws + (layer ? WS_WO1 : WS_WO0));
  const float* res = layer ? p.out : p.x;
  float* out = p.out;
  const int tid = TIDX, lane = tid & 63, wave = tid >> 6, l16 = lane & 15, gk = lane >> 4;
  const int wpa = wave >> 2, wpb = wave & 3;
  const int bid = BIDX, xcd = bid & 7, nloc = (int)gridDim.x >> 3;
  for (int q = bid >> 3; q < 16 * 4; q += nloc) {
    const int mt = xcd * 16 + (q >> 2), nt = q & 3;
    const int m0 = mt * 256, n0 = nt * 256;
    GEMM_OFFS(DM, DM)
    f32x4 acc[8][4];
    gemm_mainloop<true>(p, A + (size_t)m0 * DM, pa, Bt + (size_t)n0 * DM, pb, 64, 16, lds, acc);
    const int mw = m0 + wpa * 128, nw = n0 + wpb * 64;
#pragma unroll
    for (int i = 0; i < 8; ++i)
#pragma unroll
      for (int j = 0; j < 4; ++j) {
        const int n = nw + j * 16 + gk * 4;
        const int m = mw + i * 16 + l16;
        const float4 r = *(const float4*)(res + (size_t)m * DM + n);
        *(float4*)(out + (size_t)m * DM + n) = (float4){r.x + acc[i][j][0], r.y + acc[i][j][1], r.z + acc[i][j][2], r.w + acc[i][j][3]};
      }
  }
}

__device__ __forceinline__ void gemm_cmp1(const Params& p, u16* lds) {
  const u16* U = (const u16*)(p.ws + WS_QK);
  const float* peb = (const float*)(p.ws + WS_PEB);
  const int tid = TIDX, lane = tid & 63, wave = tid >> 6, l16 = lane & 15, gk = lane >> 4;
  const int wpa = wave >> 2, wpb = wave & 3;
  for (int tile = BIDX; tile < 64; tile += gridDim.x) {
    const int kv = tile >> 5, mt = tile & 31;
    const int m0 = mt * 256;
    const u16* Bt = (const u16*)(p.ws + (kv ? WS_W1V : WS_W1K));
    u16* Hc = (u16*)(p.ws + WS_HC) + (size_t)kv * 8192 * 256;
    uint32_t pa[4], pb[4];
#pragma unroll
    for (int i = 0; i < 4; ++i) {
      const int row = (tid >> 3) + 64 * i, kc = tid & 7;
      const int r = m0 + row, bg = r >> 9, cc = r & 511, b = bg >> 2, g = bg & 3;
      int tok0 = cc * 16; if (tok0 > SEQ - 32) tok0 = SEQ - 32;
      pa[i] = (uint32_t)(b * SEQ + tok0) * LDQ + 1024 + kv * 256 + g * 64 + kc * 8;
      pb[i] = (uint32_t)row * 2048 + kc * 8;
    }
    f32x4 acc[8][4];
    gemm_mainloop<true>(p, U, pa, Bt, pb, LDQ, 32, lds, acc);
    const int mw = m0 + wpa * 128, nw = wpb * 64;
#pragma unroll
    for (int i = 0; i < 8; ++i)
#pragma unroll
      for (int j = 0; j < 4; ++j) {
        const int n = nw + j * 16 + gk * 4;
        const int m = mw + i * 16 + l16;
        const float4 bb = *(const float4*)(peb + kv * 256 + n);
        float v0 = silu_f(acc[i][j][0] + bb.x), v1 = silu_f(acc[i][j][1] + bb.y);
        float v2 = silu_f(acc[i][j][2] + bb.z), v3 = silu_f(acc[i][j][3] + bb.w);
        if ((m & 511) == 511) { v0 = v1 = v2 = v3 = 0.f; }
        uint2 o; o.x = pack2(v0, v1); o.y = pack2(v2, v3);
        *(uint2*)(Hc + (size_t)m * 256 + n) = o;
      }
  }
}

__device__ __forceinline__ void gemm_cmp2(const Params& p, u16* lds) {
  const int tid = TIDX, lane = tid & 63, wave = tid >> 6, l16 = lane & 15, gk = lane >> 4;
  const int wpa = wave >> 2, wpb = wave & 3;
  for (int tile = BIDX; tile < 64; tile += gridDim.x) {
    const int kv = tile >> 5, mt = tile & 31;
    const int m0 = mt * 256;
    const u16* A = (const u16*)(p.ws + WS_HC) + (size_t)kv * 8192 * 256;
    const u16* Bt = (const u16*)(p.ws + (kv ? WS_W2V : WS_W2K));
    GEMM_OFFS(256, 256)
    f32x4 acc[8][4];
    const bool swapped = (kv == 0);
    if (swapped) gemm_mainloop<true>(p, A + (size_t)m0 * 256, pa, Bt, pb, 64, 4, lds, acc);
    else gemm_mainloop<false>(p, A + (size_t)m0 * 256, pa, Bt, pb, 64, 4, lds, acc);
    const int mw = m0 + wpa * 128, nw = wpb * 64;
    if (swapped) {
      u16* kc_ = (u16*)(p.ws + WS_KCMP);
#pragma unroll
      for (int i = 0; i < 8; ++i)
#pragma unroll
        for (int j = 0; j < 4; ++j) {
          const int n = nw + j * 16 + gk * 4;
          const int m = mw + i * 16 + l16;
          if (n < 64) {
            uint2 o; o.x = pack2(acc[i][j][0], acc[i][j][1]); o.y = pack2(acc[i][j][2], acc[i][j][3]);
            *(uint2*)(kc_ + (size_t)m * 64 + n) = o;
          }
        }
    } else {
      u16* vt = (u16*)(p.ws + WS_VCMPT);
#pragma unroll
      for (int i = 0; i < 8; ++i)
#pragma unroll
        for (int j = 0; j < 4; ++j) {
          const int m = mw + i * 16 + gk * 4;
          const int n = nw + j * 16 + l16;
          if (n < 64) {
            uint2 o; o.x = pack2(acc[i][j][0], acc[i][j][1]); o.y = pack2(acc[i][j][2], acc[i][j][3]);
            *(uint2*)(vt + (size_t)(m >> 9) * 32768 + (size_t)n * 512 + (m & 511)) = o;
          }
        }
    }
  }
}

#define TILE_LD(R, src, stride) { R##0 = *(const uint4*)((src) + (long)(tid >> 3) * (stride) + (tid & 7) * 8); }
#define TILE_ST(dst, R) { *(uint4*)((dst) + (tid >> 3) * TS + (tid & 7) * 8) = R##0; }
__device__ __forceinline__ void qk_tile(const u16* sK, const bf16x8 (&q)[2], f32x4 (&s)[4], int l16, int gk) {
#pragma unroll
  for (int kt = 0; kt < 4; ++kt) s[kt] = (f32x4){0.f, 0.f, 0.f, 0.f};
#pragma unroll
  for (int ks = 0; ks < 2; ++ks)
#pragma unroll
    for (int kt = 0; kt < 4; ++kt) {
      bf16x8 kf = *(const bf16x8*)(sK + (kt * 16 + l16) * TS + ks * 32 + gk * 8);
      s[kt] = MFMA(kf, q[ks], s[kt]);
    }
}
__device__ __forceinline__ void pv_tile(const u16* sV, const float (&pp)[4][4], f32x4 (&o)[4], int l16, int gk) {
  bf16x8 pf[2];
#pragma unroll
  for (int ks2 = 0; ks2 < 2; ++ks2) {
    uint4 t;
    t.x = pack2(pp[2 * ks2][0], pp[2 * ks2][1]); t.y = pack2(pp[2 * ks2][2], pp[2 * ks2][3]);
    t.z = pack2(pp[2 * ks2 + 1][0], pp[2 * ks2 + 1][1]); t.w = pack2(pp[2 * ks2 + 1][2], pp[2 * ks2 + 1][3]);
    pf[ks2] = *(bf16x8*)&t;
  }
#pragma unroll
  for (int dt = 0; dt < 4; ++dt)
#pragma unroll
    for (int ks2 = 0; ks2 < 2; ++ks2) {
      uint2 a0 = *(const uint2*)(sV + (dt * 16 + l16) * TS + (2 * ks2) * 16 + gk * 4);
      uint2 a1 = *(const uint2*)(sV + (dt * 16 + l16) * TS + (2 * ks2 + 1) * 16 + gk * 4);
      uint4 t; t.x = a0.x; t.y = a0.y; t.z = a1.x; t.w = a1.y;
      o[dt] = MFMA(*(bf16x8*)&t, pf[ks2], o[dt]);
    }
}

__device__ __forceinline__ void fox_phase(const Params& p, u16* lds) {
  const u16* QK = (const u16*)(p.ws + WS_QK);
  const u16* VT = (const u16*)(p.ws + WS_VT);
  const float* cf = (const float*)(p.ws + WS_CFOX);
  u16* Y = (u16*)(p.ws + WS_Y);
  const int tid = TIDX, lane = tid & 63, w = tid >> 6, l16 = lane & 15, gk = lane >> 4;
  const float scale2 = 0.125f * LOG2E;
  for (int unit = BIDX; unit < 2048; unit += gridDim.x) {
    const int bh = unit & 31, qblk = 63 - (unit >> 5), b = bh >> 3, h = bh & 7;
    const int tq0 = qblk * 128 + w * 16;
    const int t = tq0 + l16;
    const float* cfr = cf + (size_t)bh * SEQ;
    bf16x8 q[2];
#pragma unroll
    for (int ks = 0; ks < 2; ++ks) q[ks] = *(const bf16x8*)(QK + (size_t)(b * SEQ + t) * LDQ + h * 64 + ks * 32 + gk * 8);
    const float cq2 = cfr[t] * LOG2E;
    f32x4 o[4];
    float m = -1e30f, l = 0.f;
#pragma unroll
    for (int dt = 0; dt < 4; ++dt) o[dt] = (f32x4){0.f, 0.f, 0.f, 0.f};
    const int ntiles = qblk * 2 + 2;
    const int iw = qblk * 2 + (w >> 2);
    const u16* ksrc = QK + (size_t)(b * SEQ) * LDQ + 512 + h * 64;
    const u16* vsrc = VT + (size_t)(h * 64) * MTOK + (size_t)b * SEQ;
    float qs = 0.f;
#pragma unroll
    for (int ks = 0; ks < 2; ++ks)
#pragma unroll
      for (int e = 0; e < 8; ++e) { const float v = bf2f((u16)q[ks][e]); qs += v * v; }
    qs += __shfl_xor(qs, 16); qs += __shfl_xor(qs, 32);
#pragma unroll
    for (int o2 = 1; o2 <= 8; o2 <<= 1) qs = fmaxf(qs, __shfl_xor(qs, o2));
    float* red = (float*)(lds + 256 * TS);
    if (lane == 0) red[w] = qs;
    __syncthreads();
    float qmax2 = red[0];
#pragma unroll
    for (int i = 1; i < NWAVE; ++i) qmax2 = fmaxf(qmax2, red[i]);
    const float kmax2 = __uint_as_float(((const uint32_t*)(p.ws + WS_KMAX))[h]);
    const float T2 = 2.f * scale2 * sqrtf(qmax2 * kmax2) * 1.001f + 48.f;
    const float cfirst2 = cfr[qblk * 128] * LOG2E;
    int i_lo = 0;
    for (int base = qblk * 2 - 1; base >= 0; base -= 64) {
      const int ti = base - lane;
      bool skip = false;
      if (ti >= 0) skip = (cfirst2 - cfr[ti * 64 + 63] * LOG2E) < -T2;
      const unsigned long long bal = __ballot(skip);
      if (bal) { i_lo = base - (int)__builtin_ctzll(bal) + 1; break; }
    }
    uint4 rk0, rv0;
    TILE_LD(rk, ksrc + (size_t)i_lo * 64 * LDQ, LDQ); TILE_LD(rv, vsrc + i_lo * 64, MTOK);
    TILE_ST(lds + (i_lo & 1) * (128 * TS), rk); TILE_ST(lds + (i_lo & 1) * (128 * TS) + 64 * TS, rv);
    __syncthreads();
    for (int i = i_lo; i < ntiles; ++i) {
      u16* cur = lds + (i & 1) * (128 * TS);
      const bool more = (i + 1 < ntiles);
      if (more) { TILE_LD(rk, ksrc + (size_t)(i + 1) * 64 * LDQ, LDQ); TILE_LD(rv, vsrc + (i + 1) * 64, MTOK); }
      if (i <= iw) {
        const int s0 = i * 64;
        const bool diag = (i == iw);
        f32x4 s[4];
        qk_tile(cur, q, s, l16, gk);
        float xv[4][4];
        float mx = -1e30f;
#pragma unroll
        for (int kt = 0; kt < 4; ++kt) {
          const float4 c4 = *(const float4*)(cfr + s0 + kt * 16 + gk * 4);
          const float ck[4] = {c4.x, c4.y, c4.z, c4.w};
#pragma unroll
          for (int r = 0; r < 4; ++r) {
            float v = fmaf(s[kt][r], scale2, cq2 - ck[r] * LOG2E);
            if (diag && (s0 + kt * 16 + gk * 4 + r > t)) v = -1e30f;
            xv[kt][r] = v; mx = fmaxf(mx, v);
          }
        }
        mx = fmaxf(mx, __shfl_xor(mx, 16)); mx = fmaxf(mx, __shfl_xor(mx, 32));
        const float mnew = fmaxf(m, mx);
        const float alpha = ex2(m - mnew);
        m = mnew;
        const float muse = fmaxf(mnew, -1e20f);
        float rs = 0.f;
#pragma unroll
        for (int kt = 0; kt < 4; ++kt)
#pragma unroll
          for (int r = 0; r < 4; ++r) { xv[kt][r] = ex2(xv[kt][r] - muse); rs += xv[kt][r]; }
        l = l * alpha + rs;
#pragma unroll
        for (int dt = 0; dt < 4; ++dt) o[dt] *= alpha;
        pv_tile(cur + 64 * TS, xv, o, l16, gk);
      }
      if (more) { u16* nxt = lds + ((i + 1) & 1) * (128 * TS); TILE_ST(nxt, rk); TILE_ST(nxt + 64 * TS, rv); }
      __syncthreads();
    }
    {
      float lt = l; lt += __shfl_xor(lt, 16); lt += __shfl_xor(lt, 32);
      const float inv = lt > 0.f ? 1.f / lt : 0.f;
      const size_t mrow = (size_t)(b * SEQ + t);
#pragma unroll
      for (int dt = 0; dt < 4; ++dt) {
        const int col = h * 64 + dt * 16 + gk * 4;
        const uint2 zz = *(const uint2*)(QK + mrow * LDQ + 2048 + col);
        const float z0 = bf2f(zz.x & 0xffff), z1 = bf2f(zz.x >> 16), z2 = bf2f(zz.y & 0xffff), z3 = bf2f(zz.y >> 16);
        uint2 ov;
        ov.x = pack2(o[dt][0] * inv * silu_f(z0), o[dt][1] * inv * silu_f(z1));
        ov.y = pack2(o[dt][2] * inv * silu_f(z2), o[dt][3] * inv * silu_f(z3));
        *(uint2*)(Y + mrow * DM + col) = ov;
      }
    }
  }
}

__device__ __forceinline__ void fox_knorm(const Params& p) {
  const u16* QK = (const u16*)(p.ws + WS_QK);
  uint32_t* km = (uint32_t*)(p.ws + WS_KMAX);
  const int tid = TIDX, lane = tid & 63, wave = tid >> 6;
  float mx = 0.f;
  for (int row = BIDX * NWAVE + wave; row < MTOK; row += gridDim.x * NWAVE) {
    const uint4 v = *(const uint4*)(QK + (size_t)row * LDQ + 512 + lane * 8);
    const float a0 = bf2f(v.x & 0xffff), a1 = bf2f(v.x >> 16), a2 = bf2f(v.y & 0xffff), a3 = bf2f(v.y >> 16);
    const float a4 = bf2f(v.z & 0xffff), a5 = bf2f(v.z >> 16), a6 = bf2f(v.w & 0xffff), a7 = bf2f(v.w >> 16);
    float ss = a0 * a0 + a1 * a1 + a2 * a2 + a3 * a3 + a4 * a4 + a5 * a5 + a6 * a6 + a7 * a7;
    ss += __shfl_xor(ss, 1); ss += __shfl_xor(ss, 2); ss += __shfl_xor(ss, 4);
    mx = fmaxf(mx, ss);
  }
  if ((lane & 7) == 0) atomicMax(&km[lane >> 3], __float_as_uint(mx));
}

__device__ __forceinline__ void fox_scan(const Params& p, float* ldsf) {
  const float* fl = (const float*)(p.ws + WS_FLOG);
  float* cf = (float*)(p.ws + WS_CFOX);
  double* sd = (double*)ldsf;
  const int tid = TIDX;
  for (int bh = BIDX; bh < 32; bh += gridDim.x) {
    const int b = bh >> 3, h = bh & 7;
    const float bf = p.e_bf[h];
    float ls[16];
    double sum = 0.0;
#pragma unroll
    for (int i = 0; i < 16; ++i) {
      const float xx = fl[(size_t)(b * SEQ + tid * 16 + i) * 8 + h] + bf;
      ls[i] = fminf(xx, 0.f) - log1pf(__expf(-fabsf(xx)));
      sum += (double)ls[i];
    }
    __syncthreads();
    sd[tid] = sum;
    __syncthreads();
    double pre = 0.0;
    for (int j = 0; j < tid; ++j) pre += sd[j];
#pragma unroll
    for (int i = 0; i < 16; ++i) { pre += (double)ls[i]; cf[(size_t)bh * SEQ + tid * 16 + i] = (float)pre; }
  }
}

__device__ __forceinline__ void ret_stepA(const Params& p) {
  const u16* VT = (const u16*)(p.ws + WS_VT);
  float* dS = (float*)(p.ws + WS_DS);
  const int tid_ = TIDX, lane = tid_ & 63, w8 = tid_ >> 6, w = w8 & 3, l16 = lane & 15, gk = lane >> 4;
  for (int u2 = BIDX; u2 < 1024; u2 += gridDim.x) {
    const int u = u2 * 2 + (w8 >> 2);
    const int bh = u >> 6, n = u & 63, b = bh >> 3, h = bh & 7;
    const size_t mcol = (size_t)b * SEQ + n * 128;
    f32x4 acc[4];
#pragma unroll
    for (int dt = 0; dt < 4; ++dt) acc[dt] = (f32x4){0.f, 0.f, 0.f, 0.f};
#pragma unroll
    for (int ks = 0; ks < 4; ++ks) {
      bf16x8 af = *(const bf16x8*)(VT + (size_t)(512 + h * 64 + w * 16 + l16) * MTOK + mcol + ks * 32 + gk * 8);
#pragma unroll
      for (int dt = 0; dt < 4; ++dt) {
        bf16x8 bfr = *(const bf16x8*)(VT + (size_t)(1024 + h * 64 + dt * 16 + l16) * MTOK + mcol + ks * 32 + gk * 8);
        acc[dt] = MFMA(af, bfr, acc[dt]);
      }
    }
#pragma unroll
    for (int dt = 0; dt < 4; ++dt)
#pragma unroll
      for (int r = 0; r < 4; ++r) dS[(size_t)u * 4096 + (w * 16 + gk * 4 + r) * 64 + dt * 16 + l16] = acc[dt][r];
  }
}
__device__ __forceinline__ void ret_stepB(const Params& p) {
  const float* dS = (const float*)(p.ws + WS_DS);
  u16* st = (u16*)(p.ws + WS_ST);
  for (int idx = BIDX * NTHR + TIDX; idx < 32 * 4096; idx += gridDim.x * NTHR) {
    const int bh = idx >> 12, ed = idx & 4095, h = bh & 7;
    const float cdec = __expf(log1pf(-exp2f(-5.f - (float)h)) * 128.f);
    float s = 0.f;
#pragma unroll 8
    for (int n = 0; n < 64; ++n) {
      const size_t a = (size_t)(bh * 64 + n) * 4096 + ed;
      st[a] = f2bf(s);
      s = s * cdec + dS[a];
    }
  }
}
__device__ __forceinline__ void ret_stepC(const Params& p, u16* lds) {
  const u16* QK = (const u16*)(p.ws + WS_QK);
  const u16* VT = (const u16*)(p.ws + WS_VT);
  const u16* st = (const u16*)(p.ws + WS_ST);
  u16* Y = (u16*)(p.ws + WS_Y);
  const int tid = TIDX, lane = tid & 63, w = tid >> 6, l16 = lane & 15, gk = lane >> 4;
  for (int u = BIDX; u < 2048; u += gridDim.x) {
    const int bh = u >> 6, n = u & 63, b = bh >> 3, h = bh & 7;
    const size_t m0 = (size_t)b * SEQ + n * 128;
    const float lg2 = log1pf(-exp2f(-5.f - (float)h)) * LOG2E;
    __syncthreads();
    {
      uint4 r0;
      TILE_LD(r, QK + m0 * LDQ + 1536 + h * 64, LDQ); TILE_ST(lds, r);
      TILE_LD(r, VT + (size_t)(512 + h * 64) * MTOK + m0, MTOK); TILE_ST(lds + 64 * TS, r);
      TILE_LD(r, QK + (m0 + 64) * LDQ + 1536 + h * 64, LDQ); TILE_ST(lds + 128 * TS, r);
      TILE_LD(r, VT + (size_t)(512 + h * 64) * MTOK + m0 + 64, MTOK); TILE_ST(lds + 192 * TS, r);
      TILE_LD(r, st + (size_t)u * 4096, 64); TILE_ST(lds + 256 * TS, r);
    }
    __syncthreads();
    const int iq = 16 * w + l16;
    const size_t mrow = m0 + iq;
    bf16x8 q[2];
#pragma unroll
    for (int ks = 0; ks < 2; ++ks) q[ks] = *(const bf16x8*)(QK + mrow * LDQ + 1024 + h * 64 + ks * 32 + gk * 8);
    f32x4 o[4];
#pragma unroll
    for (int dt = 0; dt < 4; ++dt) o[dt] = (f32x4){0.f, 0.f, 0.f, 0.f};
#pragma unroll
    for (int dt = 0; dt < 4; ++dt)
#pragma unroll
      for (int ks = 0; ks < 2; ++ks) {
        bf16x8 sf = *(const bf16x8*)(lds + 256 * TS + (dt * 16 + l16) * TS + ks * 32 + gk * 8);
        o[dt] = MFMA(sf, q[ks], o[dt]);
      }
    const float cross = ex2(lg2 * (float)(iq + 1));
#pragma unroll
    for (int dt = 0; dt < 4; ++dt) o[dt] *= cross;
#pragma unroll
    for (int k64 = 0; k64 < 2; ++k64) {
      if (k64 * 64 <= 16 * w + 15) {
        f32x4 s[4];
        qk_tile(lds + k64 * 128 * TS, q, s, l16, gk);
        float pp[4][4];
#pragma unroll
        for (int kt = 0; kt < 4; ++kt)
#pragma unroll
          for (int r = 0; r < 4; ++r) {
            const int j = k64 * 64 + kt * 16 + gk * 4 + r;
            pp[kt][r] = (j <= iq) ? s[kt][r] * 0.125f * ex2(lg2 * (float)(iq - j)) : 0.f;
          }
        pv_tile(lds + k64 * 128 * TS + 64 * TS, pp, o, l16, gk);
      }
    }
    float sm = 0.f;
#pragma unroll
    for (int dt = 0; dt < 4; ++dt) sm += o[dt][0] + o[dt][1] + o[dt][2] + o[dt][3];
    sm += __shfl_xor(sm, 16); sm += __shfl_xor(sm, 32);
    const float mu = sm * (1.f / 64.f);
    float vs = 0.f;
#pragma unroll
    for (int dt = 0; dt < 4; ++dt)
#pragma unroll
      for (int r = 0; r < 4; ++r) { const float d = o[dt][r] - mu; vs += d * d; }
    vs += __shfl_xor(vs, 16); vs += __shfl_xor(vs, 32);
    const float rstd = rsqrtf(vs * (1.f / 64.f) + 1e-5f);
#pragma unroll
    for (int dt = 0; dt < 4; ++dt) {
      const int col = h * 64 + dt * 16 + gk * 4;
      const float4 gg = *(const float4*)(p.e_gn + col);
      const uint2 zz = *(const uint2*)(QK + mrow * LDQ + 2048 + 512 + col);
      const float z0 = bf2f(zz.x & 0xffff), z1 = bf2f(zz.x >> 16), z2 = bf2f(zz.y & 0xffff), z3 = bf2f(zz.y >> 16);
      uint2 ov;
      ov.x = pack2((o[dt][0] - mu) * rstd * gg.x * silu_f(z0), (o[dt][1] - mu) * rstd * gg.y * silu_f(z1));
      ov.y = pack2((o[dt][2] - mu) * rstd * gg.z * silu_f(z2), (o[dt][3] - mu) * rstd * gg.w * silu_f(z3));
      *(uint2*)(Y + mrow * DM + 512 + col) = ov;
    }
  }
}

template <int BR>
__device__ __forceinline__ void nsa_tile(const u16* sK, const u16* sV, const bf16x8 (&q)[2], f32x4 (&acc)[4],
                                         float& m, float& l, float slope2, float gmul,
                                         int t, int pos0, int pstride, int wl, bool lanesel,
                                         float* imp_row, int jbase, float& carry, int lane) {
  const int l16 = lane & 15, gk = lane >> 4;
  const float scale2 = 0.125f * LOG2E;
  const unsigned wle = lanesel ? (unsigned)wl : 0u;
  f32x4 s[4];
  qk_tile(sK, q, s, l16, gk);
  float xv[4][4];
  float mx = -1e30f;
#pragma unroll
  for (int kt = 0; kt < 4; ++kt)
#pragma unroll
    for (int r = 0; r < 4; ++r) {
      const int dist = t - (pos0 + (kt * 16 + gk * 4 + r) * pstride);
      const float pen = ((unsigned)dist < wle) ? 0.f : -1e30f;
      const float v = fmaf(s[kt][r], scale2, fmaf(-slope2, (float)dist, pen));
      xv[kt][r] = v; mx = fmaxf(mx, v);
    }
  if (BR != 1) {
    mx = fmaxf(mx, __shfl_xor(mx, 16)); mx = fmaxf(mx, __shfl_xor(mx, 32));
    const float mnew = fmaxf(m, mx);
    const float alpha = ex2(m - mnew);
    m = mnew;
    const float muse = fmaxf(mnew, -1e20f);
    float rs = 0.f;
#pragma unroll
    for (int kt = 0; kt < 4; ++kt)
#pragma unroll
      for (int r = 0; r < 4; ++r) { xv[kt][r] = ex2(xv[kt][r] - muse); rs += xv[kt][r]; }
    l = l * alpha + rs;
    if (BR == 2) {
#pragma unroll
      for (int dt = 0; dt < 4; ++dt) acc[dt] *= alpha;
      pv_tile(sV, xv, acc, l16, gk);
    }
  } else {
    const float muse = fmaxf(m, -1e20f);
    float p3[4];
#pragma unroll
    for (int kt = 0; kt < 4; ++kt) {
      float pn[4];
#pragma unroll
      for (int r = 0; r < 4; ++r) { pn[r] = ex2(xv[kt][r] - muse) * l; xv[kt][r] = pn[r] * gmul; }
      p3[kt] = pn[3];
      xv[kt][0] = xv[kt][0];
      imp_row[jbase + kt * 4 + gk] = 2.f * (pn[0] + pn[1] + pn[2]) + pn[3];
    }
    const int srcl = (lane + 48) & 63;
#pragma unroll
    for (int kt = 0; kt < 4; ++kt) {
      const float same = __shfl(p3[kt], srcl);
      const float prev = __shfl(kt > 0 ? p3[kt > 0 ? kt - 1 : 0] : carry, srcl);
      imp_row[jbase + kt * 4 + gk] += (gk == 0) ? prev : same;
    }
    carry = p3[3];
    pv_tile(sV, xv, acc, l16, gk);
  }
}

__device__ __forceinline__ void nsa_phase(const Params& p, u16* lds) {
  const u16* U = (const u16*)(p.ws + WS_QK);
  const u16* VT = (const u16*)(p.ws + WS_VT);
  const u16* KC = (const u16*)(p.ws + WS_KCMP);
  const u16* VC = (const u16*)(p.ws + WS_VCMPT);
  const float* GL = (const float*)(p.ws + WS_GL);
  u16* Y = (u16*)(p.ws + WS_Y);
  float* imp = (float*)(lds + 256 * TS);
  uint32_t* umask = (uint32_t*)(imp + 128 * IMPS);
  int* ulist = (int*)(umask + 4);
  const int tid = TIDX, lane = tid & 63, w = tid >> 6, l16 = lane & 15, gk = lane >> 4;
  const int qt = w & 1, hd = w >> 1;
  uint2* totl = (uint2*)imp + (size_t)w * 256 + lane;
  const int BIG = 1 << 30;
  for (int unit = BIDX; unit < 4096; unit += gridDim.x) {
    const int bg = unit & 15, qh = 255 - (unit >> 4), b = bg >> 2, g = bg & 3;
    const int t0 = qh * 32, qb = t0 >> 6, t = t0 + 16 * qt + l16;
    const size_t mrow = (size_t)b * SEQ + t;
    const int h = g * 4 + hd;
    bf16x8 q[2];
#pragma unroll
    for (int ks = 0; ks < 2; ++ks) q[ks] = *(const bf16x8*)(U + mrow * LDQ + h * 64 + ks * 32 + gk * 8);
    const float slope2 = exp2f(-0.5f * (float)(h + 1)) * LOG2E;
    const float g1 = sigmoid_f(GL[mrow * 48 + h * 3] + p.o_bg[h * 3]);
    f32x4 acc[4];
    float m = -1e30f, l = 0.f;
#pragma unroll
    for (int dt = 0; dt < 4; ++dt) acc[dt] = (f32x4){0.f, 0.f, 0.f, 0.f};
    __syncthreads();
    for (int i = tid; i < 128 * IMPS; i += NTHR) imp[i] = 0.f;
    if (tid < 4) umask[tid] = 0u;
    float* imp_row = imp + (hd * 32 + 16 * qt + l16) * IMPS;
    float carry = 0.f;
    uint4 rk0, rv0;
    const int ntc = ((t0 >> 4) >> 6) + 1;
    const u16* kcs = KC + (size_t)bg * 512 * 64;
    const u16* vcs = VC + (size_t)bg * 32768;
#pragma unroll 1
    for (int pass = 0; pass < 2; ++pass) {
      TILE_LD(rk, kcs, 64); TILE_LD(rv, vcs, 512);
      __syncthreads();
      TILE_ST(lds, rk); TILE_ST(lds + 64 * TS, rv);
      __syncthreads();
#pragma unroll 1
      for (int i = 0; i < ntc; ++i) {
        u16* cur = lds + (i & 1) * (128 * TS);
        const bool more = (i + 1 < ntc);
        if (more) { TILE_LD(rk, kcs + (size_t)(i + 1) * 64 * 64, 64); TILE_LD(rv, vcs + (i + 1) * 64, 512); }
        if (pass == 0) nsa_tile<0>(cur, cur + 64 * TS, q, acc, m, l, slope2, g1, t, 16 * (64 * i) + 31, 16, BIG, true, imp_row, 16 * i, carry, lane);
        else nsa_tile<1>(cur, cur + 64 * TS, q, acc, m, l, slope2, g1, t, 16 * (64 * i) + 31, 16, BIG, true, imp_row, 16 * i, carry, lane);
        if (more) { u16* nxt = lds + ((i + 1) & 1) * (128 * TS); TILE_ST(nxt, rk); TILE_ST(nxt + 64 * TS, rv); }
        __syncthreads();
      }
      if (pass == 0) {
        float lt = l; lt += __shfl_xor(lt, 16); lt += __shfl_xor(lt, 32);
        l = lt > 0.f ? 1.f / lt : 0.f;
      }
    }
    uint32_t selm = 0u;
    if (qb < 16) {
      if (gk == 0) selm = (1u << (qb + 1)) - 1u;
    } else {
      float val[32];
      const float* ra = imp + (16 * qt + l16) * IMPS + 32 * gk;
#pragma unroll
      for (int i4 = 0; i4 < 8; ++i4) {
        const float4 v0 = *(const float4*)(ra + 4 * i4);
        const float4 v1 = *(const float4*)(ra + 32 * IMPS + 4 * i4);
        const float4 v2 = *(const float4*)(ra + 64 * IMPS + 4 * i4);
        const float4 v3 = *(const float4*)(ra + 96 * IMPS + 4 * i4);
        val[4 * i4] = ((v0.x + v1.x) + v2.x) + v3.x; val[4 * i4 + 1] = ((v0.y + v1.y) + v2.y) + v3.y;
        val[4 * i4 + 2] = ((v0.z + v1.z) + v2.z) + v3.z; val[4 * i4 + 3] = ((v0.w + v1.w) + v2.w) + v3.w;
      }
#pragma unroll
      for (int i = 0; i < 32; ++i) {
        const int j = 32 * gk + i;
        const bool forced = (j == 0) || (j == qb) || (j == qb - 1);
        if (forced) selm |= (1u << i);
        if (forced || j > qb) val[i] = -1.f;
      }
#pragma unroll 1
      for (int it = 0; it < 13; ++it) {
        float best = -2.f; int bj = 0;
#pragma unroll
        for (int i = 0; i < 32; ++i) {
          const float v = ((selm >> i) & 1u) ? -1.f : val[i];
          if (v > best) { best = v; bj = 32 * gk + i; }
        }
#pragma unroll
        for (int o = 16; o <= 32; o <<= 1) {
          const float ov = __shfl_xor(best, o); const int oj = __shfl_xor(bj, o);
          if (ov > best || (ov == best && oj < bj)) { best = ov; bj = oj; }
        }
        if ((bj >> 5) == gk) selm |= (1u << (bj & 31));
      }
    }
    const uint32_t sel0 = __shfl(selm, l16), sel1 = __shfl(selm, l16 + 16), sel2 = __shfl(selm, l16 + 32), sel3 = __shfl(selm, l16 + 48);
    uint32_t wu = selm;
#pragma unroll
    for (int o = 1; o <= 8; o <<= 1) wu |= __shfl_xor(wu, o);
    const uint32_t wun0 = __shfl(wu, 0), wun1 = __shfl(wu, 16), wun2 = __shfl(wu, 32), wun3 = __shfl(wu, 48);
    if (l16 == 0) atomicOr(&umask[gk], wu);
    __syncthreads();
    int nsl = 0;
    {
      const uint32_t u0 = umask[0], u1 = umask[1], u2 = umask[2], u3 = umask[3];
      nsl = __popc(u0) + __popc(u1) + __popc(u2) + __popc(u3);
      if (tid < 128) {
        const uint32_t uw = tid < 32 ? u0 : tid < 64 ? u1 : tid < 96 ? u2 : u3;
        if ((uw >> (tid & 31)) & 1u) {
          int pos = __popc(uw & ((1u << (tid & 31)) - 1u));
          if (tid >= 32) pos += __popc(u0);
          if (tid >= 64) pos += __popc(u1);
          if (tid >= 96) pos += __popc(u2);
          ulist[pos] = tid;
        }
      }
    }
    __syncthreads();
#pragma unroll
    for (int dt = 0; dt < 4; ++dt) {
      uint2 o2; o2.x = pack2(acc[dt][0], acc[dt][1]); o2.y = pack2(acc[dt][2], acc[dt][3]);
      totl[dt * 64] = o2;
    }
#pragma unroll 1
    for (int br = 1; br < 3; ++br) {
      m = -1e30f; l = 0.f;
#pragma unroll
      for (int dt = 0; dt < 4; ++dt) acc[dt] = (f32x4){0.f, 0.f, 0.f, 0.f};
      int wfirst = ((t0 - 511) >> 6) << 6; if (wfirst < 0) wfirst = 0;
      const int nt = (br == 1) ? nsl : ((qb * 64 - wfirst) >> 6) + 1;
      const u16* kb = U + (size_t)b * SEQ * LDQ + (br == 1 ? 1536 : 1792) + g * 64;
      const u16* vb = VT + (size_t)((br == 1 ? 0 : 256) + g * 64) * MTOK + (size_t)b * SEQ;
      int s0 = (br == 1) ? ulist[0] * 64 : wfirst;
      TILE_LD(rk, kb + (size_t)s0 * LDQ, LDQ); TILE_LD(rv, vb + s0, MTOK);
      __syncthreads();
      TILE_ST(lds, rk); TILE_ST(lds + 64 * TS, rv);
      __syncthreads();
#pragma unroll 1
      for (int i = 0; i < nt; ++i) {
        u16* cur = lds + (i & 1) * (128 * TS);
        const bool more = (i + 1 < nt);
        int s1 = 0;
        if (more) {
          s1 = (br == 1) ? ulist[i + 1] * 64 : s0 + 64;
          TILE_LD(rk, kb + (size_t)s1 * LDQ, LDQ); TILE_LD(rv, vb + s1, MTOK);
        }
        bool wsel = true, ls = true;
        int wl = 512;
        if (br == 1) {
          const int j = s0 >> 6, jw = j >> 5, jb = j & 31;
          const uint32_t ww = jw == 0 ? wun0 : jw == 1 ? wun1 : jw == 2 ? wun2 : wun3;
          const uint32_t sw = jw == 0 ? sel0 : jw == 1 ? sel1 : jw == 2 ? sel2 : sel3;
          wsel = (ww >> jb) & 1u; ls = (sw >> jb) & 1u; wl = BIG;
        }
        if (wsel) nsa_tile<2>(cur, cur + 64 * TS, q, acc, m, l, slope2, g1, t, s0, 1, wl, ls, imp_row, 0, carry, lane);
        if (more) { u16* nxt = lds + ((i + 1) & 1) * (128 * TS); TILE_ST(nxt, rk); TILE_ST(nxt + 64 * TS, rv); }
        s0 = s1;
        __syncthreads();
      }
      {
        float lt = l; lt += __shfl_xor(lt, 16); lt += __shfl_xor(lt, 32);
        const float gt = sigmoid_f(GL[mrow * 48 + h * 3 + br] + p.o_bg[h * 3 + br]);
        const float sc = lt > 0.f ? gt / lt : 0.f;
#pragma unroll
        for (int dt = 0; dt < 4; ++dt) {
          const uint2 pv = totl[dt * 64];
          const float r0 = bf2f(pv.x & 0xffff) + acc[dt][0] * sc, r1 = bf2f(pv.x >> 16) + acc[dt][1] * sc;
          const float r2 = bf2f(pv.y & 0xffff) + acc[dt][2] * sc, r3 = bf2f(pv.y >> 16) + acc[dt][3] * sc;
          if (br == 1) {
            uint2 o2; o2.x = pack2(r0, r1); o2.y = pack2(r2, r3);
            totl[dt * 64] = o2;
          } else {
            const int col = h * 64 + dt * 16 + gk * 4;
            const uint2 zz = *(const uint2*)(U + mrow * LDQ + 2048 + col);
            const float z0 = bf2f(zz.x & 0xffff), z1 = bf2f(zz.x >> 16), z2 = bf2f(zz.y & 0xffff), z3 = bf2f(zz.y >> 16);
            uint2 ov;
            ov.x = pack2(r0 * silu_f(z0), r1 * silu_f(z1));
            ov.y = pack2(r2 * silu_f(z2), r3 * silu_f(z3));
            *(uint2*)(Y + mrow * DM + col) = ov;
          }
        }
      }
    }
  }
}

__device__ __forceinline__ void final_norm(const Params& p) {
  const int lane = TIDX & 63, wave = TIDX >> 6;
  for (int row = BIDX * NWAVE + wave; row < MTOK; row += gridDim.x * NWAVE) {
    float4* xr = (float4*)(p.out + (size_t)row * DM);
    float4 v[4];
    float ss = 0.f;
#pragma unroll
    for (int i = 0; i < 4; ++i) {
      v[i] = xr[lane + 64 * i];
      ss += v[i].x * v[i].x + v[i].y * v[i].y + v[i].z * v[i].z + v[i].w * v[i].w;
    }
#pragma unroll
    for (int o = 32; o >= 1; o >>= 1) ss += __shfl_xor(ss, o);
    const float rstd = rsqrtf(ss * (1.f / DM) + 1e-6f);
#pragma unroll
    for (int i = 0; i < 4; ++i) {
      const float4 gg = ((const float4*)p.fin_g)[lane + 64 * i];
      xr[lane + 64 * i] = (float4){v[i].x * rstd * gg.x, v[i].y * rstd * gg.y, v[i].z * rstd * gg.z, v[i].w * rstd * gg.w};
    }
  }
}

__device__ __forceinline__ void grid_bar(const Params& p, unsigned& target) {
  __syncthreads();
  target += gridDim.x;
  if (TIDX == 0) {
    unsigned* ctr = (unsigned*)(p.ws + WS_BAR);
    __threadfence();
    __hip_atomic_fetch_add(ctr, 1u, __ATOMIC_RELAXED, __HIP_MEMORY_SCOPE_AGENT);
    while (__hip_atomic_load(ctr, __ATOMIC_RELAXED, __HIP_MEMORY_SCOPE_AGENT) < target) __builtin_amdgcn_s_sleep(1);
    __threadfence();
  }
  __syncthreads();
}

__global__ void __launch_bounds__(NTHR, 2) mega(Params p_in) {
  Params p = p_in;
  p.pad = __builtin_amdgcn_readfirstlane((int)threadIdx.x >> 6);
  unsigned bar_target = 0u;
  extern __shared__ __attribute__((aligned(16))) unsigned char lds_raw[];
  u16* lds = (u16*)lds_raw;
  cg::grid_group grid = cg::this_grid();
  if (p_in.coop == 2) grid.sync();
#define PH_ON(k) (p.ph_lo <= (k) && (k) <= p.ph_hi)
#define PH_SYNC(k) if (p.coop && p.ph_lo <= (k) && (k) < p.ph_hi) grid_bar(p, bar_target);
  if (PH_ON(0)) {
    rms_rows(p, p.x, p.e_ng, (u16*)(p.ws + WS_HBF));
    conv_t(p, (u16*)(p.ws + WS_WT0), p.e_win, 1024, 4104, 4352, 0);
    conv_t(p, (u16*)(p.ws + WS_WT1), p.o_win, 1024, 3632, 3840, 1);
    conv_t(p, (u16*)(p.ws + WS_WO0), p.e_wout, 1024, 1024, 1024, 2);
    conv_t(p, (u16*)(p.ws + WS_WO1), p.o_wout, 1024, 1024, 1024, 2);
    conv_t(p, (u16*)(p.ws + WS_W1K), p.o_wk1, 2048, 256, 256, 2);
    conv_t(p, (u16*)(p.ws + WS_W1V), p.o_wv1, 2048, 256, 256, 2);
    conv_t(p, (u16*)(p.ws + WS_W2K), p.o_wk2, 256, 64, 256, 2);
    conv_t(p, (u16*)(p.ws + WS_W2V), p.o_wv2, 256, 64, 256, 2);
    pe_partial(p);
    if (BIDX == 0 && TIDX < 8) ((uint32_t*)(p.ws + WS_KMAX))[TIDX] = 0u;
  }
  PH_SYNC(0)
  if (PH_ON(1)) gemm_inproj(p, 0, lds);
  PH_SYNC(1)
  if (PH_ON(2)) { fox_scan(p, (float*)lds); ret_stepA(p); fox_knorm(p); }
  PH_SYNC(2)
  if (PH_ON(3)) { ret_stepB(p); fox_phase(p, lds); }
  PH_SYNC(3)
  if (PH_ON(4)) ret_stepC(p, lds);
  PH_SYNC(4)
  if (PH_ON(5)) gemm_outproj(p, 0, lds);
  PH_SYNC(5)
  if (PH_ON(6)) {
    rms_rows(p, p.out, p.o_ng, (u16*)(p.ws + WS_HBF));
    if (BIDX == 0) {
      for (int i = TIDX; i < 512; i += NTHR) {
        const float* part = (const float*)(p.ws + WS_PEP);
        float s = 0.f;
        for (int kc = 0; kc < 16; ++kc) s += part[((i >> 8) * 16 + kc) * 256 + (i & 255)];
        ((float*)(p.ws + WS_PEB))[i] = s;
      }
    }
  }
  PH_SYNC(6)
  if (PH_ON(7)) gemm_inproj(p, 1, lds);
  PH_SYNC(7)
  if (PH_ON(8)) gemm_cmp1(p, lds);
  PH_SYNC(8)
  if (PH_ON(9)) gemm_cmp2(p, lds);
  PH_SYNC(9)
  if (PH_ON(10)) nsa_phase(p, lds);
  PH_SYNC(10)
  if (PH_ON(11)) gemm_outproj(p, 1, lds);
  PH_SYNC(11)
  if (PH_ON(12)) final_norm(p);
}

extern "C" void kernel_launch(void* const* d_in, const int* in_sizes, int n_in, void* d_out, int out_size, void* d_ws,
                              size_t ws_size, hipStream_t stream) {
  static int grid_blocks = 0;
  if (!grid_blocks) {
    int dev = 0, cus = 0, per_cu = 0;
    hipGetDevice(&dev);
    hipDeviceGetAttribute(&cus, hipDeviceAttributeMultiprocessorCount, dev);
    hipFuncSetAttribute((const void*)mega, hipFuncAttributeMaxDynamicSharedMemorySize, LDS_BYTES);
    hipOccupancyMaxActiveBlocksPerMultiprocessor(&per_cu, (const void*)mega, NTHR, LDS_BYTES);
    if (per_cu < 1) per_cu = 1;
    if (per_cu > 1) per_cu = 1;
    grid_blocks = cus * per_cu;
    (void)hipGetLastError();
  }
  Params p{};
  p.x = (const float*)d_in[0]; p.e_ng = (const float*)d_in[1]; p.e_win = (const float*)d_in[2];
  p.e_bf = (const float*)d_in[3]; p.e_gn = (const float*)d_in[4]; p.e_wout = (const float*)d_in[5];
  p.o_ng = (const float*)d_in[6]; p.o_win = (const float*)d_in[7]; p.o_bg = (const float*)d_in[8];
  p.o_pek = (const float*)d_in[9]; p.o_pev = (const float*)d_in[10]; p.o_wk1 = (const float*)d_in[11];
  p.o_wk2 = (const float*)d_in[12]; p.o_wv1 = (const float*)d_in[13]; p.o_wv2 = (const float*)d_in[14];
  p.o_wout = (const float*)d_in[15]; p.fin_g = (const float*)d_in[16];
  p.out = (float*)d_out; p.ws = (unsigned char*)d_ws;
#if ONE_LAUNCH
  p.ph_lo = 0; p.ph_hi = NPHASE - 1; p.coop = 1;
  (void)hipMemsetAsync((unsigned char*)d_ws + WS_BAR, 0, 64, stream);
  void* args[] = {&p};
  hipError_t e = hipLaunchCooperativeKernel((const void*)mega, dim3(grid_blocks), dim3(NTHR), args, LDS_BYTES, stream);
  if (e != hipSuccess) fprintf(stderr, "cooperative launch failed: %s (grid %d)\n", hipGetErrorString(e), grid_blocks);
#else
  for (int ph = 0; ph < NPHASE; ++ph) {
    p.ph_lo = ph; p.ph_hi = ph; p.coop = 0;
    hipLaunchKernelGGL(mega, dim3(grid_blocks), dim3(NTHR), LDS_BYTES, stream, p);
  }
#endif
}
```

```cpp
#include <hip/hip_runtime.h>
#include <hip/hip_cooperative_groups.h>
#include <stdint.h>
#include <stdio.h>
namespace cg = cooperative_groups;

typedef unsigned short u16;
typedef short bf16x8 __attribute__((ext_vector_type(8)));
typedef short bf16x4 __attribute__((ext_vector_type(4)));
typedef float f32x4 __attribute__((ext_vector_type(4)));

#ifndef ONE_LAUNCH
#define ONE_LAUNCH 1
#endif

#define MTOK 32768
#define SEQ 8192
#define DM 1024
#define LDQ 3072
#define LOG2E 1.4426950408889634f
#define TS 72
#define IMPS 132
#define LDS_BYTES 147456
#define NTHR 512
#define NWAVE 8
#define NPHASE 13

#define MiB (1024ull * 1024ull)
#define WS_HBF   (0ull)
#define WS_DS    (0ull)
#define WS_ST    (32ull * MiB)
#define WS_QK    (64ull * MiB)
#define WS_VT    (256ull * MiB)
#define WS_Y     (352ull * MiB)
#define WS_WT0   (416ull * MiB)
#define WS_WT1   (WS_WT0 + 4352ull * 1024 * 2)
#define WS_WO0   (WS_WT1 + 3840ull * 1024 * 2)
#define WS_WO1   (WS_WO0 + 1024ull * 1024 * 2)
#define WS_W1K   (WS_WO1 + 1024ull * 1024 * 2)
#define WS_W1V   (WS_W1K + 256ull * 2048 * 2)
#define WS_W2K   (WS_W1V + 256ull * 2048 * 2)
#define WS_W2V   (WS_W2K + 256ull * 256 * 2)
#define WS_FLOG  (440ull * MiB)
#define WS_CFOX  (441ull * MiB)
#define WS_GL    (442ull * MiB)
#define WS_HC    (448ull * MiB)
#define WS_KCMP  (456ull * MiB)
#define WS_VCMPT (457ull * MiB)
#define WS_PEP   (458ull * MiB)
#define WS_PEB   (WS_PEP + 65536ull)
#define WS_KMAX  (WS_PEB + 4096ull)
#define WS_BAR   (WS_KMAX + 4096ull)

struct Params {
  const float *x, *e_ng, *e_win, *e_bf, *e_gn, *e_wout;
  const float *o_ng, *o_win, *o_bg, *o_pek, *o_pev, *o_wk1, *o_wk2, *o_wv1, *o_wv2, *o_wout, *fin_g;
  float* out;
  unsigned char* ws;
  int ph_lo, ph_hi, coop, pad;
};

typedef __bf16 bf16v2 __attribute__((ext_vector_type(2)));
typedef float f32v2 __attribute__((ext_vector_type(2)));
__device__ __forceinline__ uint32_t pack2(float a, float b) {
  f32v2 v = {a, b};
  bf16v2 r = __builtin_convertvector(v, bf16v2);
  return *(uint32_t*)&r;
}
__device__ __forceinline__ u16 f2bf(float f) { return (u16)(pack2(f, 0.f) & 0xffffu); }
__device__ __forceinline__ float bf2f(u16 h) { return __uint_as_float(((uint32_t)h) << 16); }
__device__ __forceinline__ float ex2(float x) { return __builtin_amdgcn_exp2f(x); }
__device__ __forceinline__ float silu_f(float z) { return z * __builtin_amdgcn_rcpf(1.f + ex2(-z * LOG2E)); }
__device__ __forceinline__ float sigmoid_f(float z) { return __builtin_amdgcn_rcpf(1.f + ex2(-z * LOG2E)); }

__device__ __forceinline__ int opq(int v) { asm volatile("" : "+v"(v)); return v; }
__device__ __forceinline__ int opqs(int v) { asm volatile("" : "+s"(v)); return v; }
#define TIDX opq(p.pad * 64 + (int)__lane_id())
#define BIDX opqs((int)blockIdx.x)
#define MFMA(a, b, c) __builtin_amdgcn_mfma_f32_16x16x32_bf16((a), (b), (c), 0, 0, 0)

__device__ __forceinline__ void rms_rows(const Params& p, const float* __restrict__ x, const float* __restrict__ g, u16* __restrict__ h) {
  const int lane = TIDX & 63, wave = TIDX >> 6;
  for (int row = BIDX * NWAVE + wave; row < MTOK; row += gridDim.x * NWAVE) {
    const float4* xr = (const float4*)(x + (size_t)row * DM);
    float4 v[4];
    float ss = 0.f;
#pragma unroll
    for (int i = 0; i < 4; ++i) {
      v[i] = xr[lane + 64 * i];
      ss += v[i].x * v[i].x + v[i].y * v[i].y + v[i].z * v[i].z + v[i].w * v[i].w;
    }
#pragma unroll
    for (int o = 32; o >= 1; o >>= 1) ss += __shfl_xor(ss, o);
    const float rstd = rsqrtf(ss * (1.f / DM) + 1e-6f);
#pragma unroll
    for (int i = 0; i < 4; ++i) {
      float4 gg = ((const float4*)g)[lane + 64 * i];
      uint2 o;
      o.x = pack2(v[i].x * rstd * gg.x, v[i].y * rstd * gg.y);
      o.y = pack2(v[i].z * rstd * gg.z, v[i].w * rstd * gg.w);
      *(uint2*)(h + (size_t)row * DM + (lane + 64 * i) * 4) = o;
    }
  }
}

__device__ __forceinline__ int map_col(int MAP, int n) {
  if (MAP == 0) {
    if (n < 1024) return n;
    if (n < 2048) return n + 520;
    if (n < 3072) return n + 1032;
    if (n < 3584) return n - 2048;
    if (n < 4096) return n - 1016;
    if (n < 4104) return n - 2560;
    return -1;
  } else if (MAP == 1) {
    if (n < 1792) return n;
    if (n < 2048) return n + 256;
    if (n < 3072) return n + 560;
    if (n < 3328) return n - 1280;
    if (n < 3584) return n - 1024;
    if (n < 3632) return n - 1024;
    return -1;
  } else if (MAP == 2) {
    return n;
  }
  return n;
}

__device__ __forceinline__ void conv_t(const Params& p, u16* __restrict__ dst, const float* __restrict__ src, int K, int nsrc, int ndst, int MAP) {
  const int total = ndst * (K >> 3);
  for (int id = BIDX * NTHR + TIDX; id < total; id += gridDim.x * NTHR) {
    const int n = id % ndst, kc = id / ndst;
    const int sc = map_col(MAP, n);
    float v[8];
#pragma unroll
    for (int i = 0; i < 8; ++i) v[i] = (sc >= 0 && sc < nsrc) ? src[(size_t)(kc * 8 + i) * nsrc + sc] : 0.f;
    uint4 o;
    o.x = pack2(v[0], v[1]); o.y = pack2(v[2], v[3]); o.z = pack2(v[4], v[5]); o.w = pack2(v[6], v[7]);
    *(uint4*)(dst + (size_t)n * K + kc * 8) = o;
  }
}

__device__ __forceinline__ void pe_partial(const Params& p) {
  float* part = (float*)(p.ws + WS_PEP);
  for (int task = BIDX; task < 32; task += gridDim.x) {
    const int kv = task >> 4, kc = task & 15, n = TIDX;
    if (n >= 256) continue;
    const float* pe = kv ? p.o_pev : p.o_pek;
    const float* w1 = kv ? p.o_wv1 : p.o_wk1;
    float acc = 0.f;
#pragma unroll 16
    for (int k = kc * 128; k < kc * 128 + 128; ++k) acc += pe[k] * w1[(size_t)k * 256 + n];
    part[(kv * 16 + kc) * 256 + n] = acc;
  }
}

#define GST (512 * TS)
template <bool swapped>
__device__ __forceinline__ void gemm_compute(const u16* cur, f32x4 (&acc)[8][4], int wpa, int wpb, int l16, int gk) {
  const u16* sA = cur + (wpa * 128 + l16) * TS + gk * 8;
  const u16* sB = cur + (256 + wpb * 64 + l16) * TS + gk * 8;
#pragma unroll 1
  for (int kk = 0; kk < 2; ++kk) {
    bf16x8 fa[8], fb[4];
#pragma unroll
    for (int i = 0; i < 8; ++i) fa[i] = *(const bf16x8*)(sA + i * 16 * TS + kk * 32);
#pragma unroll
    for (int j = 0; j < 4; ++j) fb[j] = *(const bf16x8*)(sB + j * 16 * TS + kk * 32);
    if (swapped) {
#pragma unroll
      for (int i = 0; i < 8; ++i)
#pragma unroll
        for (int j = 0; j < 4; ++j) acc[i][j] = MFMA(fb[j], fa[i], acc[i][j]);
    } else {
#pragma unroll
      for (int i = 0; i < 8; ++i)
#pragma unroll
        for (int j = 0; j < 4; ++j) acc[i][j] = MFMA(fa[i], fb[j], acc[i][j]);
    }
  }
}
template <bool swapped>
__device__ __forceinline__ void gemm_mainloop(const Params& p, const u16* __restrict__ Ab, const uint32_t (&pa)[4], const u16* __restrict__ Bb,
                                              const uint32_t (&pb)[4], int a_kstride, int nk,
                                              u16* lds, f32x4 (&acc)[8][4]) {
  const int tid = TIDX, lane = tid & 63, wave = tid >> 6;
  const int l16 = lane & 15, gk = lane >> 4;
  const int wpa = wave >> 2, wpb = wave & 3;
  const int woff = (tid >> 3) * TS + (tid & 7) * 8;
  uint4 ra0, ra1, ra2, ra3, rb0, rb1, rb2, rb3;
#define G_LD(kidx) { const u16* Ap_ = Ab + (size_t)(kidx) * a_kstride; const u16* Bp_ = Bb + (size_t)(kidx) * 64;   \
    ra0 = *(const uint4*)(Ap_ + pa[0]); ra1 = *(const uint4*)(Ap_ + pa[1]); ra2 = *(const uint4*)(Ap_ + pa[2]); ra3 = *(const uint4*)(Ap_ + pa[3]); \
    rb0 = *(const uint4*)(Bp_ + pb[0]); rb1 = *(const uint4*)(Bp_ + pb[1]); rb2 = *(const uint4*)(Bp_ + pb[2]); rb3 = *(const uint4*)(Bp_ + pb[3]); }
#define G_ST(D) { u16* D_ = (D) + woff;                                                                               \
    *(uint4*)(D_) = ra0; *(uint4*)(D_ + 64 * TS) = ra1; *(uint4*)(D_ + 128 * TS) = ra2; *(uint4*)(D_ + 192 * TS) = ra3;  \
    *(uint4*)(D_ + 256 * TS) = rb0; *(uint4*)(D_ + 320 * TS) = rb1; *(uint4*)(D_ + 384 * TS) = rb2; *(uint4*)(D_ + 448 * TS) = rb3; }
  G_LD(0)
  __syncthreads();
  G_ST(lds)
  __syncthreads();
#pragma unroll
  for (int i = 0; i < 8; ++i)
#pragma unroll
    for (int j = 0; j < 4; ++j) acc[i][j] = (f32x4){0.f, 0.f, 0.f, 0.f};
#pragma unroll 1
  for (int ks = 0; ks < nk; ++ks) {
    const bool more = (ks + 1 < nk);
    if (more) G_LD(ks + 1)
    gemm_compute<swapped>(lds + (ks & 1) * GST, acc, wpa, wpb, l16, gk);
    if (more) G_ST(lds + ((ks + 1) & 1) * GST)
    __syncthreads();
  }
#undef G_LD
#undef G_ST
}
#define GEMM_OFFS(rowstrideA, rowstrideB)                                   \
  uint32_t pa[4], pb[4];                                                    \
  _Pragma("unroll") for (int i = 0; i < 4; ++i) {                           \
    pa[i] = (uint32_t)((tid >> 3) + 64 * i) * (rowstrideA) + (tid & 7) * 8; \
    pb[i] = (uint32_t)((tid >> 3) + 64 * i) * (rowstrideB) + (tid & 7) * 8; \
  }

__device__ __forceinline__ void gemm_inproj(const Params& p, int layer, u16* lds) {
  const u16* A = (const u16*)(p.ws + WS_HBF);
  const u16* Bt = (const u16*)(p.ws + (layer ? WS_WT1 : WS_WT0));
  u16* QK = (u16*)(p.ws + WS_QK);
  u16* VT = (u16*)(p.ws + WS_VT);
  float* F = (float*)(p.ws + (layer ? WS_GL : WS_FLOG));
  const int NT = layer ? 15 : 17;
  const int seg_trans_end = layer ? 28 : 32;
  const int nvalidF = layer ? 48 : 8, ldf = layer ? 48 : 8;
  const int tid = TIDX, lane = tid & 63, wave = tid >> 6, l16 = lane & 15, gk = lane >> 4;
  const int wpa = wave >> 2, wpb = wave & 3;
  const int bid = BIDX, xcd = bid & 7, nloc = (int)gridDim.x >> 3;
  for (int q = bid >> 3; q < 16 * NT; q += nloc) {
    const int mt = xcd * 16 + q / NT, nt = q % NT;
    const int m0 = mt * 256, n0 = nt * 256;
    const int mw = m0 + wpa * 128, nw = n0 + wpb * 64;
    const int seg = nw >> 7;
    int mode;
    if (seg < 24) mode = (layer == 0 && seg >= 12 && seg < 16) ? 2 : 0;
    else if (seg < seg_trans_end) mode = 1;
    else if (seg == seg_trans_end) mode = 3;
    else mode = 4;
    const int seg0 = nt * 2;
    const bool swapped = !((seg0 >= 24 && seg0 < seg_trans_end) || (layer == 0 && seg0 >= 12 && seg0 < 16));
    GEMM_OFFS(DM, DM)
    f32x4 acc[8][4];
    if (swapped) gemm_mainloop<true>(p, A + (size_t)m0 * DM, pa, Bt + (size_t)n0 * DM, pb, 64, 16, lds, acc);
    else gemm_mainloop<false>(p, A + (size_t)m0 * DM, pa, Bt + (size_t)n0 * DM, pb, 64, 16, lds, acc);
    if (mode == 0 || mode == 3) {
#pragma unroll
      for (int i = 0; i < 8; ++i)
#pragma unroll
        for (int j = 0; j < 4; ++j) {
          const int n = nw + j * 16 + gk * 4;
          const int m = mw + i * 16 + l16;
          if (mode == 0) {
            uint2 o; o.x = pack2(acc[i][j][0], acc[i][j][1]); o.y = pack2(acc[i][j][2], acc[i][j][3]);
            *(uint2*)(QK + (size_t)m * LDQ + n) = o;
          } else {
            const int nn = n - seg * 128;
            if (nn < nvalidF) *(float4*)(F + (size_t)m * ldf + nn) = (float4){acc[i][j][0], acc[i][j][1], acc[i][j][2], acc[i][j][3]};
          }
        }
    } else if (mode == 1 || mode == 2) {
#pragma unroll
      for (int i = 0; i < 8; ++i)
#pragma unroll
        for (int j = 0; j < 4; ++j) {
          const int m = mw + i * 16 + gk * 4;
          const int n = nw + j * 16 + l16;
          if (mode == 1) {
            const int trow = n - 3072;
            uint2 o; o.x = pack2(acc[i][j][0], acc[i][j][1]); o.y = pack2(acc[i][j][2], acc[i][j][3]);
            *(uint2*)(VT + (size_t)trow * MTOK + m) = o;
          } else {
            const int trow = n - 512;
            const int h = (nw - 1536) >> 6;
            const float lg2 = log1pf(-exp2f(-5.f - (float)h)) * LOG2E;
            const float lane_dec = 0.125f * ex2(lg2 * (float)(127 - gk * 4));
            float sv[4];
#pragma unroll
            for (int r = 0; r < 4; ++r) {
              QK[(size_t)(m + r) * LDQ + n] = f2bf(acc[i][j][r]);
              sv[r] = acc[i][j][r] * lane_dec * ex2(lg2 * (float)(-(i * 16 + r)));
            }
            uint2 o; o.x = pack2(sv[0], sv[1]); o.y = pack2(sv[2], sv[3]);
            *(uint2*)(VT + (size_t)trow * MTOK + m) = o;
          }
        }
    }
  }
}

__device__ __forceinline__ void gemm_outproj(const Params& p, int layer, u16* lds) {
  const u16* A = (const u16*)(p.ws + WS_Y);
  const u16* Bt = (const u16*)(p.ws + (layer ? WS_WO1 : WS_WO0));
  const float* res = layer ? p.out : p.x;
  float* out = p.out;
  const int tid = TIDX, lane = tid & 63, wave = tid >> 6, l16 = lane & 15, gk = lane >> 4;
  const int wpa = wave >> 2, wpb = wave & 3;
  const int bid = BIDX, xcd = bid & 7, nloc = (int)gridDim.x >> 3;
  for (int q = bid >> 3; q < 16 * 4; q += nloc) {
    const int mt = xcd * 16 + (q >> 2), nt = q & 3;
    const int m0 = mt * 256, n0 = nt * 256;
    GEMM_OFFS(DM, DM)
    f32x4 acc[8][4];
    gemm_mainloop<true>(p, A + (size_t)m0 * DM, pa, Bt + (size_t)n0 * DM, pb, 64, 16, lds, acc);
    const int mw = m0 + wpa * 128, nw = n0 + wpb * 64;
#pragma unroll
    for (int i = 0; i < 8; ++i)
#pragma unroll
      for (int j = 0; j < 4; ++j) {
        const int n = nw + j * 16 + gk * 4;
        const int m = mw + i * 16 + l16;
        const float4 r = *(const float4*)(res + (size_t)m * DM + n);
        *(float4*)(out + (size_t)m * DM + n) = (float4){r.x + acc[i][j][0], r.y + acc[i][j][1], r.z + acc[i][j][2], r.w + acc[i][j][3]};
      }
  }
}

__device__ __forceinline__ void gemm_cmp1(const Params& p, u16* lds) {
  const u16* U = (const u16*)(p.ws + WS_QK);
  const float* peb = (const float*)(p.ws + WS_PEB);
  const int tid = TIDX, lane = tid & 63, wave = tid >> 6, l16 = lane & 15, gk = lane >> 4;
  const int wpa = wave >> 2, wpb = wave & 3;
  for (int tile = BIDX; tile < 64; tile += gridDim.x) {
    const int kv = tile >> 5, mt = tile & 31;
    const int m0 = mt * 256;
    const u16* Bt = (const u16*)(p.ws + (kv ? WS_W1V : WS_W1K));
    u16* Hc = (u16*)(p.ws + WS_HC) + (size_t)kv * 8192 * 256;
    uint32_t pa[4], pb[4];
#pragma unroll
    for (int i = 0; i < 4; ++i) {
      const int row = (tid >> 3) + 64 * i, kc = tid & 7;
      const int r = m0 + row, bg = r >> 9, cc = r & 511, b = bg >> 2, g = bg & 3;
      int tok0 = cc * 16; if (tok0 > SEQ - 32) tok0 = SEQ - 32;
      pa[i] = (uint32_t)(b * SEQ + tok0) * LDQ + 1024 + kv * 256 + g * 64 + kc * 8;
      pb[i] = (uint32_t)row * 2048 + kc * 8;
    }
    f32x4 acc[8][4];
    gemm_mainloop<true>(p, U, pa, Bt, pb, LDQ, 32, lds, acc);
    const int mw = m0 + wpa * 128, nw = wpb * 64;
#pragma unroll
    for (int i = 0; i < 8; ++i)
#pragma unroll
      for (int j = 0; j < 4; ++j) {
        const int n = nw + j * 16 + gk * 4;
        const int m = mw + i * 16 + l16;
        const float4 bb = *(const float4*)(peb + kv * 256 + n);
        float v0 = silu_f(acc[i][j][0] + bb.x), v1 = silu_f(acc[i][j][1] + bb.y);
        float v2 = silu_f(acc[i][j][2] + bb.z), v3 = silu_f(acc[i][j][3] + bb.w);
        if ((m & 511) == 511) { v0 = v1 = v2 = v3 = 0.f; }
        uint2 o; o.x = pack2(v0, v1); o.y = pack2(v2, v3);
        *(uint2*)(Hc + (size_t)m * 256 + n) = o;
      }
  }
}

__device__ __forceinline__ void gemm_cmp2(const Params& p, u16* lds) {
  const int tid = TIDX, lane = tid & 63, wave = tid >> 6, l16 = lane & 15, gk = lane >> 4;
  const int wpa = wave >> 2, wpb = wave & 3;
  for (int tile = BIDX; tile < 64; tile += gridDim.x) {
    const int kv = tile >> 5, mt = tile & 31;
    const int m0 = mt * 256;
    const u16* A = (const u16*)(p.ws + WS_HC) + (size_t)kv * 8192 * 256;
    const u16* Bt = (const u16*)(p.ws + (kv ? WS_W2V : WS_W2K));
    GEMM_OFFS(256, 256)
    f32x4 acc[8][4];
    const bool swapped = (kv == 0);
    if (swapped) gemm_mainloop<true>(p, A + (size_t)m0 * 256, pa, Bt, pb, 64, 4, lds, acc);
    else gemm_mainloop<false>(p, A + (size_t)m0 * 256, pa, Bt, pb, 64, 4, lds, acc);
    const int mw = m0 + wpa * 128, nw = wpb * 64;
    if (swapped) {
      u16* kc_ = (u16*)(p.ws + WS_KCMP);
#pragma unroll
      for (int i = 0; i < 8; ++i)
#pragma unroll
        for (int j = 0; j < 4; ++j) {
          const int n = nw + j * 16 + gk * 4;
          const int m = mw + i * 16 + l16;
          if (n < 64) {
            uint2 o; o.x = pack2(acc[i][j][0], acc[i][j][1]); o.y = pack2(acc[i][j][2], acc[i][j][3]);
            *(uint2*)(kc_ + (size_t)m * 64 + n) = o;
          }
        }
    } else {
      u16* vt = (u16*)(p.ws + WS_VCMPT);
#pragma unroll
      for (int i = 0; i < 8; ++i)
#pragma unroll
        for (int j = 0; j < 4; ++j) {
          const int m = mw + i * 16 + gk * 4;
          const int n = nw + j * 16 + l16;
          if (n < 64) {
            uint2 o; o.x = pack2(acc[i][j][0], acc[i][j][1]); o.y = pack2(acc[i][j][2], acc[i][j][3]);
            *(uint2*)(vt + (size_t)(m >> 9) * 32768 + (size_t)n * 512 + (m & 511)) = o;
          }
        }
    }
  }
}

#define TILE_LD(R, src, stride) { R##0 = *(const uint4*)((src) + (long)(tid >> 3) * (stride) + (tid & 7) * 8); }
#define TILE_ST(dst, R) { *(uint4*)((dst) + (tid >> 3) * TS + (tid & 7) * 8) = R##0; }
#define VPOS(c) ((((c) >> 2) * 32) + ((2 * ((c) & 1)) * 8) + ((((c) & 3) >> 1) * 4))
#define TILE_STV_(dst, val) { const int c_ = tid & 7; u16* d_ = (dst) + (tid >> 3) * TS + VPOS(c_); \
    *(uint2*)(d_) = make_uint2((val).x, (val).y); *(uint2*)(d_ + 8) = make_uint2((val).z, (val).w); }
#define TILE_STV(dst, R) TILE_STV_(dst, R##0)
__device__ __forceinline__ void qk_tile(const u16* sK, const bf16x8 (&q)[2], f32x4 (&s)[4], int l16, int gk) {
#pragma unroll
  for (int kt = 0; kt < 4; ++kt) s[kt] = (f32x4){0.f, 0.f, 0.f, 0.f};
#pragma unroll
  for (int ks = 0; ks < 2; ++ks)
#pragma unroll
    for (int kt = 0; kt < 4; ++kt) {
      bf16x8 kf = *(const bf16x8*)(sK + (kt * 16 + l16) * TS + ks * 32 + gk * 8);
      s[kt] = MFMA(kf, q[ks], s[kt]);
    }
}
__device__ __forceinline__ void pv_tile(const u16* sV, const float (&pp)[4][4], f32x4 (&o)[4], int l16, int gk) {
  bf16x8 pf[2];
#pragma unroll
  for (int ks2 = 0; ks2 < 2; ++ks2) {
    uint4 t;
    t.x = pack2(pp[2 * ks2][0], pp[2 * ks2][1]); t.y = pack2(pp[2 * ks2][2], pp[2 * ks2][3]);
    t.z = pack2(pp[2 * ks2 + 1][0], pp[2 * ks2 + 1][1]); t.w = pack2(pp[2 * ks2 + 1][2], pp[2 * ks2 + 1][3]);
    pf[ks2] = *(bf16x8*)&t;
  }
#pragma unroll
  for (int dt = 0; dt < 4; ++dt)
#pragma unroll
    for (int ks2 = 0; ks2 < 2; ++ks2) {
      const bf16x8 vf = *(const bf16x8*)(sV + (dt * 16 + l16) * TS + ks2 * 32 + gk * 8);
      o[dt] = MFMA(vf, pf[ks2], o[dt]);
    }
}

__device__ __forceinline__ void fox_phase(const Params& p, u16* lds) {
  const u16* QK = (const u16*)(p.ws + WS_QK);
  const u16* VT = (const u16*)(p.ws + WS_VT);
  const float* cf = (const float*)(p.ws + WS_CFOX);
  u16* Y = (u16*)(p.ws + WS_Y);
  const int tid = TIDX, lane = tid & 63, w = tid >> 6, l16 = lane & 15, gk = lane >> 4;
  const float scale2 = 0.125f * LOG2E;
  for (int unit = BIDX; unit < 2048; unit += gridDim.x) {
    const int bh = unit & 31, qblk = 63 - (unit >> 5), b = bh >> 3, h = bh & 7;
    const int tq0 = qblk * 128 + w * 16;
    const int t = tq0 + l16;
    const float* cfr = cf + (size_t)bh * SEQ;
    bf16x8 q[2];
#pragma unroll
    for (int ks = 0; ks < 2; ++ks) q[ks] = *(const bf16x8*)(QK + (size_t)(b * SEQ + t) * LDQ + h * 64 + ks * 32 + gk * 8);
    const float cq2 = cfr[t] * LOG2E;
    f32x4 o[4];
    float m = -1e30f, l = 0.f;
#pragma unroll
    for (int dt = 0; dt < 4; ++dt) o[dt] = (f32x4){0.f, 0.f, 0.f, 0.f};
    const int ntiles = qblk * 2 + 2;
    const int iw = qblk * 2 + (w >> 2);
    const u16* ksrc = QK + (size_t)(b * SEQ) * LDQ + 512 + h * 64;
    const u16* vsrc = VT + (size_t)(h * 64) * MTOK + (size_t)b * SEQ;
    float qs = 0.f;
#pragma unroll
    for (int ks = 0; ks < 2; ++ks)
#pragma unroll
      for (int e = 0; e < 8; ++e) { const float v = bf2f((u16)q[ks][e]); qs += v * v; }
    qs += __shfl_xor(qs, 16); qs += __shfl_xor(qs, 32);
#pragma unroll
    for (int o2 = 1; o2 <= 8; o2 <<= 1) qs = fmaxf(qs, __shfl_xor(qs, o2));
    float* red = (float*)(lds + 256 * TS);
    if (lane == 0) red[w] = qs;
    __syncthreads();
    float qmax2 = red[0];
#pragma unroll
    for (int i = 1; i < NWAVE; ++i) qmax2 = fmaxf(qmax2, red[i]);
    const float kmax2 = __uint_as_float(((const uint32_t*)(p.ws + WS_KMAX))[h]);
    const float T2 = 2.f * scale2 * sqrtf(qmax2 * kmax2) * 1.001f + 48.f;
    const float cfirst2 = cfr[qblk * 128] * LOG2E;
    int i_lo = 0;
    for (int base = qblk * 2 - 1; base >= 0; base -= 64) {
      const int ti = base - lane;
      bool skip = false;
      if (ti >= 0) skip = (cfirst2 - cfr[ti * 64 + 63] * LOG2E) < -T2;
      const unsigned long long bal = __ballot(skip);
      if (bal) { i_lo = base - (int)__builtin_ctzll(bal) + 1; break; }
    }
    uint4 rk0, rv0;
    TILE_LD(rk, ksrc + (size_t)i_lo * 64 * LDQ, LDQ); TILE_LD(rv, vsrc + i_lo * 64, MTOK);
    TILE_ST(lds + (i_lo & 1) * (128 * TS), rk); TILE_STV(lds + (i_lo & 1) * (128 * TS) + 64 * TS, rv);
    __syncthreads();
    for (int i = i_lo; i < ntiles; ++i) {
      u16* cur = lds + (i & 1) * (128 * TS);
      const bool more = (i + 1 < ntiles);
      if (more) { TILE_LD(rk, ksrc + (size_t)(i + 1) * 64 * LDQ, LDQ); TILE_LD(rv, vsrc + (i + 1) * 64, MTOK); }
      if (i <= iw) {
        const int s0 = i * 64;
        const bool diag = (i == iw);
        f32x4 s[4];
        qk_tile(cur, q, s, l16, gk);
        float xv[4][4];
        float mx = -1e30f;
#pragma unroll
        for (int kt = 0; kt < 4; ++kt) {
          const float4 c4 = *(const float4*)(cfr + s0 + kt * 16 + gk * 4);
          const float ck[4] = {c4.x, c4.y, c4.z, c4.w};
#pragma unroll
          for (int r = 0; r < 4; ++r) {
            float v = fmaf(s[kt][r], scale2, cq2 - ck[r] * LOG2E);
            if (diag && (s0 + kt * 16 + gk * 4 + r > t)) v = -1e30f;
            xv[kt][r] = v; mx = fmaxf(mx, v);
          }
        }
        mx = fmaxf(mx, __shfl_xor(mx, 16)); mx = fmaxf(mx, __shfl_xor(mx, 32));
        const float mnew = fmaxf(m, mx);
        const float alpha = ex2(m - mnew);
        m = mnew;
        const float muse = fmaxf(mnew, -1e20f);
        float rs = 0.f;
#pragma unroll
        for (int kt = 0; kt < 4; ++kt)
#pragma unroll
          for (int r = 0; r < 4; ++r) { xv[kt][r] = ex2(xv[kt][r] - muse); rs += xv[kt][r]; }
        l = l * alpha + rs;
#pragma unroll
        for (int dt = 0; dt < 4; ++dt) o[dt] *= alpha;
        pv_tile(cur + 64 * TS, xv, o, l16, gk);
      }
      if (more) { u16* nxt = lds + ((i + 1) & 1) * (128 * TS); TILE_ST(nxt, rk); TILE_STV(nxt + 64 * TS, rv); }
      __syncthreads();
    }
    {
      float lt = l; lt += __shfl_xor(lt, 16); lt += __shfl_xor(lt, 32);
      const float inv = lt > 0.f ? 1.f / lt : 0.f;
      const size_t mrow = (size_t)(b * SEQ + t);
#pragma unroll
      for (int dt = 0; dt < 4; ++dt) {
        const int col = h * 64 + dt * 16 + gk * 4;
        const uint2 zz = *(const uint2*)(QK + mrow * LDQ + 2048 + col);
        const float z0 = bf2f(zz.x & 0xffff), z1 = bf2f(zz.x >> 16), z2 = bf2f(zz.y & 0xffff), z3 = bf2f(zz.y >> 16);
        uint2 ov;
        ov.x = pack2(o[dt][0] * inv * silu_f(z0), o[dt][1] * inv * silu_f(z1));
        ov.y = pack2(o[dt][2] * inv * silu_f(z2), o[dt][3] * inv * silu_f(z3));
        *(uint2*)(Y + mrow * DM + col) = ov;
      }
    }
  }
}

__device__ __forceinline__ void fox_knorm(const Params& p) {
  const u16* QK = (const u16*)(p.ws + WS_QK);
  uint32_t* km = (uint32_t*)(p.ws + WS_KMAX);
  const int tid = TIDX, lane = tid & 63, wave = tid >> 6;
  float mx = 0.f;
  for (int row = BIDX * NWAVE + wave; row < MTOK; row += gridDim.x * NWAVE) {
    const uint4 v = *(const uint4*)(QK + (size_t)row * LDQ + 512 + lane * 8);
    const float a0 = bf2f(v.x & 0xffff), a1 = bf2f(v.x >> 16), a2 = bf2f(v.y & 0xffff), a3 = bf2f(v.y >> 16);
    const float a4 = bf2f(v.z & 0xffff), a5 = bf2f(v.z >> 16), a6 = bf2f(v.w & 0xffff), a7 = bf2f(v.w >> 16);
    float ss = a0 * a0 + a1 * a1 + a2 * a2 + a3 * a3 + a4 * a4 + a5 * a5 + a6 * a6 + a7 * a7;
    ss += __shfl_xor(ss, 1); ss += __shfl_xor(ss, 2); ss += __shfl_xor(ss, 4);
    mx = fmaxf(mx, ss);
  }
  if ((lane & 7) == 0) atomicMax(&km[lane >> 3], __float_as_uint(mx));
}

__device__ __forceinline__ void fox_scan(const Params& p, float* ldsf) {
  const float* fl = (const float*)(p.ws + WS_FLOG);
  float* cf = (float*)(p.ws + WS_CFOX);
  double* sd = (double*)ldsf;
  const int tid = TIDX;
  for (int bh = BIDX; bh < 32; bh += gridDim.x) {
    const int b = bh >> 3, h = bh & 7;
    const float bf = p.e_bf[h];
    float ls[16];
    double sum = 0.0;
#pragma unroll
    for (int i = 0; i < 16; ++i) {
      const float xx = fl[(size_t)(b * SEQ + tid * 16 + i) * 8 + h] + bf;
      ls[i] = fminf(xx, 0.f) - log1pf(__expf(-fabsf(xx)));
      sum += (double)ls[i];
    }
    __syncthreads();
    sd[tid] = sum;
    __syncthreads();
    double pre = 0.0;
    for (int j = 0; j < tid; ++j) pre += sd[j];
#pragma unroll
    for (int i = 0; i < 16; ++i) { pre += (double)ls[i]; cf[(size_t)bh * SEQ + tid * 16 + i] = (float)pre; }
  }
}

__device__ __forceinline__ void ret_stepA(const Params& p) {
  const u16* VT = (const u16*)(p.ws + WS_VT);
  float* dS = (float*)(p.ws + WS_DS);
  const int tid_ = TIDX, lane = tid_ & 63, w8 = tid_ >> 6, w = w8 & 3, l16 = lane & 15, gk = lane >> 4;
  for (int u2 = BIDX; u2 < 1024; u2 += gridDim.x) {
    const int u = u2 * 2 + (w8 >> 2);
    const int bh = u >> 6, n = u & 63, b = bh >> 3, h = bh & 7;
    const size_t mcol = (size_t)b * SEQ + n * 128;
    f32x4 acc[4];
#pragma unroll
    for (int dt = 0; dt < 4; ++dt) acc[dt] = (f32x4){0.f, 0.f, 0.f, 0.f};
#pragma unroll
    for (int ks = 0; ks < 4; ++ks) {
      bf16x8 af = *(const bf16x8*)(VT + (size_t)(512 + h * 64 + w * 16 + l16) * MTOK + mcol + ks * 32 + gk * 8);
#pragma unroll
      for (int dt = 0; dt < 4; ++dt) {
        bf16x8 bfr = *(const bf16x8*)(VT + (size_t)(1024 + h * 64 + dt * 16 + l16) * MTOK + mcol + ks * 32 + gk * 8);
        acc[dt] = MFMA(af, bfr, acc[dt]);
      }
    }
#pragma unroll
    for (int dt = 0; dt < 4; ++dt)
#pragma unroll
      for (int r = 0; r < 4; ++r) dS[(size_t)u * 4096 + (w * 16 + gk * 4 + r) * 64 + dt * 16 + l16] = acc[dt][r];
  }
}
__device__ __forceinline__ void ret_stepB(const Params& p) {
  const float* dS = (const float*)(p.ws + WS_DS);
  u16* st = (u16*)(p.ws + WS_ST);
  for (int idx = BIDX * NTHR + TIDX; idx < 32 * 4096; idx += gridDim.x * NTHR) {
    const int bh = idx >> 12, ed = idx & 4095, h = bh & 7;
    const float cdec = __expf(log1pf(-exp2f(-5.f - (float)h)) * 128.f);
    float s = 0.f;
#pragma unroll 8
    for (int n = 0; n < 64; ++n) {
      const size_t a = (size_t)(bh * 64 + n) * 4096 + ed;
      st[a] = f2bf(s);
      s = s * cdec + dS[a];
    }
  }
}
__device__ __forceinline__ void ret_stepC(const Params& p, u16* lds) {
  const u16* QK = (const u16*)(p.ws + WS_QK);
  const u16* VT = (const u16*)(p.ws + WS_VT);
  const u16* st = (const u16*)(p.ws + WS_ST);
  u16* Y = (u16*)(p.ws + WS_Y);
  const int tid = TIDX, lane = tid & 63, w = tid >> 6, l16 = lane & 15, gk = lane >> 4;
  for (int u = BIDX; u < 2048; u += gridDim.x) {
    const int bh = u >> 6, n = u & 63, b = bh >> 3, h = bh & 7;
    const size_t m0 = (size_t)b * SEQ + n * 128;
    const float lg2 = log1pf(-exp2f(-5.f - (float)h)) * LOG2E;
    __syncthreads();
    {
      uint4 r0;
      TILE_LD(r, QK + m0 * LDQ + 1536 + h * 64, LDQ); TILE_ST(lds, r);
      TILE_LD(r, VT + (size_t)(512 + h * 64) * MTOK + m0, MTOK); TILE_STV(lds + 64 * TS, r);
      TILE_LD(r, QK + (m0 + 64) * LDQ + 1536 + h * 64, LDQ); TILE_ST(lds + 128 * TS, r);
      TILE_LD(r, VT + (size_t)(512 + h * 64) * MTOK + m0 + 64, MTOK); TILE_STV(lds + 192 * TS, r);
      TILE_LD(r, st + (size_t)u * 4096, 64); TILE_ST(lds + 256 * TS, r);
    }
    __syncthreads();
    const int iq = 16 * w + l16;
    const size_t mrow = m0 + iq;
    bf16x8 q[2];
#pragma unroll
    for (int ks = 0; ks < 2; ++ks) q[ks] = *(const bf16x8*)(QK + mrow * LDQ + 1024 + h * 64 + ks * 32 + gk * 8);
    f32x4 o[4];
#pragma unroll
    for (int dt = 0; dt < 4; ++dt) o[dt] = (f32x4){0.f, 0.f, 0.f, 0.f};
#pragma unroll
    for (int dt = 0; dt < 4; ++dt)
#pragma unroll
      for (int ks = 0; ks < 2; ++ks) {
        bf16x8 sf = *(const bf16x8*)(lds + 256 * TS + (dt * 16 + l16) * TS + ks * 32 + gk * 8);
        o[dt] = MFMA(sf, q[ks], o[dt]);
      }
    const float cross = ex2(lg2 * (float)(iq + 1));
#pragma unroll
    for (int dt = 0; dt < 4; ++dt) o[dt] *= cross;
#pragma unroll
    for (int k64 = 0; k64 < 2; ++k64) {
      if (k64 * 64 <= 16 * w + 15) {
        f32x4 s[4];
        qk_tile(lds + k64 * 128 * TS, q, s, l16, gk);
        float pp[4][4];
#pragma unroll
        for (int kt = 0; kt < 4; ++kt)
#pragma unroll
          for (int r = 0; r < 4; ++r) {
            const int j = k64 * 64 + kt * 16 + gk * 4 + r;
            pp[kt][r] = (j <= iq) ? s[kt][r] * 0.125f * ex2(lg2 * (float)(iq - j)) : 0.f;
          }
        pv_tile(lds + k64 * 128 * TS + 64 * TS, pp, o, l16, gk);
      }
    }
    float sm = 0.f;
#pragma unroll
    for (int dt = 0; dt < 4; ++dt) sm += o[dt][0] + o[dt][1] + o[dt][2] + o[dt][3];
    sm += __shfl_xor(sm, 16); sm += __shfl_xor(sm, 32);
    const float mu = sm * (1.f / 64.f);
    float vs = 0.f;
#pragma unroll
    for (int dt = 0; dt < 4; ++dt)
#pragma unroll
      for (int r = 0; r < 4; ++r) { const float d = o[dt][r] - mu; vs += d * d; }
    vs += __shfl_xor(vs, 16); vs += __shfl_xor(vs, 32);
    const float rstd = rsqrtf(vs * (1.f / 64.f) + 1e-5f);
#pragma unroll
    for (int dt = 0; dt < 4; ++dt) {
      const int col = h * 64 + dt * 16 + gk * 4;
      const float4 gg = *(const float4*)(p.e_gn + col);
      const uint2 zz = *(const uint2*)(QK + mrow * LDQ + 2048 + 512 + col);
      const float z0 = bf2f(zz.x & 0xffff), z1 = bf2f(zz.x >> 16), z2 = bf2f(zz.y & 0xffff), z3 = bf2f(zz.y >> 16);
      uint2 ov;
      ov.x = pack2((o[dt][0] - mu) * rstd * gg.x * silu_f(z0), (o[dt][1] - mu) * rstd * gg.y * silu_f(z1));
      ov.y = pack2((o[dt][2] - mu) * rstd * gg.z * silu_f(z2), (o[dt][3] - mu) * rstd * gg.w * silu_f(z3));
      *(uint2*)(Y + mrow * DM + 512 + col) = ov;
    }
  }
}

__device__ __forceinline__ void nsa_tile_interior(const u16* sK, const u16* sV, const bf16x8 (&q)[2], f32x4 (&acc)[4],
                                                  float& m, float& l, float slope2, const float (&sk)[16],
                                                  int t, int pos0, bool lanesel, int lane) {
  const int l16 = lane & 15, gk = lane >> 4;
  const float scale2 = 0.125f * LOG2E;
  f32x4 s[4];
  qk_tile(sK, q, s, l16, gk);
  const float c0 = fmaf(-slope2, (float)(t - pos0 - gk * 4), lanesel ? 0.f : -1e30f);
  float xv[4][4];
  float mx = -1e30f;
#pragma unroll
  for (int kt = 0; kt < 4; ++kt)
#pragma unroll
    for (int r = 0; r < 4; ++r) { xv[kt][r] = fmaf(s[kt][r], scale2, sk[kt * 4 + r]); mx = fmaxf(mx, xv[kt][r]); }
  mx += c0;
  mx = fmaxf(mx, __shfl_xor(mx, 16)); mx = fmaxf(mx, __shfl_xor(mx, 32));
  const float mnew = fmaxf(m, mx);
  const float alpha = ex2(m - mnew);
  m = mnew;
  const float off = c0 - fmaxf(mnew, -1e20f);
  float rs = 0.f;
#pragma unroll
  for (int kt = 0; kt < 4; ++kt)
#pragma unroll
    for (int r = 0; r < 4; ++r) { xv[kt][r] = ex2(xv[kt][r] + off); rs += xv[kt][r]; }
  l = l * alpha + rs;
  if (__any(alpha != 1.f)) {
#pragma unroll
    for (int dt = 0; dt < 4; ++dt) acc[dt] *= alpha;
  }
  pv_tile(sV, xv, acc, l16, gk);
}
template <int BR>
__device__ __forceinline__ void nsa_tile(const u16* sK, const u16* sV, const bf16x8 (&q)[2], f32x4 (&acc)[4],
                                         float& m, float& l, float slope2, float gmul,
                                         int t, int pos0, int pstride, int wl, bool lanesel,
                                         float* imp_row, int jbase, float& carry, int lane) {
  const int l16 = lane & 15, gk = lane >> 4;
  const float scale2 = 0.125f * LOG2E;
  const unsigned wle = lanesel ? (unsigned)wl : 0u;
  f32x4 s[4];
  qk_tile(sK, q, s, l16, gk);
  float xv[4][4];
  float mx = -1e30f;
#pragma unroll
  for (int kt = 0; kt < 4; ++kt)
#pragma unroll
    for (int r = 0; r < 4; ++r) {
      const int dist = t - (pos0 + (kt * 16 + gk * 4 + r) * pstride);
      const float pen = ((unsigned)dist < wle) ? 0.f : -1e30f;
      const float v = fmaf(s[kt][r], scale2, fmaf(-slope2, (float)dist, pen));
      xv[kt][r] = v; mx = fmaxf(mx, v);
    }
  if (BR != 1) {
    mx = fmaxf(mx, __shfl_xor(mx, 16)); mx = fmaxf(mx, __shfl_xor(mx, 32));
    const float mnew = fmaxf(m, mx);
    const float alpha = ex2(m - mnew);
    m = mnew;
    const float muse = fmaxf(mnew, -1e20f);
    float rs = 0.f;
#pragma unroll
    for (int kt = 0; kt < 4; ++kt)
#pragma unroll
      for (int r = 0; r < 4; ++r) { xv[kt][r] = ex2(xv[kt][r] - muse); rs += xv[kt][r]; }
    l = l * alpha + rs;
    if (BR == 2) {
#pragma unroll
      for (int dt = 0; dt < 4; ++dt) acc[dt] *= alpha;
      pv_tile(sV, xv, acc, l16, gk);
    }
  } else {
    const float muse = fmaxf(m, -1e20f);
    float p3[4];
#pragma unroll
    for (int kt = 0; kt < 4; ++kt) {
      float pn[4];
#pragma unroll
      for (int r = 0; r < 4; ++r) { pn[r] = ex2(xv[kt][r] - muse) * l; xv[kt][r] = pn[r] * gmul; }
      p3[kt] = pn[3];
      xv[kt][0] = xv[kt][0];
      imp_row[jbase + kt * 4 + gk] = 2.f * (pn[0] + pn[1] + pn[2]) + pn[3];
    }
    const int srcl = (lane + 48) & 63;
#pragma unroll
    for (int kt = 0; kt < 4; ++kt) {
      const float same = __shfl(p3[kt], srcl);
      const float prev = __shfl(kt > 0 ? p3[kt > 0 ? kt - 1 : 0] : carry, srcl);
      imp_row[jbase + kt * 4 + gk] += (gk == 0) ? prev : same;
    }
    carry = p3[3];
    pv_tile(sV, xv, acc, l16, gk);
  }
}

__device__ __forceinline__ void nsa_phase(const Params& p, u16* lds) {
  const u16* U = (const u16*)(p.ws + WS_QK);
  const u16* VT = (const u16*)(p.ws + WS_VT);
  const u16* KC = (const u16*)(p.ws + WS_KCMP);
  const u16* VC = (const u16*)(p.ws + WS_VCMPT);
  const float* GL = (const float*)(p.ws + WS_GL);
  u16* Y = (u16*)(p.ws + WS_Y);
  float* imp = (float*)(lds + 512 * TS);
  uint32_t* umask = (uint32_t*)(imp + 128 * IMPS);
  int* ulist = (int*)(umask + 4);
  const int tid = TIDX, lane = tid & 63, w = tid >> 6, l16 = lane & 15, gk = lane >> 4;
  const int qt = w & 1, hd = w >> 1;
  uint2* totl = (uint2*)imp + (size_t)w * 256 + lane;
  const int BIG = 1 << 30;
  for (int unit = BIDX; unit < 4096; unit += gridDim.x) {
    const int bg = unit & 15, qh = 255 - (unit >> 4), b = bg >> 2, g = bg & 3;
    const int t0 = qh * 32, qb = t0 >> 6, t = t0 + 16 * qt + l16;
    const size_t mrow = (size_t)b * SEQ + t;
    const int h = g * 4 + hd;
    bf16x8 q[2];
#pragma unroll
    for (int ks = 0; ks < 2; ++ks) q[ks] = *(const bf16x8*)(U + mrow * LDQ + h * 64 + ks * 32 + gk * 8);
    const float slope2 = exp2f(-0.5f * (float)(h + 1)) * LOG2E;
    const float g1 = sigmoid_f(GL[mrow * 48 + h * 3] + p.o_bg[h * 3]);
    float sk[16];
#pragma unroll
    for (int i = 0; i < 16; ++i) sk[i] = slope2 * (float)((i >> 2) * 16 + (i & 3));
    f32x4 acc[4];
    float m = -1e30f, l = 0.f;
#pragma unroll
    for (int dt = 0; dt < 4; ++dt) acc[dt] = (f32x4){0.f, 0.f, 0.f, 0.f};
    __syncthreads();
    for (int i = tid; i < 128 * IMPS; i += NTHR) imp[i] = 0.f;
    if (tid < 4) umask[tid] = 0u;
    float* imp_row = imp + (hd * 32 + 16 * qt + l16) * IMPS;
    float carry = 0.f;
    uint4 rk0, rk1, rk2, rk3, rv0, rv1, rv2, rv3;
    u16* impbase_unused = nullptr; (void)impbase_unused;
#define SLOT(k) (lds + (k) * (128 * TS))
#define LD1(k, kp, ks_, vp, vs_) { rk##k = *(const uint4*)((kp) + (long)(tid >> 3) * (ks_) + (tid & 7) * 8); rv##k = *(const uint4*)((vp) + (long)(tid >> 3) * (vs_) + (tid & 7) * 8); }
#define ST1(k) { *(uint4*)(SLOT(k) + (tid >> 3) * TS + (tid & 7) * 8) = rk##k; TILE_STV_(SLOT(k) + 64 * TS, rv##k) }
    const int ntc = ((t0 >> 4) >> 6) + 1;
    const u16* kcs = KC + (size_t)bg * 512 * 64;
    const u16* vcs = VC + (size_t)bg * 32768;
#define CMP_LD(k, i) if ((i) < ntc) LD1(k, kcs + (size_t)(i) * 64 * 64, 64, vcs + (i) * 64, 512)
#pragma unroll 1
    for (int pass = 0; pass < 2; ++pass) {
      const int ngrp = (ntc + 3) >> 2;
      CMP_LD(0, 0) CMP_LD(1, 1) CMP_LD(2, 2) CMP_LD(3, 3)
#pragma unroll 1
      for (int gi = 0; gi < ngrp; ++gi) {
        const int ib = gi * 4;
        __syncthreads();
        if (ib < ntc) ST1(0) if (ib + 1 < ntc) ST1(1) if (ib + 2 < ntc) ST1(2) if (ib + 3 < ntc) ST1(3)
        __syncthreads();
        if (gi + 1 < ngrp) { CMP_LD(0, ib + 4) CMP_LD(1, ib + 5) CMP_LD(2, ib + 6) CMP_LD(3, ib + 7) }
#pragma unroll 1
        for (int k = 0; k < 4; ++k) {
          const int i = ib + k;
          if (i < ntc) {
            if (pass == 0) nsa_tile<0>(SLOT(k), SLOT(k) + 64 * TS, q, acc, m, l, slope2, g1, t, 16 * (64 * i) + 31, 16, BIG, true, imp_row, 16 * i, carry, lane);
            else nsa_tile<1>(SLOT(k), SLOT(k) + 64 * TS, q, acc, m, l, slope2, g1, t, 16 * (64 * i) + 31, 16, BIG, true, imp_row, 16 * i, carry, lane);
          }
        }
      }
      if (pass == 0) {
        float lt = l; lt += __shfl_xor(lt, 16); lt += __shfl_xor(lt, 32);
        l = lt > 0.f ? 1.f / lt : 0.f;
      }
    }
    __syncthreads();
    uint32_t selm = 0u;
    if (qb < 16) {
      if (gk == 0) selm = (1u << (qb + 1)) - 1u;
    } else {
      float val[32];
      const float* ra = imp + (16 * qt + l16) * IMPS + 32 * gk;
#pragma unroll
      for (int i4 = 0; i4 < 8; ++i4) {
        const float4 v0 = *(const float4*)(ra + 4 * i4);
        const float4 v1 = *(const float4*)(ra + 32 * IMPS + 4 * i4);
        const float4 v2 = *(const float4*)(ra + 64 * IMPS + 4 * i4);
        const float4 v3 = *(const float4*)(ra + 96 * IMPS + 4 * i4);
        val[4 * i4] = ((v0.x + v1.x) + v2.x) + v3.x; val[4 * i4 + 1] = ((v0.y + v1.y) + v2.y) + v3.y;
        val[4 * i4 + 2] = ((v0.z + v1.z) + v2.z) + v3.z; val[4 * i4 + 3] = ((v0.w + v1.w) + v2.w) + v3.w;
      }
#pragma unroll
      for (int i = 0; i < 32; ++i) {
        const int j = 32 * gk + i;
        const bool forced = (j == 0) || (j == qb) || (j == qb - 1);
        if (forced) selm |= (1u << i);
        if (forced || j > qb) val[i] = -1.f;
      }
#pragma unroll 1
      for (int it = 0; it < 13; ++it) {
        float best = -2.f; int bj = 0;
#pragma unroll
        for (int i = 0; i < 32; ++i) {
          const float v = ((selm >> i) & 1u) ? -1.f : val[i];
          if (v > best) { best = v; bj = 32 * gk + i; }
        }
#pragma unroll
        for (int o = 16; o <= 32; o <<= 1) {
          const float ov = __shfl_xor(best, o); const int oj = __shfl_xor(bj, o);
          if (ov > best || (ov == best && oj < bj)) { best = ov; bj = oj; }
        }
        if ((bj >> 5) == gk) selm |= (1u << (bj & 31));
      }
    }
    const uint32_t sel0 = __shfl(selm, l16), sel1 = __shfl(selm, l16 + 16), sel2 = __shfl(selm, l16 + 32), sel3 = __shfl(selm, l16 + 48);
    uint32_t wu = selm;
#pragma unroll
    for (int o = 1; o <= 8; o <<= 1) wu |= __shfl_xor(wu, o);
    const uint32_t wun0 = __shfl(wu, 0), wun1 = __shfl(wu, 16), wun2 = __shfl(wu, 32), wun3 = __shfl(wu, 48);
    if (l16 == 0) atomicOr(&umask[gk], wu);
    __syncthreads();
    int nsl = 0;
    {
      const uint32_t u0 = umask[0], u1 = umask[1], u2 = umask[2], u3 = umask[3];
      nsl = __popc(u0) + __popc(u1) + __popc(u2) + __popc(u3);
      if (tid < 128) {
        const uint32_t uw = tid < 32 ? u0 : tid < 64 ? u1 : tid < 96 ? u2 : u3;
        if ((uw >> (tid & 31)) & 1u) {
          int pos = __popc(uw & ((1u << (tid & 31)) - 1u));
          if (tid >= 32) pos += __popc(u0);
          if (tid >= 64) pos += __popc(u1);
          if (tid >= 96) pos += __popc(u2);
          ulist[pos] = tid;
        }
      }
    }
    __syncthreads();
#pragma unroll
    for (int dt = 0; dt < 4; ++dt) {
      uint2 o2; o2.x = pack2(acc[dt][0], acc[dt][1]); o2.y = pack2(acc[dt][2], acc[dt][3]);
      totl[dt * 64] = o2;
    }
#pragma unroll 1
    for (int br = 1; br < 3; ++br) {
      m = -1e30f; l = 0.f;
#pragma unroll
      for (int dt = 0; dt < 4; ++dt) acc[dt] = (f32x4){0.f, 0.f, 0.f, 0.f};
      int wfirst = ((t0 - 511) >> 6) << 6; if (wfirst < 0) wfirst = 0;
      const int nt = (br == 1) ? nsl : ((qb * 64 - wfirst) >> 6) + 1;
      const int ngrp = (nt + 3) >> 2;
      const u16* kb = U + (size_t)b * SEQ * LDQ + (br == 1 ? 1536 : 1792) + g * 64;
      const u16* vb = VT + (size_t)((br == 1 ? 0 : 256) + g * 64) * MTOK + (size_t)b * SEQ;
#define SRC_S0(i) ((br == 1) ? ulist[nt - 1 - (i)] * 64 : wfirst + 64 * (nt - 1 - (i)))
#define BR_LD(k, i) if ((i) < nt) { const int s_ = SRC_S0(i); LD1(k, kb + (size_t)s_ * LDQ, LDQ, vb + s_, MTOK) }
      BR_LD(0, 0) BR_LD(1, 1) BR_LD(2, 2) BR_LD(3, 3)
#pragma unroll 1
      for (int gi = 0; gi < ngrp; ++gi) {
        const int ib = gi * 4;
        __syncthreads();
        if (ib < nt) ST1(0) if (ib + 1 < nt) ST1(1) if (ib + 2 < nt) ST1(2) if (ib + 3 < nt) ST1(3)
        __syncthreads();
        if (gi + 1 < ngrp) { BR_LD(0, ib + 4) BR_LD(1, ib + 5) BR_LD(2, ib + 6) BR_LD(3, ib + 7) }
#pragma unroll 1
        for (int k = 0; k < 4; ++k) {
          const int i = ib + k;
          if (i < nt) {
            const int s0 = SRC_S0(i);
            bool wsel = true, ls = true;
            int wl = 512;
            if (br == 1) {
              const int j = s0 >> 6, jw = j >> 5, jb = j & 31;
              const uint32_t ww = jw == 0 ? wun0 : jw == 1 ? wun1 : jw == 2 ? wun2 : wun3;
              const uint32_t sw = jw == 0 ? sel0 : jw == 1 ? sel1 : jw == 2 ? sel2 : sel3;
              wsel = (ww >> jb) & 1u; ls = (sw >> jb) & 1u; wl = BIG;
            }
            if (wsel) {
              const int tq0 = t0 + 16 * qt;
              const bool interior = (s0 + 63 <= tq0) && (br == 1 || s0 + 512 > tq0 + 15);
              if (interior) nsa_tile_interior(SLOT(k), SLOT(k) + 64 * TS, q, acc, m, l, slope2, sk, t, s0, ls, lane);
              else nsa_tile<2>(SLOT(k), SLOT(k) + 64 * TS, q, acc, m, l, slope2, g1, t, s0, 1, wl, ls, imp_row, 0, carry, lane);
            }
          }
        }
      }
      {
        float lt = l; lt += __shfl_xor(lt, 16); lt += __shfl_xor(lt, 32);
        const float gt = sigmoid_f(GL[mrow * 48 + h * 3 + br] + p.o_bg[h * 3 + br]);
        const float sc = lt > 0.f ? gt / lt : 0.f;
#pragma unroll
        for (int dt = 0; dt < 4; ++dt) {
          const uint2 pv = totl[dt * 64];
          const float r0 = bf2f(pv.x & 0xffff) + acc[dt][0] * sc, r1 = bf2f(pv.x >> 16) + acc[dt][1] * sc;
          const float r2 = bf2f(pv.y & 0xffff) + acc[dt][2] * sc, r3 = bf2f(pv.y >> 16) + acc[dt][3] * sc;
          if (br == 1) {
            uint2 o2; o2.x = pack2(r0, r1); o2.y = pack2(r2, r3);
            totl[dt * 64] = o2;
          } else {
            const int col = h * 64 + dt * 16 + gk * 4;
            const uint2 zz = *(const uint2*)(U + mrow * LDQ + 2048 + col);
            const float z0 = bf2f(zz.x & 0xffff), z1 = bf2f(zz.x >> 16), z2 = bf2f(zz.y & 0xffff), z3 = bf2f(zz.y >> 16);
            uint2 ov;
            ov.x = pack2(r0 * silu_f(z0), r1 * silu_f(z1));
            ov.y = pack2(r2 * silu_f(z2), r3 * silu_f(z3));
            *(uint2*)(Y + mrow * DM + col) = ov;
          }
        }
      }
    }
#undef SLOT
#undef LD1
#undef ST1
#undef CMP_LD
#undef SRC_S0
#undef BR_LD
  }
}

__device__ __forceinline__ void final_norm(const Params& p) {
  const int lane = TIDX & 63, wave = TIDX >> 6;
  for (int row = BIDX * NWAVE + wave; row < MTOK; row += gridDim.x * NWAVE) {
    float4* xr = (float4*)(p.out + (size_t)row * DM);
    float4 v[4];
    float ss = 0.f;
#pragma unroll
    for (int i = 0; i < 4; ++i) {
      v[i] = xr[lane + 64 * i];
      ss += v[i].x * v[i].x + v[i].y * v[i].y + v[i].z * v[i].z + v[i].w * v[i].w;
    }
#pragma unroll
    for (int o = 32; o >= 1; o >>= 1) ss += __shfl_xor(ss, o);
    const float rstd = rsqrtf(ss * (1.f / DM) + 1e-6f);
#pragma unroll
    for (int i = 0; i < 4; ++i) {
      const float4 gg = ((const float4*)p.fin_g)[lane + 64 * i];
      xr[lane + 64 * i] = (float4){v[i].x * rstd * gg.x, v[i].y * rstd * gg.y, v[i].z * rstd * gg.z, v[i].w * rstd * gg.w};
    }
  }
}

__device__ __forceinline__ void grid_bar(const Params& p, unsigned& target) {
  __syncthreads();
  target += gridDim.x;
  if (TIDX == 0) {
    unsigned* ctr = (unsigned*)(p.ws + WS_BAR);
    __threadfence();
    __hip_atomic_fetch_add(ctr, 1u, __ATOMIC_RELAXED, __HIP_MEMORY_SCOPE_AGENT);
    while (__hip_atomic_load(ctr, __ATOMIC_RELAXED, __HIP_MEMORY_SCOPE_AGENT) < target) __builtin_amdgcn_s_sleep(1);
    __threadfence();
  }
  __syncthreads();
}

__global__ void __launch_bounds__(NTHR, 2) mega(Params p_in) {
  Params p = p_in;
  p.pad = __builtin_amdgcn_readfirstlane((int)threadIdx.x >> 6);
  unsigned bar_target = 0u;
  extern __shared__ __attribute__((aligned(16))) unsigned char lds_raw[];
  u16* lds = (u16*)lds_raw;
  cg::grid_group grid = cg::this_grid();
  if (p_in.coop == 2) grid.sync();
#define PH_ON(k) (p.ph_lo <= (k) && (k) <= p.ph_hi)
#define PH_SYNC(k) if (p.coop && p.ph_lo <= (k) && (k) < p.ph_hi) grid_bar(p, bar_target);
  if (PH_ON(0)) {
    rms_rows(p, p.x, p.e_ng, (u16*)(p.ws + WS_HBF));
    conv_t(p, (u16*)(p.ws + WS_WT0), p.e_win, 1024, 4104, 4352, 0);
    conv_t(p, (u16*)(p.ws + WS_WT1), p.o_win, 1024, 3632, 3840, 1);
    conv_t(p, (u16*)(p.ws + WS_WO0), p.e_wout, 1024, 1024, 1024, 2);
    conv_t(p, (u16*)(p.ws + WS_WO1), p.o_wout, 1024, 1024, 1024, 2);
    conv_t(p, (u16*)(p.ws + WS_W1K), p.o_wk1, 2048, 256, 256, 2);
    conv_t(p, (u16*)(p.ws + WS_W1V), p.o_wv1, 2048, 256, 256, 2);
    conv_t(p, (u16*)(p.ws + WS_W2K), p.o_wk2, 256, 64, 256, 2);
    conv_t(p, (u16*)(p.ws + WS_W2V), p.o_wv2, 256, 64, 256, 2);
    pe_partial(p);
    if (BIDX == 0 && TIDX < 8) ((uint32_t*)(p.ws + WS_KMAX))[TIDX] = 0u;
  }
  PH_SYNC(0)
  if (PH_ON(1)) gemm_inproj(p, 0, lds);
  PH_SYNC(1)
  if (PH_ON(2)) { fox_scan(p, (float*)lds); ret_stepA(p); fox_knorm(p); }
  PH_SYNC(2)
  if (PH_ON(3)) { ret_stepB(p); fox_phase(p, lds); }
  PH_SYNC(3)
  if (PH_ON(4)) ret_stepC(p, lds);
  PH_SYNC(4)
  if (PH_ON(5)) gemm_outproj(p, 0, lds);
  PH_SYNC(5)
  if (PH_ON(6)) {
    rms_rows(p, p.out, p.o_ng, (u16*)(p.ws + WS_HBF));
    if (BIDX == 0) {
      for (int i = TIDX; i < 512; i += NTHR) {
        const float* part = (const float*)(p.ws + WS_PEP);
        float s = 0.f;
        for (int kc = 0; kc < 16; ++kc) s += part[((i >> 8) * 16 + kc) * 256 + (i & 255)];
        ((float*)(p.ws + WS_PEB))[i] = s;
      }
    }
  }
  PH_SYNC(6)
  if (PH_ON(7)) gemm_inproj(p, 1, lds);
  PH_SYNC(7)
  if (PH_ON(8)) gemm_cmp1(p, lds);
  PH_SYNC(8)
  if (PH_ON(9)) gemm_cmp2(p, lds);
  PH_SYNC(9)
  if (PH_ON(10)) nsa_phase(p, lds);
  PH_SYNC(10)
  if (PH_ON(11)) gemm_outproj(p, 1, lds);
  PH_SYNC(11)
  if (PH_ON(12)) final_norm(p);
}

extern "C" void kernel_launch(void* const* d_in, const int* in_sizes, int n_in, void* d_out, int out_size, void* d_ws,
                              size_t ws_size, hipStream_t stream) {
  static int grid_blocks = 0;
  if (!grid_blocks) {
    int dev = 0, cus = 0, per_cu = 0;
    hipGetDevice(&dev);
    hipDeviceGetAttribute(&cus, hipDeviceAttributeMultiprocessorCount, dev);
    hipFuncSetAttribute((const void*)mega, hipFuncAttributeMaxDynamicSharedMemorySize, LDS_BYTES);
    hipOccupancyMaxActiveBlocksPerMultiprocessor(&per_cu, (const void*)mega, NTHR, LDS_BYTES);
    if (per_cu < 1) per_cu = 1;
    if (per_cu > 1) per_cu = 1;
    grid_blocks = cus * per_cu;
    (void)hipGetLastError();
  }
  Params p{};
  p.x = (const float*)d_in[0]; p.e_ng = (const float*)d_in[1]; p.e_win = (const float*)d_in[2];
  p.e_bf = (const float*)d_in[3]; p.e_gn = (const float*)d_in[4]; p.e_wout = (const float*)d_in[5];
  p.o_ng = (const float*)d_in[6]; p.o_win = (const float*)d_in[7]; p.o_bg = (const float*)d_in[8];
  p.o_pek = (const float*)d_in[9]; p.o_pev = (const float*)d_in[10]; p.o_wk1 = (const float*)d_in[11];
  p.o_wk2 = (const float*)d_in[12]; p.o_wv1 = (const float*)d_in[13]; p.o_wv2 = (const float*)d_in[14];
  p.o_wout = (const float*)d_in[15]; p.fin_g = (const float*)d_in[16];
  p.out = (float*)d_out; p.ws = (unsigned char*)d_ws;
#if ONE_LAUNCH
  p.ph_lo = 0; p.ph_hi = NPHASE - 1; p.coop = 1;
  (void)hipMemsetAsync((unsigned char*)d_ws + WS_BAR, 0, 64, stream);
  void* args[] = {&p};
  hipError_t e = hipLaunchCooperativeKernel((const void*)mega, dim3(grid_blocks), dim3(NTHR), args, LDS_BYTES, stream);
  if (e != hipSuccess) fprintf(stderr, "cooperative launch failed: %s (grid %d)\n", hipGetErrorString(e), grid_blocks);
#else
  for (int ph = 0; ph < NPHASE; ++ph) {
    p.ph_lo = ph; p.ph_hi = ph; p.coop = 0;
    hipLaunchKernelGGL(mega, dim3(grid_blocks), dim3(NTHR), LDS_BYTES, stream, p);
  }
#endif
}
```

```cpp
#include <hip/hip_runtime.h>
#include <hip/hip_cooperative_groups.h>
#include <stdint.h>
#include <stdio.h>
namespace cg = cooperative_groups;

typedef unsigned short u16;
typedef short bf16x8 __attribute__((ext_vector_type(8)));
typedef short bf16x4 __attribute__((ext_vector_type(4)));
typedef float f32x4 __attribute__((ext_vector_type(4)));

#ifndef ONE_LAUNCH
#define ONE_LAUNCH 1
#endif

#define MTOK 32768
#define SEQ 8192
#define DM 1024
#define LDQ 3072
#define LOG2E 1.4426950408889634f
#define TS 72
#define IMPS 132
#define LDS_BYTES 147456
#define NTHR 512
#define NWAVE 8
#define NPHASE 13

#define MiB (1024ull * 1024ull)
#define WS_HBF   (0ull)
#define WS_DS    (0ull)
#define WS_ST    (32ull * MiB)
#define WS_QK    (64ull * MiB)
#define WS_VT    (256ull * MiB)
#define WS_Y     (352ull * MiB)
#define WS_WT0   (416ull * MiB)
#define WS_WT1   (WS_WT0 + 4352ull * 1024 * 2)
#define WS_WO0   (WS_WT1 + 3840ull * 1024 * 2)
#define WS_WO1   (WS_WO0 + 1024ull * 1024 * 2)
#define WS_W1K   (WS_WO1 + 1024ull * 1024 * 2)
#define WS_W1V   (WS_W1K + 256ull * 2048 * 2)
#define WS_W2K   (WS_W1V + 256ull * 2048 * 2)
#define WS_W2V   (WS_W2K + 256ull * 256 * 2)
#define WS_FLOG  (440ull * MiB)
#define WS_CFOX  (441ull * MiB)
#define WS_GL    (442ull * MiB)
#define WS_HC    (448ull * MiB)
#define WS_KCMP  (456ull * MiB)
#define WS_VCMPT (457ull * MiB)
#define WS_PEP   (458ull * MiB)
#define WS_PEB   (WS_PEP + 65536ull)
#define WS_KMAX  (WS_PEB + 4096ull)
#define WS_SSQ   (459ull * MiB)
#define WS_BAR   (WS_KMAX + 4096ull)

struct Params {
  const float *x, *e_ng, *e_win, *e_bf, *e_gn, *e_wout;
  const float *o_ng, *o_win, *o_bg, *o_pek, *o_pev, *o_wk1, *o_wk2, *o_wv1, *o_wv2, *o_wout, *fin_g;
  float* out;
  unsigned char* ws;
  int ph_lo, ph_hi, coop, pad;
};

typedef __bf16 bf16v2 __attribute__((ext_vector_type(2)));
typedef float f32v2 __attribute__((ext_vector_type(2)));
__device__ __forceinline__ uint32_t pack2(float a, float b) {
  f32v2 v = {a, b};
  bf16v2 r = __builtin_convertvector(v, bf16v2);
  return *(uint32_t*)&r;
}
__device__ __forceinline__ u16 f2bf(float f) { return (u16)(pack2(f, 0.f) & 0xffffu); }
__device__ __forceinline__ float bf2f(u16 h) { return __uint_as_float(((uint32_t)h) << 16); }
__device__ __forceinline__ float ex2(float x) { return __builtin_amdgcn_exp2f(x); }
__device__ __forceinline__ float silu_f(float z) { return z * __builtin_amdgcn_rcpf(1.f + ex2(-z * LOG2E)); }
__device__ __forceinline__ float sigmoid_f(float z) { return __builtin_amdgcn_rcpf(1.f + ex2(-z * LOG2E)); }

__device__ __forceinline__ int opq(int v) { asm volatile("" : "+v"(v)); return v; }
__device__ __forceinline__ int opqs(int v) { asm volatile("" : "+s"(v)); return v; }
#define TIDX opq(p.pad * 64 + (int)__lane_id())
#define BIDX opqs((int)blockIdx.x)
#define MFMA(a, b, c) __builtin_amdgcn_mfma_f32_16x16x32_bf16((a), (b), (c), 0, 0, 0)

__device__ __forceinline__ void rms_rows(const Params& p, const float* __restrict__ x, const float* __restrict__ g, u16* __restrict__ h) {
  const int lane = TIDX & 63, wave = TIDX >> 6;
  for (int row = BIDX * NWAVE + wave; row < MTOK; row += gridDim.x * NWAVE) {
    const float4* xr = (const float4*)(x + (size_t)row * DM);
    float4 v[4];
    float ss = 0.f;
#pragma unroll
    for (int i = 0; i < 4; ++i) {
      v[i] = xr[lane + 64 * i];
      ss += v[i].x * v[i].x + v[i].y * v[i].y + v[i].z * v[i].z + v[i].w * v[i].w;
    }
#pragma unroll
    for (int o = 32; o >= 1; o >>= 1) ss += __shfl_xor(ss, o);
    const float rstd = rsqrtf(ss * (1.f / DM) + 1e-6f);
#pragma unroll
    for (int i = 0; i < 4; ++i) {
      float4 gg = ((const float4*)g)[lane + 64 * i];
      uint2 o;
      o.x = pack2(v[i].x * rstd * gg.x, v[i].y * rstd * gg.y);
      o.y = pack2(v[i].z * rstd * gg.z, v[i].w * rstd * gg.w);
      *(uint2*)(h + (size_t)row * DM + (lane + 64 * i) * 4) = o;
    }
  }
}

__device__ __forceinline__ int map_col(int MAP, int n) {
  if (MAP == 0) {
    if (n < 1024) return n;
    if (n < 2048) return n + 520;
    if (n < 3072) return n + 1032;
    if (n < 3584) return n - 2048;
    if (n < 4096) return n - 1016;
    if (n < 4104) return n - 2560;
    return -1;
  } else if (MAP == 1) {
    if (n < 1792) return n;
    if (n < 2048) return n + 256;
    if (n < 3072) return n + 560;
    if (n < 3328) return n - 1280;
    if (n < 3584) return n - 1024;
    if (n < 3632) return n - 1024;
    return -1;
  } else if (MAP == 2) {
    return n;
  }
  return n;
}

__device__ __forceinline__ void conv_t(const Params& p, u16* __restrict__ dst, const float* __restrict__ src, int K, int nsrc, int ndst, int MAP) {
  const int total = ndst * (K >> 3);
  for (int id = BIDX * NTHR + TIDX; id < total; id += gridDim.x * NTHR) {
    const int n = id % ndst, kc = id / ndst;
    const int sc = map_col(MAP, n);
    float v[8];
#pragma unroll
    for (int i = 0; i < 8; ++i) v[i] = (sc >= 0 && sc < nsrc) ? src[(size_t)(kc * 8 + i) * nsrc + sc] : 0.f;
    uint4 o;
    o.x = pack2(v[0], v[1]); o.y = pack2(v[2], v[3]); o.z = pack2(v[4], v[5]); o.w = pack2(v[6], v[7]);
    *(uint4*)(dst + (size_t)n * K + kc * 8) = o;
  }
}

__device__ __forceinline__ void pe_partial(const Params& p) {
  float* part = (float*)(p.ws + WS_PEP);
  for (int task = BIDX; task < 32; task += gridDim.x) {
    const int kv = task >> 4, kc = task & 15, n = TIDX;
    if (n >= 256) continue;
    const float* pe = kv ? p.o_pev : p.o_pek;
    const float* w1 = kv ? p.o_wv1 : p.o_wk1;
    float acc = 0.f;
#pragma unroll 16
    for (int k = kc * 128; k < kc * 128 + 128; ++k) acc += pe[k] * w1[(size_t)k * 256 + n];
    part[(kv * 16 + kc) * 256 + n] = acc;
  }
}

#define GST (512 * TS)
template <bool swapped>
__device__ __forceinline__ void gemm_compute(const u16* cur, f32x4 (&acc)[8][4], int wpa, int wpb, int l16, int gk) {
  const u16* sA = cur + (wpa * 128 + l16) * TS + gk * 8;
  const u16* sB = cur + (256 + wpb * 64 + l16) * TS + gk * 8;
#pragma unroll 1
  for (int kk = 0; kk < 2; ++kk) {
    bf16x8 fa[8], fb[4];
#pragma unroll
    for (int i = 0; i < 8; ++i) fa[i] = *(const bf16x8*)(sA + i * 16 * TS + kk * 32);
#pragma unroll
    for (int j = 0; j < 4; ++j) fb[j] = *(const bf16x8*)(sB + j * 16 * TS + kk * 32);
    if (swapped) {
#pragma unroll
      for (int i = 0; i < 8; ++i)
#pragma unroll
        for (int j = 0; j < 4; ++j) acc[i][j] = MFMA(fb[j], fa[i], acc[i][j]);
    } else {
#pragma unroll
      for (int i = 0; i < 8; ++i)
#pragma unroll
        for (int j = 0; j < 4; ++j) acc[i][j] = MFMA(fa[i], fb[j], acc[i][j]);
    }
  }
}
template <bool swapped>
__device__ __forceinline__ void gemm_mainloop(const Params& p, const u16* __restrict__ Ab, const uint32_t (&pa)[4], const u16* __restrict__ Bb,
                                              const uint32_t (&pb)[4], int a_kstride, int nk,
                                              u16* lds, f32x4 (&acc)[8][4]) {
  const int tid = TIDX, lane = tid & 63, wave = tid >> 6;
  const int l16 = lane & 15, gk = lane >> 4;
  const int wpa = wave >> 2, wpb = wave & 3;
  const int woff = (tid >> 3) * TS + (tid & 7) * 8;
  uint4 ra0, ra1, ra2, ra3, rb0, rb1, rb2, rb3;
#define G_LD(kidx) { const u16* Ap_ = Ab + (size_t)(kidx) * a_kstride; const u16* Bp_ = Bb + (size_t)(kidx) * 64;   \
    ra0 = *(const uint4*)(Ap_ + pa[0]); ra1 = *(const uint4*)(Ap_ + pa[1]); ra2 = *(const uint4*)(Ap_ + pa[2]); ra3 = *(const uint4*)(Ap_ + pa[3]); \
    rb0 = *(const uint4*)(Bp_ + pb[0]); rb1 = *(const uint4*)(Bp_ + pb[1]); rb2 = *(const uint4*)(Bp_ + pb[2]); rb3 = *(const uint4*)(Bp_ + pb[3]); }
#define G_ST(D) { u16* D_ = (D) + woff;                                                                               \
    *(uint4*)(D_) = ra0; *(uint4*)(D_ + 64 * TS) = ra1; *(uint4*)(D_ + 128 * TS) = ra2; *(uint4*)(D_ + 192 * TS) = ra3;  \
    *(uint4*)(D_ + 256 * TS) = rb0; *(uint4*)(D_ + 320 * TS) = rb1; *(uint4*)(D_ + 384 * TS) = rb2; *(uint4*)(D_ + 448 * TS) = rb3; }
  G_LD(0)
  __syncthreads();
  G_ST(lds)
  __syncthreads();
#pragma unroll
  for (int i = 0; i < 8; ++i)
#pragma unroll
    for (int j = 0; j < 4; ++j) acc[i][j] = (f32x4){0.f, 0.f, 0.f, 0.f};
#pragma unroll 1
  for (int ks = 0; ks < nk; ++ks) {
    const bool more = (ks + 1 < nk);
    if (more) G_LD(ks + 1)
    gemm_compute<swapped>(lds + (ks & 1) * GST, acc, wpa, wpb, l16, gk);
    if (more) G_ST(lds + ((ks + 1) & 1) * GST)
    __syncthreads();
  }
#undef G_LD
#undef G_ST
}
#define GEMM_OFFS(rowstrideA, rowstrideB)                                   \
  uint32_t pa[4], pb[4];                                                    \
  _Pragma("unroll") for (int i = 0; i < 4; ++i) {                           \
    pa[i] = (uint32_t)((tid >> 3) + 64 * i) * (rowstrideA) + (tid & 7) * 8; \
    pb[i] = (uint32_t)((tid >> 3) + 64 * i) * (rowstrideB) + (tid & 7) * 8; \
  }

__device__ __forceinline__ void gemm_inproj(const Params& p, int layer, u16* lds) {
  const u16* A = (const u16*)(p.ws + WS_HBF);
  const u16* Bt = (const u16*)(p.ws + (layer ? WS_WT1 : WS_WT0));
  u16* QK = (u16*)(p.ws + WS_QK);
  u16* VT = (u16*)(p.ws + WS_VT);
  float* F = (float*)(p.ws + (layer ? WS_GL : WS_FLOG));
  const int NT = layer ? 15 : 17;
  const int seg_trans_end = layer ? 28 : 32;
  const int nvalidF = layer ? 48 : 8, ldf = layer ? 48 : 8;
  const int tid = TIDX, lane = tid & 63, wave = tid >> 6, l16 = lane & 15, gk = lane >> 4;
  const int wpa = wave >> 2, wpb = wave & 3;
  const int bid = BIDX, xcd = bid & 7, nloc = (int)gridDim.x >> 3;
  for (int q = bid >> 3; q < 16 * NT; q += nloc) {
    const int mt = xcd * 16 + q / NT, nt = q % NT;
    const int m0 = mt * 256, n0 = nt * 256;
    const int mw = m0 + wpa * 128, nw = n0 + wpb * 64;
    const int seg = nw >> 7;
    int mode;
    if (seg < 24) mode = (layer == 0 && seg >= 12 && seg < 16) ? 2 : 0;
    else if (seg < seg_trans_end) mode = 1;
    else if (seg == seg_trans_end) mode = 3;
    else mode = 4;
    const int seg0 = nt * 2;
    const bool swapped = !((seg0 >= 24 && seg0 < seg_trans_end) || (layer == 0 && seg0 >= 12 && seg0 < 16));
    GEMM_OFFS(DM, DM)
    f32x4 acc[8][4];
    if (swapped) gemm_mainloop<true>(p, A + (size_t)m0 * DM, pa, Bt + (size_t)n0 * DM, pb, 64, 16, lds, acc);
    else gemm_mainloop<false>(p, A + (size_t)m0 * DM, pa, Bt + (size_t)n0 * DM, pb, 64, 16, lds, acc);
    const float* ssq_g = (const float*)(p.ws + WS_SSQ);
    if (mode == 0 || mode == 3) {
#pragma unroll
      for (int i = 0; i < 8; ++i) {
        const int m = mw + i * 16 + l16;
        const float rs = layer ? rsqrtf(ssq_g[m] * (1.f / DM) + 1e-6f) : 1.f;
#pragma unroll
        for (int j = 0; j < 4; ++j) {
          const int n = nw + j * 16 + gk * 4;
          const float a0 = acc[i][j][0] * rs, a1 = acc[i][j][1] * rs, a2 = acc[i][j][2] * rs, a3 = acc[i][j][3] * rs;
          if (mode == 0) {
            uint2 o; o.x = pack2(a0, a1); o.y = pack2(a2, a3);
            *(uint2*)(QK + (size_t)m * LDQ + n) = o;
          } else {
            const int nn = n - seg * 128;
            if (nn < nvalidF) *(float4*)(F + (size_t)m * ldf + nn) = (float4){a0, a1, a2, a3};
          }
        }
      }
    } else if (mode == 1 || mode == 2) {
#pragma unroll
      for (int i = 0; i < 8; ++i) {
        const int m = mw + i * 16 + gk * 4;
        float rs0 = 1.f, rs1 = 1.f, rs2 = 1.f, rs3 = 1.f;
        if (layer) {
          const float4 q4 = *(const float4*)(ssq_g + m);
          rs0 = rsqrtf(q4.x * (1.f / DM) + 1e-6f); rs1 = rsqrtf(q4.y * (1.f / DM) + 1e-6f);
          rs2 = rsqrtf(q4.z * (1.f / DM) + 1e-6f); rs3 = rsqrtf(q4.w * (1.f / DM) + 1e-6f);
        }
#pragma unroll
        for (int j = 0; j < 4; ++j) {
          const int n = nw + j * 16 + l16;
          const float a0 = acc[i][j][0] * rs0, a1 = acc[i][j][1] * rs1, a2 = acc[i][j][2] * rs2, a3 = acc[i][j][3] * rs3;
          if (mode == 1) {
            const int trow = n - 3072;
            uint2 o; o.x = pack2(a0, a1); o.y = pack2(a2, a3);
            *(uint2*)(VT + (size_t)trow * MTOK + m) = o;
          } else {
            const int trow = n - 512;
            const int h = (nw - 1536) >> 6;
            const float lg2 = log1pf(-exp2f(-5.f - (float)h)) * LOG2E;
            const float lane_dec = 0.125f * ex2(lg2 * (float)(127 - gk * 4));
            QK[(size_t)(m + 0) * LDQ + n] = f2bf(a0); QK[(size_t)(m + 1) * LDQ + n] = f2bf(a1);
            QK[(size_t)(m + 2) * LDQ + n] = f2bf(a2); QK[(size_t)(m + 3) * LDQ + n] = f2bf(a3);
            const float s0 = a0 * lane_dec * ex2(lg2 * (float)(-(i * 16 + 0))), s1 = a1 * lane_dec * ex2(lg2 * (float)(-(i * 16 + 1)));
            const float s2 = a2 * lane_dec * ex2(lg2 * (float)(-(i * 16 + 2))), s3 = a3 * lane_dec * ex2(lg2 * (float)(-(i * 16 + 3)));
            uint2 o; o.x = pack2(s0, s1); o.y = pack2(s2, s3);
            *(uint2*)(VT + (size_t)trow * MTOK + m) = o;
          }
        }
      }
    }
  }
}

__device__ __forceinline__ void gemm_outproj(const Params& p, int layer, u16* lds) {
  const u16* A = (const u16*)(p.ws + WS_Y);
  const u16* Bt = (const u16*)(p.ws + (layer ? WS_WO1 : WS_WO0));
  const float* res = layer ? p.out : p.x;
  float* out = p.out;
  u16* hb_out = (u16*)(p.ws + WS_HBF);
  float* ssq_g = (float*)(p.ws + WS_SSQ);
  const int tid = TIDX, lane = tid & 63, wave = tid >> 6, l16 = lane & 15, gk = lane >> 4;
  const int wpa = wave >> 2, wpb = wave & 3;
  const int bid = BIDX, xcd = bid & 7, nloc = (int)gridDim.x >> 3;
  for (int q = bid >> 3; q < 16 * 4; q += nloc) {
    const int mt = xcd * 16 + (q >> 2), nt = q & 3;
    const int m0 = mt * 256, n0 = nt * 256;
    GEMM_OFFS(DM, DM)
    f32x4 acc[8][4];
    gemm_mainloop<true>(p, A + (size_t)m0 * DM, pa, Bt + (size_t)n0 * DM, pb, 64, 16, lds, acc);
    const int mw = m0 + wpa * 128, nw = n0 + wpb * 64;
    float ssq[8];
#pragma unroll
    for (int i = 0; i < 8; ++i) ssq[i] = 0.f;
#pragma unroll
    for (int i = 0; i < 8; ++i)
#pragma unroll
      for (int j = 0; j < 4; ++j) {
        const int n = nw + j * 16 + gk * 4;
        const int m = mw + i * 16 + l16;
        const float4 r = *(const float4*)(res + (size_t)m * DM + n);
        const float4 v = (float4){r.x + acc[i][j][0], r.y + acc[i][j][1], r.z + acc[i][j][2], r.w + acc[i][j][3]};
        *(float4*)(out + (size_t)m * DM + n) = v;
        if (layer == 0) {
          const float4 gg = *(const float4*)(p.o_ng + n);
          uint2 hb; hb.x = pack2(v.x * gg.x, v.y * gg.y); hb.y = pack2(v.z * gg.z, v.w * gg.w);
          *(uint2*)(hb_out + (size_t)m * DM + n) = hb;
          ssq[i] += v.x * v.x + v.y * v.y + v.z * v.z + v.w * v.w;
        }
      }
    if (layer == 0) {
#pragma unroll
      for (int i = 0; i < 8; ++i) {
        float sv = ssq[i]; sv += __shfl_xor(sv, 16); sv += __shfl_xor(sv, 32);
        if (gk == 0) atomicAdd(ssq_g + mw + i * 16 + l16, sv);
      }
    }
  }
}

__device__ __forceinline__ void gemm_cmp2_tile(const Params& p, u16* lds, int kv, int mt) {
  const int tid = TIDX, lane = tid & 63, wave = tid >> 6, l16 = lane & 15, gk = lane >> 4;
  const int wpa = wave >> 2, wpb = wave & 3;
  {
    const int m0 = mt * 256;
    const u16* A = (const u16*)(p.ws + WS_HC) + (size_t)kv * 8192 * 256;
    const u16* Bt = (const u16*)(p.ws + (kv ? WS_W2V : WS_W2K));
    GEMM_OFFS(256, 256)
    f32x4 acc[8][4];
    const bool swapped = (kv == 0);
    if (swapped) gemm_mainloop<true>(p, A + (size_t)m0 * 256, pa, Bt, pb, 64, 4, lds, acc);
    else gemm_mainloop<false>(p, A + (size_t)m0 * 256, pa, Bt, pb, 64, 4, lds, acc);
    const int mw = m0 + wpa * 128, nw = wpb * 64;
    if (swapped) {
      u16* kc_ = (u16*)(p.ws + WS_KCMP);
#pragma unroll
      for (int i = 0; i < 8; ++i)
#pragma unroll
        for (int j = 0; j < 4; ++j) {
          const int n = nw + j * 16 + gk * 4;
          const int m = mw + i * 16 + l16;
          if (n < 64) {
            uint2 o; o.x = pack2(acc[i][j][0], acc[i][j][1]); o.y = pack2(acc[i][j][2], acc[i][j][3]);
            *(uint2*)(kc_ + (size_t)m * 64 + n) = o;
          }
        }
    } else {
      u16* vt = (u16*)(p.ws + WS_VCMPT);
#pragma unroll
      for (int i = 0; i < 8; ++i)
#pragma unroll
        for (int j = 0; j < 4; ++j) {
          const int m = mw + i * 16 + gk * 4;
          const int n = nw + j * 16 + l16;
          if (n < 64) {
            uint2 o; o.x = pack2(acc[i][j][0], acc[i][j][1]); o.y = pack2(acc[i][j][2], acc[i][j][3]);
            *(uint2*)(vt + (size_t)(m >> 9) * 32768 + (size_t)n * 512 + (m & 511)) = o;
          }
        }
    }
  }
}

__device__ __forceinline__ void gemm_cmp1(const Params& p, u16* lds) {
  const u16* U = (const u16*)(p.ws + WS_QK);
  const float* peb = (const float*)(p.ws + WS_PEB);
  const int tid = TIDX, lane = tid & 63, wave = tid >> 6, l16 = lane & 15, gk = lane >> 4;
  const int wpa = wave >> 2, wpb = wave & 3;
  for (int tile = BIDX; tile < 64; tile += gridDim.x) {
    const int kv = tile >> 5, mt = tile & 31;
    const int m0 = mt * 256;
    const u16* Bt = (const u16*)(p.ws + (kv ? WS_W1V : WS_W1K));
    u16* Hc = (u16*)(p.ws + WS_HC) + (size_t)kv * 8192 * 256;
    uint32_t pa[4], pb[4];
#pragma unroll
    for (int i = 0; i < 4; ++i) {
      const int row = (tid >> 3) + 64 * i, kc = tid & 7;
      const int r = m0 + row, bg = r >> 9, cc = r & 511, b = bg >> 2, g = bg & 3;
      int tok0 = cc * 16; if (tok0 > SEQ - 32) tok0 = SEQ - 32;
      pa[i] = (uint32_t)(b * SEQ + tok0) * LDQ + 1024 + kv * 256 + g * 64 + kc * 8;
      pb[i] = (uint32_t)row * 2048 + kc * 8;
    }
    f32x4 acc[8][4];
    gemm_mainloop<true>(p, U, pa, Bt, pb, LDQ, 32, lds, acc);
    const int mw = m0 + wpa * 128, nw = wpb * 64;
#pragma unroll
    for (int i = 0; i < 8; ++i)
#pragma unroll
      for (int j = 0; j < 4; ++j) {
        const int n = nw + j * 16 + gk * 4;
        const int m = mw + i * 16 + l16;
        const float4 bb = *(const float4*)(peb + kv * 256 + n);
        float v0 = silu_f(acc[i][j][0] + bb.x), v1 = silu_f(acc[i][j][1] + bb.y);
        float v2 = silu_f(acc[i][j][2] + bb.z), v3 = silu_f(acc[i][j][3] + bb.w);
        if ((m & 511) == 511) { v0 = v1 = v2 = v3 = 0.f; }
        uint2 o; o.x = pack2(v0, v1); o.y = pack2(v2, v3);
        *(uint2*)(Hc + (size_t)m * 256 + n) = o;
      }
    __threadfence_block();
    __syncthreads();
    gemm_cmp2_tile(p, lds, kv, mt);
  }
}

#define TILE_LD(R, src, stride) { R##0 = *(const uint4*)((src) + (long)(tid >> 3) * (stride) + (tid & 7) * 8); }
#define TILE_ST(dst, R) { *(uint4*)((dst) + (tid >> 3) * TS + (tid & 7) * 8) = R##0; }
#define VPOS(c) ((((c) >> 2) * 32) + ((2 * ((c) & 1)) * 8) + ((((c) & 3) >> 1) * 4))
#define TILE_STV_(dst, val) { const int c_ = tid & 7; u16* d_ = (dst) + (tid >> 3) * TS + VPOS(c_); \
    *(uint2*)(d_) = make_uint2((val).x, (val).y); *(uint2*)(d_ + 8) = make_uint2((val).z, (val).w); }
#define TILE_STV(dst, R) TILE_STV_(dst, R##0)
__device__ __forceinline__ void qk_tile(const u16* sK, const bf16x8 (&q)[2], f32x4 (&s)[4], int l16, int gk) {
#pragma unroll
  for (int kt = 0; kt < 4; ++kt) s[kt] = (f32x4){0.f, 0.f, 0.f, 0.f};
#pragma unroll
  for (int ks = 0; ks < 2; ++ks)
#pragma unroll
    for (int kt = 0; kt < 4; ++kt) {
      bf16x8 kf = *(const bf16x8*)(sK + (kt * 16 + l16) * TS + ks * 32 + gk * 8);
      s[kt] = MFMA(kf, q[ks], s[kt]);
    }
}
__device__ __forceinline__ void pv_tile(const u16* sV, const float (&pp)[4][4], f32x4 (&o)[4], int l16, int gk) {
  bf16x8 pf[2];
#pragma unroll
  for (int ks2 = 0; ks2 < 2; ++ks2) {
    uint4 t;
    t.x = pack2(pp[2 * ks2][0], pp[2 * ks2][1]); t.y = pack2(pp[2 * ks2][2], pp[2 * ks2][3]);
    t.z = pack2(pp[2 * ks2 + 1][0], pp[2 * ks2 + 1][1]); t.w = pack2(pp[2 * ks2 + 1][2], pp[2 * ks2 + 1][3]);
    pf[ks2] = *(bf16x8*)&t;
  }
#pragma unroll
  for (int dt = 0; dt < 4; ++dt)
#pragma unroll
    for (int ks2 = 0; ks2 < 2; ++ks2) {
      const bf16x8 vf = *(const bf16x8*)(sV + (dt * 16 + l16) * TS + ks2 * 32 + gk * 8);
      o[dt] = MFMA(vf, pf[ks2], o[dt]);
    }
}

__device__ __forceinline__ void fox_phase(const Params& p, u16* lds) {
  const u16* QK = (const u16*)(p.ws + WS_QK);
  const u16* VT = (const u16*)(p.ws + WS_VT);
  const float* cf = (const float*)(p.ws + WS_CFOX);
  u16* Y = (u16*)(p.ws + WS_Y);
  const int tid = TIDX, lane = tid & 63, w = tid >> 6, l16 = lane & 15, gk = lane >> 4;
  const float scale2 = 0.125f * LOG2E;
  for (int unit = BIDX; unit < 2048; unit += gridDim.x) {
    const int bh = unit & 31, qblk = 63 - (unit >> 5), b = bh >> 3, h = bh & 7;
    const int tq0 = qblk * 128 + w * 16;
    const int t = tq0 + l16;
    const float* cfr = cf + (size_t)bh * SEQ;
    bf16x8 q[2];
#pragma unroll
    for (int ks = 0; ks < 2; ++ks) q[ks] = *(const bf16x8*)(QK + (size_t)(b * SEQ + t) * LDQ + h * 64 + ks * 32 + gk * 8);
    const float cq2 = cfr[t] * LOG2E;
    f32x4 o[4];
    float m = -1e30f, l = 0.f;
#pragma unroll
    for (int dt = 0; dt < 4; ++dt) o[dt] = (f32x4){0.f, 0.f, 0.f, 0.f};
    const int ntiles = qblk * 2 + 2;
    const int iw = qblk * 2 + (w >> 2);
    const u16* ksrc = QK + (size_t)(b * SEQ) * LDQ + 512 + h * 64;
    const u16* vsrc = VT + (size_t)(h * 64) * MTOK + (size_t)b * SEQ;
    float qs = 0.f;
#pragma unroll
    for (int ks = 0; ks < 2; ++ks)
#pragma unroll
      for (int e = 0; e < 8; ++e) { const float v = bf2f((u16)q[ks][e]); qs += v * v; }
    qs += __shfl_xor(qs, 16); qs += __shfl_xor(qs, 32);
#pragma unroll
    for (int o2 = 1; o2 <= 8; o2 <<= 1) qs = fmaxf(qs, __shfl_xor(qs, o2));
    float* red = (float*)(lds + 256 * TS);
    if (lane == 0) red[w] = qs;
    __syncthreads();
    float qmax2 = red[0];
#pragma unroll
    for (int i = 1; i < NWAVE; ++i) qmax2 = fmaxf(qmax2, red[i]);
    const float kmax2 = __uint_as_float(((const uint32_t*)(p.ws + WS_KMAX))[h]);
    const float T2 = 2.f * scale2 * sqrtf(qmax2 * kmax2) * 1.001f + 48.f;
    const float cfirst2 = cfr[qblk * 128] * LOG2E;
    int i_lo = 0;
    for (int base = qblk * 2 - 1; base >= 0; base -= 64) {
      const int ti = base - lane;
      bool skip = false;
      if (ti >= 0) skip = (cfirst2 - cfr[ti * 64 + 63] * LOG2E) < -T2;
      const unsigned long long bal = __ballot(skip);
      if (bal) { i_lo = base - (int)__builtin_ctzll(bal) + 1; break; }
    }
    uint4 rk0, rv0;
    TILE_LD(rk, ksrc + (size_t)i_lo * 64 * LDQ, LDQ); TILE_LD(rv, vsrc + i_lo * 64, MTOK);
    TILE_ST(lds + (i_lo & 1) * (128 * TS), rk); TILE_STV(lds + (i_lo & 1) * (128 * TS) + 64 * TS, rv);
    __syncthreads();
    for (int i = i_lo; i < ntiles; ++i) {
      u16* cur = lds + (i & 1) * (128 * TS);
      const bool more = (i + 1 < ntiles);
      if (more) { TILE_LD(rk, ksrc + (size_t)(i + 1) * 64 * LDQ, LDQ); TILE_LD(rv, vsrc + (i + 1) * 64, MTOK); }
      if (i <= iw) {
        const int s0 = i * 64;
        const bool diag = (i == iw);
        f32x4 s[4];
        qk_tile(cur, q, s, l16, gk);
        float xv[4][4];
        float mx = -1e30f;
#pragma unroll
        for (int kt = 0; kt < 4; ++kt) {
          const float4 c4 = *(const float4*)(cfr + s0 + kt * 16 + gk * 4);
          const float ck[4] = {c4.x, c4.y, c4.z, c4.w};
#pragma unroll
          for (int r = 0; r < 4; ++r) {
            float v = fmaf(s[kt][r], scale2, cq2 - ck[r] * LOG2E);
            if (diag && (s0 + kt * 16 + gk * 4 + r > t)) v = -1e30f;
            xv[kt][r] = v; mx = fmaxf(mx, v);
          }
        }
        mx = fmaxf(mx, __shfl_xor(mx, 16)); mx = fmaxf(mx, __shfl_xor(mx, 32));
        const float mnew = fmaxf(m, mx);
        const float alpha = ex2(m - mnew);
        m = mnew;
        const float muse = fmaxf(mnew, -1e20f);
        float rs = 0.f;
#pragma unroll
        for (int kt = 0; kt < 4; ++kt)
#pragma unroll
          for (int r = 0; r < 4; ++r) { xv[kt][r] = ex2(xv[kt][r] - muse); rs += xv[kt][r]; }
        l = l * alpha + rs;
#pragma unroll
        for (int dt = 0; dt < 4; ++dt) o[dt] *= alpha;
        pv_tile(cur + 64 * TS, xv, o, l16, gk);
      }
      if (more) { u16* nxt = lds + ((i + 1) & 1) * (128 * TS); TILE_ST(nxt, rk); TILE_STV(nxt + 64 * TS, rv); }
      __syncthreads();
    }
    {
      float lt = l; lt += __shfl_xor(lt, 16); lt += __shfl_xor(lt, 32);
      const float inv = lt > 0.f ? 1.f / lt : 0.f;
      const size_t mrow = (size_t)(b * SEQ + t);
#pragma unroll
      for (int dt = 0; dt < 4; ++dt) {
        const int col = h * 64 + dt * 16 + gk * 4;
        const uint2 zz = *(const uint2*)(QK + mrow * LDQ + 2048 + col);
        const float z0 = bf2f(zz.x & 0xffff), z1 = bf2f(zz.x >> 16), z2 = bf2f(zz.y & 0xffff), z3 = bf2f(zz.y >> 16);
        uint2 ov;
        ov.x = pack2(o[dt][0] * inv * silu_f(z0), o[dt][1] * inv * silu_f(z1));
        ov.y = pack2(o[dt][2] * inv * silu_f(z2), o[dt][3] * inv * silu_f(z3));
        *(uint2*)(Y + mrow * DM + col) = ov;
      }
    }
  }
}

__device__ __forceinline__ void fox_knorm(const Params& p) {
  const u16* QK = (const u16*)(p.ws + WS_QK);
  uint32_t* km = (uint32_t*)(p.ws + WS_KMAX);
  const int tid = TIDX, lane = tid & 63, wave = tid >> 6;
  float mx = 0.f;
  for (int row = BIDX * NWAVE + wave; row < MTOK; row += gridDim.x * NWAVE) {
    const uint4 v = *(const uint4*)(QK + (size_t)row * LDQ + 512 + lane * 8);
    const float a0 = bf2f(v.x & 0xffff), a1 = bf2f(v.x >> 16), a2 = bf2f(v.y & 0xffff), a3 = bf2f(v.y >> 16);
    const float a4 = bf2f(v.z & 0xffff), a5 = bf2f(v.z >> 16), a6 = bf2f(v.w & 0xffff), a7 = bf2f(v.w >> 16);
    float ss = a0 * a0 + a1 * a1 + a2 * a2 + a3 * a3 + a4 * a4 + a5 * a5 + a6 * a6 + a7 * a7;
    ss += __shfl_xor(ss, 1); ss += __shfl_xor(ss, 2); ss += __shfl_xor(ss, 4);
    mx = fmaxf(mx, ss);
  }
  if ((lane & 7) == 0) atomicMax(&km[lane >> 3], __float_as_uint(mx));
}

__device__ __forceinline__ void fox_scan(const Params& p, float* ldsf) {
  const float* fl = (const float*)(p.ws + WS_FLOG);
  float* cf = (float*)(p.ws + WS_CFOX);
  double* sd = (double*)ldsf;
  const int tid = TIDX;
  for (int bh = BIDX; bh < 32; bh += gridDim.x) {
    const int b = bh >> 3, h = bh & 7;
    const float bf = p.e_bf[h];
    float ls[16];
    double sum = 0.0;
#pragma unroll
    for (int i = 0; i < 16; ++i) {
      const float xx = fl[(size_t)(b * SEQ + tid * 16 + i) * 8 + h] + bf;
      ls[i] = fminf(xx, 0.f) - log1pf(__expf(-fabsf(xx)));
      sum += (double)ls[i];
    }
    __syncthreads();
    sd[tid] = sum;
    __syncthreads();
    double pre = 0.0;
    for (int j = 0; j < tid; ++j) pre += sd[j];
#pragma unroll
    for (int i = 0; i < 16; ++i) { pre += (double)ls[i]; cf[(size_t)bh * SEQ + tid * 16 + i] = (float)pre; }
  }
}

__device__ __forceinline__ void ret_stepA(const Params& p) {
  const u16* VT = (const u16*)(p.ws + WS_VT);
  float* dS = (float*)(p.ws + WS_DS);
  const int tid_ = TIDX, lane = tid_ & 63, w8 = tid_ >> 6, w = w8 & 3, l16 = lane & 15, gk = lane >> 4;
  for (int u2 = BIDX; u2 < 1024; u2 += gridDim.x) {
    const int u = u2 * 2 + (w8 >> 2);
    const int bh = u >> 6, n = u & 63, b = bh >> 3, h = bh & 7;
    const size_t mcol = (size_t)b * SEQ + n * 128;
    f32x4 acc[4];
#pragma unroll
    for (int dt = 0; dt < 4; ++dt) acc[dt] = (f32x4){0.f, 0.f, 0.f, 0.f};
#pragma unroll
    for (int ks = 0; ks < 4; ++ks) {
      bf16x8 af = *(const bf16x8*)(VT + (size_t)(512 + h * 64 + w * 16 + l16) * MTOK + mcol + ks * 32 + gk * 8);
#pragma unroll
      for (int dt = 0; dt < 4; ++dt) {
        bf16x8 bfr = *(const bf16x8*)(VT + (size_t)(1024 + h * 64 + dt * 16 + l16) * MTOK + mcol + ks * 32 + gk * 8);
        acc[dt] = MFMA(af, bfr, acc[dt]);
      }
    }
#pragma unroll
    for (int dt = 0; dt < 4; ++dt)
#pragma unroll
      for (int r = 0; r < 4; ++r) dS[(size_t)u * 4096 + (w * 16 + gk * 4 + r) * 64 + dt * 16 + l16] = acc[dt][r];
  }
}
__device__ __forceinline__ void ret_stepB(const Params& p) {
  const float* dS = (const float*)(p.ws + WS_DS);
  u16* st = (u16*)(p.ws + WS_ST);
  for (int idx = BIDX * NTHR + TIDX; idx < 32 * 4096; idx += gridDim.x * NTHR) {
    const int bh = idx >> 12, ed = idx & 4095, h = bh & 7;
    const float cdec = __expf(log1pf(-exp2f(-5.f - (float)h)) * 128.f);
    float s = 0.f;
#pragma unroll 8
    for (int n = 0; n < 64; ++n) {
      const size_t a = (size_t)(bh * 64 + n) * 4096 + ed;
      st[a] = f2bf(s);
      s = s * cdec + dS[a];
    }
  }
}
__device__ __forceinline__ void ret_stepC(const Params& p, u16* lds) {
  const u16* QK = (const u16*)(p.ws + WS_QK);
  const u16* VT = (const u16*)(p.ws + WS_VT);
  const u16* st = (const u16*)(p.ws + WS_ST);
  u16* Y = (u16*)(p.ws + WS_Y);
  const int tid = TIDX, lane = tid & 63, w = tid >> 6, l16 = lane & 15, gk = lane >> 4;
  for (int u = BIDX; u < 2048; u += gridDim.x) {
    const int bh = u >> 6, n = u & 63, b = bh >> 3, h = bh & 7;
    const size_t m0 = (size_t)b * SEQ + n * 128;
    const float lg2 = log1pf(-exp2f(-5.f - (float)h)) * LOG2E;
    __syncthreads();
    {
      uint4 r0;
      TILE_LD(r, QK + m0 * LDQ + 1536 + h * 64, LDQ); TILE_ST(lds, r);
      TILE_LD(r, VT + (size_t)(512 + h * 64) * MTOK + m0, MTOK); TILE_STV(lds + 64 * TS, r);
      TILE_LD(r, QK + (m0 + 64) * LDQ + 1536 + h * 64, LDQ); TILE_ST(lds + 128 * TS, r);
      TILE_LD(r, VT + (size_t)(512 + h * 64) * MTOK + m0 + 64, MTOK); TILE_STV(lds + 192 * TS, r);
      TILE_LD(r, st + (size_t)u * 4096, 64); TILE_ST(lds + 256 * TS, r);
    }
    __syncthreads();
    const int iq = 16 * w + l16;
    const size_t mrow = m0 + iq;
    bf16x8 q[2];
#pragma unroll
    for (int ks = 0; ks < 2; ++ks) q[ks] = *(const bf16x8*)(QK + mrow * LDQ + 1024 + h * 64 + ks * 32 + gk * 8);
    f32x4 o[4];
#pragma unroll
    for (int dt = 0; dt < 4; ++dt) o[dt] = (f32x4){0.f, 0.f, 0.f, 0.f};
#pragma unroll
    for (int dt = 0; dt < 4; ++dt)
#pragma unroll
      for (int ks = 0; ks < 2; ++ks) {
        bf16x8 sf = *(const bf16x8*)(lds + 256 * TS + (dt * 16 + l16) * TS + ks * 32 + gk * 8);
        o[dt] = MFMA(sf, q[ks], o[dt]);
      }
    const float cross = ex2(lg2 * (float)(iq + 1));
#pragma unroll
    for (int dt = 0; dt < 4; ++dt) o[dt] *= cross;
#pragma unroll
    for (int k64 = 0; k64 < 2; ++k64) {
      if (k64 * 64 <= 16 * w + 15) {
        f32x4 s[4];
        qk_tile(lds + k64 * 128 * TS, q, s, l16, gk);
        float pp[4][4];
#pragma unroll
        for (int kt = 0; kt < 4; ++kt)
#pragma unroll
          for (int r = 0; r < 4; ++r) {
            const int j = k64 * 64 + kt * 16 + gk * 4 + r;
            pp[kt][r] = (j <= iq) ? s[kt][r] * 0.125f * ex2(lg2 * (float)(iq - j)) : 0.f;
          }
        pv_tile(lds + k64 * 128 * TS + 64 * TS, pp, o, l16, gk);
      }
    }
    float sm = 0.f;
#pragma unroll
    for (int dt = 0; dt < 4; ++dt) sm += o[dt][0] + o[dt][1] + o[dt][2] + o[dt][3];
    sm += __shfl_xor(sm, 16); sm += __shfl_xor(sm, 32);
    const float mu = sm * (1.f / 64.f);
    float vs = 0.f;
#pragma unroll
    for (int dt = 0; dt < 4; ++dt)
#pragma unroll
      for (int r = 0; r < 4; ++r) { const float d = o[dt][r] - mu; vs += d * d; }
    vs += __shfl_xor(vs, 16); vs += __shfl_xor(vs, 32);
    const float rstd = rsqrtf(vs * (1.f / 64.f) + 1e-5f);
#pragma unroll
    for (int dt = 0; dt < 4; ++dt) {
      const int col = h * 64 + dt * 16 + gk * 4;
      const float4 gg = *(const float4*)(p.e_gn + col);
      const uint2 zz = *(const uint2*)(QK + mrow * LDQ + 2048 + 512 + col);
      const float z0 = bf2f(zz.x & 0xffff), z1 = bf2f(zz.x >> 16), z2 = bf2f(zz.y & 0xffff), z3 = bf2f(zz.y >> 16);
      uint2 ov;
      ov.x = pack2((o[dt][0] - mu) * rstd * gg.x * silu_f(z0), (o[dt][1] - mu) * rstd * gg.y * silu_f(z1));
      ov.y = pack2((o[dt][2] - mu) * rstd * gg.z * silu_f(z2), (o[dt][3] - mu) * rstd * gg.w * silu_f(z3));
      *(uint2*)(Y + mrow * DM + 512 + col) = ov;
    }
  }
}

__device__ __forceinline__ void nsa_tile_interior(const u16* sK, const u16* sV, const bf16x8 (&q)[2], f32x4 (&acc)[4],
                                                  float& m, float& l, float slope2, const float (&sk)[16],
                                                  int t, int pos0, bool lanesel, int lane) {
  const int l16 = lane & 15, gk = lane >> 4;
  const float scale2 = 0.125f * LOG2E;
  f32x4 s[4];
  qk_tile(sK, q, s, l16, gk);
  const float c0 = fmaf(-slope2, (float)(t - pos0 - gk * 4), lanesel ? 0.f : -1e30f);
  float xv[4][4];
  float mx = -1e30f;
#pragma unroll
  for (int kt = 0; kt < 4; ++kt)
#pragma unroll
    for (int r = 0; r < 4; ++r) { xv[kt][r] = fmaf(s[kt][r], scale2, sk[kt * 4 + r]); mx = fmaxf(mx, xv[kt][r]); }
  mx += c0;
  mx = fmaxf(mx, __shfl_xor(mx, 16)); mx = fmaxf(mx, __shfl_xor(mx, 32));
  const float mnew = fmaxf(m, mx);
  const float alpha = ex2(m - mnew);
  m = mnew;
  const float off = c0 - fmaxf(mnew, -1e20f);
  float rs = 0.f;
#pragma unroll
  for (int kt = 0; kt < 4; ++kt)
#pragma unroll
    for (int r = 0; r < 4; ++r) { xv[kt][r] = ex2(xv[kt][r] + off); rs += xv[kt][r]; }
  l = l * alpha + rs;
  if (__any(alpha != 1.f)) {
#pragma unroll
    for (int dt = 0; dt < 4; ++dt) acc[dt] *= alpha;
  }
  pv_tile(sV, xv, acc, l16, gk);
}
template <int BR>
__device__ __forceinline__ void nsa_tile(const u16* sK, const u16* sV, const bf16x8 (&q)[2], f32x4 (&acc)[4],
                                         float& m, float& l, float slope2, float gmul,
                                         int t, int pos0, int pstride, int wl, bool lanesel,
                                         float* imp_row, int jbase, float& carry, int lane) {
  const int l16 = lane & 15, gk = lane >> 4;
  const float scale2 = 0.125f * LOG2E;
  const unsigned wle = lanesel ? (unsigned)wl : 0u;
  f32x4 s[4];
  qk_tile(sK, q, s, l16, gk);
  float xv[4][4];
  float mx = -1e30f;
#pragma unroll
  for (int kt = 0; kt < 4; ++kt)
#pragma unroll
    for (int r = 0; r < 4; ++r) {
      const int dist = t - (pos0 + (kt * 16 + gk * 4 + r) * pstride);
      const float pen = ((unsigned)dist < wle) ? 0.f : -1e30f;
      const float v = fmaf(s[kt][r], scale2, fmaf(-slope2, (float)dist, pen));
      xv[kt][r] = v; mx = fmaxf(mx, v);
    }
  if (BR != 1) {
    mx = fmaxf(mx, __shfl_xor(mx, 16)); mx = fmaxf(mx, __shfl_xor(mx, 32));
    const float mnew = fmaxf(m, mx);
    const float alpha = ex2(m - mnew);
    m = mnew;
    const float muse = fmaxf(mnew, -1e20f);
    float rs = 0.f;
#pragma unroll
    for (int kt = 0; kt < 4; ++kt)
#pragma unroll
      for (int r = 0; r < 4; ++r) { xv[kt][r] = ex2(xv[kt][r] - muse); rs += xv[kt][r]; }
    l = l * alpha + rs;
    if (BR == 2) {
#pragma unroll
      for (int dt = 0; dt < 4; ++dt) acc[dt] *= alpha;
      pv_tile(sV, xv, acc, l16, gk);
    }
  } else {
    const float muse = fmaxf(m, -1e20f);
    float p3[4];
#pragma unroll
    for (int kt = 0; kt < 4; ++kt) {
      float pn[4];
#pragma unroll
      for (int r = 0; r < 4; ++r) { pn[r] = ex2(xv[kt][r] - muse) * l; xv[kt][r] = pn[r] * gmul; }
      p3[kt] = pn[3];
      xv[kt][0] = xv[kt][0];
      imp_row[jbase + kt * 4 + gk] = 2.f * (pn[0] + pn[1] + pn[2]) + pn[3];
    }
    const int srcl = (lane + 48) & 63;
#pragma unroll
    for (int kt = 0; kt < 4; ++kt) {
      const float same = __shfl(p3[kt], srcl);
      const float prev = __shfl(kt > 0 ? p3[kt > 0 ? kt - 1 : 0] : carry, srcl);
      imp_row[jbase + kt * 4 + gk] += (gk == 0) ? prev : same;
    }
    carry = p3[3];
    pv_tile(sV, xv, acc, l16, gk);
  }
}

__device__ __forceinline__ void nsa_phase(const Params& p, u16* lds) {
  const u16* U = (const u16*)(p.ws + WS_QK);
  const u16* VT = (const u16*)(p.ws + WS_VT);
  const u16* KC = (const u16*)(p.ws + WS_KCMP);
  const u16* VC = (const u16*)(p.ws + WS_VCMPT);
  const float* GL = (const float*)(p.ws + WS_GL);
  u16* Y = (u16*)(p.ws + WS_Y);
  float* imp = (float*)(lds + 512 * TS);
  uint32_t* umask = (uint32_t*)(imp + 128 * IMPS);
  int* ulist = (int*)(umask + 4);
  const int tid = TIDX, lane = tid & 63, w = tid >> 6, l16 = lane & 15, gk = lane >> 4;
  const int qt = w & 1, hd = w >> 1;
  uint2* totl = (uint2*)imp + 128 + (size_t)w * 256 + lane;
  const int BIG = 1 << 30;
  for (int unit = BIDX; unit < 4096; unit += gridDim.x) {
    const int bg = unit & 15, qh = 255 - (unit >> 4), b = bg >> 2, g = bg & 3;
    const int t0 = qh * 32, qb = t0 >> 6, t = t0 + 16 * qt + l16;
    const size_t mrow = (size_t)b * SEQ + t;
    const int h = g * 4 + hd;
    bf16x8 q[2];
#pragma unroll
    for (int ks = 0; ks < 2; ++ks) q[ks] = *(const bf16x8*)(U + mrow * LDQ + h * 64 + ks * 32 + gk * 8);
    const float slope2 = exp2f(-0.5f * (float)(h + 1)) * LOG2E;
    const float g1 = sigmoid_f(GL[mrow * 48 + h * 3] + p.o_bg[h * 3]);
    float sk[16];
#pragma unroll
    for (int i = 0; i < 16; ++i) sk[i] = slope2 * (float)((i >> 2) * 16 + (i & 3));
    f32x4 acc[4];
    float m = -1e30f, l = 0.f;
#pragma unroll
    for (int dt = 0; dt < 4; ++dt) acc[dt] = (f32x4){0.f, 0.f, 0.f, 0.f};
    __syncthreads();
    for (int i = tid; i < 128 * IMPS; i += NTHR) imp[i] = 0.f;
    if (tid < 4) umask[tid] = 0u;
    float* imp_row = imp + (hd * 32 + 16 * qt + l16) * IMPS;
    float carry = 0.f;
    uint4 rk0, rk1, rk2, rk3, rv0, rv1, rv2, rv3;
    u16* impbase_unused = nullptr; (void)impbase_unused;
#define SLOT(k) (lds + (k) * (128 * TS))
#define LD1(k, kp, ks_, vp, vs_) { rk##k = *(const uint4*)((kp) + (long)(tid >> 3) * (ks_) + (tid & 7) * 8); rv##k = *(const uint4*)((vp) + (long)(tid >> 3) * (vs_) + (tid & 7) * 8); }
#define ST1(k) { *(uint4*)(SLOT(k) + (tid >> 3) * TS + (tid & 7) * 8) = rk##k; TILE_STV_(SLOT(k) + 64 * TS, rv##k) }
    const int ntc = ((t0 >> 4) >> 6) + 1;
    const u16* kcs = KC + (size_t)bg * 512 * 64;
    const u16* vcs = VC + (size_t)bg * 32768;
#define CMP_LD(k, i) if ((i) < ntc) LD1(k, kcs + (size_t)(i) * 64 * 64, 64, vcs + (i) * 64, 512)
#pragma unroll 1
    for (int pass = 0; pass < 2; ++pass) {
      const int ngrp = (ntc + 3) >> 2;
      CMP_LD(0, 0) CMP_LD(1, 1) CMP_LD(2, 2) CMP_LD(3, 3)
#pragma unroll 1
      for (int gi = 0; gi < ngrp; ++gi) {
        const int ib = gi * 4;
        __syncthreads();
        if (ib < ntc) ST1(0) if (ib + 1 < ntc) ST1(1) if (ib + 2 < ntc) ST1(2) if (ib + 3 < ntc) ST1(3)
        __syncthreads();
        if (gi + 1 < ngrp) { CMP_LD(0, ib + 4) CMP_LD(1, ib + 5) CMP_LD(2, ib + 6) CMP_LD(3, ib + 7) }
#pragma unroll 1
        for (int k = 0; k < 4; ++k) {
          const int i = ib + k;
          if (i < ntc) {
            if (pass == 0) nsa_tile<0>(SLOT(k), SLOT(k) + 64 * TS, q, acc, m, l, slope2, g1, t, 16 * (64 * i) + 31, 16, BIG, true, imp_row, 16 * i, carry, lane);
            else nsa_tile<1>(SLOT(k), SLOT(k) + 64 * TS, q, acc, m, l, slope2, g1, t, 16 * (64 * i) + 31, 16, BIG, true, imp_row, 16 * i, carry, lane);
          }
        }
      }
      if (pass == 0) {
        float lt = l; lt += __shfl_xor(lt, 16); lt += __shfl_xor(lt, 32);
        l = lt > 0.f ? 1.f / lt : 0.f;
      }
    }
    __syncthreads();
    {
      const int qi = w * 4 + gk;
      const int c8 = l16 * 8;
      uint32_t selb = 0u;
      if (qb < 16) {
#pragma unroll
        for (int i = 0; i < 8; ++i) if (c8 + i <= qb) selb |= (1u << i);
      } else {
        float val[8];
        const float* ra = imp + qi * IMPS + c8;
#pragma unroll
        for (int i4 = 0; i4 < 2; ++i4) {
          const float4 v0 = *(const float4*)(ra + 4 * i4);
          const float4 v1 = *(const float4*)(ra + 32 * IMPS + 4 * i4);
          const float4 v2 = *(const float4*)(ra + 64 * IMPS + 4 * i4);
          const float4 v3 = *(const float4*)(ra + 96 * IMPS + 4 * i4);
          val[4 * i4] = ((v0.x + v1.x) + v2.x) + v3.x; val[4 * i4 + 1] = ((v0.y + v1.y) + v2.y) + v3.y;
          val[4 * i4 + 2] = ((v0.z + v1.z) + v2.z) + v3.z; val[4 * i4 + 3] = ((v0.w + v1.w) + v2.w) + v3.w;
        }
#pragma unroll
        for (int i = 0; i < 8; ++i) {
          const int j = c8 + i;
          const bool forced = (j == 0) || (j == qb) || (j == qb - 1);
          if (forced) selb |= (1u << i);
          if (forced || j > qb) val[i] = -1.f;
        }
#pragma unroll 1
        for (int it = 0; it < 13; ++it) {
          float best = -2.f; int bj = 0;
#pragma unroll
          for (int i = 0; i < 8; ++i) {
            const float v = ((selb >> i) & 1u) ? -1.f : val[i];
            if (v > best) { best = v; bj = c8 + i; }
          }
#pragma unroll
          for (int o = 1; o <= 8; o <<= 1) {
            const float ov = __shfl_xor(best, o); const int oj = __shfl_xor(bj, o);
            if (ov > best || (ov == best && oj < bj)) { best = ov; bj = oj; }
          }
          if ((bj >> 3) == l16) selb |= (1u << (bj & 7));
        }
      }
      uint32_t wd = selb << ((l16 & 3) * 8);
      wd |= __shfl_xor(wd, 1); wd |= __shfl_xor(wd, 2);
      __syncthreads();
      uint32_t* selw = (uint32_t*)imp;
      if ((l16 & 3) == 0) selw[qi * 4 + (l16 >> 2)] = wd;
      uint32_t uq = wd; uq |= __shfl_xor(uq, 16); uq |= __shfl_xor(uq, 32);
      if (gk == 0 && (l16 & 3) == 0) atomicOr(&umask[l16 >> 2], uq);
    }
    __syncthreads();
    const uint32_t* selq = (const uint32_t*)imp + (16 * qt + l16) * 4;
    const uint32_t sel0 = selq[0], sel1 = selq[1], sel2 = selq[2], sel3 = selq[3];
    uint32_t wun0 = sel0, wun1 = sel1, wun2 = sel2, wun3 = sel3;
#pragma unroll
    for (int o = 1; o <= 8; o <<= 1) { wun0 |= __shfl_xor(wun0, o); wun1 |= __shfl_xor(wun1, o); wun2 |= __shfl_xor(wun2, o); wun3 |= __shfl_xor(wun3, o); }
    int nsl = 0;
    {
      const uint32_t u0 = umask[0], u1 = umask[1], u2 = umask[2], u3 = umask[3];
      nsl = __popc(u0) + __popc(u1) + __popc(u2) + __popc(u3);
      if (tid < 128) {
        const uint32_t uw = tid < 32 ? u0 : tid < 64 ? u1 : tid < 96 ? u2 : u3;
        if ((uw >> (tid & 31)) & 1u) {
          int pos = __popc(uw & ((1u << (tid & 31)) - 1u));
          if (tid >= 32) pos += __popc(u0);
          if (tid >= 64) pos += __popc(u1);
          if (tid >= 96) pos += __popc(u2);
          ulist[pos] = tid;
        }
      }
    }
    __syncthreads();
#pragma unroll
    for (int dt = 0; dt < 4; ++dt) {
      uint2 o2; o2.x = pack2(acc[dt][0], acc[dt][1]); o2.y = pack2(acc[dt][2], acc[dt][3]);
      totl[dt * 64] = o2;
    }
#pragma unroll 1
    for (int br = 1; br < 3; ++br) {
      m = -1e30f; l = 0.f;
#pragma unroll
      for (int dt = 0; dt < 4; ++dt) acc[dt] = (f32x4){0.f, 0.f, 0.f, 0.f};
      int wfirst = ((t0 - 511) >> 6) << 6; if (wfirst < 0) wfirst = 0;
      const int nt = (br == 1) ? nsl : ((qb * 64 - wfirst) >> 6) + 1;
      const int ngrp = (nt + 3) >> 2;
      const u16* kb = U + (size_t)b * SEQ * LDQ + (br == 1 ? 1536 : 1792) + g * 64;
      const u16* vb = VT + (size_t)((br == 1 ? 0 : 256) + g * 64) * MTOK + (size_t)b * SEQ;
#define SRC_S0(i) ((br == 1) ? ulist[nt - 1 - (i)] * 64 : wfirst + 64 * (nt - 1 - (i)))
#define BR_LD(k, i) if ((i) < nt) { const int s_ = SRC_S0(i); LD1(k, kb + (size_t)s_ * LDQ, LDQ, vb + s_, MTOK) }
      BR_LD(0, 0) BR_LD(1, 1) BR_LD(2, 2) BR_LD(3, 3)
#pragma unroll 1
      for (int gi = 0; gi < ngrp; ++gi) {
        const int ib = gi * 4;
        __syncthreads();
        if (ib < nt) ST1(0) if (ib + 1 < nt) ST1(1) if (ib + 2 < nt) ST1(2) if (ib + 3 < nt) ST1(3)
        __syncthreads();
        if (gi + 1 < ngrp) { BR_LD(0, ib + 4) BR_LD(1, ib + 5) BR_LD(2, ib + 6) BR_LD(3, ib + 7) }
#pragma unroll 1
        for (int k = 0; k < 4; ++k) {
          const int i = ib + k;
          if (i < nt) {
            const int s0 = SRC_S0(i);
            bool wsel = true, ls = true;
            int wl = 512;
            if (br == 1) {
              const int j = s0 >> 6, jw = j >> 5, jb = j & 31;
              const uint32_t ww = jw == 0 ? wun0 : jw == 1 ? wun1 : jw == 2 ? wun2 : wun3;
              const uint32_t sw = jw == 0 ? sel0 : jw == 1 ? sel1 : jw == 2 ? sel2 : sel3;
              wsel = (ww >> jb) & 1u; ls = (sw >> jb) & 1u; wl = BIG;
            }
            if (wsel) {
              const int tq0 = t0 + 16 * qt;
              const bool interior = (s0 + 63 <= tq0) && (br == 1 || s0 + 512 > tq0 + 15);
              if (interior) nsa_tile_interior(SLOT(k), SLOT(k) + 64 * TS, q, acc, m, l, slope2, sk, t, s0, ls, lane);
              else nsa_tile<2>(SLOT(k), SLOT(k) + 64 * TS, q, acc, m, l, slope2, g1, t, s0, 1, wl, ls, imp_row, 0, carry, lane);
            }
          }
        }
      }
      {
        float lt = l; lt += __shfl_xor(lt, 16); lt += __shfl_xor(lt, 32);
        const float gt = sigmoid_f(GL[mrow * 48 + h * 3 + br] + p.o_bg[h * 3 + br]);
        const float sc = lt > 0.f ? gt / lt : 0.f;
#pragma unroll
        for (int dt = 0; dt < 4; ++dt) {
          const uint2 pv = totl[dt * 64];
          const float r0 = bf2f(pv.x & 0xffff) + acc[dt][0] * sc, r1 = bf2f(pv.x >> 16) + acc[dt][1] * sc;
          const float r2 = bf2f(pv.y & 0xffff) + acc[dt][2] * sc, r3 = bf2f(pv.y >> 16) + acc[dt][3] * sc;
          if (br == 1) {
            uint2 o2; o2.x = pack2(r0, r1); o2.y = pack2(r2, r3);
            totl[dt * 64] = o2;
          } else {
            const int col = h * 64 + dt * 16 + gk * 4;
            const uint2 zz = *(const uint2*)(U + mrow * LDQ + 2048 + col);
            const float z0 = bf2f(zz.x & 0xffff), z1 = bf2f(zz.x >> 16), z2 = bf2f(zz.y & 0xffff), z3 = bf2f(zz.y >> 16);
            uint2 ov;
            ov.x = pack2(r0 * silu_f(z0), r1 * silu_f(z1));
            ov.y = pack2(r2 * silu_f(z2), r3 * silu_f(z3));
            *(uint2*)(Y + mrow * DM + col) = ov;
          }
        }
      }
    }
#undef SLOT
#undef LD1
#undef ST1
#undef CMP_LD
#undef SRC_S0
#undef BR_LD
  }
}

__device__ __forceinline__ void final_norm(const Params& p) {
  const int lane = TIDX & 63, wave = TIDX >> 6;
  for (int row = BIDX * NWAVE + wave; row < MTOK; row += gridDim.x * NWAVE) {
    float4* xr = (float4*)(p.out + (size_t)row * DM);
    float4 v[4];
    float ss = 0.f;
#pragma unroll
    for (int i = 0; i < 4; ++i) {
      v[i] = xr[lane + 64 * i];
      ss += v[i].x * v[i].x + v[i].y * v[i].y + v[i].z * v[i].z + v[i].w * v[i].w;
    }
#pragma unroll
    for (int o = 32; o >= 1; o >>= 1) ss += __shfl_xor(ss, o);
    const float rstd = rsqrtf(ss * (1.f / DM) + 1e-6f);
#pragma unroll
    for (int i = 0; i < 4; ++i) {
      const float4 gg = ((const float4*)p.fin_g)[lane + 64 * i];
      xr[lane + 64 * i] = (float4){v[i].x * rstd * gg.x, v[i].y * rstd * gg.y, v[i].z * rstd * gg.z, v[i].w * rstd * gg.w};
    }
  }
}

__device__ __forceinline__ void grid_bar(const Params& p, unsigned& target) {
  __syncthreads();
  target += gridDim.x;
  if (TIDX == 0) {
    unsigned* ctr = (unsigned*)(p.ws + WS_BAR);
    __threadfence();
    __hip_atomic_fetch_add(ctr, 1u, __ATOMIC_RELAXED, __HIP_MEMORY_SCOPE_AGENT);
    while (__hip_atomic_load(ctr, __ATOMIC_RELAXED, __HIP_MEMORY_SCOPE_AGENT) < target) __builtin_amdgcn_s_sleep(1);
    __threadfence();
  }
  __syncthreads();
}

__global__ void __launch_bounds__(NTHR, 2) mega(Params p_in) {
  Params p = p_in;
  p.pad = __builtin_amdgcn_readfirstlane((int)threadIdx.x >> 6);
  unsigned bar_target = 0u;
  extern __shared__ __attribute__((aligned(16))) unsigned char lds_raw[];
  u16* lds = (u16*)lds_raw;
  cg::grid_group grid = cg::this_grid();
  if (p_in.coop == 2) grid.sync();
#define PH_ON(k) (p.ph_lo <= (k) && (k) <= p.ph_hi)
#define PH_SYNC(k) if (p.coop && p.ph_lo <= (k) && (k) < p.ph_hi) grid_bar(p, bar_target);
  if (PH_ON(0)) {
    rms_rows(p, p.x, p.e_ng, (u16*)(p.ws + WS_HBF));
    conv_t(p, (u16*)(p.ws + WS_WT0), p.e_win, 1024, 4104, 4352, 0);
    conv_t(p, (u16*)(p.ws + WS_WT1), p.o_win, 1024, 3632, 3840, 1);
    conv_t(p, (u16*)(p.ws + WS_WO0), p.e_wout, 1024, 1024, 1024, 2);
    conv_t(p, (u16*)(p.ws + WS_WO1), p.o_wout, 1024, 1024, 1024, 2);
    conv_t(p, (u16*)(p.ws + WS_W1K), p.o_wk1, 2048, 256, 256, 2);
    conv_t(p, (u16*)(p.ws + WS_W1V), p.o_wv1, 2048, 256, 256, 2);
    conv_t(p, (u16*)(p.ws + WS_W2K), p.o_wk2, 256, 64, 256, 2);
    conv_t(p, (u16*)(p.ws + WS_W2V), p.o_wv2, 256, 64, 256, 2);
    pe_partial(p);
    if (BIDX == 0 && TIDX < 8) ((uint32_t*)(p.ws + WS_KMAX))[TIDX] = 0u;
    for (int i = BIDX * NTHR + TIDX; i < MTOK; i += gridDim.x * NTHR) ((float*)(p.ws + WS_SSQ))[i] = 0.f;
  }
  PH_SYNC(0)
  if (PH_ON(1)) gemm_inproj(p, 0, lds);
  PH_SYNC(1)
  if (PH_ON(2)) {
    fox_scan(p, (float*)lds); ret_stepA(p); fox_knorm(p);
    if (BIDX == gridDim.x - 1) {
      for (int i = TIDX; i < 512; i += NTHR) {
        const float* part = (const float*)(p.ws + WS_PEP);
        float sum = 0.f;
        for (int kc = 0; kc < 16; ++kc) sum += part[((i >> 8) * 16 + kc) * 256 + (i & 255)];
        ((float*)(p.ws + WS_PEB))[i] = sum;
      }
    }
  }
  PH_SYNC(2)
  if (PH_ON(3)) { ret_stepB(p); fox_phase(p, lds); }
  PH_SYNC(3)
  if (PH_ON(4)) ret_stepC(p, lds);
  PH_SYNC(4)
  if (PH_ON(5)) gemm_outproj(p, 0, lds);
  PH_SYNC(5)
  if (PH_ON(7)) gemm_inproj(p, 1, lds);
  PH_SYNC(7)
  if (PH_ON(8)) gemm_cmp1(p, lds);
  PH_SYNC(8)
  if (PH_ON(10)) nsa_phase(p, lds);
  PH_SYNC(10)
  if (PH_ON(11)) gemm_outproj(p, 1, lds);
  PH_SYNC(11)
  if (PH_ON(12)) final_norm(p);
}

extern "C" void kernel_launch(void* const* d_in, const int* in_sizes, int n_in, void* d_out, int out_size, void* d_ws,
                              size_t ws_size, hipStream_t stream) {
  static int grid_blocks = 0;
  if (!grid_blocks) {
    int dev = 0, cus = 0, per_cu = 0;
    hipGetDevice(&dev);
    hipDeviceGetAttribute(&cus, hipDeviceAttributeMultiprocessorCount, dev);
    hipFuncSetAttribute((const void*)mega, hipFuncAttributeMaxDynamicSharedMemorySize, LDS_BYTES);
    hipOccupancyMaxActiveBlocksPerMultiprocessor(&per_cu, (const void*)mega, NTHR, LDS_BYTES);
    if (per_cu < 1) per_cu = 1;
    if (per_cu > 1) per_cu = 1;
    grid_blocks = cus * per_cu;
    (void)hipGetLastError();
  }
  Params p{};
  p.x = (const float*)d_in[0]; p.e_ng = (const float*)d_in[1]; p.e_win = (const float*)d_in[2];
  p.e_bf = (const float*)d_in[3]; p.e_gn = (const float*)d_in[4]; p.e_wout = (const float*)d_in[5];
  p.o_ng = (const float*)d_in[6]; p.o_win = (const float*)d_in[7]; p.o_bg = (const float*)d_in[8];
  p.o_pek = (const float*)d_in[9]; p.o_pev = (const float*)d_in[10]; p.o_wk1 = (const float*)d_in[11];
  p.o_wk2 = (const float*)d_in[12]; p.o_wv1 = (const float*)d_in[13]; p.o_wv2 = (const float*)d_in[14];
  p.o_wout = (const float*)d_in[15]; p.fin_g = (const float*)d_in[16];
  p.out = (float*)d_out; p.ws = (unsigned char*)d_ws;
#if ONE_LAUNCH
  p.ph_lo = 0; p.ph_hi = NPHASE - 1; p.coop = 1;
  (void)hipMemsetAsync((unsigned char*)d_ws + WS_BAR, 0, 64, stream);
  void* args[] = {&p};
  hipError_t e = hipLaunchCooperativeKernel((const void*)mega, dim3(grid_blocks), dim3(NTHR), args, LDS_BYTES, stream);
  if (e != hipSuccess) fprintf(stderr, "cooperative launch failed: %s (grid %d)\n", hipGetErrorString(e), grid_blocks);
#else
  for (int ph = 0; ph < NPHASE; ++ph) {
    p.ph_lo = ph; p.ph_hi = ph; p.coop = 0;
    hipLaunchKernelGGL(mega, dim3(grid_blocks), dim3(NTHR), LDS_BYTES, stream, p);
  }
#endif
}
```

```cpp
#include <hip/hip_runtime.h>
#include <hip/hip_cooperative_groups.h>
#include <stdint.h>
#include <stdio.h>
namespace cg = cooperative_groups;

typedef unsigned short u16;
typedef short bf16x8 __attribute__((ext_vector_type(8)));
typedef short bf16x4 __attribute__((ext_vector_type(4)));
typedef float f32x4 __attribute__((ext_vector_type(4)));

#ifndef ONE_LAUNCH
#define ONE_LAUNCH 1
#endif

#define MTOK 32768
#define SEQ 8192
#define DM 1024
#define LDQ 3072
#define LOG2E 1.4426950408889634f
#define TS 72
#define IMPS 132
#define LDS_BYTES 147456
#define NTHR 512
#define NWAVE 8
#define NPHASE 13

#define MiB (1024ull * 1024ull)
#define WS_HBF   (0ull)
#define WS_DS    (0ull)
#define WS_ST    (32ull * MiB)
#define WS_QK    (64ull * MiB)
#define WS_VT    (256ull * MiB)
#define WS_Y     (352ull * MiB)
#define WS_WT0   (416ull * MiB)
#define WS_WT1   (WS_WT0 + 4352ull * 1024 * 2)
#define WS_WO0   (WS_WT1 + 3840ull * 1024 * 2)
#define WS_WO1   (WS_WO0 + 1024ull * 1024 * 2)
#define WS_W1K   (WS_WO1 + 1024ull * 1024 * 2)
#define WS_W1V   (WS_W1K + 256ull * 2048 * 2)
#define WS_W2K   (WS_W1V + 256ull * 2048 * 2)
#define WS_W2V   (WS_W2K + 256ull * 256 * 2)
#define WS_FLOG  (440ull * MiB)
#define WS_CFOX  (441ull * MiB)
#define WS_GL    (442ull * MiB)
#define WS_HC    (448ull * MiB)
#define WS_KCMP  (456ull * MiB)
#define WS_VCMPT (457ull * MiB)
#define WS_PEP   (458ull * MiB)
#define WS_PEB   (WS_PEP + 65536ull)
#define WS_KMAX  (WS_PEB + 4096ull)
#define WS_SSQ   (459ull * MiB)
#define WS_BAR   (WS_KMAX + 4096ull)

struct Params {
  const float *x, *e_ng, *e_win, *e_bf, *e_gn, *e_wout;
  const float *o_ng, *o_win, *o_bg, *o_pek, *o_pev, *o_wk1, *o_wk2, *o_wv1, *o_wv2, *o_wout, *fin_g;
  float* out;
  unsigned char* ws;
  int ph_lo, ph_hi, coop, pad;
};

typedef __bf16 bf16v2 __attribute__((ext_vector_type(2)));
typedef float f32v2 __attribute__((ext_vector_type(2)));
__device__ __forceinline__ uint32_t pack2(float a, float b) {
  f32v2 v = {a, b};
  bf16v2 r = __builtin_convertvector(v, bf16v2);
  return *(uint32_t*)&r;
}
__device__ __forceinline__ u16 f2bf(float f) { return (u16)(pack2(f, 0.f) & 0xffffu); }
__device__ __forceinline__ float bf2f(u16 h) { return __uint_as_float(((uint32_t)h) << 16); }
__device__ __forceinline__ float ex2(float x) { return __builtin_amdgcn_exp2f(x); }
__device__ __forceinline__ float silu_f(float z) { return z * __builtin_amdgcn_rcpf(1.f + ex2(-z * LOG2E)); }
__device__ __forceinline__ float sigmoid_f(float z) { return __builtin_amdgcn_rcpf(1.f + ex2(-z * LOG2E)); }

__device__ __forceinline__ int opq(int v) { asm volatile("" : "+v"(v)); return v; }
__device__ __forceinline__ int opqs(int v) { asm volatile("" : "+s"(v)); return v; }
#define TIDX opq(p.pad * 64 + (int)__lane_id())
#define BIDX opqs((int)blockIdx.x)
#define MFMA(a, b, c) __builtin_amdgcn_mfma_f32_16x16x32_bf16((a), (b), (c), 0, 0, 0)

__device__ __forceinline__ void rms_rows(const Params& p, const float* __restrict__ x, const float* __restrict__ g, u16* __restrict__ h) {
  const int lane = TIDX & 63, wave = TIDX >> 6;
  for (int row = BIDX * NWAVE + wave; row < MTOK; row += gridDim.x * NWAVE) {
    const float4* xr = (const float4*)(x + (size_t)row * DM);
    float4 v[4];
    float ss = 0.f;
#pragma unroll
    for (int i = 0; i < 4; ++i) {
      v[i] = xr[lane + 64 * i];
      ss += v[i].x * v[i].x + v[i].y * v[i].y + v[i].z * v[i].z + v[i].w * v[i].w;
    }
#pragma unroll
    for (int o = 32; o >= 1; o >>= 1) ss += __shfl_xor(ss, o);
    const float rstd = rsqrtf(ss * (1.f / DM) + 1e-6f);
#pragma unroll
    for (int i = 0; i < 4; ++i) {
      float4 gg = ((const float4*)g)[lane + 64 * i];
      uint2 o;
      o.x = pack2(v[i].x * rstd * gg.x, v[i].y * rstd * gg.y);
      o.y = pack2(v[i].z * rstd * gg.z, v[i].w * rstd * gg.w);
      *(uint2*)(h + (size_t)row * DM + (lane + 64 * i) * 4) = o;
    }
  }
}

__device__ __forceinline__ int map_col(int MAP, int n) {
  if (MAP == 0) {
    if (n < 1024) return n;
    if (n < 2048) return n + 520;
    if (n < 3072) return n + 1032;
    if (n < 3584) return n - 2048;
    if (n < 4096) return n - 1016;
    if (n < 4104) return n - 2560;
    return -1;
  } else if (MAP == 1) {
    if (n < 1792) return n;
    if (n < 2048) return n + 256;
    if (n < 3072) return n + 560;
    if (n < 3328) return n - 1280;
    if (n < 3584) return n - 1024;
    if (n < 3632) return n - 1024;
    return -1;
  } else if (MAP == 2) {
    return n;
  }
  return n;
}

__device__ __forceinline__ void conv_t(const Params& p, u16* __restrict__ dst, const float* __restrict__ src, int K, int nsrc, int ndst, int MAP) {
  const int total = ndst * (K >> 3);
  for (int id = BIDX * NTHR + TIDX; id < total; id += gridDim.x * NTHR) {
    const int n = id % ndst, kc = id / ndst;
    const int sc = map_col(MAP, n);
    float v[8];
#pragma unroll
    for (int i = 0; i < 8; ++i) v[i] = (sc >= 0 && sc < nsrc) ? src[(size_t)(kc * 8 + i) * nsrc + sc] : 0.f;
    uint4 o;
    o.x = pack2(v[0], v[1]); o.y = pack2(v[2], v[3]); o.z = pack2(v[4], v[5]); o.w = pack2(v[6], v[7]);
    *(uint4*)(dst + (size_t)n * K + kc * 8) = o;
  }
}

__device__ __forceinline__ void pe_partial(const Params& p) {
  float* part = (float*)(p.ws + WS_PEP);
  for (int task = BIDX; task < 32; task += gridDim.x) {
    const int kv = task >> 4, kc = task & 15, n = TIDX;
    if (n >= 256) continue;
    const float* pe = kv ? p.o_pev : p.o_pek;
    const float* w1 = kv ? p.o_wv1 : p.o_wk1;
    float acc = 0.f;
#pragma unroll 16
    for (int k = kc * 128; k < kc * 128 + 128; ++k) acc += pe[k] * w1[(size_t)k * 256 + n];
    part[(kv * 16 + kc) * 256 + n] = acc;
  }
}

#define GST (512 * TS)
template <bool swapped>
__device__ __forceinline__ void gemm_compute(const u16* cur, f32x4 (&acc)[8][4], int wpa, int wpb, int l16, int gk) {
  const u16* sA = cur + (wpa * 128 + l16) * TS + gk * 8;
  const u16* sB = cur + (256 + wpb * 64 + l16) * TS + gk * 8;
#pragma unroll 1
  for (int kk = 0; kk < 2; ++kk) {
    bf16x8 fa[8], fb[4];
#pragma unroll
    for (int i = 0; i < 8; ++i) fa[i] = *(const bf16x8*)(sA + i * 16 * TS + kk * 32);
#pragma unroll
    for (int j = 0; j < 4; ++j) fb[j] = *(const bf16x8*)(sB + j * 16 * TS + kk * 32);
    if (swapped) {
#pragma unroll
      for (int i = 0; i < 8; ++i)
#pragma unroll
        for (int j = 0; j < 4; ++j) acc[i][j] = MFMA(fb[j], fa[i], acc[i][j]);
    } else {
#pragma unroll
      for (int i = 0; i < 8; ++i)
#pragma unroll
        for (int j = 0; j < 4; ++j) acc[i][j] = MFMA(fa[i], fb[j], acc[i][j]);
    }
  }
}
template <bool swapped>
__device__ __forceinline__ void gemm_mainloop(const Params& p, const u16* __restrict__ Ab, const uint32_t (&pa)[4], const u16* __restrict__ Bb,
                                              const uint32_t (&pb)[4], int a_kstride, int nk,
                                              u16* lds, f32x4 (&acc)[8][4]) {
  const int tid = TIDX, lane = tid & 63, wave = tid >> 6;
  const int l16 = lane & 15, gk = lane >> 4;
  const int wpa = wave >> 2, wpb = wave & 3;
  const int woff = (tid >> 3) * TS + (tid & 7) * 8;
  uint4 ra0, ra1, ra2, ra3, rb0, rb1, rb2, rb3;
#define G_LD(kidx) { const u16* Ap_ = Ab + (size_t)(kidx) * a_kstride; const u16* Bp_ = Bb + (size_t)(kidx) * 64;   \
    ra0 = *(const uint4*)(Ap_ + pa[0]); ra1 = *(const uint4*)(Ap_ + pa[1]); ra2 = *(const uint4*)(Ap_ + pa[2]); ra3 = *(const uint4*)(Ap_ + pa[3]); \
    rb0 = *(const uint4*)(Bp_ + pb[0]); rb1 = *(const uint4*)(Bp_ + pb[1]); rb2 = *(const uint4*)(Bp_ + pb[2]); rb3 = *(const uint4*)(Bp_ + pb[3]); }
#define G_ST(D) { u16* D_ = (D) + woff;                                                                               \
    *(uint4*)(D_) = ra0; *(uint4*)(D_ + 64 * TS) = ra1; *(uint4*)(D_ + 128 * TS) = ra2; *(uint4*)(D_ + 192 * TS) = ra3;  \
    *(uint4*)(D_ + 256 * TS) = rb0; *(uint4*)(D_ + 320 * TS) = rb1; *(uint4*)(D_ + 384 * TS) = rb2; *(uint4*)(D_ + 448 * TS) = rb3; }
  G_LD(0)
  __syncthreads();
  G_ST(lds)
  __syncthreads();
#pragma unroll
  for (int i = 0; i < 8; ++i)
#pragma unroll
    for (int j = 0; j < 4; ++j) acc[i][j] = (f32x4){0.f, 0.f, 0.f, 0.f};
#pragma unroll 1
  for (int ks = 0; ks < nk; ++ks) {
    const bool more = (ks + 1 < nk);
    if (more) G_LD(ks + 1)
    gemm_compute<swapped>(lds + (ks & 1) * GST, acc, wpa, wpb, l16, gk);
    if (more) G_ST(lds + ((ks + 1) & 1) * GST)
    __syncthreads();
  }
#undef G_LD
#undef G_ST
}
#define GEMM_OFFS(rowstrideA, rowstrideB)                                   \
  uint32_t pa[4], pb[4];                                                    \
  _Pragma("unroll") for (int i = 0; i < 4; ++i) {                           \
    pa[i] = (uint32_t)((tid >> 3) + 64 * i) * (rowstrideA) + (tid & 7) * 8; \
    pb[i] = (uint32_t)((tid >> 3) + 64 * i) * (rowstrideB) + (tid & 7) * 8; \
  }

__device__ __forceinline__ void gemm_inproj(const Params& p, int layer, u16* lds) {
  const u16* A = (const u16*)(p.ws + WS_HBF);
  const u16* Bt = (const u16*)(p.ws + (layer ? WS_WT1 : WS_WT0));
  u16* QK = (u16*)(p.ws + WS_QK);
  u16* VT = (u16*)(p.ws + WS_VT);
  float* F = (float*)(p.ws + (layer ? WS_GL : WS_FLOG));
  const int NT = layer ? 15 : 17;
  const int seg_trans_end = layer ? 28 : 32;
  const int nvalidF = layer ? 48 : 8, ldf = layer ? 48 : 8;
  const int tid = TIDX, lane = tid & 63, wave = tid >> 6, l16 = lane & 15, gk = lane >> 4;
  const int wpa = wave >> 2, wpb = wave & 3;
  const int bid = BIDX, xcd = bid & 7, nloc = (int)gridDim.x >> 3;
  for (int q = bid >> 3; q < 16 * NT; q += nloc) {
    const int mt = xcd * 16 + q / NT, nt = q % NT;
    const int m0 = mt * 256, n0 = nt * 256;
    const int mw = m0 + wpa * 128, nw = n0 + wpb * 64;
    const int seg = nw >> 7;
    int mode;
    if (seg < 24) mode = (layer == 0 && seg >= 12 && seg < 16) ? 2 : 0;
    else if (seg < seg_trans_end) mode = 1;
    else if (seg == seg_trans_end) mode = 3;
    else mode = 4;
    const int seg0 = nt * 2;
    const bool swapped = !((seg0 >= 24 && seg0 < seg_trans_end) || (layer == 0 && seg0 >= 12 && seg0 < 16));
    GEMM_OFFS(DM, DM)
    f32x4 acc[8][4];
    if (swapped) gemm_mainloop<true>(p, A + (size_t)m0 * DM, pa, Bt + (size_t)n0 * DM, pb, 64, 16, lds, acc);
    else gemm_mainloop<false>(p, A + (size_t)m0 * DM, pa, Bt + (size_t)n0 * DM, pb, 64, 16, lds, acc);
    const float* ssq_g = (const float*)(p.ws + WS_SSQ);
    if (mode == 0 || mode == 3) {
#pragma unroll
      for (int i = 0; i < 8; ++i) {
        const int m = mw + i * 16 + l16;
        const float rs = layer ? rsqrtf(ssq_g[m] * (1.f / DM) + 1e-6f) : 1.f;
#pragma unroll
        for (int j = 0; j < 4; ++j) {
          const int n = nw + j * 16 + gk * 4;
          const float a0 = acc[i][j][0] * rs, a1 = acc[i][j][1] * rs, a2 = acc[i][j][2] * rs, a3 = acc[i][j][3] * rs;
          if (mode == 0) {
            uint2 o; o.x = pack2(a0, a1); o.y = pack2(a2, a3);
            *(uint2*)(QK + (size_t)m * LDQ + n) = o;
          } else {
            const int nn = n - seg * 128;
            if (nn < nvalidF) *(float4*)(F + (size_t)m * ldf + nn) = (float4){a0, a1, a2, a3};
          }
        }
      }
    } else if (mode == 1 || mode == 2) {
#pragma unroll
      for (int i = 0; i < 8; ++i) {
        const int m = mw + i * 16 + gk * 4;
        float rs0 = 1.f, rs1 = 1.f, rs2 = 1.f, rs3 = 1.f;
        if (layer) {
          const float4 q4 = *(const float4*)(ssq_g + m);
          rs0 = rsqrtf(q4.x * (1.f / DM) + 1e-6f); rs1 = rsqrtf(q4.y * (1.f / DM) + 1e-6f);
          rs2 = rsqrtf(q4.z * (1.f / DM) + 1e-6f); rs3 = rsqrtf(q4.w * (1.f / DM) + 1e-6f);
        }
#pragma unroll
        for (int j = 0; j < 4; ++j) {
          const int n = nw + j * 16 + l16;
          const float a0 = acc[i][j][0] * rs0, a1 = acc[i][j][1] * rs1, a2 = acc[i][j][2] * rs2, a3 = acc[i][j][3] * rs3;
          if (mode == 1) {
            const int trow = n - 3072;
            uint2 o; o.x = pack2(a0, a1); o.y = pack2(a2, a3);
            *(uint2*)(VT + (size_t)trow * MTOK + m) = o;
          } else {
            const int trow = n - 512;
            const int h = (nw - 1536) >> 6;
            const float lg2 = log1pf(-exp2f(-5.f - (float)h)) * LOG2E;
            const float lane_dec = 0.125f * ex2(lg2 * (float)(127 - gk * 4));
            QK[(size_t)(m + 0) * LDQ + n] = f2bf(a0); QK[(size_t)(m + 1) * LDQ + n] = f2bf(a1);
            QK[(size_t)(m + 2) * LDQ + n] = f2bf(a2); QK[(size_t)(m + 3) * LDQ + n] = f2bf(a3);
            const float s0 = a0 * lane_dec * ex2(lg2 * (float)(-(i * 16 + 0))), s1 = a1 * lane_dec * ex2(lg2 * (float)(-(i * 16 + 1)));
            const float s2 = a2 * lane_dec * ex2(lg2 * (float)(-(i * 16 + 2))), s3 = a3 * lane_dec * ex2(lg2 * (float)(-(i * 16 + 3)));
            uint2 o; o.x = pack2(s0, s1); o.y = pack2(s2, s3);
            *(uint2*)(VT + (size_t)trow * MTOK + m) = o;
          }
        }
      }
    }
  }
}

__device__ __forceinline__ void gemm_outproj(const Params& p, int layer, u16* lds) {
  const u16* A = (const u16*)(p.ws + WS_Y);
  const u16* Bt = (const u16*)(p.ws + (layer ? WS_WO1 : WS_WO0));
  const float* res = layer ? p.out : p.x;
  float* out = p.out;
  u16* hb_out = (u16*)(p.ws + WS_HBF);
  float* ssq_g = (float*)(p.ws + WS_SSQ);
  const int tid = TIDX, lane = tid & 63, wave = tid >> 6, l16 = lane & 15, gk = lane >> 4;
  const int wpa = wave >> 2, wpb = wave & 3;
  const int bid = BIDX, xcd = bid & 7, nloc = (int)gridDim.x >> 3;
  for (int q = bid >> 3; q < 16 * 4; q += nloc) {
    const int mt = xcd * 16 + (q >> 2), nt = q & 3;
    const int m0 = mt * 256, n0 = nt * 256;
    GEMM_OFFS(DM, DM)
    f32x4 acc[8][4];
    gemm_mainloop<true>(p, A + (size_t)m0 * DM, pa, Bt + (size_t)n0 * DM, pb, 64, 16, lds, acc);
    const int mw = m0 + wpa * 128, nw = n0 + wpb * 64;
    float ssq[8];
#pragma unroll
    for (int i = 0; i < 8; ++i) ssq[i] = 0.f;
#pragma unroll
    for (int i = 0; i < 8; ++i)
#pragma unroll
      for (int j = 0; j < 4; ++j) {
        const int n = nw + j * 16 + gk * 4;
        const int m = mw + i * 16 + l16;
        const float4 r = *(const float4*)(res + (size_t)m * DM + n);
        const float4 v = (float4){r.x + acc[i][j][0], r.y + acc[i][j][1], r.z + acc[i][j][2], r.w + acc[i][j][3]};
        *(float4*)(out + (size_t)m * DM + n) = v;
        if (layer == 0) {
          const float4 gg = *(const float4*)(p.o_ng + n);
          uint2 hb; hb.x = pack2(v.x * gg.x, v.y * gg.y); hb.y = pack2(v.z * gg.z, v.w * gg.w);
          *(uint2*)(hb_out + (size_t)m * DM + n) = hb;
          ssq[i] += v.x * v.x + v.y * v.y + v.z * v.z + v.w * v.w;
        }
      }
    if (layer == 0) {
#pragma unroll
      for (int i = 0; i < 8; ++i) {
        float sv = ssq[i]; sv += __shfl_xor(sv, 16); sv += __shfl_xor(sv, 32);
        if (gk == 0) atomicAdd(ssq_g + mw + i * 16 + l16, sv);
      }
    }
  }
}

__device__ __forceinline__ void gemm_cmp2_tile(const Params& p, u16* lds, int kv, int mt) {
  const int tid = TIDX, lane = tid & 63, wave = tid >> 6, l16 = lane & 15, gk = lane >> 4;
  const int wpa = wave >> 2, wpb = wave & 3;
  {
    const int m0 = mt * 256;
    const u16* A = (const u16*)(p.ws + WS_HC) + (size_t)kv * 8192 * 256;
    const u16* Bt = (const u16*)(p.ws + (kv ? WS_W2V : WS_W2K));
    GEMM_OFFS(256, 256)
    f32x4 acc[8][4];
    const bool swapped = (kv == 0);
    if (swapped) gemm_mainloop<true>(p, A + (size_t)m0 * 256, pa, Bt, pb, 64, 4, lds, acc);
    else gemm_mainloop<false>(p, A + (size_t)m0 * 256, pa, Bt, pb, 64, 4, lds, acc);
    const int mw = m0 + wpa * 128, nw = wpb * 64;
    if (swapped) {
      u16* kc_ = (u16*)(p.ws + WS_KCMP);
#pragma unroll
      for (int i = 0; i < 8; ++i)
#pragma unroll
        for (int j = 0; j < 4; ++j) {
          const int n = nw + j * 16 + gk * 4;
          const int m = mw + i * 16 + l16;
          if (n < 64) {
            uint2 o; o.x = pack2(acc[i][j][0], acc[i][j][1]); o.y = pack2(acc[i][j][2], acc[i][j][3]);
            *(uint2*)(kc_ + (size_t)m * 64 + n) = o;
          }
        }
      if (wpb == 0) {
        float mxn = 0.f;
#pragma unroll
        for (int i = 0; i < 8; ++i) {
          float ss = 0.f;
#pragma unroll
          for (int j = 0; j < 4; ++j) ss += acc[i][j][0] * acc[i][j][0] + acc[i][j][1] * acc[i][j][1] + acc[i][j][2] * acc[i][j][2] + acc[i][j][3] * acc[i][j][3];
          ss += __shfl_xor(ss, 16); ss += __shfl_xor(ss, 32);
          mxn = fmaxf(mxn, ss);
        }
#pragma unroll
        for (int o2 = 1; o2 <= 8; o2 <<= 1) mxn = fmaxf(mxn, __shfl_xor(mxn, o2));
        if (lane == 0) atomicMax((uint32_t*)(p.ws + WS_KMAX) + 16 + ((mw >> 9) & 3), __float_as_uint(mxn));
      }
    } else {
      u16* vt = (u16*)(p.ws + WS_VCMPT);
#pragma unroll
      for (int i = 0; i < 8; ++i)
#pragma unroll
        for (int j = 0; j < 4; ++j) {
          const int m = mw + i * 16 + gk * 4;
          const int n = nw + j * 16 + l16;
          if (n < 64) {
            uint2 o; o.x = pack2(acc[i][j][0], acc[i][j][1]); o.y = pack2(acc[i][j][2], acc[i][j][3]);
            *(uint2*)(vt + (size_t)(m >> 9) * 32768 + (size_t)n * 512 + (m & 511)) = o;
          }
        }
    }
  }
}

__device__ __forceinline__ void gemm_cmp1(const Params& p, u16* lds) {
  const u16* U = (const u16*)(p.ws + WS_QK);
  const float* peb = (const float*)(p.ws + WS_PEB);
  const int tid = TIDX, lane = tid & 63, wave = tid >> 6, l16 = lane & 15, gk = lane >> 4;
  const int wpa = wave >> 2, wpb = wave & 3;
  for (int tile = BIDX; tile < 64; tile += gridDim.x) {
    const int kv = tile >> 5, mt = tile & 31;
    const int m0 = mt * 256;
    const u16* Bt = (const u16*)(p.ws + (kv ? WS_W1V : WS_W1K));
    u16* Hc = (u16*)(p.ws + WS_HC) + (size_t)kv * 8192 * 256;
    uint32_t pa[4], pb[4];
#pragma unroll
    for (int i = 0; i < 4; ++i) {
      const int row = (tid >> 3) + 64 * i, kc = tid & 7;
      const int r = m0 + row, bg = r >> 9, cc = r & 511, b = bg >> 2, g = bg & 3;
      int tok0 = cc * 16; if (tok0 > SEQ - 32) tok0 = SEQ - 32;
      pa[i] = (uint32_t)(b * SEQ + tok0) * LDQ + 1024 + kv * 256 + g * 64 + kc * 8;
      pb[i] = (uint32_t)row * 2048 + kc * 8;
    }
    f32x4 acc[8][4];
    gemm_mainloop<true>(p, U, pa, Bt, pb, LDQ, 32, lds, acc);
    const int tid2 = TIDX, lane2 = tid2 & 63, wave2 = tid2 >> 6;
    const int mw = m0 + (wave2 >> 2) * 128, nw = (wave2 & 3) * 64;
#pragma unroll
    for (int i = 0; i < 8; ++i)
#pragma unroll
      for (int j = 0; j < 4; ++j) {
        const int n = nw + j * 16 + (lane2 >> 4) * 4;
        const int m = mw + i * 16 + (lane2 & 15);
        const float4 bb = *(const float4*)(peb + kv * 256 + n);
        float v0 = silu_f(acc[i][j][0] + bb.x), v1 = silu_f(acc[i][j][1] + bb.y);
        float v2 = silu_f(acc[i][j][2] + bb.z), v3 = silu_f(acc[i][j][3] + bb.w);
        if ((m & 511) == 511) { v0 = v1 = v2 = v3 = 0.f; }
        uint2 o; o.x = pack2(v0, v1); o.y = pack2(v2, v3);
        *(uint2*)(Hc + (size_t)m * 256 + n) = o;
      }
    __threadfence_block();
    __syncthreads();
    gemm_cmp2_tile(p, lds, kv, mt);
  }
}

#define TILE_LD(R, src, stride) { R##0 = *(const uint4*)((src) + (long)(tid >> 3) * (stride) + (tid & 7) * 8); }
#define TILE_ST(dst, R) { *(uint4*)((dst) + (tid >> 3) * TS + (tid & 7) * 8) = R##0; }
#define VPOS(c) ((((c) >> 2) * 32) + ((2 * ((c) & 1)) * 8) + ((((c) & 3) >> 1) * 4))
#define TILE_STV_(dst, val) { const int c_ = tid & 7; u16* d_ = (dst) + (tid >> 3) * TS + VPOS(c_); \
    *(uint2*)(d_) = make_uint2((val).x, (val).y); *(uint2*)(d_ + 8) = make_uint2((val).z, (val).w); }
#define TILE_STV(dst, R) TILE_STV_(dst, R##0)
__device__ __forceinline__ void qk_tile(const u16* sK, const bf16x8 (&q)[2], f32x4 (&s)[4], int l16, int gk) {
#pragma unroll
  for (int kt = 0; kt < 4; ++kt) s[kt] = (f32x4){0.f, 0.f, 0.f, 0.f};
#pragma unroll
  for (int ks = 0; ks < 2; ++ks)
#pragma unroll
    for (int kt = 0; kt < 4; ++kt) {
      bf16x8 kf = *(const bf16x8*)(sK + (kt * 16 + l16) * TS + ks * 32 + gk * 8);
      s[kt] = MFMA(kf, q[ks], s[kt]);
    }
}
__device__ __forceinline__ void pv_tile(const u16* sV, const float (&pp)[4][4], f32x4 (&o)[4], int l16, int gk) {
  bf16x8 pf[2];
#pragma unroll
  for (int ks2 = 0; ks2 < 2; ++ks2) {
    uint4 t;
    t.x = pack2(pp[2 * ks2][0], pp[2 * ks2][1]); t.y = pack2(pp[2 * ks2][2], pp[2 * ks2][3]);
    t.z = pack2(pp[2 * ks2 + 1][0], pp[2 * ks2 + 1][1]); t.w = pack2(pp[2 * ks2 + 1][2], pp[2 * ks2 + 1][3]);
    pf[ks2] = *(bf16x8*)&t;
  }
#pragma unroll
  for (int dt = 0; dt < 4; ++dt)
#pragma unroll
    for (int ks2 = 0; ks2 < 2; ++ks2) {
      const bf16x8 vf = *(const bf16x8*)(sV + (dt * 16 + l16) * TS + ks2 * 32 + gk * 8);
      o[dt] = MFMA(vf, pf[ks2], o[dt]);
    }
}

__device__ __forceinline__ void fox_phase(const Params& p, u16* lds) {
  const u16* QK = (const u16*)(p.ws + WS_QK);
  const u16* VT = (const u16*)(p.ws + WS_VT);
  const float* cf = (const float*)(p.ws + WS_CFOX);
  u16* Y = (u16*)(p.ws + WS_Y);
  const int tid = TIDX, lane = tid & 63, w = tid >> 6, l16 = lane & 15, gk = lane >> 4;
  const float scale2 = 0.125f * LOG2E;
  for (int unit = BIDX; unit < 2048; unit += gridDim.x) {
    const int bh = unit & 31, qblk = 63 - (unit >> 5), b = bh >> 3, h = bh & 7;
    const int tq0 = qblk * 128 + w * 16;
    const int t = tq0 + l16;
    const float* cfr = cf + (size_t)bh * SEQ;
    bf16x8 q[2];
#pragma unroll
    for (int ks = 0; ks < 2; ++ks) q[ks] = *(const bf16x8*)(QK + (size_t)(b * SEQ + t) * LDQ + h * 64 + ks * 32 + gk * 8);
    const float cq2 = cfr[t] * LOG2E;
    f32x4 o[4];
    float m = -1e30f, l = 0.f;
#pragma unroll
    for (int dt = 0; dt < 4; ++dt) o[dt] = (f32x4){0.f, 0.f, 0.f, 0.f};
    const int ntiles = qblk * 2 + 2;
    const int iw = qblk * 2 + (w >> 2);
    const u16* ksrc = QK + (size_t)(b * SEQ) * LDQ + 512 + h * 64;
    const u16* vsrc = VT + (size_t)(h * 64) * MTOK + (size_t)b * SEQ;
    float qs = 0.f;
#pragma unroll
    for (int ks = 0; ks < 2; ++ks)
#pragma unroll
      for (int e = 0; e < 8; ++e) { const float v = bf2f((u16)q[ks][e]); qs += v * v; }
    qs += __shfl_xor(qs, 16); qs += __shfl_xor(qs, 32);
#pragma unroll
    for (int o2 = 1; o2 <= 8; o2 <<= 1) qs = fmaxf(qs, __shfl_xor(qs, o2));
    float* red = (float*)(lds + 256 * TS);
    if (lane == 0) red[w] = qs;
    __syncthreads();
    float qmax2 = red[0];
#pragma unroll
    for (int i = 1; i < NWAVE; ++i) qmax2 = fmaxf(qmax2, red[i]);
    const float kmax2 = __uint_as_float(((const uint32_t*)(p.ws + WS_KMAX))[h]);
    const float T2 = 2.f * scale2 * sqrtf(qmax2 * kmax2) * 1.001f + 48.f;
    const float cfirst2 = cfr[qblk * 128] * LOG2E;
    int i_lo = 0;
    for (int base = qblk * 2 - 1; base >= 0; base -= 64) {
      const int ti = base - lane;
      bool skip = false;
      if (ti >= 0) skip = (cfirst2 - cfr[ti * 64 + 63] * LOG2E) < -T2;
      const unsigned long long bal = __ballot(skip);
      if (bal) { i_lo = base - (int)__builtin_ctzll(bal) + 1; break; }
    }
    uint4 rk0, rv0;
    TILE_LD(rk, ksrc + (size_t)i_lo * 64 * LDQ, LDQ); TILE_LD(rv, vsrc + i_lo * 64, MTOK);
    TILE_ST(lds + (i_lo & 1) * (128 * TS), rk); TILE_STV(lds + (i_lo & 1) * (128 * TS) + 64 * TS, rv);
    __syncthreads();
    for (int i = i_lo; i < ntiles; ++i) {
      u16* cur = lds + (i & 1) * (128 * TS);
      const bool more = (i + 1 < ntiles);
      if (more) { TILE_LD(rk, ksrc + (size_t)(i + 1) * 64 * LDQ, LDQ); TILE_LD(rv, vsrc + (i + 1) * 64, MTOK); }
      if (i <= iw) {
        const int s0 = i * 64;
        const bool diag = (i == iw);
        f32x4 s[4];
        qk_tile(cur, q, s, l16, gk);
        float xv[4][4];
        float mx = -1e30f;
#pragma unroll
        for (int kt = 0; kt < 4; ++kt) {
          const float4 c4 = *(const float4*)(cfr + s0 + kt * 16 + gk * 4);
          const float ck[4] = {c4.x, c4.y, c4.z, c4.w};
#pragma unroll
          for (int r = 0; r < 4; ++r) {
            float v = fmaf(s[kt][r], scale2, cq2 - ck[r] * LOG2E);
            if (diag && (s0 + kt * 16 + gk * 4 + r > t)) v = -1e30f;
            xv[kt][r] = v; mx = fmaxf(mx, v);
          }
        }
        mx = fmaxf(mx, __shfl_xor(mx, 16)); mx = fmaxf(mx, __shfl_xor(mx, 32));
        const float mnew = fmaxf(m, mx);
        const float alpha = ex2(m - mnew);
        m = mnew;
        const float muse = fmaxf(mnew, -1e20f);
        float rs = 0.f;
#pragma unroll
        for (int kt = 0; kt < 4; ++kt)
#pragma unroll
          for (int r = 0; r < 4; ++r) { xv[kt][r] = ex2(xv[kt][r] - muse); rs += xv[kt][r]; }
        l = l * alpha + rs;
#pragma unroll
        for (int dt = 0; dt < 4; ++dt) o[dt] *= alpha;
        pv_tile(cur + 64 * TS, xv, o, l16, gk);
      }
      if (more) { u16* nxt = lds + ((i + 1) & 1) * (128 * TS); TILE_ST(nxt, rk); TILE_STV(nxt + 64 * TS, rv); }
      __syncthreads();
    }
    {
      float lt = l; lt += __shfl_xor(lt, 16); lt += __shfl_xor(lt, 32);
      const float inv = lt > 0.f ? 1.f / lt : 0.f;
      const size_t mrow = (size_t)(b * SEQ + t);
#pragma unroll
      for (int dt = 0; dt < 4; ++dt) {
        const int col = h * 64 + dt * 16 + gk * 4;
        const uint2 zz = *(const uint2*)(QK + mrow * LDQ + 2048 + col);
        const float z0 = bf2f(zz.x & 0xffff), z1 = bf2f(zz.x >> 16), z2 = bf2f(zz.y & 0xffff), z3 = bf2f(zz.y >> 16);
        uint2 ov;
        ov.x = pack2(o[dt][0] * inv * silu_f(z0), o[dt][1] * inv * silu_f(z1));
        ov.y = pack2(o[dt][2] * inv * silu_f(z2), o[dt][3] * inv * silu_f(z3));
        *(uint2*)(Y + mrow * DM + col) = ov;
      }
    }
  }
}

__device__ __forceinline__ void fox_knorm(const Params& p) {
  const u16* QK = (const u16*)(p.ws + WS_QK);
  uint32_t* km = (uint32_t*)(p.ws + WS_KMAX);
  const int tid = TIDX, lane = tid & 63, wave = tid >> 6;
  float mx = 0.f;
  for (int row = BIDX * NWAVE + wave; row < MTOK; row += gridDim.x * NWAVE) {
    const uint4 v = *(const uint4*)(QK + (size_t)row * LDQ + 512 + lane * 8);
    const float a0 = bf2f(v.x & 0xffff), a1 = bf2f(v.x >> 16), a2 = bf2f(v.y & 0xffff), a3 = bf2f(v.y >> 16);
    const float a4 = bf2f(v.z & 0xffff), a5 = bf2f(v.z >> 16), a6 = bf2f(v.w & 0xffff), a7 = bf2f(v.w >> 16);
    float ss = a0 * a0 + a1 * a1 + a2 * a2 + a3 * a3 + a4 * a4 + a5 * a5 + a6 * a6 + a7 * a7;
    ss += __shfl_xor(ss, 1); ss += __shfl_xor(ss, 2); ss += __shfl_xor(ss, 4);
    mx = fmaxf(mx, ss);
  }
  if ((lane & 7) == 0) atomicMax(&km[lane >> 3], __float_as_uint(mx));
}

__device__ __forceinline__ void fox_scan(const Params& p, float* ldsf) {
  const float* fl = (const float*)(p.ws + WS_FLOG);
  float* cf = (float*)(p.ws + WS_CFOX);
  double* sd = (double*)ldsf;
  const int tid = TIDX;
  for (int bh = BIDX; bh < 32; bh += gridDim.x) {
    const int b = bh >> 3, h = bh & 7;
    const float bf = p.e_bf[h];
    float ls[16];
    double sum = 0.0;
#pragma unroll
    for (int i = 0; i < 16; ++i) {
      const float xx = fl[(size_t)(b * SEQ + tid * 16 + i) * 8 + h] + bf;
      ls[i] = fminf(xx, 0.f) - log1pf(__expf(-fabsf(xx)));
      sum += (double)ls[i];
    }
    __syncthreads();
    sd[tid] = sum;
    __syncthreads();
    double pre = 0.0;
    for (int j = 0; j < tid; ++j) pre += sd[j];
#pragma unroll
    for (int i = 0; i < 16; ++i) { pre += (double)ls[i]; cf[(size_t)bh * SEQ + tid * 16 + i] = (float)pre; }
  }
}

__device__ __forceinline__ void ret_stepA(const Params& p) {
  const u16* VT = (const u16*)(p.ws + WS_VT);
  float* dS = (float*)(p.ws + WS_DS);
  const int tid_ = TIDX, lane = tid_ & 63, w8 = tid_ >> 6, w = w8 & 3, l16 = lane & 15, gk = lane >> 4;
  for (int u2 = BIDX; u2 < 1024; u2 += gridDim.x) {
    const int u = u2 * 2 + (w8 >> 2);
    const int bh = u >> 6, n = u & 63, b = bh >> 3, h = bh & 7;
    const size_t mcol = (size_t)b * SEQ + n * 128;
    f32x4 acc[4];
#pragma unroll
    for (int dt = 0; dt < 4; ++dt) acc[dt] = (f32x4){0.f, 0.f, 0.f, 0.f};
#pragma unroll
    for (int ks = 0; ks < 4; ++ks) {
      bf16x8 af = *(const bf16x8*)(VT + (size_t)(512 + h * 64 + w * 16 + l16) * MTOK + mcol + ks * 32 + gk * 8);
#pragma unroll
      for (int dt = 0; dt < 4; ++dt) {
        bf16x8 bfr = *(const bf16x8*)(VT + (size_t)(1024 + h * 64 + dt * 16 + l16) * MTOK + mcol + ks * 32 + gk * 8);
        acc[dt] = MFMA(af, bfr, acc[dt]);
      }
    }
#pragma unroll
    for (int dt = 0; dt < 4; ++dt)
#pragma unroll
      for (int r = 0; r < 4; ++r) dS[(size_t)u * 4096 + (w * 16 + gk * 4 + r) * 64 + dt * 16 + l16] = acc[dt][r];
  }
}
__device__ __forceinline__ void ret_stepB(const Params& p) {
  const float* dS = (const float*)(p.ws + WS_DS);
  u16* st = (u16*)(p.ws + WS_ST);
  for (int idx = BIDX * NTHR + TIDX; idx < 32 * 4096; idx += gridDim.x * NTHR) {
    const int bh = idx >> 12, ed = idx & 4095, h = bh & 7;
    const float cdec = __expf(log1pf(-exp2f(-5.f - (float)h)) * 128.f);
    float s = 0.f;
#pragma unroll 8
    for (int n = 0; n < 64; ++n) {
      const size_t a = (size_t)(bh * 64 + n) * 4096 + ed;
      st[a] = f2bf(s);
      s = s * cdec + dS[a];
    }
  }
}
__device__ __forceinline__ void ret_stepC(const Params& p, u16* lds) {
  const u16* QK = (const u16*)(p.ws + WS_QK);
  const u16* VT = (const u16*)(p.ws + WS_VT);
  const u16* st = (const u16*)(p.ws + WS_ST);
  u16* Y = (u16*)(p.ws + WS_Y);
  const int tid = TIDX, lane = tid & 63, w = tid >> 6, l16 = lane & 15, gk = lane >> 4;
  for (int u = BIDX; u < 2048; u += gridDim.x) {
    const int bh = u >> 6, n = u & 63, b = bh >> 3, h = bh & 7;
    const size_t m0 = (size_t)b * SEQ + n * 128;
    const float lg2 = log1pf(-exp2f(-5.f - (float)h)) * LOG2E;
    __syncthreads();
    {
      uint4 r0;
      TILE_LD(r, QK + m0 * LDQ + 1536 + h * 64, LDQ); TILE_ST(lds, r);
      TILE_LD(r, VT + (size_t)(512 + h * 64) * MTOK + m0, MTOK); TILE_STV(lds + 64 * TS, r);
      TILE_LD(r, QK + (m0 + 64) * LDQ + 1536 + h * 64, LDQ); TILE_ST(lds + 128 * TS, r);
      TILE_LD(r, VT + (size_t)(512 + h * 64) * MTOK + m0 + 64, MTOK); TILE_STV(lds + 192 * TS, r);
      TILE_LD(r, st + (size_t)u * 4096, 64); TILE_ST(lds + 256 * TS, r);
    }
    __syncthreads();
    const int iq = 16 * w + l16;
    const size_t mrow = m0 + iq;
    bf16x8 q[2];
#pragma unroll
    for (int ks = 0; ks < 2; ++ks) q[ks] = *(const bf16x8*)(QK + mrow * LDQ + 1024 + h * 64 + ks * 32 + gk * 8);
    f32x4 o[4];
#pragma unroll
    for (int dt = 0; dt < 4; ++dt) o[dt] = (f32x4){0.f, 0.f, 0.f, 0.f};
#pragma unroll
    for (int dt = 0; dt < 4; ++dt)
#pragma unroll
      for (int ks = 0; ks < 2; ++ks) {
        bf16x8 sf = *(const bf16x8*)(lds + 256 * TS + (dt * 16 + l16) * TS + ks * 32 + gk * 8);
        o[dt] = MFMA(sf, q[ks], o[dt]);
      }
    const float cross = ex2(lg2 * (float)(iq + 1));
#pragma unroll
    for (int dt = 0; dt < 4; ++dt) o[dt] *= cross;
#pragma unroll
    for (int k64 = 0; k64 < 2; ++k64) {
      if (k64 * 64 <= 16 * w + 15) {
        f32x4 s[4];
        qk_tile(lds + k64 * 128 * TS, q, s, l16, gk);
        float pp[4][4];
#pragma unroll
        for (int kt = 0; kt < 4; ++kt)
#pragma unroll
          for (int r = 0; r < 4; ++r) {
            const int j = k64 * 64 + kt * 16 + gk * 4 + r;
            pp[kt][r] = (j <= iq) ? s[kt][r] * 0.125f * ex2(lg2 * (float)(iq - j)) : 0.f;
          }
        pv_tile(lds + k64 * 128 * TS + 64 * TS, pp, o, l16, gk);
      }
    }
    float sm = 0.f;
#pragma unroll
    for (int dt = 0; dt < 4; ++dt) sm += o[dt][0] + o[dt][1] + o[dt][2] + o[dt][3];
    sm += __shfl_xor(sm, 16); sm += __shfl_xor(sm, 32);
    const float mu = sm * (1.f / 64.f);
    float vs = 0.f;
#pragma unroll
    for (int dt = 0; dt < 4; ++dt)
#pragma unroll
      for (int r = 0; r < 4; ++r) { const float d = o[dt][r] - mu; vs += d * d; }
    vs += __shfl_xor(vs, 16); vs += __shfl_xor(vs, 32);
    const float rstd = rsqrtf(vs * (1.f / 64.f) + 1e-5f);
#pragma unroll
    for (int dt = 0; dt < 4; ++dt) {
      const int col = h * 64 + dt * 16 + gk * 4;
      const float4 gg = *(const float4*)(p.e_gn + col);
      const uint2 zz = *(const uint2*)(QK + mrow * LDQ + 2048 + 512 + col);
      const float z0 = bf2f(zz.x & 0xffff), z1 = bf2f(zz.x >> 16), z2 = bf2f(zz.y & 0xffff), z3 = bf2f(zz.y >> 16);
      uint2 ov;
      ov.x = pack2((o[dt][0] - mu) * rstd * gg.x * silu_f(z0), (o[dt][1] - mu) * rstd * gg.y * silu_f(z1));
      ov.y = pack2((o[dt][2] - mu) * rstd * gg.z * silu_f(z2), (o[dt][3] - mu) * rstd * gg.w * silu_f(z3));
      *(uint2*)(Y + mrow * DM + 512 + col) = ov;
    }
  }
}

__device__ __forceinline__ void nsa_tile_interior(const u16* sK, const u16* sV, const bf16x8 (&q)[2], f32x4 (&acc)[4],
                                                  float& m, float& l, float slope2, const float (&sk)[16],
                                                  int t, int pos0, bool lanesel, int lane) {
  const int l16 = lane & 15, gk = lane >> 4;
  const float scale2 = 0.125f * LOG2E;
  f32x4 s[4];
  qk_tile(sK, q, s, l16, gk);
  const float c0 = fmaf(-slope2, (float)(t - pos0 - gk * 4), lanesel ? 0.f : -1e30f);
  float xv[4][4];
  float mx = -1e30f;
#pragma unroll
  for (int kt = 0; kt < 4; ++kt)
#pragma unroll
    for (int r = 0; r < 4; ++r) { xv[kt][r] = fmaf(s[kt][r], scale2, sk[kt * 4 + r]); mx = fmaxf(mx, xv[kt][r]); }
  mx += c0;
  mx = fmaxf(mx, __shfl_xor(mx, 16)); mx = fmaxf(mx, __shfl_xor(mx, 32));
  const float mnew = fmaxf(m, mx);
  const float alpha = ex2(m - mnew);
  m = mnew;
  const float off = c0 - fmaxf(mnew, -1e20f);
  float rs = 0.f;
#pragma unroll
  for (int kt = 0; kt < 4; ++kt)
#pragma unroll
    for (int r = 0; r < 4; ++r) { xv[kt][r] = ex2(xv[kt][r] + off); rs += xv[kt][r]; }
  l = l * alpha + rs;
  if (__any(alpha != 1.f)) {
#pragma unroll
    for (int dt = 0; dt < 4; ++dt) acc[dt] *= alpha;
  }
  pv_tile(sV, xv, acc, l16, gk);
}
template <int BR>
__device__ __forceinline__ void nsa_tile(const u16* sK, const u16* sV, const bf16x8 (&q)[2], f32x4 (&acc)[4],
                                         float& m, float& l, float slope2, float gmul,
                                         int t, int pos0, int pstride, int wl, bool lanesel,
                                         float* imp_row, int jbase, float& carry, int lane) {
  const int l16 = lane & 15, gk = lane >> 4;
  const float scale2 = 0.125f * LOG2E;
  const unsigned wle = lanesel ? (unsigned)wl : 0u;
  f32x4 s[4];
  qk_tile(sK, q, s, l16, gk);
  float xv[4][4];
  float mx = -1e30f;
#pragma unroll
  for (int kt = 0; kt < 4; ++kt)
#pragma unroll
    for (int r = 0; r < 4; ++r) {
      const int dist = t - (pos0 + (kt * 16 + gk * 4 + r) * pstride);
      const float pen = ((unsigned)dist < wle) ? 0.f : -1e30f;
      const float v = fmaf(s[kt][r], scale2, fmaf(-slope2, (float)dist, pen));
      xv[kt][r] = v; mx = fmaxf(mx, v);
    }
  if (BR != 1) {
    mx = fmaxf(mx, __shfl_xor(mx, 16)); mx = fmaxf(mx, __shfl_xor(mx, 32));
    const float mnew = fmaxf(m, mx);
    const float alpha = ex2(m - mnew);
    m = mnew;
    const float muse = fmaxf(mnew, -1e20f);
    float rs = 0.f;
#pragma unroll
    for (int kt = 0; kt < 4; ++kt)
#pragma unroll
      for (int r = 0; r < 4; ++r) { xv[kt][r] = ex2(xv[kt][r] - muse); rs += xv[kt][r]; }
    l = l * alpha + rs;
    if (BR == 2) {
#pragma unroll
      for (int dt = 0; dt < 4; ++dt) acc[dt] *= alpha;
      pv_tile(sV, xv, acc, l16, gk);
    }
  } else {
    const float muse = fmaxf(m, -1e20f);
    float p3[4];
#pragma unroll
    for (int kt = 0; kt < 4; ++kt) {
      float pn[4];
#pragma unroll
      for (int r = 0; r < 4; ++r) { pn[r] = ex2(xv[kt][r] - muse) * l; xv[kt][r] = pn[r] * gmul; }
      p3[kt] = pn[3];
      xv[kt][0] = xv[kt][0];
      imp_row[jbase + kt * 4 + gk] = 2.f * (pn[0] + pn[1] + pn[2]) + pn[3];
    }
    const int srcl = (lane + 48) & 63;
#pragma unroll
    for (int kt = 0; kt < 4; ++kt) {
      const float same = __shfl(p3[kt], srcl);
      const float prev = __shfl(kt > 0 ? p3[kt > 0 ? kt - 1 : 0] : carry, srcl);
      imp_row[jbase + kt * 4 + gk] += (gk == 0) ? prev : same;
    }
    carry = p3[3];
    pv_tile(sV, xv, acc, l16, gk);
  }
}

__device__ __forceinline__ void nsa_phase(const Params& p, u16* lds) {
  const u16* U = (const u16*)(p.ws + WS_QK);
  const u16* VT = (const u16*)(p.ws + WS_VT);
  const u16* KC = (const u16*)(p.ws + WS_KCMP);
  const u16* VC = (const u16*)(p.ws + WS_VCMPT);
  const float* GL = (const float*)(p.ws + WS_GL);
  u16* Y = (u16*)(p.ws + WS_Y);
  float* imp = (float*)(lds + 512 * TS);
  uint32_t* umask = (uint32_t*)(imp + 128 * IMPS);
  int* ulist = (int*)(umask + 4);
  const int tid = TIDX, lane = tid & 63, w = tid >> 6, l16 = lane & 15, gk = lane >> 4;
  const int qt = w & 1, hd = w >> 1;
  uint2* totl = (uint2*)imp + 128 + (size_t)w * 256 + lane;
  const int BIG = 1 << 30;
  int* uslot = ulist + 128;
  unsigned* uctr = (unsigned*)(p.ws + WS_KMAX) + 24;
  for (;;) {
    __syncthreads();
    if (tid == 0) uslot[0] = (int)atomicAdd(uctr, 1u);
    __syncthreads();
    const int unit = uslot[0];
    if (unit >= 4096) break;
    const int bg = unit & 15, qh = 255 - (unit >> 4), b = bg >> 2, g = bg & 3;
    const int t0 = qh * 32, qb = t0 >> 6, t = t0 + 16 * qt + l16;
    const size_t mrow = (size_t)b * SEQ + t;
    const int h = g * 4 + hd;
    bf16x8 q[2];
#pragma unroll
    for (int ks = 0; ks < 2; ++ks) q[ks] = *(const bf16x8*)(U + mrow * LDQ + h * 64 + ks * 32 + gk * 8);
    const float slope2 = exp2f(-0.5f * (float)(h + 1)) * LOG2E;
    const float g1 = sigmoid_f(GL[mrow * 48 + h * 3] + p.o_bg[h * 3]);
    float sk[16];
#pragma unroll
    for (int i = 0; i < 16; ++i) sk[i] = slope2 * (float)((i >> 2) * 16 + (i & 3));
    float qn2 = 0.f;
#pragma unroll
    for (int ks = 0; ks < 2; ++ks)
#pragma unroll
      for (int e = 0; e < 8; ++e) { const float v = bf2f((u16)q[ks][e]); qn2 += v * v; }
    qn2 += __shfl_xor(qn2, 16); qn2 += __shfl_xor(qn2, 32);
#pragma unroll
    for (int o2 = 1; o2 <= 8; o2 <<= 1) qn2 = fmaxf(qn2, __shfl_xor(qn2, o2));
    const uint32_t* kmx = (const uint32_t*)(p.ws + WS_KMAX);
    const float sc2 = 0.125f * LOG2E;
    const float T_slc = 2.02f * sc2 * sqrtf(qn2 * __uint_as_float(kmx[8 + g])) + 48.f;
    const float T_win = 2.02f * sc2 * sqrtf(qn2 * __uint_as_float(kmx[12 + g])) + 48.f;
    const float T_cmp = 2.05f * sc2 * sqrtf(qn2 * __uint_as_float(kmx[16 + g])) + 16.f * slope2 + 48.f;
    const int tq0w = t0 + 16 * qt;
    f32x4 acc[4];
    float m = -1e30f, l = 0.f;
#pragma unroll
    for (int dt = 0; dt < 4; ++dt) acc[dt] = (f32x4){0.f, 0.f, 0.f, 0.f};
    __syncthreads();
    for (int i = tid; i < 128 * IMPS; i += NTHR) imp[i] = 0.f;
    if (tid < 4) umask[tid] = 0u;
    float* imp_row = imp + (hd * 32 + 16 * qt + l16) * IMPS;
    float carry = 0.f;
    uint4 rk0, rk1, rk2, rk3, rv0, rv1, rv2, rv3;
    u16* impbase_unused = nullptr; (void)impbase_unused;
#define SLOT(k) (lds + (k) * (128 * TS))
#define LD1(k, kp, ks_, vp, vs_) { rk##k = *(const uint4*)((kp) + (long)(tid >> 3) * (ks_) + (tid & 7) * 8); rv##k = *(const uint4*)((vp) + (long)(tid >> 3) * (vs_) + (tid & 7) * 8); }
#define ST1(k) { *(uint4*)(SLOT(k) + (tid >> 3) * TS + (tid & 7) * 8) = rk##k; TILE_STV_(SLOT(k) + 64 * TS, rv##k) }
    const int ntc = ((t0 >> 4) >> 6) + 1;
    const u16* kcs = KC + (size_t)bg * 512 * 64;
    const u16* vcs = VC + (size_t)bg * 32768;
#define CMP_LD(k, i) if ((i) < ntc) LD1(k, kcs + (size_t)(i) * 64 * 64, 64, vcs + (i) * 64, 512)
#pragma unroll 1
    for (int pass = 0; pass < 2; ++pass) {
      const int ngrp = (ntc + 3) >> 2;
      CMP_LD(0, 0) CMP_LD(1, 1) CMP_LD(2, 2) CMP_LD(3, 3)
#pragma unroll 1
      for (int gi = 0; gi < ngrp; ++gi) {
        const int ib = gi * 4;
        __syncthreads();
        if (ib < ntc) ST1(0) if (ib + 1 < ntc) ST1(1) if (ib + 2 < ntc) ST1(2) if (ib + 3 < ntc) ST1(3)
        __syncthreads();
        if (gi + 1 < ngrp) { CMP_LD(0, ib + 4) CMP_LD(1, ib + 5) CMP_LD(2, ib + 6) CMP_LD(3, ib + 7) }
#pragma unroll 1
        for (int k = 0; k < 4; ++k) {
          const int i = ib + k;
          if (i < ntc) {
            const int dmin = tq0w - (16 * (64 * i + 63) + 31);
            if (dmin > 0 && slope2 * (float)dmin > T_cmp) { carry = 0.f; continue; }
            if (pass == 0) nsa_tile<0>(SLOT(k), SLOT(k) + 64 * TS, q, acc, m, l, slope2, g1, t, 16 * (64 * i) + 31, 16, BIG, true, imp_row, 16 * i, carry, lane);
            else nsa_tile<1>(SLOT(k), SLOT(k) + 64 * TS, q, acc, m, l, slope2, g1, t, 16 * (64 * i) + 31, 16, BIG, true, imp_row, 16 * i, carry, lane);
          }
        }
      }
      if (pass == 0) {
        float lt = l; lt += __shfl_xor(lt, 16); lt += __shfl_xor(lt, 32);
        l = lt > 0.f ? 1.f / lt : 0.f;
      }
    }
    __syncthreads();
    {
      const int qi = w * 4 + gk;
      const int c8 = l16 * 8;
      uint32_t selb = 0u;
      if (qb < 16) {
#pragma unroll
        for (int i = 0; i < 8; ++i) if (c8 + i <= qb) selb |= (1u << i);
      } else {
        float val[8];
        const float* ra = imp + qi * IMPS + c8;
#pragma unroll
        for (int i4 = 0; i4 < 2; ++i4) {
          const float4 v0 = *(const float4*)(ra + 4 * i4);
          const float4 v1 = *(const float4*)(ra + 32 * IMPS + 4 * i4);
          const float4 v2 = *(const float4*)(ra + 64 * IMPS + 4 * i4);
          const float4 v3 = *(const float4*)(ra + 96 * IMPS + 4 * i4);
          val[4 * i4] = ((v0.x + v1.x) + v2.x) + v3.x; val[4 * i4 + 1] = ((v0.y + v1.y) + v2.y) + v3.y;
          val[4 * i4 + 2] = ((v0.z + v1.z) + v2.z) + v3.z; val[4 * i4 + 3] = ((v0.w + v1.w) + v2.w) + v3.w;
        }
#pragma unroll
        for (int i = 0; i < 8; ++i) {
          const int j = c8 + i;
          const bool forced = (j == 0) || (j == qb) || (j == qb - 1);
          if (forced) selb |= (1u << i);
          if (forced || j > qb) val[i] = -1.f;
        }
#pragma unroll 1
        for (int it = 0; it < 13; ++it) {
          float best = -2.f; int bj = 0;
#pragma unroll
          for (int i = 0; i < 8; ++i) {
            const float v = ((selb >> i) & 1u) ? -1.f : val[i];
            if (v > best) { best = v; bj = c8 + i; }
          }
#pragma unroll
          for (int o = 1; o <= 8; o <<= 1) {
            const float ov = __shfl_xor(best, o); const int oj = __shfl_xor(bj, o);
            if (ov > best || (ov == best && oj < bj)) { best = ov; bj = oj; }
          }
          if ((bj >> 3) == l16) selb |= (1u << (bj & 7));
        }
      }
      uint32_t wd = selb << ((l16 & 3) * 8);
      wd |= __shfl_xor(wd, 1); wd |= __shfl_xor(wd, 2);
      __syncthreads();
      uint32_t* selw = (uint32_t*)imp;
      if ((l16 & 3) == 0) selw[qi * 4 + (l16 >> 2)] = wd;
      uint32_t uq = wd; uq |= __shfl_xor(uq, 16); uq |= __shfl_xor(uq, 32);
      if (gk == 0 && (l16 & 3) == 0) atomicOr(&umask[l16 >> 2], uq);
    }
    __syncthreads();
    const uint32_t* selq = (const uint32_t*)imp + (16 * qt + l16) * 4;
    const uint32_t sel0 = selq[0], sel1 = selq[1], sel2 = selq[2], sel3 = selq[3];
    uint32_t wun0 = sel0, wun1 = sel1, wun2 = sel2, wun3 = sel3;
#pragma unroll
    for (int o = 1; o <= 8; o <<= 1) { wun0 |= __shfl_xor(wun0, o); wun1 |= __shfl_xor(wun1, o); wun2 |= __shfl_xor(wun2, o); wun3 |= __shfl_xor(wun3, o); }
    int nsl = 0;
    {
      const uint32_t u0 = umask[0], u1 = umask[1], u2 = umask[2], u3 = umask[3];
      nsl = __popc(u0) + __popc(u1) + __popc(u2) + __popc(u3);
      if (tid < 128) {
        const uint32_t uw = tid < 32 ? u0 : tid < 64 ? u1 : tid < 96 ? u2 : u3;
        if ((uw >> (tid & 31)) & 1u) {
          int pos = __popc(uw & ((1u << (tid & 31)) - 1u));
          if (tid >= 32) pos += __popc(u0);
          if (tid >= 64) pos += __popc(u1);
          if (tid >= 96) pos += __popc(u2);
          ulist[pos] = tid;
        }
      }
    }
    __syncthreads();
#pragma unroll
    for (int dt = 0; dt < 4; ++dt) {
      uint2 o2; o2.x = pack2(acc[dt][0], acc[dt][1]); o2.y = pack2(acc[dt][2], acc[dt][3]);
      totl[dt * 64] = o2;
    }
#pragma unroll 1
    for (int br = 1; br < 3; ++br) {
      m = -1e30f; l = 0.f;
#pragma unroll
      for (int dt = 0; dt < 4; ++dt) acc[dt] = (f32x4){0.f, 0.f, 0.f, 0.f};
      int wfirst = ((t0 - 511) >> 6) << 6; if (wfirst < 0) wfirst = 0;
      const int nt = (br == 1) ? nsl : ((qb * 64 - wfirst) >> 6) + 1;
      const int ngrp = (nt + 3) >> 2;
      const u16* kb = U + (size_t)b * SEQ * LDQ + (br == 1 ? 1536 : 1792) + g * 64;
      const u16* vb = VT + (size_t)((br == 1 ? 0 : 256) + g * 64) * MTOK + (size_t)b * SEQ;
#define SRC_S0(i) ((br == 1) ? ulist[nt - 1 - (i)] * 64 : wfirst + 64 * (nt - 1 - (i)))
#define BR_LD(k, i) if ((i) < nt) { const int s_ = SRC_S0(i); LD1(k, kb + (size_t)s_ * LDQ, LDQ, vb + s_, MTOK) }
      BR_LD(0, 0) BR_LD(1, 1) BR_LD(2, 2) BR_LD(3, 3)
#pragma unroll 1
      for (int gi = 0; gi < ngrp; ++gi) {
        const int ib = gi * 4;
        __syncthreads();
        if (ib < nt) ST1(0) if (ib + 1 < nt) ST1(1) if (ib + 2 < nt) ST1(2) if (ib + 3 < nt) ST1(3)
        __syncthreads();
        if (gi + 1 < ngrp) { BR_LD(0, ib + 4) BR_LD(1, ib + 5) BR_LD(2, ib + 6) BR_LD(3, ib + 7) }
#pragma unroll 1
        for (int k = 0; k < 4; ++k) {
          const int i = ib + k;
          if (i < nt) {
            const int s0 = SRC_S0(i);
            bool wsel = true, ls = true;
            int wl = 512;
            if (br == 1) {
              const int j = s0 >> 6, jw = j >> 5, jb = j & 31;
              const uint32_t ww = jw == 0 ? wun0 : jw == 1 ? wun1 : jw == 2 ? wun2 : wun3;
              const uint32_t sw = jw == 0 ? sel0 : jw == 1 ? sel1 : jw == 2 ? sel2 : sel3;
              wsel = (ww >> jb) & 1u; ls = (sw >> jb) & 1u; wl = BIG;
            }
            if (wsel) {
              const int dminw = tq0w - (s0 + 63);
              if (dminw > 0 && slope2 * (float)dminw > (br == 1 ? T_slc : T_win)) wsel = false;
            }
            if (wsel) {
              const int tq0 = t0 + 16 * qt;
              const bool interior = (s0 + 63 <= tq0) && (br == 1 || s0 + 512 > tq0 + 15);
              if (interior) nsa_tile_interior(SLOT(k), SLOT(k) + 64 * TS, q, acc, m, l, slope2, sk, t, s0, ls, lane);
              else nsa_tile<2>(SLOT(k), SLOT(k) + 64 * TS, q, acc, m, l, slope2, g1, t, s0, 1, wl, ls, imp_row, 0, carry, lane);
            }
          }
        }
      }
      {
        float lt = l; lt += __shfl_xor(lt, 16); lt += __shfl_xor(lt, 32);
        const float gt = sigmoid_f(GL[mrow * 48 + h * 3 + br] + p.o_bg[h * 3 + br]);
        const float sc = lt > 0.f ? gt / lt : 0.f;
#pragma unroll
        for (int dt = 0; dt < 4; ++dt) {
          const uint2 pv = totl[dt * 64];
          const float r0 = bf2f(pv.x & 0xffff) + acc[dt][0] * sc, r1 = bf2f(pv.x >> 16) + acc[dt][1] * sc;
          const float r2 = bf2f(pv.y & 0xffff) + acc[dt][2] * sc, r3 = bf2f(pv.y >> 16) + acc[dt][3] * sc;
          if (br == 1) {
            uint2 o2; o2.x = pack2(r0, r1); o2.y = pack2(r2, r3);
            totl[dt * 64] = o2;
          } else {
            const int col = h * 64 + dt * 16 + gk * 4;
            const uint2 zz = *(const uint2*)(U + mrow * LDQ + 2048 + col);
            const float z0 = bf2f(zz.x & 0xffff), z1 = bf2f(zz.x >> 16), z2 = bf2f(zz.y & 0xffff), z3 = bf2f(zz.y >> 16);
            uint2 ov;
            ov.x = pack2(r0 * silu_f(z0), r1 * silu_f(z1));
            ov.y = pack2(r2 * silu_f(z2), r3 * silu_f(z3));
            *(uint2*)(Y + mrow * DM + col) = ov;
          }
        }
      }
    }
#undef SLOT
#undef LD1
#undef ST1
#undef CMP_LD
#undef SRC_S0
#undef BR_LD
  }
}

__device__ __forceinline__ void final_norm(const Params& p) {
  const int lane = TIDX & 63, wave = TIDX >> 6;
  for (int row = BIDX * NWAVE + wave; row < MTOK; row += gridDim.x * NWAVE) {
    float4* xr = (float4*)(p.out + (size_t)row * DM);
    float4 v[4];
    float ss = 0.f;
#pragma unroll
    for (int i = 0; i < 4; ++i) {
      v[i] = xr[lane + 64 * i];
      ss += v[i].x * v[i].x + v[i].y * v[i].y + v[i].z * v[i].z + v[i].w * v[i].w;
    }
#pragma unroll
    for (int o = 32; o >= 1; o >>= 1) ss += __shfl_xor(ss, o);
    const float rstd = rsqrtf(ss * (1.f / DM) + 1e-6f);
#pragma unroll
    for (int i = 0; i < 4; ++i) {
      const float4 gg = ((const float4*)p.fin_g)[lane + 64 * i];
      xr[lane + 64 * i] = (float4){v[i].x * rstd * gg.x, v[i].y * rstd * gg.y, v[i].z * rstd * gg.z, v[i].w * rstd * gg.w};
    }
  }
}

__device__ __forceinline__ void grid_bar(const Params& p, unsigned& target) {
  __syncthreads();
  target += gridDim.x;
  if (TIDX == 0) {
    unsigned* ctr = (unsigned*)(p.ws + WS_BAR);
    __threadfence();
    __hip_atomic_fetch_add(ctr, 1u, __ATOMIC_RELAXED, __HIP_MEMORY_SCOPE_AGENT);
    while (__hip_atomic_load(ctr, __ATOMIC_RELAXED, __HIP_MEMORY_SCOPE_AGENT) < target) __builtin_amdgcn_s_sleep(1);
    __threadfence();
  }
  __syncthreads();
}

__device__ __forceinline__ void nsa_knorm(const Params& p) {
  if (BIDX < 64) return;
  const u16* U = (const u16*)(p.ws + WS_QK);
  uint32_t* km = (uint32_t*)(p.ws + WS_KMAX);
  const int tid = TIDX, lane = tid & 63, wave = tid >> 6;
  float mx = 0.f;
  for (int row = (BIDX - 64) * NWAVE + wave; row < MTOK; row += (gridDim.x - 64) * NWAVE) {
    const uint4 v = *(const uint4*)(U + (size_t)row * LDQ + 1536 + lane * 8);
    const float a0 = bf2f(v.x & 0xffff), a1 = bf2f(v.x >> 16), a2 = bf2f(v.y & 0xffff), a3 = bf2f(v.y >> 16);
    const float a4 = bf2f(v.z & 0xffff), a5 = bf2f(v.z >> 16), a6 = bf2f(v.w & 0xffff), a7 = bf2f(v.w >> 16);
    float ss = a0 * a0 + a1 * a1 + a2 * a2 + a3 * a3 + a4 * a4 + a5 * a5 + a6 * a6 + a7 * a7;
    ss += __shfl_xor(ss, 1); ss += __shfl_xor(ss, 2); ss += __shfl_xor(ss, 4);
    mx = fmaxf(mx, ss);
  }
  if ((lane & 7) == 0) atomicMax(&km[8 + (lane >> 3)], __float_as_uint(mx));
}

__global__ void __launch_bounds__(NTHR, 2) mega(Params p_in) {
  Params p = p_in;
  p.pad = __builtin_amdgcn_readfirstlane((int)threadIdx.x >> 6);
  unsigned bar_target = 0u;
  extern __shared__ __attribute__((aligned(16))) unsigned char lds_raw[];
  u16* lds = (u16*)lds_raw;
  cg::grid_group grid = cg::this_grid();
  if (p_in.coop == 2) grid.sync();
#define PH_ON(k) (p.ph_lo <= (k) && (k) <= p.ph_hi)
#define PH_SYNC(k) if (p.coop && p.ph_lo <= (k) && (k) < p.ph_hi) grid_bar(p, bar_target);
  if (PH_ON(0)) {
    rms_rows(p, p.x, p.e_ng, (u16*)(p.ws + WS_HBF));
    conv_t(p, (u16*)(p.ws + WS_WT0), p.e_win, 1024, 4104, 4352, 0);
    conv_t(p, (u16*)(p.ws + WS_WT1), p.o_win, 1024, 3632, 3840, 1);
    conv_t(p, (u16*)(p.ws + WS_WO0), p.e_wout, 1024, 1024, 1024, 2);
    conv_t(p, (u16*)(p.ws + WS_WO1), p.o_wout, 1024, 1024, 1024, 2);
    conv_t(p, (u16*)(p.ws + WS_W1K), p.o_wk1, 2048, 256, 256, 2);
    conv_t(p, (u16*)(p.ws + WS_W1V), p.o_wv1, 2048, 256, 256, 2);
    conv_t(p, (u16*)(p.ws + WS_W2K), p.o_wk2, 256, 64, 256, 2);
    conv_t(p, (u16*)(p.ws + WS_W2V), p.o_wv2, 256, 64, 256, 2);
    pe_partial(p);
    if (BIDX == 0 && TIDX < 32) ((uint32_t*)(p.ws + WS_KMAX))[TIDX] = 0u;
    for (int i = BIDX * NTHR + TIDX; i < MTOK; i += gridDim.x * NTHR) ((float*)(p.ws + WS_SSQ))[i] = 0.f;
  }
  PH_SYNC(0)
  if (PH_ON(1)) gemm_inproj(p, 0, lds);
  PH_SYNC(1)
  if (PH_ON(2)) {
    fox_scan(p, (float*)lds); ret_stepA(p); fox_knorm(p);
    if (BIDX == gridDim.x - 1) {
      for (int i = TIDX; i < 512; i += NTHR) {
        const float* part = (const float*)(p.ws + WS_PEP);
        float sum = 0.f;
        for (int kc = 0; kc < 16; ++kc) sum += part[((i >> 8) * 16 + kc) * 256 + (i & 255)];
        ((float*)(p.ws + WS_PEB))[i] = sum;
      }
    }
  }
  PH_SYNC(2)
  if (PH_ON(3)) { ret_stepB(p); fox_phase(p, lds); }
  PH_SYNC(3)
  if (PH_ON(4)) ret_stepC(p, lds);
  PH_SYNC(4)
  if (PH_ON(5)) gemm_outproj(p, 0, lds);
  PH_SYNC(5)
  if (PH_ON(7)) gemm_inproj(p, 1, lds);
  PH_SYNC(7)
  if (PH_ON(8)) { gemm_cmp1(p, lds); nsa_knorm(p); }
  PH_SYNC(8)
  if (PH_ON(10)) nsa_phase(p, lds);
  PH_SYNC(10)
  if (PH_ON(11)) gemm_outproj(p, 1, lds);
  PH_SYNC(11)
  if (PH_ON(12)) final_norm(p);
}

extern "C" void kernel_launch(void* const* d_in, const int* in_sizes, int n_in, void* d_out, int out_size, void* d_ws,
                              size_t ws_size, hipStream_t stream) {
  static int grid_blocks = 0;
  if (!grid_blocks) {
    int dev = 0, cus = 0, per_cu = 0;
    hipGetDevice(&dev);
    hipDeviceGetAttribute(&cus, hipDeviceAttributeMultiprocessorCount, dev);
    hipFuncSetAttribute((const void*)mega, hipFuncAttributeMaxDynamicSharedMemorySize, LDS_BYTES);
    hipOccupancyMaxActiveBlocksPerMultiprocessor(&per_cu, (const void*)mega, NTHR, LDS_BYTES);
    if (per_cu < 1) per_cu = 1;
    if (per_cu > 1) per_cu = 1;
    grid_blocks = cus * per_cu;
    (void)hipGetLastError();
  }
  Params p{};
  p.x = (const float*)d_in[0]; p.e_ng = (const float*)d_in[1]; p.e_win = (const float*)d_in[2];
  p.e_bf = (const float*)d_in[3]; p.e_gn = (const float*)d_in[4]; p.e_wout = (const float*)d_in[5];
  p.o_ng = (const float*)d_in[6]; p.o_win = (const float*)d_in[7]; p.o_bg = (const float*)d_in[8];
  p.o_pek = (const float*)d_in[9]; p.o_pev = (const float*)d_in[10]; p.o_wk1 = (const float*)d_in[11];
  p.o_wk2 = (const float*)d_in[12]; p.o_wv1 = (const float*)d_in[13]; p.o_wv2 = (const float*)d_in[14];
  p.o_wout = (const float*)d_in[15]; p.fin_g = (const float*)d_in[16];
  p.out = (float*)d_out; p.ws = (unsigned char*)d_ws;
#if ONE_LAUNCH
  p.ph_lo = 0; p.ph_hi = NPHASE - 1; p.coop = 1;
  (void)hipMemsetAsync((unsigned char*)d_ws + WS_BAR, 0, 64, stream);
  void* args[] = {&p};
  hipError_t e = hipLaunchCooperativeKernel((const void*)mega, dim3(grid_blocks), dim3(NTHR), args, LDS_BYTES, stream);
  if (e != hipSuccess) fprintf(stderr, "cooperative launch failed: %s (grid %d)\n", hipGetErrorString(e), grid_blocks);
#else
  for (int ph = 0; ph < NPHASE; ++ph) {
    p.ph_lo = ph; p.ph_hi = ph; p.coop = 0;
    hipLaunchKernelGGL(mega, dim3(grid_blocks), dim3(NTHR), LDS_BYTES, stream, p);
  }
#endif
}
```

```cpp
#include <hip/hip_runtime.h>
#include <hip/hip_cooperative_groups.h>
#include <stdint.h>
#include <stdio.h>
namespace cg = cooperative_groups;

typedef unsigned short u16;
typedef short bf16x8 __attribute__((ext_vector_type(8)));
typedef short bf16x4 __attribute__((ext_vector_type(4)));
typedef float f32x4 __attribute__((ext_vector_type(4)));

#ifndef ONE_LAUNCH
#define ONE_LAUNCH 1
#endif

#define MTOK 32768
#define SEQ 8192
#define DM 1024
#define LDQ 3072
#define LOG2E 1.4426950408889634f
#define TS 72
#define IMPS 132
#define LDS_BYTES 147456
#define NTHR 512
#define NWAVE 8
#define NPHASE 13

#define MiB (1024ull * 1024ull)
#define WS_HBF   (0ull)
#define WS_DS    (0ull)
#define WS_ST    (32ull * MiB)
#define WS_QK    (64ull * MiB)
#define WS_VT    (256ull * MiB)
#define WS_Y     (352ull * MiB)
#define WS_WT0   (416ull * MiB)
#define WS_WT1   (WS_WT0 + 4352ull * 1024 * 2)
#define WS_WO0   (WS_WT1 + 3840ull * 1024 * 2)
#define WS_WO1   (WS_WO0 + 1024ull * 1024 * 2)
#define WS_W1K   (WS_WO1 + 1024ull * 1024 * 2)
#define WS_W1V   (WS_W1K + 256ull * 2048 * 2)
#define WS_W2K   (WS_W1V + 256ull * 2048 * 2)
#define WS_W2V   (WS_W2K + 256ull * 256 * 2)
#define WS_FLOG  (440ull * MiB)
#define WS_CFOX  (441ull * MiB)
#define WS_GL    (442ull * MiB)
#define WS_HC    (448ull * MiB)
#define WS_KCMP  (456ull * MiB)
#define WS_VCMPT (457ull * MiB)
#define WS_PEP   (458ull * MiB)
#define WS_PEB   (WS_PEP + 65536ull)
#define WS_KMAX  (WS_PEB + 4096ull)
#define WS_SSQ   (459ull * MiB)
#define WS_BAR   (WS_KMAX + 4096ull)

struct Params {
  const float *x, *e_ng, *e_win, *e_bf, *e_gn, *e_wout;
  const float *o_ng, *o_win, *o_bg, *o_pek, *o_pev, *o_wk1, *o_wk2, *o_wv1, *o_wv2, *o_wout, *fin_g;
  float* out;
  unsigned char* ws;
  int ph_lo, ph_hi, coop, pad;
};

typedef __bf16 bf16v2 __attribute__((ext_vector_type(2)));
typedef float f32v2 __attribute__((ext_vector_type(2)));
__device__ __forceinline__ uint32_t pack2(float a, float b) {
  f32v2 v = {a, b};
  bf16v2 r = __builtin_convertvector(v, bf16v2);
  return *(uint32_t*)&r;
}
__device__ __forceinline__ u16 f2bf(float f) { return (u16)(pack2(f, 0.f) & 0xffffu); }
__device__ __forceinline__ float bf2f(u16 h) { return __uint_as_float(((uint32_t)h) << 16); }
__device__ __forceinline__ float ex2(float x) { return __builtin_amdgcn_exp2f(x); }
__device__ __forceinline__ float silu_f(float z) { return z * __builtin_amdgcn_rcpf(1.f + ex2(-z * LOG2E)); }
__device__ __forceinline__ float sigmoid_f(float z) { return __builtin_amdgcn_rcpf(1.f + ex2(-z * LOG2E)); }

__device__ __forceinline__ int opq(int v) { asm volatile("" : "+v"(v)); return v; }
__device__ __forceinline__ int opqs(int v) { asm volatile("" : "+s"(v)); return v; }
#define TIDX opq(p.pad * 64 + (int)__lane_id())
#define BIDX opqs((int)blockIdx.x)
#define MFMA(a, b, c) __builtin_amdgcn_mfma_f32_16x16x32_bf16((a), (b), (c), 0, 0, 0)

__device__ __forceinline__ void rms_rows(const Params& p, const float* __restrict__ x, const float* __restrict__ g, u16* __restrict__ h) {
  const int lane = TIDX & 63, wave = TIDX >> 6;
  for (int row = BIDX * NWAVE + wave; row < MTOK; row += gridDim.x * NWAVE) {
    const float4* xr = (const float4*)(x + (size_t)row * DM);
    float4 v[4];
    float ss = 0.f;
#pragma unroll
    for (int i = 0; i < 4; ++i) {
      v[i] = xr[lane + 64 * i];
      ss += v[i].x * v[i].x + v[i].y * v[i].y + v[i].z * v[i].z + v[i].w * v[i].w;
    }
#pragma unroll
    for (int o = 32; o >= 1; o >>= 1) ss += __shfl_xor(ss, o);
    const float rstd = rsqrtf(ss * (1.f / DM) + 1e-6f);
#pragma unroll
    for (int i = 0; i < 4; ++i) {
      float4 gg = ((const float4*)g)[lane + 64 * i];
      uint2 o;
      o.x = pack2(v[i].x * rstd * gg.x, v[i].y * rstd * gg.y);
      o.y = pack2(v[i].z * rstd * gg.z, v[i].w * rstd * gg.w);
      *(uint2*)(h + (size_t)row * DM + (lane + 64 * i) * 4) = o;
    }
  }
}

__device__ __forceinline__ int map_col(int MAP, int n) {
  if (MAP == 0) {
    if (n < 1024) return n;
    if (n < 2048) return n + 520;
    if (n < 3072) return n + 1032;
    if (n < 3584) return n - 2048;
    if (n < 4096) return n - 1016;
    if (n < 4104) return n - 2560;
    return -1;
  } else if (MAP == 1) {
    if (n < 1792) return n;
    if (n < 2048) return n + 256;
    if (n < 3072) return n + 560;
    if (n < 3328) return n - 1280;
    if (n < 3584) return n - 1024;
    if (n < 3632) return n - 1024;
    return -1;
  } else if (MAP == 2) {
    return n;
  }
  return n;
}

__device__ __forceinline__ void conv_t(const Params& p, u16* __restrict__ dst, const float* __restrict__ src, int K, int nsrc, int ndst, int MAP) {
  const int total = ndst * (K >> 3);
  for (int id = BIDX * NTHR + TIDX; id < total; id += gridDim.x * NTHR) {
    const int n = id % ndst, kc = id / ndst;
    const int sc = map_col(MAP, n);
    float v[8];
#pragma unroll
    for (int i = 0; i < 8; ++i) v[i] = (sc >= 0 && sc < nsrc) ? src[(size_t)(kc * 8 + i) * nsrc + sc] : 0.f;
    uint4 o;
    o.x = pack2(v[0], v[1]); o.y = pack2(v[2], v[3]); o.z = pack2(v[4], v[5]); o.w = pack2(v[6], v[7]);
    *(uint4*)(dst + (size_t)n * K + kc * 8) = o;
  }
}

__device__ __forceinline__ void pe_partial(const Params& p) {
  float* part = (float*)(p.ws + WS_PEP);
  for (int task = BIDX; task < 32; task += gridDim.x) {
    const int kv = task >> 4, kc = task & 15, n = TIDX;
    if (n >= 256) continue;
    const float* pe = kv ? p.o_pev : p.o_pek;
    const float* w1 = kv ? p.o_wv1 : p.o_wk1;
    float acc = 0.f;
#pragma unroll 16
    for (int k = kc * 128; k < kc * 128 + 128; ++k) acc += pe[k] * w1[(size_t)k * 256 + n];
    part[(kv * 16 + kc) * 256 + n] = acc;
  }
}

#define GST (512 * TS)
template <bool swapped>
__device__ __forceinline__ void gemm_compute(const u16* cur, f32x4 (&acc)[8][4], int wpa, int wpb, int l16, int gk) {
  const u16* sA = cur + (wpa * 128 + l16) * TS + gk * 8;
  const u16* sB = cur + (256 + wpb * 64 + l16) * TS + gk * 8;
#pragma unroll 1
  for (int kk = 0; kk < 2; ++kk) {
    bf16x8 fa[8], fb[4];
#pragma unroll
    for (int i = 0; i < 8; ++i) fa[i] = *(const bf16x8*)(sA + i * 16 * TS + kk * 32);
#pragma unroll
    for (int j = 0; j < 4; ++j) fb[j] = *(const bf16x8*)(sB + j * 16 * TS + kk * 32);
    if (swapped) {
#pragma unroll
      for (int i = 0; i < 8; ++i)
#pragma unroll
        for (int j = 0; j < 4; ++j) acc[i][j] = MFMA(fb[j], fa[i], acc[i][j]);
    } else {
#pragma unroll
      for (int i = 0; i < 8; ++i)
#pragma unroll
        for (int j = 0; j < 4; ++j) acc[i][j] = MFMA(fa[i], fb[j], acc[i][j]);
    }
  }
}
template <bool swapped>
__device__ __forceinline__ void gemm_mainloop(const Params& p, const u16* __restrict__ Ab, const uint32_t (&pa)[4], const u16* __restrict__ Bb,
                                              const uint32_t (&pb)[4], int a_kstride, int nk,
                                              u16* lds, f32x4 (&acc)[8][4]) {
  const int tid = TIDX, lane = tid & 63, wave = tid >> 6;
  const int l16 = lane & 15, gk = lane >> 4;
  const int wpa = wave >> 2, wpb = wave & 3;
  const int woff = (tid >> 3) * TS + (tid & 7) * 8;
  uint4 ra0, ra1, ra2, ra3, rb0, rb1, rb2, rb3;
#define G_LD(kidx) { const u16* Ap_ = Ab + (size_t)(kidx) * a_kstride; const u16* Bp_ = Bb + (size_t)(kidx) * 64;   \
    ra0 = *(const uint4*)(Ap_ + pa[0]); ra1 = *(const uint4*)(Ap_ + pa[1]); ra2 = *(const uint4*)(Ap_ + pa[2]); ra3 = *(const uint4*)(Ap_ + pa[3]); \
    rb0 = *(const uint4*)(Bp_ + pb[0]); rb1 = *(const uint4*)(Bp_ + pb[1]); rb2 = *(const uint4*)(Bp_ + pb[2]); rb3 = *(const uint4*)(Bp_ + pb[3]); }
#define G_ST(D) { u16* D_ = (D) + woff;                                                                               \
    *(uint4*)(D_) = ra0; *(uint4*)(D_ + 64 * TS) = ra1; *(uint4*)(D_ + 128 * TS) = ra2; *(uint4*)(D_ + 192 * TS) = ra3;  \
    *(uint4*)(D_ + 256 * TS) = rb0; *(uint4*)(D_ + 320 * TS) = rb1; *(uint4*)(D_ + 384 * TS) = rb2; *(uint4*)(D_ + 448 * TS) = rb3; }
  G_LD(0)
  __syncthreads();
  G_ST(lds)
  __syncthreads();
#pragma unroll
  for (int i = 0; i < 8; ++i)
#pragma unroll
    for (int j = 0; j < 4; ++j) acc[i][j] = (f32x4){0.f, 0.f, 0.f, 0.f};
#pragma unroll 1
  for (int ks = 0; ks < nk; ++ks) {
    const bool more = (ks + 1 < nk);
    if (more) G_LD(ks + 1)
    gemm_compute<swapped>(lds + (ks & 1) * GST, acc, wpa, wpb, l16, gk);
    if (more) G_ST(lds + ((ks + 1) & 1) * GST)
    __syncthreads();
  }
#undef G_LD
#undef G_ST
}
#define GEMM_OFFS(rowstrideA, rowstrideB)                                   \
  uint32_t pa[4], pb[4];                                                    \
  _Pragma("unroll") for (int i = 0; i < 4; ++i) {                           \
    pa[i] = (uint32_t)((tid >> 3) + 64 * i) * (rowstrideA) + (tid & 7) * 8; \
    pb[i] = (uint32_t)((tid >> 3) + 64 * i) * (rowstrideB) + (tid & 7) * 8; \
  }

__device__ __forceinline__ void gemm_inproj(const Params& p, int layer, u16* lds) {
  const u16* A = (const u16*)(p.ws + WS_HBF);
  const u16* Bt = (const u16*)(p.ws + (layer ? WS_WT1 : WS_WT0));
  u16* QK = (u16*)(p.ws + WS_QK);
  u16* VT = (u16*)(p.ws + WS_VT);
  float* F = (float*)(p.ws + (layer ? WS_GL : WS_FLOG));
  const int NT = layer ? 15 : 17;
  const int seg_trans_end = layer ? 28 : 32;
  const int nvalidF = layer ? 48 : 8, ldf = layer ? 48 : 8;
  const int tid = TIDX, lane = tid & 63, wave = tid >> 6, l16 = lane & 15, gk = lane >> 4;
  const int wpa = wave >> 2, wpb = wave & 3;
  const int bid = BIDX, xcd = bid & 7, nloc = (int)gridDim.x >> 3;
  for (int q = bid >> 3; q < 16 * NT; q += nloc) {
    const int mt = xcd * 16 + q / NT, nt = q % NT;
    const int m0 = mt * 256, n0 = nt * 256;
    const int mw = m0 + wpa * 128, nw = n0 + wpb * 64;
    const int seg = nw >> 7;
    int mode;
    if (seg < 24) mode = (layer == 0 && seg >= 12 && seg < 16) ? 2 : 0;
    else if (seg < seg_trans_end) mode = 1;
    else if (seg == seg_trans_end) mode = 3;
    else mode = 4;
    const int seg0 = nt * 2;
    const bool swapped = !((seg0 >= 24 && seg0 < seg_trans_end) || (layer == 0 && seg0 >= 12 && seg0 < 16));
    GEMM_OFFS(DM, DM)
    f32x4 acc[8][4];
    if (swapped) gemm_mainloop<true>(p, A + (size_t)m0 * DM, pa, Bt + (size_t)n0 * DM, pb, 64, 16, lds, acc);
    else gemm_mainloop<false>(p, A + (size_t)m0 * DM, pa, Bt + (size_t)n0 * DM, pb, 64, 16, lds, acc);
    const float* ssq_g = (const float*)(p.ws + WS_SSQ);
    if (mode == 0 || mode == 3) {
#pragma unroll
      for (int i = 0; i < 8; ++i) {
        const int m = mw + i * 16 + l16;
        const float rs = layer ? rsqrtf(ssq_g[m] * (1.f / DM) + 1e-6f) : 1.f;
#pragma unroll
        for (int j = 0; j < 4; ++j) {
          const int n = nw + j * 16 + gk * 4;
          const float a0 = acc[i][j][0] * rs, a1 = acc[i][j][1] * rs, a2 = acc[i][j][2] * rs, a3 = acc[i][j][3] * rs;
          if (mode == 0) {
            uint2 o; o.x = pack2(a0, a1); o.y = pack2(a2, a3);
            *(uint2*)(QK + (size_t)m * LDQ + n) = o;
          } else {
            const int nn = n - seg * 128;
            if (nn < nvalidF) *(float4*)(F + (size_t)m * ldf + nn) = (float4){a0, a1, a2, a3};
          }
        }
      }
    } else if (mode == 1 || mode == 2) {
#pragma unroll
      for (int i = 0; i < 8; ++i) {
        const int m = mw + i * 16 + gk * 4;
        float rs0 = 1.f, rs1 = 1.f, rs2 = 1.f, rs3 = 1.f;
        if (layer) {
          const float4 q4 = *(const float4*)(ssq_g + m);
          rs0 = rsqrtf(q4.x * (1.f / DM) + 1e-6f); rs1 = rsqrtf(q4.y * (1.f / DM) + 1e-6f);
          rs2 = rsqrtf(q4.z * (1.f / DM) + 1e-6f); rs3 = rsqrtf(q4.w * (1.f / DM) + 1e-6f);
        }
#pragma unroll
        for (int j = 0; j < 4; ++j) {
          const int n = nw + j * 16 + l16;
          const float a0 = acc[i][j][0] * rs0, a1 = acc[i][j][1] * rs1, a2 = acc[i][j][2] * rs2, a3 = acc[i][j][3] * rs3;
          if (mode == 1) {
            const int trow = n - 3072;
            uint2 o; o.x = pack2(a0, a1); o.y = pack2(a2, a3);
            *(uint2*)(VT + (size_t)trow * MTOK + m) = o;
          } else {
            const int trow = n - 512;
            const int h = (nw - 1536) >> 6;
            const float lg2 = log1pf(-exp2f(-5.f - (float)h)) * LOG2E;
            const float lane_dec = 0.125f * ex2(lg2 * (float)(127 - gk * 4));
            QK[(size_t)(m + 0) * LDQ + n] = f2bf(a0); QK[(size_t)(m + 1) * LDQ + n] = f2bf(a1);
            QK[(size_t)(m + 2) * LDQ + n] = f2bf(a2); QK[(size_t)(m + 3) * LDQ + n] = f2bf(a3);
            const float s0 = a0 * lane_dec * ex2(lg2 * (float)(-(i * 16 + 0))), s1 = a1 * lane_dec * ex2(lg2 * (float)(-(i * 16 + 1)));
            const float s2 = a2 * lane_dec * ex2(lg2 * (float)(-(i * 16 + 2))), s3 = a3 * lane_dec * ex2(lg2 * (float)(-(i * 16 + 3)));
            uint2 o; o.x = pack2(s0, s1); o.y = pack2(s2, s3);
            *(uint2*)(VT + (size_t)trow * MTOK + m) = o;
          }
        }
      }
    }
  }
}

__device__ __forceinline__ void gemm_outproj(const Params& p, int layer, u16* lds) {
  const u16* A = (const u16*)(p.ws + WS_Y);
  const u16* Bt = (const u16*)(p.ws + (layer ? WS_WO1 : WS_WO0));
  const float* res = layer ? p.out : p.x;
  float* out = p.out;
  u16* hb_out = (u16*)(p.ws + WS_HBF);
  float* ssq_g = (float*)(p.ws + WS_SSQ);
  const int tid = TIDX, lane = tid & 63, wave = tid >> 6, l16 = lane & 15, gk = lane >> 4;
  const int wpa = wave >> 2, wpb = wave & 3;
  const int bid = BIDX, xcd = bid & 7, nloc = (int)gridDim.x >> 3;
  for (int q = bid >> 3; q < 16 * 4; q += nloc) {
    const int mt = xcd * 16 + (q >> 2), nt = q & 3;
    const int m0 = mt * 256, n0 = nt * 256;
    GEMM_OFFS(DM, DM)
    f32x4 acc[8][4];
    gemm_mainloop<true>(p, A + (size_t)m0 * DM, pa, Bt + (size_t)n0 * DM, pb, 64, 16, lds, acc);
    const int tid2 = TIDX, lane2 = tid2 & 63, wave2 = tid2 >> 6, l16b = lane2 & 15, gkb = lane2 >> 4;
    const int mw = m0 + (wave2 >> 2) * 128, nw = n0 + (wave2 & 3) * 64;
#pragma unroll
    for (int i = 0; i < 8; ++i) {
      const int m = mw + i * 16 + l16b;
      float sq = 0.f;
#pragma unroll
      for (int j = 0; j < 4; ++j) {
        const int n = nw + j * 16 + gkb * 4;
        const float4 r = *(const float4*)(res + (size_t)m * DM + n);
        const float4 v = (float4){r.x + acc[i][j][0], r.y + acc[i][j][1], r.z + acc[i][j][2], r.w + acc[i][j][3]};
        *(float4*)(out + (size_t)m * DM + n) = v;
        if (layer == 0) {
          const float4 gg = *(const float4*)(p.o_ng + n);
          uint2 hb; hb.x = pack2(v.x * gg.x, v.y * gg.y); hb.y = pack2(v.z * gg.z, v.w * gg.w);
          *(uint2*)(hb_out + (size_t)m * DM + n) = hb;
          sq += v.x * v.x + v.y * v.y + v.z * v.z + v.w * v.w;
        }
      }
      if (layer == 0) {
        sq += __shfl_xor(sq, 16); sq += __shfl_xor(sq, 32);
        if (gkb == 0) atomicAdd(ssq_g + m, sq);
      }
    }
  }
}

__device__ __forceinline__ void gemm_cmp2_tile(const Params& p, u16* lds, int kv, int mt) {
  const int tid = TIDX, lane = tid & 63, wave = tid >> 6, l16 = lane & 15, gk = lane >> 4;
  const int wpa = wave >> 2, wpb = wave & 3;
  {
    const int m0 = mt * 256;
    const u16* A = (const u16*)(p.ws + WS_HC) + (size_t)kv * 8192 * 256;
    const u16* Bt = (const u16*)(p.ws + (kv ? WS_W2V : WS_W2K));
    GEMM_OFFS(256, 256)
    f32x4 acc[8][4];
    const bool swapped = (kv == 0);
    if (swapped) gemm_mainloop<true>(p, A + (size_t)m0 * 256, pa, Bt, pb, 64, 4, lds, acc);
    else gemm_mainloop<false>(p, A + (size_t)m0 * 256, pa, Bt, pb, 64, 4, lds, acc);
    const int mw = m0 + wpa * 128, nw = wpb * 64;
    if (swapped) {
      u16* kc_ = (u16*)(p.ws + WS_KCMP);
#pragma unroll
      for (int i = 0; i < 8; ++i)
#pragma unroll
        for (int j = 0; j < 4; ++j) {
          const int n = nw + j * 16 + gk * 4;
          const int m = mw + i * 16 + l16;
          if (n < 64) {
            uint2 o; o.x = pack2(acc[i][j][0], acc[i][j][1]); o.y = pack2(acc[i][j][2], acc[i][j][3]);
            *(uint2*)(kc_ + (size_t)m * 64 + n) = o;
          }
        }
      if (wpb == 0) {
        float mxn = 0.f;
#pragma unroll
        for (int i = 0; i < 8; ++i) {
          float ss = 0.f;
#pragma unroll
          for (int j = 0; j < 4; ++j) ss += acc[i][j][0] * acc[i][j][0] + acc[i][j][1] * acc[i][j][1] + acc[i][j][2] * acc[i][j][2] + acc[i][j][3] * acc[i][j][3];
          ss += __shfl_xor(ss, 16); ss += __shfl_xor(ss, 32);
          mxn = fmaxf(mxn, ss);
        }
#pragma unroll
        for (int o2 = 1; o2 <= 8; o2 <<= 1) mxn = fmaxf(mxn, __shfl_xor(mxn, o2));
        if (lane == 0) atomicMax((uint32_t*)(p.ws + WS_KMAX) + 16 + ((mw >> 9) & 3), __float_as_uint(mxn));
      }
    } else {
      u16* vt = (u16*)(p.ws + WS_VCMPT);
#pragma unroll
      for (int i = 0; i < 8; ++i)
#pragma unroll
        for (int j = 0; j < 4; ++j) {
          const int m = mw + i * 16 + gk * 4;
          const int n = nw + j * 16 + l16;
          if (n < 64) {
            uint2 o; o.x = pack2(acc[i][j][0], acc[i][j][1]); o.y = pack2(acc[i][j][2], acc[i][j][3]);
            *(uint2*)(vt + (size_t)(m >> 9) * 32768 + (size_t)n * 512 + (m & 511)) = o;
          }
        }
    }
  }
}

__device__ __forceinline__ void gemm_cmp1(const Params& p, u16* lds) {
  const u16* U = (const u16*)(p.ws + WS_QK);
  const float* peb = (const float*)(p.ws + WS_PEB);
  const int tid = TIDX, lane = tid & 63, wave = tid >> 6, l16 = lane & 15, gk = lane >> 4;
  const int wpa = wave >> 2, wpb = wave & 3;
  for (int tile = BIDX; tile < 64; tile += gridDim.x) {
    const int kv = tile >> 5, mt = tile & 31;
    const int m0 = mt * 256;
    const u16* Bt = (const u16*)(p.ws + (kv ? WS_W1V : WS_W1K));
    u16* Hc = (u16*)(p.ws + WS_HC) + (size_t)kv * 8192 * 256;
    uint32_t pa[4], pb[4];
#pragma unroll
    for (int i = 0; i < 4; ++i) {
      const int row = (tid >> 3) + 64 * i, kc = tid & 7;
      const int r = m0 + row, bg = r >> 9, cc = r & 511, b = bg >> 2, g = bg & 3;
      int tok0 = cc * 16; if (tok0 > SEQ - 32) tok0 = SEQ - 32;
      pa[i] = (uint32_t)(b * SEQ + tok0) * LDQ + 1024 + kv * 256 + g * 64 + kc * 8;
      pb[i] = (uint32_t)row * 2048 + kc * 8;
    }
    f32x4 acc[8][4];
    gemm_mainloop<true>(p, U, pa, Bt, pb, LDQ, 32, lds, acc);
    const int tid2 = TIDX, lane2 = tid2 & 63, wave2 = tid2 >> 6;
    const int mw = m0 + (wave2 >> 2) * 128, nw = (wave2 & 3) * 64;
#pragma unroll
    for (int i = 0; i < 8; ++i)
#pragma unroll
      for (int j = 0; j < 4; ++j) {
        const int n = nw + j * 16 + (lane2 >> 4) * 4;
        const int m = mw + i * 16 + (lane2 & 15);
        const float4 bb = *(const float4*)(peb + kv * 256 + n);
        float v0 = silu_f(acc[i][j][0] + bb.x), v1 = silu_f(acc[i][j][1] + bb.y);
        float v2 = silu_f(acc[i][j][2] + bb.z), v3 = silu_f(acc[i][j][3] + bb.w);
        if ((m & 511) == 511) { v0 = v1 = v2 = v3 = 0.f; }
        uint2 o; o.x = pack2(v0, v1); o.y = pack2(v2, v3);
        *(uint2*)(Hc + (size_t)m * 256 + n) = o;
      }
    __threadfence_block();
    __syncthreads();
    gemm_cmp2_tile(p, lds, kv, mt);
  }
}

#define TILE_LD(R, src, stride) { R##0 = *(const uint4*)((src) + (long)(tid >> 3) * (stride) + (tid & 7) * 8); }
#define TILE_ST(dst, R) { *(uint4*)((dst) + (tid >> 3) * TS + (tid & 7) * 8) = R##0; }
#define VPOS(c) ((((c) >> 2) * 32) + ((2 * ((c) & 1)) * 8) + ((((c) & 3) >> 1) * 4))
#define TILE_STV_(dst, val) { const int c_ = tid & 7; u16* d_ = (dst) + (tid >> 3) * TS + VPOS(c_); \
    *(uint2*)(d_) = make_uint2((val).x, (val).y); *(uint2*)(d_ + 8) = make_uint2((val).z, (val).w); }
#define TILE_STV(dst, R) TILE_STV_(dst, R##0)
__device__ __forceinline__ void qk_tile(const u16* sK, const bf16x8 (&q)[2], f32x4 (&s)[4], int l16, int gk) {
#pragma unroll
  for (int kt = 0; kt < 4; ++kt) s[kt] = (f32x4){0.f, 0.f, 0.f, 0.f};
#pragma unroll
  for (int ks = 0; ks < 2; ++ks)
#pragma unroll
    for (int kt = 0; kt < 4; ++kt) {
      bf16x8 kf = *(const bf16x8*)(sK + (kt * 16 + l16) * TS + ks * 32 + gk * 8);
      s[kt] = MFMA(kf, q[ks], s[kt]);
    }
}
__device__ __forceinline__ void pv_tile(const u16* sV, const float (&pp)[4][4], f32x4 (&o)[4], int l16, int gk) {
  bf16x8 pf[2];
#pragma unroll
  for (int ks2 = 0; ks2 < 2; ++ks2) {
    uint4 t;
    t.x = pack2(pp[2 * ks2][0], pp[2 * ks2][1]); t.y = pack2(pp[2 * ks2][2], pp[2 * ks2][3]);
    t.z = pack2(pp[2 * ks2 + 1][0], pp[2 * ks2 + 1][1]); t.w = pack2(pp[2 * ks2 + 1][2], pp[2 * ks2 + 1][3]);
    pf[ks2] = *(bf16x8*)&t;
  }
#pragma unroll
  for (int dt = 0; dt < 4; ++dt)
#pragma unroll
    for (int ks2 = 0; ks2 < 2; ++ks2) {
      const bf16x8 vf = *(const bf16x8*)(sV + (dt * 16 + l16) * TS + ks2 * 32 + gk * 8);
      o[dt] = MFMA(vf, pf[ks2], o[dt]);
    }
}

__device__ __forceinline__ void fox_phase(const Params& p, u16* lds) {
  const u16* QK = (const u16*)(p.ws + WS_QK);
  const u16* VT = (const u16*)(p.ws + WS_VT);
  const float* cf = (const float*)(p.ws + WS_CFOX);
  u16* Y = (u16*)(p.ws + WS_Y);
  const int tid = TIDX, lane = tid & 63, w = tid >> 6, l16 = lane & 15, gk = lane >> 4;
  const float scale2 = 0.125f * LOG2E;
  for (int unit = BIDX; unit < 2048; unit += gridDim.x) {
    const int bh = unit & 31, qblk = 63 - (unit >> 5), b = bh >> 3, h = bh & 7;
    const int tq0 = qblk * 128 + w * 16;
    const int t = tq0 + l16;
    const float* cfr = cf + (size_t)bh * SEQ;
    bf16x8 q[2];
#pragma unroll
    for (int ks = 0; ks < 2; ++ks) q[ks] = *(const bf16x8*)(QK + (size_t)(b * SEQ + t) * LDQ + h * 64 + ks * 32 + gk * 8);
    const float cq2 = cfr[t] * LOG2E;
    f32x4 o[4];
    float m = -1e30f, l = 0.f;
#pragma unroll
    for (int dt = 0; dt < 4; ++dt) o[dt] = (f32x4){0.f, 0.f, 0.f, 0.f};
    const int ntiles = qblk * 2 + 2;
    const int iw = qblk * 2 + (w >> 2);
    const u16* ksrc = QK + (size_t)(b * SEQ) * LDQ + 512 + h * 64;
    const u16* vsrc = VT + (size_t)(h * 64) * MTOK + (size_t)b * SEQ;
    float qs = 0.f;
#pragma unroll
    for (int ks = 0; ks < 2; ++ks)
#pragma unroll
      for (int e = 0; e < 8; ++e) { const float v = bf2f((u16)q[ks][e]); qs += v * v; }
    qs += __shfl_xor(qs, 16); qs += __shfl_xor(qs, 32);
#pragma unroll
    for (int o2 = 1; o2 <= 8; o2 <<= 1) qs = fmaxf(qs, __shfl_xor(qs, o2));
    float* red = (float*)(lds + 256 * TS);
    if (lane == 0) red[w] = qs;
    __syncthreads();
    float qmax2 = red[0];
#pragma unroll
    for (int i = 1; i < NWAVE; ++i) qmax2 = fmaxf(qmax2, red[i]);
    const float kmax2 = __uint_as_float(((const uint32_t*)(p.ws + WS_KMAX))[h]);
    const float T2 = 2.f * scale2 * sqrtf(qmax2 * kmax2) * 1.001f + 48.f;
    const float cfirst2 = cfr[qblk * 128] * LOG2E;
    int i_lo = 0;
    for (int base = qblk * 2 - 1; base >= 0; base -= 64) {
      const int ti = base - lane;
      bool skip = false;
      if (ti >= 0) skip = (cfirst2 - cfr[ti * 64 + 63] * LOG2E) < -T2;
      const unsigned long long bal = __ballot(skip);
      if (bal) { i_lo = base - (int)__builtin_ctzll(bal) + 1; break; }
    }
    uint4 rk0, rv0;
    TILE_LD(rk, ksrc + (size_t)i_lo * 64 * LDQ, LDQ); TILE_LD(rv, vsrc + i_lo * 64, MTOK);
    TILE_ST(lds + (i_lo & 1) * (128 * TS), rk); TILE_STV(lds + (i_lo & 1) * (128 * TS) + 64 * TS, rv);
    __syncthreads();
    for (int i = i_lo; i < ntiles; ++i) {
      u16* cur = lds + (i & 1) * (128 * TS);
      const bool more = (i + 1 < ntiles);
      if (more) { TILE_LD(rk, ksrc + (size_t)(i + 1) * 64 * LDQ, LDQ); TILE_LD(rv, vsrc + (i + 1) * 64, MTOK); }
      if (i <= iw) {
        const int s0 = i * 64;
        const bool diag = (i == iw);
        f32x4 s[4];
        qk_tile(cur, q, s, l16, gk);
        float xv[4][4];
        float mx = -1e30f;
#pragma unroll
        for (int kt = 0; kt < 4; ++kt) {
          const float4 c4 = *(const float4*)(cfr + s0 + kt * 16 + gk * 4);
          const float ck[4] = {c4.x, c4.y, c4.z, c4.w};
#pragma unroll
          for (int r = 0; r < 4; ++r) {
            float v = fmaf(s[kt][r], scale2, cq2 - ck[r] * LOG2E);
            if (diag && (s0 + kt * 16 + gk * 4 + r > t)) v = -1e30f;
            xv[kt][r] = v; mx = fmaxf(mx, v);
          }
        }
        mx = fmaxf(mx, __shfl_xor(mx, 16)); mx = fmaxf(mx, __shfl_xor(mx, 32));
        const float mnew = fmaxf(m, mx);
        const float alpha = ex2(m - mnew);
        m = mnew;
        const float muse = fmaxf(mnew, -1e20f);
        float rs = 0.f;
#pragma unroll
        for (int kt = 0; kt < 4; ++kt)
#pragma unroll
          for (int r = 0; r < 4; ++r) { xv[kt][r] = ex2(xv[kt][r] - muse); rs += xv[kt][r]; }
        l = l * alpha + rs;
#pragma unroll
        for (int dt = 0; dt < 4; ++dt) o[dt] *= alpha;
        pv_tile(cur + 64 * TS, xv, o, l16, gk);
      }
      if (more) { u16* nxt = lds + ((i + 1) & 1) * (128 * TS); TILE_ST(nxt, rk); TILE_STV(nxt + 64 * TS, rv); }
      __syncthreads();
    }
    {
      float lt = l; lt += __shfl_xor(lt, 16); lt += __shfl_xor(lt, 32);
      const float inv = lt > 0.f ? 1.f / lt : 0.f;
      const size_t mrow = (size_t)(b * SEQ + t);
#pragma unroll
      for (int dt = 0; dt < 4; ++dt) {
        const int col = h * 64 + dt * 16 + gk * 4;
        const uint2 zz = *(const uint2*)(QK + mrow * LDQ + 2048 + col);
        const float z0 = bf2f(zz.x & 0xffff), z1 = bf2f(zz.x >> 16), z2 = bf2f(zz.y & 0xffff), z3 = bf2f(zz.y >> 16);
        uint2 ov;
        ov.x = pack2(o[dt][0] * inv * silu_f(z0), o[dt][1] * inv * silu_f(z1));
        ov.y = pack2(o[dt][2] * inv * silu_f(z2), o[dt][3] * inv * silu_f(z3));
        *(uint2*)(Y + mrow * DM + col) = ov;
      }
    }
  }
}

__device__ __forceinline__ void fox_knorm(const Params& p) {
  const u16* QK = (const u16*)(p.ws + WS_QK);
  uint32_t* km = (uint32_t*)(p.ws + WS_KMAX);
  const int tid = TIDX, lane = tid & 63, wave = tid >> 6;
  float mx = 0.f;
  for (int row = BIDX * NWAVE + wave; row < MTOK; row += gridDim.x * NWAVE) {
    const uint4 v = *(const uint4*)(QK + (size_t)row * LDQ + 512 + lane * 8);
    const float a0 = bf2f(v.x & 0xffff), a1 = bf2f(v.x >> 16), a2 = bf2f(v.y & 0xffff), a3 = bf2f(v.y >> 16);
    const float a4 = bf2f(v.z & 0xffff), a5 = bf2f(v.z >> 16), a6 = bf2f(v.w & 0xffff), a7 = bf2f(v.w >> 16);
    float ss = a0 * a0 + a1 * a1 + a2 * a2 + a3 * a3 + a4 * a4 + a5 * a5 + a6 * a6 + a7 * a7;
    ss += __shfl_xor(ss, 1); ss += __shfl_xor(ss, 2); ss += __shfl_xor(ss, 4);
    mx = fmaxf(mx, ss);
  }
  if ((lane & 7) == 0) atomicMax(&km[lane >> 3], __float_as_uint(mx));
}

__device__ __forceinline__ void fox_scan(const Params& p, float* ldsf) {
  const float* fl = (const float*)(p.ws + WS_FLOG);
  float* cf = (float*)(p.ws + WS_CFOX);
  double* sd = (double*)ldsf;
  const int tid = TIDX;
  for (int bh = BIDX; bh < 32; bh += gridDim.x) {
    const int b = bh >> 3, h = bh & 7;
    const float bf = p.e_bf[h];
    float ls[16];
    double sum = 0.0;
#pragma unroll
    for (int i = 0; i < 16; ++i) {
      const float xx = fl[(size_t)(b * SEQ + tid * 16 + i) * 8 + h] + bf;
      ls[i] = fminf(xx, 0.f) - log1pf(__expf(-fabsf(xx)));
      sum += (double)ls[i];
    }
    __syncthreads();
    sd[tid] = sum;
    __syncthreads();
    double pre = 0.0;
    for (int j = 0; j < tid; ++j) pre += sd[j];
#pragma unroll
    for (int i = 0; i < 16; ++i) { pre += (double)ls[i]; cf[(size_t)bh * SEQ + tid * 16 + i] = (float)pre; }
  }
}

__device__ __forceinline__ void ret_stepA(const Params& p) {
  const u16* VT = (const u16*)(p.ws + WS_VT);
  float* dS = (float*)(p.ws + WS_DS);
  const int tid_ = TIDX, lane = tid_ & 63, w8 = tid_ >> 6, w = w8 & 3, l16 = lane & 15, gk = lane >> 4;
  for (int u2 = BIDX; u2 < 1024; u2 += gridDim.x) {
    const int u = u2 * 2 + (w8 >> 2);
    const int bh = u >> 6, n = u & 63, b = bh >> 3, h = bh & 7;
    const size_t mcol = (size_t)b * SEQ + n * 128;
    f32x4 acc[4];
#pragma unroll
    for (int dt = 0; dt < 4; ++dt) acc[dt] = (f32x4){0.f, 0.f, 0.f, 0.f};
#pragma unroll
    for (int ks = 0; ks < 4; ++ks) {
      bf16x8 af = *(const bf16x8*)(VT + (size_t)(512 + h * 64 + w * 16 + l16) * MTOK + mcol + ks * 32 + gk * 8);
#pragma unroll
      for (int dt = 0; dt < 4; ++dt) {
        bf16x8 bfr = *(const bf16x8*)(VT + (size_t)(1024 + h * 64 + dt * 16 + l16) * MTOK + mcol + ks * 32 + gk * 8);
        acc[dt] = MFMA(af, bfr, acc[dt]);
      }
    }
#pragma unroll
    for (int dt = 0; dt < 4; ++dt)
#pragma unroll
      for (int r = 0; r < 4; ++r) dS[(size_t)u * 4096 + (w * 16 + gk * 4 + r) * 64 + dt * 16 + l16] = acc[dt][r];
  }
}
__device__ __forceinline__ void ret_stepB(const Params& p) {
  const float* dS = (const float*)(p.ws + WS_DS);
  u16* st = (u16*)(p.ws + WS_ST);
  for (int idx = BIDX * NTHR + TIDX; idx < 32 * 4096; idx += gridDim.x * NTHR) {
    const int bh = idx >> 12, ed = idx & 4095, h = bh & 7;
    const float cdec = __expf(log1pf(-exp2f(-5.f - (float)h)) * 128.f);
    float s = 0.f;
#pragma unroll 8
    for (int n = 0; n < 64; ++n) {
      const size_t a = (size_t)(bh * 64 + n) * 4096 + ed;
      st[a] = f2bf(s);
      s = s * cdec + dS[a];
    }
  }
}
__device__ __forceinline__ void ret_stepC(const Params& p, u16* lds) {
  const u16* QK = (const u16*)(p.ws + WS_QK);
  const u16* VT = (const u16*)(p.ws + WS_VT);
  const u16* st = (const u16*)(p.ws + WS_ST);
  u16* Y = (u16*)(p.ws + WS_Y);
  const int tid = TIDX, lane = tid & 63, w = tid >> 6, l16 = lane & 15, gk = lane >> 4;
  for (int u = BIDX; u < 2048; u += gridDim.x) {
    const int bh = u >> 6, n = u & 63, b = bh >> 3, h = bh & 7;
    const size_t m0 = (size_t)b * SEQ + n * 128;
    const float lg2 = log1pf(-exp2f(-5.f - (float)h)) * LOG2E;
    __syncthreads();
    {
      uint4 r0;
      TILE_LD(r, QK + m0 * LDQ + 1536 + h * 64, LDQ); TILE_ST(lds, r);
      TILE_LD(r, VT + (size_t)(512 + h * 64) * MTOK + m0, MTOK); TILE_STV(lds + 64 * TS, r);
      TILE_LD(r, QK + (m0 + 64) * LDQ + 1536 + h * 64, LDQ); TILE_ST(lds + 128 * TS, r);
      TILE_LD(r, VT + (size_t)(512 + h * 64) * MTOK + m0 + 64, MTOK); TILE_STV(lds + 192 * TS, r);
      TILE_LD(r, st + (size_t)u * 4096, 64); TILE_ST(lds + 256 * TS, r);
    }
    __syncthreads();
    const int iq = 16 * w + l16;
    const size_t mrow = m0 + iq;
    bf16x8 q[2];
#pragma unroll
    for (int ks = 0; ks < 2; ++ks) q[ks] = *(const bf16x8*)(QK + mrow * LDQ + 1024 + h * 64 + ks * 32 + gk * 8);
    f32x4 o[4];
#pragma unroll
    for (int dt = 0; dt < 4; ++dt) o[dt] = (f32x4){0.f, 0.f, 0.f, 0.f};
#pragma unroll
    for (int dt = 0; dt < 4; ++dt)
#pragma unroll
      for (int ks = 0; ks < 2; ++ks) {
        bf16x8 sf = *(const bf16x8*)(lds + 256 * TS + (dt * 16 + l16) * TS + ks * 32 + gk * 8);
        o[dt] = MFMA(sf, q[ks], o[dt]);
      }
    const float cross = ex2(lg2 * (float)(iq + 1));
#pragma unroll
    for (int dt = 0; dt < 4; ++dt) o[dt] *= cross;
#pragma unroll
    for (int k64 = 0; k64 < 2; ++k64) {
      if (k64 * 64 <= 16 * w + 15) {
        f32x4 s[4];
        qk_tile(lds + k64 * 128 * TS, q, s, l16, gk);
        float pp[4][4];
#pragma unroll
        for (int kt = 0; kt < 4; ++kt)
#pragma unroll
          for (int r = 0; r < 4; ++r) {
            const int j = k64 * 64 + kt * 16 + gk * 4 + r;
            pp[kt][r] = (j <= iq) ? s[kt][r] * 0.125f * ex2(lg2 * (float)(iq - j)) : 0.f;
          }
        pv_tile(lds + k64 * 128 * TS + 64 * TS, pp, o, l16, gk);
      }
    }
    float sm = 0.f;
#pragma unroll
    for (int dt = 0; dt < 4; ++dt) sm += o[dt][0] + o[dt][1] + o[dt][2] + o[dt][3];
    sm += __shfl_xor(sm, 16); sm += __shfl_xor(sm, 32);
    const float mu = sm * (1.f / 64.f);
    float vs = 0.f;
#pragma unroll
    for (int dt = 0; dt < 4; ++dt)
#pragma unroll
      for (int r = 0; r < 4; ++r) { const float d = o[dt][r] - mu; vs += d * d; }
    vs += __shfl_xor(vs, 16); vs += __shfl_xor(vs, 32);
    const float rstd = rsqrtf(vs * (1.f / 64.f) + 1e-5f);
#pragma unroll
    for (int dt = 0; dt < 4; ++dt) {
      const int col = h * 64 + dt * 16 + gk * 4;
      const float4 gg = *(const float4*)(p.e_gn + col);
      const uint2 zz = *(const uint2*)(QK + mrow * LDQ + 2048 + 512 + col);
      const float z0 = bf2f(zz.x & 0xffff), z1 = bf2f(zz.x >> 16), z2 = bf2f(zz.y & 0xffff), z3 = bf2f(zz.y >> 16);
      uint2 ov;
      ov.x = pack2((o[dt][0] - mu) * rstd * gg.x * silu_f(z0), (o[dt][1] - mu) * rstd * gg.y * silu_f(z1));
      ov.y = pack2((o[dt][2] - mu) * rstd * gg.z * silu_f(z2), (o[dt][3] - mu) * rstd * gg.w * silu_f(z3));
      *(uint2*)(Y + mrow * DM + 512 + col) = ov;
    }
  }
}

__device__ __forceinline__ void nsa_tile_interior(const u16* sK, const u16* sV, const bf16x8 (&q)[2], f32x4 (&acc)[4],
                                                  float& m, float& l, float slope2, const float (&sk)[16],
                                                  int t, int pos0, bool lanesel, int lane) {
  const int l16 = lane & 15, gk = lane >> 4;
  const float scale2 = 0.125f * LOG2E;
  f32x4 s[4];
  qk_tile(sK, q, s, l16, gk);
  const float c0 = fmaf(-slope2, (float)(t - pos0 - gk * 4), lanesel ? 0.f : -1e30f);
  float xv[4][4];
  float mx = -1e30f;
#pragma unroll
  for (int kt = 0; kt < 4; ++kt)
#pragma unroll
    for (int r = 0; r < 4; ++r) { xv[kt][r] = fmaf(s[kt][r], scale2, sk[kt * 4 + r]); mx = fmaxf(mx, xv[kt][r]); }
  mx += c0;
  mx = fmaxf(mx, __shfl_xor(mx, 16)); mx = fmaxf(mx, __shfl_xor(mx, 32));
  const float mnew = fmaxf(m, mx);
  const float alpha = ex2(m - mnew);
  m = mnew;
  const float off = c0 - fmaxf(mnew, -1e20f);
  float rs = 0.f;
#pragma unroll
  for (int kt = 0; kt < 4; ++kt)
#pragma unroll
    for (int r = 0; r < 4; ++r) { xv[kt][r] = ex2(xv[kt][r] + off); rs += xv[kt][r]; }
  l = l * alpha + rs;
  if (__any(alpha != 1.f)) {
#pragma unroll
    for (int dt = 0; dt < 4; ++dt) acc[dt] *= alpha;
  }
  pv_tile(sV, xv, acc, l16, gk);
}
template <int BR>
__device__ __forceinline__ void nsa_tile(const u16* sK, const u16* sV, const bf16x8 (&q)[2], f32x4 (&acc)[4],
                                         float& m, float& l, float slope2, float gmul,
                                         int t, int pos0, int pstride, int wl, bool lanesel,
                                         float* imp_row, int jbase, float& carry, int lane, float* imp_scale = nullptr) {
  const int l16 = lane & 15, gk = lane >> 4;
  const float scale2 = 0.125f * LOG2E;
  const unsigned wle = lanesel ? (unsigned)wl : 0u;
  f32x4 s[4];
  qk_tile(sK, q, s, l16, gk);
  float xv[4][4];
  float mx = -1e30f;
#pragma unroll
  for (int kt = 0; kt < 4; ++kt)
#pragma unroll
    for (int r = 0; r < 4; ++r) {
      const int dist = t - (pos0 + (kt * 16 + gk * 4 + r) * pstride);
      const float pen = ((unsigned)dist < wle) ? 0.f : -1e30f;
      const float v = fmaf(s[kt][r], scale2, fmaf(-slope2, (float)dist, pen));
      xv[kt][r] = v; mx = fmaxf(mx, v);
    }
  if (BR != 1) {
    mx = fmaxf(mx, __shfl_xor(mx, 16)); mx = fmaxf(mx, __shfl_xor(mx, 32));
    const float mnew = fmaxf(m, mx);
    const float alpha = ex2(m - mnew);
    m = mnew;
    const float muse = fmaxf(mnew, -1e20f);
    float rs = 0.f;
#pragma unroll
    for (int kt = 0; kt < 4; ++kt)
#pragma unroll
      for (int r = 0; r < 4; ++r) { xv[kt][r] = ex2(xv[kt][r] - muse); rs += xv[kt][r]; }
    l = l * alpha + rs;
    if (BR == 2 || BR == 3) {
#pragma unroll
      for (int dt = 0; dt < 4; ++dt) acc[dt] *= alpha;
    }
    if (BR == 3) {
      float p3[4];
#pragma unroll
      for (int kt = 0; kt < 4; ++kt) {
        p3[kt] = xv[kt][3];
        imp_row[jbase + kt * 4 + gk] = 2.f * (xv[kt][0] + xv[kt][1] + xv[kt][2]) + xv[kt][3];
      }
      const int srcl = (lane + 48) & 63;
      const float carry_s = carry * alpha;
#pragma unroll
      for (int kt = 0; kt < 4; ++kt) {
        const float same = __shfl(p3[kt], srcl);
        const float prev = __shfl(kt > 0 ? p3[kt > 0 ? kt - 1 : 0] : carry_s, srcl);
        imp_row[jbase + kt * 4 + gk] += (gk == 0) ? prev : same;
      }
      carry = p3[3];
      if (gk == 0) *imp_scale = mnew;
    }
    if (BR == 2 || BR == 3) pv_tile(sV, xv, acc, l16, gk);
  } else {
    const float muse = fmaxf(m, -1e20f);
    float p3[4];
#pragma unroll
    for (int kt = 0; kt < 4; ++kt) {
      float pn[4];
#pragma unroll
      for (int r = 0; r < 4; ++r) { pn[r] = ex2(xv[kt][r] - muse) * l; xv[kt][r] = pn[r] * gmul; }
      p3[kt] = pn[3];
      xv[kt][0] = xv[kt][0];
      imp_row[jbase + kt * 4 + gk] = 2.f * (pn[0] + pn[1] + pn[2]) + pn[3];
    }
    const int srcl = (lane + 48) & 63;
#pragma unroll
    for (int kt = 0; kt < 4; ++kt) {
      const float same = __shfl(p3[kt], srcl);
      const float prev = __shfl(kt > 0 ? p3[kt > 0 ? kt - 1 : 0] : carry, srcl);
      imp_row[jbase + kt * 4 + gk] += (gk == 0) ? prev : same;
    }
    carry = p3[3];
    pv_tile(sV, xv, acc, l16, gk);
  }
}

__device__ __forceinline__ void nsa_phase(const Params& p, u16* lds) {
  const u16* U = (const u16*)(p.ws + WS_QK);
  const u16* VT = (const u16*)(p.ws + WS_VT);
  const u16* KC = (const u16*)(p.ws + WS_KCMP);
  const u16* VC = (const u16*)(p.ws + WS_VCMPT);
  const float* GL = (const float*)(p.ws + WS_GL);
  u16* Y = (u16*)(p.ws + WS_Y);
  float* imp = (float*)(lds + 512 * TS);
  uint32_t* umask = (uint32_t*)(imp + 128 * IMPS);
  int* ulist = (int*)(umask + 4);
  const int tid = TIDX, lane = tid & 63, w = tid >> 6, l16 = lane & 15, gk = lane >> 4;
  const int qt = w & 1, hd = w >> 1;
  uint2* totl = (uint2*)imp + 128 + (size_t)w * 256 + lane;
  const int BIG = 1 << 30;
  int* uslot = ulist + 128;
  unsigned* uctr = (unsigned*)(p.ws + WS_KMAX) + 24;
  for (;;) {
    __syncthreads();
    if (tid == 0) uslot[0] = (int)atomicAdd(uctr, 1u);
    __syncthreads();
    const int unit = uslot[0];
    if (unit >= 4096) break;
    const int bg = unit & 15, qh = 255 - (unit >> 4), b = bg >> 2, g = bg & 3;
    const int t0 = qh * 32, qb = t0 >> 6, t = t0 + 16 * qt + l16;
    const size_t mrow = (size_t)b * SEQ + t;
    const int h = g * 4 + hd;
    bf16x8 q[2];
#pragma unroll
    for (int ks = 0; ks < 2; ++ks) q[ks] = *(const bf16x8*)(U + mrow * LDQ + h * 64 + ks * 32 + gk * 8);
    const float slope2 = exp2f(-0.5f * (float)(h + 1)) * LOG2E;
    const float g1 = sigmoid_f(GL[mrow * 48 + h * 3] + p.o_bg[h * 3]);
    float sk[16];
#pragma unroll
    for (int i = 0; i < 16; ++i) sk[i] = slope2 * (float)((i >> 2) * 16 + (i & 3));
    float qn2 = 0.f;
#pragma unroll
    for (int ks = 0; ks < 2; ++ks)
#pragma unroll
      for (int e = 0; e < 8; ++e) { const float v = bf2f((u16)q[ks][e]); qn2 += v * v; }
    qn2 += __shfl_xor(qn2, 16); qn2 += __shfl_xor(qn2, 32);
#pragma unroll
    for (int o2 = 1; o2 <= 8; o2 <<= 1) qn2 = fmaxf(qn2, __shfl_xor(qn2, o2));
    const uint32_t* kmx = (const uint32_t*)(p.ws + WS_KMAX);
    const float sc2 = 0.125f * LOG2E;
    const float T_slc = 2.02f * sc2 * sqrtf(qn2 * __uint_as_float(kmx[8 + g])) + 48.f;
    const float T_win = 2.02f * sc2 * sqrtf(qn2 * __uint_as_float(kmx[12 + g])) + 48.f;
    const float T_cmp = 2.05f * sc2 * sqrtf(qn2 * __uint_as_float(kmx[16 + g])) + 16.f * slope2 + 48.f;
    const int tq0w = t0 + 16 * qt;
    f32x4 acc[4];
    float m = -1e30f, l = 0.f;
#pragma unroll
    for (int dt = 0; dt < 4; ++dt) acc[dt] = (f32x4){0.f, 0.f, 0.f, 0.f};
    __syncthreads();
    for (int i = tid; i < 128 * IMPS; i += NTHR) imp[i] = 0.f;
    if (tid < 4) umask[tid] = 0u;
    float* imp_row = imp + (hd * 32 + 16 * qt + l16) * IMPS;
    float carry = 0.f;
    uint4 rk0, rk1, rk2, rk3, rv0, rv1, rv2, rv3;
    u16* impbase_unused = nullptr; (void)impbase_unused;
#define SLOT(k) (lds + (k) * (128 * TS))
#define LD1(k, kp, ks_, vp, vs_) { rk##k = *(const uint4*)((kp) + (long)(tid >> 3) * (ks_) + (tid & 7) * 8); rv##k = *(const uint4*)((vp) + (long)(tid >> 3) * (vs_) + (tid & 7) * 8); }
#define ST1(k) { *(uint4*)(SLOT(k) + (tid >> 3) * TS + (tid & 7) * 8) = rk##k; TILE_STV_(SLOT(k) + 64 * TS, rv##k) }
    const int ntc = ((t0 >> 4) >> 6) + 1;
    const u16* kcs = KC + (size_t)bg * 512 * 64;
    const u16* vcs = VC + (size_t)bg * 32768;
#define CMP_LD(k, i) if ((i) < ntc) LD1(k, kcs + (size_t)(i) * 64 * 64, 64, vcs + (i) * 64, 512)
    float* mrec = (float*)(uslot + 4) + (w * 16 + l16) * 8;
    {
      const int ngrp = (ntc + 3) >> 2;
      CMP_LD(0, 0) CMP_LD(1, 1) CMP_LD(2, 2) CMP_LD(3, 3)
#pragma unroll 1
      for (int gi = 0; gi < ngrp; ++gi) {
        const int ib = gi * 4;
        __syncthreads();
        if (ib < ntc) ST1(0) if (ib + 1 < ntc) ST1(1) if (ib + 2 < ntc) ST1(2) if (ib + 3 < ntc) ST1(3)
        __syncthreads();
        if (gi + 1 < ngrp) { CMP_LD(0, ib + 4) CMP_LD(1, ib + 5) CMP_LD(2, ib + 6) CMP_LD(3, ib + 7) }
#pragma unroll 1
        for (int k = 0; k < 4; ++k) {
          const int i = ib + k;
          if (i < ntc) {
            const int dmin = tq0w - (16 * (64 * i + 63) + 31);
            if (dmin > 0 && slope2 * (float)dmin > T_cmp) { carry = 0.f; if (gk == 0) mrec[i] = -1e30f; continue; }
            nsa_tile<3>(SLOT(k), SLOT(k) + 64 * TS, q, acc, m, l, slope2, g1, t, 16 * (64 * i) + 31, 16, BIG, true, imp_row, 16 * i, carry, lane, mrec + i);
          }
        }
      }
      float lt = l; lt += __shfl_xor(lt, 16); lt += __shfl_xor(lt, 32);
      const float inv = lt > 0.f ? 1.f / lt : 0.f;
      const float mfin = fmaxf(m, -1e20f);
#pragma unroll 1
      for (int i = 0; i < ntc; ++i) {
        const float f = ex2(fmaxf(mrec[i], -1e20f) - mfin) * inv;
#pragma unroll
        for (int kt = 0; kt < 4; ++kt) imp_row[16 * i + kt * 4 + gk] *= f;
      }
      const float og = g1 * inv;
#pragma unroll
      for (int dt = 0; dt < 4; ++dt) acc[dt] *= og;
    }
    __syncthreads();
    {
      const int qi = w * 4 + gk;
      const int c8 = l16 * 8;
      uint32_t selb = 0u;
      if (qb < 16) {
#pragma unroll
        for (int i = 0; i < 8; ++i) if (c8 + i <= qb) selb |= (1u << i);
      } else {
        float val[8];
        const float* ra = imp + qi * IMPS + c8;
#pragma unroll
        for (int i4 = 0; i4 < 2; ++i4) {
          const float4 v0 = *(const float4*)(ra + 4 * i4);
          const float4 v1 = *(const float4*)(ra + 32 * IMPS + 4 * i4);
          const float4 v2 = *(const float4*)(ra + 64 * IMPS + 4 * i4);
          const float4 v3 = *(const float4*)(ra + 96 * IMPS + 4 * i4);
          val[4 * i4] = ((v0.x + v1.x) + v2.x) + v3.x; val[4 * i4 + 1] = ((v0.y + v1.y) + v2.y) + v3.y;
          val[4 * i4 + 2] = ((v0.z + v1.z) + v2.z) + v3.z; val[4 * i4 + 3] = ((v0.w + v1.w) + v2.w) + v3.w;
        }
#pragma unroll
        for (int i = 0; i < 8; ++i) {
          const int j = c8 + i;
          const bool forced = (j == 0) || (j == qb) || (j == qb - 1);
          if (forced) selb |= (1u << i);
          if (forced || j > qb) val[i] = -1.f;
        }
#pragma unroll 1
        for (int it = 0; it < 13; ++it) {
          float best = -2.f; int bj = 0;
#pragma unroll
          for (int i = 0; i < 8; ++i) {
            const float v = ((selb >> i) & 1u) ? -1.f : val[i];
            if (v > best) { best = v; bj = c8 + i; }
          }
#pragma unroll
          for (int o = 1; o <= 8; o <<= 1) {
            const float ov = __shfl_xor(best, o); const int oj = __shfl_xor(bj, o);
            if (ov > best || (ov == best && oj < bj)) { best = ov; bj = oj; }
          }
          if ((bj >> 3) == l16) selb |= (1u << (bj & 7));
        }
      }
      uint32_t wd = selb << ((l16 & 3) * 8);
      wd |= __shfl_xor(wd, 1); wd |= __shfl_xor(wd, 2);
      __syncthreads();
      uint32_t* selw = (uint32_t*)imp;
      if ((l16 & 3) == 0) selw[qi * 4 + (l16 >> 2)] = wd;
      uint32_t uq = wd; uq |= __shfl_xor(uq, 16); uq |= __shfl_xor(uq, 32);
      if (gk == 0 && (l16 & 3) == 0) atomicOr(&umask[l16 >> 2], uq);
    }
    __syncthreads();
    const uint32_t* selq = (const uint32_t*)imp + (16 * qt + l16) * 4;
    const uint32_t sel0 = selq[0], sel1 = selq[1], sel2 = selq[2], sel3 = selq[3];
    uint32_t wun0 = sel0, wun1 = sel1, wun2 = sel2, wun3 = sel3;
#pragma unroll
    for (int o = 1; o <= 8; o <<= 1) { wun0 |= __shfl_xor(wun0, o); wun1 |= __shfl_xor(wun1, o); wun2 |= __shfl_xor(wun2, o); wun3 |= __shfl_xor(wun3, o); }
    int nsl = 0;
    {
      const uint32_t u0 = umask[0], u1 = umask[1], u2 = umask[2], u3 = umask[3];
      nsl = __popc(u0) + __popc(u1) + __popc(u2) + __popc(u3);
      if (tid < 128) {
        const uint32_t uw = tid < 32 ? u0 : tid < 64 ? u1 : tid < 96 ? u2 : u3;
        if ((uw >> (tid & 31)) & 1u) {
          int pos = __popc(uw & ((1u << (tid & 31)) - 1u));
          if (tid >= 32) pos += __popc(u0);
          if (tid >= 64) pos += __popc(u1);
          if (tid >= 96) pos += __popc(u2);
          ulist[pos] = tid;
        }
      }
    }
    __syncthreads();
#pragma unroll
    for (int dt = 0; dt < 4; ++dt) {
      uint2 o2; o2.x = pack2(acc[dt][0], acc[dt][1]); o2.y = pack2(acc[dt][2], acc[dt][3]);
      totl[dt * 64] = o2;
    }
#pragma unroll 1
    for (int br = 1; br < 3; ++br) {
      m = -1e30f; l = 0.f;
#pragma unroll
      for (int dt = 0; dt < 4; ++dt) acc[dt] = (f32x4){0.f, 0.f, 0.f, 0.f};
      int wfirst = ((t0 - 511) >> 6) << 6; if (wfirst < 0) wfirst = 0;
      const int nt = (br == 1) ? nsl : ((qb * 64 - wfirst) >> 6) + 1;
      const int ngrp = (nt + 3) >> 2;
      const u16* kb = U + (size_t)b * SEQ * LDQ + (br == 1 ? 1536 : 1792) + g * 64;
      const u16* vb = VT + (size_t)((br == 1 ? 0 : 256) + g * 64) * MTOK + (size_t)b * SEQ;
#define SRC_S0(i) ((br == 1) ? ulist[nt - 1 - (i)] * 64 : wfirst + 64 * (nt - 1 - (i)))
#define BR_LD(k, i) if ((i) < nt) { const int s_ = SRC_S0(i); LD1(k, kb + (size_t)s_ * LDQ, LDQ, vb + s_, MTOK) }
      BR_LD(0, 0) BR_LD(1, 1) BR_LD(2, 2) BR_LD(3, 3)
#pragma unroll 1
      for (int gi = 0; gi < ngrp; ++gi) {
        const int ib = gi * 4;
        __syncthreads();
        if (ib < nt) ST1(0) if (ib + 1 < nt) ST1(1) if (ib + 2 < nt) ST1(2) if (ib + 3 < nt) ST1(3)
        __syncthreads();
        if (gi + 1 < ngrp) { BR_LD(0, ib + 4) BR_LD(1, ib + 5) BR_LD(2, ib + 6) BR_LD(3, ib + 7) }
#pragma unroll 1
        for (int k = 0; k < 4; ++k) {
          const int i = ib + k;
          if (i < nt) {
            const int s0 = SRC_S0(i);
            bool wsel = true, ls = true;
            int wl = 512;
            if (br == 1) {
              const int j = s0 >> 6, jw = j >> 5, jb = j & 31;
              const uint32_t ww = jw == 0 ? wun0 : jw == 1 ? wun1 : jw == 2 ? wun2 : wun3;
              const uint32_t sw = jw == 0 ? sel0 : jw == 1 ? sel1 : jw == 2 ? sel2 : sel3;
              wsel = (ww >> jb) & 1u; ls = (sw >> jb) & 1u; wl = BIG;
            }
            if (wsel) {
              const int dminw = tq0w - (s0 + 63);
              if (dminw > 0 && slope2 * (float)dminw > (br == 1 ? T_slc : T_win)) wsel = false;
            }
            if (wsel) {
              const int tq0 = t0 + 16 * qt;
              const bool interior = (s0 + 63 <= tq0) && (br == 1 || s0 + 512 > tq0 + 15);
              if (interior) nsa_tile_interior(SLOT(k), SLOT(k) + 64 * TS, q, acc, m, l, slope2, sk, t, s0, ls, lane);
              else nsa_tile<2>(SLOT(k), SLOT(k) + 64 * TS, q, acc, m, l, slope2, g1, t, s0, 1, wl, ls, imp_row, 0, carry, lane);
            }
          }
        }
      }
      {
        float lt = l; lt += __shfl_xor(lt, 16); lt += __shfl_xor(lt, 32);
        const float gt = sigmoid_f(GL[mrow * 48 + h * 3 + br] + p.o_bg[h * 3 + br]);
        const float sc = lt > 0.f ? gt / lt : 0.f;
#pragma unroll
        for (int dt = 0; dt < 4; ++dt) {
          const uint2 pv = totl[dt * 64];
          const float r0 = bf2f(pv.x & 0xffff) + acc[dt][0] * sc, r1 = bf2f(pv.x >> 16) + acc[dt][1] * sc;
          const float r2 = bf2f(pv.y & 0xffff) + acc[dt][2] * sc, r3 = bf2f(pv.y >> 16) + acc[dt][3] * sc;
          if (br == 1) {
            uint2 o2; o2.x = pack2(r0, r1); o2.y = pack2(r2, r3);
            totl[dt * 64] = o2;
          } else {
            const int col = h * 64 + dt * 16 + gk * 4;
            const uint2 zz = *(const uint2*)(U + mrow * LDQ + 2048 + col);
            const float z0 = bf2f(zz.x & 0xffff), z1 = bf2f(zz.x >> 16), z2 = bf2f(zz.y & 0xffff), z3 = bf2f(zz.y >> 16);
            uint2 ov;
            ov.x = pack2(r0 * silu_f(z0), r1 * silu_f(z1));
            ov.y = pack2(r2 * silu_f(z2), r3 * silu_f(z3));
            *(uint2*)(Y + mrow * DM + col) = ov;
          }
        }
      }
    }
#undef SLOT
#undef LD1
#undef ST1
#undef CMP_LD
#undef SRC_S0
#undef BR_LD
  }
}

__device__ __forceinline__ void final_norm(const Params& p) {
  const int lane = TIDX & 63, wave = TIDX >> 6;
  for (int row = BIDX * NWAVE + wave; row < MTOK; row += gridDim.x * NWAVE) {
    float4* xr = (float4*)(p.out + (size_t)row * DM);
    float4 v[4];
    float ss = 0.f;
#pragma unroll
    for (int i = 0; i < 4; ++i) {
      v[i] = xr[lane + 64 * i];
      ss += v[i].x * v[i].x + v[i].y * v[i].y + v[i].z * v[i].z + v[i].w * v[i].w;
    }
#pragma unroll
    for (int o = 32; o >= 1; o >>= 1) ss += __shfl_xor(ss, o);
    const float rstd = rsqrtf(ss * (1.f / DM) + 1e-6f);
#pragma unroll
    for (int i = 0; i < 4; ++i) {
      const float4 gg = ((const float4*)p.fin_g)[lane + 64 * i];
      xr[lane + 64 * i] = (float4){v[i].x * rstd * gg.x, v[i].y * rstd * gg.y, v[i].z * rstd * gg.z, v[i].w * rstd * gg.w};
    }
  }
}

__device__ __forceinline__ void grid_bar(const Params& p, unsigned& target) {
  __syncthreads();
  target += gridDim.x;
  if (TIDX == 0) {
    unsigned* ctr = (unsigned*)(p.ws + WS_BAR);
    __threadfence();
    __hip_atomic_fetch_add(ctr, 1u, __ATOMIC_RELAXED, __HIP_MEMORY_SCOPE_AGENT);
    while (__hip_atomic_load(ctr, __ATOMIC_RELAXED, __HIP_MEMORY_SCOPE_AGENT) < target) __builtin_amdgcn_s_sleep(1);
    __threadfence();
  }
  __syncthreads();
}

__device__ __forceinline__ void nsa_knorm(const Params& p) {
  if (BIDX < 64) return;
  const u16* U = (const u16*)(p.ws + WS_QK);
  uint32_t* km = (uint32_t*)(p.ws + WS_KMAX);
  const int tid = TIDX, lane = tid & 63, wave = tid >> 6;
  float mx = 0.f;
  for (int row = (BIDX - 64) * NWAVE + wave; row < MTOK; row += (gridDim.x - 64) * NWAVE) {
    const uint4 v = *(const uint4*)(U + (size_t)row * LDQ + 1536 + lane * 8);
    const float a0 = bf2f(v.x & 0xffff), a1 = bf2f(v.x >> 16), a2 = bf2f(v.y & 0xffff), a3 = bf2f(v.y >> 16);
    const float a4 = bf2f(v.z & 0xffff), a5 = bf2f(v.z >> 16), a6 = bf2f(v.w & 0xffff), a7 = bf2f(v.w >> 16);
    float ss = a0 * a0 + a1 * a1 + a2 * a2 + a3 * a3 + a4 * a4 + a5 * a5 + a6 * a6 + a7 * a7;
    ss += __shfl_xor(ss, 1); ss += __shfl_xor(ss, 2); ss += __shfl_xor(ss, 4);
    mx = fmaxf(mx, ss);
  }
  if ((lane & 7) == 0) atomicMax(&km[8 + (lane >> 3)], __float_as_uint(mx));
}

__global__ void __launch_bounds__(NTHR, 2) mega(Params p_in) {
  Params p = p_in;
  p.pad = __builtin_amdgcn_readfirstlane((int)threadIdx.x >> 6);
  unsigned bar_target = 0u;
  extern __shared__ __attribute__((aligned(16))) unsigned char lds_raw[];
  u16* lds = (u16*)lds_raw;
  cg::grid_group grid = cg::this_grid();
  if (p_in.coop == 2) grid.sync();
#define PH_ON(k) (p.ph_lo <= (k) && (k) <= p.ph_hi)
#define PH_SYNC(k) if (p.coop && p.ph_lo <= (k) && (k) < p.ph_hi) grid_bar(p, bar_target);
  if (PH_ON(0)) {
    rms_rows(p, p.x, p.e_ng, (u16*)(p.ws + WS_HBF));
    conv_t(p, (u16*)(p.ws + WS_WT0), p.e_win, 1024, 4104, 4352, 0);
    conv_t(p, (u16*)(p.ws + WS_WT1), p.o_win, 1024, 3632, 3840, 1);
    conv_t(p, (u16*)(p.ws + WS_WO0), p.e_wout, 1024, 1024, 1024, 2);
    conv_t(p, (u16*)(p.ws + WS_WO1), p.o_wout, 1024, 1024, 1024, 2);
    conv_t(p, (u16*)(p.ws + WS_W1K), p.o_wk1, 2048, 256, 256, 2);
    conv_t(p, (u16*)(p.ws + WS_W1V), p.o_wv1, 2048, 256, 256, 2);
    conv_t(p, (u16*)(p.ws + WS_W2K), p.o_wk2, 256, 64, 256, 2);
    conv_t(p, (u16*)(p.ws + WS_W2V), p.o_wv2, 256, 64, 256, 2);
    pe_partial(p);
    if (BIDX == 0 && TIDX < 32) ((uint32_t*)(p.ws + WS_KMAX))[TIDX] = 0u;
    for (int i = BIDX * NTHR + TIDX; i < MTOK; i += gridDim.x * NTHR) ((float*)(p.ws + WS_SSQ))[i] = 0.f;
  }
  PH_SYNC(0)
  if (PH_ON(1)) gemm_inproj(p, 0, lds);
  PH_SYNC(1)
  if (PH_ON(2)) {
    fox_scan(p, (float*)lds); ret_stepA(p); fox_knorm(p);
    if (BIDX == gridDim.x - 1) {
      for (int i = TIDX; i < 512; i += NTHR) {
        const float* part = (const float*)(p.ws + WS_PEP);
        float sum = 0.f;
        for (int kc = 0; kc < 16; ++kc) sum += part[((i >> 8) * 16 + kc) * 256 + (i & 255)];
        ((float*)(p.ws + WS_PEB))[i] = sum;
      }
    }
  }
  PH_SYNC(2)
  if (PH_ON(3)) { ret_stepB(p); fox_phase(p, lds); }
  PH_SYNC(3)
  if (PH_ON(4)) ret_stepC(p, lds);
  PH_SYNC(4)
  if (PH_ON(5)) gemm_outproj(p, 0, lds);
  PH_SYNC(5)
  if (PH_ON(7)) gemm_inproj(p, 1, lds);
  PH_SYNC(7)
  if (PH_ON(8)) { gemm_cmp1(p, lds); nsa_knorm(p); }
  PH_SYNC(8)
  if (PH_ON(10)) nsa_phase(p, lds);
  PH_SYNC(10)
  if (PH_ON(11)) gemm_outproj(p, 1, lds);
  PH_SYNC(11)
  if (PH_ON(12)) final_norm(p);
}

extern "C" void kernel_launch(void* const* d_in, const int* in_sizes, int n_in, void* d_out, int out_size, void* d_ws,
                              size_t ws_size, hipStream_t stream) {
  static int grid_blocks = 0;
  if (!grid_blocks) {
    int dev = 0, cus = 0, per_cu = 0;
    hipGetDevice(&dev);
    hipDeviceGetAttribute(&cus, hipDeviceAttributeMultiprocessorCount, dev);
    hipFuncSetAttribute((const void*)mega, hipFuncAttributeMaxDynamicSharedMemorySize, LDS_BYTES);
    hipOccupancyMaxActiveBlocksPerMultiprocessor(&per_cu, (const void*)mega, NTHR, LDS_BYTES);
    if (per_cu < 1) per_cu = 1;
    if (per_cu > 1) per_cu = 1;
    grid_blocks = cus * per_cu;
    (void)hipGetLastError();
  }
  Params p{};
  p.x = (const float*)d_in[0]; p.e_ng = (const float*)d_in[1]; p.e_win = (const float*)d_in[2];
  p.e_bf = (const float*)d_in[3]; p.e_gn = (const float*)d_in[4]; p.e_wout = (const float*)d_in[5];
  p.o_ng = (const float*)d_in[6]; p.o_win = (const float*)d_in[7]; p.o_bg = (const float*)d_in[8];
  p.o_pek = (const float*)d_in[9]; p.o_pev = (const float*)d_in[10]; p.o_wk1 = (const float*)d_in[11];
  p.o_wk2 = (const float*)d_in[12]; p.o_wv1 = (const float*)d_in[13]; p.o_wv2 = (const float*)d_in[14];
  p.o_wout = (const float*)d_in[15]; p.fin_g = (const float*)d_in[16];
  p.out = (float*)d_out; p.ws = (unsigned char*)d_ws;
#if ONE_LAUNCH
  p.ph_lo = 0; p.ph_hi = NPHASE - 1; p.coop = 1;
  (void)hipMemsetAsync((unsigned char*)d_ws + WS_BAR, 0, 64, stream);
  void* args[] = {&p};
  hipError_t e = hipLaunchCooperativeKernel((const void*)mega, dim3(grid_blocks), dim3(NTHR), args, LDS_BYTES, stream);
  if (e != hipSuccess) fprintf(stderr, "cooperative launch failed: %s (grid %d)\n", hipGetErrorString(e), grid_blocks);
#else
  for (int ph = 0; ph < NPHASE; ++ph) {
    p.ph_lo = ph; p.ph_hi = ph; p.coop = 0;
    hipLaunchKernelGGL(mega, dim3(grid_blocks), dim3(NTHR), LDS_BYTES, stream, p);
  }
#endif
}
```

```cpp
#include <hip/hip_runtime.h>
#include <hip/hip_cooperative_groups.h>
#include <stdint.h>
#include <stdio.h>
namespace cg = cooperative_groups;

typedef unsigned short u16;
typedef short bf16x8 __attribute__((ext_vector_type(8)));
typedef short bf16x4 __attribute__((ext_vector_type(4)));
typedef float f32x4 __attribute__((ext_vector_type(4)));

#ifndef ONE_LAUNCH
#define ONE_LAUNCH 1
#endif

#define MTOK 32768
#define SEQ 8192
#define DM 1024
#define LDQ 3072
#define LOG2E 1.4426950408889634f
#define TS 72
#define IMPS 132
#define LDS_BYTES 147456
#define NTHR 512
#define NWAVE 8
#define NPHASE 13

#define MiB (1024ull * 1024ull)
#define WS_HBF   (0ull)
#define WS_DS    (0ull)
#define WS_ST    (32ull * MiB)
#define WS_QK    (64ull * MiB)
#define WS_VT    (256ull * MiB)
#define WS_Y     (352ull * MiB)
#define WS_WT0   (416ull * MiB)
#define WS_WT1   (WS_WT0 + 4352ull * 1024 * 2)
#define WS_WO0   (WS_WT1 + 3840ull * 1024 * 2)
#define WS_WO1   (WS_WO0 + 1024ull * 1024 * 2)
#define WS_W1K   (WS_WO1 + 1024ull * 1024 * 2)
#define WS_W1V   (WS_W1K + 256ull * 2048 * 2)
#define WS_W2K   (WS_W1V + 256ull * 2048 * 2)
#define WS_W2V   (WS_W2K + 256ull * 256 * 2)
#define WS_FLOG  (440ull * MiB)
#define WS_CFOX  (441ull * MiB)
#define WS_GL    (442ull * MiB)
#define WS_HC    (448ull * MiB)
#define WS_KCMP  (456ull * MiB)
#define WS_VCMPT (457ull * MiB)
#define WS_PEP   (458ull * MiB)
#define WS_PEB   (WS_PEP + 65536ull)
#define WS_KMAX  (WS_PEB + 4096ull)
#define WS_SSQ   (459ull * MiB)
#define WS_BAR   (WS_KMAX + 4096ull)

struct Params {
  const float *x, *e_ng, *e_win, *e_bf, *e_gn, *e_wout;
  const float *o_ng, *o_win, *o_bg, *o_pek, *o_pev, *o_wk1, *o_wk2, *o_wv1, *o_wv2, *o_wout, *fin_g;
  float* out;
  unsigned char* ws;
  int ph_lo, ph_hi, coop, pad;
};

typedef __bf16 bf16v2 __attribute__((ext_vector_type(2)));
typedef float f32v2 __attribute__((ext_vector_type(2)));
__device__ __forceinline__ uint32_t pack2(float a, float b) {
  f32v2 v = {a, b};
  bf16v2 r = __builtin_convertvector(v, bf16v2);
  return *(uint32_t*)&r;
}
__device__ __forceinline__ u16 f2bf(float f) { return (u16)(pack2(f, 0.f) & 0xffffu); }
__device__ __forceinline__ float bf2f(u16 h) { return __uint_as_float(((uint32_t)h) << 16); }
__device__ __forceinline__ float ex2(float x) { return __builtin_amdgcn_exp2f(x); }
__device__ __forceinline__ float silu_f(float z) { return z * __builtin_amdgcn_rcpf(1.f + ex2(-z * LOG2E)); }
__device__ __forceinline__ float sigmoid_f(float z) { return __builtin_amdgcn_rcpf(1.f + ex2(-z * LOG2E)); }

__device__ __forceinline__ int opq(int v) { asm volatile("" : "+v"(v)); return v; }
__device__ __forceinline__ int opqs(int v) { asm volatile("" : "+s"(v)); return v; }
#define TIDX opq(p.pad * 64 + (int)__lane_id())
#define BIDX opqs((int)blockIdx.x)
#define MFMA(a, b, c) __builtin_amdgcn_mfma_f32_16x16x32_bf16((a), (b), (c), 0, 0, 0)

__device__ __forceinline__ void rms_rows(const Params& p, const float* __restrict__ x, const float* __restrict__ g, u16* __restrict__ h) {
  const int lane = TIDX & 63, wave = TIDX >> 6;
  for (int row = BIDX * NWAVE + wave; row < MTOK; row += gridDim.x * NWAVE) {
    const float4* xr = (const float4*)(x + (size_t)row * DM);
    float4 v[4];
    float ss = 0.f;
#pragma unroll
    for (int i = 0; i < 4; ++i) {
      v[i] = xr[lane + 64 * i];
      ss += v[i].x * v[i].x + v[i].y * v[i].y + v[i].z * v[i].z + v[i].w * v[i].w;
    }
#pragma unroll
    for (int o = 32; o >= 1; o >>= 1) ss += __shfl_xor(ss, o);
    const float rstd = rsqrtf(ss * (1.f / DM) + 1e-6f);
#pragma unroll
    for (int i = 0; i < 4; ++i) {
      float4 gg = ((const float4*)g)[lane + 64 * i];
      uint2 o;
      o.x = pack2(v[i].x * rstd * gg.x, v[i].y * rstd * gg.y);
      o.y = pack2(v[i].z * rstd * gg.z, v[i].w * rstd * gg.w);
      *(uint2*)(h + (size_t)row * DM + (lane + 64 * i) * 4) = o;
    }
  }
}

__device__ __forceinline__ void rms_rows_fl(const Params& p, float* ldsf) {
  const float* __restrict__ x = p.x; const float* __restrict__ g = p.e_ng;
  u16* __restrict__ h = (u16*)(p.ws + WS_HBF);
  float* __restrict__ fl = (float*)(p.ws + WS_FLOG);
  const int tid = TIDX, lane = tid & 63, wave = tid >> 6;
  for (int i = tid; i < 8 * DM; i += NTHR) { const int j = i >> 10, k = i & 1023; ldsf[i] = g[k] * p.e_win[(size_t)k * 4104 + 1536 + j]; }
  __syncthreads();
  for (int row = BIDX * NWAVE + wave; row < MTOK; row += gridDim.x * NWAVE) {
    const float4* xr = (const float4*)(x + (size_t)row * DM);
    float4 v[4];
    float ss = 0.f;
#pragma unroll
    for (int i = 0; i < 4; ++i) {
      v[i] = xr[lane + 64 * i];
      ss += v[i].x * v[i].x + v[i].y * v[i].y + v[i].z * v[i].z + v[i].w * v[i].w;
    }
#pragma unroll
    for (int o = 32; o >= 1; o >>= 1) ss += __shfl_xor(ss, o);
    const float rstd = rsqrtf(ss * (1.f / DM) + 1e-6f);
#pragma unroll
    for (int i = 0; i < 4; ++i) {
      float4 gg = ((const float4*)g)[lane + 64 * i];
      uint2 o;
      o.x = pack2(v[i].x * rstd * gg.x, v[i].y * rstd * gg.y);
      o.y = pack2(v[i].z * rstd * gg.z, v[i].w * rstd * gg.w);
      *(uint2*)(h + (size_t)row * DM + (lane + 64 * i) * 4) = o;
    }
    float myf = 0.f;
#pragma unroll
    for (int j = 0; j < 8; ++j) {
      float d = 0.f;
#pragma unroll
      for (int i = 0; i < 4; ++i) {
        const float4 w4 = *(const float4*)(ldsf + j * DM + (lane + 64 * i) * 4);
        d += v[i].x * w4.x + v[i].y * w4.y + v[i].z * w4.z + v[i].w * w4.w;
      }
#pragma unroll
      for (int o = 32; o >= 1; o >>= 1) d += __shfl_xor(d, o);
      if (lane == j) myf = d * rstd;
    }
    if (lane < 8) fl[(size_t)row * 8 + lane] = myf;
  }
}

__device__ __forceinline__ int map_col(int MAP, int n) {
  if (MAP == 0) {
    if (n < 1024) return n;
    if (n < 2048) return n + 520;
    if (n < 3072) return n + 1032;
    if (n < 3584) return n - 2048;
    if (n < 4096) return n - 1016;
    if (n < 4104) return n - 2560;
    return -1;
  } else if (MAP == 1) {
    if (n < 1792) return n;
    if (n < 2048) return n + 256;
    if (n < 3072) return n + 560;
    if (n < 3328) return n - 1280;
    if (n < 3584) return n - 1024;
    if (n < 3632) return n - 1024;
    return -1;
  } else if (MAP == 2) {
    return n;
  }
  return n;
}

__device__ __forceinline__ void conv_t(const Params& p, u16* __restrict__ dst, const float* __restrict__ src, int K, int nsrc, int ndst, int MAP) {
  const int total = ndst * (K >> 3);
  for (int id = BIDX * NTHR + TIDX; id < total; id += gridDim.x * NTHR) {
    const int n = id % ndst, kc = id / ndst;
    const int sc = map_col(MAP, n);
    float v[8];
#pragma unroll
    for (int i = 0; i < 8; ++i) v[i] = (sc >= 0 && sc < nsrc) ? src[(size_t)(kc * 8 + i) * nsrc + sc] : 0.f;
    uint4 o;
    o.x = pack2(v[0], v[1]); o.y = pack2(v[2], v[3]); o.z = pack2(v[4], v[5]); o.w = pack2(v[6], v[7]);
    *(uint4*)(dst + (size_t)n * K + kc * 8) = o;
  }
}

__device__ __forceinline__ void pe_partial(const Params& p) {
  float* part = (float*)(p.ws + WS_PEP);
  for (int task = BIDX; task < 32; task += gridDim.x) {
    const int kv = task >> 4, kc = task & 15, n = TIDX;
    if (n >= 256) continue;
    const float* pe = kv ? p.o_pev : p.o_pek;
    const float* w1 = kv ? p.o_wv1 : p.o_wk1;
    float acc = 0.f;
#pragma unroll 16
    for (int k = kc * 128; k < kc * 128 + 128; ++k) acc += pe[k] * w1[(size_t)k * 256 + n];
    part[(kv * 16 + kc) * 256 + n] = acc;
  }
}

#define GST (512 * TS)
template <bool swapped>
__device__ __forceinline__ void gemm_compute(const u16* cur, f32x4 (&acc)[8][4], int wpa, int wpb, int l16, int gk) {
  const u16* sA = cur + (wpa * 128 + l16) * TS + gk * 8;
  const u16* sB = cur + (256 + wpb * 64 + l16) * TS + gk * 8;
#pragma unroll 1
  for (int kk = 0; kk < 2; ++kk) {
    bf16x8 fa[8], fb[4];
#pragma unroll
    for (int i = 0; i < 8; ++i) fa[i] = *(const bf16x8*)(sA + i * 16 * TS + kk * 32);
#pragma unroll
    for (int j = 0; j < 4; ++j) fb[j] = *(const bf16x8*)(sB + j * 16 * TS + kk * 32);
    if (swapped) {
#pragma unroll
      for (int i = 0; i < 8; ++i)
#pragma unroll
        for (int j = 0; j < 4; ++j) acc[i][j] = MFMA(fb[j], fa[i], acc[i][j]);
    } else {
#pragma unroll
      for (int i = 0; i < 8; ++i)
#pragma unroll
        for (int j = 0; j < 4; ++j) acc[i][j] = MFMA(fa[i], fb[j], acc[i][j]);
    }
  }
}
template <bool swapped>
__device__ __forceinline__ void gemm_mainloop(const Params& p, const u16* __restrict__ Ab, const uint32_t (&pa)[4], const u16* __restrict__ Bb,
                                              const uint32_t (&pb)[4], int a_kstride, int nk,
                                              u16* lds, f32x4 (&acc)[8][4]) {
  const int tid = TIDX, lane = tid & 63, wave = tid >> 6;
  const int l16 = lane & 15, gk = lane >> 4;
  const int wpa = wave >> 2, wpb = wave & 3;
  const int woff = (tid >> 3) * TS + (tid & 7) * 8;
  uint4 ra0, ra1, ra2, ra3, rb0, rb1, rb2, rb3;
#define G_LD(kidx) { const u16* Ap_ = Ab + (size_t)(kidx) * a_kstride; const u16* Bp_ = Bb + (size_t)(kidx) * 64;   \
    ra0 = *(const uint4*)(Ap_ + pa[0]); ra1 = *(const uint4*)(Ap_ + pa[1]); ra2 = *(const uint4*)(Ap_ + pa[2]); ra3 = *(const uint4*)(Ap_ + pa[3]); \
    rb0 = *(const uint4*)(Bp_ + pb[0]); rb1 = *(const uint4*)(Bp_ + pb[1]); rb2 = *(const uint4*)(Bp_ + pb[2]); rb3 = *(const uint4*)(Bp_ + pb[3]); }
#define G_ST(D) { u16* D_ = (D) + woff;                                                                               \
    *(uint4*)(D_) = ra0; *(uint4*)(D_ + 64 * TS) = ra1; *(uint4*)(D_ + 128 * TS) = ra2; *(uint4*)(D_ + 192 * TS) = ra3;  \
    *(uint4*)(D_ + 256 * TS) = rb0; *(uint4*)(D_ + 320 * TS) = rb1; *(uint4*)(D_ + 384 * TS) = rb2; *(uint4*)(D_ + 448 * TS) = rb3; }
  G_LD(0)
  __syncthreads();
  G_ST(lds)
  __syncthreads();
#pragma unroll
  for (int i = 0; i < 8; ++i)
#pragma unroll
    for (int j = 0; j < 4; ++j) acc[i][j] = (f32x4){0.f, 0.f, 0.f, 0.f};
#pragma unroll 1
  for (int ks = 0; ks < nk; ++ks) {
    const bool more = (ks + 1 < nk);
    if (more) G_LD(ks + 1)
    gemm_compute<swapped>(lds + (ks & 1) * GST, acc, wpa, wpb, l16, gk);
    if (more) G_ST(lds + ((ks + 1) & 1) * GST)
    __syncthreads();
  }
#undef G_LD
#undef G_ST
}
#define GEMM_OFFS(rowstrideA, rowstrideB)                                   \
  uint32_t pa[4], pb[4];                                                    \
  _Pragma("unroll") for (int i = 0; i < 4; ++i) {                           \
    pa[i] = (uint32_t)((tid >> 3) + 64 * i) * (rowstrideA) + (tid & 7) * 8; \
    pb[i] = (uint32_t)((tid >> 3) + 64 * i) * (rowstrideB) + (tid & 7) * 8; \
  }

__device__ __forceinline__ void gemm_inproj(const Params& p, int layer, u16* lds, int part) {
  const u16* A = (const u16*)(p.ws + WS_HBF);
  const u16* Bt = (const u16*)(p.ws + (layer ? WS_WT1 : WS_WT0));
  u16* QK = (u16*)(p.ws + WS_QK);
  u16* VT = (u16*)(p.ws + WS_VT);
  float* F = (float*)(p.ws + (layer ? WS_GL : WS_FLOG));
  const int NT = layer ? 14 : 16;
  const int seg_trans_end = layer ? 28 : 32;
  const int nvalidF = layer ? 48 : 8, ldf = layer ? 48 : 8;
  const int tid = TIDX, lane = tid & 63, wave = tid >> 6, l16 = lane & 15, gk = lane >> 4;
  const int wpa = wave >> 2, wpb = wave & 3;
  const int bid = BIDX, xcd = bid & 7, nloc = (int)gridDim.x >> 3;
  const int qbeg = part ? bid - 64 : (bid >> 3), qend = part ? (bid >= 64 ? 128 : -(1 << 20)) : 16 * NT, qstep = part ? (int)gridDim.x - 64 : nloc;
  for (int q = qbeg; q < qend; q += qstep) {
    const int mt = part ? q : xcd * 16 + q / NT, nt = part ? NT : q % NT;
    const int m0 = mt * 256, n0 = nt * 256;
    const int mw = m0 + wpa * 128, nw = n0 + wpb * 64;
    const int seg = nw >> 7;
    int mode;
    if (seg < 24) mode = (layer == 0 && seg >= 12 && seg < 16) ? 2 : 0;
    else if (seg < seg_trans_end) mode = 1;
    else if (seg == seg_trans_end) mode = 3;
    else mode = 4;
    const int seg0 = nt * 2;
    const bool swapped = !((seg0 >= 24 && seg0 < seg_trans_end) || (layer == 0 && seg0 >= 12 && seg0 < 16));
    GEMM_OFFS(DM, DM)
    f32x4 acc[8][4];
    if (swapped) gemm_mainloop<true>(p, A + (size_t)m0 * DM, pa, Bt + (size_t)n0 * DM, pb, 64, 16, lds, acc);
    else gemm_mainloop<false>(p, A + (size_t)m0 * DM, pa, Bt + (size_t)n0 * DM, pb, 64, 16, lds, acc);
    const float* ssq_g = (const float*)(p.ws + WS_SSQ);
    if (mode == 0 || mode == 3) {
#pragma unroll
      for (int i = 0; i < 8; ++i) {
        const int m = mw + i * 16 + l16;
        const float rs = layer ? rsqrtf(ssq_g[m] * (1.f / DM) + 1e-6f) : 1.f;
#pragma unroll
        for (int j = 0; j < 4; ++j) {
          const int n = nw + j * 16 + gk * 4;
          const float a0 = acc[i][j][0] * rs, a1 = acc[i][j][1] * rs, a2 = acc[i][j][2] * rs, a3 = acc[i][j][3] * rs;
          if (mode == 0) {
            uint2 o; o.x = pack2(a0, a1); o.y = pack2(a2, a3);
            *(uint2*)(QK + (size_t)m * LDQ + n) = o;
          } else {
            const int nn = n - seg * 128;
            if (nn < nvalidF) *(float4*)(F + (size_t)m * ldf + nn) = (float4){a0, a1, a2, a3};
          }
        }
      }
    } else if (mode == 1 || mode == 2) {
#pragma unroll
      for (int i = 0; i < 8; ++i) {
        const int m = mw + i * 16 + gk * 4;
        float rs0 = 1.f, rs1 = 1.f, rs2 = 1.f, rs3 = 1.f;
        if (layer) {
          const float4 q4 = *(const float4*)(ssq_g + m);
          rs0 = rsqrtf(q4.x * (1.f / DM) + 1e-6f); rs1 = rsqrtf(q4.y * (1.f / DM) + 1e-6f);
          rs2 = rsqrtf(q4.z * (1.f / DM) + 1e-6f); rs3 = rsqrtf(q4.w * (1.f / DM) + 1e-6f);
        }
#pragma unroll
        for (int j = 0; j < 4; ++j) {
          const int n = nw + j * 16 + l16;
          const float a0 = acc[i][j][0] * rs0, a1 = acc[i][j][1] * rs1, a2 = acc[i][j][2] * rs2, a3 = acc[i][j][3] * rs3;
          if (mode == 1) {
            const int trow = n - 3072;
            uint2 o; o.x = pack2(a0, a1); o.y = pack2(a2, a3);
            *(uint2*)(VT + (size_t)trow * MTOK + m) = o;
          } else {
            const int trow = n - 512;
            const int h = (nw - 1536) >> 6;
            const float lg2 = log1pf(-exp2f(-5.f - (float)h)) * LOG2E;
            const float lane_dec = 0.125f * ex2(lg2 * (float)(127 - gk * 4));
            QK[(size_t)(m + 0) * LDQ + n] = f2bf(a0); QK[(size_t)(m + 1) * LDQ + n] = f2bf(a1);
            QK[(size_t)(m + 2) * LDQ + n] = f2bf(a2); QK[(size_t)(m + 3) * LDQ + n] = f2bf(a3);
            const float s0 = a0 * lane_dec * ex2(lg2 * (float)(-(i * 16 + 0))), s1 = a1 * lane_dec * ex2(lg2 * (float)(-(i * 16 + 1)));
            const float s2 = a2 * lane_dec * ex2(lg2 * (float)(-(i * 16 + 2))), s3 = a3 * lane_dec * ex2(lg2 * (float)(-(i * 16 + 3)));
            uint2 o; o.x = pack2(s0, s1); o.y = pack2(s2, s3);
            *(uint2*)(VT + (size_t)trow * MTOK + m) = o;
          }
        }
      }
    }
  }
}

__device__ __forceinline__ void gemm_outproj(const Params& p, int layer, u16* lds) {
  const u16* A = (const u16*)(p.ws + WS_Y);
  const u16* Bt = (const u16*)(p.ws + (layer ? WS_WO1 : WS_WO0));
  const float* res = layer ? p.out : p.x;
  float* out = p.out;
  u16* hb_out = (u16*)(p.ws + WS_HBF);
  float* ssq_g = (float*)(p.ws + WS_SSQ);
  const int tid = TIDX, lane = tid & 63, wave = tid >> 6, l16 = lane & 15, gk = lane >> 4;
  const int wpa = wave >> 2, wpb = wave & 3;
  const int bid = BIDX, xcd = bid & 7, nloc = (int)gridDim.x >> 3;
  for (int q = bid >> 3; q < 16 * 4; q += nloc) {
    const int mt = xcd * 16 + (q >> 2), nt = q & 3;
    const int m0 = mt * 256, n0 = nt * 256;
    GEMM_OFFS(DM, DM)
    f32x4 acc[8][4];
    gemm_mainloop<true>(p, A + (size_t)m0 * DM, pa, Bt + (size_t)n0 * DM, pb, 64, 16, lds, acc);
    const int tid2 = TIDX, lane2 = tid2 & 63, wave2 = tid2 >> 6, l16b = lane2 & 15, gkb = lane2 >> 4;
    const int mw = m0 + (wave2 >> 2) * 128, nw = n0 + (wave2 & 3) * 64;
#pragma unroll
    for (int i = 0; i < 8; ++i) {
      const int m = mw + i * 16 + l16b;
      float sq = 0.f;
#pragma unroll
      for (int j = 0; j < 4; ++j) {
        const int n = nw + j * 16 + gkb * 4;
        const float4 r = *(const float4*)(res + (size_t)m * DM + n);
        const float4 v = (float4){r.x + acc[i][j][0], r.y + acc[i][j][1], r.z + acc[i][j][2], r.w + acc[i][j][3]};
        *(float4*)(out + (size_t)m * DM + n) = v;
        if (layer == 0) {
          const float4 gg = *(const float4*)(p.o_ng + n);
          uint2 hb; hb.x = pack2(v.x * gg.x, v.y * gg.y); hb.y = pack2(v.z * gg.z, v.w * gg.w);
          *(uint2*)(hb_out + (size_t)m * DM + n) = hb;
          sq += v.x * v.x + v.y * v.y + v.z * v.z + v.w * v.w;
        }
      }
      if (layer == 0) {
        sq += __shfl_xor(sq, 16); sq += __shfl_xor(sq, 32);
        if (gkb == 0) atomicAdd(ssq_g + m, sq);
      }
    }
  }
}

__device__ __forceinline__ void gemm_cmp2_tile(const Params& p, u16* lds, int kv, int mt) {
  const int tid = TIDX, lane = tid & 63, wave = tid >> 6, l16 = lane & 15, gk = lane >> 4;
  const int wpa = wave >> 2, wpb = wave & 3;
  {
    const int m0 = mt * 256;
    const u16* A = (const u16*)(p.ws + WS_HC) + (size_t)kv * 8192 * 256;
    const u16* Bt = (const u16*)(p.ws + (kv ? WS_W2V : WS_W2K));
    GEMM_OFFS(256, 256)
    f32x4 acc[8][4];
    const bool swapped = (kv == 0);
    if (swapped) gemm_mainloop<true>(p, A + (size_t)m0 * 256, pa, Bt, pb, 64, 4, lds, acc);
    else gemm_mainloop<false>(p, A + (size_t)m0 * 256, pa, Bt, pb, 64, 4, lds, acc);
    const int mw = m0 + wpa * 128, nw = wpb * 64;
    if (swapped) {
      u16* kc_ = (u16*)(p.ws + WS_KCMP);
#pragma unroll
      for (int i = 0; i < 8; ++i)
#pragma unroll
        for (int j = 0; j < 4; ++j) {
          const int n = nw + j * 16 + gk * 4;
          const int m = mw + i * 16 + l16;
          if (n < 64) {
            uint2 o; o.x = pack2(acc[i][j][0], acc[i][j][1]); o.y = pack2(acc[i][j][2], acc[i][j][3]);
            *(uint2*)(kc_ + (size_t)m * 64 + n) = o;
          }
        }
      if (wpb == 0) {
        float mxn = 0.f;
#pragma unroll
        for (int i = 0; i < 8; ++i) {
          float ss = 0.f;
#pragma unroll
          for (int j = 0; j < 4; ++j) ss += acc[i][j][0] * acc[i][j][0] + acc[i][j][1] * acc[i][j][1] + acc[i][j][2] * acc[i][j][2] + acc[i][j][3] * acc[i][j][3];
          ss += __shfl_xor(ss, 16); ss += __shfl_xor(ss, 32);
          mxn = fmaxf(mxn, ss);
        }
#pragma unroll
        for (int o2 = 1; o2 <= 8; o2 <<= 1) mxn = fmaxf(mxn, __shfl_xor(mxn, o2));
        if (lane == 0) atomicMax((uint32_t*)(p.ws + WS_KMAX) + 16 + ((mw >> 9) & 3), __float_as_uint(mxn));
      }
    } else {
      u16* vt = (u16*)(p.ws + WS_VCMPT);
#pragma unroll
      for (int i = 0; i < 8; ++i)
#pragma unroll
        for (int j = 0; j < 4; ++j) {
          const int m = mw + i * 16 + gk * 4;
          const int n = nw + j * 16 + l16;
          if (n < 64) {
            uint2 o; o.x = pack2(acc[i][j][0], acc[i][j][1]); o.y = pack2(acc[i][j][2], acc[i][j][3]);
            *(uint2*)(vt + (size_t)(m >> 9) * 32768 + (size_t)n * 512 + (m & 511)) = o;
          }
        }
    }
  }
}

__device__ __forceinline__ void gemm_cmp1(const Params& p, u16* lds) {
  const u16* U = (const u16*)(p.ws + WS_QK);
  const float* peb = (const float*)(p.ws + WS_PEB);
  const int tid = TIDX, lane = tid & 63, wave = tid >> 6, l16 = lane & 15, gk = lane >> 4;
  const int wpa = wave >> 2, wpb = wave & 3;
  for (int tile = BIDX; tile < 64; tile += gridDim.x) {
    const int kv = tile >> 5, mt = tile & 31;
    const int m0 = mt * 256;
    const u16* Bt = (const u16*)(p.ws + (kv ? WS_W1V : WS_W1K));
    u16* Hc = (u16*)(p.ws + WS_HC) + (size_t)kv * 8192 * 256;
    uint32_t pa[4], pb[4];
#pragma unroll
    for (int i = 0; i < 4; ++i) {
      const int row = (tid >> 3) + 64 * i, kc = tid & 7;
      const int r = m0 + row, bg = r >> 9, cc = r & 511, b = bg >> 2, g = bg & 3;
      int tok0 = cc * 16; if (tok0 > SEQ - 32) tok0 = SEQ - 32;
      pa[i] = (uint32_t)(b * SEQ + tok0) * LDQ + 1024 + kv * 256 + g * 64 + kc * 8;
      pb[i] = (uint32_t)row * 2048 + kc * 8;
    }
    f32x4 acc[8][4];
    gemm_mainloop<true>(p, U, pa, Bt, pb, LDQ, 32, lds, acc);
    const int tid2 = TIDX, lane2 = tid2 & 63, wave2 = tid2 >> 6;
    const int mw = m0 + (wave2 >> 2) * 128, nw = (wave2 & 3) * 64;
#pragma unroll
    for (int i = 0; i < 8; ++i)
#pragma unroll
      for (int j = 0; j < 4; ++j) {
        const int n = nw + j * 16 + (lane2 >> 4) * 4;
        const int m = mw + i * 16 + (lane2 & 15);
        const float4 bb = *(const float4*)(peb + kv * 256 + n);
        float v0 = silu_f(acc[i][j][0] + bb.x), v1 = silu_f(acc[i][j][1] + bb.y);
        float v2 = silu_f(acc[i][j][2] + bb.z), v3 = silu_f(acc[i][j][3] + bb.w);
        if ((m & 511) == 511) { v0 = v1 = v2 = v3 = 0.f; }
        uint2 o; o.x = pack2(v0, v1); o.y = pack2(v2, v3);
        *(uint2*)(Hc + (size_t)m * 256 + n) = o;
      }
    __threadfence_block();
    __syncthreads();
    gemm_cmp2_tile(p, lds, kv, mt);
  }
}

#define TILE_LD(R, src, stride) { R##0 = *(const uint4*)((src) + (long)(tid >> 3) * (stride) + (tid & 7) * 8); }
#define TILE_ST(dst, R) { *(uint4*)((dst) + (tid >> 3) * TS + (tid & 7) * 8) = R##0; }
#define VPOS(c) ((((c) >> 2) * 32) + ((2 * ((c) & 1)) * 8) + ((((c) & 3) >> 1) * 4))
#define TILE_STV_(dst, val) { const int c_ = tid & 7; u16* d_ = (dst) + (tid >> 3) * TS + VPOS(c_); \
    *(uint2*)(d_) = make_uint2((val).x, (val).y); *(uint2*)(d_ + 8) = make_uint2((val).z, (val).w); }
#define TILE_STV(dst, R) TILE_STV_(dst, R##0)
__device__ __forceinline__ void qk_tile(const u16* sK, const bf16x8 (&q)[2], f32x4 (&s)[4], int l16, int gk) {
#pragma unroll
  for (int kt = 0; kt < 4; ++kt) s[kt] = (f32x4){0.f, 0.f, 0.f, 0.f};
#pragma unroll
  for (int ks = 0; ks < 2; ++ks)
#pragma unroll
    for (int kt = 0; kt < 4; ++kt) {
      bf16x8 kf = *(const bf16x8*)(sK + (kt * 16 + l16) * TS + ks * 32 + gk * 8);
      s[kt] = MFMA(kf, q[ks], s[kt]);
    }
}
__device__ __forceinline__ void pv_tile(const u16* sV, const float (&pp)[4][4], f32x4 (&o)[4], int l16, int gk) {
  bf16x8 pf[2];
#pragma unroll
  for (int ks2 = 0; ks2 < 2; ++ks2) {
    uint4 t;
    t.x = pack2(pp[2 * ks2][0], pp[2 * ks2][1]); t.y = pack2(pp[2 * ks2][2], pp[2 * ks2][3]);
    t.z = pack2(pp[2 * ks2 + 1][0], pp[2 * ks2 + 1][1]); t.w = pack2(pp[2 * ks2 + 1][2], pp[2 * ks2 + 1][3]);
    pf[ks2] = *(bf16x8*)&t;
  }
#pragma unroll
  for (int dt = 0; dt < 4; ++dt)
#pragma unroll
    for (int ks2 = 0; ks2 < 2; ++ks2) {
      const bf16x8 vf = *(const bf16x8*)(sV + (dt * 16 + l16) * TS + ks2 * 32 + gk * 8);
      o[dt] = MFMA(vf, pf[ks2], o[dt]);
    }
}

__device__ __forceinline__ void fox_phase(const Params& p, u16* lds) {
  const u16* QK = (const u16*)(p.ws + WS_QK);
  const u16* VT = (const u16*)(p.ws + WS_VT);
  const float* cf = (const float*)(p.ws + WS_CFOX);
  u16* Y = (u16*)(p.ws + WS_Y);
  const int tid = TIDX, lane = tid & 63, w = tid >> 6, l16 = lane & 15, gk = lane >> 4;
  const float scale2 = 0.125f * LOG2E;
  for (int unit = BIDX; unit < 2048; unit += gridDim.x) {
    const int bh = unit & 31, qblk = 63 - (unit >> 5), b = bh >> 3, h = bh & 7;
    const int tq0 = qblk * 128 + w * 16;
    const int t = tq0 + l16;
    const float* cfr = cf + (size_t)bh * SEQ;
    bf16x8 q[2];
#pragma unroll
    for (int ks = 0; ks < 2; ++ks) q[ks] = *(const bf16x8*)(QK + (size_t)(b * SEQ + t) * LDQ + h * 64 + ks * 32 + gk * 8);
    const float cq2 = cfr[t] * LOG2E;
    f32x4 o[4];
    float m = -1e30f, l = 0.f;
#pragma unroll
    for (int dt = 0; dt < 4; ++dt) o[dt] = (f32x4){0.f, 0.f, 0.f, 0.f};
    const int ntiles = qblk * 2 + 2;
    const int iw = qblk * 2 + (w >> 2);
    const u16* ksrc = QK + (size_t)(b * SEQ) * LDQ + 512 + h * 64;
    const u16* vsrc = VT + (size_t)(h * 64) * MTOK + (size_t)b * SEQ;
    float qs = 0.f;
#pragma unroll
    for (int ks = 0; ks < 2; ++ks)
#pragma unroll
      for (int e = 0; e < 8; ++e) { const float v = bf2f((u16)q[ks][e]); qs += v * v; }
    qs += __shfl_xor(qs, 16); qs += __shfl_xor(qs, 32);
#pragma unroll
    for (int o2 = 1; o2 <= 8; o2 <<= 1) qs = fmaxf(qs, __shfl_xor(qs, o2));
    float* red = (float*)(lds + 256 * TS);
    if (lane == 0) red[w] = qs;
    __syncthreads();
    float qmax2 = red[0];
#pragma unroll
    for (int i = 1; i < NWAVE; ++i) qmax2 = fmaxf(qmax2, red[i]);
    const float kmax2 = __uint_as_float(((const uint32_t*)(p.ws + WS_KMAX))[h]);
    const float T2 = 2.f * scale2 * sqrtf(qmax2 * kmax2) * 1.001f + 48.f;
    const float cfirst2 = cfr[qblk * 128] * LOG2E;
    int i_lo = 0;
    for (int base = qblk * 2 - 1; base >= 0; base -= 64) {
      const int ti = base - lane;
      bool skip = false;
      if (ti >= 0) skip = (cfirst2 - cfr[ti * 64 + 63] * LOG2E) < -T2;
      const unsigned long long bal = __ballot(skip);
      if (bal) { i_lo = base - (int)__builtin_ctzll(bal) + 1; break; }
    }
    uint4 rk0, rv0;
    TILE_LD(rk, ksrc + (size_t)i_lo * 64 * LDQ, LDQ); TILE_LD(rv, vsrc + i_lo * 64, MTOK);
    TILE_ST(lds + (i_lo & 1) * (128 * TS), rk); TILE_STV(lds + (i_lo & 1) * (128 * TS) + 64 * TS, rv);
    __syncthreads();
    for (int i = i_lo; i < ntiles; ++i) {
      u16* cur = lds + (i & 1) * (128 * TS);
      const bool more = (i + 1 < ntiles);
      if (more) { TILE_LD(rk, ksrc + (size_t)(i + 1) * 64 * LDQ, LDQ); TILE_LD(rv, vsrc + (i + 1) * 64, MTOK); }
      if (i <= iw) {
        const int s0 = i * 64;
        const bool diag = (i == iw);
        f32x4 s[4];
        qk_tile(cur, q, s, l16, gk);
        float xv[4][4];
        float mx = -1e30f;
#pragma unroll
        for (int kt = 0; kt < 4; ++kt) {
          const float4 c4 = *(const float4*)(cfr + s0 + kt * 16 + gk * 4);
          const float ck[4] = {c4.x, c4.y, c4.z, c4.w};
#pragma unroll
          for (int r = 0; r < 4; ++r) {
            float v = fmaf(s[kt][r], scale2, cq2 - ck[r] * LOG2E);
            if (diag && (s0 + kt * 16 + gk * 4 + r > t)) v = -1e30f;
            xv[kt][r] = v; mx = fmaxf(mx, v);
          }
        }
        mx = fmaxf(mx, __shfl_xor(mx, 16)); mx = fmaxf(mx, __shfl_xor(mx, 32));
        const float mnew = fmaxf(m, mx);
        const float alpha = ex2(m - mnew);
        m = mnew;
        const float muse = fmaxf(mnew, -1e20f);
        float rs = 0.f;
#pragma unroll
        for (int kt = 0; kt < 4; ++kt)
#pragma unroll
          for (int r = 0; r < 4; ++r) { xv[kt][r] = ex2(xv[kt][r] - muse); rs += xv[kt][r]; }
        l = l * alpha + rs;
#pragma unroll
        for (int dt = 0; dt < 4; ++dt) o[dt] *= alpha;
        pv_tile(cur + 64 * TS, xv, o, l16, gk);
      }
      if (more) { u16* nxt = lds + ((i + 1) & 1) * (128 * TS); TILE_ST(nxt, rk); TILE_STV(nxt + 64 * TS, rv); }
      __syncthreads();
    }
    {
      float lt = l; lt += __shfl_xor(lt, 16); lt += __shfl_xor(lt, 32);
      const float inv = lt > 0.f ? 1.f / lt : 0.f;
      const size_t mrow = (size_t)(b * SEQ + t);
#pragma unroll
      for (int dt = 0; dt < 4; ++dt) {
        const int col = h * 64 + dt * 16 + gk * 4;
        const uint2 zz = *(const uint2*)(QK + mrow * LDQ + 2048 + col);
        const float z0 = bf2f(zz.x & 0xffff), z1 = bf2f(zz.x >> 16), z2 = bf2f(zz.y & 0xffff), z3 = bf2f(zz.y >> 16);
        uint2 ov;
        ov.x = pack2(o[dt][0] * inv * silu_f(z0), o[dt][1] * inv * silu_f(z1));
        ov.y = pack2(o[dt][2] * inv * silu_f(z2), o[dt][3] * inv * silu_f(z3));
        *(uint2*)(Y + mrow * DM + col) = ov;
      }
    }
  }
}

__device__ __forceinline__ void fox_knorm(const Params& p) {
  const u16* QK = (const u16*)(p.ws + WS_QK);
  uint32_t* km = (uint32_t*)(p.ws + WS_KMAX);
  const int tid = TIDX, lane = tid & 63, wave = tid >> 6;
  float mx = 0.f;
  for (int row = BIDX * NWAVE + wave; row < MTOK; row += gridDim.x * NWAVE) {
    const uint4 v = *(const uint4*)(QK + (size_t)row * LDQ + 512 + lane * 8);
    const float a0 = bf2f(v.x & 0xffff), a1 = bf2f(v.x >> 16), a2 = bf2f(v.y & 0xffff), a3 = bf2f(v.y >> 16);
    const float a4 = bf2f(v.z & 0xffff), a5 = bf2f(v.z >> 16), a6 = bf2f(v.w & 0xffff), a7 = bf2f(v.w >> 16);
    float ss = a0 * a0 + a1 * a1 + a2 * a2 + a3 * a3 + a4 * a4 + a5 * a5 + a6 * a6 + a7 * a7;
    ss += __shfl_xor(ss, 1); ss += __shfl_xor(ss, 2); ss += __shfl_xor(ss, 4);
    mx = fmaxf(mx, ss);
  }
  if ((lane & 7) == 0) atomicMax(&km[lane >> 3], __float_as_uint(mx));
}

__device__ __forceinline__ void fox_scan(const Params& p, float* ldsf) {
  const float* fl = (const float*)(p.ws + WS_FLOG);
  float* cf = (float*)(p.ws + WS_CFOX);
  double* sd = (double*)ldsf;
  const int tid = TIDX;
  for (int bh = BIDX; bh < 32; bh += gridDim.x) {
    const int b = bh >> 3, h = bh & 7;
    const float bf = p.e_bf[h];
    float ls[16];
    double sum = 0.0;
#pragma unroll
    for (int i = 0; i < 16; ++i) {
      const float xx = fl[(size_t)(b * SEQ + tid * 16 + i) * 8 + h] + bf;
      ls[i] = fminf(xx, 0.f) - log1pf(__expf(-fabsf(xx)));
      sum += (double)ls[i];
    }
    __syncthreads();
    sd[tid] = sum;
    __syncthreads();
    double pre = 0.0;
    for (int j = 0; j < tid; ++j) pre += sd[j];
#pragma unroll
    for (int i = 0; i < 16; ++i) { pre += (double)ls[i]; cf[(size_t)bh * SEQ + tid * 16 + i] = (float)pre; }
  }
}

__device__ __forceinline__ void ret_stepA(const Params& p) {
  const u16* VT = (const u16*)(p.ws + WS_VT);
  float* dS = (float*)(p.ws + WS_DS);
  const int tid_ = TIDX, lane = tid_ & 63, w8 = tid_ >> 6, w = w8 & 3, l16 = lane & 15, gk = lane >> 4;
  for (int u2 = BIDX; u2 < 1024; u2 += gridDim.x) {
    const int u = u2 * 2 + (w8 >> 2);
    const int bh = u >> 6, n = u & 63, b = bh >> 3, h = bh & 7;
    const size_t mcol = (size_t)b * SEQ + n * 128;
    f32x4 acc[4];
#pragma unroll
    for (int dt = 0; dt < 4; ++dt) acc[dt] = (f32x4){0.f, 0.f, 0.f, 0.f};
#pragma unroll
    for (int ks = 0; ks < 4; ++ks) {
      bf16x8 af = *(const bf16x8*)(VT + (size_t)(512 + h * 64 + w * 16 + l16) * MTOK + mcol + ks * 32 + gk * 8);
#pragma unroll
      for (int dt = 0; dt < 4; ++dt) {
        bf16x8 bfr = *(const bf16x8*)(VT + (size_t)(1024 + h * 64 + dt * 16 + l16) * MTOK + mcol + ks * 32 + gk * 8);
        acc[dt] = MFMA(af, bfr, acc[dt]);
      }
    }
#pragma unroll
    for (int dt = 0; dt < 4; ++dt)
#pragma unroll
      for (int r = 0; r < 4; ++r) dS[(size_t)u * 4096 + (w * 16 + gk * 4 + r) * 64 + dt * 16 + l16] = acc[dt][r];
  }
}
__device__ __forceinline__ void ret_stepB(const Params& p) {
  const float* dS = (const float*)(p.ws + WS_DS);
  u16* st = (u16*)(p.ws + WS_ST);
  for (int idx = BIDX * NTHR + TIDX; idx < 32 * 4096; idx += gridDim.x * NTHR) {
    const int bh = idx >> 12, ed = idx & 4095, h = bh & 7;
    const float cdec = __expf(log1pf(-exp2f(-5.f - (float)h)) * 128.f);
    float s = 0.f;
#pragma unroll 8
    for (int n = 0; n < 64; ++n) {
      const size_t a = (size_t)(bh * 64 + n) * 4096 + ed;
      st[a] = f2bf(s);
      s = s * cdec + dS[a];
    }
  }
}
__device__ __forceinline__ void ret_stepC(const Params& p, u16* lds) {
  const u16* QK = (const u16*)(p.ws + WS_QK);
  const u16* VT = (const u16*)(p.ws + WS_VT);
  const u16* st = (const u16*)(p.ws + WS_ST);
  u16* Y = (u16*)(p.ws + WS_Y);
  const int tid = TIDX, lane = tid & 63, w = tid >> 6, l16 = lane & 15, gk = lane >> 4;
  for (int u = BIDX; u < 2048; u += gridDim.x) {
    const int bh = u >> 6, n = u & 63, b = bh >> 3, h = bh & 7;
    const size_t m0 = (size_t)b * SEQ + n * 128;
    const float lg2 = log1pf(-exp2f(-5.f - (float)h)) * LOG2E;
    __syncthreads();
    {
      uint4 r0;
      TILE_LD(r, QK + m0 * LDQ + 1536 + h * 64, LDQ); TILE_ST(lds, r);
      TILE_LD(r, VT + (size_t)(512 + h * 64) * MTOK + m0, MTOK); TILE_STV(lds + 64 * TS, r);
      TILE_LD(r, QK + (m0 + 64) * LDQ + 1536 + h * 64, LDQ); TILE_ST(lds + 128 * TS, r);
      TILE_LD(r, VT + (size_t)(512 + h * 64) * MTOK + m0 + 64, MTOK); TILE_STV(lds + 192 * TS, r);
      TILE_LD(r, st + (size_t)u * 4096, 64); TILE_ST(lds + 256 * TS, r);
    }
    __syncthreads();
    const int iq = 16 * w + l16;
    const size_t mrow = m0 + iq;
    bf16x8 q[2];
#pragma unroll
    for (int ks = 0; ks < 2; ++ks) q[ks] = *(const bf16x8*)(QK + mrow * LDQ + 1024 + h * 64 + ks * 32 + gk * 8);
    f32x4 o[4];
#pragma unroll
    for (int dt = 0; dt < 4; ++dt) o[dt] = (f32x4){0.f, 0.f, 0.f, 0.f};
#pragma unroll
    for (int dt = 0; dt < 4; ++dt)
#pragma unroll
      for (int ks = 0; ks < 2; ++ks) {
        bf16x8 sf = *(const bf16x8*)(lds + 256 * TS + (dt * 16 + l16) * TS + ks * 32 + gk * 8);
        o[dt] = MFMA(sf, q[ks], o[dt]);
      }
    const float cross = ex2(lg2 * (float)(iq + 1));
#pragma unroll
    for (int dt = 0; dt < 4; ++dt) o[dt] *= cross;
#pragma unroll
    for (int k64 = 0; k64 < 2; ++k64) {
      if (k64 * 64 <= 16 * w + 15) {
        f32x4 s[4];
        qk_tile(lds + k64 * 128 * TS, q, s, l16, gk);
        float pp[4][4];
#pragma unroll
        for (int kt = 0; kt < 4; ++kt)
#pragma unroll
          for (int r = 0; r < 4; ++r) {
            const int j = k64 * 64 + kt * 16 + gk * 4 + r;
            pp[kt][r] = (j <= iq) ? s[kt][r] * 0.125f * ex2(lg2 * (float)(iq - j)) : 0.f;
          }
        pv_tile(lds + k64 * 128 * TS + 64 * TS, pp, o, l16, gk);
      }
    }
    float sm = 0.f;
#pragma unroll
    for (int dt = 0; dt < 4; ++dt) sm += o[dt][0] + o[dt][1] + o[dt][2] + o[dt][3];
    sm += __shfl_xor(sm, 16); sm += __shfl_xor(sm, 32);
    const float mu = sm * (1.f / 64.f);
    float vs = 0.f;
#pragma unroll
    for (int dt = 0; dt < 4; ++dt)
#pragma unroll
      for (int r = 0; r < 4; ++r) { const float d = o[dt][r] - mu; vs += d * d; }
    vs += __shfl_xor(vs, 16); vs += __shfl_xor(vs, 32);
    const float rstd = rsqrtf(vs * (1.f / 64.f) + 1e-5f);
#pragma unroll
    for (int dt = 0; dt < 4; ++dt) {
      const int col = h * 64 + dt * 16 + gk * 4;
      const float4 gg = *(const float4*)(p.e_gn + col);
      const uint2 zz = *(const uint2*)(QK + mrow * LDQ + 2048 + 512 + col);
      const float z0 = bf2f(zz.x & 0xffff), z1 = bf2f(zz.x >> 16), z2 = bf2f(zz.y & 0xffff), z3 = bf2f(zz.y >> 16);
      uint2 ov;
      ov.x = pack2((o[dt][0] - mu) * rstd * gg.x * silu_f(z0), (o[dt][1] - mu) * rstd * gg.y * silu_f(z1));
      ov.y = pack2((o[dt][2] - mu) * rstd * gg.z * silu_f(z2), (o[dt][3] - mu) * rstd * gg.w * silu_f(z3));
      *(uint2*)(Y + mrow * DM + 512 + col) = ov;
    }
  }
}

__device__ __forceinline__ void nsa_tile_interior(const u16* sK, const u16* sV, const bf16x8 (&q)[2], f32x4 (&acc)[4],
                                                  float& m, float& l, float slope2, const float (&sk)[16],
                                                  int t, int pos0, bool lanesel, int lane) {
  const int l16 = lane & 15, gk = lane >> 4;
  const float scale2 = 0.125f * LOG2E;
  f32x4 s[4];
  qk_tile(sK, q, s, l16, gk);
  const float c0 = fmaf(-slope2, (float)(t - pos0 - gk * 4), lanesel ? 0.f : -1e30f);
  float xv[4][4];
  float mx = -1e30f;
#pragma unroll
  for (int kt = 0; kt < 4; ++kt)
#pragma unroll
    for (int r = 0; r < 4; ++r) { xv[kt][r] = fmaf(s[kt][r], scale2, sk[kt * 4 + r]); mx = fmaxf(mx, xv[kt][r]); }
  mx += c0;
  mx = fmaxf(mx, __shfl_xor(mx, 16)); mx = fmaxf(mx, __shfl_xor(mx, 32));
  const float mnew = fmaxf(m, mx);
  const float alpha = ex2(m - mnew);
  m = mnew;
  const float off = c0 - fmaxf(mnew, -1e20f);
  float rs = 0.f;
#pragma unroll
  for (int kt = 0; kt < 4; ++kt)
#pragma unroll
    for (int r = 0; r < 4; ++r) { xv[kt][r] = ex2(xv[kt][r] + off); rs += xv[kt][r]; }
  l = l * alpha + rs;
  if (__any(alpha != 1.f)) {
#pragma unroll
    for (int dt = 0; dt < 4; ++dt) acc[dt] *= alpha;
  }
  pv_tile(sV, xv, acc, l16, gk);
}
template <int BR>
__device__ __forceinline__ void nsa_tile(const u16* sK, const u16* sV, const bf16x8 (&q)[2], f32x4 (&acc)[4],
                                         float& m, float& l, float slope2, float gmul,
                                         int t, int pos0, int pstride, int wl, bool lanesel,
                                         float* imp_row, int jbase, float& carry, int lane, float* imp_scale = nullptr) {
  const int l16 = lane & 15, gk = lane >> 4;
  const float scale2 = 0.125f * LOG2E;
  const unsigned wle = lanesel ? (unsigned)wl : 0u;
  f32x4 s[4];
  qk_tile(sK, q, s, l16, gk);
  float xv[4][4];
  float mx = -1e30f;
#pragma unroll
  for (int kt = 0; kt < 4; ++kt)
#pragma unroll
    for (int r = 0; r < 4; ++r) {
      const int dist = t - (pos0 + (kt * 16 + gk * 4 + r) * pstride);
      const float pen = ((unsigned)dist < wle) ? 0.f : -1e30f;
      const float v = fmaf(s[kt][r], scale2, fmaf(-slope2, (float)dist, pen));
      xv[kt][r] = v; mx = fmaxf(mx, v);
    }
  if (BR != 1) {
    mx = fmaxf(mx, __shfl_xor(mx, 16)); mx = fmaxf(mx, __shfl_xor(mx, 32));
    const float mnew = fmaxf(m, mx);
    const float alpha = ex2(m - mnew);
    m = mnew;
    const float muse = fmaxf(mnew, -1e20f);
    float rs = 0.f;
#pragma unroll
    for (int kt = 0; kt < 4; ++kt)
#pragma unroll
      for (int r = 0; r < 4; ++r) { xv[kt][r] = ex2(xv[kt][r] - muse); rs += xv[kt][r]; }
    l = l * alpha + rs;
    if (BR == 2 || BR == 3) {
#pragma unroll
      for (int dt = 0; dt < 4; ++dt) acc[dt] *= alpha;
    }
    if (BR == 3) {
      float p3[4];
#pragma unroll
      for (int kt = 0; kt < 4; ++kt) {
        p3[kt] = xv[kt][3];
        imp_row[jbase + kt * 4 + gk] = 2.f * (xv[kt][0] + xv[kt][1] + xv[kt][2]) + xv[kt][3];
      }
      const int srcl = (lane + 48) & 63;
      const float carry_s = carry * alpha;
#pragma unroll
      for (int kt = 0; kt < 4; ++kt) {
        const float same = __shfl(p3[kt], srcl);
        const float prev = __shfl(kt > 0 ? p3[kt > 0 ? kt - 1 : 0] : carry_s, srcl);
        imp_row[jbase + kt * 4 + gk] += (gk == 0) ? prev : same;
      }
      carry = p3[3];
      if (gk == 0) *imp_scale = mnew;
    }
    if (BR == 2 || BR == 3) pv_tile(sV, xv, acc, l16, gk);
  } else {
    const float muse = fmaxf(m, -1e20f);
    float p3[4];
#pragma unroll
    for (int kt = 0; kt < 4; ++kt) {
      float pn[4];
#pragma unroll
      for (int r = 0; r < 4; ++r) { pn[r] = ex2(xv[kt][r] - muse) * l; xv[kt][r] = pn[r] * gmul; }
      p3[kt] = pn[3];
      xv[kt][0] = xv[kt][0];
      imp_row[jbase + kt * 4 + gk] = 2.f * (pn[0] + pn[1] + pn[2]) + pn[3];
    }
    const int srcl = (lane + 48) & 63;
#pragma unroll
    for (int kt = 0; kt < 4; ++kt) {
      const float same = __shfl(p3[kt], srcl);
      const float prev = __shfl(kt > 0 ? p3[kt > 0 ? kt - 1 : 0] : carry, srcl);
      imp_row[jbase + kt * 4 + gk] += (gk == 0) ? prev : same;
    }
    carry = p3[3];
    pv_tile(sV, xv, acc, l16, gk);
  }
}

__device__ __forceinline__ void nsa_phase(const Params& p, u16* lds) {
  const u16* U = (const u16*)(p.ws + WS_QK);
  const u16* VT = (const u16*)(p.ws + WS_VT);
  const u16* KC = (const u16*)(p.ws + WS_KCMP);
  const u16* VC = (const u16*)(p.ws + WS_VCMPT);
  const float* GL = (const float*)(p.ws + WS_GL);
  u16* Y = (u16*)(p.ws + WS_Y);
  float* imp = (float*)(lds + 512 * TS);
  uint32_t* umask = (uint32_t*)(imp + 128 * IMPS);
  int* ulist = (int*)(umask + 4);
  const int tid = TIDX, lane = tid & 63, w = tid >> 6, l16 = lane & 15, gk = lane >> 4;
  const int qt = w & 1, hd = w >> 1;
  uint2* totl = (uint2*)imp + 128 + (size_t)w * 256 + lane;
  const int BIG = 1 << 30;
  int* uslot = ulist + 128;
  unsigned* uctr = (unsigned*)(p.ws + WS_KMAX) + 24;
  for (;;) {
    __syncthreads();
    if (tid == 0) uslot[0] = (int)atomicAdd(uctr, 1u);
    __syncthreads();
    const int unit = uslot[0];
    if (unit >= 4096) break;
    const int bg = unit & 15, qh = 255 - (unit >> 4), b = bg >> 2, g = bg & 3;
    const int t0 = qh * 32, qb = t0 >> 6, t = t0 + 16 * qt + l16;
    const size_t mrow = (size_t)b * SEQ + t;
    const int h = g * 4 + hd;
    bf16x8 q[2];
#pragma unroll
    for (int ks = 0; ks < 2; ++ks) q[ks] = *(const bf16x8*)(U + mrow * LDQ + h * 64 + ks * 32 + gk * 8);
    const float slope2 = exp2f(-0.5f * (float)(h + 1)) * LOG2E;
    const float g1 = sigmoid_f(GL[mrow * 48 + h * 3] + p.o_bg[h * 3]);
    float sk[16];
#pragma unroll
    for (int i = 0; i < 16; ++i) sk[i] = slope2 * (float)((i >> 2) * 16 + (i & 3));
    float qn2 = 0.f;
#pragma unroll
    for (int ks = 0; ks < 2; ++ks)
#pragma unroll
      for (int e = 0; e < 8; ++e) { const float v = bf2f((u16)q[ks][e]); qn2 += v * v; }
    qn2 += __shfl_xor(qn2, 16); qn2 += __shfl_xor(qn2, 32);
#pragma unroll
    for (int o2 = 1; o2 <= 8; o2 <<= 1) qn2 = fmaxf(qn2, __shfl_xor(qn2, o2));
    const uint32_t* kmx = (const uint32_t*)(p.ws + WS_KMAX);
    const float sc2 = 0.125f * LOG2E;
    const float T_slc = 2.02f * sc2 * sqrtf(qn2 * __uint_as_float(kmx[8 + g])) + 48.f;
    const float T_win = 2.02f * sc2 * sqrtf(qn2 * __uint_as_float(kmx[12 + g])) + 48.f;
    const float T_cmp = 2.05f * sc2 * sqrtf(qn2 * __uint_as_float(kmx[16 + g])) + 16.f * slope2 + 48.f;
    const int tq0w = t0 + 16 * qt;
    f32x4 acc[4];
    float m = -1e30f, l = 0.f;
#pragma unroll
    for (int dt = 0; dt < 4; ++dt) acc[dt] = (f32x4){0.f, 0.f, 0.f, 0.f};
    __syncthreads();
    for (int i = tid; i < 128 * IMPS; i += NTHR) imp[i] = 0.f;
    if (tid < 4) umask[tid] = 0u;
    float* imp_row = imp + (hd * 32 + 16 * qt + l16) * IMPS;
    float carry = 0.f;
    uint4 rk0, rk1, rk2, rk3, rv0, rv1, rv2, rv3;
    u16* impbase_unused = nullptr; (void)impbase_unused;
#define SLOT(k) (lds + (k) * (128 * TS))
#define LD1(k, kp, ks_, vp, vs_) { rk##k = *(const uint4*)((kp) + (long)(tid >> 3) * (ks_) + (tid & 7) * 8); rv##k = *(const uint4*)((vp) + (long)(tid >> 3) * (vs_) + (tid & 7) * 8); }
#define ST1(k) { *(uint4*)(SLOT(k) + (tid >> 3) * TS + (tid & 7) * 8) = rk##k; TILE_STV_(SLOT(k) + 64 * TS, rv##k) }
    const int ntc = ((t0 >> 4) >> 6) + 1;
    const u16* kcs = KC + (size_t)bg * 512 * 64;
    const u16* vcs = VC + (size_t)bg * 32768;
#define CMP_LD(k, i) if ((i) < ntc) LD1(k, kcs + (size_t)(i) * 64 * 64, 64, vcs + (i) * 64, 512)
    float* mrec = (float*)(uslot + 4) + (w * 16 + l16) * 8;
    {
      const int ngrp = (ntc + 3) >> 2;
      CMP_LD(0, 0) CMP_LD(1, 1) CMP_LD(2, 2) CMP_LD(3, 3)
#pragma unroll 1
      for (int gi = 0; gi < ngrp; ++gi) {
        const int ib = gi * 4;
        __syncthreads();
        if (ib < ntc) ST1(0) if (ib + 1 < ntc) ST1(1) if (ib + 2 < ntc) ST1(2) if (ib + 3 < ntc) ST1(3)
        __syncthreads();
        if (gi + 1 < ngrp) { CMP_LD(0, ib + 4) CMP_LD(1, ib + 5) CMP_LD(2, ib + 6) CMP_LD(3, ib + 7) }
#pragma unroll 1
        for (int k = 0; k < 4; ++k) {
          const int i = ib + k;
          if (i < ntc) {
            const int dmin = tq0w - (16 * (64 * i + 63) + 31);
            if (dmin > 0 && slope2 * (float)dmin > T_cmp) { carry = 0.f; if (gk == 0) mrec[i] = -1e30f; continue; }
            nsa_tile<3>(SLOT(k), SLOT(k) + 64 * TS, q, acc, m, l, slope2, g1, t, 16 * (64 * i) + 31, 16, BIG, true, imp_row, 16 * i, carry, lane, mrec + i);
          }
        }
      }
      float lt = l; lt += __shfl_xor(lt, 16); lt += __shfl_xor(lt, 32);
      const float inv = lt > 0.f ? 1.f / lt : 0.f;
      const float mfin = fmaxf(m, -1e20f);
#pragma unroll 1
      for (int i = 0; i < ntc; ++i) {
        const float f = ex2(fmaxf(mrec[i], -1e20f) - mfin) * inv;
#pragma unroll
        for (int kt = 0; kt < 4; ++kt) imp_row[16 * i + kt * 4 + gk] *= f;
      }
      const float og = g1 * inv;
#pragma unroll
      for (int dt = 0; dt < 4; ++dt) acc[dt] *= og;
    }
    __syncthreads();
    {
      const int qi = w * 4 + gk;
      const int c8 = l16 * 8;
      uint32_t selb = 0u;
      if (qb < 16) {
#pragma unroll
        for (int i = 0; i < 8; ++i) if (c8 + i <= qb) selb |= (1u << i);
      } else {
        float val[8];
        const float* ra = imp + qi * IMPS + c8;
#pragma unroll
        for (int i4 = 0; i4 < 2; ++i4) {
          const float4 v0 = *(const float4*)(ra + 4 * i4);
          const float4 v1 = *(const float4*)(ra + 32 * IMPS + 4 * i4);
          const float4 v2 = *(const float4*)(ra + 64 * IMPS + 4 * i4);
          const float4 v3 = *(const float4*)(ra + 96 * IMPS + 4 * i4);
          val[4 * i4] = ((v0.x + v1.x) + v2.x) + v3.x; val[4 * i4 + 1] = ((v0.y + v1.y) + v2.y) + v3.y;
          val[4 * i4 + 2] = ((v0.z + v1.z) + v2.z) + v3.z; val[4 * i4 + 3] = ((v0.w + v1.w) + v2.w) + v3.w;
        }
#pragma unroll
        for (int i = 0; i < 8; ++i) {
          const int j = c8 + i;
          const bool forced = (j == 0) || (j == qb) || (j == qb - 1);
          if (forced) selb |= (1u << i);
          if (forced || j > qb) val[i] = -1.f;
        }
#pragma unroll 1
        for (int it = 0; it < 13; ++it) {
          float best = -2.f; int bj = 0;
#pragma unroll
          for (int i = 0; i < 8; ++i) {
            const float v = ((selb >> i) & 1u) ? -1.f : val[i];
            if (v > best) { best = v; bj = c8 + i; }
          }
#pragma unroll
          for (int o = 1; o <= 8; o <<= 1) {
            const float ov = __shfl_xor(best, o); const int oj = __shfl_xor(bj, o);
            if (ov > best || (ov == best && oj < bj)) { best = ov; bj = oj; }
          }
          if ((bj >> 3) == l16) selb |= (1u << (bj & 7));
        }
      }
      uint32_t wd = selb << ((l16 & 3) * 8);
      wd |= __shfl_xor(wd, 1); wd |= __shfl_xor(wd, 2);
      __syncthreads();
      uint32_t* selw = (uint32_t*)imp;
      if ((l16 & 3) == 0) selw[qi * 4 + (l16 >> 2)] = wd;
      uint32_t uq = wd; uq |= __shfl_xor(uq, 16); uq |= __shfl_xor(uq, 32);
      if (gk == 0 && (l16 & 3) == 0) atomicOr(&umask[l16 >> 2], uq);
    }
    __syncthreads();
    const uint32_t* selq = (const uint32_t*)imp + (16 * qt + l16) * 4;
    const uint32_t sel0 = selq[0], sel1 = selq[1], sel2 = selq[2], sel3 = selq[3];
    uint32_t wun0 = sel0, wun1 = sel1, wun2 = sel2, wun3 = sel3;
#pragma unroll
    for (int o = 1; o <= 8; o <<= 1) { wun0 |= __shfl_xor(wun0, o); wun1 |= __shfl_xor(wun1, o); wun2 |= __shfl_xor(wun2, o); wun3 |= __shfl_xor(wun3, o); }
    int nsl = 0;
    {
      const uint32_t u0 = umask[0], u1 = umask[1], u2 = umask[2], u3 = umask[3];
      nsl = __popc(u0) + __popc(u1) + __popc(u2) + __popc(u3);
      if (tid < 128) {
        const uint32_t uw = tid < 32 ? u0 : tid < 64 ? u1 : tid < 96 ? u2 : u3;
        if ((uw >> (tid & 31)) & 1u) {
          int pos = __popc(uw & ((1u << (tid & 31)) - 1u));
          if (tid >= 32) pos += __popc(u0);
          if (tid >= 64) pos += __popc(u1);
          if (tid >= 96) pos += __popc(u2);
          ulist[pos] = tid;
        }
      }
    }
    __syncthreads();
#pragma unroll
    for (int dt = 0; dt < 4; ++dt) {
      uint2 o2; o2.x = pack2(acc[dt][0], acc[dt][1]); o2.y = pack2(acc[dt][2], acc[dt][3]);
      totl[dt * 64] = o2;
    }
#pragma unroll 1
    for (int br = 1; br < 3; ++br) {
      m = -1e30f; l = 0.f;
#pragma unroll
      for (int dt = 0; dt < 4; ++dt) acc[dt] = (f32x4){0.f, 0.f, 0.f, 0.f};
      int wfirst = ((t0 - 511) >> 6) << 6; if (wfirst < 0) wfirst = 0;
      const int nt = (br == 1) ? nsl : ((qb * 64 - wfirst) >> 6) + 1;
      const int ngrp = (nt + 3) >> 2;
      const u16* kb = U + (size_t)b * SEQ * LDQ + (br == 1 ? 1536 : 1792) + g * 64;
      const u16* vb = VT + (size_t)((br == 1 ? 0 : 256) + g * 64) * MTOK + (size_t)b * SEQ;
#define SRC_S0(i) ((br == 1) ? ulist[nt - 1 - (i)] * 64 : wfirst + 64 * (nt - 1 - (i)))
#define BR_LD(k, i) if ((i) < nt) { const int s_ = SRC_S0(i); LD1(k, kb + (size_t)s_ * LDQ, LDQ, vb + s_, MTOK) }
      BR_LD(0, 0) BR_LD(1, 1) BR_LD(2, 2) BR_LD(3, 3)
#pragma unroll 1
      for (int gi = 0; gi < ngrp; ++gi) {
        const int ib = gi * 4;
        __syncthreads();
        if (ib < nt) ST1(0) if (ib + 1 < nt) ST1(1) if (ib + 2 < nt) ST1(2) if (ib + 3 < nt) ST1(3)
        __syncthreads();
        if (gi + 1 < ngrp) { BR_LD(0, ib + 4) BR_LD(1, ib + 5) BR_LD(2, ib + 6) BR_LD(3, ib + 7) }
#pragma unroll 1
        for (int k = 0; k < 4; ++k) {
          const int i = ib + k;
          if (i < nt) {
            const int s0 = SRC_S0(i);
            bool wsel = true, ls = true;
            int wl = 512;
            if (br == 1) {
              const int j = s0 >> 6, jw = j >> 5, jb = j & 31;
              const uint32_t ww = jw == 0 ? wun0 : jw == 1 ? wun1 : jw == 2 ? wun2 : wun3;
              const uint32_t sw = jw == 0 ? sel0 : jw == 1 ? sel1 : jw == 2 ? sel2 : sel3;
              wsel = (ww >> jb) & 1u; ls = (sw >> jb) & 1u; wl = BIG;
            }
            if (wsel) {
              const int dminw = tq0w - (s0 + 63);
              if (dminw > 0 && slope2 * (float)dminw > (br == 1 ? T_slc : T_win)) wsel = false;
            }
            if (wsel) {
              const int tq0 = t0 + 16 * qt;
              const bool interior = (s0 + 63 <= tq0) && (br == 1 || s0 + 512 > tq0 + 15);
              if (interior) nsa_tile_interior(SLOT(k), SLOT(k) + 64 * TS, q, acc, m, l, slope2, sk, t, s0, ls, lane);
              else nsa_tile<2>(SLOT(k), SLOT(k) + 64 * TS, q, acc, m, l, slope2, g1, t, s0, 1, wl, ls, imp_row, 0, carry, lane);
            }
          }
        }
      }
      {
        float lt = l; lt += __shfl_xor(lt, 16); lt += __shfl_xor(lt, 32);
        const float gt = sigmoid_f(GL[mrow * 48 + h * 3 + br] + p.o_bg[h * 3 + br]);
        const float sc = lt > 0.f ? gt / lt : 0.f;
#pragma unroll
        for (int dt = 0; dt < 4; ++dt) {
          const uint2 pv = totl[dt * 64];
          const float r0 = bf2f(pv.x & 0xffff) + acc[dt][0] * sc, r1 = bf2f(pv.x >> 16) + acc[dt][1] * sc;
          const float r2 = bf2f(pv.y & 0xffff) + acc[dt][2] * sc, r3 = bf2f(pv.y >> 16) + acc[dt][3] * sc;
          if (br == 1) {
            uint2 o2; o2.x = pack2(r0, r1); o2.y = pack2(r2, r3);
            totl[dt * 64] = o2;
          } else {
            const int col = h * 64 + dt * 16 + gk * 4;
            const uint2 zz = *(const uint2*)(U + mrow * LDQ + 2048 + col);
            const float z0 = bf2f(zz.x & 0xffff), z1 = bf2f(zz.x >> 16), z2 = bf2f(zz.y & 0xffff), z3 = bf2f(zz.y >> 16);
            uint2 ov;
            ov.x = pack2(r0 * silu_f(z0), r1 * silu_f(z1));
            ov.y = pack2(r2 * silu_f(z2), r3 * silu_f(z3));
            *(uint2*)(Y + mrow * DM + col) = ov;
          }
        }
      }
    }
#undef SLOT
#undef LD1
#undef ST1
#undef CMP_LD
#undef SRC_S0
#undef BR_LD
  }
}

__device__ __forceinline__ void final_norm(const Params& p) {
  const int lane = TIDX & 63, wave = TIDX >> 6;
  for (int row = BIDX * NWAVE + wave; row < MTOK; row += gridDim.x * NWAVE) {
    float4* xr = (float4*)(p.out + (size_t)row * DM);
    float4 v[4];
    float ss = 0.f;
#pragma unroll
    for (int i = 0; i < 4; ++i) {
      v[i] = xr[lane + 64 * i];
      ss += v[i].x * v[i].x + v[i].y * v[i].y + v[i].z * v[i].z + v[i].w * v[i].w;
    }
#pragma unroll
    for (int o = 32; o >= 1; o >>= 1) ss += __shfl_xor(ss, o);
    const float rstd = rsqrtf(ss * (1.f / DM) + 1e-6f);
#pragma unroll
    for (int i = 0; i < 4; ++i) {
      const float4 gg = ((const float4*)p.fin_g)[lane + 64 * i];
      xr[lane + 64 * i] = (float4){v[i].x * rstd * gg.x, v[i].y * rstd * gg.y, v[i].z * rstd * gg.z, v[i].w * rstd * gg.w};
    }
  }
}

__device__ __forceinline__ void grid_bar(const Params& p, unsigned& target) {
  __syncthreads();
  target += gridDim.x;
  if (TIDX == 0) {
    unsigned* ctr = (unsigned*)(p.ws + WS_BAR);
    __threadfence();
    __hip_atomic_fetch_add(ctr, 1u, __ATOMIC_RELAXED, __HIP_MEMORY_SCOPE_AGENT);
    while (__hip_atomic_load(ctr, __ATOMIC_RELAXED, __HIP_MEMORY_SCOPE_AGENT) < target) __builtin_amdgcn_s_sleep(1);
    __threadfence();
  }
  __syncthreads();
}

__device__ __forceinline__ void nsa_knorm(const Params& p) {
  if (BIDX < 64) return;
  const u16* U = (const u16*)(p.ws + WS_QK);
  uint32_t* km = (uint32_t*)(p.ws + WS_KMAX);
  const int tid = TIDX, lane = tid & 63, wave = tid >> 6;
  float mx = 0.f;
  for (int row = (BIDX - 64) * NWAVE + wave; row < MTOK; row += (gridDim.x - 64) * NWAVE) {
    const uint4 v = *(const uint4*)(U + (size_t)row * LDQ + 1536 + lane * 8);
    const float a0 = bf2f(v.x & 0xffff), a1 = bf2f(v.x >> 16), a2 = bf2f(v.y & 0xffff), a3 = bf2f(v.y >> 16);
    const float a4 = bf2f(v.z & 0xffff), a5 = bf2f(v.z >> 16), a6 = bf2f(v.w & 0xffff), a7 = bf2f(v.w >> 16);
    float ss = a0 * a0 + a1 * a1 + a2 * a2 + a3 * a3 + a4 * a4 + a5 * a5 + a6 * a6 + a7 * a7;
    ss += __shfl_xor(ss, 1); ss += __shfl_xor(ss, 2); ss += __shfl_xor(ss, 4);
    mx = fmaxf(mx, ss);
  }
  if ((lane & 7) == 0) atomicMax(&km[8 + (lane >> 3)], __float_as_uint(mx));
}

__global__ void __launch_bounds__(NTHR, 2) mega(Params p_in) {
  Params p = p_in;
  p.pad = __builtin_amdgcn_readfirstlane((int)threadIdx.x >> 6);
  unsigned bar_target = 0u;
  extern __shared__ __attribute__((aligned(16))) unsigned char lds_raw[];
  u16* lds = (u16*)lds_raw;
  cg::grid_group grid = cg::this_grid();
  if (p_in.coop == 2) grid.sync();
#define PH_ON(k) (p.ph_lo <= (k) && (k) <= p.ph_hi)
#define PH_SYNC(k) if (p.coop && p.ph_lo <= (k) && (k) < p.ph_hi) grid_bar(p, bar_target);
  if (PH_ON(0)) {
    rms_rows_fl(p, (float*)lds);
    conv_t(p, (u16*)(p.ws + WS_WT0), p.e_win, 1024, 4104, 4352, 0);
    conv_t(p, (u16*)(p.ws + WS_WT1), p.o_win, 1024, 3632, 3840, 1);
    conv_t(p, (u16*)(p.ws + WS_WO0), p.e_wout, 1024, 1024, 1024, 2);
    conv_t(p, (u16*)(p.ws + WS_WO1), p.o_wout, 1024, 1024, 1024, 2);
    conv_t(p, (u16*)(p.ws + WS_W1K), p.o_wk1, 2048, 256, 256, 2);
    conv_t(p, (u16*)(p.ws + WS_W1V), p.o_wv1, 2048, 256, 256, 2);
    conv_t(p, (u16*)(p.ws + WS_W2K), p.o_wk2, 256, 64, 256, 2);
    conv_t(p, (u16*)(p.ws + WS_W2V), p.o_wv2, 256, 64, 256, 2);
    pe_partial(p);
    if (BIDX == 0 && TIDX < 32) ((uint32_t*)(p.ws + WS_KMAX))[TIDX] = 0u;
    for (int i = BIDX * NTHR + TIDX; i < MTOK; i += gridDim.x * NTHR) ((float*)(p.ws + WS_SSQ))[i] = 0.f;
  }
  PH_SYNC(0)
  if (PH_ON(1)) gemm_inproj(p, 0, lds, 0);
  PH_SYNC(1)
  if (PH_ON(2)) {
    fox_scan(p, (float*)lds); ret_stepA(p); fox_knorm(p);
    if (BIDX == gridDim.x - 1) {
      for (int i = TIDX; i < 512; i += NTHR) {
        const float* part = (const float*)(p.ws + WS_PEP);
        float sum = 0.f;
        for (int kc = 0; kc < 16; ++kc) sum += part[((i >> 8) * 16 + kc) * 256 + (i & 255)];
        ((float*)(p.ws + WS_PEB))[i] = sum;
      }
    }
  }
  PH_SYNC(2)
  if (PH_ON(3)) { ret_stepB(p); fox_phase(p, lds); }
  PH_SYNC(3)
  if (PH_ON(4)) ret_stepC(p, lds);
  PH_SYNC(4)
  if (PH_ON(5)) gemm_outproj(p, 0, lds);
  PH_SYNC(5)
  if (PH_ON(7)) gemm_inproj(p, 1, lds, 0);
  PH_SYNC(7)
  if (PH_ON(8)) { gemm_cmp1(p, lds); gemm_inproj(p, 1, lds, 1); nsa_knorm(p); }
  PH_SYNC(8)
  if (PH_ON(10)) nsa_phase(p, lds);
  PH_SYNC(10)
  if (PH_ON(11)) gemm_outproj(p, 1, lds);
  PH_SYNC(11)
  if (PH_ON(12)) final_norm(p);
}

extern "C" void kernel_launch(void* const* d_in, const int* in_sizes, int n_in, void* d_out, int out_size, void* d_ws,
                              size_t ws_size, hipStream_t stream) {
  static int grid_blocks = 0;
  if (!grid_blocks) {
    int dev = 0, cus = 0, per_cu = 0;
    hipGetDevice(&dev);
    hipDeviceGetAttribute(&cus, hipDeviceAttributeMultiprocessorCount, dev);
    hipFuncSetAttribute((const void*)mega, hipFuncAttributeMaxDynamicSharedMemorySize, LDS_BYTES);
    hipOccupancyMaxActiveBlocksPerMultiprocessor(&per_cu, (const void*)mega, NTHR, LDS_BYTES);
    if (per_cu < 1) per_cu = 1;
    if (per_cu > 1) per_cu = 1;
    grid_blocks = cus * per_cu;
    (void)hipGetLastError();
  }
  Params p{};
  p.x = (const float*)d_in[0]; p.e_ng = (const float*)d_in[1]; p.e_win = (const float*)d_in[2];
  p.e_bf = (const float*)d_in[3]; p.e_gn = (const float*)d_in[4]; p.e_wout = (const float*)d_in[5];
  p.o_ng = (const float*)d_in[6]; p.o_win = (const float*)d_in[7]; p.o_bg = (const float*)d_in[8];
  p.o_pek = (const float*)d_in[9]; p.o_pev = (const float*)d_in[10]; p.o_wk1 = (const float*)d_in[11];
  p.o_wk2 = (const float*)d_in[12]; p.o_wv1 = (const float*)d_in[13]; p.o_wv2 = (const float*)d_in[14];
  p.o_wout = (const float*)d_in[15]; p.fin_g = (const float*)d_in[16];
  p.out = (float*)d_out; p.ws = (unsigned char*)d_ws;
#if ONE_LAUNCH
  p.ph_lo = 0; p.ph_hi = NPHASE - 1; p.coop = 1;
  (void)hipMemsetAsync((unsigned char*)d_ws + WS_BAR, 0, 64, stream);
  void* args[] = {&p};
  hipError_t e = hipLaunchCooperativeKernel((const void*)mega, dim3(grid_blocks), dim3(NTHR), args, LDS_BYTES, stream);
  if (e != hipSuccess) fprintf(stderr, "cooperative launch failed: %s (grid %d)\n", hipGetErrorString(e), grid_blocks);
#else
  for (int ph = 0; ph < NPHASE; ++ph) {
    p.ph_lo = ph; p.ph_hi = ph; p.coop = 0;
    hipLaunchKernelGGL(mega, dim3(grid_blocks), dim3(NTHR), LDS_BYTES, stream, p);
  }
#endif
}
```

```cpp
#include <hip/hip_runtime.h>
#include <hip/hip_cooperative_groups.h>
#include <stdint.h>
#include <stdio.h>
namespace cg = cooperative_groups;

typedef unsigned short u16;
typedef short bf16x8 __attribute__((ext_vector_type(8)));
typedef short bf16x4 __attribute__((ext_vector_type(4)));
typedef float f32x4 __attribute__((ext_vector_type(4)));

#ifndef ONE_LAUNCH
#define ONE_LAUNCH 1
#endif

#define MTOK 32768
#define SEQ 8192
#define DM 1024
#define LDQ 3072
#define LOG2E 1.4426950408889634f
#define TS 72
#define IMPS 132
#define LDS_BYTES 147520
#define NTHR 512
#define NWAVE 8
#define NPHASE 13

#define MiB (1024ull * 1024ull)
#define WS_HBF   (0ull)
#define WS_DS    (0ull)
#define WS_ST    (32ull * MiB)
#define WS_QK    (64ull * MiB)
#define WS_VT    (256ull * MiB)
#define WS_Y     (352ull * MiB)
#define WS_WT0   (416ull * MiB)
#define WS_WT1   (WS_WT0 + 4352ull * 1024 * 2)
#define WS_WO0   (WS_WT1 + 3840ull * 1024 * 2)
#define WS_WO1   (WS_WO0 + 1024ull * 1024 * 2)
#define WS_W1K   (WS_WO1 + 1024ull * 1024 * 2)
#define WS_W1V   (WS_W1K + 256ull * 2048 * 2)
#define WS_W2K   (WS_W1V + 256ull * 2048 * 2)
#define WS_W2V   (WS_W2K + 256ull * 256 * 2)
#define WS_FLOG  (440ull * MiB)
#define WS_CFOX  (441ull * MiB)
#define WS_GL    (442ull * MiB)
#define WS_HC    (448ull * MiB)
#define WS_KCMP  (456ull * MiB)
#define WS_VCMPT (457ull * MiB)
#define WS_PEP   (458ull * MiB)
#define WS_PEB   (WS_PEP + 65536ull)
#define WS_KMAX  (WS_PEB + 4096ull)
#define WS_SSQ   (459ull * MiB)
#define WS_BAR   (460ull * MiB)

struct Params {
  const float *x, *e_ng, *e_win, *e_bf, *e_gn, *e_wout;
  const float *o_ng, *o_win, *o_bg, *o_pek, *o_pev, *o_wk1, *o_wk2, *o_wv1, *o_wv2, *o_wout, *fin_g;
  float* out;
  unsigned char* ws;
  int ph_lo, ph_hi, coop, pad;
};

typedef __bf16 bf16v2 __attribute__((ext_vector_type(2)));
typedef float f32v2 __attribute__((ext_vector_type(2)));
__device__ __forceinline__ uint32_t pack2(float a, float b) {
  f32v2 v = {a, b};
  bf16v2 r = __builtin_convertvector(v, bf16v2);
  return *(uint32_t*)&r;
}
__device__ __forceinline__ u16 f2bf(float f) { return (u16)(pack2(f, 0.f) & 0xffffu); }
__device__ __forceinline__ float bf2f(u16 h) { return __uint_as_float(((uint32_t)h) << 16); }
__device__ __forceinline__ float ex2(float x) { return __builtin_amdgcn_exp2f(x); }
__device__ __forceinline__ float silu_f(float z) { return z * __builtin_amdgcn_rcpf(1.f + ex2(-z * LOG2E)); }
__device__ __forceinline__ float sigmoid_f(float z) { return __builtin_amdgcn_rcpf(1.f + ex2(-z * LOG2E)); }

__device__ __forceinline__ int opq(int v) { asm volatile("" : "+v"(v)); return v; }
__device__ __forceinline__ int opqs(int v) { asm volatile("" : "+s"(v)); return v; }
#define TIDX opq(p.pad * 64 + (int)__lane_id())
#define BIDX opqs((int)blockIdx.x)
#define MFMA(a, b, c) __builtin_amdgcn_mfma_f32_16x16x32_bf16((a), (b), (c), 0, 0, 0)

__device__ __forceinline__ void rms_rows(const Params& p, const float* __restrict__ x, const float* __restrict__ g, u16* __restrict__ h) {
  const int lane = TIDX & 63, wave = TIDX >> 6;
  for (int row = BIDX * NWAVE + wave; row < MTOK; row += gridDim.x * NWAVE) {
    const float4* xr = (const float4*)(x + (size_t)row * DM);
    float4 v[4];
    float ss = 0.f;
#pragma unroll
    for (int i = 0; i < 4; ++i) {
      v[i] = xr[lane + 64 * i];
      ss += v[i].x * v[i].x + v[i].y * v[i].y + v[i].z * v[i].z + v[i].w * v[i].w;
    }
#pragma unroll
    for (int o = 32; o >= 1; o >>= 1) ss += __shfl_xor(ss, o);
    const float rstd = rsqrtf(ss * (1.f / DM) + 1e-6f);
#pragma unroll
    for (int i = 0; i < 4; ++i) {
      float4 gg = ((const float4*)g)[lane + 64 * i];
      uint2 o;
      o.x = pack2(v[i].x * rstd * gg.x, v[i].y * rstd * gg.y);
      o.y = pack2(v[i].z * rstd * gg.z, v[i].w * rstd * gg.w);
      *(uint2*)(h + (size_t)row * DM + (lane + 64 * i) * 4) = o;
    }
  }
}

__device__ __forceinline__ void rms_rows_fl(const Params& p, float* ldsf) {
  const float* __restrict__ x = p.x; const float* __restrict__ g = p.e_ng;
  u16* __restrict__ h = (u16*)(p.ws + WS_HBF);
  float* __restrict__ fl = (float*)(p.ws + WS_FLOG);
  const int tid = TIDX, lane = tid & 63, wave = tid >> 6;
  for (int i = tid; i < 8 * DM; i += NTHR) { const int j = i >> 10, k = i & 1023; ldsf[i] = g[k] * p.e_win[(size_t)k * 4104 + 1536 + j]; }
  __syncthreads();
  for (int row = BIDX * NWAVE + wave; row < MTOK; row += gridDim.x * NWAVE) {
    const float4* xr = (const float4*)(x + (size_t)row * DM);
    float4 v[4];
    float ss = 0.f;
#pragma unroll
    for (int i = 0; i < 4; ++i) {
      v[i] = xr[lane + 64 * i];
      ss += v[i].x * v[i].x + v[i].y * v[i].y + v[i].z * v[i].z + v[i].w * v[i].w;
    }
#pragma unroll
    for (int o = 32; o >= 1; o >>= 1) ss += __shfl_xor(ss, o);
    const float rstd = rsqrtf(ss * (1.f / DM) + 1e-6f);
#pragma unroll
    for (int i = 0; i < 4; ++i) {
      float4 gg = ((const float4*)g)[lane + 64 * i];
      uint2 o;
      o.x = pack2(v[i].x * rstd * gg.x, v[i].y * rstd * gg.y);
      o.y = pack2(v[i].z * rstd * gg.z, v[i].w * rstd * gg.w);
      *(uint2*)(h + (size_t)row * DM + (lane + 64 * i) * 4) = o;
    }
    float myf = 0.f;
#pragma unroll
    for (int j = 0; j < 8; ++j) {
      float d = 0.f;
#pragma unroll
      for (int i = 0; i < 4; ++i) {
        const float4 w4 = *(const float4*)(ldsf + j * DM + (lane + 64 * i) * 4);
        d += v[i].x * w4.x + v[i].y * w4.y + v[i].z * w4.z + v[i].w * w4.w;
      }
#pragma unroll
      for (int o = 32; o >= 1; o >>= 1) d += __shfl_xor(d, o);
      if (lane == j) myf = d * rstd;
    }
    if (lane < 8) fl[(size_t)row * 8 + lane] = myf;
  }
}

__device__ __forceinline__ int map_col(int MAP, int n) {
  if (MAP == 0) {
    if (n < 1024) return n;
    if (n < 2048) return n + 520;
    if (n < 3072) return n + 1032;
    if (n < 3584) return n - 2048;
    if (n < 4096) return n - 1016;
    if (n < 4104) return n - 2560;
    return -1;
  } else if (MAP == 1) {
    if (n < 1792) return n;
    if (n < 2048) return n + 256;
    if (n < 3072) return n + 560;
    if (n < 3328) return n - 1280;
    if (n < 3584) return n - 1024;
    if (n < 3632) return n - 1024;
    return -1;
  } else if (MAP == 2) {
    return n;
  }
  return n;
}

__device__ __forceinline__ void conv_t(const Params& p, u16* __restrict__ dst, const float* __restrict__ src, int K, int nsrc, int ndst, int MAP) {
  const int total = ndst * (K >> 3);
  for (int id = BIDX * NTHR + TIDX; id < total; id += gridDim.x * NTHR) {
    const int n = id % ndst, kc = id / ndst;
    const int sc = map_col(MAP, n);
    float v[8];
#pragma unroll
    for (int i = 0; i < 8; ++i) v[i] = (sc >= 0 && sc < nsrc) ? src[(size_t)(kc * 8 + i) * nsrc + sc] : 0.f;
    uint4 o;
    o.x = pack2(v[0], v[1]); o.y = pack2(v[2], v[3]); o.z = pack2(v[4], v[5]); o.w = pack2(v[6], v[7]);
    *(uint4*)(dst + (size_t)n * K + kc * 8) = o;
  }
}

__device__ __forceinline__ void pe_partial(const Params& p) {
  float* part = (float*)(p.ws + WS_PEP);
  for (int task = BIDX; task < 32; task += gridDim.x) {
    const int kv = task >> 4, kc = task & 15, n = TIDX;
    if (n >= 256) continue;
    const float* pe = kv ? p.o_pev : p.o_pek;
    const float* w1 = kv ? p.o_wv1 : p.o_wk1;
    float acc = 0.f;
#pragma unroll 16
    for (int k = kc * 128; k < kc * 128 + 128; ++k) acc += pe[k] * w1[(size_t)k * 256 + n];
    part[(kv * 16 + kc) * 256 + n] = acc;
  }
}

#define GST (512 * TS)
template <bool swapped>
__device__ __forceinline__ void gemm_compute(const u16* cur, f32x4 (&acc)[8][4], int wpa, int wpb, int l16, int gk) {
  const u16* sA = cur + (wpa * 128 + l16) * TS + gk * 8;
  const u16* sB = cur + (256 + wpb * 64 + l16) * TS + gk * 8;
#pragma unroll 1
  for (int kk = 0; kk < 2; ++kk) {
    bf16x8 fa[8], fb[4];
#pragma unroll
    for (int i = 0; i < 8; ++i) fa[i] = *(const bf16x8*)(sA + i * 16 * TS + kk * 32);
#pragma unroll
    for (int j = 0; j < 4; ++j) fb[j] = *(const bf16x8*)(sB + j * 16 * TS + kk * 32);
    if (swapped) {
#pragma unroll
      for (int i = 0; i < 8; ++i)
#pragma unroll
        for (int j = 0; j < 4; ++j) acc[i][j] = MFMA(fb[j], fa[i], acc[i][j]);
    } else {
#pragma unroll
      for (int i = 0; i < 8; ++i)
#pragma unroll
        for (int j = 0; j < 4; ++j) acc[i][j] = MFMA(fa[i], fb[j], acc[i][j]);
    }
  }
}
template <bool swapped>
__device__ __forceinline__ void gemm_mainloop(const Params& p, const u16* __restrict__ Ab, const uint32_t (&pa)[4], const u16* __restrict__ Bb,
                                              const uint32_t (&pb)[4], int a_kstride, int nk,
                                              u16* lds, f32x4 (&acc)[8][4]) {
  const int tid = TIDX, lane = tid & 63, wave = tid >> 6;
  const int l16 = lane & 15, gk = lane >> 4;
  const int wpa = wave >> 2, wpb = wave & 3;
  const int woff = (tid >> 3) * TS + (tid & 7) * 8;
  uint4 ra0, ra1, ra2, ra3, rb0, rb1, rb2, rb3;
#define G_LD(kidx) { const u16* Ap_ = Ab + (size_t)(kidx) * a_kstride; const u16* Bp_ = Bb + (size_t)(kidx) * 64;   \
    ra0 = *(const uint4*)(Ap_ + pa[0]); ra1 = *(const uint4*)(Ap_ + pa[1]); ra2 = *(const uint4*)(Ap_ + pa[2]); ra3 = *(const uint4*)(Ap_ + pa[3]); \
    rb0 = *(const uint4*)(Bp_ + pb[0]); rb1 = *(const uint4*)(Bp_ + pb[1]); rb2 = *(const uint4*)(Bp_ + pb[2]); rb3 = *(const uint4*)(Bp_ + pb[3]); }
#define G_ST(D) { u16* D_ = (D) + woff;                                                                               \
    *(uint4*)(D_) = ra0; *(uint4*)(D_ + 64 * TS) = ra1; *(uint4*)(D_ + 128 * TS) = ra2; *(uint4*)(D_ + 192 * TS) = ra3;  \
    *(uint4*)(D_ + 256 * TS) = rb0; *(uint4*)(D_ + 320 * TS) = rb1; *(uint4*)(D_ + 384 * TS) = rb2; *(uint4*)(D_ + 448 * TS) = rb3; }
  G_LD(0)
  __syncthreads();
  G_ST(lds)
  __syncthreads();
#pragma unroll
  for (int i = 0; i < 8; ++i)
#pragma unroll
    for (int j = 0; j < 4; ++j) acc[i][j] = (f32x4){0.f, 0.f, 0.f, 0.f};
#pragma unroll 1
  for (int ks = 0; ks < nk; ++ks) {
    const bool more = (ks + 1 < nk);
    if (more) G_LD(ks + 1)
    gemm_compute<swapped>(lds + (ks & 1) * GST, acc, wpa, wpb, l16, gk);
    if (more) G_ST(lds + ((ks + 1) & 1) * GST)
    __syncthreads();
  }
#undef G_LD
#undef G_ST
}
#define GEMM_OFFS(rowstrideA, rowstrideB)                                   \
  uint32_t pa[4], pb[4];                                                    \
  _Pragma("unroll") for (int i = 0; i < 4; ++i) {                           \
    pa[i] = (uint32_t)((tid >> 3) + 64 * i) * (rowstrideA) + (tid & 7) * 8; \
    pb[i] = (uint32_t)((tid >> 3) + 64 * i) * (rowstrideB) + (tid & 7) * 8; \
  }

__device__ __forceinline__ void gemm_inproj(const Params& p, int layer, u16* lds, int part) {
  const u16* A = (const u16*)(p.ws + WS_HBF);
  const u16* Bt = (const u16*)(p.ws + (layer ? WS_WT1 : WS_WT0));
  u16* QK = (u16*)(p.ws + WS_QK);
  u16* VT = (u16*)(p.ws + WS_VT);
  float* F = (float*)(p.ws + (layer ? WS_GL : WS_FLOG));
  const int NT = layer ? 14 : 16;
  const int seg_trans_end = layer ? 28 : 32;
  const int nvalidF = layer ? 48 : 8, ldf = layer ? 48 : 8;
  const int tid = TIDX, lane = tid & 63, wave = tid >> 6, l16 = lane & 15, gk = lane >> 4;
  const int wpa = wave >> 2, wpb = wave & 3;
  const int bid = BIDX, xcd = bid & 7, nloc = (int)gridDim.x >> 3;
  const int qbeg = part ? bid - 64 : (bid >> 3), qend = part ? (bid >= 64 ? 128 : -(1 << 20)) : 16 * NT, qstep = part ? (int)gridDim.x - 64 : nloc;
  for (int q = qbeg; q < qend; q += qstep) {
    const int mt = part ? q : xcd * 16 + q / NT, nt = part ? NT : q % NT;
    const int m0 = mt * 256, n0 = nt * 256;
    const int mw = m0 + wpa * 128, nw = n0 + wpb * 64;
    const int seg = nw >> 7;
    int mode;
    if (seg < 24) mode = (layer == 0 && seg >= 12 && seg < 16) ? 2 : 0;
    else if (seg < seg_trans_end) mode = 1;
    else if (seg == seg_trans_end) mode = 3;
    else mode = 4;
    const int seg0 = nt * 2;
    const bool swapped = !((seg0 >= 24 && seg0 < seg_trans_end) || (layer == 0 && seg0 >= 12 && seg0 < 16));
    GEMM_OFFS(DM, DM)
    f32x4 acc[8][4];
    if (swapped) gemm_mainloop<true>(p, A + (size_t)m0 * DM, pa, Bt + (size_t)n0 * DM, pb, 64, 16, lds, acc);
    else gemm_mainloop<false>(p, A + (size_t)m0 * DM, pa, Bt + (size_t)n0 * DM, pb, 64, 16, lds, acc);
    const float* ssq_g = (const float*)(p.ws + WS_SSQ);
    if (mode == 0 || mode == 3) {
#pragma unroll
      for (int i = 0; i < 8; ++i) {
        const int m = mw + i * 16 + l16;
        const float rs = layer ? rsqrtf(ssq_g[m] * (1.f / DM) + 1e-6f) : 1.f;
#pragma unroll
        for (int j = 0; j < 4; ++j) {
          const int n = nw + j * 16 + gk * 4;
          const float a0 = acc[i][j][0] * rs, a1 = acc[i][j][1] * rs, a2 = acc[i][j][2] * rs, a3 = acc[i][j][3] * rs;
          if (mode == 0) {
            uint2 o; o.x = pack2(a0, a1); o.y = pack2(a2, a3);
            *(uint2*)(QK + (size_t)m * LDQ + n) = o;
          } else {
            const int nn = n - seg * 128;
            if (nn < nvalidF) *(float4*)(F + (size_t)m * ldf + nn) = (float4){a0, a1, a2, a3};
          }
        }
      }
    } else if (mode == 1 || mode == 2) {
#pragma unroll
      for (int i = 0; i < 8; ++i) {
        const int m = mw + i * 16 + gk * 4;
        float rs0 = 1.f, rs1 = 1.f, rs2 = 1.f, rs3 = 1.f;
        if (layer) {
          const float4 q4 = *(const float4*)(ssq_g + m);
          rs0 = rsqrtf(q4.x * (1.f / DM) + 1e-6f); rs1 = rsqrtf(q4.y * (1.f / DM) + 1e-6f);
          rs2 = rsqrtf(q4.z * (1.f / DM) + 1e-6f); rs3 = rsqrtf(q4.w * (1.f / DM) + 1e-6f);
        }
#pragma unroll
        for (int j = 0; j < 4; ++j) {
          const int n = nw + j * 16 + l16;
          const float a0 = acc[i][j][0] * rs0, a1 = acc[i][j][1] * rs1, a2 = acc[i][j][2] * rs2, a3 = acc[i][j][3] * rs3;
          if (mode == 1) {
            const int trow = n - 3072;
            uint2 o; o.x = pack2(a0, a1); o.y = pack2(a2, a3);
            *(uint2*)(VT + (size_t)trow * MTOK + m) = o;
          } else {
            const int trow = n - 512;
            const int h = (nw - 1536) >> 6;
            const float lg2 = log1pf(-exp2f(-5.f - (float)h)) * LOG2E;
            const float lane_dec = 0.125f * ex2(lg2 * (float)(127 - gk * 4));
            QK[(size_t)(m + 0) * LDQ + n] = f2bf(a0); QK[(size_t)(m + 1) * LDQ + n] = f2bf(a1);
            QK[(size_t)(m + 2) * LDQ + n] = f2bf(a2); QK[(size_t)(m + 3) * LDQ + n] = f2bf(a3);
            const float s0 = a0 * lane_dec * ex2(lg2 * (float)(-(i * 16 + 0))), s1 = a1 * lane_dec * ex2(lg2 * (float)(-(i * 16 + 1)));
            const float s2 = a2 * lane_dec * ex2(lg2 * (float)(-(i * 16 + 2))), s3 = a3 * lane_dec * ex2(lg2 * (float)(-(i * 16 + 3)));
            uint2 o; o.x = pack2(s0, s1); o.y = pack2(s2, s3);
            *(uint2*)(VT + (size_t)trow * MTOK + m) = o;
          }
        }
      }
    }
  }
}

__device__ __forceinline__ void gemm_outproj(const Params& p, int layer, u16* lds) {
  const u16* A = (const u16*)(p.ws + WS_Y);
  const u16* Bt = (const u16*)(p.ws + (layer ? WS_WO1 : WS_WO0));
  const float* res = layer ? p.out : p.x;
  float* out = p.out;
  u16* hb_out = (u16*)(p.ws + WS_HBF);
  float* ssq_g = (float*)(p.ws + WS_SSQ);
  const int tid = TIDX, lane = tid & 63, wave = tid >> 6, l16 = lane & 15, gk = lane >> 4;
  const int wpa = wave >> 2, wpb = wave & 3;
  const int bid = BIDX, xcd = bid & 7, nloc = (int)gridDim.x >> 3;
  for (int q = bid >> 3; q < 16 * 4; q += nloc) {
    const int mt = xcd * 16 + (q >> 2), nt = q & 3;
    const int m0 = mt * 256, n0 = nt * 256;
    GEMM_OFFS(DM, DM)
    f32x4 acc[8][4];
    gemm_mainloop<true>(p, A + (size_t)m0 * DM, pa, Bt + (size_t)n0 * DM, pb, 64, 16, lds, acc);
    const int tid2 = TIDX, lane2 = tid2 & 63, wave2 = tid2 >> 6, l16b = lane2 & 15, gkb = lane2 >> 4;
    const int mw = m0 + (wave2 >> 2) * 128, nw = n0 + (wave2 & 3) * 64;
#pragma unroll
    for (int i = 0; i < 8; ++i) {
      const int m = mw + i * 16 + l16b;
      float sq = 0.f;
#pragma unroll
      for (int j = 0; j < 4; ++j) {
        const int n = nw + j * 16 + gkb * 4;
        const float4 r = *(const float4*)(res + (size_t)m * DM + n);
        const float4 v = (float4){r.x + acc[i][j][0], r.y + acc[i][j][1], r.z + acc[i][j][2], r.w + acc[i][j][3]};
        *(float4*)(out + (size_t)m * DM + n) = v;
        if (layer == 0) {
          const float4 gg = *(const float4*)(p.o_ng + n);
          uint2 hb; hb.x = pack2(v.x * gg.x, v.y * gg.y); hb.y = pack2(v.z * gg.z, v.w * gg.w);
          *(uint2*)(hb_out + (size_t)m * DM + n) = hb;
          sq += v.x * v.x + v.y * v.y + v.z * v.z + v.w * v.w;
        }
      }
      if (layer == 0) {
        sq += __shfl_xor(sq, 16); sq += __shfl_xor(sq, 32);
        if (gkb == 0) atomicAdd(ssq_g + m, sq);
      }
    }
  }
}

__device__ __forceinline__ void gemm_cmp2_tile(const Params& p, u16* lds, int kv, int mt) {
  const int tid = TIDX, lane = tid & 63, wave = tid >> 6, l16 = lane & 15, gk = lane >> 4;
  const int wpa = wave >> 2, wpb = wave & 3;
  {
    const int m0 = mt * 256;
    const u16* A = (const u16*)(p.ws + WS_HC) + (size_t)kv * 8192 * 256;
    const u16* Bt = (const u16*)(p.ws + (kv ? WS_W2V : WS_W2K));
    GEMM_OFFS(256, 256)
    f32x4 acc[8][4];
    const bool swapped = (kv == 0);
    if (swapped) gemm_mainloop<true>(p, A + (size_t)m0 * 256, pa, Bt, pb, 64, 4, lds, acc);
    else gemm_mainloop<false>(p, A + (size_t)m0 * 256, pa, Bt, pb, 64, 4, lds, acc);
    const int mw = m0 + wpa * 128, nw = wpb * 64;
    if (swapped) {
      u16* kc_ = (u16*)(p.ws + WS_KCMP);
#pragma unroll
      for (int i = 0; i < 8; ++i)
#pragma unroll
        for (int j = 0; j < 4; ++j) {
          const int n = nw + j * 16 + gk * 4;
          const int m = mw + i * 16 + l16;
          if (n < 64) {
            uint2 o; o.x = pack2(acc[i][j][0], acc[i][j][1]); o.y = pack2(acc[i][j][2], acc[i][j][3]);
            *(uint2*)(kc_ + (size_t)m * 64 + n) = o;
          }
        }
      if (wpb == 0) {
        float mxn = 0.f;
#pragma unroll
        for (int i = 0; i < 8; ++i) {
          float ss = 0.f;
#pragma unroll
          for (int j = 0; j < 4; ++j) ss += acc[i][j][0] * acc[i][j][0] + acc[i][j][1] * acc[i][j][1] + acc[i][j][2] * acc[i][j][2] + acc[i][j][3] * acc[i][j][3];
          ss += __shfl_xor(ss, 16); ss += __shfl_xor(ss, 32);
          mxn = fmaxf(mxn, ss);
        }
#pragma unroll
        for (int o2 = 1; o2 <= 8; o2 <<= 1) mxn = fmaxf(mxn, __shfl_xor(mxn, o2));
        if (lane == 0) atomicMax((uint32_t*)(p.ws + WS_KMAX) + 16 + ((mw >> 9) & 3), __float_as_uint(mxn));
      }
    } else {
      u16* vt = (u16*)(p.ws + WS_VCMPT);
#pragma unroll
      for (int i = 0; i < 8; ++i)
#pragma unroll
        for (int j = 0; j < 4; ++j) {
          const int m = mw + i * 16 + gk * 4;
          const int n = nw + j * 16 + l16;
          if (n < 64) {
            uint2 o; o.x = pack2(acc[i][j][0], acc[i][j][1]); o.y = pack2(acc[i][j][2], acc[i][j][3]);
            *(uint2*)(vt + (size_t)(m >> 9) * 32768 + (size_t)n * 512 + (m & 511)) = o;
          }
        }
    }
  }
}

__device__ __forceinline__ void gemm_cmp1(const Params& p, u16* lds) {
  const u16* U = (const u16*)(p.ws + WS_QK);
  const float* peb = (const float*)(p.ws + WS_PEB);
  const int tid = TIDX, lane = tid & 63, wave = tid >> 6, l16 = lane & 15, gk = lane >> 4;
  const int wpa = wave >> 2, wpb = wave & 3;
  for (int tile = BIDX; tile < 64; tile += gridDim.x) {
    const int kv = tile >> 5, mt = tile & 31;
    const int m0 = mt * 256;
    const u16* Bt = (const u16*)(p.ws + (kv ? WS_W1V : WS_W1K));
    u16* Hc = (u16*)(p.ws + WS_HC) + (size_t)kv * 8192 * 256;
    uint32_t pa[4], pb[4];
#pragma unroll
    for (int i = 0; i < 4; ++i) {
      const int row = (tid >> 3) + 64 * i, kc = tid & 7;
      const int r = m0 + row, bg = r >> 9, cc = r & 511, b = bg >> 2, g = bg & 3;
      int tok0 = cc * 16; if (tok0 > SEQ - 32) tok0 = SEQ - 32;
      pa[i] = (uint32_t)(b * SEQ + tok0) * LDQ + 1024 + kv * 256 + g * 64 + kc * 8;
      pb[i] = (uint32_t)row * 2048 + kc * 8;
    }
    f32x4 acc[8][4];
    gemm_mainloop<true>(p, U, pa, Bt, pb, LDQ, 32, lds, acc);
    const int tid2 = TIDX, lane2 = tid2 & 63, wave2 = tid2 >> 6;
    const int mw = m0 + (wave2 >> 2) * 128, nw = (wave2 & 3) * 64;
#pragma unroll
    for (int i = 0; i < 8; ++i)
#pragma unroll
      for (int j = 0; j < 4; ++j) {
        const int n = nw + j * 16 + (lane2 >> 4) * 4;
        const int m = mw + i * 16 + (lane2 & 15);
        const float4 bb = *(const float4*)(peb + kv * 256 + n);
        float v0 = silu_f(acc[i][j][0] + bb.x), v1 = silu_f(acc[i][j][1] + bb.y);
        float v2 = silu_f(acc[i][j][2] + bb.z), v3 = silu_f(acc[i][j][3] + bb.w);
        if ((m & 511) == 511) { v0 = v1 = v2 = v3 = 0.f; }
        uint2 o; o.x = pack2(v0, v1); o.y = pack2(v2, v3);
        *(uint2*)(Hc + (size_t)m * 256 + n) = o;
      }
    __threadfence_block();
    __syncthreads();
    gemm_cmp2_tile(p, lds, kv, mt);
  }
}

#define TILE_LD(R, src, stride) { R##0 = *(const uint4*)((src) + (long)(tid >> 3) * (stride) + (tid & 7) * 8); }
#define TILE_ST(dst, R) { *(uint4*)((dst) + (tid >> 3) * TS + (tid & 7) * 8) = R##0; }
#define VPOS(c) ((((c) >> 2) * 32) + ((2 * ((c) & 1)) * 8) + ((((c) & 3) >> 1) * 4))
#define TILE_STV_(dst, val) { const int c_ = tid & 7; u16* d_ = (dst) + (tid >> 3) * TS + VPOS(c_); \
    *(uint2*)(d_) = make_uint2((val).x, (val).y); *(uint2*)(d_ + 8) = make_uint2((val).z, (val).w); }
#define TILE_STV(dst, R) TILE_STV_(dst, R##0)
__device__ __forceinline__ void qk_tile(const u16* sK, const bf16x8 (&q)[2], f32x4 (&s)[4], int l16, int gk) {
#pragma unroll
  for (int kt = 0; kt < 4; ++kt) s[kt] = (f32x4){0.f, 0.f, 0.f, 0.f};
#pragma unroll
  for (int ks = 0; ks < 2; ++ks)
#pragma unroll
    for (int kt = 0; kt < 4; ++kt) {
      bf16x8 kf = *(const bf16x8*)(sK + (kt * 16 + l16) * TS + ks * 32 + gk * 8);
      s[kt] = MFMA(kf, q[ks], s[kt]);
    }
}
__device__ __forceinline__ void pv_tile(const u16* sV, const float (&pp)[4][4], f32x4 (&o)[4], int l16, int gk) {
  bf16x8 pf[2];
#pragma unroll
  for (int ks2 = 0; ks2 < 2; ++ks2) {
    uint4 t;
    t.x = pack2(pp[2 * ks2][0], pp[2 * ks2][1]); t.y = pack2(pp[2 * ks2][2], pp[2 * ks2][3]);
    t.z = pack2(pp[2 * ks2 + 1][0], pp[2 * ks2 + 1][1]); t.w = pack2(pp[2 * ks2 + 1][2], pp[2 * ks2 + 1][3]);
    pf[ks2] = *(bf16x8*)&t;
  }
#pragma unroll
  for (int dt = 0; dt < 4; ++dt)
#pragma unroll
    for (int ks2 = 0; ks2 < 2; ++ks2) {
      const bf16x8 vf = *(const bf16x8*)(sV + (dt * 16 + l16) * TS + ks2 * 32 + gk * 8);
      o[dt] = MFMA(vf, pf[ks2], o[dt]);
    }
}

__device__ __forceinline__ void fox_phase(const Params& p, u16* lds) {
  const u16* QK = (const u16*)(p.ws + WS_QK);
  const u16* VT = (const u16*)(p.ws + WS_VT);
  const float* cf = (const float*)(p.ws + WS_CFOX);
  u16* Y = (u16*)(p.ws + WS_Y);
  const int tid = TIDX, lane = tid & 63, w = tid >> 6, l16 = lane & 15, gk = lane >> 4;
  const float scale2 = 0.125f * LOG2E;
  for (int unit = BIDX; unit < 2048; unit += gridDim.x) {
    const int bh = unit & 31, qblk = 63 - (unit >> 5), b = bh >> 3, h = bh & 7;
    const int tq0 = qblk * 128 + w * 16;
    const int t = tq0 + l16;
    const float* cfr = cf + (size_t)bh * SEQ;
    bf16x8 q[2];
#pragma unroll
    for (int ks = 0; ks < 2; ++ks) q[ks] = *(const bf16x8*)(QK + (size_t)(b * SEQ + t) * LDQ + h * 64 + ks * 32 + gk * 8);
    const float cq2 = cfr[t] * LOG2E;
    f32x4 o[4];
    float m = -1e30f, l = 0.f;
#pragma unroll
    for (int dt = 0; dt < 4; ++dt) o[dt] = (f32x4){0.f, 0.f, 0.f, 0.f};
    const int ntiles = qblk * 2 + 2;
    const int iw = qblk * 2 + (w >> 2);
    const u16* ksrc = QK + (size_t)(b * SEQ) * LDQ + 512 + h * 64;
    const u16* vsrc = VT + (size_t)(h * 64) * MTOK + (size_t)b * SEQ;
    float qs = 0.f;
#pragma unroll
    for (int ks = 0; ks < 2; ++ks)
#pragma unroll
      for (int e = 0; e < 8; ++e) { const float v = bf2f((u16)q[ks][e]); qs += v * v; }
    qs += __shfl_xor(qs, 16); qs += __shfl_xor(qs, 32);
#pragma unroll
    for (int o2 = 1; o2 <= 8; o2 <<= 1) qs = fmaxf(qs, __shfl_xor(qs, o2));
    float* red = (float*)(lds + 256 * TS);
    if (lane == 0) red[w] = qs;
    __syncthreads();
    float qmax2 = red[0];
#pragma unroll
    for (int i = 1; i < NWAVE; ++i) qmax2 = fmaxf(qmax2, red[i]);
    const float kmax2 = __uint_as_float(((const uint32_t*)(p.ws + WS_KMAX))[h]);
    const float T2 = 2.f * scale2 * sqrtf(qmax2 * kmax2) * 1.001f + 48.f;
    const float cfirst2 = cfr[qblk * 128] * LOG2E;
    int i_lo = 0;
    for (int base = qblk * 2 - 1; base >= 0; base -= 64) {
      const int ti = base - lane;
      bool skip = false;
      if (ti >= 0) skip = (cfirst2 - cfr[ti * 64 + 63] * LOG2E) < -T2;
      const unsigned long long bal = __ballot(skip);
      if (bal) { i_lo = base - (int)__builtin_ctzll(bal) + 1; break; }
    }
    uint4 rk0, rv0;
    TILE_LD(rk, ksrc + (size_t)i_lo * 64 * LDQ, LDQ); TILE_LD(rv, vsrc + i_lo * 64, MTOK);
    TILE_ST(lds + (i_lo & 1) * (128 * TS), rk); TILE_STV(lds + (i_lo & 1) * (128 * TS) + 64 * TS, rv);
    __syncthreads();
    for (int i = i_lo; i < ntiles; ++i) {
      u16* cur = lds + (i & 1) * (128 * TS);
      const bool more = (i + 1 < ntiles);
      if (more) { TILE_LD(rk, ksrc + (size_t)(i + 1) * 64 * LDQ, LDQ); TILE_LD(rv, vsrc + (i + 1) * 64, MTOK); }
      if (i <= iw) {
        const int s0 = i * 64;
        const bool diag = (i == iw);
        f32x4 s[4];
        qk_tile(cur, q, s, l16, gk);
        float xv[4][4];
        float mx = -1e30f;
#pragma unroll
        for (int kt = 0; kt < 4; ++kt) {
          const float4 c4 = *(const float4*)(cfr + s0 + kt * 16 + gk * 4);
          const float ck[4] = {c4.x, c4.y, c4.z, c4.w};
#pragma unroll
          for (int r = 0; r < 4; ++r) {
            float v = fmaf(s[kt][r], scale2, cq2 - ck[r] * LOG2E);
            if (diag && (s0 + kt * 16 + gk * 4 + r > t)) v = -1e30f;
            xv[kt][r] = v; mx = fmaxf(mx, v);
          }
        }
        mx = fmaxf(mx, __shfl_xor(mx, 16)); mx = fmaxf(mx, __shfl_xor(mx, 32));
        const float mnew = fmaxf(m, mx);
        const float alpha = ex2(m - mnew);
        m = mnew;
        const float muse = fmaxf(mnew, -1e20f);
        float rs = 0.f;
#pragma unroll
        for (int kt = 0; kt < 4; ++kt)
#pragma unroll
          for (int r = 0; r < 4; ++r) { xv[kt][r] = ex2(xv[kt][r] - muse); rs += xv[kt][r]; }
        l = l * alpha + rs;
#pragma unroll
        for (int dt = 0; dt < 4; ++dt) o[dt] *= alpha;
        pv_tile(cur + 64 * TS, xv, o, l16, gk);
      }
      if (more) { u16* nxt = lds + ((i + 1) & 1) * (128 * TS); TILE_ST(nxt, rk); TILE_STV(nxt + 64 * TS, rv); }
      __syncthreads();
    }
    {
      float lt = l; lt += __shfl_xor(lt, 16); lt += __shfl_xor(lt, 32);
      const float inv = lt > 0.f ? 1.f / lt : 0.f;
      const size_t mrow = (size_t)(b * SEQ + t);
#pragma unroll
      for (int dt = 0; dt < 4; ++dt) {
        const int col = h * 64 + dt * 16 + gk * 4;
        const uint2 zz = *(const uint2*)(QK + mrow * LDQ + 2048 + col);
        const float z0 = bf2f(zz.x & 0xffff), z1 = bf2f(zz.x >> 16), z2 = bf2f(zz.y & 0xffff), z3 = bf2f(zz.y >> 16);
        uint2 ov;
        ov.x = pack2(o[dt][0] * inv * silu_f(z0), o[dt][1] * inv * silu_f(z1));
        ov.y = pack2(o[dt][2] * inv * silu_f(z2), o[dt][3] * inv * silu_f(z3));
        *(uint2*)(Y + mrow * DM + col) = ov;
      }
    }
  }
}

__device__ __forceinline__ void fox_knorm(const Params& p) {
  const u16* QK = (const u16*)(p.ws + WS_QK);
  uint32_t* km = (uint32_t*)(p.ws + WS_KMAX);
  const int tid = TIDX, lane = tid & 63, wave = tid >> 6;
  float mx = 0.f;
  for (int row = BIDX * NWAVE + wave; row < MTOK; row += gridDim.x * NWAVE) {
    const uint4 v = *(const uint4*)(QK + (size_t)row * LDQ + 512 + lane * 8);
    const float a0 = bf2f(v.x & 0xffff), a1 = bf2f(v.x >> 16), a2 = bf2f(v.y & 0xffff), a3 = bf2f(v.y >> 16);
    const float a4 = bf2f(v.z & 0xffff), a5 = bf2f(v.z >> 16), a6 = bf2f(v.w & 0xffff), a7 = bf2f(v.w >> 16);
    float ss = a0 * a0 + a1 * a1 + a2 * a2 + a3 * a3 + a4 * a4 + a5 * a5 + a6 * a6 + a7 * a7;
    ss += __shfl_xor(ss, 1); ss += __shfl_xor(ss, 2); ss += __shfl_xor(ss, 4);
    mx = fmaxf(mx, ss);
  }
  if ((lane & 7) == 0) atomicMax(&km[lane >> 3], __float_as_uint(mx));
}

__device__ __forceinline__ void fox_scan(const Params& p, float* ldsf) {
  const float* fl = (const float*)(p.ws + WS_FLOG);
  float* cf = (float*)(p.ws + WS_CFOX);
  double* sd = (double*)ldsf;
  const int tid = TIDX;
  for (int bh = BIDX; bh < 32; bh += gridDim.x) {
    const int b = bh >> 3, h = bh & 7;
    const float bf = p.e_bf[h];
    float ls[16];
    double sum = 0.0;
#pragma unroll
    for (int i = 0; i < 16; ++i) {
      const float xx = fl[(size_t)(b * SEQ + tid * 16 + i) * 8 + h] + bf;
      ls[i] = fminf(xx, 0.f) - log1pf(__expf(-fabsf(xx)));
      sum += (double)ls[i];
    }
    __syncthreads();
    sd[tid] = sum;
    __syncthreads();
    double pre = 0.0;
    for (int j = 0; j < tid; ++j) pre += sd[j];
#pragma unroll
    for (int i = 0; i < 16; ++i) { pre += (double)ls[i]; cf[(size_t)bh * SEQ + tid * 16 + i] = (float)pre; }
  }
}

__device__ __forceinline__ void ret_stepA(const Params& p) {
  const u16* VT = (const u16*)(p.ws + WS_VT);
  float* dS = (float*)(p.ws + WS_DS);
  const int tid_ = TIDX, lane = tid_ & 63, w8 = tid_ >> 6, w = w8 & 3, l16 = lane & 15, gk = lane >> 4;
  for (int u2 = BIDX; u2 < 1024; u2 += gridDim.x) {
    const int u = u2 * 2 + (w8 >> 2);
    const int bh = u >> 6, n = u & 63, b = bh >> 3, h = bh & 7;
    const size_t mcol = (size_t)b * SEQ + n * 128;
    f32x4 acc[4];
#pragma unroll
    for (int dt = 0; dt < 4; ++dt) acc[dt] = (f32x4){0.f, 0.f, 0.f, 0.f};
#pragma unroll
    for (int ks = 0; ks < 4; ++ks) {
      bf16x8 af = *(const bf16x8*)(VT + (size_t)(512 + h * 64 + w * 16 + l16) * MTOK + mcol + ks * 32 + gk * 8);
#pragma unroll
      for (int dt = 0; dt < 4; ++dt) {
        bf16x8 bfr = *(const bf16x8*)(VT + (size_t)(1024 + h * 64 + dt * 16 + l16) * MTOK + mcol + ks * 32 + gk * 8);
        acc[dt] = MFMA(af, bfr, acc[dt]);
      }
    }
#pragma unroll
    for (int dt = 0; dt < 4; ++dt)
#pragma unroll
      for (int r = 0; r < 4; ++r) dS[(size_t)u * 4096 + (w * 16 + gk * 4 + r) * 64 + dt * 16 + l16] = acc[dt][r];
  }
}
__device__ __forceinline__ void ret_stepB(const Params& p) {
  const float* dS = (const float*)(p.ws + WS_DS);
  u16* st = (u16*)(p.ws + WS_ST);
  for (int idx = BIDX * NTHR + TIDX; idx < 32 * 4096; idx += gridDim.x * NTHR) {
    const int bh = idx >> 12, ed = idx & 4095, h = bh & 7;
    const float cdec = __expf(log1pf(-exp2f(-5.f - (float)h)) * 128.f);
    float s = 0.f;
#pragma unroll 8
    for (int n = 0; n < 64; ++n) {
      const size_t a = (size_t)(bh * 64 + n) * 4096 + ed;
      st[a] = f2bf(s);
      s = s * cdec + dS[a];
    }
  }
}
__device__ __forceinline__ void ret_stepC(const Params& p, u16* lds) {
  const u16* QK = (const u16*)(p.ws + WS_QK);
  const u16* VT = (const u16*)(p.ws + WS_VT);
  const u16* st = (const u16*)(p.ws + WS_ST);
  u16* Y = (u16*)(p.ws + WS_Y);
  const int tid = TIDX, lane = tid & 63, w = tid >> 6, l16 = lane & 15, gk = lane >> 4;
  for (int u = BIDX; u < 2048; u += gridDim.x) {
    const int bh = u >> 6, n = u & 63, b = bh >> 3, h = bh & 7;
    const size_t m0 = (size_t)b * SEQ + n * 128;
    const float lg2 = log1pf(-exp2f(-5.f - (float)h)) * LOG2E;
    __syncthreads();
    {
      uint4 r0;
      TILE_LD(r, QK + m0 * LDQ + 1536 + h * 64, LDQ); TILE_ST(lds, r);
      TILE_LD(r, VT + (size_t)(512 + h * 64) * MTOK + m0, MTOK); TILE_STV(lds + 64 * TS, r);
      TILE_LD(r, QK + (m0 + 64) * LDQ + 1536 + h * 64, LDQ); TILE_ST(lds + 128 * TS, r);
      TILE_LD(r, VT + (size_t)(512 + h * 64) * MTOK + m0 + 64, MTOK); TILE_STV(lds + 192 * TS, r);
      TILE_LD(r, st + (size_t)u * 4096, 64); TILE_ST(lds + 256 * TS, r);
    }
    __syncthreads();
    const int iq = 16 * w + l16;
    const size_t mrow = m0 + iq;
    bf16x8 q[2];
#pragma unroll
    for (int ks = 0; ks < 2; ++ks) q[ks] = *(const bf16x8*)(QK + mrow * LDQ + 1024 + h * 64 + ks * 32 + gk * 8);
    f32x4 o[4];
#pragma unroll
    for (int dt = 0; dt < 4; ++dt) o[dt] = (f32x4){0.f, 0.f, 0.f, 0.f};
#pragma unroll
    for (int dt = 0; dt < 4; ++dt)
#pragma unroll
      for (int ks = 0; ks < 2; ++ks) {
        bf16x8 sf = *(const bf16x8*)(lds + 256 * TS + (dt * 16 + l16) * TS + ks * 32 + gk * 8);
        o[dt] = MFMA(sf, q[ks], o[dt]);
      }
    const float cross = ex2(lg2 * (float)(iq + 1));
#pragma unroll
    for (int dt = 0; dt < 4; ++dt) o[dt] *= cross;
#pragma unroll
    for (int k64 = 0; k64 < 2; ++k64) {
      if (k64 * 64 <= 16 * w + 15) {
        f32x4 s[4];
        qk_tile(lds + k64 * 128 * TS, q, s, l16, gk);
        float pp[4][4];
#pragma unroll
        for (int kt = 0; kt < 4; ++kt)
#pragma unroll
          for (int r = 0; r < 4; ++r) {
            const int j = k64 * 64 + kt * 16 + gk * 4 + r;
            pp[kt][r] = (j <= iq) ? s[kt][r] * 0.125f * ex2(lg2 * (float)(iq - j)) : 0.f;
          }
        pv_tile(lds + k64 * 128 * TS + 64 * TS, pp, o, l16, gk);
      }
    }
    float sm = 0.f;
#pragma unroll
    for (int dt = 0; dt < 4; ++dt) sm += o[dt][0] + o[dt][1] + o[dt][2] + o[dt][3];
    sm += __shfl_xor(sm, 16); sm += __shfl_xor(sm, 32);
    const float mu = sm * (1.f / 64.f);
    float vs = 0.f;
#pragma unroll
    for (int dt = 0; dt < 4; ++dt)
#pragma unroll
      for (int r = 0; r < 4; ++r) { const float d = o[dt][r] - mu; vs += d * d; }
    vs += __shfl_xor(vs, 16); vs += __shfl_xor(vs, 32);
    const float rstd = rsqrtf(vs * (1.f / 64.f) + 1e-5f);
#pragma unroll
    for (int dt = 0; dt < 4; ++dt) {
      const int col = h * 64 + dt * 16 + gk * 4;
      const float4 gg = *(const float4*)(p.e_gn + col);
      const uint2 zz = *(const uint2*)(QK + mrow * LDQ + 2048 + 512 + col);
      const float z0 = bf2f(zz.x & 0xffff), z1 = bf2f(zz.x >> 16), z2 = bf2f(zz.y & 0xffff), z3 = bf2f(zz.y >> 16);
      uint2 ov;
      ov.x = pack2((o[dt][0] - mu) * rstd * gg.x * silu_f(z0), (o[dt][1] - mu) * rstd * gg.y * silu_f(z1));
      ov.y = pack2((o[dt][2] - mu) * rstd * gg.z * silu_f(z2), (o[dt][3] - mu) * rstd * gg.w * silu_f(z3));
      *(uint2*)(Y + mrow * DM + 512 + col) = ov;
    }
  }
}

__device__ __forceinline__ void nsa_tile_interior(const u16* sK, const u16* sV, const bf16x8 (&q)[2], f32x4 (&acc)[4],
                                                  float& m, float& l, float slope2, const float (&sk)[16],
                                                  int t, int pos0, bool lanesel, int lane) {
  const int l16 = lane & 15, gk = lane >> 4;
  const float scale2 = 0.125f * LOG2E;
  f32x4 s[4];
  qk_tile(sK, q, s, l16, gk);
  const float c0 = fmaf(-slope2, (float)(t - pos0 - gk * 4), lanesel ? 0.f : -1e30f);
  float xv[4][4];
  float mx = -1e30f;
#pragma unroll
  for (int kt = 0; kt < 4; ++kt)
#pragma unroll
    for (int r = 0; r < 4; ++r) { xv[kt][r] = fmaf(s[kt][r], scale2, sk[kt * 4 + r]); mx = fmaxf(mx, xv[kt][r]); }
  mx += c0;
  mx = fmaxf(mx, __shfl_xor(mx, 16)); mx = fmaxf(mx, __shfl_xor(mx, 32));
  const float mnew = fmaxf(m, mx);
  const float alpha = ex2(m - mnew);
  m = mnew;
  const float off = c0 - fmaxf(mnew, -1e20f);
  float rs = 0.f;
#pragma unroll
  for (int kt = 0; kt < 4; ++kt)
#pragma unroll
    for (int r = 0; r < 4; ++r) { xv[kt][r] = ex2(xv[kt][r] + off); rs += xv[kt][r]; }
  l = l * alpha + rs;
  if (__any(alpha != 1.f)) {
#pragma unroll
    for (int dt = 0; dt < 4; ++dt) acc[dt] *= alpha;
  }
  pv_tile(sV, xv, acc, l16, gk);
}
template <int BR>
__device__ __forceinline__ void nsa_tile(const u16* sK, const u16* sV, const bf16x8 (&q)[2], f32x4 (&acc)[4],
                                         float& m, float& l, float slope2, float gmul,
                                         int t, int pos0, int pstride, int wl, bool lanesel,
                                         float* imp_row, int jbase, float& carry, int lane, float* imp_scale = nullptr) {
  const int l16 = lane & 15, gk = lane >> 4;
  const float scale2 = 0.125f * LOG2E;
  const unsigned wle = lanesel ? (unsigned)wl : 0u;
  f32x4 s[4];
  qk_tile(sK, q, s, l16, gk);
  float xv[4][4];
  float mx = -1e30f;
#pragma unroll
  for (int kt = 0; kt < 4; ++kt)
#pragma unroll
    for (int r = 0; r < 4; ++r) {
      const int dist = t - (pos0 + (kt * 16 + gk * 4 + r) * pstride);
      const float pen = ((unsigned)dist < wle) ? 0.f : -1e30f;
      const float v = fmaf(s[kt][r], scale2, fmaf(-slope2, (float)dist, pen));
      xv[kt][r] = v; mx = fmaxf(mx, v);
    }
  if (BR != 1) {
    mx = fmaxf(mx, __shfl_xor(mx, 16)); mx = fmaxf(mx, __shfl_xor(mx, 32));
    const float mnew = fmaxf(m, mx);
    const float alpha = ex2(m - mnew);
    m = mnew;
    const float muse = fmaxf(mnew, -1e20f);
    float rs = 0.f;
#pragma unroll
    for (int kt = 0; kt < 4; ++kt)
#pragma unroll
      for (int r = 0; r < 4; ++r) { xv[kt][r] = ex2(xv[kt][r] - muse); rs += xv[kt][r]; }
    l = l * alpha + rs;
    if (BR == 2 || BR == 3) {
#pragma unroll
      for (int dt = 0; dt < 4; ++dt) acc[dt] *= alpha;
    }
    if (BR == 3) {
      float p3[4];
#pragma unroll
      for (int kt = 0; kt < 4; ++kt) {
        p3[kt] = xv[kt][3];
        imp_row[jbase + kt * 4 + gk] = 2.f * (xv[kt][0] + xv[kt][1] + xv[kt][2]) + xv[kt][3];
      }
      const int srcl = (lane + 48) & 63;
      const float carry_s = carry * alpha;
#pragma unroll
      for (int kt = 0; kt < 4; ++kt) {
        const float same = __shfl(p3[kt], srcl);
        const float prev = __shfl(kt > 0 ? p3[kt > 0 ? kt - 1 : 0] : carry_s, srcl);
        imp_row[jbase + kt * 4 + gk] += (gk == 0) ? prev : same;
      }
      carry = p3[3];
      if (gk == 0) *imp_scale = mnew;
    }
    if (BR == 2 || BR == 3) pv_tile(sV, xv, acc, l16, gk);
  } else {
    const float muse = fmaxf(m, -1e20f);
    float p3[4];
#pragma unroll
    for (int kt = 0; kt < 4; ++kt) {
      float pn[4];
#pragma unroll
      for (int r = 0; r < 4; ++r) { pn[r] = ex2(xv[kt][r] - muse) * l; xv[kt][r] = pn[r] * gmul; }
      p3[kt] = pn[3];
      xv[kt][0] = xv[kt][0];
      imp_row[jbase + kt * 4 + gk] = 2.f * (pn[0] + pn[1] + pn[2]) + pn[3];
    }
    const int srcl = (lane + 48) & 63;
#pragma unroll
    for (int kt = 0; kt < 4; ++kt) {
      const float same = __shfl(p3[kt], srcl);
      const float prev = __shfl(kt > 0 ? p3[kt > 0 ? kt - 1 : 0] : carry, srcl);
      imp_row[jbase + kt * 4 + gk] += (gk == 0) ? prev : same;
    }
    carry = p3[3];
    pv_tile(sV, xv, acc, l16, gk);
  }
}

__device__ __forceinline__ void nsa_phase(const Params& p, u16* lds) {
  const u16* U = (const u16*)(p.ws + WS_QK);
  const u16* VT = (const u16*)(p.ws + WS_VT);
  const u16* KC = (const u16*)(p.ws + WS_KCMP);
  const u16* VC = (const u16*)(p.ws + WS_VCMPT);
  const float* GL = (const float*)(p.ws + WS_GL);
  u16* Y = (u16*)(p.ws + WS_Y);
  float* imp = (float*)(lds + 512 * TS);
  uint32_t* umask = (uint32_t*)(imp + 128 * IMPS);
  int* ulist = (int*)(umask + 4);
  const int tid = TIDX, lane = tid & 63, w = tid >> 6, l16 = lane & 15, gk = lane >> 4;
  const int qt = w & 1, hd = w >> 1;
  uint2* totl = (uint2*)imp + 128 + (size_t)w * 256 + lane;
  const int BIG = 1 << 30;
  int* uslot = ulist + 128;
  unsigned* uctr = (unsigned*)(p.ws + WS_KMAX) + 24;
  for (;;) {
    __syncthreads();
    if (tid == 0) uslot[0] = (int)atomicAdd(uctr, 1u);
    __syncthreads();
    const int unit = uslot[0];
    if (unit >= 4096) break;
    const int bg = unit & 15, qh = 255 - (unit >> 4), b = bg >> 2, g = bg & 3;
    const int t0 = qh * 32, qb = t0 >> 6, t = t0 + 16 * qt + l16;
    const size_t mrow = (size_t)b * SEQ + t;
    const int h = g * 4 + hd;
    bf16x8 q[2];
#pragma unroll
    for (int ks = 0; ks < 2; ++ks) q[ks] = *(const bf16x8*)(U + mrow * LDQ + h * 64 + ks * 32 + gk * 8);
    const float slope2 = exp2f(-0.5f * (float)(h + 1)) * LOG2E;
    const float g1 = sigmoid_f(GL[mrow * 48 + h * 3] + p.o_bg[h * 3]);
    float sk[16];
#pragma unroll
    for (int i = 0; i < 16; ++i) sk[i] = slope2 * (float)((i >> 2) * 16 + (i & 3));
    float qn2 = 0.f;
#pragma unroll
    for (int ks = 0; ks < 2; ++ks)
#pragma unroll
      for (int e = 0; e < 8; ++e) { const float v = bf2f((u16)q[ks][e]); qn2 += v * v; }
    qn2 += __shfl_xor(qn2, 16); qn2 += __shfl_xor(qn2, 32);
#pragma unroll
    for (int o2 = 1; o2 <= 8; o2 <<= 1) qn2 = fmaxf(qn2, __shfl_xor(qn2, o2));
    const uint32_t* kmx = (const uint32_t*)(p.ws + WS_KMAX);
    const float sc2 = 0.125f * LOG2E;
    const float T_slc = 2.02f * sc2 * sqrtf(qn2 * __uint_as_float(kmx[8 + g])) + 48.f;
    const float T_win = 2.02f * sc2 * sqrtf(qn2 * __uint_as_float(kmx[12 + g])) + 48.f;
    const float T_cmp = 2.05f * sc2 * sqrtf(qn2 * __uint_as_float(kmx[16 + g])) + 16.f * slope2 + 48.f;
    const int tq0w = t0 + 16 * qt;
    f32x4 acc[4];
    float m = -1e30f, l = 0.f;
#pragma unroll
    for (int dt = 0; dt < 4; ++dt) acc[dt] = (f32x4){0.f, 0.f, 0.f, 0.f};
    __syncthreads();
    for (int i = tid; i < 128 * IMPS; i += NTHR) imp[i] = 0.f;
    if (tid < 4) umask[tid] = 0u;
    float* imp_row = imp + (hd * 32 + 16 * qt + l16) * IMPS;
    float carry = 0.f;
    uint4 rk0, rk1, rk2, rk3, rv0, rv1, rv2, rv3;
    u16* impbase_unused = nullptr; (void)impbase_unused;
#define SLOT(k) (lds + (k) * (128 * TS))
#define LD1(k, kp, ks_, vp, vs_) { rk##k = *(const uint4*)((kp) + (long)(tid >> 3) * (ks_) + (tid & 7) * 8); rv##k = *(const uint4*)((vp) + (long)(tid >> 3) * (vs_) + (tid & 7) * 8); }
#define ST1(k) { *(uint4*)(SLOT(k) + (tid >> 3) * TS + (tid & 7) * 8) = rk##k; TILE_STV_(SLOT(k) + 64 * TS, rv##k) }
    const int ntc = ((t0 >> 4) >> 6) + 1;
    const u16* kcs = KC + (size_t)bg * 512 * 64;
    const u16* vcs = VC + (size_t)bg * 32768;
#define CMP_LD(k, i) if ((i) < ntc) LD1(k, kcs + (size_t)(i) * 64 * 64, 64, vcs + (i) * 64, 512)
    float* mrec = (float*)(uslot + 4) + (w * 16 + l16) * 8;
    {
      const int ngrp = (ntc + 3) >> 2;
      CMP_LD(0, 0) CMP_LD(1, 1) CMP_LD(2, 2) CMP_LD(3, 3)
#pragma unroll 1
      for (int gi = 0; gi < ngrp; ++gi) {
        const int ib = gi * 4;
        __syncthreads();
        if (ib < ntc) ST1(0) if (ib + 1 < ntc) ST1(1) if (ib + 2 < ntc) ST1(2) if (ib + 3 < ntc) ST1(3)
        __syncthreads();
        if (gi + 1 < ngrp) { CMP_LD(0, ib + 4) CMP_LD(1, ib + 5) CMP_LD(2, ib + 6) CMP_LD(3, ib + 7) }
#pragma unroll 1
        for (int k = 0; k < 4; ++k) {
          const int i = ib + k;
          if (i < ntc) {
            const int dmin = tq0w - (16 * (64 * i + 63) + 31);
            if (dmin > 0 && slope2 * (float)dmin > T_cmp) { carry = 0.f; if (gk == 0) mrec[i] = -1e30f; continue; }
            nsa_tile<3>(SLOT(k), SLOT(k) + 64 * TS, q, acc, m, l, slope2, g1, t, 16 * (64 * i) + 31, 16, BIG, true, imp_row, 16 * i, carry, lane, mrec + i);
          }
        }
      }
      float lt = l; lt += __shfl_xor(lt, 16); lt += __shfl_xor(lt, 32);
      const float inv = lt > 0.f ? 1.f / lt : 0.f;
      const float mfin = fmaxf(m, -1e20f);
#pragma unroll 1
      for (int i = 0; i < ntc; ++i) {
        const float f = ex2(fmaxf(mrec[i], -1e20f) - mfin) * inv;
#pragma unroll
        for (int kt = 0; kt < 4; ++kt) imp_row[16 * i + kt * 4 + gk] *= f;
      }
      const float og = g1 * inv;
#pragma unroll
      for (int dt = 0; dt < 4; ++dt) acc[dt] *= og;
    }
    __syncthreads();
    {
      const int qi = w * 4 + gk;
      const int c8 = l16 * 8;
      uint32_t selb = 0u;
      if (qb < 16) {
#pragma unroll
        for (int i = 0; i < 8; ++i) if (c8 + i <= qb) selb |= (1u << i);
      } else {
        float val[8];
        const float* ra = imp + qi * IMPS + c8;
#pragma unroll
        for (int i4 = 0; i4 < 2; ++i4) {
          const float4 v0 = *(const float4*)(ra + 4 * i4);
          const float4 v1 = *(const float4*)(ra + 32 * IMPS + 4 * i4);
          const float4 v2 = *(const float4*)(ra + 64 * IMPS + 4 * i4);
          const float4 v3 = *(const float4*)(ra + 96 * IMPS + 4 * i4);
          val[4 * i4] = ((v0.x + v1.x) + v2.x) + v3.x; val[4 * i4 + 1] = ((v0.y + v1.y) + v2.y) + v3.y;
          val[4 * i4 + 2] = ((v0.z + v1.z) + v2.z) + v3.z; val[4 * i4 + 3] = ((v0.w + v1.w) + v2.w) + v3.w;
        }
#pragma unroll
        for (int i = 0; i < 8; ++i) {
          const int j = c8 + i;
          const bool forced = (j == 0) || (j == qb) || (j == qb - 1);
          if (forced) selb |= (1u << i);
          if (forced || j > qb) val[i] = -1.f;
        }
#pragma unroll 1
        for (int it = 0; it < 13; ++it) {
          float best = -2.f; int bj = 0;
#pragma unroll
          for (int i = 0; i < 8; ++i) {
            const float v = ((selb >> i) & 1u) ? -1.f : val[i];
            if (v > best) { best = v; bj = c8 + i; }
          }
#pragma unroll
          for (int o = 1; o <= 8; o <<= 1) {
            const float ov = __shfl_xor(best, o); const int oj = __shfl_xor(bj, o);
            if (ov > best || (ov == best && oj < bj)) { best = ov; bj = oj; }
          }
          if ((bj >> 3) == l16) selb |= (1u << (bj & 7));
        }
      }
      uint32_t wd = selb << ((l16 & 3) * 8);
      wd |= __shfl_xor(wd, 1); wd |= __shfl_xor(wd, 2);
      __syncthreads();
      uint32_t* selw = (uint32_t*)imp;
      if ((l16 & 3) == 0) selw[qi * 4 + (l16 >> 2)] = wd;
      uint32_t uq = wd; uq |= __shfl_xor(uq, 16); uq |= __shfl_xor(uq, 32);
      if (gk == 0 && (l16 & 3) == 0) atomicOr(&umask[l16 >> 2], uq);
    }
    __syncthreads();
    const uint32_t* selq = (const uint32_t*)imp + (16 * qt + l16) * 4;
    const uint32_t sel0 = selq[0], sel1 = selq[1], sel2 = selq[2], sel3 = selq[3];
    uint32_t wun0 = sel0, wun1 = sel1, wun2 = sel2, wun3 = sel3;
#pragma unroll
    for (int o = 1; o <= 8; o <<= 1) { wun0 |= __shfl_xor(wun0, o); wun1 |= __shfl_xor(wun1, o); wun2 |= __shfl_xor(wun2, o); wun3 |= __shfl_xor(wun3, o); }
    int nsl = 0;
    {
      const uint32_t u0 = umask[0], u1 = umask[1], u2 = umask[2], u3 = umask[3];
      nsl = __popc(u0) + __popc(u1) + __popc(u2) + __popc(u3);
      if (tid < 128) {
        const uint32_t uw = tid < 32 ? u0 : tid < 64 ? u1 : tid < 96 ? u2 : u3;
        if ((uw >> (tid & 31)) & 1u) {
          int pos = __popc(uw & ((1u << (tid & 31)) - 1u));
          if (tid >= 32) pos += __popc(u0);
          if (tid >= 64) pos += __popc(u1);
          if (tid >= 96) pos += __popc(u2);
          ulist[pos] = tid;
        }
      }
    }
    __syncthreads();
#pragma unroll
    for (int dt = 0; dt < 4; ++dt) {
      uint2 o2; o2.x = pack2(acc[dt][0], acc[dt][1]); o2.y = pack2(acc[dt][2], acc[dt][3]);
      totl[dt * 64] = o2;
    }
#pragma unroll 1
    for (int br = 1; br < 3; ++br) {
      m = -1e30f; l = 0.f;
#pragma unroll
      for (int dt = 0; dt < 4; ++dt) acc[dt] = (f32x4){0.f, 0.f, 0.f, 0.f};
      int wfirst = ((t0 - 511) >> 6) << 6; if (wfirst < 0) wfirst = 0;
      const int nt = (br == 1) ? nsl : ((qb * 64 - wfirst) >> 6) + 1;
      const int ngrp = (nt + 3) >> 2;
      const u16* kb = U + (size_t)b * SEQ * LDQ + (br == 1 ? 1536 : 1792) + g * 64;
      const u16* vb = VT + (size_t)((br == 1 ? 0 : 256) + g * 64) * MTOK + (size_t)b * SEQ;
#define SRC_S0(i) ((br == 1) ? ulist[nt - 1 - (i)] * 64 : wfirst + 64 * (nt - 1 - (i)))
#define BR_LD(k, i) if ((i) < nt) { const int s_ = SRC_S0(i); LD1(k, kb + (size_t)s_ * LDQ, LDQ, vb + s_, MTOK) }
      BR_LD(0, 0) BR_LD(1, 1) BR_LD(2, 2) BR_LD(3, 3)
#pragma unroll 1
      for (int gi = 0; gi < ngrp; ++gi) {
        const int ib = gi * 4;
        __syncthreads();
        if (ib < nt) ST1(0) if (ib + 1 < nt) ST1(1) if (ib + 2 < nt) ST1(2) if (ib + 3 < nt) ST1(3)
        __syncthreads();
        if (gi + 1 < ngrp) { BR_LD(0, ib + 4) BR_LD(1, ib + 5) BR_LD(2, ib + 6) BR_LD(3, ib + 7) }
#pragma unroll 1
        for (int k = 0; k < 4; ++k) {
          const int i = ib + k;
          if (i < nt) {
            const int s0 = SRC_S0(i);
            bool wsel = true, ls = true;
            int wl = 512;
            if (br == 1) {
              const int j = s0 >> 6, jw = j >> 5, jb = j & 31;
              const uint32_t ww = jw == 0 ? wun0 : jw == 1 ? wun1 : jw == 2 ? wun2 : wun3;
              const uint32_t sw = jw == 0 ? sel0 : jw == 1 ? sel1 : jw == 2 ? sel2 : sel3;
              wsel = (ww >> jb) & 1u; ls = (sw >> jb) & 1u; wl = BIG;
            }
            if (wsel) {
              const int dminw = tq0w - (s0 + 63);
              if (dminw > 0 && slope2 * (float)dminw > (br == 1 ? T_slc : T_win)) wsel = false;
            }
            if (wsel) {
              const int tq0 = t0 + 16 * qt;
              const bool interior = (s0 + 63 <= tq0) && (br == 1 || s0 + 512 > tq0 + 15);
              if (interior) nsa_tile_interior(SLOT(k), SLOT(k) + 64 * TS, q, acc, m, l, slope2, sk, t, s0, ls, lane);
              else nsa_tile<2>(SLOT(k), SLOT(k) + 64 * TS, q, acc, m, l, slope2, g1, t, s0, 1, wl, ls, imp_row, 0, carry, lane);
            }
          }
        }
      }
      {
        float lt = l; lt += __shfl_xor(lt, 16); lt += __shfl_xor(lt, 32);
        const float gt = sigmoid_f(GL[mrow * 48 + h * 3 + br] + p.o_bg[h * 3 + br]);
        const float sc = lt > 0.f ? gt / lt : 0.f;
#pragma unroll
        for (int dt = 0; dt < 4; ++dt) {
          const uint2 pv = totl[dt * 64];
          const float r0 = bf2f(pv.x & 0xffff) + acc[dt][0] * sc, r1 = bf2f(pv.x >> 16) + acc[dt][1] * sc;
          const float r2 = bf2f(pv.y & 0xffff) + acc[dt][2] * sc, r3 = bf2f(pv.y >> 16) + acc[dt][3] * sc;
          if (br == 1) {
            uint2 o2; o2.x = pack2(r0, r1); o2.y = pack2(r2, r3);
            totl[dt * 64] = o2;
          } else {
            const int col = h * 64 + dt * 16 + gk * 4;
            const uint2 zz = *(const uint2*)(U + mrow * LDQ + 2048 + col);
            const float z0 = bf2f(zz.x & 0xffff), z1 = bf2f(zz.x >> 16), z2 = bf2f(zz.y & 0xffff), z3 = bf2f(zz.y >> 16);
            uint2 ov;
            ov.x = pack2(r0 * silu_f(z0), r1 * silu_f(z1));
            ov.y = pack2(r2 * silu_f(z2), r3 * silu_f(z3));
            *(uint2*)(Y + mrow * DM + col) = ov;
          }
        }
      }
    }
#undef SLOT
#undef LD1
#undef ST1
#undef CMP_LD
#undef SRC_S0
#undef BR_LD
  }
}

__device__ __forceinline__ void final_norm(const Params& p) {
  const int lane = TIDX & 63, wave = TIDX >> 6;
  for (int row = BIDX * NWAVE + wave; row < MTOK; row += gridDim.x * NWAVE) {
    float4* xr = (float4*)(p.out + (size_t)row * DM);
    float4 v[4];
    float ss = 0.f;
#pragma unroll
    for (int i = 0; i < 4; ++i) {
      v[i] = xr[lane + 64 * i];
      ss += v[i].x * v[i].x + v[i].y * v[i].y + v[i].z * v[i].z + v[i].w * v[i].w;
    }
#pragma unroll
    for (int o = 32; o >= 1; o >>= 1) ss += __shfl_xor(ss, o);
    const float rstd = rsqrtf(ss * (1.f / DM) + 1e-6f);
#pragma unroll
    for (int i = 0; i < 4; ++i) {
      const float4 gg = ((const float4*)p.fin_g)[lane + 64 * i];
      xr[lane + 64 * i] = (float4){v[i].x * rstd * gg.x, v[i].y * rstd * gg.y, v[i].z * rstd * gg.z, v[i].w * rstd * gg.w};
    }
  }
}

#define XB_XCNT(j)  (64 * (j))
#define XB_XSUB(j)  (1024 + 64 * (j))
#define XB_XGEN(j)  (2048 + 64 * (j))
#define XB_TOP      3072
#define XB_TOPGEN   3136
#define XB_WORDS    3200
#define LAS __attribute__((address_space(3)))
__device__ __forceinline__ unsigned xb_ld(unsigned* q) { return __hip_atomic_load(q, __ATOMIC_RELAXED, __HIP_MEMORY_SCOPE_AGENT); }
__device__ __forceinline__ unsigned xb_add(unsigned* q, unsigned v) { return __hip_atomic_fetch_add(q, v, __ATOMIC_RELAXED, __HIP_MEMORY_SCOPE_AGENT); }
__device__ __forceinline__ unsigned xb_xcc_id() { return (unsigned)__builtin_amdgcn_s_getreg((3 << 11) | 20) & 0xFu; }
__device__ __forceinline__ void grid_bar(const Params& p, unsigned xcc, volatile unsigned* st) {
  asm volatile("s_waitcnt vmcnt(0)" ::: "memory");
  __syncthreads();
  if (TIDX == 0) {
    unsigned* bar = (unsigned*)(p.ws + WS_BAR);
    __builtin_amdgcn_s_waitcnt(0);
    unsigned nloc = st[0], nx = st[1];
    if (nloc == 0u) {
      const unsigned G = gridDim.x;
      for (;;) {
        unsigned sum = 0u, cnt = 0u, mine = 0u;
#pragma unroll
        for (unsigned j = 0; j < 16; ++j) { const unsigned c = xb_ld(&bar[XB_XCNT(j)]); sum += c; cnt += (c > 0u) ? 1u : 0u; mine = (j == xcc) ? c : mine; }
        nloc = mine; nx = cnt;
        if (sum == G) break;
        __builtin_amdgcn_s_sleep(1);
      }
      st[0] = nloc; st[1] = nx;
    }
    const unsigned old = xb_add(&bar[XB_XSUB(xcc)], 1u);
    const unsigned gen = old / nloc;
    if (old + 1u == (gen + 1u) * nloc) {
      __builtin_amdgcn_fence(__ATOMIC_RELEASE, "agent");
      asm volatile("s_waitcnt vmcnt(0)" ::: "memory");
      const unsigned og = xb_add(&bar[XB_TOP], 1u);
      const unsigned tg = og / nx;
      if (og + 1u == (tg + 1u) * nx) xb_add(&bar[XB_TOPGEN], 1u);
      else while (xb_ld(&bar[XB_TOPGEN]) == tg) __builtin_amdgcn_s_sleep(1);
      __builtin_amdgcn_fence(__ATOMIC_ACQUIRE, "agent");
      xb_add(&bar[XB_XGEN(xcc)], 1u);
      asm volatile("s_waitcnt vmcnt(0)" ::: "memory");
    } else {
      while (xb_ld(&bar[XB_XGEN(xcc)]) == gen) __builtin_amdgcn_s_sleep(1);
      __builtin_amdgcn_fence(__ATOMIC_ACQUIRE, "agent");
      asm volatile("s_waitcnt vmcnt(0)" ::: "memory");
    }
  }
  __syncthreads();
}

__device__ __forceinline__ void nsa_knorm(const Params& p) {
  if (BIDX < 64) return;
  const u16* U = (const u16*)(p.ws + WS_QK);
  uint32_t* km = (uint32_t*)(p.ws + WS_KMAX);
  const int tid = TIDX, lane = tid & 63, wave = tid >> 6;
  float mx = 0.f;
  for (int row = (BIDX - 64) * NWAVE + wave; row < MTOK; row += (gridDim.x - 64) * NWAVE) {
    const uint4 v = *(const uint4*)(U + (size_t)row * LDQ + 1536 + lane * 8);
    const float a0 = bf2f(v.x & 0xffff), a1 = bf2f(v.x >> 16), a2 = bf2f(v.y & 0xffff), a3 = bf2f(v.y >> 16);
    const float a4 = bf2f(v.z & 0xffff), a5 = bf2f(v.z >> 16), a6 = bf2f(v.w & 0xffff), a7 = bf2f(v.w >> 16);
    float ss = a0 * a0 + a1 * a1 + a2 * a2 + a3 * a3 + a4 * a4 + a5 * a5 + a6 * a6 + a7 * a7;
    ss += __shfl_xor(ss, 1); ss += __shfl_xor(ss, 2); ss += __shfl_xor(ss, 4);
    mx = fmaxf(mx, ss);
  }
  if ((lane & 7) == 0) atomicMax(&km[8 + (lane >> 3)], __float_as_uint(mx));
}

__global__ void __launch_bounds__(NTHR, 2) mega(Params p_in) {
  Params p = p_in;
  p.pad = __builtin_amdgcn_readfirstlane((int)threadIdx.x >> 6);
  extern __shared__ __attribute__((aligned(16))) unsigned char lds_raw[];
  u16* lds = (u16*)lds_raw;
  const unsigned xcc = xb_xcc_id();
  volatile unsigned* bst = (volatile unsigned*)(lds_raw + 147456);
  if (threadIdx.x < 2) bst[threadIdx.x] = 0u;
  if (p_in.coop && threadIdx.x == 0) (void)xb_add((unsigned*)(p_in.ws + WS_BAR) + XB_XCNT(xcc), 1u);
  __syncthreads();
  cg::grid_group grid = cg::this_grid();
  if (p_in.coop == 2) grid.sync();
#define PH_ON(k) (p.ph_lo <= (k) && (k) <= p.ph_hi)
#define PH_SYNC(k) if (p.coop && p.ph_lo <= (k) && (k) < p.ph_hi) grid_bar(p, xcc, bst);
  if (PH_ON(0)) {
    rms_rows_fl(p, (float*)lds);
    conv_t(p, (u16*)(p.ws + WS_WT0), p.e_win, 1024, 4104, 4352, 0);
    conv_t(p, (u16*)(p.ws + WS_WT1), p.o_win, 1024, 3632, 3840, 1);
    conv_t(p, (u16*)(p.ws + WS_WO0), p.e_wout, 1024, 1024, 1024, 2);
    conv_t(p, (u16*)(p.ws + WS_WO1), p.o_wout, 1024, 1024, 1024, 2);
    conv_t(p, (u16*)(p.ws + WS_W1K), p.o_wk1, 2048, 256, 256, 2);
    conv_t(p, (u16*)(p.ws + WS_W1V), p.o_wv1, 2048, 256, 256, 2);
    conv_t(p, (u16*)(p.ws + WS_W2K), p.o_wk2, 256, 64, 256, 2);
    conv_t(p, (u16*)(p.ws + WS_W2V), p.o_wv2, 256, 64, 256, 2);
    pe_partial(p);
    if (BIDX == 0 && TIDX < 32) ((uint32_t*)(p.ws + WS_KMAX))[TIDX] = 0u;
    for (int i = BIDX * NTHR + TIDX; i < MTOK; i += gridDim.x * NTHR) ((float*)(p.ws + WS_SSQ))[i] = 0.f;
  }
  PH_SYNC(0)
  if (PH_ON(1)) gemm_inproj(p, 0, lds, 0);
  PH_SYNC(1)
  if (PH_ON(2)) {
    fox_scan(p, (float*)lds); ret_stepA(p); fox_knorm(p);
    if (BIDX == gridDim.x - 1) {
      for (int i = TIDX; i < 512; i += NTHR) {
        const float* part = (const float*)(p.ws + WS_PEP);
        float sum = 0.f;
        for (int kc = 0; kc < 16; ++kc) sum += part[((i >> 8) * 16 + kc) * 256 + (i & 255)];
        ((float*)(p.ws + WS_PEB))[i] = sum;
      }
    }
  }
  PH_SYNC(2)
  if (PH_ON(3)) { ret_stepB(p); fox_phase(p, lds); }
  PH_SYNC(3)
  if (PH_ON(4)) ret_stepC(p, lds);
  PH_SYNC(4)
  if (PH_ON(5)) gemm_outproj(p, 0, lds);
  PH_SYNC(5)
  if (PH_ON(7)) gemm_inproj(p, 1, lds, 0);
  PH_SYNC(7)
  if (PH_ON(8)) { gemm_cmp1(p, lds); gemm_inproj(p, 1, lds, 1); nsa_knorm(p); }
  PH_SYNC(8)
  if (PH_ON(10)) nsa_phase(p, lds);
  PH_SYNC(10)
  if (PH_ON(11)) gemm_outproj(p, 1, lds);
  PH_SYNC(11)
  if (PH_ON(12)) final_norm(p);
}

extern "C" void kernel_launch(void* const* d_in, const int* in_sizes, int n_in, void* d_out, int out_size, void* d_ws,
                              size_t ws_size, hipStream_t stream) {
  static int grid_blocks = 0;
  if (!grid_blocks) {
    int dev = 0, cus = 0, per_cu = 0;
    hipGetDevice(&dev);
    hipDeviceGetAttribute(&cus, hipDeviceAttributeMultiprocessorCount, dev);
    hipFuncSetAttribute((const void*)mega, hipFuncAttributeMaxDynamicSharedMemorySize, LDS_BYTES);
    hipOccupancyMaxActiveBlocksPerMultiprocessor(&per_cu, (const void*)mega, NTHR, LDS_BYTES);
    if (per_cu < 1) per_cu = 1;
    if (per_cu > 1) per_cu = 1;
    grid_blocks = cus * per_cu;
    (void)hipGetLastError();
  }
  Params p{};
  p.x = (const float*)d_in[0]; p.e_ng = (const float*)d_in[1]; p.e_win = (const float*)d_in[2];
  p.e_bf = (const float*)d_in[3]; p.e_gn = (const float*)d_in[4]; p.e_wout = (const float*)d_in[5];
  p.o_ng = (const float*)d_in[6]; p.o_win = (const float*)d_in[7]; p.o_bg = (const float*)d_in[8];
  p.o_pek = (const float*)d_in[9]; p.o_pev = (const float*)d_in[10]; p.o_wk1 = (const float*)d_in[11];
  p.o_wk2 = (const float*)d_in[12]; p.o_wv1 = (const float*)d_in[13]; p.o_wv2 = (const float*)d_in[14];
  p.o_wout = (const float*)d_in[15]; p.fin_g = (const float*)d_in[16];
  p.out = (float*)d_out; p.ws = (unsigned char*)d_ws;
#if ONE_LAUNCH
  p.ph_lo = 0; p.ph_hi = NPHASE - 1; p.coop = 1;
  (void)hipMemsetAsync((unsigned char*)d_ws + WS_BAR, 0, 16384, stream);
  void* args[] = {&p};
  hipError_t e = hipLaunchCooperativeKernel((const void*)mega, dim3(grid_blocks), dim3(NTHR), args, LDS_BYTES, stream);
  if (e != hipSuccess) fprintf(stderr, "cooperative launch failed: %s (grid %d)\n", hipGetErrorString(e), grid_blocks);
#else
  for (int ph = 0; ph < NPHASE; ++ph) {
    p.ph_lo = ph; p.ph_hi = ph; p.coop = 0;
    hipLaunchKernelGGL(mega, dim3(grid_blocks), dim3(NTHR), LDS_BYTES, stream, p);
  }
#endif
}
```

```cpp
#include <hip/hip_runtime.h>
#include <hip/hip_cooperative_groups.h>
#include <stdint.h>
#include <stdio.h>
namespace cg = cooperative_groups;

typedef unsigned short u16;
typedef short bf16x8 __attribute__((ext_vector_type(8)));
typedef short bf16x4 __attribute__((ext_vector_type(4)));
typedef float f32x4 __attribute__((ext_vector_type(4)));

#ifndef ONE_LAUNCH
#define ONE_LAUNCH 1
#endif

#define MTOK 32768
#define SEQ 8192
#define DM 1024
#define LDQ 3072
#define LOG2E 1.4426950408889634f
#define TS 72
#define IMPS 132
#define LDS_BYTES 147520
#define NTHR 512
#define NWAVE 8
#define NPHASE 13

#define MiB (1024ull * 1024ull)
#define WS_HBF   (0ull)
#define WS_DS    (0ull)
#define WS_ST    (32ull * MiB)
#define WS_QK    (64ull * MiB)
#define WS_VT    (256ull * MiB)
#define WS_Y     (352ull * MiB)
#define WS_WT0   (416ull * MiB)
#define WS_WT1   (WS_WT0 + 4352ull * 1024 * 2)
#define WS_WO0   (WS_WT1 + 3840ull * 1024 * 2)
#define WS_WO1   (WS_WO0 + 1024ull * 1024 * 2)
#define WS_W1K   (WS_WO1 + 1024ull * 1024 * 2)
#define WS_W1V   (WS_W1K + 256ull * 2048 * 2)
#define WS_W2K   (WS_W1V + 256ull * 2048 * 2)
#define WS_W2V   (WS_W2K + 256ull * 256 * 2)
#define WS_FLOG  (440ull * MiB)
#define WS_CFOX  (441ull * MiB)
#define WS_GL    (442ull * MiB)
#define WS_HC    (448ull * MiB)
#define WS_KCMP  (456ull * MiB)
#define WS_VCMPT (457ull * MiB)
#define WS_PEP   (458ull * MiB)
#define WS_PEB   (WS_PEP + 65536ull)
#define WS_KMAX  (WS_PEB + 4096ull)
#define WS_SSQ   (459ull * MiB)
#define WS_BAR   (460ull * MiB)

struct Params {
  const float *x, *e_ng, *e_win, *e_bf, *e_gn, *e_wout;
  const float *o_ng, *o_win, *o_bg, *o_pek, *o_pev, *o_wk1, *o_wk2, *o_wv1, *o_wv2, *o_wout, *fin_g;
  float* out;
  unsigned char* ws;
  int ph_lo, ph_hi, coop, pad;
};

typedef __bf16 bf16v2 __attribute__((ext_vector_type(2)));
typedef float f32v2 __attribute__((ext_vector_type(2)));
__device__ __forceinline__ uint32_t pack2(float a, float b) {
  f32v2 v = {a, b};
  bf16v2 r = __builtin_convertvector(v, bf16v2);
  return *(uint32_t*)&r;
}
__device__ __forceinline__ u16 f2bf(float f) { return (u16)(pack2(f, 0.f) & 0xffffu); }
__device__ __forceinline__ float bf2f(u16 h) { return __uint_as_float(((uint32_t)h) << 16); }
__device__ __forceinline__ float ex2(float x) { return __builtin_amdgcn_exp2f(x); }
__device__ __forceinline__ float silu_f(float z) { return z * __builtin_amdgcn_rcpf(1.f + ex2(-z * LOG2E)); }
__device__ __forceinline__ float sigmoid_f(float z) { return __builtin_amdgcn_rcpf(1.f + ex2(-z * LOG2E)); }

__device__ __forceinline__ int opq(int v) { asm volatile("" : "+v"(v)); return v; }
__device__ __forceinline__ int opqs(int v) { asm volatile("" : "+s"(v)); return v; }
#define TIDX opq(p.pad * 64 + (int)__lane_id())
#define BIDX opqs((int)blockIdx.x)
#define MFMA(a, b, c) __builtin_amdgcn_mfma_f32_16x16x32_bf16((a), (b), (c), 0, 0, 0)

__device__ __forceinline__ void rms_rows(const Params& p, const float* __restrict__ x, const float* __restrict__ g, u16* __restrict__ h) {
  const int lane = TIDX & 63, wave = TIDX >> 6;
  for (int row = BIDX * NWAVE + wave; row < MTOK; row += gridDim.x * NWAVE) {
    const float4* xr = (const float4*)(x + (size_t)row * DM);
    float4 v[4];
    float ss = 0.f;
#pragma unroll
    for (int i = 0; i < 4; ++i) {
      v[i] = xr[lane + 64 * i];
      ss += v[i].x * v[i].x + v[i].y * v[i].y + v[i].z * v[i].z + v[i].w * v[i].w;
    }
#pragma unroll
    for (int o = 32; o >= 1; o >>= 1) ss += __shfl_xor(ss, o);
    const float rstd = rsqrtf(ss * (1.f / DM) + 1e-6f);
#pragma unroll
    for (int i = 0; i < 4; ++i) {
      float4 gg = ((const float4*)g)[lane + 64 * i];
      uint2 o;
      o.x = pack2(v[i].x * rstd * gg.x, v[i].y * rstd * gg.y);
      o.y = pack2(v[i].z * rstd * gg.z, v[i].w * rstd * gg.w);
      *(uint2*)(h + (size_t)row * DM + (lane + 64 * i) * 4) = o;
    }
  }
}

__device__ __forceinline__ void rms_rows_fl(const Params& p, float* ldsf) {
  const float* __restrict__ x = p.x; const float* __restrict__ g = p.e_ng;
  u16* __restrict__ h = (u16*)(p.ws + WS_HBF);
  float* __restrict__ fl = (float*)(p.ws + WS_FLOG);
  const int tid = TIDX, lane = tid & 63, wave = tid >> 6;
  for (int i = tid; i < 8 * DM; i += NTHR) { const int j = i >> 10, k = i & 1023; ldsf[i] = g[k] * p.e_win[(size_t)k * 4104 + 1536 + j]; }
  __syncthreads();
  for (int row = BIDX * NWAVE + wave; row < MTOK; row += gridDim.x * NWAVE) {
    const float4* xr = (const float4*)(x + (size_t)row * DM);
    float4 v[4];
    float ss = 0.f;
#pragma unroll
    for (int i = 0; i < 4; ++i) {
      v[i] = xr[lane + 64 * i];
      ss += v[i].x * v[i].x + v[i].y * v[i].y + v[i].z * v[i].z + v[i].w * v[i].w;
    }
#pragma unroll
    for (int o = 32; o >= 1; o >>= 1) ss += __shfl_xor(ss, o);
    const float rstd = rsqrtf(ss * (1.f / DM) + 1e-6f);
#pragma unroll
    for (int i = 0; i < 4; ++i) {
      float4 gg = ((const float4*)g)[lane + 64 * i];
      uint2 o;
      o.x = pack2(v[i].x * rstd * gg.x, v[i].y * rstd * gg.y);
      o.y = pack2(v[i].z * rstd * gg.z, v[i].w * rstd * gg.w);
      *(uint2*)(h + (size_t)row * DM + (lane + 64 * i) * 4) = o;
    }
    float myf = 0.f;
#pragma unroll
    for (int j = 0; j < 8; ++j) {
      float d = 0.f;
#pragma unroll
      for (int i = 0; i < 4; ++i) {
        const float4 w4 = *(const float4*)(ldsf + j * DM + (lane + 64 * i) * 4);
        d += v[i].x * w4.x + v[i].y * w4.y + v[i].z * w4.z + v[i].w * w4.w;
      }
#pragma unroll
      for (int o = 32; o >= 1; o >>= 1) d += __shfl_xor(d, o);
      if (lane == j) myf = d * rstd;
    }
    if (lane < 8) fl[(size_t)row * 8 + lane] = myf;
  }
}

__device__ __forceinline__ int map_col(int MAP, int n) {
  if (MAP == 0) {
    if (n < 1024) return n;
    if (n < 2048) return n + 520;
    if (n < 3072) return n + 1032;
    if (n < 3584) return n - 2048;
    if (n < 4096) return n - 1016;
    if (n < 4104) return n - 2560;
    return -1;
  } else if (MAP == 1) {
    if (n < 1792) return n;
    if (n < 2048) return n + 256;
    if (n < 3072) return n + 560;
    if (n < 3328) return n - 1280;
    if (n < 3584) return n - 1024;
    if (n < 3632) return n - 1024;
    return -1;
  } else if (MAP == 2) {
    return n;
  }
  return n;
}

__device__ __forceinline__ void conv_t(const Params& p, u16* __restrict__ dst, const float* __restrict__ src, int K, int nsrc, int ndst, int MAP) {
  const int total = ndst * (K >> 3);
  for (int id = BIDX * NTHR + TIDX; id < total; id += gridDim.x * NTHR) {
    const int n = id % ndst, kc = id / ndst;
    const int sc = map_col(MAP, n);
    float v[8];
#pragma unroll
    for (int i = 0; i < 8; ++i) v[i] = (sc >= 0 && sc < nsrc) ? src[(size_t)(kc * 8 + i) * nsrc + sc] : 0.f;
    uint4 o;
    o.x = pack2(v[0], v[1]); o.y = pack2(v[2], v[3]); o.z = pack2(v[4], v[5]); o.w = pack2(v[6], v[7]);
    *(uint4*)(dst + (size_t)n * K + kc * 8) = o;
  }
}

__device__ __forceinline__ void pe_partial(const Params& p) {
  float* part = (float*)(p.ws + WS_PEP);
  for (int task = BIDX; task < 32; task += gridDim.x) {
    const int kv = task >> 4, kc = task & 15, n = TIDX;
    if (n >= 256) continue;
    const float* pe = kv ? p.o_pev : p.o_pek;
    const float* w1 = kv ? p.o_wv1 : p.o_wk1;
    float acc = 0.f;
#pragma unroll 16
    for (int k = kc * 128; k < kc * 128 + 128; ++k) acc += pe[k] * w1[(size_t)k * 256 + n];
    part[(kv * 16 + kc) * 256 + n] = acc;
  }
}

#define GST (512 * TS)
template <bool swapped>
__device__ __forceinline__ void gemm_compute(const u16* cur, f32x4 (&acc)[8][4], int wpa, int wpb, int l16, int gk) {
  const u16* sA = cur + (wpa * 128 + l16) * TS + gk * 8;
  const u16* sB = cur + (256 + wpb * 64 + l16) * TS + gk * 8;
#pragma unroll 1
  for (int kk = 0; kk < 2; ++kk) {
    bf16x8 fa[8], fb[4];
#pragma unroll
    for (int i = 0; i < 8; ++i) fa[i] = *(const bf16x8*)(sA + i * 16 * TS + kk * 32);
#pragma unroll
    for (int j = 0; j < 4; ++j) fb[j] = *(const bf16x8*)(sB + j * 16 * TS + kk * 32);
    if (swapped) {
#pragma unroll
      for (int i = 0; i < 8; ++i)
#pragma unroll
        for (int j = 0; j < 4; ++j) acc[i][j] = MFMA(fb[j], fa[i], acc[i][j]);
    } else {
#pragma unroll
      for (int i = 0; i < 8; ++i)
#pragma unroll
        for (int j = 0; j < 4; ++j) acc[i][j] = MFMA(fa[i], fb[j], acc[i][j]);
    }
  }
}
template <bool swapped>
__device__ __forceinline__ void gemm_mainloop(const Params& p, const u16* __restrict__ Ab, const uint32_t (&pa)[4], const u16* __restrict__ Bb,
                                              const uint32_t (&pb)[4], int a_kstride, int nk,
                                              u16* lds, f32x4 (&acc)[8][4],
                                              bool primed = false, const u16* __restrict__ Abn = nullptr, const u16* __restrict__ Bbn = nullptr) {
  const int tid = TIDX, lane = tid & 63, wave = tid >> 6;
  const int l16 = lane & 15, gk = lane >> 4;
  const int wpa = wave >> 2, wpb = wave & 3;
  const int woff = (tid >> 3) * TS + (tid & 7) * 8;
  uint4 ra0, ra1, ra2, ra3, rb0, rb1, rb2, rb3;
#define G_LD(kidx) { const u16* Ap_ = Ab + (size_t)(kidx) * a_kstride; const u16* Bp_ = Bb + (size_t)(kidx) * 64;   \
    ra0 = *(const uint4*)(Ap_ + pa[0]); ra1 = *(const uint4*)(Ap_ + pa[1]); ra2 = *(const uint4*)(Ap_ + pa[2]); ra3 = *(const uint4*)(Ap_ + pa[3]); \
    rb0 = *(const uint4*)(Bp_ + pb[0]); rb1 = *(const uint4*)(Bp_ + pb[1]); rb2 = *(const uint4*)(Bp_ + pb[2]); rb3 = *(const uint4*)(Bp_ + pb[3]); }
#define G_ST(D) { u16* D_ = (D) + woff;                                                                               \
    *(uint4*)(D_) = ra0; *(uint4*)(D_ + 64 * TS) = ra1; *(uint4*)(D_ + 128 * TS) = ra2; *(uint4*)(D_ + 192 * TS) = ra3;  \
    *(uint4*)(D_ + 256 * TS) = rb0; *(uint4*)(D_ + 320 * TS) = rb1; *(uint4*)(D_ + 384 * TS) = rb2; *(uint4*)(D_ + 448 * TS) = rb3; }
  if (!primed) {
    G_LD(0)
    __syncthreads();
    G_ST(lds)
    __syncthreads();
  }
#pragma unroll
  for (int i = 0; i < 8; ++i)
#pragma unroll
    for (int j = 0; j < 4; ++j) acc[i][j] = (f32x4){0.f, 0.f, 0.f, 0.f};
#pragma unroll 1
  for (int ks = 0; ks < nk; ++ks) {
    const bool last = (ks + 1 == nk);
    const bool more = !last || (Abn != nullptr);
    if (more) {
      if (!last) G_LD(ks + 1)
      else { const u16* Ab = Abn; const u16* Bb = Bbn; G_LD(0) }
    }
    gemm_compute<swapped>(lds + (ks & 1) * GST, acc, wpa, wpb, l16, gk);
    if (more) G_ST(lds + ((ks + 1) & 1) * GST)
    __syncthreads();
  }
#undef G_LD
#undef G_ST
}
#define GEMM_OFFS(rowstrideA, rowstrideB)                                   \
  uint32_t pa[4], pb[4];                                                    \
  _Pragma("unroll") for (int i = 0; i < 4; ++i) {                           \
    pa[i] = (uint32_t)((tid >> 3) + 64 * i) * (rowstrideA) + (tid & 7) * 8; \
    pb[i] = (uint32_t)((tid >> 3) + 64 * i) * (rowstrideB) + (tid & 7) * 8; \
  }

__device__ __forceinline__ void gemm_inproj(const Params& p, int layer, u16* lds, int part) {
  const u16* A = (const u16*)(p.ws + WS_HBF);
  const u16* Bt = (const u16*)(p.ws + (layer ? WS_WT1 : WS_WT0));
  u16* QK = (u16*)(p.ws + WS_QK);
  u16* VT = (u16*)(p.ws + WS_VT);
  float* F = (float*)(p.ws + (layer ? WS_GL : WS_FLOG));
  const int NT = layer ? 14 : 16;
  const int seg_trans_end = layer ? 28 : 32;
  const int nvalidF = layer ? 48 : 8, ldf = layer ? 48 : 8;
  const int tid = TIDX, lane = tid & 63, wave = tid >> 6, l16 = lane & 15, gk = lane >> 4;
  const int wpa = wave >> 2, wpb = wave & 3;
  const int bid = BIDX;
  int xcd = bid & 7, nloc = (int)gridDim.x >> 3, lrank = bid >> 3;
  { const uint4 cw = *(const uint4*)((const unsigned char*)lds + 147456);
    const int c0 = __builtin_amdgcn_readfirstlane((int)cw.x), c1 = __builtin_amdgcn_readfirstlane((int)cw.y);
    const int c2 = __builtin_amdgcn_readfirstlane((int)cw.z), c3 = __builtin_amdgcn_readfirstlane((int)cw.w);
    if (c1 == 8 && c0 * 8 == (int)gridDim.x) { xcd = c3; lrank = c2; } }
  const int qbeg = part ? bid - 64 : lrank, qend = part ? (bid >= 64 ? 128 : -(1 << 20)) : 16 * NT, qstep = part ? (int)gridDim.x - 64 : nloc;
  bool primed = false;
  for (int q = qbeg; q < qend; q += qstep) {
    const int mt = part ? q : xcd * 16 + q / NT, nt = part ? NT : q % NT;
    const int m0 = mt * 256, n0 = nt * 256;
    const int qn = q + qstep;
    const bool has_next = (part == 0) && (qn < qend);
    const u16* Abn = has_next ? A + (size_t)((xcd * 16 + qn / NT) * 256) * DM : nullptr;
    const u16* Bbn = has_next ? Bt + (size_t)((qn % NT) * 256) * DM : nullptr;
    const int mw = m0 + wpa * 128, nw = n0 + wpb * 64;
    const int seg = nw >> 7;
    int mode;
    if (seg < 24) mode = (layer == 0 && seg >= 12 && seg < 16) ? 2 : 0;
    else if (seg < seg_trans_end) mode = 1;
    else if (seg == seg_trans_end) mode = 3;
    else mode = 4;
    const int seg0 = nt * 2;
    const bool swapped = !((seg0 >= 24 && seg0 < seg_trans_end) || (layer == 0 && seg0 >= 12 && seg0 < 16));
    GEMM_OFFS(DM, DM)
    f32x4 acc[8][4];
    if (swapped) gemm_mainloop<true>(p, A + (size_t)m0 * DM, pa, Bt + (size_t)n0 * DM, pb, 64, 16, lds, acc, primed, Abn, Bbn);
    else gemm_mainloop<false>(p, A + (size_t)m0 * DM, pa, Bt + (size_t)n0 * DM, pb, 64, 16, lds, acc, primed, Abn, Bbn);
    primed = has_next;
    const float* ssq_g = (const float*)(p.ws + WS_SSQ);
    if (mode == 0 || mode == 3) {
#pragma unroll
      for (int i = 0; i < 8; ++i) {
        const int m = mw + i * 16 + l16;
        const float rs = layer ? rsqrtf(ssq_g[m] * (1.f / DM) + 1e-6f) : 1.f;
#pragma unroll
        for (int j = 0; j < 4; ++j) {
          const int n = nw + j * 16 + gk * 4;
          const float a0 = acc[i][j][0] * rs, a1 = acc[i][j][1] * rs, a2 = acc[i][j][2] * rs, a3 = acc[i][j][3] * rs;
          if (mode == 0) {
            uint2 o; o.x = pack2(a0, a1); o.y = pack2(a2, a3);
            *(uint2*)(QK + (size_t)m * LDQ + n) = o;
          } else {
            const int nn = n - seg * 128;
            if (nn < nvalidF) *(float4*)(F + (size_t)m * ldf + nn) = (float4){a0, a1, a2, a3};
          }
        }
      }
    } else if (mode == 1 || mode == 2) {
#pragma unroll
      for (int i = 0; i < 8; ++i) {
        const int m = mw + i * 16 + gk * 4;
        float rs0 = 1.f, rs1 = 1.f, rs2 = 1.f, rs3 = 1.f;
        if (layer) {
          const float4 q4 = *(const float4*)(ssq_g + m);
          rs0 = rsqrtf(q4.x * (1.f / DM) + 1e-6f); rs1 = rsqrtf(q4.y * (1.f / DM) + 1e-6f);
          rs2 = rsqrtf(q4.z * (1.f / DM) + 1e-6f); rs3 = rsqrtf(q4.w * (1.f / DM) + 1e-6f);
        }
#pragma unroll
        for (int j = 0; j < 4; ++j) {
          const int n = nw + j * 16 + l16;
          const float a0 = acc[i][j][0] * rs0, a1 = acc[i][j][1] * rs1, a2 = acc[i][j][2] * rs2, a3 = acc[i][j][3] * rs3;
          if (mode == 1) {
            const int trow = n - 3072;
            uint2 o; o.x = pack2(a0, a1); o.y = pack2(a2, a3);
            *(uint2*)(VT + (size_t)trow * MTOK + m) = o;
          } else {
            const int trow = n - 512;
            const int h = (nw - 1536) >> 6;
            const float lg2 = log1pf(-exp2f(-5.f - (float)h)) * LOG2E;
            const float lane_dec = 0.125f * ex2(lg2 * (float)(127 - gk * 4));
            QK[(size_t)(m + 0) * LDQ + n] = f2bf(a0); QK[(size_t)(m + 1) * LDQ + n] = f2bf(a1);
            QK[(size_t)(m + 2) * LDQ + n] = f2bf(a2); QK[(size_t)(m + 3) * LDQ + n] = f2bf(a3);
            const float s0 = a0 * lane_dec * ex2(lg2 * (float)(-(i * 16 + 0))), s1 = a1 * lane_dec * ex2(lg2 * (float)(-(i * 16 + 1)));
            const float s2 = a2 * lane_dec * ex2(lg2 * (float)(-(i * 16 + 2))), s3 = a3 * lane_dec * ex2(lg2 * (float)(-(i * 16 + 3)));
            uint2 o; o.x = pack2(s0, s1); o.y = pack2(s2, s3);
            *(uint2*)(VT + (size_t)trow * MTOK + m) = o;
          }
        }
      }
    }
  }
}

__device__ __forceinline__ void gemm_outproj(const Params& p, int layer, u16* lds) {
  const u16* A = (const u16*)(p.ws + WS_Y);
  const u16* Bt = (const u16*)(p.ws + (layer ? WS_WO1 : WS_WO0));
  const float* res = layer ? p.out : p.x;
  float* out = p.out;
  u16* hb_out = (u16*)(p.ws + WS_HBF);
  float* ssq_g = (float*)(p.ws + WS_SSQ);
  const int tid = TIDX, lane = tid & 63, wave = tid >> 6, l16 = lane & 15, gk = lane >> 4;
  const int wpa = wave >> 2, wpb = wave & 3;
  const int bid = BIDX;
  int xcd = bid & 7, nloc = (int)gridDim.x >> 3, lrank = bid >> 3;
  { const uint4 cw = *(const uint4*)((const unsigned char*)lds + 147456);
    const int c0 = __builtin_amdgcn_readfirstlane((int)cw.x), c1 = __builtin_amdgcn_readfirstlane((int)cw.y);
    const int c2 = __builtin_amdgcn_readfirstlane((int)cw.z), c3 = __builtin_amdgcn_readfirstlane((int)cw.w);
    if (c1 == 8 && c0 * 8 == (int)gridDim.x) { xcd = c3; lrank = c2; } }
  bool primed = false;
  for (int q = lrank; q < 16 * 4; q += nloc) {
    const int mt = xcd * 16 + (q >> 2), nt = q & 3;
    const int m0 = mt * 256, n0 = nt * 256;
    const int qn = q + nloc;
    const bool has_next = qn < 16 * 4;
    const u16* Abn = has_next ? A + (size_t)((xcd * 16 + (qn >> 2)) * 256) * DM : nullptr;
    const u16* Bbn = has_next ? Bt + (size_t)((qn & 3) * 256) * DM : nullptr;
    GEMM_OFFS(DM, DM)
    f32x4 acc[8][4];
    gemm_mainloop<true>(p, A + (size_t)m0 * DM, pa, Bt + (size_t)n0 * DM, pb, 64, 16, lds, acc, primed, Abn, Bbn);
    primed = has_next;
    const int tid2 = TIDX, lane2 = tid2 & 63, wave2 = tid2 >> 6, l16b = lane2 & 15, gkb = lane2 >> 4;
    const int mw = m0 + (wave2 >> 2) * 128, nw = n0 + (wave2 & 3) * 64;
#pragma unroll
    for (int i = 0; i < 8; ++i) {
      const int m = mw + i * 16 + l16b;
      float sq = 0.f;
#pragma unroll
      for (int j = 0; j < 4; ++j) {
        const int n = nw + j * 16 + gkb * 4;
        const float4 r = *(const float4*)(res + (size_t)m * DM + n);
        const float4 v = (float4){r.x + acc[i][j][0], r.y + acc[i][j][1], r.z + acc[i][j][2], r.w + acc[i][j][3]};
        *(float4*)(out + (size_t)m * DM + n) = v;
        if (layer == 0) {
          const float4 gg = *(const float4*)(p.o_ng + n);
          uint2 hb; hb.x = pack2(v.x * gg.x, v.y * gg.y); hb.y = pack2(v.z * gg.z, v.w * gg.w);
          *(uint2*)(hb_out + (size_t)m * DM + n) = hb;
          sq += v.x * v.x + v.y * v.y + v.z * v.z + v.w * v.w;
        }
      }
      if (layer == 0) {
        sq += __shfl_xor(sq, 16); sq += __shfl_xor(sq, 32);
        if (gkb == 0) atomicAdd(ssq_g + m, sq);
      }
    }
  }
}

__device__ __forceinline__ void gemm_cmp2_tile(const Params& p, u16* lds, int kv, int mt) {
  const int tid = TIDX, lane = tid & 63, wave = tid >> 6, l16 = lane & 15, gk = lane >> 4;
  const int wpa = wave >> 2, wpb = wave & 3;
  {
    const int m0 = mt * 256;
    const u16* A = (const u16*)(p.ws + WS_HC) + (size_t)kv * 8192 * 256;
    const u16* Bt = (const u16*)(p.ws + (kv ? WS_W2V : WS_W2K));
    GEMM_OFFS(256, 256)
    f32x4 acc[8][4];
    const bool swapped = (kv == 0);
    if (swapped) gemm_mainloop<true>(p, A + (size_t)m0 * 256, pa, Bt, pb, 64, 4, lds, acc);
    else gemm_mainloop<false>(p, A + (size_t)m0 * 256, pa, Bt, pb, 64, 4, lds, acc);
    const int mw = m0 + wpa * 128, nw = wpb * 64;
    if (swapped) {
      u16* kc_ = (u16*)(p.ws + WS_KCMP);
#pragma unroll
      for (int i = 0; i < 8; ++i)
#pragma unroll
        for (int j = 0; j < 4; ++j) {
          const int n = nw + j * 16 + gk * 4;
          const int m = mw + i * 16 + l16;
          if (n < 64) {
            uint2 o; o.x = pack2(acc[i][j][0], acc[i][j][1]); o.y = pack2(acc[i][j][2], acc[i][j][3]);
            *(uint2*)(kc_ + (size_t)m * 64 + n) = o;
          }
        }
      if (wpb == 0) {
        float mxn = 0.f;
#pragma unroll
        for (int i = 0; i < 8; ++i) {
          float ss = 0.f;
#pragma unroll
          for (int j = 0; j < 4; ++j) ss += acc[i][j][0] * acc[i][j][0] + acc[i][j][1] * acc[i][j][1] + acc[i][j][2] * acc[i][j][2] + acc[i][j][3] * acc[i][j][3];
          ss += __shfl_xor(ss, 16); ss += __shfl_xor(ss, 32);
          mxn = fmaxf(mxn, ss);
        }
#pragma unroll
        for (int o2 = 1; o2 <= 8; o2 <<= 1) mxn = fmaxf(mxn, __shfl_xor(mxn, o2));
        if (lane == 0) atomicMax((uint32_t*)(p.ws + WS_KMAX) + 16 + ((mw >> 9) & 3), __float_as_uint(mxn));
      }
    } else {
      u16* vt = (u16*)(p.ws + WS_VCMPT);
#pragma unroll
      for (int i = 0; i < 8; ++i)
#pragma unroll
        for (int j = 0; j < 4; ++j) {
          const int m = mw + i * 16 + gk * 4;
          const int n = nw + j * 16 + l16;
          if (n < 64) {
            uint2 o; o.x = pack2(acc[i][j][0], acc[i][j][1]); o.y = pack2(acc[i][j][2], acc[i][j][3]);
            *(uint2*)(vt + (size_t)(m >> 9) * 32768 + (size_t)n * 512 + (m & 511)) = o;
          }
        }
    }
  }
}

__device__ __forceinline__ void gemm_cmp1(const Params& p, u16* lds) {
  const u16* U = (const u16*)(p.ws + WS_QK);
  const float* peb = (const float*)(p.ws + WS_PEB);
  const int tid = TIDX, lane = tid & 63, wave = tid >> 6, l16 = lane & 15, gk = lane >> 4;
  const int wpa = wave >> 2, wpb = wave & 3;
  for (int tile = BIDX; tile < 64; tile += gridDim.x) {
    const int kv = tile >> 5, mt = tile & 31;
    const int m0 = mt * 256;
    const u16* Bt = (const u16*)(p.ws + (kv ? WS_W1V : WS_W1K));
    u16* Hc = (u16*)(p.ws + WS_HC) + (size_t)kv * 8192 * 256;
    uint32_t pa[4], pb[4];
#pragma unroll
    for (int i = 0; i < 4; ++i) {
      const int row = (tid >> 3) + 64 * i, kc = tid & 7;
      const int r = m0 + row, bg = r >> 9, cc = r & 511, b = bg >> 2, g = bg & 3;
      int tok0 = cc * 16; if (tok0 > SEQ - 32) tok0 = SEQ - 32;
      pa[i] = (uint32_t)(b * SEQ + tok0) * LDQ + 1024 + kv * 256 + g * 64 + kc * 8;
      pb[i] = (uint32_t)row * 2048 + kc * 8;
    }
    f32x4 acc[8][4];
    gemm_mainloop<true>(p, U, pa, Bt, pb, LDQ, 32, lds, acc);
    const int tid2 = TIDX, lane2 = tid2 & 63, wave2 = tid2 >> 6;
    const int mw = m0 + (wave2 >> 2) * 128, nw = (wave2 & 3) * 64;
#pragma unroll
    for (int i = 0; i < 8; ++i)
#pragma unroll
      for (int j = 0; j < 4; ++j) {
        const int n = nw + j * 16 + (lane2 >> 4) * 4;
        const int m = mw + i * 16 + (lane2 & 15);
        const float4 bb = *(const float4*)(peb + kv * 256 + n);
        float v0 = silu_f(acc[i][j][0] + bb.x), v1 = silu_f(acc[i][j][1] + bb.y);
        float v2 = silu_f(acc[i][j][2] + bb.z), v3 = silu_f(acc[i][j][3] + bb.w);
        if ((m & 511) == 511) { v0 = v1 = v2 = v3 = 0.f; }
        uint2 o; o.x = pack2(v0, v1); o.y = pack2(v2, v3);
        *(uint2*)(Hc + (size_t)m * 256 + n) = o;
      }
    __threadfence_block();
    __syncthreads();
    gemm_cmp2_tile(p, lds, kv, mt);
  }
}

#define TILE_LD(R, src, stride) { R##0 = *(const uint4*)((src) + (long)(tid >> 3) * (stride) + (tid & 7) * 8); }
#define TILE_ST(dst, R) { *(uint4*)((dst) + (tid >> 3) * TS + (tid & 7) * 8) = R##0; }
#define VPOS(c) ((((c) >> 2) * 32) + ((2 * ((c) & 1)) * 8) + ((((c) & 3) >> 1) * 4))
#define TILE_STV_(dst, val) { const int c_ = tid & 7; u16* d_ = (dst) + (tid >> 3) * TS + VPOS(c_); \
    *(uint2*)(d_) = make_uint2((val).x, (val).y); *(uint2*)(d_ + 8) = make_uint2((val).z, (val).w); }
#define TILE_STV(dst, R) TILE_STV_(dst, R##0)
__device__ __forceinline__ void qk_tile(const u16* sK, const bf16x8 (&q)[2], f32x4 (&s)[4], int l16, int gk) {
#pragma unroll
  for (int kt = 0; kt < 4; ++kt) s[kt] = (f32x4){0.f, 0.f, 0.f, 0.f};
#pragma unroll
  for (int ks = 0; ks < 2; ++ks)
#pragma unroll
    for (int kt = 0; kt < 4; ++kt) {
      bf16x8 kf = *(const bf16x8*)(sK + (kt * 16 + l16) * TS + ks * 32 + gk * 8);
      s[kt] = MFMA(kf, q[ks], s[kt]);
    }
}
__device__ __forceinline__ void pv_tile(const u16* sV, const float (&pp)[4][4], f32x4 (&o)[4], int l16, int gk) {
  bf16x8 pf[2];
#pragma unroll
  for (int ks2 = 0; ks2 < 2; ++ks2) {
    uint4 t;
    t.x = pack2(pp[2 * ks2][0], pp[2 * ks2][1]); t.y = pack2(pp[2 * ks2][2], pp[2 * ks2][3]);
    t.z = pack2(pp[2 * ks2 + 1][0], pp[2 * ks2 + 1][1]); t.w = pack2(pp[2 * ks2 + 1][2], pp[2 * ks2 + 1][3]);
    pf[ks2] = *(bf16x8*)&t;
  }
#pragma unroll
  for (int dt = 0; dt < 4; ++dt)
#pragma unroll
    for (int ks2 = 0; ks2 < 2; ++ks2) {
      const bf16x8 vf = *(const bf16x8*)(sV + (dt * 16 + l16) * TS + ks2 * 32 + gk * 8);
      o[dt] = MFMA(vf, pf[ks2], o[dt]);
    }
}

__device__ __forceinline__ void fox_phase(const Params& p, u16* lds) {
  const u16* QK = (const u16*)(p.ws + WS_QK);
  const u16* VT = (const u16*)(p.ws + WS_VT);
  const float* cf = (const float*)(p.ws + WS_CFOX);
  u16* Y = (u16*)(p.ws + WS_Y);
  const int tid = TIDX, lane = tid & 63, w = tid >> 6, l16 = lane & 15, gk = lane >> 4;
  const float scale2 = 0.125f * LOG2E;
  for (int unit = BIDX; unit < 2048; unit += gridDim.x) {
    const int bh = unit & 31, qblk = 63 - (unit >> 5), b = bh >> 3, h = bh & 7;
    const int tq0 = qblk * 128 + w * 16;
    const int t = tq0 + l16;
    const float* cfr = cf + (size_t)bh * SEQ;
    bf16x8 q[2];
#pragma unroll
    for (int ks = 0; ks < 2; ++ks) q[ks] = *(const bf16x8*)(QK + (size_t)(b * SEQ + t) * LDQ + h * 64 + ks * 32 + gk * 8);
    const float cq2 = cfr[t] * LOG2E;
    f32x4 o[4];
    float m = -1e30f, l = 0.f;
#pragma unroll
    for (int dt = 0; dt < 4; ++dt) o[dt] = (f32x4){0.f, 0.f, 0.f, 0.f};
    const int ntiles = qblk * 2 + 2;
    const int iw = qblk * 2 + (w >> 2);
    const u16* ksrc = QK + (size_t)(b * SEQ) * LDQ + 512 + h * 64;
    const u16* vsrc = VT + (size_t)(h * 64) * MTOK + (size_t)b * SEQ;
    float qs = 0.f;
#pragma unroll
    for (int ks = 0; ks < 2; ++ks)
#pragma unroll
      for (int e = 0; e < 8; ++e) { const float v = bf2f((u16)q[ks][e]); qs += v * v; }
    qs += __shfl_xor(qs, 16); qs += __shfl_xor(qs, 32);
#pragma unroll
    for (int o2 = 1; o2 <= 8; o2 <<= 1) qs = fmaxf(qs, __shfl_xor(qs, o2));
    float* red = (float*)(lds + 256 * TS);
    if (lane == 0) red[w] = qs;
    __syncthreads();
    float qmax2 = red[0];
#pragma unroll
    for (int i = 1; i < NWAVE; ++i) qmax2 = fmaxf(qmax2, red[i]);
    const float kmax2 = __uint_as_float(((const uint32_t*)(p.ws + WS_KMAX))[h]);
    const float T2 = 2.f * scale2 * sqrtf(qmax2 * kmax2) * 1.001f + 48.f;
    const float cfirst2 = cfr[qblk * 128] * LOG2E;
    int i_lo = 0;
    for (int base = qblk * 2 - 1; base >= 0; base -= 64) {
      const int ti = base - lane;
      bool skip = false;
      if (ti >= 0) skip = (cfirst2 - cfr[ti * 64 + 63] * LOG2E) < -T2;
      const unsigned long long bal = __ballot(skip);
      if (bal) { i_lo = base - (int)__builtin_ctzll(bal) + 1; break; }
    }
    uint4 rk0, rv0;
    TILE_LD(rk, ksrc + (size_t)i_lo * 64 * LDQ, LDQ); TILE_LD(rv, vsrc + i_lo * 64, MTOK);
    TILE_ST(lds + (i_lo & 1) * (128 * TS), rk); TILE_STV(lds + (i_lo & 1) * (128 * TS) + 64 * TS, rv);
    __syncthreads();
    for (int i = i_lo; i < ntiles; ++i) {
      u16* cur = lds + (i & 1) * (128 * TS);
      const bool more = (i + 1 < ntiles);
      if (more) { TILE_LD(rk, ksrc + (size_t)(i + 1) * 64 * LDQ, LDQ); TILE_LD(rv, vsrc + (i + 1) * 64, MTOK); }
      if (i <= iw) {
        const int s0 = i * 64;
        const bool diag = (i == iw);
        f32x4 s[4];
        qk_tile(cur, q, s, l16, gk);
        float xv[4][4];
        float mx = -1e30f;
#pragma unroll
        for (int kt = 0; kt < 4; ++kt) {
          const float4 c4 = *(const float4*)(cfr + s0 + kt * 16 + gk * 4);
          const float ck[4] = {c4.x, c4.y, c4.z, c4.w};
#pragma unroll
          for (int r = 0; r < 4; ++r) {
            float v = fmaf(s[kt][r], scale2, cq2 - ck[r] * LOG2E);
            if (diag && (s0 + kt * 16 + gk * 4 + r > t)) v = -1e30f;
            xv[kt][r] = v; mx = fmaxf(mx, v);
          }
        }
        mx = fmaxf(mx, __shfl_xor(mx, 16)); mx = fmaxf(mx, __shfl_xor(mx, 32));
        const float mnew = fmaxf(m, mx);
        const float alpha = ex2(m - mnew);
        m = mnew;
        const float muse = fmaxf(mnew, -1e20f);
        float rs = 0.f;
#pragma unroll
        for (int kt = 0; kt < 4; ++kt)
#pragma unroll
          for (int r = 0; r < 4; ++r) { xv[kt][r] = ex2(xv[kt][r] - muse); rs += xv[kt][r]; }
        l = l * alpha + rs;
#pragma unroll
        for (int dt = 0; dt < 4; ++dt) o[dt] *= alpha;
        pv_tile(cur + 64 * TS, xv, o, l16, gk);
      }
      if (more) { u16* nxt = lds + ((i + 1) & 1) * (128 * TS); TILE_ST(nxt, rk); TILE_STV(nxt + 64 * TS, rv); }
      __syncthreads();
    }
    {
      float lt = l; lt += __shfl_xor(lt, 16); lt += __shfl_xor(lt, 32);
      const float inv = lt > 0.f ? 1.f / lt : 0.f;
      const size_t mrow = (size_t)(b * SEQ + t);
#pragma unroll
      for (int dt = 0; dt < 4; ++dt) {
        const int col = h * 64 + dt * 16 + gk * 4;
        const uint2 zz = *(const uint2*)(QK + mrow * LDQ + 2048 + col);
        const float z0 = bf2f(zz.x & 0xffff), z1 = bf2f(zz.x >> 16), z2 = bf2f(zz.y & 0xffff), z3 = bf2f(zz.y >> 16);
        uint2 ov;
        ov.x = pack2(o[dt][0] * inv * silu_f(z0), o[dt][1] * inv * silu_f(z1));
        ov.y = pack2(o[dt][2] * inv * silu_f(z2), o[dt][3] * inv * silu_f(z3));
        *(uint2*)(Y + mrow * DM + col) = ov;
      }
    }
  }
}

__device__ __forceinline__ void fox_knorm(const Params& p) {
  const u16* QK = (const u16*)(p.ws + WS_QK);
  uint32_t* km = (uint32_t*)(p.ws + WS_KMAX);
  const int tid = TIDX, lane = tid & 63, wave = tid >> 6;
  float mx = 0.f;
  for (int row = BIDX * NWAVE + wave; row < MTOK; row += gridDim.x * NWAVE) {
    const uint4 v = *(const uint4*)(QK + (size_t)row * LDQ + 512 + lane * 8);
    const float a0 = bf2f(v.x & 0xffff), a1 = bf2f(v.x >> 16), a2 = bf2f(v.y & 0xffff), a3 = bf2f(v.y >> 16);
    const float a4 = bf2f(v.z & 0xffff), a5 = bf2f(v.z >> 16), a6 = bf2f(v.w & 0xffff), a7 = bf2f(v.w >> 16);
    float ss = a0 * a0 + a1 * a1 + a2 * a2 + a3 * a3 + a4 * a4 + a5 * a5 + a6 * a6 + a7 * a7;
    ss += __shfl_xor(ss, 1); ss += __shfl_xor(ss, 2); ss += __shfl_xor(ss, 4);
    mx = fmaxf(mx, ss);
  }
  if ((lane & 7) == 0) atomicMax(&km[lane >> 3], __float_as_uint(mx));
}

__device__ __forceinline__ void fox_scan(const Params& p, float* ldsf) {
  const float* fl = (const float*)(p.ws + WS_FLOG);
  float* cf = (float*)(p.ws + WS_CFOX);
  double* sd = (double*)ldsf;
  const int tid = TIDX;
  for (int bh = BIDX; bh < 32; bh += gridDim.x) {
    const int b = bh >> 3, h = bh & 7;
    const float bf = p.e_bf[h];
    float ls[16];
    double sum = 0.0;
#pragma unroll
    for (int i = 0; i < 16; ++i) {
      const float xx = fl[(size_t)(b * SEQ + tid * 16 + i) * 8 + h] + bf;
      ls[i] = fminf(xx, 0.f) - log1pf(__expf(-fabsf(xx)));
      sum += (double)ls[i];
    }
    __syncthreads();
    sd[tid] = sum;
    __syncthreads();
    double pre = 0.0;
    for (int j = 0; j < tid; ++j) pre += sd[j];
#pragma unroll
    for (int i = 0; i < 16; ++i) { pre += (double)ls[i]; cf[(size_t)bh * SEQ + tid * 16 + i] = (float)pre; }
  }
}

__device__ __forceinline__ void ret_stepA(const Params& p) {
  const u16* VT = (const u16*)(p.ws + WS_VT);
  float* dS = (float*)(p.ws + WS_DS);
  const int tid_ = TIDX, lane = tid_ & 63, w8 = tid_ >> 6, w = w8 & 3, l16 = lane & 15, gk = lane >> 4;
  for (int u2 = BIDX; u2 < 1024; u2 += gridDim.x) {
    const int u = u2 * 2 + (w8 >> 2);
    const int bh = u >> 6, n = u & 63, b = bh >> 3, h = bh & 7;
    const size_t mcol = (size_t)b * SEQ + n * 128;
    f32x4 acc[4];
#pragma unroll
    for (int dt = 0; dt < 4; ++dt) acc[dt] = (f32x4){0.f, 0.f, 0.f, 0.f};
#pragma unroll
    for (int ks = 0; ks < 4; ++ks) {
      bf16x8 af = *(const bf16x8*)(VT + (size_t)(512 + h * 64 + w * 16 + l16) * MTOK + mcol + ks * 32 + gk * 8);
#pragma unroll
      for (int dt = 0; dt < 4; ++dt) {
        bf16x8 bfr = *(const bf16x8*)(VT + (size_t)(1024 + h * 64 + dt * 16 + l16) * MTOK + mcol + ks * 32 + gk * 8);
        acc[dt] = MFMA(af, bfr, acc[dt]);
      }
    }
#pragma unroll
    for (int dt = 0; dt < 4; ++dt)
#pragma unroll
      for (int r = 0; r < 4; ++r) dS[(size_t)u * 4096 + (w * 16 + gk * 4 + r) * 64 + dt * 16 + l16] = acc[dt][r];
  }
}
__device__ __forceinline__ void ret_stepB(const Params& p) {
  const float* dS = (const float*)(p.ws + WS_DS);
  u16* st = (u16*)(p.ws + WS_ST);
  for (int idx = BIDX * NTHR + TIDX; idx < 32 * 4096; idx += gridDim.x * NTHR) {
    const int bh = idx >> 12, ed = idx & 4095, h = bh & 7;
    const float cdec = __expf(log1pf(-exp2f(-5.f - (float)h)) * 128.f);
    float s = 0.f;
#pragma unroll 8
    for (int n = 0; n < 64; ++n) {
      const size_t a = (size_t)(bh * 64 + n) * 4096 + ed;
      st[a] = f2bf(s);
      s = s * cdec + dS[a];
    }
  }
}
__device__ __forceinline__ void ret_stepC(const Params& p, u16* lds) {
  const u16* QK = (const u16*)(p.ws + WS_QK);
  const u16* VT = (const u16*)(p.ws + WS_VT);
  const u16* st = (const u16*)(p.ws + WS_ST);
  u16* Y = (u16*)(p.ws + WS_Y);
  const int tid = TIDX, lane = tid & 63, w = tid >> 6, l16 = lane & 15, gk = lane >> 4;
  for (int u = BIDX; u < 2048; u += gridDim.x) {
    const int bh = u >> 6, n = u & 63, b = bh >> 3, h = bh & 7;
    const size_t m0 = (size_t)b * SEQ + n * 128;
    const float lg2 = log1pf(-exp2f(-5.f - (float)h)) * LOG2E;
    __syncthreads();
    {
      uint4 r0;
      TILE_LD(r, QK + m0 * LDQ + 1536 + h * 64, LDQ); TILE_ST(lds, r);
      TILE_LD(r, VT + (size_t)(512 + h * 64) * MTOK + m0, MTOK); TILE_STV(lds + 64 * TS, r);
      TILE_LD(r, QK + (m0 + 64) * LDQ + 1536 + h * 64, LDQ); TILE_ST(lds + 128 * TS, r);
      TILE_LD(r, VT + (size_t)(512 + h * 64) * MTOK + m0 + 64, MTOK); TILE_STV(lds + 192 * TS, r);
      TILE_LD(r, st + (size_t)u * 4096, 64); TILE_ST(lds + 256 * TS, r);
    }
    __syncthreads();
    const int iq = 16 * w + l16;
    const size_t mrow = m0 + iq;
    bf16x8 q[2];
#pragma unroll
    for (int ks = 0; ks < 2; ++ks) q[ks] = *(const bf16x8*)(QK + mrow * LDQ + 1024 + h * 64 + ks * 32 + gk * 8);
    f32x4 o[4];
#pragma unroll
    for (int dt = 0; dt < 4; ++dt) o[dt] = (f32x4){0.f, 0.f, 0.f, 0.f};
#pragma unroll
    for (int dt = 0; dt < 4; ++dt)
#pragma unroll
      for (int ks = 0; ks < 2; ++ks) {
        bf16x8 sf = *(const bf16x8*)(lds + 256 * TS + (dt * 16 + l16) * TS + ks * 32 + gk * 8);
        o[dt] = MFMA(sf, q[ks], o[dt]);
      }
    const float cross = ex2(lg2 * (float)(iq + 1));
#pragma unroll
    for (int dt = 0; dt < 4; ++dt) o[dt] *= cross;
#pragma unroll
    for (int k64 = 0; k64 < 2; ++k64) {
      if (k64 * 64 <= 16 * w + 15) {
        f32x4 s[4];
        qk_tile(lds + k64 * 128 * TS, q, s, l16, gk);
        float pp[4][4];
#pragma unroll
        for (int kt = 0; kt < 4; ++kt)
#pragma unroll
          for (int r = 0; r < 4; ++r) {
            const int j = k64 * 64 + kt * 16 + gk * 4 + r;
            pp[kt][r] = (j <= iq) ? s[kt][r] * 0.125f * ex2(lg2 * (float)(iq - j)) : 0.f;
          }
        pv_tile(lds + k64 * 128 * TS + 64 * TS, pp, o, l16, gk);
      }
    }
    float sm = 0.f;
#pragma unroll
    for (int dt = 0; dt < 4; ++dt) sm += o[dt][0] + o[dt][1] + o[dt][2] + o[dt][3];
    sm += __shfl_xor(sm, 16); sm += __shfl_xor(sm, 32);
    const float mu = sm * (1.f / 64.f);
    float vs = 0.f;
#pragma unroll
    for (int dt = 0; dt < 4; ++dt)
#pragma unroll
      for (int r = 0; r < 4; ++r) { const float d = o[dt][r] - mu; vs += d * d; }
    vs += __shfl_xor(vs, 16); vs += __shfl_xor(vs, 32);
    const float rstd = rsqrtf(vs * (1.f / 64.f) + 1e-5f);
#pragma unroll
    for (int dt = 0; dt < 4; ++dt) {
      const int col = h * 64 + dt * 16 + gk * 4;
      const float4 gg = *(const float4*)(p.e_gn + col);
      const uint2 zz = *(const uint2*)(QK + mrow * LDQ + 2048 + 512 + col);
      const float z0 = bf2f(zz.x & 0xffff), z1 = bf2f(zz.x >> 16), z2 = bf2f(zz.y & 0xffff), z3 = bf2f(zz.y >> 16);
      uint2 ov;
      ov.x = pack2((o[dt][0] - mu) * rstd * gg.x * silu_f(z0), (o[dt][1] - mu) * rstd * gg.y * silu_f(z1));
      ov.y = pack2((o[dt][2] - mu) * rstd * gg.z * silu_f(z2), (o[dt][3] - mu) * rstd * gg.w * silu_f(z3));
      *(uint2*)(Y + mrow * DM + 512 + col) = ov;
    }
  }
}

__device__ __forceinline__ void nsa_tile_interior(const u16* sK, const u16* sV, const bf16x8 (&q)[2], f32x4 (&acc)[4],
                                                  float& m, float& l, float slope2, const float (&sk)[16],
                                                  int t, int pos0, bool lanesel, int lane) {
  const int l16 = lane & 15, gk = lane >> 4;
  const float scale2 = 0.125f * LOG2E;
  f32x4 s[4];
  qk_tile(sK, q, s, l16, gk);
  const float c0 = fmaf(-slope2, (float)(t - pos0 - gk * 4), lanesel ? 0.f : -1e30f);
  float xv[4][4];
  float mx = -1e30f;
#pragma unroll
  for (int kt = 0; kt < 4; ++kt)
#pragma unroll
    for (int r = 0; r < 4; ++r) { xv[kt][r] = fmaf(s[kt][r], scale2, sk[kt * 4 + r]); mx = fmaxf(mx, xv[kt][r]); }
  mx += c0;
  mx = fmaxf(mx, __shfl_xor(mx, 16)); mx = fmaxf(mx, __shfl_xor(mx, 32));
  const float mnew = fmaxf(m, mx);
  const float alpha = ex2(m - mnew);
  m = mnew;
  const float off = c0 - fmaxf(mnew, -1e20f);
  float rs = 0.f;
#pragma unroll
  for (int kt = 0; kt < 4; ++kt)
#pragma unroll
    for (int r = 0; r < 4; ++r) { xv[kt][r] = ex2(xv[kt][r] + off); rs += xv[kt][r]; }
  l = l * alpha + rs;
  if (__any(alpha != 1.f)) {
#pragma unroll
    for (int dt = 0; dt < 4; ++dt) acc[dt] *= alpha;
  }
  pv_tile(sV, xv, acc, l16, gk);
}
template <int BR>
__device__ __forceinline__ void nsa_tile(const u16* sK, const u16* sV, const bf16x8 (&q)[2], f32x4 (&acc)[4],
                                         float& m, float& l, float slope2, float gmul,
                                         int t, int pos0, int pstride, int wl, bool lanesel,
                                         float* imp_row, int jbase, float& carry, int lane, float* imp_scale = nullptr) {
  const int l16 = lane & 15, gk = lane >> 4;
  const float scale2 = 0.125f * LOG2E;
  const unsigned wle = lanesel ? (unsigned)wl : 0u;
  f32x4 s[4];
  qk_tile(sK, q, s, l16, gk);
  float xv[4][4];
  float mx = -1e30f;
#pragma unroll
  for (int kt = 0; kt < 4; ++kt)
#pragma unroll
    for (int r = 0; r < 4; ++r) {
      const int dist = t - (pos0 + (kt * 16 + gk * 4 + r) * pstride);
      const float pen = ((unsigned)dist < wle) ? 0.f : -1e30f;
      const float v = fmaf(s[kt][r], scale2, fmaf(-slope2, (float)dist, pen));
      xv[kt][r] = v; mx = fmaxf(mx, v);
    }
  if (BR != 1) {
    mx = fmaxf(mx, __shfl_xor(mx, 16)); mx = fmaxf(mx, __shfl_xor(mx, 32));
    const float mnew = fmaxf(m, mx);
    const float alpha = ex2(m - mnew);
    m = mnew;
    const float muse = fmaxf(mnew, -1e20f);
    float rs = 0.f;
#pragma unroll
    for (int kt = 0; kt < 4; ++kt)
#pragma unroll
      for (int r = 0; r < 4; ++r) { xv[kt][r] = ex2(xv[kt][r] - muse); rs += xv[kt][r]; }
    l = l * alpha + rs;
    if (BR == 2 || BR == 3) {
#pragma unroll
      for (int dt = 0; dt < 4; ++dt) acc[dt] *= alpha;
    }
    if (BR == 3) {
      float p3[4];
#pragma unroll
      for (int kt = 0; kt < 4; ++kt) {
        p3[kt] = xv[kt][3];
        imp_row[jbase + kt * 4 + gk] = 2.f * (xv[kt][0] + xv[kt][1] + xv[kt][2]) + xv[kt][3];
      }
      const int srcl = (lane + 48) & 63;
      const float carry_s = carry * alpha;
#pragma unroll
      for (int kt = 0; kt < 4; ++kt) {
        const float same = __shfl(p3[kt], srcl);
        const float prev = __shfl(kt > 0 ? p3[kt > 0 ? kt - 1 : 0] : carry_s, srcl);
        imp_row[jbase + kt * 4 + gk] += (gk == 0) ? prev : same;
      }
      carry = p3[3];
      if (gk == 0) *imp_scale = mnew;
    }
    if (BR == 2 || BR == 3) pv_tile(sV, xv, acc, l16, gk);
  } else {
    const float muse = fmaxf(m, -1e20f);
    float p3[4];
#pragma unroll
    for (int kt = 0; kt < 4; ++kt) {
      float pn[4];
#pragma unroll
      for (int r = 0; r < 4; ++r) { pn[r] = ex2(xv[kt][r] - muse) * l; xv[kt][r] = pn[r] * gmul; }
      p3[kt] = pn[3];
      xv[kt][0] = xv[kt][0];
      imp_row[jbase + kt * 4 + gk] = 2.f * (pn[0] + pn[1] + pn[2]) + pn[3];
    }
    const int srcl = (lane + 48) & 63;
#pragma unroll
    for (int kt = 0; kt < 4; ++kt) {
      const float same = __shfl(p3[kt], srcl);
      const float prev = __shfl(kt > 0 ? p3[kt > 0 ? kt - 1 : 0] : carry, srcl);
      imp_row[jbase + kt * 4 + gk] += (gk == 0) ? prev : same;
    }
    carry = p3[3];
    pv_tile(sV, xv, acc, l16, gk);
  }
}

__device__ __forceinline__ void nsa_phase(const Params& p, u16* lds) {
  const u16* U = (const u16*)(p.ws + WS_QK);
  const u16* VT = (const u16*)(p.ws + WS_VT);
  const u16* KC = (const u16*)(p.ws + WS_KCMP);
  const u16* VC = (const u16*)(p.ws + WS_VCMPT);
  const float* GL = (const float*)(p.ws + WS_GL);
  u16* Y = (u16*)(p.ws + WS_Y);
  float* imp = (float*)(lds + 512 * TS);
  uint32_t* umask = (uint32_t*)(imp + 128 * IMPS);
  int* ulist = (int*)(umask + 4);
  const int tid = TIDX, lane = tid & 63, w = tid >> 6, l16 = lane & 15, gk = lane >> 4;
  const int qt = w & 1, hd = w >> 1;
  uint2* totl = (uint2*)imp + 128 + (size_t)w * 256 + lane;
  const int BIG = 1 << 30;
  int* uslot = ulist + 128;
  unsigned* uctr = (unsigned*)(p.ws + WS_KMAX) + 24;
  for (;;) {
    __syncthreads();
    if (tid == 0) uslot[0] = (int)atomicAdd(uctr, 1u);
    __syncthreads();
    const int unit = uslot[0];
    if (unit >= 4096) break;
    const int bg = unit & 15, qh = 255 - (unit >> 4), b = bg >> 2, g = bg & 3;
    const int t0 = qh * 32, qb = t0 >> 6, t = t0 + 16 * qt + l16;
    const size_t mrow = (size_t)b * SEQ + t;
    const int h = g * 4 + hd;
    bf16x8 q[2];
#pragma unroll
    for (int ks = 0; ks < 2; ++ks) q[ks] = *(const bf16x8*)(U + mrow * LDQ + h * 64 + ks * 32 + gk * 8);
    const float slope2 = exp2f(-0.5f * (float)(h + 1)) * LOG2E;
    const float g1 = sigmoid_f(GL[mrow * 48 + h * 3] + p.o_bg[h * 3]);
    float sk[16];
#pragma unroll
    for (int i = 0; i < 16; ++i) sk[i] = slope2 * (float)((i >> 2) * 16 + (i & 3));
    float qn2 = 0.f;
#pragma unroll
    for (int ks = 0; ks < 2; ++ks)
#pragma unroll
      for (int e = 0; e < 8; ++e) { const float v = bf2f((u16)q[ks][e]); qn2 += v * v; }
    qn2 += __shfl_xor(qn2, 16); qn2 += __shfl_xor(qn2, 32);
#pragma unroll
    for (int o2 = 1; o2 <= 8; o2 <<= 1) qn2 = fmaxf(qn2, __shfl_xor(qn2, o2));
    const uint32_t* kmx = (const uint32_t*)(p.ws + WS_KMAX);
    const float sc2 = 0.125f * LOG2E;
    const float T_slc = 2.02f * sc2 * sqrtf(qn2 * __uint_as_float(kmx[8 + g])) + 48.f;
    const float T_win = 2.02f * sc2 * sqrtf(qn2 * __uint_as_float(kmx[12 + g])) + 48.f;
    const float T_cmp = 2.05f * sc2 * sqrtf(qn2 * __uint_as_float(kmx[16 + g])) + 16.f * slope2 + 48.f;
    const int tq0w = t0 + 16 * qt;
    f32x4 acc[4];
    float m = -1e30f, l = 0.f;
#pragma unroll
    for (int dt = 0; dt < 4; ++dt) acc[dt] = (f32x4){0.f, 0.f, 0.f, 0.f};
    __syncthreads();
    for (int i = tid; i < 128 * IMPS; i += NTHR) imp[i] = 0.f;
    if (tid < 4) umask[tid] = 0u;
    float* imp_row = imp + (hd * 32 + 16 * qt + l16) * IMPS;
    float carry = 0.f;
    uint4 rk0, rk1, rk2, rk3, rv0, rv1, rv2, rv3;
    u16* impbase_unused = nullptr; (void)impbase_unused;
#define SLOT(k) (lds + (k) * (128 * TS))
#define LD1(k, kp, ks_, vp, vs_) { rk##k = *(const uint4*)((kp) + (long)(tid >> 3) * (ks_) + (tid & 7) * 8); rv##k = *(const uint4*)((vp) + (long)(tid >> 3) * (vs_) + (tid & 7) * 8); }
#define ST1(k) { *(uint4*)(SLOT(k) + (tid >> 3) * TS + (tid & 7) * 8) = rk##k; TILE_STV_(SLOT(k) + 64 * TS, rv##k) }
    const int ntc = ((t0 >> 4) >> 6) + 1;
    const u16* kcs = KC + (size_t)bg * 512 * 64;
    const u16* vcs = VC + (size_t)bg * 32768;
#define CMP_LD(k, i) if ((i) < ntc) LD1(k, kcs + (size_t)(i) * 64 * 64, 64, vcs + (i) * 64, 512)
    float* mrec = (float*)(uslot + 4) + (w * 16 + l16) * 8;
    {
      const int ngrp = (ntc + 3) >> 2;
      CMP_LD(0, 0) CMP_LD(1, 1) CMP_LD(2, 2) CMP_LD(3, 3)
#pragma unroll 1
      for (int gi = 0; gi < ngrp; ++gi) {
        const int ib = gi * 4;
        __syncthreads();
        if (ib < ntc) ST1(0) if (ib + 1 < ntc) ST1(1) if (ib + 2 < ntc) ST1(2) if (ib + 3 < ntc) ST1(3)
        __syncthreads();
        if (gi + 1 < ngrp) { CMP_LD(0, ib + 4) CMP_LD(1, ib + 5) CMP_LD(2, ib + 6) CMP_LD(3, ib + 7) }
#pragma unroll 1
        for (int k = 0; k < 4; ++k) {
          const int i = ib + k;
          if (i < ntc) {
            const int dmin = tq0w - (16 * (64 * i + 63) + 31);
            if (dmin > 0 && slope2 * (float)dmin > T_cmp) { carry = 0.f; if (gk == 0) mrec[i] = -1e30f; continue; }
            nsa_tile<3>(SLOT(k), SLOT(k) + 64 * TS, q, acc, m, l, slope2, g1, t, 16 * (64 * i) + 31, 16, BIG, true, imp_row, 16 * i, carry, lane, mrec + i);
          }
        }
      }
      float lt = l; lt += __shfl_xor(lt, 16); lt += __shfl_xor(lt, 32);
      const float inv = lt > 0.f ? 1.f / lt : 0.f;
      const float mfin = fmaxf(m, -1e20f);
#pragma unroll 1
      for (int i = 0; i < ntc; ++i) {
        const float f = ex2(fmaxf(mrec[i], -1e20f) - mfin) * inv;
#pragma unroll
        for (int kt = 0; kt < 4; ++kt) imp_row[16 * i + kt * 4 + gk] *= f;
      }
      const float og = g1 * inv;
#pragma unroll
      for (int dt = 0; dt < 4; ++dt) acc[dt] *= og;
    }
    __syncthreads();
    {
      const int qi = w * 4 + gk;
      const int c8 = l16 * 8;
      uint32_t selb = 0u;
      if (qb < 16) {
#pragma unroll
        for (int i = 0; i < 8; ++i) if (c8 + i <= qb) selb |= (1u << i);
      } else {
        float val[8];
        const float* ra = imp + qi * IMPS + c8;
#pragma unroll
        for (int i4 = 0; i4 < 2; ++i4) {
          const float4 v0 = *(const float4*)(ra + 4 * i4);
          const float4 v1 = *(const float4*)(ra + 32 * IMPS + 4 * i4);
          const float4 v2 = *(const float4*)(ra + 64 * IMPS + 4 * i4);
          const float4 v3 = *(const float4*)(ra + 96 * IMPS + 4 * i4);
          val[4 * i4] = ((v0.x + v1.x) + v2.x) + v3.x; val[4 * i4 + 1] = ((v0.y + v1.y) + v2.y) + v3.y;
          val[4 * i4 + 2] = ((v0.z + v1.z) + v2.z) + v3.z; val[4 * i4 + 3] = ((v0.w + v1.w) + v2.w) + v3.w;
        }
#pragma unroll
        for (int i = 0; i < 8; ++i) {
          const int j = c8 + i;
          const bool forced = (j == 0) || (j == qb) || (j == qb - 1);
          if (forced) selb |= (1u << i);
          if (forced || j > qb) val[i] = -1.f;
        }
#pragma unroll 1
        for (int it = 0; it < 13; ++it) {
          float best = -2.f; int bj = 0;
#pragma unroll
          for (int i = 0; i < 8; ++i) {
            const float v = ((selb >> i) & 1u) ? -1.f : val[i];
            if (v > best) { best = v; bj = c8 + i; }
          }
#pragma unroll
          for (int o = 1; o <= 8; o <<= 1) {
            const float ov = __shfl_xor(best, o); const int oj = __shfl_xor(bj, o);
            if (ov > best || (ov == best && oj < bj)) { best = ov; bj = oj; }
          }
          if ((bj >> 3) == l16) selb |= (1u << (bj & 7));
        }
      }
      uint32_t wd = selb << ((l16 & 3) * 8);
      wd |= __shfl_xor(wd, 1); wd |= __shfl_xor(wd, 2);
      __syncthreads();
      uint32_t* selw = (uint32_t*)imp;
      if ((l16 & 3) == 0) selw[qi * 4 + (l16 >> 2)] = wd;
      uint32_t uq = wd; uq |= __shfl_xor(uq, 16); uq |= __shfl_xor(uq, 32);
      if (gk == 0 && (l16 & 3) == 0) atomicOr(&umask[l16 >> 2], uq);
    }
    __syncthreads();
    const uint32_t* selq = (const uint32_t*)imp + (16 * qt + l16) * 4;
    const uint32_t sel0 = selq[0], sel1 = selq[1], sel2 = selq[2], sel3 = selq[3];
    uint32_t wun0 = sel0, wun1 = sel1, wun2 = sel2, wun3 = sel3;
#pragma unroll
    for (int o = 1; o <= 8; o <<= 1) { wun0 |= __shfl_xor(wun0, o); wun1 |= __shfl_xor(wun1, o); wun2 |= __shfl_xor(wun2, o); wun3 |= __shfl_xor(wun3, o); }
    int nsl = 0;
    {
      const uint32_t u0 = umask[0], u1 = umask[1], u2 = umask[2], u3 = umask[3];
      nsl = __popc(u0) + __popc(u1) + __popc(u2) + __popc(u3);
      if (tid < 128) {
        const uint32_t uw = tid < 32 ? u0 : tid < 64 ? u1 : tid < 96 ? u2 : u3;
        if ((uw >> (tid & 31)) & 1u) {
          int pos = __popc(uw & ((1u << (tid & 31)) - 1u));
          if (tid >= 32) pos += __popc(u0);
          if (tid >= 64) pos += __popc(u1);
          if (tid >= 96) pos += __popc(u2);
          ulist[pos] = tid;
        }
      }
    }
    __syncthreads();
#pragma unroll
    for (int dt = 0; dt < 4; ++dt) {
      uint2 o2; o2.x = pack2(acc[dt][0], acc[dt][1]); o2.y = pack2(acc[dt][2], acc[dt][3]);
      totl[dt * 64] = o2;
    }
#pragma unroll 1
    for (int br = 1; br < 3; ++br) {
      m = -1e30f; l = 0.f;
#pragma unroll
      for (int dt = 0; dt < 4; ++dt) acc[dt] = (f32x4){0.f, 0.f, 0.f, 0.f};
      int wfirst = ((t0 - 511) >> 6) << 6; if (wfirst < 0) wfirst = 0;
      const int nt = (br == 1) ? nsl : ((qb * 64 - wfirst) >> 6) + 1;
      const int ngrp = (nt + 3) >> 2;
      const u16* kb = U + (size_t)b * SEQ * LDQ + (br == 1 ? 1536 : 1792) + g * 64;
      const u16* vb = VT + (size_t)((br == 1 ? 0 : 256) + g * 64) * MTOK + (size_t)b * SEQ;
#define SRC_S0(i) ((br == 1) ? ulist[nt - 1 - (i)] * 64 : wfirst + 64 * (nt - 1 - (i)))
#define BR_LD(k, i) if ((i) < nt) { const int s_ = SRC_S0(i); LD1(k, kb + (size_t)s_ * LDQ, LDQ, vb + s_, MTOK) }
      BR_LD(0, 0) BR_LD(1, 1) BR_LD(2, 2) BR_LD(3, 3)
#pragma unroll 1
      for (int gi = 0; gi < ngrp; ++gi) {
        const int ib = gi * 4;
        __syncthreads();
        if (ib < nt) ST1(0) if (ib + 1 < nt) ST1(1) if (ib + 2 < nt) ST1(2) if (ib + 3 < nt) ST1(3)
        __syncthreads();
        if (gi + 1 < ngrp) { BR_LD(0, ib + 4) BR_LD(1, ib + 5) BR_LD(2, ib + 6) BR_LD(3, ib + 7) }
#pragma unroll 1
        for (int k = 0; k < 4; ++k) {
          const int i = ib + k;
          if (i < nt) {
            const int s0 = SRC_S0(i);
            bool wsel = true, ls = true;
            int wl = 512;
            if (br == 1) {
              const int j = s0 >> 6, jw = j >> 5, jb = j & 31;
              const uint32_t ww = jw == 0 ? wun0 : jw == 1 ? wun1 : jw == 2 ? wun2 : wun3;
              const uint32_t sw = jw == 0 ? sel0 : jw == 1 ? sel1 : jw == 2 ? sel2 : sel3;
              wsel = (ww >> jb) & 1u; ls = (sw >> jb) & 1u; wl = BIG;
            }
            if (wsel) {
              const int dminw = tq0w - (s0 + 63);
              if (dminw > 0 && slope2 * (float)dminw > (br == 1 ? T_slc : T_win)) wsel = false;
            }
            if (wsel) {
              const int tq0 = t0 + 16 * qt;
              const bool interior = (s0 + 63 <= tq0) && (br == 1 || s0 + 512 > tq0 + 15);
              if (interior) nsa_tile_interior(SLOT(k), SLOT(k) + 64 * TS, q, acc, m, l, slope2, sk, t, s0, ls, lane);
              else nsa_tile<2>(SLOT(k), SLOT(k) + 64 * TS, q, acc, m, l, slope2, g1, t, s0, 1, wl, ls, imp_row, 0, carry, lane);
            }
          }
        }
      }
      {
        float lt = l; lt += __shfl_xor(lt, 16); lt += __shfl_xor(lt, 32);
        const float gt = sigmoid_f(GL[mrow * 48 + h * 3 + br] + p.o_bg[h * 3 + br]);
        const float sc = lt > 0.f ? gt / lt : 0.f;
#pragma unroll
        for (int dt = 0; dt < 4; ++dt) {
          const uint2 pv = totl[dt * 64];
          const float r0 = bf2f(pv.x & 0xffff) + acc[dt][0] * sc, r1 = bf2f(pv.x >> 16) + acc[dt][1] * sc;
          const float r2 = bf2f(pv.y & 0xffff) + acc[dt][2] * sc, r3 = bf2f(pv.y >> 16) + acc[dt][3] * sc;
          if (br == 1) {
            uint2 o2; o2.x = pack2(r0, r1); o2.y = pack2(r2, r3);
            totl[dt * 64] = o2;
          } else {
            const int col = h * 64 + dt * 16 + gk * 4;
            const uint2 zz = *(const uint2*)(U + mrow * LDQ + 2048 + col);
            const float z0 = bf2f(zz.x & 0xffff), z1 = bf2f(zz.x >> 16), z2 = bf2f(zz.y & 0xffff), z3 = bf2f(zz.y >> 16);
            uint2 ov;
            ov.x = pack2(r0 * silu_f(z0), r1 * silu_f(z1));
            ov.y = pack2(r2 * silu_f(z2), r3 * silu_f(z3));
            *(uint2*)(Y + mrow * DM + col) = ov;
          }
        }
      }
    }
#undef SLOT
#undef LD1
#undef ST1
#undef CMP_LD
#undef SRC_S0
#undef BR_LD
  }
}

__device__ __forceinline__ void final_norm(const Params& p) {
  const int lane = TIDX & 63, wave = TIDX >> 6;
  for (int row = BIDX * NWAVE + wave; row < MTOK; row += gridDim.x * NWAVE) {
    float4* xr = (float4*)(p.out + (size_t)row * DM);
    float4 v[4];
    float ss = 0.f;
#pragma unroll
    for (int i = 0; i < 4; ++i) {
      v[i] = xr[lane + 64 * i];
      ss += v[i].x * v[i].x + v[i].y * v[i].y + v[i].z * v[i].z + v[i].w * v[i].w;
    }
#pragma unroll
    for (int o = 32; o >= 1; o >>= 1) ss += __shfl_xor(ss, o);
    const float rstd = rsqrtf(ss * (1.f / DM) + 1e-6f);
#pragma unroll
    for (int i = 0; i < 4; ++i) {
      const float4 gg = ((const float4*)p.fin_g)[lane + 64 * i];
      xr[lane + 64 * i] = (float4){v[i].x * rstd * gg.x, v[i].y * rstd * gg.y, v[i].z * rstd * gg.z, v[i].w * rstd * gg.w};
    }
  }
}

#define XB_XCNT(j)  (64 * (j))
#define XB_XSUB(j)  (1024 + 64 * (j))
#define XB_XGEN(j)  (2048 + 64 * (j))
#define XB_TOP      3072
#define XB_TOPGEN   3136
#define XB_WORDS    3200
#define LAS __attribute__((address_space(3)))
__device__ __forceinline__ unsigned xb_ld(unsigned* q) { return __hip_atomic_load(q, __ATOMIC_RELAXED, __HIP_MEMORY_SCOPE_AGENT); }
__device__ __forceinline__ unsigned xb_add(unsigned* q, unsigned v) { return __hip_atomic_fetch_add(q, v, __ATOMIC_RELAXED, __HIP_MEMORY_SCOPE_AGENT); }
__device__ __forceinline__ unsigned xb_xcc_id() { return (unsigned)__builtin_amdgcn_s_getreg((3 << 11) | 20) & 0xFu; }
__device__ __forceinline__ void grid_bar(const Params& p, unsigned xcc, volatile unsigned* st) {
  asm volatile("s_waitcnt vmcnt(0)" ::: "memory");
  __syncthreads();
  if (TIDX == 0) {
    unsigned* bar = (unsigned*)(p.ws + WS_BAR);
    __builtin_amdgcn_s_waitcnt(0);
    unsigned nloc = st[0], nx = st[1];
    if (nloc == 0u) {
      const unsigned G = gridDim.x;
      for (;;) {
        unsigned sum = 0u, cnt = 0u, mine = 0u, below = 0u;
#pragma unroll
        for (unsigned j = 0; j < 16; ++j) { const unsigned c = xb_ld(&bar[XB_XCNT(j)]); sum += c; cnt += (c > 0u) ? 1u : 0u; mine = (j == xcc) ? c : mine; below += (j < xcc && c > 0u) ? 1u : 0u; }
        nloc = mine; nx = cnt; st[3] = below;
        if (sum == G) break;
        __builtin_amdgcn_s_sleep(1);
      }
      st[0] = nloc; st[1] = nx;
    }
    const unsigned old = xb_add(&bar[XB_XSUB(xcc)], 1u);
    const unsigned gen = old / nloc;
    if (old + 1u == (gen + 1u) * nloc) {
      __builtin_amdgcn_fence(__ATOMIC_RELEASE, "agent");
      asm volatile("s_waitcnt vmcnt(0)" ::: "memory");
      const unsigned og = xb_add(&bar[XB_TOP], 1u);
      const unsigned tg = og / nx;
      if (og + 1u == (tg + 1u) * nx) xb_add(&bar[XB_TOPGEN], 1u);
      else while (xb_ld(&bar[XB_TOPGEN]) == tg) __builtin_amdgcn_s_sleep(1);
      __builtin_amdgcn_fence(__ATOMIC_ACQUIRE, "agent");
      xb_add(&bar[XB_XGEN(xcc)], 1u);
      asm volatile("s_waitcnt vmcnt(0)" ::: "memory");
    } else {
      while (xb_ld(&bar[XB_XGEN(xcc)]) == gen) __builtin_amdgcn_s_sleep(1);
      __builtin_amdgcn_fence(__ATOMIC_ACQUIRE, "agent");
      asm volatile("s_waitcnt vmcnt(0)" ::: "memory");
    }
  }
  __syncthreads();
}

__device__ __forceinline__ void nsa_knorm(const Params& p) {
  if (BIDX < 64) return;
  const u16* U = (const u16*)(p.ws + WS_QK);
  uint32_t* km = (uint32_t*)(p.ws + WS_KMAX);
  const int tid = TIDX, lane = tid & 63, wave = tid >> 6;
  float mx = 0.f;
  for (int row = (BIDX - 64) * NWAVE + wave; row < MTOK; row += (gridDim.x - 64) * NWAVE) {
    const uint4 v = *(const uint4*)(U + (size_t)row * LDQ + 1536 + lane * 8);
    const float a0 = bf2f(v.x & 0xffff), a1 = bf2f(v.x >> 16), a2 = bf2f(v.y & 0xffff), a3 = bf2f(v.y >> 16);
    const float a4 = bf2f(v.z & 0xffff), a5 = bf2f(v.z >> 16), a6 = bf2f(v.w & 0xffff), a7 = bf2f(v.w >> 16);
    float ss = a0 * a0 + a1 * a1 + a2 * a2 + a3 * a3 + a4 * a4 + a5 * a5 + a6 * a6 + a7 * a7;
    ss += __shfl_xor(ss, 1); ss += __shfl_xor(ss, 2); ss += __shfl_xor(ss, 4);
    mx = fmaxf(mx, ss);
  }
  if ((lane & 7) == 0) atomicMax(&km[8 + (lane >> 3)], __float_as_uint(mx));
}

__global__ void __launch_bounds__(NTHR, 2) mega(Params p_in) {
  Params p = p_in;
  p.pad = __builtin_amdgcn_readfirstlane((int)threadIdx.x >> 6);
  extern __shared__ __attribute__((aligned(16))) unsigned char lds_raw[];
  u16* lds = (u16*)lds_raw;
  const unsigned xcc = xb_xcc_id();
  volatile unsigned* bst = (volatile unsigned*)(lds_raw + 147456);
  if (threadIdx.x < 4) bst[threadIdx.x] = 0u;
  __syncthreads();
  if (p_in.coop && threadIdx.x == 0) bst[2] = xb_add((unsigned*)(p_in.ws + WS_BAR) + XB_XCNT(xcc), 1u);
  __syncthreads();
  cg::grid_group grid = cg::this_grid();
  if (p_in.coop == 2) grid.sync();
#define PH_ON(k) (p.ph_lo <= (k) && (k) <= p.ph_hi)
#define PH_SYNC(k) if (p.coop && p.ph_lo <= (k) && (k) < p.ph_hi) grid_bar(p, xcc, bst);
  if (PH_ON(0)) {
    rms_rows_fl(p, (float*)lds);
    conv_t(p, (u16*)(p.ws + WS_WT0), p.e_win, 1024, 4104, 4352, 0);
    conv_t(p, (u16*)(p.ws + WS_WT1), p.o_win, 1024, 3632, 3840, 1);
    conv_t(p, (u16*)(p.ws + WS_WO0), p.e_wout, 1024, 1024, 1024, 2);
    conv_t(p, (u16*)(p.ws + WS_WO1), p.o_wout, 1024, 1024, 1024, 2);
    conv_t(p, (u16*)(p.ws + WS_W1K), p.o_wk1, 2048, 256, 256, 2);
    conv_t(p, (u16*)(p.ws + WS_W1V), p.o_wv1, 2048, 256, 256, 2);
    conv_t(p, (u16*)(p.ws + WS_W2K), p.o_wk2, 256, 64, 256, 2);
    conv_t(p, (u16*)(p.ws + WS_W2V), p.o_wv2, 256, 64, 256, 2);
    pe_partial(p);
    if (BIDX == 0 && TIDX < 32) ((uint32_t*)(p.ws + WS_KMAX))[TIDX] = 0u;
    for (int i = BIDX * NTHR + TIDX; i < MTOK; i += gridDim.x * NTHR) ((float*)(p.ws + WS_SSQ))[i] = 0.f;
  }
  PH_SYNC(0)
  if (PH_ON(1)) gemm_inproj(p, 0, lds, 0);
  PH_SYNC(1)
  if (PH_ON(2)) {
    fox_scan(p, (float*)lds); ret_stepA(p); fox_knorm(p);
    if (BIDX == gridDim.x - 1) {
      for (int i = TIDX; i < 512; i += NTHR) {
        const float* part = (const float*)(p.ws + WS_PEP);
        float sum = 0.f;
        for (int kc = 0; kc < 16; ++kc) sum += part[((i >> 8) * 16 + kc) * 256 + (i & 255)];
        ((float*)(p.ws + WS_PEB))[i] = sum;
      }
    }
  }
  PH_SYNC(2)
  if (PH_ON(3)) { ret_stepB(p); fox_phase(p, lds); }
  PH_SYNC(3)
  if (PH_ON(4)) ret_stepC(p, lds);
  PH_SYNC(4)
  if (PH_ON(5)) gemm_outproj(p, 0, lds);
  PH_SYNC(5)
  if (PH_ON(7)) gemm_inproj(p, 1, lds, 0);
  PH_SYNC(7)
  if (PH_ON(8)) { gemm_cmp1(p, lds); gemm_inproj(p, 1, lds, 1); nsa_knorm(p); }
  PH_SYNC(8)
  if (PH_ON(10)) nsa_phase(p, lds);
  PH_SYNC(10)
  if (PH_ON(11)) gemm_outproj(p, 1, lds);
  PH_SYNC(11)
  if (PH_ON(12)) final_norm(p);
}

extern "C" void kernel_launch(void* const* d_in, const int* in_sizes, int n_in, void* d_out, int out_size, void* d_ws,
                              size_t ws_size, hipStream_t stream) {
  static int grid_blocks = 0;
  if (!grid_blocks) {
    int dev = 0, cus = 0, per_cu = 0;
    hipGetDevice(&dev);
    hipDeviceGetAttribute(&cus, hipDeviceAttributeMultiprocessorCount, dev);
    hipFuncSetAttribute((const void*)mega, hipFuncAttributeMaxDynamicSharedMemorySize, LDS_BYTES);
    hipOccupancyMaxActiveBlocksPerMultiprocessor(&per_cu, (const void*)mega, NTHR, LDS_BYTES);
    if (per_cu < 1) per_cu = 1;
    if (per_cu > 1) per_cu = 1;
    grid_blocks = cus * per_cu;
    (void)hipGetLastError();
  }
  Params p{};
  p.x = (const float*)d_in[0]; p.e_ng = (const float*)d_in[1]; p.e_win = (const float*)d_in[2];
  p.e_bf = (const float*)d_in[3]; p.e_gn = (const float*)d_in[4]; p.e_wout = (const float*)d_in[5];
  p.o_ng = (const float*)d_in[6]; p.o_win = (const float*)d_in[7]; p.o_bg = (const float*)d_in[8];
  p.o_pek = (const float*)d_in[9]; p.o_pev = (const float*)d_in[10]; p.o_wk1 = (const float*)d_in[11];
  p.o_wk2 = (const float*)d_in[12]; p.o_wv1 = (const float*)d_in[13]; p.o_wv2 = (const float*)d_in[14];
  p.o_wout = (const float*)d_in[15]; p.fin_g = (const float*)d_in[16];
  p.out = (float*)d_out; p.ws = (unsigned char*)d_ws;
#if ONE_LAUNCH
  p.ph_lo = 0; p.ph_hi = NPHASE - 1; p.coop = 1;
  (void)hipMemsetAsync((unsigned char*)d_ws + WS_BAR, 0, 16384, stream);
  void* args[] = {&p};
  hipError_t e = hipLaunchCooperativeKernel((const void*)mega, dim3(grid_blocks), dim3(NTHR), args, LDS_BYTES, stream);
  if (e != hipSuccess) fprintf(stderr, "cooperative launch failed: %s (grid %d)\n", hipGetErrorString(e), grid_blocks);
#else
  for (int ph = 0; ph < NPHASE; ++ph) {
    p.ph_lo = ph; p.ph_hi = ph; p.coop = 0;
    hipLaunchKernelGGL(mega, dim3(grid_blocks), dim3(NTHR), LDS_BYTES, stream, p);
  }
#endif
}
```

```cpp
#include <hip/hip_runtime.h>
#include <hip/hip_cooperative_groups.h>
#include <stdint.h>
#include <stdio.h>
namespace cg = cooperative_groups;

typedef unsigned short u16;
typedef short bf16x8 __attribute__((ext_vector_type(8)));
typedef short bf16x4 __attribute__((ext_vector_type(4)));
typedef float f32x4 __attribute__((ext_vector_type(4)));

#ifndef ONE_LAUNCH
#define ONE_LAUNCH 1
#endif

#define MTOK 32768
#define SEQ 8192
#define DM 1024
#define LDQ 3072
#define LOG2E 1.4426950408889634f
#define TS 72
#define IMPS 132
#define LDS_BYTES 147520
#define NTHR 512
#define NWAVE 8
#define NPHASE 13

#define MiB (1024ull * 1024ull)
#define WS_HBF   (0ull)
#define WS_DS    (0ull)
#define WS_ST    (32ull * MiB)
#define WS_QK    (64ull * MiB)
#define WS_VT    (256ull * MiB)
#define WS_Y     (352ull * MiB)
#define WS_WT0   (416ull * MiB)
#define WS_WT1   (WS_WT0 + 4352ull * 1024 * 2)
#define WS_WO0   (WS_WT1 + 3840ull * 1024 * 2)
#define WS_WO1   (WS_WO0 + 1024ull * 1024 * 2)
#define WS_W1K   (WS_WO1 + 1024ull * 1024 * 2)
#define WS_W1V   (WS_W1K + 256ull * 2048 * 2)
#define WS_W2K   (WS_W1V + 256ull * 2048 * 2)
#define WS_W2V   (WS_W2K + 256ull * 256 * 2)
#define WS_FLOG  (440ull * MiB)
#define WS_CFOX  (441ull * MiB)
#define WS_GL    (442ull * MiB)
#define WS_HC    (448ull * MiB)
#define WS_KCMP  (456ull * MiB)
#define WS_VCMPT (457ull * MiB)
#define WS_PEP   (458ull * MiB)
#define WS_PEB   (WS_PEP + 65536ull)
#define WS_KMAX  (WS_PEB + 4096ull)
#define WS_SSQ   (459ull * MiB)
#define WS_BAR   (460ull * MiB)

struct Params {
  const float *x, *e_ng, *e_win, *e_bf, *e_gn, *e_wout;
  const float *o_ng, *o_win, *o_bg, *o_pek, *o_pev, *o_wk1, *o_wk2, *o_wv1, *o_wv2, *o_wout, *fin_g;
  float* out;
  unsigned char* ws;
  int ph_lo, ph_hi, coop, pad;
};

typedef __bf16 bf16v2 __attribute__((ext_vector_type(2)));
typedef float f32v2 __attribute__((ext_vector_type(2)));
__device__ __forceinline__ uint32_t pack2(float a, float b) {
  f32v2 v = {a, b};
  bf16v2 r = __builtin_convertvector(v, bf16v2);
  return *(uint32_t*)&r;
}
__device__ __forceinline__ u16 f2bf(float f) { return (u16)(pack2(f, 0.f) & 0xffffu); }
__device__ __forceinline__ float bf2f(u16 h) { return __uint_as_float(((uint32_t)h) << 16); }
__device__ __forceinline__ float ex2(float x) { return __builtin_amdgcn_exp2f(x); }
__device__ __forceinline__ float silu_f(float z) { return z * __builtin_amdgcn_rcpf(1.f + ex2(-z * LOG2E)); }
__device__ __forceinline__ float sigmoid_f(float z) { return __builtin_amdgcn_rcpf(1.f + ex2(-z * LOG2E)); }

__device__ __forceinline__ int opq(int v) { asm volatile("" : "+v"(v)); return v; }
__device__ __forceinline__ int opqs(int v) { asm volatile("" : "+s"(v)); return v; }
#define TIDX opq(p.pad * 64 + (int)__lane_id())
#define BIDX opqs((int)blockIdx.x)
#define MFMA(a, b, c) __builtin_amdgcn_mfma_f32_16x16x32_bf16((a), (b), (c), 0, 0, 0)

__device__ __forceinline__ void rms_rows(const Params& p, const float* __restrict__ x, const float* __restrict__ g, u16* __restrict__ h) {
  const int lane = TIDX & 63, wave = TIDX >> 6;
  for (int row = BIDX * NWAVE + wave; row < MTOK; row += gridDim.x * NWAVE) {
    const float4* xr = (const float4*)(x + (size_t)row * DM);
    float4 v[4];
    float ss = 0.f;
#pragma unroll
    for (int i = 0; i < 4; ++i) {
      v[i] = xr[lane + 64 * i];
      ss += v[i].x * v[i].x + v[i].y * v[i].y + v[i].z * v[i].z + v[i].w * v[i].w;
    }
#pragma unroll
    for (int o = 32; o >= 1; o >>= 1) ss += __shfl_xor(ss, o);
    const float rstd = rsqrtf(ss * (1.f / DM) + 1e-6f);
#pragma unroll
    for (int i = 0; i < 4; ++i) {
      float4 gg = ((const float4*)g)[lane + 64 * i];
      uint2 o;
      o.x = pack2(v[i].x * rstd * gg.x, v[i].y * rstd * gg.y);
      o.y = pack2(v[i].z * rstd * gg.z, v[i].w * rstd * gg.w);
      *(uint2*)(h + (size_t)row * DM + (lane + 64 * i) * 4) = o;
    }
  }
}

__device__ __forceinline__ void rms_rows_fl(const Params& p, float* ldsf) {
  const float* __restrict__ x = p.x; const float* __restrict__ g = p.e_ng;
  u16* __restrict__ h = (u16*)(p.ws + WS_HBF);
  float* __restrict__ fl = (float*)(p.ws + WS_FLOG);
  const int tid = TIDX, lane = tid & 63, wave = tid >> 6;
  for (int i = tid; i < 8 * DM; i += NTHR) { const int j = i >> 10, k = i & 1023; ldsf[i] = g[k] * p.e_win[(size_t)k * 4104 + 1536 + j]; }
  __syncthreads();
  for (int row = BIDX * NWAVE + wave; row < MTOK; row += gridDim.x * NWAVE) {
    const float4* xr = (const float4*)(x + (size_t)row * DM);
    float4 v[4];
    float ss = 0.f;
#pragma unroll
    for (int i = 0; i < 4; ++i) {
      v[i] = xr[lane + 64 * i];
      ss += v[i].x * v[i].x + v[i].y * v[i].y + v[i].z * v[i].z + v[i].w * v[i].w;
    }
#pragma unroll
    for (int o = 32; o >= 1; o >>= 1) ss += __shfl_xor(ss, o);
    const float rstd = rsqrtf(ss * (1.f / DM) + 1e-6f);
#pragma unroll
    for (int i = 0; i < 4; ++i) {
      float4 gg = ((const float4*)g)[lane + 64 * i];
      uint2 o;
      o.x = pack2(v[i].x * rstd * gg.x, v[i].y * rstd * gg.y);
      o.y = pack2(v[i].z * rstd * gg.z, v[i].w * rstd * gg.w);
      *(uint2*)(h + (size_t)row * DM + (lane + 64 * i) * 4) = o;
    }
    float myf = 0.f;
#pragma unroll
    for (int j = 0; j < 8; ++j) {
      float d = 0.f;
#pragma unroll
      for (int i = 0; i < 4; ++i) {
        const float4 w4 = *(const float4*)(ldsf + j * DM + (lane + 64 * i) * 4);
        d += v[i].x * w4.x + v[i].y * w4.y + v[i].z * w4.z + v[i].w * w4.w;
      }
#pragma unroll
      for (int o = 32; o >= 1; o >>= 1) d += __shfl_xor(d, o);
      if (lane == j) myf = d * rstd;
    }
    if (lane < 8) fl[(size_t)row * 8 + lane] = myf;
  }
}

__device__ __forceinline__ int map_col(int MAP, int n) {
  if (MAP == 0) {
    if (n < 1024) return n;
    if (n < 2048) return n + 520;
    if (n < 3072) return n + 1032;
    if (n < 3584) return n - 2048;
    if (n < 4096) return n - 1016;
    if (n < 4104) return n - 2560;
    return -1;
  } else if (MAP == 1) {
    if (n < 1792) return n;
    if (n < 2048) return n + 256;
    if (n < 3072) return n + 560;
    if (n < 3328) return n - 1280;
    if (n < 3584) return n - 1024;
    if (n < 3632) return n - 1024;
    return -1;
  } else if (MAP == 2) {
    return n;
  }
  return n;
}

__device__ __forceinline__ void conv_t(const Params& p, u16* __restrict__ dst, const float* __restrict__ src, int K, int nsrc, int ndst, int MAP) {
  const int total = ndst * (K >> 3);
  for (int id = BIDX * NTHR + TIDX; id < total; id += gridDim.x * NTHR) {
    const int n = id % ndst, kc = id / ndst;
    const int sc = map_col(MAP, n);
    const bool okc = (sc >= 0 && sc < nsrc);
    const int scc = okc ? sc : 0;
    float v[8];
#pragma unroll
    for (int i = 0; i < 8; ++i) v[i] = src[(size_t)(kc * 8 + i) * nsrc + scc];
#pragma unroll
    for (int i = 0; i < 8; ++i) v[i] = okc ? v[i] : 0.f;
    uint4 o;
    o.x = pack2(v[0], v[1]); o.y = pack2(v[2], v[3]); o.z = pack2(v[4], v[5]); o.w = pack2(v[6], v[7]);
    *(uint4*)(dst + (size_t)n * K + kc * 8) = o;
  }
}

__device__ __forceinline__ void pe_partial(const Params& p) {
  float* part = (float*)(p.ws + WS_PEP);
  for (int task = BIDX; task < 32; task += gridDim.x) {
    const int kv = task >> 4, kc = task & 15, n = TIDX;
    if (n >= 256) continue;
    const float* pe = kv ? p.o_pev : p.o_pek;
    const float* w1 = kv ? p.o_wv1 : p.o_wk1;
    float acc = 0.f;
#pragma unroll 16
    for (int k = kc * 128; k < kc * 128 + 128; ++k) acc += pe[k] * w1[(size_t)k * 256 + n];
    part[(kv * 16 + kc) * 256 + n] = acc;
  }
}

#define GST (512 * TS)
template <bool swapped>
__device__ __forceinline__ void gemm_compute(const u16* cur, f32x4 (&acc)[8][4], int wpa, int wpb, int l16, int gk) {
  const u16* sA = cur + (wpa * 128 + l16) * TS + gk * 8;
  const u16* sB = cur + (256 + wpb * 64 + l16) * TS + gk * 8;
#pragma unroll 1
  for (int kk = 0; kk < 2; ++kk) {
    bf16x8 fa[8], fb[4];
#pragma unroll
    for (int i = 0; i < 8; ++i) fa[i] = *(const bf16x8*)(sA + i * 16 * TS + kk * 32);
#pragma unroll
    for (int j = 0; j < 4; ++j) fb[j] = *(const bf16x8*)(sB + j * 16 * TS + kk * 32);
    if (swapped) {
#pragma unroll
      for (int i = 0; i < 8; ++i)
#pragma unroll
        for (int j = 0; j < 4; ++j) acc[i][j] = MFMA(fb[j], fa[i], acc[i][j]);
    } else {
#pragma unroll
      for (int i = 0; i < 8; ++i)
#pragma unroll
        for (int j = 0; j < 4; ++j) acc[i][j] = MFMA(fa[i], fb[j], acc[i][j]);
    }
  }
}
template <bool swapped>
__device__ __forceinline__ void gemm_mainloop(const Params& p, const u16* __restrict__ Ab, const uint32_t (&pa)[4], const u16* __restrict__ Bb,
                                              const uint32_t (&pb)[4], int a_kstride, int nk,
                                              u16* lds, f32x4 (&acc)[8][4],
                                              bool primed = false, const u16* __restrict__ Abn = nullptr, const u16* __restrict__ Bbn = nullptr) {
  const int tid = TIDX, lane = tid & 63, wave = tid >> 6;
  const int l16 = lane & 15, gk = lane >> 4;
  const int wpa = wave >> 2, wpb = wave & 3;
  const int woff = (tid >> 3) * TS + (tid & 7) * 8;
  uint4 ra0, ra1, ra2, ra3, rb0, rb1, rb2, rb3;
#define G_LD(kidx) { const u16* Ap_ = Ab + (size_t)(kidx) * a_kstride; const u16* Bp_ = Bb + (size_t)(kidx) * 64;   \
    ra0 = *(const uint4*)(Ap_ + pa[0]); ra1 = *(const uint4*)(Ap_ + pa[1]); ra2 = *(const uint4*)(Ap_ + pa[2]); ra3 = *(const uint4*)(Ap_ + pa[3]); \
    rb0 = *(const uint4*)(Bp_ + pb[0]); rb1 = *(const uint4*)(Bp_ + pb[1]); rb2 = *(const uint4*)(Bp_ + pb[2]); rb3 = *(const uint4*)(Bp_ + pb[3]); }
#define G_ST(D) { u16* D_ = (D) + woff;                                                                               \
    *(uint4*)(D_) = ra0; *(uint4*)(D_ + 64 * TS) = ra1; *(uint4*)(D_ + 128 * TS) = ra2; *(uint4*)(D_ + 192 * TS) = ra3;  \
    *(uint4*)(D_ + 256 * TS) = rb0; *(uint4*)(D_ + 320 * TS) = rb1; *(uint4*)(D_ + 384 * TS) = rb2; *(uint4*)(D_ + 448 * TS) = rb3; }
  if (!primed) {
    G_LD(0)
    __syncthreads();
    G_ST(lds)
    __syncthreads();
  }
#pragma unroll
  for (int i = 0; i < 8; ++i)
#pragma unroll
    for (int j = 0; j < 4; ++j) acc[i][j] = (f32x4){0.f, 0.f, 0.f, 0.f};
#pragma unroll 1
  for (int ks = 0; ks < nk; ++ks) {
    const bool last = (ks + 1 == nk);
    const bool more = !last || (Abn != nullptr);
    if (more) {
      if (!last) G_LD(ks + 1)
      else { const u16* Ab = Abn; const u16* Bb = Bbn; G_LD(0) }
    }
    gemm_compute<swapped>(lds + (ks & 1) * GST, acc, wpa, wpb, l16, gk);
    if (more) G_ST(lds + ((ks + 1) & 1) * GST)
    __syncthreads();
  }
#undef G_LD
#undef G_ST
}
#define GEMM_OFFS(rowstrideA, rowstrideB)                                   \
  uint32_t pa[4], pb[4];                                                    \
  _Pragma("unroll") for (int i = 0; i < 4; ++i) {                           \
    pa[i] = (uint32_t)((tid >> 3) + 64 * i) * (rowstrideA) + (tid & 7) * 8; \
    pb[i] = (uint32_t)((tid >> 3) + 64 * i) * (rowstrideB) + (tid & 7) * 8; \
  }

__device__ __forceinline__ void gemm_inproj(const Params& p, int layer, u16* lds, int part) {
  const u16* A = (const u16*)(p.ws + WS_HBF);
  const u16* Bt = (const u16*)(p.ws + (layer ? WS_WT1 : WS_WT0));
  u16* QK = (u16*)(p.ws + WS_QK);
  u16* VT = (u16*)(p.ws + WS_VT);
  float* F = (float*)(p.ws + (layer ? WS_GL : WS_FLOG));
  const int NT = layer ? 14 : 16;
  const int seg_trans_end = layer ? 28 : 32;
  const int nvalidF = layer ? 48 : 8, ldf = layer ? 48 : 8;
  const int tid = TIDX, lane = tid & 63, wave = tid >> 6, l16 = lane & 15, gk = lane >> 4;
  const int wpa = wave >> 2, wpb = wave & 3;
  const int bid = BIDX;
  int xcd = bid & 7, nloc = (int)gridDim.x >> 3, lrank = bid >> 3;
  { const uint4 cw = *(const uint4*)((const unsigned char*)lds + 147456);
    const int c0 = __builtin_amdgcn_readfirstlane((int)cw.x), c1 = __builtin_amdgcn_readfirstlane((int)cw.y);
    const int c2 = __builtin_amdgcn_readfirstlane((int)cw.z), c3 = __builtin_amdgcn_readfirstlane((int)cw.w);
    if (c1 == 8 && c0 * 8 == (int)gridDim.x) { xcd = c3; lrank = c2; } }
  const int qbeg = part ? bid - 64 : lrank, qend = part ? (bid >= 64 ? 128 : -(1 << 20)) : 16 * NT, qstep = part ? (int)gridDim.x - 64 : nloc;
  bool primed = false;
  for (int q = qbeg; q < qend; q += qstep) {
    const int mt = part ? q : xcd * 16 + q / NT, nt = part ? NT : q % NT;
    const int m0 = mt * 256, n0 = nt * 256;
    const int qn = q + qstep;
    const bool has_next = (part == 0) && (qn < qend);
    const u16* Abn = has_next ? A + (size_t)((xcd * 16 + qn / NT) * 256) * DM : nullptr;
    const u16* Bbn = has_next ? Bt + (size_t)((qn % NT) * 256) * DM : nullptr;
    const int mw = m0 + wpa * 128, nw = n0 + wpb * 64;
    const int seg = nw >> 7;
    int mode;
    if (seg < 24) mode = (layer == 0 && seg >= 12 && seg < 16) ? 2 : 0;
    else if (seg < seg_trans_end) mode = 1;
    else if (seg == seg_trans_end) mode = 3;
    else mode = 4;
    const int seg0 = nt * 2;
    const bool swapped = !((seg0 >= 24 && seg0 < seg_trans_end) || (layer == 0 && seg0 >= 12 && seg0 < 16));
    GEMM_OFFS(DM, DM)
    f32x4 acc[8][4];
    if (swapped) gemm_mainloop<true>(p, A + (size_t)m0 * DM, pa, Bt + (size_t)n0 * DM, pb, 64, 16, lds, acc, primed, Abn, Bbn);
    else gemm_mainloop<false>(p, A + (size_t)m0 * DM, pa, Bt + (size_t)n0 * DM, pb, 64, 16, lds, acc, primed, Abn, Bbn);
    primed = has_next;
    const float* ssq_g = (const float*)(p.ws + WS_SSQ);
    const bool tile_normal = (nt < 12) && !(layer == 0 && nt >= 6 && nt < 8);
    if (tile_normal) {
      u16* stg = lds + GST;
      const int ES = 264;
#pragma unroll 1
      for (int half = 0; half < 2; ++half) {
        __syncthreads();
        if (wpa == half) {
#pragma unroll
          for (int i = 0; i < 8; ++i) {
            const float rs = layer ? rsqrtf(ssq_g[mw + i * 16 + l16] * (1.f / DM) + 1e-6f) : 1.f;
#pragma unroll
            for (int j = 0; j < 4; ++j) {
              uint2 o; o.x = pack2(acc[i][j][0] * rs, acc[i][j][1] * rs); o.y = pack2(acc[i][j][2] * rs, acc[i][j][3] * rs);
              *(uint2*)(stg + (i * 16 + l16) * ES + wpb * 64 + j * 16 + gk * 4) = o;
            }
          }
        }
        __syncthreads();
#pragma unroll
        for (int c = 0; c < 8; ++c) {
          const int idx = tid + NTHR * c, row = idx >> 5, ch = idx & 31;
          const uint4 v = *(const uint4*)(stg + row * ES + ch * 8);
          *(uint4*)(QK + (size_t)(m0 + half * 128 + row) * LDQ + n0 + ch * 8) = v;
        }
      }
      __syncthreads();
    } else if (mode == 0 || mode == 3) {
#pragma unroll
      for (int i = 0; i < 8; ++i) {
        const int m = mw + i * 16 + l16;
        const float rs = layer ? rsqrtf(ssq_g[m] * (1.f / DM) + 1e-6f) : 1.f;
#pragma unroll
        for (int j = 0; j < 4; ++j) {
          const int n = nw + j * 16 + gk * 4;
          const float a0 = acc[i][j][0] * rs, a1 = acc[i][j][1] * rs, a2 = acc[i][j][2] * rs, a3 = acc[i][j][3] * rs;
          if (mode == 0) {
            uint2 o; o.x = pack2(a0, a1); o.y = pack2(a2, a3);
            *(uint2*)(QK + (size_t)m * LDQ + n) = o;
          } else {
            const int nn = n - seg * 128;
            if (nn < nvalidF) *(float4*)(F + (size_t)m * ldf + nn) = (float4){a0, a1, a2, a3};
          }
        }
      }
    } else if (mode == 1 || mode == 2) {
#pragma unroll
      for (int i = 0; i < 8; ++i) {
        const int m = mw + i * 16 + gk * 4;
        float rs0 = 1.f, rs1 = 1.f, rs2 = 1.f, rs3 = 1.f;
        if (layer) {
          const float4 q4 = *(const float4*)(ssq_g + m);
          rs0 = rsqrtf(q4.x * (1.f / DM) + 1e-6f); rs1 = rsqrtf(q4.y * (1.f / DM) + 1e-6f);
          rs2 = rsqrtf(q4.z * (1.f / DM) + 1e-6f); rs3 = rsqrtf(q4.w * (1.f / DM) + 1e-6f);
        }
#pragma unroll
        for (int j = 0; j < 4; ++j) {
          const int n = nw + j * 16 + l16;
          const float a0 = acc[i][j][0] * rs0, a1 = acc[i][j][1] * rs1, a2 = acc[i][j][2] * rs2, a3 = acc[i][j][3] * rs3;
          if (mode == 1) {
            const int trow = n - 3072;
            uint2 o; o.x = pack2(a0, a1); o.y = pack2(a2, a3);
            *(uint2*)(VT + (size_t)trow * MTOK + m) = o;
          } else {
            const int trow = n - 512;
            const int h = (nw - 1536) >> 6;
            const float lg2 = log1pf(-exp2f(-5.f - (float)h)) * LOG2E;
            const float lane_dec = 0.125f * ex2(lg2 * (float)(127 - gk * 4));
            QK[(size_t)(m + 0) * LDQ + n] = f2bf(a0); QK[(size_t)(m + 1) * LDQ + n] = f2bf(a1);
            QK[(size_t)(m + 2) * LDQ + n] = f2bf(a2); QK[(size_t)(m + 3) * LDQ + n] = f2bf(a3);
            const float s0 = a0 * lane_dec * ex2(lg2 * (float)(-(i * 16 + 0))), s1 = a1 * lane_dec * ex2(lg2 * (float)(-(i * 16 + 1)));
            const float s2 = a2 * lane_dec * ex2(lg2 * (float)(-(i * 16 + 2))), s3 = a3 * lane_dec * ex2(lg2 * (float)(-(i * 16 + 3)));
            uint2 o; o.x = pack2(s0, s1); o.y = pack2(s2, s3);
            *(uint2*)(VT + (size_t)trow * MTOK + m) = o;
          }
        }
      }
    }
  }
}

__device__ __forceinline__ void gemm_outproj(const Params& p, int layer, u16* lds) {
  const u16* A = (const u16*)(p.ws + WS_Y);
  const u16* Bt = (const u16*)(p.ws + (layer ? WS_WO1 : WS_WO0));
  const float* res = layer ? p.out : p.x;
  float* out = p.out;
  u16* hb_out = (u16*)(p.ws + WS_HBF);
  float* ssq_g = (float*)(p.ws + WS_SSQ);
  const int tid = TIDX, lane = tid & 63, wave = tid >> 6, l16 = lane & 15, gk = lane >> 4;
  const int wpa = wave >> 2, wpb = wave & 3;
  const int bid = BIDX;
  int xcd = bid & 7, nloc = (int)gridDim.x >> 3, lrank = bid >> 3;
  { const uint4 cw = *(const uint4*)((const unsigned char*)lds + 147456);
    const int c0 = __builtin_amdgcn_readfirstlane((int)cw.x), c1 = __builtin_amdgcn_readfirstlane((int)cw.y);
    const int c2 = __builtin_amdgcn_readfirstlane((int)cw.z), c3 = __builtin_amdgcn_readfirstlane((int)cw.w);
    if (c1 == 8 && c0 * 8 == (int)gridDim.x) { xcd = c3; lrank = c2; } }
  bool primed = false;
  for (int q = lrank; q < 16 * 4; q += nloc) {
    const int mt = xcd * 16 + (q >> 2), nt = q & 3;
    const int m0 = mt * 256, n0 = nt * 256;
    const int qn = q + nloc;
    const bool has_next = qn < 16 * 4;
    const u16* Abn = has_next ? A + (size_t)((xcd * 16 + (qn >> 2)) * 256) * DM : nullptr;
    const u16* Bbn = has_next ? Bt + (size_t)((qn & 3) * 256) * DM : nullptr;
    GEMM_OFFS(DM, DM)
    f32x4 acc[8][4];
    gemm_mainloop<true>(p, A + (size_t)m0 * DM, pa, Bt + (size_t)n0 * DM, pb, 64, 16, lds, acc, primed, Abn, Bbn);
    primed = has_next;
    const int tid2 = TIDX, lane2 = tid2 & 63, wave2 = tid2 >> 6, l16b = lane2 & 15, gkb = lane2 >> 4;
    const int mw = m0 + (wave2 >> 2) * 128, nw = n0 + (wave2 & 3) * 64;
#pragma unroll
    for (int i = 0; i < 8; ++i) {
      const int m = mw + i * 16 + l16b;
      float sq = 0.f;
#pragma unroll
      for (int j = 0; j < 4; ++j) {
        const int n = nw + j * 16 + gkb * 4;
        const float4 r = *(const float4*)(res + (size_t)m * DM + n);
        const float4 v = (float4){r.x + acc[i][j][0], r.y + acc[i][j][1], r.z + acc[i][j][2], r.w + acc[i][j][3]};
        *(float4*)(out + (size_t)m * DM + n) = v;
        if (layer == 0) {
          const float4 gg = *(const float4*)(p.o_ng + n);
          uint2 hb; hb.x = pack2(v.x * gg.x, v.y * gg.y); hb.y = pack2(v.z * gg.z, v.w * gg.w);
          *(uint2*)(hb_out + (size_t)m * DM + n) = hb;
          sq += v.x * v.x + v.y * v.y + v.z * v.z + v.w * v.w;
        }
      }
      if (layer == 0) {
        sq += __shfl_xor(sq, 16); sq += __shfl_xor(sq, 32);
        if (gkb == 0) atomicAdd(ssq_g + m, sq);
      }
    }
  }
}

__device__ __forceinline__ void gemm_cmp2_tile(const Params& p, u16* lds, int kv, int mt) {
  const int tid = TIDX, lane = tid & 63, wave = tid >> 6, l16 = lane & 15, gk = lane >> 4;
  const int wpa = wave >> 2, wpb = wave & 3;
  {
    const int m0 = mt * 256;
    const u16* A = (const u16*)(p.ws + WS_HC) + (size_t)kv * 8192 * 256;
    const u16* Bt = (const u16*)(p.ws + (kv ? WS_W2V : WS_W2K));
    GEMM_OFFS(256, 256)
    f32x4 acc[8][4];
    const bool swapped = (kv == 0);
    if (swapped) gemm_mainloop<true>(p, A + (size_t)m0 * 256, pa, Bt, pb, 64, 4, lds, acc);
    else gemm_mainloop<false>(p, A + (size_t)m0 * 256, pa, Bt, pb, 64, 4, lds, acc);
    const int mw = m0 + wpa * 128, nw = wpb * 64;
    if (swapped) {
      u16* kc_ = (u16*)(p.ws + WS_KCMP);
#pragma unroll
      for (int i = 0; i < 8; ++i)
#pragma unroll
        for (int j = 0; j < 4; ++j) {
          const int n = nw + j * 16 + gk * 4;
          const int m = mw + i * 16 + l16;
          if (n < 64) {
            uint2 o; o.x = pack2(acc[i][j][0], acc[i][j][1]); o.y = pack2(acc[i][j][2], acc[i][j][3]);
            *(uint2*)(kc_ + (size_t)m * 64 + n) = o;
          }
        }
      if (wpb == 0) {
        float mxn = 0.f;
#pragma unroll
        for (int i = 0; i < 8; ++i) {
          float ss = 0.f;
#pragma unroll
          for (int j = 0; j < 4; ++j) ss += acc[i][j][0] * acc[i][j][0] + acc[i][j][1] * acc[i][j][1] + acc[i][j][2] * acc[i][j][2] + acc[i][j][3] * acc[i][j][3];
          ss += __shfl_xor(ss, 16); ss += __shfl_xor(ss, 32);
          mxn = fmaxf(mxn, ss);
        }
#pragma unroll
        for (int o2 = 1; o2 <= 8; o2 <<= 1) mxn = fmaxf(mxn, __shfl_xor(mxn, o2));
        if (lane == 0) atomicMax((uint32_t*)(p.ws + WS_KMAX) + 16 + ((mw >> 9) & 3), __float_as_uint(mxn));
      }
    } else {
      u16* vt = (u16*)(p.ws + WS_VCMPT);
#pragma unroll
      for (int i = 0; i < 8; ++i)
#pragma unroll
        for (int j = 0; j < 4; ++j) {
          const int m = mw + i * 16 + gk * 4;
          const int n = nw + j * 16 + l16;
          if (n < 64) {
            uint2 o; o.x = pack2(acc[i][j][0], acc[i][j][1]); o.y = pack2(acc[i][j][2], acc[i][j][3]);
            *(uint2*)(vt + (size_t)(m >> 9) * 32768 + (size_t)n * 512 + (m & 511)) = o;
          }
        }
    }
  }
}

__device__ __forceinline__ void gemm_cmp1(const Params& p, u16* lds) {
  const u16* U = (const u16*)(p.ws + WS_QK);
  const float* peb = (const float*)(p.ws + WS_PEB);
  const int tid = TIDX, lane = tid & 63, wave = tid >> 6, l16 = lane & 15, gk = lane >> 4;
  const int wpa = wave >> 2, wpb = wave & 3;
  for (int tile = BIDX; tile < 64; tile += gridDim.x) {
    const int kv = tile >> 5, mt = tile & 31;
    const int m0 = mt * 256;
    const u16* Bt = (const u16*)(p.ws + (kv ? WS_W1V : WS_W1K));
    u16* Hc = (u16*)(p.ws + WS_HC) + (size_t)kv * 8192 * 256;
    uint32_t pa[4], pb[4];
#pragma unroll
    for (int i = 0; i < 4; ++i) {
      const int row = (tid >> 3) + 64 * i, kc = tid & 7;
      const int r = m0 + row, bg = r >> 9, cc = r & 511, b = bg >> 2, g = bg & 3;
      int tok0 = cc * 16; if (tok0 > SEQ - 32) tok0 = SEQ - 32;
      pa[i] = (uint32_t)(b * SEQ + tok0) * LDQ + 1024 + kv * 256 + g * 64 + kc * 8;
      pb[i] = (uint32_t)row * 2048 + kc * 8;
    }
    f32x4 acc[8][4];
    gemm_mainloop<true>(p, U, pa, Bt, pb, LDQ, 32, lds, acc);
    const int tid2 = TIDX, lane2 = tid2 & 63, wave2 = tid2 >> 6;
    const int mw = m0 + (wave2 >> 2) * 128, nw = (wave2 & 3) * 64;
#pragma unroll
    for (int i = 0; i < 8; ++i)
#pragma unroll
      for (int j = 0; j < 4; ++j) {
        const int n = nw + j * 16 + (lane2 >> 4) * 4;
        const int m = mw + i * 16 + (lane2 & 15);
        const float4 bb = *(const float4*)(peb + kv * 256 + n);
        float v0 = silu_f(acc[i][j][0] + bb.x), v1 = silu_f(acc[i][j][1] + bb.y);
        float v2 = silu_f(acc[i][j][2] + bb.z), v3 = silu_f(acc[i][j][3] + bb.w);
        if ((m & 511) == 511) { v0 = v1 = v2 = v3 = 0.f; }
        uint2 o; o.x = pack2(v0, v1); o.y = pack2(v2, v3);
        *(uint2*)(Hc + (size_t)m * 256 + n) = o;
      }
    __threadfence_block();
    __syncthreads();
    gemm_cmp2_tile(p, lds, kv, mt);
  }
}

#define TILE_LD(R, src, stride) { R##0 = *(const uint4*)((src) + (long)(tid >> 3) * (stride) + (tid & 7) * 8); }
#define TILE_ST(dst, R) { *(uint4*)((dst) + (tid >> 3) * TS + (tid & 7) * 8) = R##0; }
#define VPOS(c) ((((c) >> 2) * 32) + ((2 * ((c) & 1)) * 8) + ((((c) & 3) >> 1) * 4))
#define TILE_STV_(dst, val) { const int c_ = tid & 7; u16* d_ = (dst) + (tid >> 3) * TS + VPOS(c_); \
    *(uint2*)(d_) = make_uint2((val).x, (val).y); *(uint2*)(d_ + 8) = make_uint2((val).z, (val).w); }
#define TILE_STV(dst, R) TILE_STV_(dst, R##0)
__device__ __forceinline__ void qk_tile(const u16* sK, const bf16x8 (&q)[2], f32x4 (&s)[4], int l16, int gk) {
#pragma unroll
  for (int kt = 0; kt < 4; ++kt) s[kt] = (f32x4){0.f, 0.f, 0.f, 0.f};
#pragma unroll
  for (int ks = 0; ks < 2; ++ks)
#pragma unroll
    for (int kt = 0; kt < 4; ++kt) {
      bf16x8 kf = *(const bf16x8*)(sK + (kt * 16 + l16) * TS + ks * 32 + gk * 8);
      s[kt] = MFMA(kf, q[ks], s[kt]);
    }
}
__device__ __forceinline__ void pv_tile(const u16* sV, const float (&pp)[4][4], f32x4 (&o)[4], int l16, int gk) {
  bf16x8 pf[2];
#pragma unroll
  for (int ks2 = 0; ks2 < 2; ++ks2) {
    uint4 t;
    t.x = pack2(pp[2 * ks2][0], pp[2 * ks2][1]); t.y = pack2(pp[2 * ks2][2], pp[2 * ks2][3]);
    t.z = pack2(pp[2 * ks2 + 1][0], pp[2 * ks2 + 1][1]); t.w = pack2(pp[2 * ks2 + 1][2], pp[2 * ks2 + 1][3]);
    pf[ks2] = *(bf16x8*)&t;
  }
#pragma unroll
  for (int dt = 0; dt < 4; ++dt)
#pragma unroll
    for (int ks2 = 0; ks2 < 2; ++ks2) {
      const bf16x8 vf = *(const bf16x8*)(sV + (dt * 16 + l16) * TS + ks2 * 32 + gk * 8);
      o[dt] = MFMA(vf, pf[ks2], o[dt]);
    }
}

__device__ __forceinline__ void fox_phase(const Params& p, u16* lds) {
  const u16* QK = (const u16*)(p.ws + WS_QK);
  const u16* VT = (const u16*)(p.ws + WS_VT);
  const float* cf = (const float*)(p.ws + WS_CFOX);
  u16* Y = (u16*)(p.ws + WS_Y);
  const int tid = TIDX, lane = tid & 63, w = tid >> 6, l16 = lane & 15, gk = lane >> 4;
  const float scale2 = 0.125f * LOG2E;
  for (int unit = BIDX; unit < 2048; unit += gridDim.x) {
    const int bh = unit & 31, qblk = 63 - (unit >> 5), b = bh >> 3, h = bh & 7;
    const int tq0 = qblk * 128 + w * 16;
    const int t = tq0 + l16;
    const float* cfr = cf + (size_t)bh * SEQ;
    bf16x8 q[2];
#pragma unroll
    for (int ks = 0; ks < 2; ++ks) q[ks] = *(const bf16x8*)(QK + (size_t)(b * SEQ + t) * LDQ + h * 64 + ks * 32 + gk * 8);
    const float cq2 = cfr[t] * LOG2E;
    f32x4 o[4];
    float m = -1e30f, l = 0.f;
#pragma unroll
    for (int dt = 0; dt < 4; ++dt) o[dt] = (f32x4){0.f, 0.f, 0.f, 0.f};
    const int ntiles = qblk * 2 + 2;
    const int iw = qblk * 2 + (w >> 2);
    const u16* ksrc = QK + (size_t)(b * SEQ) * LDQ + 512 + h * 64;
    const u16* vsrc = VT + (size_t)(h * 64) * MTOK + (size_t)b * SEQ;
    float qs = 0.f;
#pragma unroll
    for (int ks = 0; ks < 2; ++ks)
#pragma unroll
      for (int e = 0; e < 8; ++e) { const float v = bf2f((u16)q[ks][e]); qs += v * v; }
    qs += __shfl_xor(qs, 16); qs += __shfl_xor(qs, 32);
#pragma unroll
    for (int o2 = 1; o2 <= 8; o2 <<= 1) qs = fmaxf(qs, __shfl_xor(qs, o2));
    float* red = (float*)(lds + 256 * TS);
    if (lane == 0) red[w] = qs;
    __syncthreads();
    float qmax2 = red[0];
#pragma unroll
    for (int i = 1; i < NWAVE; ++i) qmax2 = fmaxf(qmax2, red[i]);
    const float kmax2 = __uint_as_float(((const uint32_t*)(p.ws + WS_KMAX))[h]);
    const float T2 = 2.f * scale2 * sqrtf(qmax2 * kmax2) * 1.001f + 48.f;
    const float cfirst2 = cfr[qblk * 128] * LOG2E;
    int i_lo = 0;
    for (int base = qblk * 2 - 1; base >= 0; base -= 64) {
      const int ti = base - lane;
      bool skip = false;
      if (ti >= 0) skip = (cfirst2 - cfr[ti * 64 + 63] * LOG2E) < -T2;
      const unsigned long long bal = __ballot(skip);
      if (bal) { i_lo = base - (int)__builtin_ctzll(bal) + 1; break; }
    }
    uint4 rk0, rv0;
    TILE_LD(rk, ksrc + (size_t)i_lo * 64 * LDQ, LDQ); TILE_LD(rv, vsrc + i_lo * 64, MTOK);
    TILE_ST(lds + (i_lo & 1) * (128 * TS), rk); TILE_STV(lds + (i_lo & 1) * (128 * TS) + 64 * TS, rv);
    __syncthreads();
    for (int i = i_lo; i < ntiles; ++i) {
      u16* cur = lds + (i & 1) * (128 * TS);
      const bool more = (i + 1 < ntiles);
      if (more) { TILE_LD(rk, ksrc + (size_t)(i + 1) * 64 * LDQ, LDQ); TILE_LD(rv, vsrc + (i + 1) * 64, MTOK); }
      if (i <= iw) {
        const int s0 = i * 64;
        const bool diag = (i == iw);
        f32x4 s[4];
        qk_tile(cur, q, s, l16, gk);
        float xv[4][4];
        float mx = -1e30f;
#pragma unroll
        for (int kt = 0; kt < 4; ++kt) {
          const float4 c4 = *(const float4*)(cfr + s0 + kt * 16 + gk * 4);
          const float ck[4] = {c4.x, c4.y, c4.z, c4.w};
#pragma unroll
          for (int r = 0; r < 4; ++r) {
            float v = fmaf(s[kt][r], scale2, cq2 - ck[r] * LOG2E);
            if (diag && (s0 + kt * 16 + gk * 4 + r > t)) v = -1e30f;
            xv[kt][r] = v; mx = fmaxf(mx, v);
          }
        }
        mx = fmaxf(mx, __shfl_xor(mx, 16)); mx = fmaxf(mx, __shfl_xor(mx, 32));
        const float mnew = fmaxf(m, mx);
        const float alpha = ex2(m - mnew);
        m = mnew;
        const float muse = fmaxf(mnew, -1e20f);
        float rs = 0.f;
#pragma unroll
        for (int kt = 0; kt < 4; ++kt)
#pragma unroll
          for (int r = 0; r < 4; ++r) { xv[kt][r] = ex2(xv[kt][r] - muse); rs += xv[kt][r]; }
        l = l * alpha + rs;
#pragma unroll
        for (int dt = 0; dt < 4; ++dt) o[dt] *= alpha;
        pv_tile(cur + 64 * TS, xv, o, l16, gk);
      }
      if (more) { u16* nxt = lds + ((i + 1) & 1) * (128 * TS); TILE_ST(nxt, rk); TILE_STV(nxt + 64 * TS, rv); }
      __syncthreads();
    }
    {
      float lt = l; lt += __shfl_xor(lt, 16); lt += __shfl_xor(lt, 32);
      const float inv = lt > 0.f ? 1.f / lt : 0.f;
      const size_t mrow = (size_t)(b * SEQ + t);
#pragma unroll
      for (int dt = 0; dt < 4; ++dt) {
        const int col = h * 64 + dt * 16 + gk * 4;
        const uint2 zz = *(const uint2*)(QK + mrow * LDQ + 2048 + col);
        const float z0 = bf2f(zz.x & 0xffff), z1 = bf2f(zz.x >> 16), z2 = bf2f(zz.y & 0xffff), z3 = bf2f(zz.y >> 16);
        uint2 ov;
        ov.x = pack2(o[dt][0] * inv * silu_f(z0), o[dt][1] * inv * silu_f(z1));
        ov.y = pack2(o[dt][2] * inv * silu_f(z2), o[dt][3] * inv * silu_f(z3));
        *(uint2*)(Y + mrow * DM + col) = ov;
      }
    }
  }
}

__device__ __forceinline__ void fox_knorm(const Params& p) {
  const u16* QK = (const u16*)(p.ws + WS_QK);
  uint32_t* km = (uint32_t*)(p.ws + WS_KMAX);
  const int tid = TIDX, lane = tid & 63, wave = tid >> 6;
  float mx = 0.f;
  for (int row = BIDX * NWAVE + wave; row < MTOK; row += gridDim.x * NWAVE) {
    const uint4 v = *(const uint4*)(QK + (size_t)row * LDQ + 512 + lane * 8);
    const float a0 = bf2f(v.x & 0xffff), a1 = bf2f(v.x >> 16), a2 = bf2f(v.y & 0xffff), a3 = bf2f(v.y >> 16);
    const float a4 = bf2f(v.z & 0xffff), a5 = bf2f(v.z >> 16), a6 = bf2f(v.w & 0xffff), a7 = bf2f(v.w >> 16);
    float ss = a0 * a0 + a1 * a1 + a2 * a2 + a3 * a3 + a4 * a4 + a5 * a5 + a6 * a6 + a7 * a7;
    ss += __shfl_xor(ss, 1); ss += __shfl_xor(ss, 2); ss += __shfl_xor(ss, 4);
    mx = fmaxf(mx, ss);
  }
  if ((lane & 7) == 0) atomicMax(&km[lane >> 3], __float_as_uint(mx));
}

__device__ __forceinline__ void fox_scan(const Params& p, float* ldsf) {
  const float* fl = (const float*)(p.ws + WS_FLOG);
  float* cf = (float*)(p.ws + WS_CFOX);
  double* sd = (double*)ldsf;
  const int tid = TIDX;
  for (int bh = BIDX; bh < 32; bh += gridDim.x) {
    const int b = bh >> 3, h = bh & 7;
    const float bf = p.e_bf[h];
    float ls[16];
    double sum = 0.0;
#pragma unroll
    for (int i = 0; i < 16; ++i) {
      const float xx = fl[(size_t)(b * SEQ + tid * 16 + i) * 8 + h] + bf;
      ls[i] = fminf(xx, 0.f) - log1pf(__expf(-fabsf(xx)));
      sum += (double)ls[i];
    }
    __syncthreads();
    sd[tid] = sum;
    __syncthreads();
    double pre = 0.0;
    for (int j = 0; j < tid; ++j) pre += sd[j];
#pragma unroll
    for (int i = 0; i < 16; ++i) { pre += (double)ls[i]; cf[(size_t)bh * SEQ + tid * 16 + i] = (float)pre; }
  }
}

__device__ __forceinline__ void ret_stepA(const Params& p) {
  const u16* VT = (const u16*)(p.ws + WS_VT);
  float* dS = (float*)(p.ws + WS_DS);
  const int tid_ = TIDX, lane = tid_ & 63, w8 = tid_ >> 6, w = w8 & 3, l16 = lane & 15, gk = lane >> 4;
  for (int u2 = BIDX; u2 < 1024; u2 += gridDim.x) {
    const int u = u2 * 2 + (w8 >> 2);
    const int bh = u >> 6, n = u & 63, b = bh >> 3, h = bh & 7;
    const size_t mcol = (size_t)b * SEQ + n * 128;
    f32x4 acc[4];
#pragma unroll
    for (int dt = 0; dt < 4; ++dt) acc[dt] = (f32x4){0.f, 0.f, 0.f, 0.f};
#pragma unroll
    for (int ks = 0; ks < 4; ++ks) {
      bf16x8 af = *(const bf16x8*)(VT + (size_t)(512 + h * 64 + w * 16 + l16) * MTOK + mcol + ks * 32 + gk * 8);
#pragma unroll
      for (int dt = 0; dt < 4; ++dt) {
        bf16x8 bfr = *(const bf16x8*)(VT + (size_t)(1024 + h * 64 + dt * 16 + l16) * MTOK + mcol + ks * 32 + gk * 8);
        acc[dt] = MFMA(af, bfr, acc[dt]);
      }
    }
#pragma unroll
    for (int dt = 0; dt < 4; ++dt)
#pragma unroll
      for (int r = 0; r < 4; ++r) dS[(size_t)u * 4096 + (w * 16 + gk * 4 + r) * 64 + dt * 16 + l16] = acc[dt][r];
  }
}
__device__ __forceinline__ void ret_stepB(const Params& p) {
  const float* dS = (const float*)(p.ws + WS_DS);
  u16* st = (u16*)(p.ws + WS_ST);
  for (int idx = BIDX * NTHR + TIDX; idx < 32 * 4096; idx += gridDim.x * NTHR) {
    const int bh = idx >> 12, ed = idx & 4095, h = bh & 7;
    const float cdec = __expf(log1pf(-exp2f(-5.f - (float)h)) * 128.f);
    float s = 0.f;
#pragma unroll 8
    for (int n = 0; n < 64; ++n) {
      const size_t a = (size_t)(bh * 64 + n) * 4096 + ed;
      st[a] = f2bf(s);
      s = s * cdec + dS[a];
    }
  }
}
__device__ __forceinline__ void ret_stepC(const Params& p, u16* lds) {
  const u16* QK = (const u16*)(p.ws + WS_QK);
  const u16* VT = (const u16*)(p.ws + WS_VT);
  const u16* st = (const u16*)(p.ws + WS_ST);
  u16* Y = (u16*)(p.ws + WS_Y);
  const int tid = TIDX, lane = tid & 63, w = tid >> 6, l16 = lane & 15, gk = lane >> 4;
  for (int u = BIDX; u < 2048; u += gridDim.x) {
    const int bh = u >> 6, n = u & 63, b = bh >> 3, h = bh & 7;
    const size_t m0 = (size_t)b * SEQ + n * 128;
    const float lg2 = log1pf(-exp2f(-5.f - (float)h)) * LOG2E;
    __syncthreads();
    {
      uint4 r0;
      TILE_LD(r, QK + m0 * LDQ + 1536 + h * 64, LDQ); TILE_ST(lds, r);
      TILE_LD(r, VT + (size_t)(512 + h * 64) * MTOK + m0, MTOK); TILE_STV(lds + 64 * TS, r);
      TILE_LD(r, QK + (m0 + 64) * LDQ + 1536 + h * 64, LDQ); TILE_ST(lds + 128 * TS, r);
      TILE_LD(r, VT + (size_t)(512 + h * 64) * MTOK + m0 + 64, MTOK); TILE_STV(lds + 192 * TS, r);
      TILE_LD(r, st + (size_t)u * 4096, 64); TILE_ST(lds + 256 * TS, r);
    }
    __syncthreads();
    const int iq = 16 * w + l16;
    const size_t mrow = m0 + iq;
    bf16x8 q[2];
#pragma unroll
    for (int ks = 0; ks < 2; ++ks) q[ks] = *(const bf16x8*)(QK + mrow * LDQ + 1024 + h * 64 + ks * 32 + gk * 8);
    f32x4 o[4];
#pragma unroll
    for (int dt = 0; dt < 4; ++dt) o[dt] = (f32x4){0.f, 0.f, 0.f, 0.f};
#pragma unroll
    for (int dt = 0; dt < 4; ++dt)
#pragma unroll
      for (int ks = 0; ks < 2; ++ks) {
        bf16x8 sf = *(const bf16x8*)(lds + 256 * TS + (dt * 16 + l16) * TS + ks * 32 + gk * 8);
        o[dt] = MFMA(sf, q[ks], o[dt]);
      }
    const float cross = ex2(lg2 * (float)(iq + 1));
#pragma unroll
    for (int dt = 0; dt < 4; ++dt) o[dt] *= cross;
#pragma unroll
    for (int k64 = 0; k64 < 2; ++k64) {
      if (k64 * 64 <= 16 * w + 15) {
        f32x4 s[4];
        qk_tile(lds + k64 * 128 * TS, q, s, l16, gk);
        float pp[4][4];
#pragma unroll
        for (int kt = 0; kt < 4; ++kt)
#pragma unroll
          for (int r = 0; r < 4; ++r) {
            const int j = k64 * 64 + kt * 16 + gk * 4 + r;
            pp[kt][r] = (j <= iq) ? s[kt][r] * 0.125f * ex2(lg2 * (float)(iq - j)) : 0.f;
          }
        pv_tile(lds + k64 * 128 * TS + 64 * TS, pp, o, l16, gk);
      }
    }
    float sm = 0.f;
#pragma unroll
    for (int dt = 0; dt < 4; ++dt) sm += o[dt][0] + o[dt][1] + o[dt][2] + o[dt][3];
    sm += __shfl_xor(sm, 16); sm += __shfl_xor(sm, 32);
    const float mu = sm * (1.f / 64.f);
    float vs = 0.f;
#pragma unroll
    for (int dt = 0; dt < 4; ++dt)
#pragma unroll
      for (int r = 0; r < 4; ++r) { const float d = o[dt][r] - mu; vs += d * d; }
    vs += __shfl_xor(vs, 16); vs += __shfl_xor(vs, 32);
    const float rstd = rsqrtf(vs * (1.f / 64.f) + 1e-5f);
#pragma unroll
    for (int dt = 0; dt < 4; ++dt) {
      const int col = h * 64 + dt * 16 + gk * 4;
      const float4 gg = *(const float4*)(p.e_gn + col);
      const uint2 zz = *(const uint2*)(QK + mrow * LDQ + 2048 + 512 + col);
      const float z0 = bf2f(zz.x & 0xffff), z1 = bf2f(zz.x >> 16), z2 = bf2f(zz.y & 0xffff), z3 = bf2f(zz.y >> 16);
      uint2 ov;
      ov.x = pack2((o[dt][0] - mu) * rstd * gg.x * silu_f(z0), (o[dt][1] - mu) * rstd * gg.y * silu_f(z1));
      ov.y = pack2((o[dt][2] - mu) * rstd * gg.z * silu_f(z2), (o[dt][3] - mu) * rstd * gg.w * silu_f(z3));
      *(uint2*)(Y + mrow * DM + 512 + col) = ov;
    }
  }
}

__device__ __forceinline__ void nsa_tile_interior(const u16* sK, const u16* sV, const bf16x8 (&q)[2], f32x4 (&acc)[4],
                                                  float& m, float& l, float slope2, const float (&sk)[16],
                                                  int t, int pos0, bool lanesel, int lane) {
  const int l16 = lane & 15, gk = lane >> 4;
  const float scale2 = 0.125f * LOG2E;
  f32x4 s[4];
  qk_tile(sK, q, s, l16, gk);
  const float c0 = fmaf(-slope2, (float)(t - pos0 - gk * 4), lanesel ? 0.f : -1e30f);
  float xv[4][4];
  float mx = -1e30f;
#pragma unroll
  for (int kt = 0; kt < 4; ++kt)
#pragma unroll
    for (int r = 0; r < 4; ++r) { xv[kt][r] = fmaf(s[kt][r], scale2, sk[kt * 4 + r]); mx = fmaxf(mx, xv[kt][r]); }
  mx += c0;
  mx = fmaxf(mx, __shfl_xor(mx, 16)); mx = fmaxf(mx, __shfl_xor(mx, 32));
  const float mnew = fmaxf(m, mx);
  const float alpha = ex2(m - mnew);
  m = mnew;
  const float off = c0 - fmaxf(mnew, -1e20f);
  float rs = 0.f;
#pragma unroll
  for (int kt = 0; kt < 4; ++kt)
#pragma unroll
    for (int r = 0; r < 4; ++r) { xv[kt][r] = ex2(xv[kt][r] + off); rs += xv[kt][r]; }
  l = l * alpha + rs;
  if (__any(alpha != 1.f)) {
#pragma unroll
    for (int dt = 0; dt < 4; ++dt) acc[dt] *= alpha;
  }
  pv_tile(sV, xv, acc, l16, gk);
}
template <int BR>
__device__ __forceinline__ void nsa_tile(const u16* sK, const u16* sV, const bf16x8 (&q)[2], f32x4 (&acc)[4],
                                         float& m, float& l, float slope2, float gmul,
                                         int t, int pos0, int pstride, int wl, bool lanesel,
                                         float* imp_row, int jbase, float& carry, int lane, float* imp_scale = nullptr) {
  const int l16 = lane & 15, gk = lane >> 4;
  const float scale2 = 0.125f * LOG2E;
  const unsigned wle = lanesel ? (unsigned)wl : 0u;
  f32x4 s[4];
  qk_tile(sK, q, s, l16, gk);
  float xv[4][4];
  float mx = -1e30f;
#pragma unroll
  for (int kt = 0; kt < 4; ++kt)
#pragma unroll
    for (int r = 0; r < 4; ++r) {
      const int dist = t - (pos0 + (kt * 16 + gk * 4 + r) * pstride);
      const float pen = ((unsigned)dist < wle) ? 0.f : -1e30f;
      const float v = fmaf(s[kt][r], scale2, fmaf(-slope2, (float)dist, pen));
      xv[kt][r] = v; mx = fmaxf(mx, v);
    }
  if (BR != 1) {
    mx = fmaxf(mx, __shfl_xor(mx, 16)); mx = fmaxf(mx, __shfl_xor(mx, 32));
    const float mnew = fmaxf(m, mx);
    const float alpha = ex2(m - mnew);
    m = mnew;
    const float muse = fmaxf(mnew, -1e20f);
    float rs = 0.f;
#pragma unroll
    for (int kt = 0; kt < 4; ++kt)
#pragma unroll
      for (int r = 0; r < 4; ++r) { xv[kt][r] = ex2(xv[kt][r] - muse); rs += xv[kt][r]; }
    l = l * alpha + rs;
    if (BR == 2 || BR == 3) {
#pragma unroll
      for (int dt = 0; dt < 4; ++dt) acc[dt] *= alpha;
    }
    if (BR == 3) {
      float p3[4];
#pragma unroll
      for (int kt = 0; kt < 4; ++kt) {
        p3[kt] = xv[kt][3];
        imp_row[jbase + kt * 4 + gk] = 2.f * (xv[kt][0] + xv[kt][1] + xv[kt][2]) + xv[kt][3];
      }
      const int srcl = (lane + 48) & 63;
      const float carry_s = carry * alpha;
#pragma unroll
      for (int kt = 0; kt < 4; ++kt) {
        const float same = __shfl(p3[kt], srcl);
        const float prev = __shfl(kt > 0 ? p3[kt > 0 ? kt - 1 : 0] : carry_s, srcl);
        imp_row[jbase + kt * 4 + gk] += (gk == 0) ? prev : same;
      }
      carry = p3[3];
      if (gk == 0) *imp_scale = mnew;
    }
    if (BR == 2 || BR == 3) pv_tile(sV, xv, acc, l16, gk);
  } else {
    const float muse = fmaxf(m, -1e20f);
    float p3[4];
#pragma unroll
    for (int kt = 0; kt < 4; ++kt) {
      float pn[4];
#pragma unroll
      for (int r = 0; r < 4; ++r) { pn[r] = ex2(xv[kt][r] - muse) * l; xv[kt][r] = pn[r] * gmul; }
      p3[kt] = pn[3];
      xv[kt][0] = xv[kt][0];
      imp_row[jbase + kt * 4 + gk] = 2.f * (pn[0] + pn[1] + pn[2]) + pn[3];
    }
    const int srcl = (lane + 48) & 63;
#pragma unroll
    for (int kt = 0; kt < 4; ++kt) {
      const float same = __shfl(p3[kt], srcl);
      const float prev = __shfl(kt > 0 ? p3[kt > 0 ? kt - 1 : 0] : carry, srcl);
      imp_row[jbase + kt * 4 + gk] += (gk == 0) ? prev : same;
    }
    carry = p3[3];
    pv_tile(sV, xv, acc, l16, gk);
  }
}

__device__ __forceinline__ void nsa_phase(const Params& p, u16* lds) {
  const u16* U = (const u16*)(p.ws + WS_QK);
  const u16* VT = (const u16*)(p.ws + WS_VT);
  const u16* KC = (const u16*)(p.ws + WS_KCMP);
  const u16* VC = (const u16*)(p.ws + WS_VCMPT);
  const float* GL = (const float*)(p.ws + WS_GL);
  u16* Y = (u16*)(p.ws + WS_Y);
  float* imp = (float*)(lds + 512 * TS);
  uint32_t* umask = (uint32_t*)(imp + 128 * IMPS);
  int* ulist = (int*)(umask + 4);
  const int tid = TIDX, lane = tid & 63, w = tid >> 6, l16 = lane & 15, gk = lane >> 4;
  const int qt = w & 1, hd = w >> 1;
  uint2* totl = (uint2*)imp + 128 + (size_t)w * 256 + lane;
  const int BIG = 1 << 30;
  int* uslot = ulist + 128;
  unsigned* uctr = (unsigned*)(p.ws + WS_KMAX) + 24;
  for (;;) {
    __syncthreads();
    if (tid == 0) uslot[0] = (int)atomicAdd(uctr, 1u);
    __syncthreads();
    const int unit = uslot[0];
    if (unit >= 4096) break;
    const int bg = unit & 15, qh = 255 - (unit >> 4), b = bg >> 2, g = bg & 3;
    const int t0 = qh * 32, qb = t0 >> 6, t = t0 + 16 * qt + l16;
    const size_t mrow = (size_t)b * SEQ + t;
    const int h = g * 4 + hd;
    bf16x8 q[2];
#pragma unroll
    for (int ks = 0; ks < 2; ++ks) q[ks] = *(const bf16x8*)(U + mrow * LDQ + h * 64 + ks * 32 + gk * 8);
    const float slope2 = exp2f(-0.5f * (float)(h + 1)) * LOG2E;
    const float g1 = sigmoid_f(GL[mrow * 48 + h * 3] + p.o_bg[h * 3]);
    float sk[16];
#pragma unroll
    for (int i = 0; i < 16; ++i) sk[i] = slope2 * (float)((i >> 2) * 16 + (i & 3));
    float qn2 = 0.f;
#pragma unroll
    for (int ks = 0; ks < 2; ++ks)
#pragma unroll
      for (int e = 0; e < 8; ++e) { const float v = bf2f((u16)q[ks][e]); qn2 += v * v; }
    qn2 += __shfl_xor(qn2, 16); qn2 += __shfl_xor(qn2, 32);
#pragma unroll
    for (int o2 = 1; o2 <= 8; o2 <<= 1) qn2 = fmaxf(qn2, __shfl_xor(qn2, o2));
    const uint32_t* kmx = (const uint32_t*)(p.ws + WS_KMAX);
    const float sc2 = 0.125f * LOG2E;
    const float T_slc = 2.02f * sc2 * sqrtf(qn2 * __uint_as_float(kmx[8 + g])) + 48.f;
    const float T_win = 2.02f * sc2 * sqrtf(qn2 * __uint_as_float(kmx[12 + g])) + 48.f;
    const float T_cmp = 2.05f * sc2 * sqrtf(qn2 * __uint_as_float(kmx[16 + g])) + 16.f * slope2 + 48.f;
    const int tq0w = t0 + 16 * qt;
    f32x4 acc[4];
    float m = -1e30f, l = 0.f;
#pragma unroll
    for (int dt = 0; dt < 4; ++dt) acc[dt] = (f32x4){0.f, 0.f, 0.f, 0.f};
    __syncthreads();
    for (int i = tid; i < 128 * IMPS; i += NTHR) imp[i] = 0.f;
    if (tid < 4) umask[tid] = 0u;
    float* imp_row = imp + (hd * 32 + 16 * qt + l16) * IMPS;
    float carry = 0.f;
    uint4 rk0, rk1, rk2, rk3, rv0, rv1, rv2, rv3;
    u16* impbase_unused = nullptr; (void)impbase_unused;
#define SLOT(k) (lds + (k) * (128 * TS))
#define LD1(k, kp, ks_, vp, vs_) { rk##k = *(const uint4*)((kp) + (long)(tid >> 3) * (ks_) + (tid & 7) * 8); rv##k = *(const uint4*)((vp) + (long)(tid >> 3) * (vs_) + (tid & 7) * 8); }
#define ST1(k) { *(uint4*)(SLOT(k) + (tid >> 3) * TS + (tid & 7) * 8) = rk##k; TILE_STV_(SLOT(k) + 64 * TS, rv##k) }
    const int ntc = ((t0 >> 4) >> 6) + 1;
    const u16* kcs = KC + (size_t)bg * 512 * 64;
    const u16* vcs = VC + (size_t)bg * 32768;
#define CMP_LD(k, i) if ((i) < ntc) LD1(k, kcs + (size_t)(i) * 64 * 64, 64, vcs + (i) * 64, 512)
    float* mrec = (float*)(uslot + 4) + (w * 16 + l16) * 8;
    {
      const int ngrp = (ntc + 3) >> 2;
      CMP_LD(0, 0) CMP_LD(1, 1) CMP_LD(2, 2) CMP_LD(3, 3)
#pragma unroll 1
      for (int gi = 0; gi < ngrp; ++gi) {
        const int ib = gi * 4;
        __syncthreads();
        if (ib < ntc) ST1(0) if (ib + 1 < ntc) ST1(1) if (ib + 2 < ntc) ST1(2) if (ib + 3 < ntc) ST1(3)
        __syncthreads();
        if (gi + 1 < ngrp) { CMP_LD(0, ib + 4) CMP_LD(1, ib + 5) CMP_LD(2, ib + 6) CMP_LD(3, ib + 7) }
#pragma unroll 1
        for (int k = 0; k < 4; ++k) {
          const int i = ib + k;
          if (i < ntc) {
            const int dmin = tq0w - (16 * (64 * i + 63) + 31);
            if (dmin > 0 && slope2 * (float)dmin > T_cmp) { carry = 0.f; if (gk == 0) mrec[i] = -1e30f; continue; }
            nsa_tile<3>(SLOT(k), SLOT(k) + 64 * TS, q, acc, m, l, slope2, g1, t, 16 * (64 * i) + 31, 16, BIG, true, imp_row, 16 * i, carry, lane, mrec + i);
          }
        }
      }
      float lt = l; lt += __shfl_xor(lt, 16); lt += __shfl_xor(lt, 32);
      const float inv = lt > 0.f ? 1.f / lt : 0.f;
      const float mfin = fmaxf(m, -1e20f);
#pragma unroll 1
      for (int i = 0; i < ntc; ++i) {
        const float f = ex2(fmaxf(mrec[i], -1e20f) - mfin) * inv;
#pragma unroll
        for (int kt = 0; kt < 4; ++kt) imp_row[16 * i + kt * 4 + gk] *= f;
      }
      const float og = g1 * inv;
#pragma unroll
      for (int dt = 0; dt < 4; ++dt) acc[dt] *= og;
    }
    __syncthreads();
    {
      const int qi = w * 4 + gk;
      const int c8 = l16 * 8;
      uint32_t selb = 0u;
      if (qb < 16) {
#pragma unroll
        for (int i = 0; i < 8; ++i) if (c8 + i <= qb) selb |= (1u << i);
      } else {
        float val[8];
        const float* ra = imp + qi * IMPS + c8;
#pragma unroll
        for (int i4 = 0; i4 < 2; ++i4) {
          const float4 v0 = *(const float4*)(ra + 4 * i4);
          const float4 v1 = *(const float4*)(ra + 32 * IMPS + 4 * i4);
          const float4 v2 = *(const float4*)(ra + 64 * IMPS + 4 * i4);
          const float4 v3 = *(const float4*)(ra + 96 * IMPS + 4 * i4);
          val[4 * i4] = ((v0.x + v1.x) + v2.x) + v3.x; val[4 * i4 + 1] = ((v0.y + v1.y) + v2.y) + v3.y;
          val[4 * i4 + 2] = ((v0.z + v1.z) + v2.z) + v3.z; val[4 * i4 + 3] = ((v0.w + v1.w) + v2.w) + v3.w;
        }
#pragma unroll
        for (int i = 0; i < 8; ++i) {
          const int j = c8 + i;
          const bool forced = (j == 0) || (j == qb) || (j == qb - 1);
          if (forced) selb |= (1u << i);
          if (forced || j > qb) val[i] = -1.f;
        }
#pragma unroll 1
        for (int it = 0; it < 13; ++it) {
          float best = -2.f; int bj = 0;
#pragma unroll
          for (int i = 0; i < 8; ++i) {
            const float v = ((selb >> i) & 1u) ? -1.f : val[i];
            if (v > best) { best = v; bj = c8 + i; }
          }
#pragma unroll
          for (int o = 1; o <= 8; o <<= 1) {
            const float ov = __shfl_xor(best, o); const int oj = __shfl_xor(bj, o);
            if (ov > best || (ov == best && oj < bj)) { best = ov; bj = oj; }
          }
          if ((bj >> 3) == l16) selb |= (1u << (bj & 7));
        }
      }
      uint32_t wd = selb << ((l16 & 3) * 8);
      wd |= __shfl_xor(wd, 1); wd |= __shfl_xor(wd, 2);
      __syncthreads();
      uint32_t* selw = (uint32_t*)imp;
      if ((l16 & 3) == 0) selw[qi * 4 + (l16 >> 2)] = wd;
      uint32_t uq = wd; uq |= __shfl_xor(uq, 16); uq |= __shfl_xor(uq, 32);
      if (gk == 0 && (l16 & 3) == 0) atomicOr(&umask[l16 >> 2], uq);
    }
    __syncthreads();
    const uint32_t* selq = (const uint32_t*)imp + (16 * qt + l16) * 4;
    const uint32_t sel0 = selq[0], sel1 = selq[1], sel2 = selq[2], sel3 = selq[3];
    uint32_t wun0 = sel0, wun1 = sel1, wun2 = sel2, wun3 = sel3;
#pragma unroll
    for (int o = 1; o <= 8; o <<= 1) { wun0 |= __shfl_xor(wun0, o); wun1 |= __shfl_xor(wun1, o); wun2 |= __shfl_xor(wun2, o); wun3 |= __shfl_xor(wun3, o); }
    int nsl = 0;
    {
      const uint32_t u0 = umask[0], u1 = umask[1], u2 = umask[2], u3 = umask[3];
      nsl = __popc(u0) + __popc(u1) + __popc(u2) + __popc(u3);
      if (tid < 128) {
        const uint32_t uw = tid < 32 ? u0 : tid < 64 ? u1 : tid < 96 ? u2 : u3;
        if ((uw >> (tid & 31)) & 1u) {
          int pos = __popc(uw & ((1u << (tid & 31)) - 1u));
          if (tid >= 32) pos += __popc(u0);
          if (tid >= 64) pos += __popc(u1);
          if (tid >= 96) pos += __popc(u2);
          ulist[pos] = tid;
        }
      }
    }
    __syncthreads();
#pragma unroll
    for (int dt = 0; dt < 4; ++dt) {
      uint2 o2; o2.x = pack2(acc[dt][0], acc[dt][1]); o2.y = pack2(acc[dt][2], acc[dt][3]);
      totl[dt * 64] = o2;
    }
#pragma unroll 1
    for (int br = 1; br < 3; ++br) {
      m = -1e30f; l = 0.f;
#pragma unroll
      for (int dt = 0; dt < 4; ++dt) acc[dt] = (f32x4){0.f, 0.f, 0.f, 0.f};
      int wfirst = ((t0 - 511) >> 6) << 6; if (wfirst < 0) wfirst = 0;
      const int nt = (br == 1) ? nsl : ((qb * 64 - wfirst) >> 6) + 1;
      const int ngrp = (nt + 3) >> 2;
      const u16* kb = U + (size_t)b * SEQ * LDQ + (br == 1 ? 1536 : 1792) + g * 64;
      const u16* vb = VT + (size_t)((br == 1 ? 0 : 256) + g * 64) * MTOK + (size_t)b * SEQ;
#define SRC_S0(i) ((br == 1) ? ulist[nt - 1 - (i)] * 64 : wfirst + 64 * (nt - 1 - (i)))
#define BR_LD(k, i) if ((i) < nt) { const int s_ = SRC_S0(i); LD1(k, kb + (size_t)s_ * LDQ, LDQ, vb + s_, MTOK) }
      BR_LD(0, 0) BR_LD(1, 1) BR_LD(2, 2) BR_LD(3, 3)
#pragma unroll 1
      for (int gi = 0; gi < ngrp; ++gi) {
        const int ib = gi * 4;
        __syncthreads();
        if (ib < nt) ST1(0) if (ib + 1 < nt) ST1(1) if (ib + 2 < nt) ST1(2) if (ib + 3 < nt) ST1(3)
        __syncthreads();
        if (gi + 1 < ngrp) { BR_LD(0, ib + 4) BR_LD(1, ib + 5) BR_LD(2, ib + 6) BR_LD(3, ib + 7) }
#pragma unroll 1
        for (int k = 0; k < 4; ++k) {
          const int i = ib + k;
          if (i < nt) {
            const int s0 = SRC_S0(i);
            bool wsel = true, ls = true;
            int wl = 512;
            if (br == 1) {
              const int j = s0 >> 6, jw = j >> 5, jb = j & 31;
              const uint32_t ww = jw == 0 ? wun0 : jw == 1 ? wun1 : jw == 2 ? wun2 : wun3;
              const uint32_t sw = jw == 0 ? sel0 : jw == 1 ? sel1 : jw == 2 ? sel2 : sel3;
              wsel = (ww >> jb) & 1u; ls = (sw >> jb) & 1u; wl = BIG;
            }
            if (wsel) {
              const int dminw = tq0w - (s0 + 63);
              if (dminw > 0 && slope2 * (float)dminw > (br == 1 ? T_slc : T_win)) wsel = false;
            }
            if (wsel) {
              const int tq0 = t0 + 16 * qt;
              const bool interior = (s0 + 63 <= tq0) && (br == 1 || s0 + 512 > tq0 + 15);
              if (interior) nsa_tile_interior(SLOT(k), SLOT(k) + 64 * TS, q, acc, m, l, slope2, sk, t, s0, ls, lane);
              else nsa_tile<2>(SLOT(k), SLOT(k) + 64 * TS, q, acc, m, l, slope2, g1, t, s0, 1, wl, ls, imp_row, 0, carry, lane);
            }
          }
        }
      }
      {
        float lt = l; lt += __shfl_xor(lt, 16); lt += __shfl_xor(lt, 32);
        const float gt = sigmoid_f(GL[mrow * 48 + h * 3 + br] + p.o_bg[h * 3 + br]);
        const float sc = lt > 0.f ? gt / lt : 0.f;
#pragma unroll
        for (int dt = 0; dt < 4; ++dt) {
          const uint2 pv = totl[dt * 64];
          const float r0 = bf2f(pv.x & 0xffff) + acc[dt][0] * sc, r1 = bf2f(pv.x >> 16) + acc[dt][1] * sc;
          const float r2 = bf2f(pv.y & 0xffff) + acc[dt][2] * sc, r3 = bf2f(pv.y >> 16) + acc[dt][3] * sc;
          if (br == 1) {
            uint2 o2; o2.x = pack2(r0, r1); o2.y = pack2(r2, r3);
            totl[dt * 64] = o2;
          } else {
            const int col = h * 64 + dt * 16 + gk * 4;
            const uint2 zz = *(const uint2*)(U + mrow * LDQ + 2048 + col);
            const float z0 = bf2f(zz.x & 0xffff), z1 = bf2f(zz.x >> 16), z2 = bf2f(zz.y & 0xffff), z3 = bf2f(zz.y >> 16);
            uint2 ov;
            ov.x = pack2(r0 * silu_f(z0), r1 * silu_f(z1));
            ov.y = pack2(r2 * silu_f(z2), r3 * silu_f(z3));
            *(uint2*)(Y + mrow * DM + col) = ov;
          }
        }
      }
    }
#undef SLOT
#undef LD1
#undef ST1
#undef CMP_LD
#undef SRC_S0
#undef BR_LD
  }
}

__device__ __forceinline__ void final_norm(const Params& p) {
  const int lane = TIDX & 63, wave = TIDX >> 6;
  for (int row = BIDX * NWAVE + wave; row < MTOK; row += gridDim.x * NWAVE) {
    float4* xr = (float4*)(p.out + (size_t)row * DM);
    float4 v[4];
    float ss = 0.f;
#pragma unroll
    for (int i = 0; i < 4; ++i) {
      v[i] = xr[lane + 64 * i];
      ss += v[i].x * v[i].x + v[i].y * v[i].y + v[i].z * v[i].z + v[i].w * v[i].w;
    }
#pragma unroll
    for (int o = 32; o >= 1; o >>= 1) ss += __shfl_xor(ss, o);
    const float rstd = rsqrtf(ss * (1.f / DM) + 1e-6f);
#pragma unroll
    for (int i = 0; i < 4; ++i) {
      const float4 gg = ((const float4*)p.fin_g)[lane + 64 * i];
      xr[lane + 64 * i] = (float4){v[i].x * rstd * gg.x, v[i].y * rstd * gg.y, v[i].z * rstd * gg.z, v[i].w * rstd * gg.w};
    }
  }
}

#define XB_XCNT(j)  (64 * (j))
#define XB_XSUB(j)  (1024 + 64 * (j))
#define XB_XGEN(j)  (2048 + 64 * (j))
#define XB_TOP      3072
#define XB_TOPGEN   3136
#define XB_WORDS    3200
#define LAS __attribute__((address_space(3)))
__device__ __forceinline__ unsigned xb_ld(unsigned* q) { return __hip_atomic_load(q, __ATOMIC_RELAXED, __HIP_MEMORY_SCOPE_AGENT); }
__device__ __forceinline__ unsigned xb_add(unsigned* q, unsigned v) { return __hip_atomic_fetch_add(q, v, __ATOMIC_RELAXED, __HIP_MEMORY_SCOPE_AGENT); }
__device__ __forceinline__ unsigned xb_xcc_id() { return (unsigned)__builtin_amdgcn_s_getreg((3 << 11) | 20) & 0xFu; }
__device__ __forceinline__ void grid_bar(const Params& p, unsigned xcc, volatile unsigned* st) {
  asm volatile("s_waitcnt vmcnt(0)" ::: "memory");
  __syncthreads();
  if (TIDX == 0) {
    unsigned* bar = (unsigned*)(p.ws + WS_BAR);
    __builtin_amdgcn_s_waitcnt(0);
    unsigned nloc = st[0], nx = st[1];
    if (nloc == 0u) {
      const unsigned G = gridDim.x;
      for (;;) {
        unsigned sum = 0u, cnt = 0u, mine = 0u, below = 0u;
#pragma unroll
        for (unsigned j = 0; j < 16; ++j) { const unsigned c = xb_ld(&bar[XB_XCNT(j)]); sum += c; cnt += (c > 0u) ? 1u : 0u; mine = (j == xcc) ? c : mine; below += (j < xcc && c > 0u) ? 1u : 0u; }
        nloc = mine; nx = cnt; st[3] = below;
        if (sum == G) break;
        __builtin_amdgcn_s_sleep(1);
      }
      st[0] = nloc; st[1] = nx;
    }
    const unsigned old = xb_add(&bar[XB_XSUB(xcc)], 1u);
    const unsigned gen = old / nloc;
    if (old + 1u == (gen + 1u) * nloc) {
      __builtin_amdgcn_fence(__ATOMIC_RELEASE, "agent");
      asm volatile("s_waitcnt vmcnt(0)" ::: "memory");
      const unsigned og = xb_add(&bar[XB_TOP], 1u);
      const unsigned tg = og / nx;
      if (og + 1u == (tg + 1u) * nx) xb_add(&bar[XB_TOPGEN], 1u);
      else while (xb_ld(&bar[XB_TOPGEN]) == tg) __builtin_amdgcn_s_sleep(1);
      __builtin_amdgcn_fence(__ATOMIC_ACQUIRE, "agent");
      xb_add(&bar[XB_XGEN(xcc)], 1u);
      asm volatile("s_waitcnt vmcnt(0)" ::: "memory");
    } else {
      while (xb_ld(&bar[XB_XGEN(xcc)]) == gen) __builtin_amdgcn_s_sleep(1);
      __builtin_amdgcn_fence(__ATOMIC_ACQUIRE, "agent");
      asm volatile("s_waitcnt vmcnt(0)" ::: "memory");
    }
  }
  __syncthreads();
}

__device__ __forceinline__ void nsa_knorm(const Params& p) {
  if (BIDX < 64) return;
  const u16* U = (const u16*)(p.ws + WS_QK);
  uint32_t* km = (uint32_t*)(p.ws + WS_KMAX);
  const int tid = TIDX, lane = tid & 63, wave = tid >> 6;
  float mx = 0.f;
  for (int row = (BIDX - 64) * NWAVE + wave; row < MTOK; row += (gridDim.x - 64) * NWAVE) {
    const uint4 v = *(const uint4*)(U + (size_t)row * LDQ + 1536 + lane * 8);
    const float a0 = bf2f(v.x & 0xffff), a1 = bf2f(v.x >> 16), a2 = bf2f(v.y & 0xffff), a3 = bf2f(v.y >> 16);
    const float a4 = bf2f(v.z & 0xffff), a5 = bf2f(v.z >> 16), a6 = bf2f(v.w & 0xffff), a7 = bf2f(v.w >> 16);
    float ss = a0 * a0 + a1 * a1 + a2 * a2 + a3 * a3 + a4 * a4 + a5 * a5 + a6 * a6 + a7 * a7;
    ss += __shfl_xor(ss, 1); ss += __shfl_xor(ss, 2); ss += __shfl_xor(ss, 4);
    mx = fmaxf(mx, ss);
  }
  if ((lane & 7) == 0) atomicMax(&km[8 + (lane >> 3)], __float_as_uint(mx));
}

__global__ void __launch_bounds__(NTHR, 2) mega(Params p_in) {
  Params p = p_in;
  p.pad = __builtin_amdgcn_readfirstlane((int)threadIdx.x >> 6);
  extern __shared__ __attribute__((aligned(16))) unsigned char lds_raw[];
  u16* lds = (u16*)lds_raw;
  const unsigned xcc = xb_xcc_id();
  volatile unsigned* bst = (volatile unsigned*)(lds_raw + 147456);
  if (threadIdx.x < 4) bst[threadIdx.x] = 0u;
  __syncthreads();
  if (p_in.coop && threadIdx.x == 0) bst[2] = xb_add((unsigned*)(p_in.ws + WS_BAR) + XB_XCNT(xcc), 1u);
  __syncthreads();
  cg::grid_group grid = cg::this_grid();
  if (p_in.coop == 2) grid.sync();
#define PH_ON(k) (p.ph_lo <= (k) && (k) <= p.ph_hi)
#define PH_SYNC(k) if (p.coop && p.ph_lo <= (k) && (k) < p.ph_hi) grid_bar(p, xcc, bst);
  if (PH_ON(0)) {
    rms_rows_fl(p, (float*)lds);
    conv_t(p, (u16*)(p.ws + WS_WT0), p.e_win, 1024, 4104, 4352, 0);
    conv_t(p, (u16*)(p.ws + WS_WT1), p.o_win, 1024, 3632, 3840, 1);
    conv_t(p, (u16*)(p.ws + WS_WO0), p.e_wout, 1024, 1024, 1024, 2);
    conv_t(p, (u16*)(p.ws + WS_WO1), p.o_wout, 1024, 1024, 1024, 2);
    conv_t(p, (u16*)(p.ws + WS_W1K), p.o_wk1, 2048, 256, 256, 2);
    conv_t(p, (u16*)(p.ws + WS_W1V), p.o_wv1, 2048, 256, 256, 2);
    conv_t(p, (u16*)(p.ws + WS_W2K), p.o_wk2, 256, 64, 256, 2);
    conv_t(p, (u16*)(p.ws + WS_W2V), p.o_wv2, 256, 64, 256, 2);
    pe_partial(p);
    if (BIDX == 0 && TIDX < 32) ((uint32_t*)(p.ws + WS_KMAX))[TIDX] = 0u;
    for (int i = BIDX * NTHR + TIDX; i < MTOK; i += gridDim.x * NTHR) ((float*)(p.ws + WS_SSQ))[i] = 0.f;
  }
  PH_SYNC(0)
  if (PH_ON(1)) gemm_inproj(p, 0, lds, 0);
  PH_SYNC(1)
  if (PH_ON(2)) {
    fox_scan(p, (float*)lds); ret_stepA(p); fox_knorm(p);
    if (BIDX == gridDim.x - 1) {
      for (int i = TIDX; i < 512; i += NTHR) {
        const float* part = (const float*)(p.ws + WS_PEP);
        float sum = 0.f;
        for (int kc = 0; kc < 16; ++kc) sum += part[((i >> 8) * 16 + kc) * 256 + (i & 255)];
        ((float*)(p.ws + WS_PEB))[i] = sum;
      }
    }
  }
  PH_SYNC(2)
  if (PH_ON(3)) { ret_stepB(p); fox_phase(p, lds); }
  PH_SYNC(3)
  if (PH_ON(4)) ret_stepC(p, lds);
  PH_SYNC(4)
  if (PH_ON(5)) gemm_outproj(p, 0, lds);
  PH_SYNC(5)
  if (PH_ON(7)) gemm_inproj(p, 1, lds, 0);
  PH_SYNC(7)
  if (PH_ON(8)) { gemm_cmp1(p, lds); gemm_inproj(p, 1, lds, 1); nsa_knorm(p); }
  PH_SYNC(8)
  if (PH_ON(10)) nsa_phase(p, lds);
  PH_SYNC(10)
  if (PH_ON(11)) gemm_outproj(p, 1, lds);
  PH_SYNC(11)
  if (PH_ON(12)) final_norm(p);
}

extern "C" void kernel_launch(void* const* d_in, const int* in_sizes, int n_in, void* d_out, int out_size, void* d_ws,
                              size_t ws_size, hipStream_t stream) {
  static int grid_blocks = 0;
  if (!grid_blocks) {
    int dev = 0, cus = 0, per_cu = 0;
    hipGetDevice(&dev);
    hipDeviceGetAttribute(&cus, hipDeviceAttributeMultiprocessorCount, dev);
    hipFuncSetAttribute((const void*)mega, hipFuncAttributeMaxDynamicSharedMemorySize, LDS_BYTES);
    hipOccupancyMaxActiveBlocksPerMultiprocessor(&per_cu, (const void*)mega, NTHR, LDS_BYTES);
    if (per_cu < 1) per_cu = 1;
    if (per_cu > 1) per_cu = 1;
    grid_blocks = cus * per_cu;
    (void)hipGetLastError();
  }
  Params p{};
  p.x = (const float*)d_in[0]; p.e_ng = (const float*)d_in[1]; p.e_win = (const float*)d_in[2];
  p.e_bf = (const float*)d_in[3]; p.e_gn = (const float*)d_in[4]; p.e_wout = (const float*)d_in[5];
  p.o_ng = (const float*)d_in[6]; p.o_win = (const float*)d_in[7]; p.o_bg = (const float*)d_in[8];
  p.o_pek = (const float*)d_in[9]; p.o_pev = (const float*)d_in[10]; p.o_wk1 = (const float*)d_in[11];
  p.o_wk2 = (const float*)d_in[12]; p.o_wv1 = (const float*)d_in[13]; p.o_wv2 = (const float*)d_in[14];
  p.o_wout = (const float*)d_in[15]; p.fin_g = (const float*)d_in[16];
  p.out = (float*)d_out; p.ws = (unsigned char*)d_ws;
#if ONE_LAUNCH
  p.ph_lo = 0; p.ph_hi = NPHASE - 1; p.coop = 1;
  (void)hipMemsetAsync((unsigned char*)d_ws + WS_BAR, 0, 16384, stream);
  void* args[] = {&p};
  hipError_t e = hipLaunchCooperativeKernel((const void*)mega, dim3(grid_blocks), dim3(NTHR), args, LDS_BYTES, stream);
  if (e != hipSuccess) fprintf(stderr, "cooperative launch failed: %s (grid %d)\n", hipGetErrorString(e), grid_blocks);
#else
  for (int ph = 0; ph < NPHASE; ++ph) {
    p.ph_lo = ph; p.ph_hi = ph; p.coop = 0;
    hipLaunchKernelGGL(mega, dim3(grid_blocks), dim3(NTHR), LDS_BYTES, stream, p);
  }
#endif
}
```

```cpp
#include <hip/hip_runtime.h>
#include <hip/hip_cooperative_groups.h>
#include <stdint.h>
#include <stdio.h>
namespace cg = cooperative_groups;

typedef unsigned short u16;
typedef short bf16x8 __attribute__((ext_vector_type(8)));
typedef short bf16x4 __attribute__((ext_vector_type(4)));
typedef float f32x4 __attribute__((ext_vector_type(4)));

#ifndef ONE_LAUNCH
#define ONE_LAUNCH 1
#endif

#define MTOK 32768
#define SEQ 8192
#define DM 1024
#define LDQ 3072
#define LOG2E 1.4426950408889634f
#define TS 72
#define IMPS 132
#define LDS_BYTES 147520
#define NTHR 512
#define NWAVE 8
#define NPHASE 13

#define MiB (1024ull * 1024ull)
#define WS_HBF   (0ull)
#define WS_DS    (0ull)
#define WS_ST    (32ull * MiB)
#define WS_QK    (64ull * MiB)
#define WS_VT    (256ull * MiB)
#define WS_Y     (352ull * MiB)
#define WS_WT0   (416ull * MiB)
#define WS_WT1   (WS_WT0 + 4352ull * 1024 * 2)
#define WS_WO0   (WS_WT1 + 3840ull * 1024 * 2)
#define WS_WO1   (WS_WO0 + 1024ull * 1024 * 2)
#define WS_W1K   (WS_WO1 + 1024ull * 1024 * 2)
#define WS_W1V   (WS_W1K + 256ull * 2048 * 2)
#define WS_W2K   (WS_W1V + 256ull * 2048 * 2)
#define WS_W2V   (WS_W2K + 256ull * 256 * 2)
#define WS_FLOG  (440ull * MiB)
#define WS_CFOX  (441ull * MiB)
#define WS_GL    (442ull * MiB)
#define WS_HC    (448ull * MiB)
#define WS_KCMP  (456ull * MiB)
#define WS_VCMPT (457ull * MiB)
#define WS_PEP   (458ull * MiB)
#define WS_PEB   (WS_PEP + 65536ull)
#define WS_KMAX  (WS_PEB + 4096ull)
#define WS_SSQ   (459ull * MiB)
#define WS_BAR   (460ull * MiB)

struct Params {
  const float *x, *e_ng, *e_win, *e_bf, *e_gn, *e_wout;
  const float *o_ng, *o_win, *o_bg, *o_pek, *o_pev, *o_wk1, *o_wk2, *o_wv1, *o_wv2, *o_wout, *fin_g;
  float* out;
  unsigned char* ws;
  int ph_lo, ph_hi, coop, pad;
};

typedef __bf16 bf16v2 __attribute__((ext_vector_type(2)));
typedef float f32v2 __attribute__((ext_vector_type(2)));
__device__ __forceinline__ uint32_t pack2(float a, float b) {
  f32v2 v = {a, b};
  bf16v2 r = __builtin_convertvector(v, bf16v2);
  return *(uint32_t*)&r;
}
__device__ __forceinline__ u16 f2bf(float f) { return (u16)(pack2(f, 0.f) & 0xffffu); }
__device__ __forceinline__ float bf2f(u16 h) { return __uint_as_float(((uint32_t)h) << 16); }
__device__ __forceinline__ float ex2(float x) { return __builtin_amdgcn_exp2f(x); }
__device__ __forceinline__ float silu_f(float z) { return z * __builtin_amdgcn_rcpf(1.f + ex2(-z * LOG2E)); }
__device__ __forceinline__ float sigmoid_f(float z) { return __builtin_amdgcn_rcpf(1.f + ex2(-z * LOG2E)); }

__device__ __forceinline__ int opq(int v) { asm volatile("" : "+v"(v)); return v; }
__device__ __forceinline__ int opqs(int v) { asm volatile("" : "+s"(v)); return v; }
#define TIDX opq(p.pad * 64 + (int)__lane_id())
#define BIDX opqs((int)blockIdx.x)
#define MFMA(a, b, c) __builtin_amdgcn_mfma_f32_16x16x32_bf16((a), (b), (c), 0, 0, 0)

__device__ __forceinline__ void rms_rows(const Params& p, const float* __restrict__ x, const float* __restrict__ g, u16* __restrict__ h) {
  const int lane = TIDX & 63, wave = TIDX >> 6;
  for (int row = BIDX * NWAVE + wave; row < MTOK; row += gridDim.x * NWAVE) {
    const float4* xr = (const float4*)(x + (size_t)row * DM);
    float4 v[4];
    float ss = 0.f;
#pragma unroll
    for (int i = 0; i < 4; ++i) {
      v[i] = xr[lane + 64 * i];
      ss += v[i].x * v[i].x + v[i].y * v[i].y + v[i].z * v[i].z + v[i].w * v[i].w;
    }
#pragma unroll
    for (int o = 32; o >= 1; o >>= 1) ss += __shfl_xor(ss, o);
    const float rstd = rsqrtf(ss * (1.f / DM) + 1e-6f);
#pragma unroll
    for (int i = 0; i < 4; ++i) {
      float4 gg = ((const float4*)g)[lane + 64 * i];
      uint2 o;
      o.x = pack2(v[i].x * rstd * gg.x, v[i].y * rstd * gg.y);
      o.y = pack2(v[i].z * rstd * gg.z, v[i].w * rstd * gg.w);
      *(uint2*)(h + (size_t)row * DM + (lane + 64 * i) * 4) = o;
    }
  }
}

__device__ __forceinline__ void rms_rows_fl(const Params& p, float* ldsf) {
  const float* __restrict__ x = p.x; const float* __restrict__ g = p.e_ng;
  u16* __restrict__ h = (u16*)(p.ws + WS_HBF);
  float* __restrict__ fl = (float*)(p.ws + WS_FLOG);
  const int tid = TIDX, lane = tid & 63, wave = tid >> 6;
  for (int i = tid; i < 8 * DM; i += NTHR) { const int j = i >> 10, k = i & 1023; ldsf[i] = g[k] * p.e_win[(size_t)k * 4104 + 1536 + j]; }
  __syncthreads();
  for (int row = BIDX * NWAVE + wave; row < MTOK; row += gridDim.x * NWAVE) {
    const float4* xr = (const float4*)(x + (size_t)row * DM);
    float4 v[4];
    float ss = 0.f;
#pragma unroll
    for (int i = 0; i < 4; ++i) {
      v[i] = xr[lane + 64 * i];
      ss += v[i].x * v[i].x + v[i].y * v[i].y + v[i].z * v[i].z + v[i].w * v[i].w;
    }
#pragma unroll
    for (int o = 32; o >= 1; o >>= 1) ss += __shfl_xor(ss, o);
    const float rstd = rsqrtf(ss * (1.f / DM) + 1e-6f);
#pragma unroll
    for (int i = 0; i < 4; ++i) {
      float4 gg = ((const float4*)g)[lane + 64 * i];
      uint2 o;
      o.x = pack2(v[i].x * rstd * gg.x, v[i].y * rstd * gg.y);
      o.y = pack2(v[i].z * rstd * gg.z, v[i].w * rstd * gg.w);
      *(uint2*)(h + (size_t)row * DM + (lane + 64 * i) * 4) = o;
    }
    float myf = 0.f;
#pragma unroll
    for (int j = 0; j < 8; ++j) {
      float d = 0.f;
#pragma unroll
      for (int i = 0; i < 4; ++i) {
        const float4 w4 = *(const float4*)(ldsf + j * DM + (lane + 64 * i) * 4);
        d += v[i].x * w4.x + v[i].y * w4.y + v[i].z * w4.z + v[i].w * w4.w;
      }
#pragma unroll
      for (int o = 32; o >= 1; o >>= 1) d += __shfl_xor(d, o);
      if (lane == j) myf = d * rstd;
    }
    if (lane < 8) fl[(size_t)row * 8 + lane] = myf;
  }
}

__device__ __forceinline__ int map_col(int MAP, int n) {
  if (MAP == 0) {
    if (n < 1024) return n;
    if (n < 2048) return n + 520;
    if (n < 3072) return n + 1032;
    if (n < 3584) return n - 2048;
    if (n < 4096) return n - 1016;
    if (n < 4104) return n - 2560;
    return -1;
  } else if (MAP == 1) {
    if (n < 1792) return n;
    if (n < 2048) return n + 256;
    if (n < 3072) return n + 560;
    if (n < 3328) return n - 1280;
    if (n < 3584) return n - 1024;
    if (n < 3632) return n - 1024;
    return -1;
  } else if (MAP == 2) {
    return n;
  }
  return n;
}

__device__ __forceinline__ void conv_t(const Params& p, u16* __restrict__ dst, const float* __restrict__ src, int K, int nsrc, int ndst, int MAP) {
  const int total = ndst * (K >> 3);
  for (int id = BIDX * NTHR + TIDX; id < total; id += gridDim.x * NTHR) {
    const int n = id % ndst, kc = id / ndst;
    const int sc = map_col(MAP, n);
    const bool okc = (sc >= 0 && sc < nsrc);
    const int scc = okc ? sc : 0;
    float v[8];
#pragma unroll
    for (int i = 0; i < 8; ++i) v[i] = src[(size_t)(kc * 8 + i) * nsrc + scc];
#pragma unroll
    for (int i = 0; i < 8; ++i) v[i] = okc ? v[i] : 0.f;
    uint4 o;
    o.x = pack2(v[0], v[1]); o.y = pack2(v[2], v[3]); o.z = pack2(v[4], v[5]); o.w = pack2(v[6], v[7]);
    *(uint4*)(dst + (size_t)n * K + kc * 8) = o;
  }
}

__device__ __forceinline__ void pe_partial(const Params& p) {
  float* part = (float*)(p.ws + WS_PEP);
  for (int task = BIDX; task < 32; task += gridDim.x) {
    const int kv = task >> 4, kc = task & 15, n = TIDX;
    if (n >= 256) continue;
    const float* pe = kv ? p.o_pev : p.o_pek;
    const float* w1 = kv ? p.o_wv1 : p.o_wk1;
    float acc = 0.f;
#pragma unroll 16
    for (int k = kc * 128; k < kc * 128 + 128; ++k) acc += pe[k] * w1[(size_t)k * 256 + n];
    part[(kv * 16 + kc) * 256 + n] = acc;
  }
}

#define GST (512 * TS)
template <bool swapped>
__device__ __forceinline__ void gemm_compute(const u16* cur, f32x4 (&acc)[8][4], int wpa, int wpb, int l16, int gk) {
  const u16* sA = cur + (wpa * 128 + l16) * TS + gk * 8;
  const u16* sB = cur + (256 + wpb * 64 + l16) * TS + gk * 8;
#pragma unroll 1
  for (int kk = 0; kk < 2; ++kk) {
    bf16x8 fa[8], fb[4];
#pragma unroll
    for (int i = 0; i < 8; ++i) fa[i] = *(const bf16x8*)(sA + i * 16 * TS + kk * 32);
#pragma unroll
    for (int j = 0; j < 4; ++j) fb[j] = *(const bf16x8*)(sB + j * 16 * TS + kk * 32);
    if (swapped) {
#pragma unroll
      for (int i = 0; i < 8; ++i)
#pragma unroll
        for (int j = 0; j < 4; ++j) acc[i][j] = MFMA(fb[j], fa[i], acc[i][j]);
    } else {
#pragma unroll
      for (int i = 0; i < 8; ++i)
#pragma unroll
        for (int j = 0; j < 4; ++j) acc[i][j] = MFMA(fa[i], fb[j], acc[i][j]);
    }
  }
}
template <bool swapped>
__device__ __forceinline__ void gemm_mainloop(const Params& p, const u16* __restrict__ Ab, const uint32_t (&pa)[4], const u16* __restrict__ Bb,
                                              const uint32_t (&pb)[4], int a_kstride, int nk,
                                              u16* lds, f32x4 (&acc)[8][4],
                                              bool primed = false, const u16* __restrict__ Abn = nullptr, const u16* __restrict__ Bbn = nullptr) {
  const int tid = TIDX, lane = tid & 63, wave = tid >> 6;
  const int l16 = lane & 15, gk = lane >> 4;
  const int wpa = wave >> 2, wpb = wave & 3;
  const int woff = (tid >> 3) * TS + (tid & 7) * 8;
  uint4 ra0, ra1, ra2, ra3, rb0, rb1, rb2, rb3;
#define G_LD(kidx) { const u16* Ap_ = Ab + (size_t)(kidx) * a_kstride; const u16* Bp_ = Bb + (size_t)(kidx) * 64;   \
    ra0 = *(const uint4*)(Ap_ + pa[0]); ra1 = *(const uint4*)(Ap_ + pa[1]); ra2 = *(const uint4*)(Ap_ + pa[2]); ra3 = *(const uint4*)(Ap_ + pa[3]); \
    rb0 = *(const uint4*)(Bp_ + pb[0]); rb1 = *(const uint4*)(Bp_ + pb[1]); rb2 = *(const uint4*)(Bp_ + pb[2]); rb3 = *(const uint4*)(Bp_ + pb[3]); }
#define G_ST(D) { u16* D_ = (D) + woff;                                                                               \
    *(uint4*)(D_) = ra0; *(uint4*)(D_ + 64 * TS) = ra1; *(uint4*)(D_ + 128 * TS) = ra2; *(uint4*)(D_ + 192 * TS) = ra3;  \
    *(uint4*)(D_ + 256 * TS) = rb0; *(uint4*)(D_ + 320 * TS) = rb1; *(uint4*)(D_ + 384 * TS) = rb2; *(uint4*)(D_ + 448 * TS) = rb3; }
  if (!primed) {
    G_LD(0)
    __syncthreads();
    G_ST(lds)
    __syncthreads();
  }
#pragma unroll
  for (int i = 0; i < 8; ++i)
#pragma unroll
    for (int j = 0; j < 4; ++j) acc[i][j] = (f32x4){0.f, 0.f, 0.f, 0.f};
#pragma unroll 1
  for (int ks = 0; ks < nk; ++ks) {
    const bool last = (ks + 1 == nk);
    const bool more = !last || (Abn != nullptr);
    if (more) {
      if (!last) G_LD(ks + 1)
      else { const u16* Ab = Abn; const u16* Bb = Bbn; G_LD(0) }
    }
    gemm_compute<swapped>(lds + (ks & 1) * GST, acc, wpa, wpb, l16, gk);
    if (more) G_ST(lds + ((ks + 1) & 1) * GST)
    __syncthreads();
  }
#undef G_LD
#undef G_ST
}
#define GEMM_OFFS(rowstrideA, rowstrideB)                                   \
  uint32_t pa[4], pb[4];                                                    \
  _Pragma("unroll") for (int i = 0; i < 4; ++i) {                           \
    pa[i] = (uint32_t)((tid >> 3) + 64 * i) * (rowstrideA) + (tid & 7) * 8; \
    pb[i] = (uint32_t)((tid >> 3) + 64 * i) * (rowstrideB) + (tid & 7) * 8; \
  }

__device__ __forceinline__ void gemm_inproj(const Params& p, int layer, u16* lds, int part) {
  const u16* A = (const u16*)(p.ws + WS_HBF);
  const u16* Bt = (const u16*)(p.ws + (layer ? WS_WT1 : WS_WT0));
  u16* QK = (u16*)(p.ws + WS_QK);
  u16* VT = (u16*)(p.ws + WS_VT);
  float* F = (float*)(p.ws + (layer ? WS_GL : WS_FLOG));
  const int NT = layer ? 14 : 16;
  const int seg_trans_end = layer ? 28 : 32;
  const int nvalidF = layer ? 48 : 8, ldf = layer ? 48 : 8;
  const int tid = TIDX, lane = tid & 63, wave = tid >> 6, l16 = lane & 15, gk = lane >> 4;
  const int wpa = wave >> 2, wpb = wave & 3;
  const int bid = BIDX;
  int xcd = bid & 7, nloc = (int)gridDim.x >> 3, lrank = bid >> 3;
  { const uint4 cw = *(const uint4*)((const unsigned char*)lds + 147456);
    const int c0 = __builtin_amdgcn_readfirstlane((int)cw.x), c1 = __builtin_amdgcn_readfirstlane((int)cw.y);
    const int c2 = __builtin_amdgcn_readfirstlane((int)cw.z), c3 = __builtin_amdgcn_readfirstlane((int)cw.w);
    if (c1 == 8 && c0 * 8 == (int)gridDim.x) { xcd = c3; lrank = c2; } }
  const int qbeg = part ? bid - 64 : lrank, qend = part ? (bid >= 64 ? 128 : -(1 << 20)) : 16 * NT, qstep = part ? (int)gridDim.x - 64 : nloc;
  bool primed = false;
  for (int q = qbeg; q < qend; q += qstep) {
    const int mt = part ? q : xcd * 16 + q / NT, nt = part ? NT : q % NT;
    const int m0 = mt * 256, n0 = nt * 256;
    const int qn = q + qstep;
    const bool has_next = (part == 0) && (qn < qend);
    const u16* Abn = has_next ? A + (size_t)((xcd * 16 + qn / NT) * 256) * DM : nullptr;
    const u16* Bbn = has_next ? Bt + (size_t)((qn % NT) * 256) * DM : nullptr;
    const int mw = m0 + wpa * 128, nw = n0 + wpb * 64;
    const int seg = nw >> 7;
    int mode;
    if (seg < 24) mode = (layer == 0 && seg >= 12 && seg < 16) ? 2 : 0;
    else if (seg < seg_trans_end) mode = 1;
    else if (seg == seg_trans_end) mode = 3;
    else mode = 4;
    const int seg0 = nt * 2;
    const bool swapped = !((seg0 >= 24 && seg0 < seg_trans_end) || (layer == 0 && seg0 >= 12 && seg0 < 16));
    GEMM_OFFS(DM, DM)
    f32x4 acc[8][4];
    if (swapped) gemm_mainloop<true>(p, A + (size_t)m0 * DM, pa, Bt + (size_t)n0 * DM, pb, 64, 16, lds, acc, primed, Abn, Bbn);
    else gemm_mainloop<false>(p, A + (size_t)m0 * DM, pa, Bt + (size_t)n0 * DM, pb, 64, 16, lds, acc, primed, Abn, Bbn);
    primed = has_next;
    const float* ssq_g = (const float*)(p.ws + WS_SSQ);
    const bool tile_normal = (nt < 12) && !(layer == 0 && nt >= 6 && nt < 8);
    if (tile_normal) {
      u16* stg = lds + GST;
      const int ES = 264;
#pragma unroll 1
      for (int half = 0; half < 2; ++half) {
        __syncthreads();
        if (wpa == half) {
#pragma unroll
          for (int i = 0; i < 8; ++i) {
            const float rs = layer ? rsqrtf(ssq_g[mw + i * 16 + l16] * (1.f / DM) + 1e-6f) : 1.f;
#pragma unroll
            for (int j = 0; j < 4; ++j) {
              uint2 o; o.x = pack2(acc[i][j][0] * rs, acc[i][j][1] * rs); o.y = pack2(acc[i][j][2] * rs, acc[i][j][3] * rs);
              *(uint2*)(stg + (i * 16 + l16) * ES + wpb * 64 + j * 16 + gk * 4) = o;
            }
          }
        }
        __syncthreads();
#pragma unroll
        for (int c = 0; c < 8; ++c) {
          const int idx = tid + NTHR * c, row = idx >> 5, ch = idx & 31;
          const uint4 v = *(const uint4*)(stg + row * ES + ch * 8);
          *(uint4*)(QK + (size_t)(m0 + half * 128 + row) * LDQ + n0 + ch * 8) = v;
        }
      }
      __syncthreads();
    } else if (mode == 0 || mode == 3) {
#pragma unroll
      for (int i = 0; i < 8; ++i) {
        const int m = mw + i * 16 + l16;
        const float rs = layer ? rsqrtf(ssq_g[m] * (1.f / DM) + 1e-6f) : 1.f;
#pragma unroll
        for (int j = 0; j < 4; ++j) {
          const int n = nw + j * 16 + gk * 4;
          const float a0 = acc[i][j][0] * rs, a1 = acc[i][j][1] * rs, a2 = acc[i][j][2] * rs, a3 = acc[i][j][3] * rs;
          if (mode == 0) {
            uint2 o; o.x = pack2(a0, a1); o.y = pack2(a2, a3);
            *(uint2*)(QK + (size_t)m * LDQ + n) = o;
          } else {
            const int nn = n - seg * 128;
            if (nn < nvalidF) *(float4*)(F + (size_t)m * ldf + nn) = (float4){a0, a1, a2, a3};
          }
        }
      }
    } else if (mode == 1 || mode == 2) {
#pragma unroll
      for (int i = 0; i < 8; ++i) {
        const int m = mw + i * 16 + gk * 4;
        float rs0 = 1.f, rs1 = 1.f, rs2 = 1.f, rs3 = 1.f;
        if (layer) {
          const float4 q4 = *(const float4*)(ssq_g + m);
          rs0 = rsqrtf(q4.x * (1.f / DM) + 1e-6f); rs1 = rsqrtf(q4.y * (1.f / DM) + 1e-6f);
          rs2 = rsqrtf(q4.z * (1.f / DM) + 1e-6f); rs3 = rsqrtf(q4.w * (1.f / DM) + 1e-6f);
        }
#pragma unroll
        for (int j = 0; j < 4; ++j) {
          const int n = nw + j * 16 + l16;
          const float a0 = acc[i][j][0] * rs0, a1 = acc[i][j][1] * rs1, a2 = acc[i][j][2] * rs2, a3 = acc[i][j][3] * rs3;
          if (mode == 1) {
            const int trow = n - 3072;
            uint2 o; o.x = pack2(a0, a1); o.y = pack2(a2, a3);
            *(uint2*)(VT + (size_t)trow * MTOK + m) = o;
          } else {
            const int trow = n - 512;
            const int h = (nw - 1536) >> 6;
            const float lg2 = log1pf(-exp2f(-5.f - (float)h)) * LOG2E;
            const float lane_dec = 0.125f * ex2(lg2 * (float)(127 - gk * 4));
            QK[(size_t)(m + 0) * LDQ + n] = f2bf(a0); QK[(size_t)(m + 1) * LDQ + n] = f2bf(a1);
            QK[(size_t)(m + 2) * LDQ + n] = f2bf(a2); QK[(size_t)(m + 3) * LDQ + n] = f2bf(a3);
            const float s0 = a0 * lane_dec * ex2(lg2 * (float)(-(i * 16 + 0))), s1 = a1 * lane_dec * ex2(lg2 * (float)(-(i * 16 + 1)));
            const float s2 = a2 * lane_dec * ex2(lg2 * (float)(-(i * 16 + 2))), s3 = a3 * lane_dec * ex2(lg2 * (float)(-(i * 16 + 3)));
            uint2 o; o.x = pack2(s0, s1); o.y = pack2(s2, s3);
            *(uint2*)(VT + (size_t)trow * MTOK + m) = o;
          }
        }
      }
    }
  }
}

__device__ __forceinline__ void gemm_outproj(const Params& p, int layer, u16* lds) {
  const u16* A = (const u16*)(p.ws + WS_Y);
  const u16* Bt = (const u16*)(p.ws + (layer ? WS_WO1 : WS_WO0));
  const float* res = layer ? p.out : p.x;
  float* out = p.out;
  u16* hb_out = (u16*)(p.ws + WS_HBF);
  float* ssq_g = (float*)(p.ws + WS_SSQ);
  const int tid = TIDX, lane = tid & 63, wave = tid >> 6, l16 = lane & 15, gk = lane >> 4;
  const int wpa = wave >> 2, wpb = wave & 3;
  const int bid = BIDX;
  int xcd = bid & 7, nloc = (int)gridDim.x >> 3, lrank = bid >> 3;
  { const uint4 cw = *(const uint4*)((const unsigned char*)lds + 147456);
    const int c0 = __builtin_amdgcn_readfirstlane((int)cw.x), c1 = __builtin_amdgcn_readfirstlane((int)cw.y);
    const int c2 = __builtin_amdgcn_readfirstlane((int)cw.z), c3 = __builtin_amdgcn_readfirstlane((int)cw.w);
    if (c1 == 8 && c0 * 8 == (int)gridDim.x) { xcd = c3; lrank = c2; } }
  bool primed = false;
  for (int q = lrank; q < 16 * 4; q += nloc) {
    const int mt = xcd * 16 + (q >> 2), nt = q & 3;
    const int m0 = mt * 256, n0 = nt * 256;
    const int qn = q + nloc;
    const bool has_next = qn < 16 * 4;
    const u16* Abn = has_next ? A + (size_t)((xcd * 16 + (qn >> 2)) * 256) * DM : nullptr;
    const u16* Bbn = has_next ? Bt + (size_t)((qn & 3) * 256) * DM : nullptr;
    GEMM_OFFS(DM, DM)
    f32x4 acc[8][4];
    gemm_mainloop<true>(p, A + (size_t)m0 * DM, pa, Bt + (size_t)n0 * DM, pb, 64, 16, lds, acc, primed, Abn, Bbn);
    primed = has_next;
    const int tid2 = TIDX, lane2 = tid2 & 63, wave2 = tid2 >> 6, l16b = lane2 & 15, gkb = lane2 >> 4;
    const int mw = m0 + (wave2 >> 2) * 128, nw = n0 + (wave2 & 3) * 64;
#pragma unroll
    for (int i = 0; i < 8; ++i) {
      const int m = mw + i * 16 + l16b;
      float sq = 0.f;
#pragma unroll
      for (int j = 0; j < 4; ++j) {
        const int n = nw + j * 16 + gkb * 4;
        const float4 r = *(const float4*)(res + (size_t)m * DM + n);
        const float4 v = (float4){r.x + acc[i][j][0], r.y + acc[i][j][1], r.z + acc[i][j][2], r.w + acc[i][j][3]};
        *(float4*)(out + (size_t)m * DM + n) = v;
        if (layer == 0) {
          const float4 gg = *(const float4*)(p.o_ng + n);
          uint2 hb; hb.x = pack2(v.x * gg.x, v.y * gg.y); hb.y = pack2(v.z * gg.z, v.w * gg.w);
          *(uint2*)(hb_out + (size_t)m * DM + n) = hb;
          sq += v.x * v.x + v.y * v.y + v.z * v.z + v.w * v.w;
        }
      }
      if (layer == 0) {
        sq += __shfl_xor(sq, 16); sq += __shfl_xor(sq, 32);
        if (gkb == 0) atomicAdd(ssq_g + m, sq);
      }
    }
  }
}

__device__ __forceinline__ void gemm_cmp2_tile(const Params& p, u16* lds, int kv, int mt) {
  const int tid = TIDX, lane = tid & 63, wave = tid >> 6, l16 = lane & 15, gk = lane >> 4;
  const int wpa = wave >> 2, wpb = wave & 3;
  {
    const int m0 = mt * 256;
    const u16* A = (const u16*)(p.ws + WS_HC) + (size_t)kv * 8192 * 256;
    const u16* Bt = (const u16*)(p.ws + (kv ? WS_W2V : WS_W2K));
    GEMM_OFFS(256, 256)
    f32x4 acc[8][4];
    const bool swapped = (kv == 0);
    if (swapped) gemm_mainloop<true>(p, A + (size_t)m0 * 256, pa, Bt, pb, 64, 4, lds, acc);
    else gemm_mainloop<false>(p, A + (size_t)m0 * 256, pa, Bt, pb, 64, 4, lds, acc);
    const int mw = m0 + wpa * 128, nw = wpb * 64;
    if (swapped) {
      u16* kc_ = (u16*)(p.ws + WS_KCMP);
#pragma unroll
      for (int i = 0; i < 8; ++i)
#pragma unroll
        for (int j = 0; j < 4; ++j) {
          const int n = nw + j * 16 + gk * 4;
          const int m = mw + i * 16 + l16;
          if (n < 64) {
            uint2 o; o.x = pack2(acc[i][j][0], acc[i][j][1]); o.y = pack2(acc[i][j][2], acc[i][j][3]);
            *(uint2*)(kc_ + (size_t)m * 64 + n) = o;
          }
        }
      if (wpb == 0) {
        float mxn = 0.f;
#pragma unroll
        for (int i = 0; i < 8; ++i) {
          float ss = 0.f;
#pragma unroll
          for (int j = 0; j < 4; ++j) ss += acc[i][j][0] * acc[i][j][0] + acc[i][j][1] * acc[i][j][1] + acc[i][j][2] * acc[i][j][2] + acc[i][j][3] * acc[i][j][3];
          ss += __shfl_xor(ss, 16); ss += __shfl_xor(ss, 32);
          mxn = fmaxf(mxn, ss);
        }
#pragma unroll
        for (int o2 = 1; o2 <= 8; o2 <<= 1) mxn = fmaxf(mxn, __shfl_xor(mxn, o2));
        if (lane == 0) atomicMax((uint32_t*)(p.ws + WS_KMAX) + 16 + ((mw >> 9) & 3), __float_as_uint(mxn));
      }
    } else {
      u16* vt = (u16*)(p.ws + WS_VCMPT);
#pragma unroll
      for (int i = 0; i < 8; ++i)
#pragma unroll
        for (int j = 0; j < 4; ++j) {
          const int m = mw + i * 16 + gk * 4;
          const int n = nw + j * 16 + l16;
          if (n < 64) {
            uint2 o; o.x = pack2(acc[i][j][0], acc[i][j][1]); o.y = pack2(acc[i][j][2], acc[i][j][3]);
            *(uint2*)(vt + (size_t)(m >> 9) * 32768 + (size_t)n * 512 + (m & 511)) = o;
          }
        }
    }
  }
}

__device__ __forceinline__ void gemm_cmp1(const Params& p, u16* lds) {
  const u16* U = (const u16*)(p.ws + WS_QK);
  const float* peb = (const float*)(p.ws + WS_PEB);
  const int tid = TIDX, lane = tid & 63, wave = tid >> 6, l16 = lane & 15, gk = lane >> 4;
  const int wpa = wave >> 2, wpb = wave & 3;
  for (int tile = BIDX; tile < 64; tile += gridDim.x) {
    const int kv = tile >> 5, mt = tile & 31;
    const int m0 = mt * 256;
    const u16* Bt = (const u16*)(p.ws + (kv ? WS_W1V : WS_W1K));
    u16* Hc = (u16*)(p.ws + WS_HC) + (size_t)kv * 8192 * 256;
    uint32_t pa[4], pb[4];
#pragma unroll
    for (int i = 0; i < 4; ++i) {
      const int row = (tid >> 3) + 64 * i, kc = tid & 7;
      const int r = m0 + row, bg = r >> 9, cc = r & 511, b = bg >> 2, g = bg & 3;
      int tok0 = cc * 16; if (tok0 > SEQ - 32) tok0 = SEQ - 32;
      pa[i] = (uint32_t)(b * SEQ + tok0) * LDQ + 1024 + kv * 256 + g * 64 + kc * 8;
      pb[i] = (uint32_t)row * 2048 + kc * 8;
    }
    f32x4 acc[8][4];
    gemm_mainloop<true>(p, U, pa, Bt, pb, LDQ, 32, lds, acc);
    const int tid2 = TIDX, lane2 = tid2 & 63, wave2 = tid2 >> 6;
    const int mw = m0 + (wave2 >> 2) * 128, nw = (wave2 & 3) * 64;
#pragma unroll
    for (int i = 0; i < 8; ++i)
#pragma unroll
      for (int j = 0; j < 4; ++j) {
        const int n = nw + j * 16 + (lane2 >> 4) * 4;
        const int m = mw + i * 16 + (lane2 & 15);
        const float4 bb = *(const float4*)(peb + kv * 256 + n);
        float v0 = silu_f(acc[i][j][0] + bb.x), v1 = silu_f(acc[i][j][1] + bb.y);
        float v2 = silu_f(acc[i][j][2] + bb.z), v3 = silu_f(acc[i][j][3] + bb.w);
        if ((m & 511) == 511) { v0 = v1 = v2 = v3 = 0.f; }
        uint2 o; o.x = pack2(v0, v1); o.y = pack2(v2, v3);
        *(uint2*)(Hc + (size_t)m * 256 + n) = o;
      }
    __threadfence_block();
    __syncthreads();
    gemm_cmp2_tile(p, lds, kv, mt);
  }
}

#define TILE_LD(R, src, stride) { R##0 = *(const uint4*)((src) + (long)(tid >> 3) * (stride) + (tid & 7) * 8); }
#define TILE_ST(dst, R) { *(uint4*)((dst) + (tid >> 3) * TS + (tid & 7) * 8) = R##0; }
#define VPOS(c) ((((c) >> 2) * 32) + ((2 * ((c) & 1)) * 8) + ((((c) & 3) >> 1) * 4))
#define TILE_STV_(dst, val) { const int c_ = tid & 7; u16* d_ = (dst) + (tid >> 3) * TS + VPOS(c_); \
    *(uint2*)(d_) = make_uint2((val).x, (val).y); *(uint2*)(d_ + 8) = make_uint2((val).z, (val).w); }
#define TILE_STV(dst, R) TILE_STV_(dst, R##0)
__device__ __forceinline__ void qk_tile(const u16* sK, const bf16x8 (&q)[2], f32x4 (&s)[4], int l16, int gk) {
#pragma unroll
  for (int kt = 0; kt < 4; ++kt) s[kt] = (f32x4){0.f, 0.f, 0.f, 0.f};
#pragma unroll
  for (int ks = 0; ks < 2; ++ks)
#pragma unroll
    for (int kt = 0; kt < 4; ++kt) {
      bf16x8 kf = *(const bf16x8*)(sK + (kt * 16 + l16) * TS + ks * 32 + gk * 8);
      s[kt] = MFMA(kf, q[ks], s[kt]);
    }
}
__device__ __forceinline__ void pv_tile(const u16* sV, const float (&pp)[4][4], f32x4 (&o)[4], int l16, int gk) {
  bf16x8 pf[2];
#pragma unroll
  for (int ks2 = 0; ks2 < 2; ++ks2) {
    uint4 t;
    t.x = pack2(pp[2 * ks2][0], pp[2 * ks2][1]); t.y = pack2(pp[2 * ks2][2], pp[2 * ks2][3]);
    t.z = pack2(pp[2 * ks2 + 1][0], pp[2 * ks2 + 1][1]); t.w = pack2(pp[2 * ks2 + 1][2], pp[2 * ks2 + 1][3]);
    pf[ks2] = *(bf16x8*)&t;
  }
#pragma unroll
  for (int dt = 0; dt < 4; ++dt)
#pragma unroll
    for (int ks2 = 0; ks2 < 2; ++ks2) {
      const bf16x8 vf = *(const bf16x8*)(sV + (dt * 16 + l16) * TS + ks2 * 32 + gk * 8);
      o[dt] = MFMA(vf, pf[ks2], o[dt]);
    }
}

__device__ __forceinline__ void fox_phase(const Params& p, u16* lds) {
  const u16* QK = (const u16*)(p.ws + WS_QK);
  const u16* VT = (const u16*)(p.ws + WS_VT);
  const float* cf = (const float*)(p.ws + WS_CFOX);
  u16* Y = (u16*)(p.ws + WS_Y);
  const int tid = TIDX, lane = tid & 63, w = tid >> 6, l16 = lane & 15, gk = lane >> 4;
  const float scale2 = 0.125f * LOG2E;
  for (int unit = BIDX; unit < 2048; unit += gridDim.x) {
    const int bh = unit & 31, qblk = 63 - (unit >> 5), b = bh >> 3, h = bh & 7;
    const int tq0 = qblk * 128 + w * 16;
    const int t = tq0 + l16;
    const float* cfr = cf + (size_t)bh * SEQ;
    bf16x8 q[2];
#pragma unroll
    for (int ks = 0; ks < 2; ++ks) q[ks] = *(const bf16x8*)(QK + (size_t)(b * SEQ + t) * LDQ + h * 64 + ks * 32 + gk * 8);
    const float cq2 = cfr[t] * LOG2E;
    f32x4 o[4];
    float m = -1e30f, l = 0.f;
#pragma unroll
    for (int dt = 0; dt < 4; ++dt) o[dt] = (f32x4){0.f, 0.f, 0.f, 0.f};
    const int ntiles = qblk * 2 + 2;
    const int iw = qblk * 2 + (w >> 2);
    const u16* ksrc = QK + (size_t)(b * SEQ) * LDQ + 512 + h * 64;
    const u16* vsrc = VT + (size_t)(h * 64) * MTOK + (size_t)b * SEQ;
    float qs = 0.f;
#pragma unroll
    for (int ks = 0; ks < 2; ++ks)
#pragma unroll
      for (int e = 0; e < 8; ++e) { const float v = bf2f((u16)q[ks][e]); qs += v * v; }
    qs += __shfl_xor(qs, 16); qs += __shfl_xor(qs, 32);
#pragma unroll
    for (int o2 = 1; o2 <= 8; o2 <<= 1) qs = fmaxf(qs, __shfl_xor(qs, o2));
    float* red = (float*)(lds + 256 * TS);
    if (lane == 0) red[w] = qs;
    __syncthreads();
    float qmax2 = red[0];
#pragma unroll
    for (int i = 1; i < NWAVE; ++i) qmax2 = fmaxf(qmax2, red[i]);
    const float kmax2 = __uint_as_float(((const uint32_t*)(p.ws + WS_KMAX))[h]);
    const float T2 = 2.f * scale2 * sqrtf(qmax2 * kmax2) * 1.001f + 48.f;
    const float cfirst2 = cfr[qblk * 128] * LOG2E;
    int i_lo = 0;
    for (int base = qblk * 2 - 1; base >= 0; base -= 64) {
      const int ti = base - lane;
      bool skip = false;
      if (ti >= 0) skip = (cfirst2 - cfr[ti * 64 + 63] * LOG2E) < -T2;
      const unsigned long long bal = __ballot(skip);
      if (bal) { i_lo = base - (int)__builtin_ctzll(bal) + 1; break; }
    }
    uint4 rk0, rv0;
    TILE_LD(rk, ksrc + (size_t)i_lo * 64 * LDQ, LDQ); TILE_LD(rv, vsrc + i_lo * 64, MTOK);
    TILE_ST(lds + (i_lo & 1) * (128 * TS), rk); TILE_STV(lds + (i_lo & 1) * (128 * TS) + 64 * TS, rv);
    __syncthreads();
    for (int i = i_lo; i < ntiles; ++i) {
      u16* cur = lds + (i & 1) * (128 * TS);
      const bool more = (i + 1 < ntiles);
      if (more) { TILE_LD(rk, ksrc + (size_t)(i + 1) * 64 * LDQ, LDQ); TILE_LD(rv, vsrc + (i + 1) * 64, MTOK); }
      if (i <= iw) {
        const int s0 = i * 64;
        const bool diag = (i == iw);
        f32x4 s[4];
        qk_tile(cur, q, s, l16, gk);
        float xv[4][4];
        float mx = -1e30f;
#pragma unroll
        for (int kt = 0; kt < 4; ++kt) {
          const float4 c4 = *(const float4*)(cfr + s0 + kt * 16 + gk * 4);
          const float ck[4] = {c4.x, c4.y, c4.z, c4.w};
#pragma unroll
          for (int r = 0; r < 4; ++r) {
            float v = fmaf(s[kt][r], scale2, cq2 - ck[r] * LOG2E);
            if (diag && (s0 + kt * 16 + gk * 4 + r > t)) v = -1e30f;
            xv[kt][r] = v; mx = fmaxf(mx, v);
          }
        }
        mx = fmaxf(mx, __shfl_xor(mx, 16)); mx = fmaxf(mx, __shfl_xor(mx, 32));
        const float mnew = fmaxf(m, mx);
        const float alpha = ex2(m - mnew);
        m = mnew;
        const float muse = fmaxf(mnew, -1e20f);
        float rs = 0.f;
#pragma unroll
        for (int kt = 0; kt < 4; ++kt)
#pragma unroll
          for (int r = 0; r < 4; ++r) { xv[kt][r] = ex2(xv[kt][r] - muse); rs += xv[kt][r]; }
        l = l * alpha + rs;
#pragma unroll
        for (int dt = 0; dt < 4; ++dt) o[dt] *= alpha;
        pv_tile(cur + 64 * TS, xv, o, l16, gk);
      }
      if (more) { u16* nxt = lds + ((i + 1) & 1) * (128 * TS); TILE_ST(nxt, rk); TILE_STV(nxt + 64 * TS, rv); }
      __syncthreads();
    }
    {
      float lt = l; lt += __shfl_xor(lt, 16); lt += __shfl_xor(lt, 32);
      const float inv = lt > 0.f ? 1.f / lt : 0.f;
      const size_t mrow = (size_t)(b * SEQ + t);
#pragma unroll
      for (int dt = 0; dt < 4; ++dt) {
        const int col = h * 64 + dt * 16 + gk * 4;
        const uint2 zz = *(const uint2*)(QK + mrow * LDQ + 2048 + col);
        const float z0 = bf2f(zz.x & 0xffff), z1 = bf2f(zz.x >> 16), z2 = bf2f(zz.y & 0xffff), z3 = bf2f(zz.y >> 16);
        uint2 ov;
        ov.x = pack2(o[dt][0] * inv * silu_f(z0), o[dt][1] * inv * silu_f(z1));
        ov.y = pack2(o[dt][2] * inv * silu_f(z2), o[dt][3] * inv * silu_f(z3));
        *(uint2*)(Y + mrow * DM + col) = ov;
      }
    }
  }
}

__device__ __forceinline__ void fox_knorm(const Params& p) {
  const u16* QK = (const u16*)(p.ws + WS_QK);
  uint32_t* km = (uint32_t*)(p.ws + WS_KMAX);
  const int tid = TIDX, lane = tid & 63, wave = tid >> 6;
  float mx = 0.f;
  for (int row = BIDX * NWAVE + wave; row < MTOK; row += gridDim.x * NWAVE) {
    const uint4 v = *(const uint4*)(QK + (size_t)row * LDQ + 512 + lane * 8);
    const float a0 = bf2f(v.x & 0xffff), a1 = bf2f(v.x >> 16), a2 = bf2f(v.y & 0xffff), a3 = bf2f(v.y >> 16);
    const float a4 = bf2f(v.z & 0xffff), a5 = bf2f(v.z >> 16), a6 = bf2f(v.w & 0xffff), a7 = bf2f(v.w >> 16);
    float ss = a0 * a0 + a1 * a1 + a2 * a2 + a3 * a3 + a4 * a4 + a5 * a5 + a6 * a6 + a7 * a7;
    ss += __shfl_xor(ss, 1); ss += __shfl_xor(ss, 2); ss += __shfl_xor(ss, 4);
    mx = fmaxf(mx, ss);
  }
  if ((lane & 7) == 0) atomicMax(&km[lane >> 3], __float_as_uint(mx));
}

__device__ __forceinline__ void fox_scan(const Params& p, float* ldsf) {
  const float* fl = (const float*)(p.ws + WS_FLOG);
  float* cf = (float*)(p.ws + WS_CFOX);
  double* sd = (double*)ldsf;
  const int tid = TIDX;
  for (int bh = BIDX; bh < 32; bh += gridDim.x) {
    const int b = bh >> 3, h = bh & 7;
    const float bf = p.e_bf[h];
    float ls[16];
    double sum = 0.0;
#pragma unroll
    for (int i = 0; i < 16; ++i) {
      const float xx = fl[(size_t)(b * SEQ + tid * 16 + i) * 8 + h] + bf;
      ls[i] = fminf(xx, 0.f) - log1pf(__expf(-fabsf(xx)));
      sum += (double)ls[i];
    }
    __syncthreads();
    sd[tid] = sum;
    __syncthreads();
    double pre = 0.0;
    for (int j = 0; j < tid; ++j) pre += sd[j];
#pragma unroll
    for (int i = 0; i < 16; ++i) { pre += (double)ls[i]; cf[(size_t)bh * SEQ + tid * 16 + i] = (float)pre; }
  }
}

__device__ __forceinline__ void ret_stepA(const Params& p) {
  const u16* VT = (const u16*)(p.ws + WS_VT);
  float* dS = (float*)(p.ws + WS_DS);
  const int tid_ = TIDX, lane = tid_ & 63, w8 = tid_ >> 6, w = w8 & 3, l16 = lane & 15, gk = lane >> 4;
  for (int u2 = BIDX; u2 < 1024; u2 += gridDim.x) {
    const int u = u2 * 2 + (w8 >> 2);
    const int bh = u >> 6, n = u & 63, b = bh >> 3, h = bh & 7;
    const size_t mcol = (size_t)b * SEQ + n * 128;
    f32x4 acc[4];
#pragma unroll
    for (int dt = 0; dt < 4; ++dt) acc[dt] = (f32x4){0.f, 0.f, 0.f, 0.f};
#pragma unroll
    for (int ks = 0; ks < 4; ++ks) {
      bf16x8 af = *(const bf16x8*)(VT + (size_t)(512 + h * 64 + w * 16 + l16) * MTOK + mcol + ks * 32 + gk * 8);
#pragma unroll
      for (int dt = 0; dt < 4; ++dt) {
        bf16x8 bfr = *(const bf16x8*)(VT + (size_t)(1024 + h * 64 + dt * 16 + l16) * MTOK + mcol + ks * 32 + gk * 8);
        acc[dt] = MFMA(af, bfr, acc[dt]);
      }
    }
#pragma unroll
    for (int dt = 0; dt < 4; ++dt)
#pragma unroll
      for (int r = 0; r < 4; ++r) dS[(size_t)u * 4096 + (w * 16 + gk * 4 + r) * 64 + dt * 16 + l16] = acc[dt][r];
  }
}
__device__ __forceinline__ void ret_stepB(const Params& p) {
  const float* dS = (const float*)(p.ws + WS_DS);
  u16* st = (u16*)(p.ws + WS_ST);
  for (int idx = BIDX * NTHR + TIDX; idx < 32 * 4096; idx += gridDim.x * NTHR) {
    const int bh = idx >> 12, ed = idx & 4095, h = bh & 7;
    const float cdec = __expf(log1pf(-exp2f(-5.f - (float)h)) * 128.f);
    float s = 0.f;
#pragma unroll 1
    for (int n0 = 0; n0 < 64; n0 += 16) {
      float d[16];
#pragma unroll
      for (int k = 0; k < 16; ++k) d[k] = dS[(size_t)(bh * 64 + n0 + k) * 4096 + ed];
#pragma unroll
      for (int k = 0; k < 16; ++k) {
        st[(size_t)(bh * 64 + n0 + k) * 4096 + ed] = f2bf(s);
        s = s * cdec + d[k];
      }
    }
  }
}
__device__ __forceinline__ void ret_stepC(const Params& p, u16* lds) {
  const u16* QK = (const u16*)(p.ws + WS_QK);
  const u16* VT = (const u16*)(p.ws + WS_VT);
  const u16* st = (const u16*)(p.ws + WS_ST);
  u16* Y = (u16*)(p.ws + WS_Y);
  const int tid = TIDX, lane = tid & 63, w = tid >> 6, l16 = lane & 15, gk = lane >> 4;
  for (int u = BIDX; u < 2048; u += gridDim.x) {
    const int bh = u >> 6, n = u & 63, b = bh >> 3, h = bh & 7;
    const size_t m0 = (size_t)b * SEQ + n * 128;
    const float lg2 = log1pf(-exp2f(-5.f - (float)h)) * LOG2E;
    __syncthreads();
    {
      uint4 r0;
      TILE_LD(r, QK + m0 * LDQ + 1536 + h * 64, LDQ); TILE_ST(lds, r);
      TILE_LD(r, VT + (size_t)(512 + h * 64) * MTOK + m0, MTOK); TILE_STV(lds + 64 * TS, r);
      TILE_LD(r, QK + (m0 + 64) * LDQ + 1536 + h * 64, LDQ); TILE_ST(lds + 128 * TS, r);
      TILE_LD(r, VT + (size_t)(512 + h * 64) * MTOK + m0 + 64, MTOK); TILE_STV(lds + 192 * TS, r);
      TILE_LD(r, st + (size_t)u * 4096, 64); TILE_ST(lds + 256 * TS, r);
    }
    __syncthreads();
    const int iq = 16 * w + l16;
    const size_t mrow = m0 + iq;
    bf16x8 q[2];
#pragma unroll
    for (int ks = 0; ks < 2; ++ks) q[ks] = *(const bf16x8*)(QK + mrow * LDQ + 1024 + h * 64 + ks * 32 + gk * 8);
    f32x4 o[4];
#pragma unroll
    for (int dt = 0; dt < 4; ++dt) o[dt] = (f32x4){0.f, 0.f, 0.f, 0.f};
#pragma unroll
    for (int dt = 0; dt < 4; ++dt)
#pragma unroll
      for (int ks = 0; ks < 2; ++ks) {
        bf16x8 sf = *(const bf16x8*)(lds + 256 * TS + (dt * 16 + l16) * TS + ks * 32 + gk * 8);
        o[dt] = MFMA(sf, q[ks], o[dt]);
      }
    const float cross = ex2(lg2 * (float)(iq + 1));
#pragma unroll
    for (int dt = 0; dt < 4; ++dt) o[dt] *= cross;
#pragma unroll
    for (int k64 = 0; k64 < 2; ++k64) {
      if (k64 * 64 <= 16 * w + 15) {
        f32x4 s[4];
        qk_tile(lds + k64 * 128 * TS, q, s, l16, gk);
        float pp[4][4];
#pragma unroll
        for (int kt = 0; kt < 4; ++kt)
#pragma unroll
          for (int r = 0; r < 4; ++r) {
            const int j = k64 * 64 + kt * 16 + gk * 4 + r;
            pp[kt][r] = (j <= iq) ? s[kt][r] * 0.125f * ex2(lg2 * (float)(iq - j)) : 0.f;
          }
        pv_tile(lds + k64 * 128 * TS + 64 * TS, pp, o, l16, gk);
      }
    }
    float sm = 0.f;
#pragma unroll
    for (int dt = 0; dt < 4; ++dt) sm += o[dt][0] + o[dt][1] + o[dt][2] + o[dt][3];
    sm += __shfl_xor(sm, 16); sm += __shfl_xor(sm, 32);
    const float mu = sm * (1.f / 64.f);
    float vs = 0.f;
#pragma unroll
    for (int dt = 0; dt < 4; ++dt)
#pragma unroll
      for (int r = 0; r < 4; ++r) { const float d = o[dt][r] - mu; vs += d * d; }
    vs += __shfl_xor(vs, 16); vs += __shfl_xor(vs, 32);
    const float rstd = rsqrtf(vs * (1.f / 64.f) + 1e-5f);
#pragma unroll
    for (int dt = 0; dt < 4; ++dt) {
      const int col = h * 64 + dt * 16 + gk * 4;
      const float4 gg = *(const float4*)(p.e_gn + col);
      const uint2 zz = *(const uint2*)(QK + mrow * LDQ + 2048 + 512 + col);
      const float z0 = bf2f(zz.x & 0xffff), z1 = bf2f(zz.x >> 16), z2 = bf2f(zz.y & 0xffff), z3 = bf2f(zz.y >> 16);
      uint2 ov;
      ov.x = pack2((o[dt][0] - mu) * rstd * gg.x * silu_f(z0), (o[dt][1] - mu) * rstd * gg.y * silu_f(z1));
      ov.y = pack2((o[dt][2] - mu) * rstd * gg.z * silu_f(z2), (o[dt][3] - mu) * rstd * gg.w * silu_f(z3));
      *(uint2*)(Y + mrow * DM + 512 + col) = ov;
    }
  }
}

__device__ __forceinline__ void nsa_tile_interior(const u16* sK, const u16* sV, const bf16x8 (&q)[2], f32x4 (&acc)[4],
                                                  float& m, float& l, float slope2, const float (&sk)[16],
                                                  int t, int pos0, bool lanesel, int lane, bool fixm) {
  const int l16 = lane & 15, gk = lane >> 4;
  const float scale2 = 0.125f * LOG2E;
  f32x4 s[4];
  qk_tile(sK, q, s, l16, gk);
  const float c0 = fmaf(-slope2, (float)(t - pos0 - gk * 4), lanesel ? 0.f : -1e30f);
  float xv[4][4];
  float mx = -1e30f;
#pragma unroll
  for (int kt = 0; kt < 4; ++kt)
#pragma unroll
    for (int r = 0; r < 4; ++r) { xv[kt][r] = fmaf(s[kt][r], scale2, sk[kt * 4 + r]); mx = fmaxf(mx, xv[kt][r]); }
  if (fixm) {
    const float offf = c0 - m;
    float rsf = 0.f;
#pragma unroll
    for (int kt = 0; kt < 4; ++kt)
#pragma unroll
      for (int r = 0; r < 4; ++r) { xv[kt][r] = ex2(xv[kt][r] + offf); rsf += xv[kt][r]; }
    l += rsf;
    pv_tile(sV, xv, acc, l16, gk);
    return;
  }
  mx += c0;
  mx = fmaxf(mx, __shfl_xor(mx, 16)); mx = fmaxf(mx, __shfl_xor(mx, 32));
  const float mnew = fmaxf(m, mx);
  const float alpha = ex2(m - mnew);
  m = mnew;
  const float off = c0 - fmaxf(mnew, -1e20f);
  float rs = 0.f;
#pragma unroll
  for (int kt = 0; kt < 4; ++kt)
#pragma unroll
    for (int r = 0; r < 4; ++r) { xv[kt][r] = ex2(xv[kt][r] + off); rs += xv[kt][r]; }
  l = l * alpha + rs;
  if (__any(alpha != 1.f)) {
#pragma unroll
    for (int dt = 0; dt < 4; ++dt) acc[dt] *= alpha;
  }
  pv_tile(sV, xv, acc, l16, gk);
}
template <int BR>
__device__ __forceinline__ void nsa_tile(const u16* sK, const u16* sV, const bf16x8 (&q)[2], f32x4 (&acc)[4],
                                         float& m, float& l, float slope2, float gmul,
                                         int t, int pos0, int pstride, int wl, bool lanesel,
                                         float* imp_row, int jbase, float& carry, int lane, float* imp_scale = nullptr, bool fixm = false) {
  const int l16 = lane & 15, gk = lane >> 4;
  const float scale2 = 0.125f * LOG2E;
  const unsigned wle = lanesel ? (unsigned)wl : 0u;
  f32x4 s[4];
  qk_tile(sK, q, s, l16, gk);
  float xv[4][4];
  float mx = -1e30f;
#pragma unroll
  for (int kt = 0; kt < 4; ++kt)
#pragma unroll
    for (int r = 0; r < 4; ++r) {
      const int dist = t - (pos0 + (kt * 16 + gk * 4 + r) * pstride);
      const float pen = ((unsigned)dist < wle) ? 0.f : -1e30f;
      const float v = fmaf(s[kt][r], scale2, fmaf(-slope2, (float)dist, pen));
      xv[kt][r] = v; mx = fmaxf(mx, v);
    }
  if (BR == 2 && fixm) {
    float rsf = 0.f;
#pragma unroll
    for (int kt = 0; kt < 4; ++kt)
#pragma unroll
      for (int r = 0; r < 4; ++r) { xv[kt][r] = ex2(xv[kt][r] - m); rsf += xv[kt][r]; }
    l += rsf;
    pv_tile(sV, xv, acc, l16, gk);
    return;
  }
  if (BR != 1) {
    mx = fmaxf(mx, __shfl_xor(mx, 16)); mx = fmaxf(mx, __shfl_xor(mx, 32));
    const float mnew = fmaxf(m, mx);
    const float alpha = ex2(m - mnew);
    m = mnew;
    const float muse = fmaxf(mnew, -1e20f);
    float rs = 0.f;
#pragma unroll
    for (int kt = 0; kt < 4; ++kt)
#pragma unroll
      for (int r = 0; r < 4; ++r) { xv[kt][r] = ex2(xv[kt][r] - muse); rs += xv[kt][r]; }
    l = l * alpha + rs;
    if (BR == 2 || BR == 3) {
#pragma unroll
      for (int dt = 0; dt < 4; ++dt) acc[dt] *= alpha;
    }
    if (BR == 3) {
      float p3[4];
#pragma unroll
      for (int kt = 0; kt < 4; ++kt) {
        p3[kt] = xv[kt][3];
        imp_row[jbase + kt * 4 + gk] = 2.f * (xv[kt][0] + xv[kt][1] + xv[kt][2]) + xv[kt][3];
      }
      const int srcl = (lane + 48) & 63;
      const float carry_s = carry * alpha;
#pragma unroll
      for (int kt = 0; kt < 4; ++kt) {
        const float same = __shfl(p3[kt], srcl);
        const float prev = __shfl(kt > 0 ? p3[kt > 0 ? kt - 1 : 0] : carry_s, srcl);
        imp_row[jbase + kt * 4 + gk] += (gk == 0) ? prev : same;
      }
      carry = p3[3];
      if (gk == 0) *imp_scale = mnew;
    }
    if (BR == 2 || BR == 3) pv_tile(sV, xv, acc, l16, gk);
  } else {
    const float muse = fmaxf(m, -1e20f);
    float p3[4];
#pragma unroll
    for (int kt = 0; kt < 4; ++kt) {
      float pn[4];
#pragma unroll
      for (int r = 0; r < 4; ++r) { pn[r] = ex2(xv[kt][r] - muse) * l; xv[kt][r] = pn[r] * gmul; }
      p3[kt] = pn[3];
      xv[kt][0] = xv[kt][0];
      imp_row[jbase + kt * 4 + gk] = 2.f * (pn[0] + pn[1] + pn[2]) + pn[3];
    }
    const int srcl = (lane + 48) & 63;
#pragma unroll
    for (int kt = 0; kt < 4; ++kt) {
      const float same = __shfl(p3[kt], srcl);
      const float prev = __shfl(kt > 0 ? p3[kt > 0 ? kt - 1 : 0] : carry, srcl);
      imp_row[jbase + kt * 4 + gk] += (gk == 0) ? prev : same;
    }
    carry = p3[3];
    pv_tile(sV, xv, acc, l16, gk);
  }
}

__device__ __forceinline__ void nsa_phase(const Params& p, u16* lds) {
  const u16* U = (const u16*)(p.ws + WS_QK);
  const u16* VT = (const u16*)(p.ws + WS_VT);
  const u16* KC = (const u16*)(p.ws + WS_KCMP);
  const u16* VC = (const u16*)(p.ws + WS_VCMPT);
  const float* GL = (const float*)(p.ws + WS_GL);
  u16* Y = (u16*)(p.ws + WS_Y);
  float* imp = (float*)(lds + 512 * TS);
  uint32_t* umask = (uint32_t*)(imp + 128 * IMPS);
  int* ulist = (int*)(umask + 4);
  const int tid = TIDX, lane = tid & 63, w = tid >> 6, l16 = lane & 15, gk = lane >> 4;
  const int qt = w & 1, hd = w >> 1;
  uint2* totl = (uint2*)imp + 128 + (size_t)w * 256 + lane;
  const int BIG = 1 << 30;
  int* uslot = ulist + 128;
  unsigned* uctr = (unsigned*)(p.ws + WS_KMAX) + 24;
  for (;;) {
    __syncthreads();
    if (tid == 0) uslot[0] = (int)atomicAdd(uctr, 1u);
    __syncthreads();
    const int unit = uslot[0];
    if (unit >= 4096) break;
    const int bg = unit & 15, qh = 255 - (unit >> 4), b = bg >> 2, g = bg & 3;
    const int t0 = qh * 32, qb = t0 >> 6, t = t0 + 16 * qt + l16;
    const size_t mrow = (size_t)b * SEQ + t;
    const int h = g * 4 + hd;
    bf16x8 q[2];
#pragma unroll
    for (int ks = 0; ks < 2; ++ks) q[ks] = *(const bf16x8*)(U + mrow * LDQ + h * 64 + ks * 32 + gk * 8);
    const float slope2 = exp2f(-0.5f * (float)(h + 1)) * LOG2E;
    const float g1 = sigmoid_f(GL[mrow * 48 + h * 3] + p.o_bg[h * 3]);
    float sk[16];
#pragma unroll
    for (int i = 0; i < 16; ++i) sk[i] = slope2 * (float)((i >> 2) * 16 + (i & 3));
    float qn2 = 0.f;
#pragma unroll
    for (int ks = 0; ks < 2; ++ks)
#pragma unroll
      for (int e = 0; e < 8; ++e) { const float v = bf2f((u16)q[ks][e]); qn2 += v * v; }
    qn2 += __shfl_xor(qn2, 16); qn2 += __shfl_xor(qn2, 32);
#pragma unroll
    for (int o2 = 1; o2 <= 8; o2 <<= 1) qn2 = fmaxf(qn2, __shfl_xor(qn2, o2));
    const uint32_t* kmx = (const uint32_t*)(p.ws + WS_KMAX);
    const float sc2 = 0.125f * LOG2E;
    const float T_slc = 2.02f * sc2 * sqrtf(qn2 * __uint_as_float(kmx[8 + g])) + 48.f;
    const float T_win = 2.02f * sc2 * sqrtf(qn2 * __uint_as_float(kmx[12 + g])) + 48.f;
    const float T_cmp = 2.05f * sc2 * sqrtf(qn2 * __uint_as_float(kmx[16 + g])) + 16.f * slope2 + 48.f;
    const int tq0w = t0 + 16 * qt;
    const float mfix_slc = 1.01f * sc2 * sqrtf(qn2 * __uint_as_float(kmx[8 + g])), mfix_win = 1.01f * sc2 * sqrtf(qn2 * __uint_as_float(kmx[12 + g]));
    f32x4 acc[4];
    float m = -1e30f, l = 0.f;
#pragma unroll
    for (int dt = 0; dt < 4; ++dt) acc[dt] = (f32x4){0.f, 0.f, 0.f, 0.f};
    __syncthreads();
    for (int i = tid; i < 128 * IMPS; i += NTHR) imp[i] = 0.f;
    if (tid < 4) umask[tid] = 0u;
    float* imp_row = imp + (hd * 32 + 16 * qt + l16) * IMPS;
    float carry = 0.f;
    uint4 rk0, rk1, rk2, rk3, rv0, rv1, rv2, rv3;
    u16* impbase_unused = nullptr; (void)impbase_unused;
#define SLOT(k) (lds + (k) * (128 * TS))
#define LD1(k, kp, ks_, vp, vs_) { rk##k = *(const uint4*)((kp) + (long)(tid >> 3) * (ks_) + (tid & 7) * 8); rv##k = *(const uint4*)((vp) + (long)(tid >> 3) * (vs_) + (tid & 7) * 8); }
#define ST1(k) { *(uint4*)(SLOT(k) + (tid >> 3) * TS + (tid & 7) * 8) = rk##k; TILE_STV_(SLOT(k) + 64 * TS, rv##k) }
    const int ntc = ((t0 >> 4) >> 6) + 1;
    const u16* kcs = KC + (size_t)bg * 512 * 64;
    const u16* vcs = VC + (size_t)bg * 32768;
#define CMP_LD(k, i) if ((i) < ntc) LD1(k, kcs + (size_t)(i) * 64 * 64, 64, vcs + (i) * 64, 512)
    float* mrec = (float*)(uslot + 4) + (w * 16 + l16) * 8;
    {
      const int ngrp = (ntc + 3) >> 2;
      CMP_LD(0, 0) CMP_LD(1, 1) CMP_LD(2, 2) CMP_LD(3, 3)
#pragma unroll 1
      for (int gi = 0; gi < ngrp; ++gi) {
        const int ib = gi * 4;
        __syncthreads();
        if (ib < ntc) ST1(0) if (ib + 1 < ntc) ST1(1) if (ib + 2 < ntc) ST1(2) if (ib + 3 < ntc) ST1(3)
        __syncthreads();
        if (gi + 1 < ngrp) { CMP_LD(0, ib + 4) CMP_LD(1, ib + 5) CMP_LD(2, ib + 6) CMP_LD(3, ib + 7) }
#pragma unroll 1
        for (int k = 0; k < 4; ++k) {
          const int i = ib + k;
          if (i < ntc) {
            const int dmin = tq0w - (16 * (64 * i + 63) + 31);
            if (dmin > 0 && slope2 * (float)dmin > T_cmp) { carry = 0.f; if (gk == 0) mrec[i] = -1e30f; continue; }
            nsa_tile<3>(SLOT(k), SLOT(k) + 64 * TS, q, acc, m, l, slope2, g1, t, 16 * (64 * i) + 31, 16, BIG, true, imp_row, 16 * i, carry, lane, mrec + i);
          }
        }
      }
      float lt = l; lt += __shfl_xor(lt, 16); lt += __shfl_xor(lt, 32);
      const float inv = lt > 0.f ? 1.f / lt : 0.f;
      const float mfin = fmaxf(m, -1e20f);
#pragma unroll 1
      for (int i = 0; i < ntc; ++i) {
        const float f = ex2(fmaxf(mrec[i], -1e20f) - mfin) * inv;
#pragma unroll
        for (int kt = 0; kt < 4; ++kt) imp_row[16 * i + kt * 4 + gk] *= f;
      }
      const float og = g1 * inv;
#pragma unroll
      for (int dt = 0; dt < 4; ++dt) acc[dt] *= og;
    }
    __syncthreads();
    {
      const int qi = w * 4 + gk;
      const int c8 = l16 * 8;
      uint32_t selb = 0u;
      if (qb < 16) {
#pragma unroll
        for (int i = 0; i < 8; ++i) if (c8 + i <= qb) selb |= (1u << i);
      } else {
        float val[8];
        const float* ra = imp + qi * IMPS + c8;
#pragma unroll
        for (int i4 = 0; i4 < 2; ++i4) {
          const float4 v0 = *(const float4*)(ra + 4 * i4);
          const float4 v1 = *(const float4*)(ra + 32 * IMPS + 4 * i4);
          const float4 v2 = *(const float4*)(ra + 64 * IMPS + 4 * i4);
          const float4 v3 = *(const float4*)(ra + 96 * IMPS + 4 * i4);
          val[4 * i4] = ((v0.x + v1.x) + v2.x) + v3.x; val[4 * i4 + 1] = ((v0.y + v1.y) + v2.y) + v3.y;
          val[4 * i4 + 2] = ((v0.z + v1.z) + v2.z) + v3.z; val[4 * i4 + 3] = ((v0.w + v1.w) + v2.w) + v3.w;
        }
#pragma unroll
        for (int i = 0; i < 8; ++i) {
          const int j = c8 + i;
          const bool forced = (j == 0) || (j == qb) || (j == qb - 1);
          if (forced) selb |= (1u << i);
          if (forced || j > qb) val[i] = -1.f;
        }
#pragma unroll 1
        for (int it = 0; it < 13; ++it) {
          float best = -2.f; int bj = 0;
#pragma unroll
          for (int i = 0; i < 8; ++i) {
            const float v = ((selb >> i) & 1u) ? -1.f : val[i];
            if (v > best) { best = v; bj = c8 + i; }
          }
#pragma unroll
          for (int o = 1; o <= 8; o <<= 1) {
            const float ov = __shfl_xor(best, o); const int oj = __shfl_xor(bj, o);
            if (ov > best || (ov == best && oj < bj)) { best = ov; bj = oj; }
          }
          if ((bj >> 3) == l16) selb |= (1u << (bj & 7));
        }
      }
      uint32_t wd = selb << ((l16 & 3) * 8);
      wd |= __shfl_xor(wd, 1); wd |= __shfl_xor(wd, 2);
      __syncthreads();
      uint32_t* selw = (uint32_t*)imp;
      if ((l16 & 3) == 0) selw[qi * 4 + (l16 >> 2)] = wd;
      uint32_t uq = wd; uq |= __shfl_xor(uq, 16); uq |= __shfl_xor(uq, 32);
      if (gk == 0 && (l16 & 3) == 0) atomicOr(&umask[l16 >> 2], uq);
    }
    __syncthreads();
    const uint32_t* selq = (const uint32_t*)imp + (16 * qt + l16) * 4;
    const uint32_t sel0 = selq[0], sel1 = selq[1], sel2 = selq[2], sel3 = selq[3];
    uint32_t wun0 = sel0, wun1 = sel1, wun2 = sel2, wun3 = sel3;
#pragma unroll
    for (int o = 1; o <= 8; o <<= 1) { wun0 |= __shfl_xor(wun0, o); wun1 |= __shfl_xor(wun1, o); wun2 |= __shfl_xor(wun2, o); wun3 |= __shfl_xor(wun3, o); }
    int nsl = 0;
    {
      const uint32_t u0 = umask[0], u1 = umask[1], u2 = umask[2], u3 = umask[3];
      nsl = __popc(u0) + __popc(u1) + __popc(u2) + __popc(u3);
      if (tid < 128) {
        const uint32_t uw = tid < 32 ? u0 : tid < 64 ? u1 : tid < 96 ? u2 : u3;
        if ((uw >> (tid & 31)) & 1u) {
          int pos = __popc(uw & ((1u << (tid & 31)) - 1u));
          if (tid >= 32) pos += __popc(u0);
          if (tid >= 64) pos += __popc(u1);
          if (tid >= 96) pos += __popc(u2);
          ulist[pos] = tid;
        }
      }
    }
    __syncthreads();
#pragma unroll
    for (int dt = 0; dt < 4; ++dt) {
      uint2 o2; o2.x = pack2(acc[dt][0], acc[dt][1]); o2.y = pack2(acc[dt][2], acc[dt][3]);
      totl[dt * 64] = o2;
    }
#pragma unroll 1
    for (int br = 1; br < 3; ++br) {
      const float mfix = (br == 1) ? mfix_slc : mfix_win;
      const bool fixm = mfix < 50.f;
      m = fixm ? mfix : -1e30f; l = 0.f;
#pragma unroll
      for (int dt = 0; dt < 4; ++dt) acc[dt] = (f32x4){0.f, 0.f, 0.f, 0.f};
      int wfirst = ((t0 - 511) >> 6) << 6; if (wfirst < 0) wfirst = 0;
      const int nt = (br == 1) ? nsl : ((qb * 64 - wfirst) >> 6) + 1;
      const int ngrp = (nt + 3) >> 2;
      const u16* kb = U + (size_t)b * SEQ * LDQ + (br == 1 ? 1536 : 1792) + g * 64;
      const u16* vb = VT + (size_t)((br == 1 ? 0 : 256) + g * 64) * MTOK + (size_t)b * SEQ;
#define SRC_S0(i) ((br == 1) ? ulist[nt - 1 - (i)] * 64 : wfirst + 64 * (nt - 1 - (i)))
#define BR_LD(k, i) if ((i) < nt) { const int s_ = SRC_S0(i); LD1(k, kb + (size_t)s_ * LDQ, LDQ, vb + s_, MTOK) }
      BR_LD(0, 0) BR_LD(1, 1) BR_LD(2, 2) BR_LD(3, 3)
#pragma unroll 1
      for (int gi = 0; gi < ngrp; ++gi) {
        const int ib = gi * 4;
        __syncthreads();
        if (ib < nt) ST1(0) if (ib + 1 < nt) ST1(1) if (ib + 2 < nt) ST1(2) if (ib + 3 < nt) ST1(3)
        __syncthreads();
        if (gi + 1 < ngrp) { BR_LD(0, ib + 4) BR_LD(1, ib + 5) BR_LD(2, ib + 6) BR_LD(3, ib + 7) }
#pragma unroll 1
        for (int k = 0; k < 4; ++k) {
          const int i = ib + k;
          if (i < nt) {
            const int s0 = SRC_S0(i);
            bool wsel = true, ls = true;
            int wl = 512;
            if (br == 1) {
              const int j = s0 >> 6, jw = j >> 5, jb = j & 31;
              const uint32_t ww = jw == 0 ? wun0 : jw == 1 ? wun1 : jw == 2 ? wun2 : wun3;
              const uint32_t sw = jw == 0 ? sel0 : jw == 1 ? sel1 : jw == 2 ? sel2 : sel3;
              wsel = (ww >> jb) & 1u; ls = (sw >> jb) & 1u; wl = BIG;
            }
            if (wsel) {
              const int dminw = tq0w - (s0 + 63);
              if (dminw > 0 && slope2 * (float)dminw > (br == 1 ? T_slc : T_win)) wsel = false;
            }
            if (wsel) {
              const int tq0 = t0 + 16 * qt;
              const bool interior = (s0 + 63 <= tq0) && (br == 1 || s0 + 512 > tq0 + 15);
              if (interior) nsa_tile_interior(SLOT(k), SLOT(k) + 64 * TS, q, acc, m, l, slope2, sk, t, s0, ls, lane, fixm);
              else nsa_tile<2>(SLOT(k), SLOT(k) + 64 * TS, q, acc, m, l, slope2, g1, t, s0, 1, wl, ls, imp_row, 0, carry, lane, nullptr, fixm);
            }
          }
        }
      }
      {
        float lt = l; lt += __shfl_xor(lt, 16); lt += __shfl_xor(lt, 32);
        const float gt = sigmoid_f(GL[mrow * 48 + h * 3 + br] + p.o_bg[h * 3 + br]);
        const float sc = lt > 0.f ? gt / lt : 0.f;
#pragma unroll
        for (int dt = 0; dt < 4; ++dt) {
          const uint2 pv = totl[dt * 64];
          const float r0 = bf2f(pv.x & 0xffff) + acc[dt][0] * sc, r1 = bf2f(pv.x >> 16) + acc[dt][1] * sc;
          const float r2 = bf2f(pv.y & 0xffff) + acc[dt][2] * sc, r3 = bf2f(pv.y >> 16) + acc[dt][3] * sc;
          if (br == 1) {
            uint2 o2; o2.x = pack2(r0, r1); o2.y = pack2(r2, r3);
            totl[dt * 64] = o2;
          } else {
            const int col = h * 64 + dt * 16 + gk * 4;
            const uint2 zz = *(const uint2*)(U + mrow * LDQ + 2048 + col);
            const float z0 = bf2f(zz.x & 0xffff), z1 = bf2f(zz.x >> 16), z2 = bf2f(zz.y & 0xffff), z3 = bf2f(zz.y >> 16);
            uint2 ov;
            ov.x = pack2(r0 * silu_f(z0), r1 * silu_f(z1));
            ov.y = pack2(r2 * silu_f(z2), r3 * silu_f(z3));
            *(uint2*)(Y + mrow * DM + col) = ov;
          }
        }
      }
    }
#undef SLOT
#undef LD1
#undef ST1
#undef CMP_LD
#undef SRC_S0
#undef BR_LD
  }
}

__device__ __forceinline__ void final_norm(const Params& p) {
  const int lane = TIDX & 63, wave = TIDX >> 6;
  const int nrw = gridDim.x * NWAVE;
  for (int row = BIDX * NWAVE + wave; row < MTOK; row += 2 * nrw) {
    float4* xr0 = (float4*)(p.out + (size_t)row * DM);
    float4* xr1 = (float4*)(p.out + (size_t)(row + nrw) * DM);
    float4 v0[4], v1[4];
    float s0 = 0.f, s1 = 0.f;
#pragma unroll
    for (int i = 0; i < 4; ++i) { v0[i] = xr0[lane + 64 * i]; v1[i] = xr1[lane + 64 * i]; }
#pragma unroll
    for (int i = 0; i < 4; ++i) {
      s0 += v0[i].x * v0[i].x + v0[i].y * v0[i].y + v0[i].z * v0[i].z + v0[i].w * v0[i].w;
      s1 += v1[i].x * v1[i].x + v1[i].y * v1[i].y + v1[i].z * v1[i].z + v1[i].w * v1[i].w;
    }
#pragma unroll
    for (int o = 32; o >= 1; o >>= 1) { s0 += __shfl_xor(s0, o); s1 += __shfl_xor(s1, o); }
    const float r0 = rsqrtf(s0 * (1.f / DM) + 1e-6f), r1 = rsqrtf(s1 * (1.f / DM) + 1e-6f);
#pragma unroll
    for (int i = 0; i < 4; ++i) {
      const float4 gg = ((const float4*)p.fin_g)[lane + 64 * i];
      xr0[lane + 64 * i] = (float4){v0[i].x * r0 * gg.x, v0[i].y * r0 * gg.y, v0[i].z * r0 * gg.z, v0[i].w * r0 * gg.w};
      xr1[lane + 64 * i] = (float4){v1[i].x * r1 * gg.x, v1[i].y * r1 * gg.y, v1[i].z * r1 * gg.z, v1[i].w * r1 * gg.w};
    }
  }
}

#define XB_XCNT(j)  (64 * (j))
#define XB_XSUB(j)  (1024 + 64 * (j))
#define XB_XGEN(j)  (2048 + 64 * (j))
#define XB_TOP      3072
#define XB_TOPGEN   3136
#define XB_WORDS    3200
#define LAS __attribute__((address_space(3)))
__device__ __forceinline__ unsigned xb_ld(unsigned* q) { return __hip_atomic_load(q, __ATOMIC_RELAXED, __HIP_MEMORY_SCOPE_AGENT); }
__device__ __forceinline__ unsigned xb_add(unsigned* q, unsigned v) { return __hip_atomic_fetch_add(q, v, __ATOMIC_RELAXED, __HIP_MEMORY_SCOPE_AGENT); }
__device__ __forceinline__ unsigned xb_xcc_id() { return (unsigned)__builtin_amdgcn_s_getreg((3 << 11) | 20) & 0xFu; }
__device__ __forceinline__ void grid_bar(const Params& p, unsigned xcc, volatile unsigned* st) {
  asm volatile("s_waitcnt vmcnt(0)" ::: "memory");
  __syncthreads();
  if (TIDX == 0) {
    unsigned* bar = (unsigned*)(p.ws + WS_BAR);
    __builtin_amdgcn_s_waitcnt(0);
    unsigned nloc = st[0], nx = st[1];
    if (nloc == 0u) {
      const unsigned G = gridDim.x;
      for (;;) {
        unsigned sum = 0u, cnt = 0u, mine = 0u, below = 0u;
#pragma unroll
        for (unsigned j = 0; j < 16; ++j) { const unsigned c = xb_ld(&bar[XB_XCNT(j)]); sum += c; cnt += (c > 0u) ? 1u : 0u; mine = (j == xcc) ? c : mine; below += (j < xcc && c > 0u) ? 1u : 0u; }
        nloc = mine; nx = cnt; st[3] = below;
        if (sum == G) break;
        __builtin_amdgcn_s_sleep(1);
      }
      st[0] = nloc; st[1] = nx;
    }
    const unsigned old = xb_add(&bar[XB_XSUB(xcc)], 1u);
    const unsigned gen = old / nloc;
    if (old + 1u == (gen + 1u) * nloc) {
      __builtin_amdgcn_fence(__ATOMIC_RELEASE, "agent");
      asm volatile("s_waitcnt vmcnt(0)" ::: "memory");
      const unsigned og = xb_add(&bar[XB_TOP], 1u);
      const unsigned tg = og / nx;
      if (og + 1u == (tg + 1u) * nx) xb_add(&bar[XB_TOPGEN], 1u);
      else while (xb_ld(&bar[XB_TOPGEN]) == tg) __builtin_amdgcn_s_sleep(1);
      __builtin_amdgcn_fence(__ATOMIC_ACQUIRE, "agent");
      xb_add(&bar[XB_XGEN(xcc)], 1u);
      asm volatile("s_waitcnt vmcnt(0)" ::: "memory");
    } else {
      while (xb_ld(&bar[XB_XGEN(xcc)]) == gen) __builtin_amdgcn_s_sleep(1);
      __builtin_amdgcn_fence(__ATOMIC_ACQUIRE, "agent");
      asm volatile("s_waitcnt vmcnt(0)" ::: "memory");
    }
  }
  __syncthreads();
}

__device__ __forceinline__ void nsa_knorm(const Params& p) {
  if (BIDX < 64) return;
  const u16* U = (const u16*)(p.ws + WS_QK);
  uint32_t* km = (uint32_t*)(p.ws + WS_KMAX);
  const int tid = TIDX, lane = tid & 63, wave = tid >> 6;
  float mx = 0.f;
  for (int row = (BIDX - 64) * NWAVE + wave; row < MTOK; row += (gridDim.x - 64) * NWAVE) {
    const uint4 v = *(const uint4*)(U + (size_t)row * LDQ + 1536 + lane * 8);
    const float a0 = bf2f(v.x & 0xffff), a1 = bf2f(v.x >> 16), a2 = bf2f(v.y & 0xffff), a3 = bf2f(v.y >> 16);
    const float a4 = bf2f(v.z & 0xffff), a5 = bf2f(v.z >> 16), a6 = bf2f(v.w & 0xffff), a7 = bf2f(v.w >> 16);
    float ss = a0 * a0 + a1 * a1 + a2 * a2 + a3 * a3 + a4 * a4 + a5 * a5 + a6 * a6 + a7 * a7;
    ss += __shfl_xor(ss, 1); ss += __shfl_xor(ss, 2); ss += __shfl_xor(ss, 4);
    mx = fmaxf(mx, ss);
  }
  if ((lane & 7) == 0) atomicMax(&km[8 + (lane >> 3)], __float_as_uint(mx));
}

__global__ void __launch_bounds__(NTHR, 2) mega(Params p_in) {
  Params p = p_in;
  p.pad = __builtin_amdgcn_readfirstlane((int)threadIdx.x >> 6);
  extern __shared__ __attribute__((aligned(16))) unsigned char lds_raw[];
  u16* lds = (u16*)lds_raw;
  const unsigned xcc = xb_xcc_id();
  volatile unsigned* bst = (volatile unsigned*)(lds_raw + 147456);
  if (threadIdx.x < 4) bst[threadIdx.x] = 0u;
  __syncthreads();
  if (p_in.coop && threadIdx.x == 0) bst[2] = xb_add((unsigned*)(p_in.ws + WS_BAR) + XB_XCNT(xcc), 1u);
  __syncthreads();
  cg::grid_group grid = cg::this_grid();
  if (p_in.coop == 2) grid.sync();
#define PH_ON(k) (p.ph_lo <= (k) && (k) <= p.ph_hi)
#define PH_SYNC(k) if (p.coop && p.ph_lo <= (k) && (k) < p.ph_hi) grid_bar(p, xcc, bst);
  if (PH_ON(0)) {
    rms_rows_fl(p, (float*)lds);
    conv_t(p, (u16*)(p.ws + WS_WT0), p.e_win, 1024, 4104, 4352, 0);
    conv_t(p, (u16*)(p.ws + WS_WT1), p.o_win, 1024, 3632, 3840, 1);
    conv_t(p, (u16*)(p.ws + WS_WO0), p.e_wout, 1024, 1024, 1024, 2);
    conv_t(p, (u16*)(p.ws + WS_WO1), p.o_wout, 1024, 1024, 1024, 2);
    conv_t(p, (u16*)(p.ws + WS_W1K), p.o_wk1, 2048, 256, 256, 2);
    conv_t(p, (u16*)(p.ws + WS_W1V), p.o_wv1, 2048, 256, 256, 2);
    conv_t(p, (u16*)(p.ws + WS_W2K), p.o_wk2, 256, 64, 256, 2);
    conv_t(p, (u16*)(p.ws + WS_W2V), p.o_wv2, 256, 64, 256, 2);
    pe_partial(p);
    if (BIDX == 0 && TIDX < 32) ((uint32_t*)(p.ws + WS_KMAX))[TIDX] = 0u;
    for (int i = BIDX * NTHR + TIDX; i < MTOK; i += gridDim.x * NTHR) ((float*)(p.ws + WS_SSQ))[i] = 0.f;
  }
  PH_SYNC(0)
  if (PH_ON(1)) gemm_inproj(p, 0, lds, 0);
  PH_SYNC(1)
  if (PH_ON(2)) {
    fox_scan(p, (float*)lds); ret_stepA(p); fox_knorm(p);
    if (BIDX == gridDim.x - 1) {
      for (int i = TIDX; i < 512; i += NTHR) {
        const float* part = (const float*)(p.ws + WS_PEP);
        float sum = 0.f;
        for (int kc = 0; kc < 16; ++kc) sum += part[((i >> 8) * 16 + kc) * 256 + (i & 255)];
        ((float*)(p.ws + WS_PEB))[i] = sum;
      }
    }
  }
  PH_SYNC(2)
  if (PH_ON(3)) { ret_stepB(p); fox_phase(p, lds); }
  PH_SYNC(3)
  if (PH_ON(4)) ret_stepC(p, lds);
  PH_SYNC(4)
  if (PH_ON(5)) gemm_outproj(p, 0, lds);
  PH_SYNC(5)
  if (PH_ON(7)) gemm_inproj(p, 1, lds, 0);
  PH_SYNC(7)
  if (PH_ON(8)) { gemm_cmp1(p, lds); gemm_inproj(p, 1, lds, 1); nsa_knorm(p); }
  PH_SYNC(8)
  if (PH_ON(10)) nsa_phase(p, lds);
  PH_SYNC(10)
  if (PH_ON(11)) gemm_outproj(p, 1, lds);
  PH_SYNC(11)
  if (PH_ON(12)) final_norm(p);
}

extern "C" void kernel_launch(void* const* d_in, const int* in_sizes, int n_in, void* d_out, int out_size, void* d_ws,
                              size_t ws_size, hipStream_t stream) {
  static int grid_blocks = 0;
  if (!grid_blocks) {
    int dev = 0, cus = 0, per_cu = 0;
    hipGetDevice(&dev);
    hipDeviceGetAttribute(&cus, hipDeviceAttributeMultiprocessorCount, dev);
    hipFuncSetAttribute((const void*)mega, hipFuncAttributeMaxDynamicSharedMemorySize, LDS_BYTES);
    hipOccupancyMaxActiveBlocksPerMultiprocessor(&per_cu, (const void*)mega, NTHR, LDS_BYTES);
    if (per_cu < 1) per_cu = 1;
    if (per_cu > 1) per_cu = 1;
    grid_blocks = cus * per_cu;
    (void)hipGetLastError();
  }
  Params p{};
  p.x = (const float*)d_in[0]; p.e_ng = (const float*)d_in[1]; p.e_win = (const float*)d_in[2];
  p.e_bf = (const float*)d_in[3]; p.e_gn = (const float*)d_in[4]; p.e_wout = (const float*)d_in[5];
  p.o_ng = (const float*)d_in[6]; p.o_win = (const float*)d_in[7]; p.o_bg = (const float*)d_in[8];
  p.o_pek = (const float*)d_in[9]; p.o_pev = (const float*)d_in[10]; p.o_wk1 = (const float*)d_in[11];
  p.o_wk2 = (const float*)d_in[12]; p.o_wv1 = (const float*)d_in[13]; p.o_wv2 = (const float*)d_in[14];
  p.o_wout = (const float*)d_in[15]; p.fin_g = (const float*)d_in[16];
  p.out = (float*)d_out; p.ws = (unsigned char*)d_ws;
#if ONE_LAUNCH
  p.ph_lo = 0; p.ph_hi = NPHASE - 1; p.coop = 1;
  (void)hipMemsetAsync((unsigned char*)d_ws + WS_BAR, 0, 16384, stream);
  void* args[] = {&p};
  hipError_t e = hipLaunchCooperativeKernel((const void*)mega, dim3(grid_blocks), dim3(NTHR), args, LDS_BYTES, stream);
  if (e != hipSuccess) fprintf(stderr, "cooperative launch failed: %s (grid %d)\n", hipGetErrorString(e), grid_blocks);
#else
  for (int ph = 0; ph < NPHASE; ++ph) {
    p.ph_lo = ph; p.ph_hi = ph; p.coop = 0;
    hipLaunchKernelGGL(mega, dim3(grid_blocks), dim3(NTHR), LDS_BYTES, stream, p);
  }
#endif
}
```

```cpp
#include <hip/hip_runtime.h>
#include <hip/hip_cooperative_groups.h>
#include <stdint.h>
#include <stdio.h>
namespace cg = cooperative_groups;

typedef unsigned short u16;
typedef short bf16x8 __attribute__((ext_vector_type(8)));
typedef short bf16x4 __attribute__((ext_vector_type(4)));
typedef float f32x4 __attribute__((ext_vector_type(4)));

#ifndef ONE_LAUNCH
#define ONE_LAUNCH 1
#endif

#define MTOK 32768
#define SEQ 8192
#define DM 1024
#define LDQ 3072
#define LOG2E 1.4426950408889634f
#define TS 72
#define IMPS 132
#define LDS_BYTES 147520
#define NTHR 512
#define NWAVE 8
#define NPHASE 13

#define MiB (1024ull * 1024ull)
#define WS_HBF   (0ull)
#define WS_DS    (0ull)
#define WS_ST    (32ull * MiB)
#define WS_QK    (64ull * MiB)
#define WS_VT    (256ull * MiB)
#define WS_Y     (352ull * MiB)
#define WS_WT0   (416ull * MiB)
#define WS_WT1   (WS_WT0 + 4352ull * 1024 * 2)
#define WS_WO0   (WS_WT1 + 3840ull * 1024 * 2)
#define WS_WO1   (WS_WO0 + 1024ull * 1024 * 2)
#define WS_W1K   (WS_WO1 + 1024ull * 1024 * 2)
#define WS_W1V   (WS_W1K + 256ull * 2048 * 2)
#define WS_W2K   (WS_W1V + 256ull * 2048 * 2)
#define WS_W2V   (WS_W2K + 256ull * 256 * 2)
#define WS_FLOG  (440ull * MiB)
#define WS_CFOX  (441ull * MiB)
#define WS_GL    (442ull * MiB)
#define WS_HC    (448ull * MiB)
#define WS_KCMP  (456ull * MiB)
#define WS_VCMPT (457ull * MiB)
#define WS_PEP   (458ull * MiB)
#define WS_PEB   (WS_PEP + 65536ull)
#define WS_KMAX  (WS_PEB + 4096ull)
#define WS_SSQ   (459ull * MiB)
#define WS_BAR   (460ull * MiB)

struct Params {
  const float *x, *e_ng, *e_win, *e_bf, *e_gn, *e_wout;
  const float *o_ng, *o_win, *o_bg, *o_pek, *o_pev, *o_wk1, *o_wk2, *o_wv1, *o_wv2, *o_wout, *fin_g;
  float* out;
  unsigned char* ws;
  int ph_lo, ph_hi, coop, pad;
};

typedef __bf16 bf16v2 __attribute__((ext_vector_type(2)));
typedef float f32v2 __attribute__((ext_vector_type(2)));
__device__ __forceinline__ uint32_t pack2(float a, float b) {
  f32v2 v = {a, b};
  bf16v2 r = __builtin_convertvector(v, bf16v2);
  return *(uint32_t*)&r;
}
__device__ __forceinline__ u16 f2bf(float f) { return (u16)(pack2(f, 0.f) & 0xffffu); }
__device__ __forceinline__ float bf2f(u16 h) { return __uint_as_float(((uint32_t)h) << 16); }
__device__ __forceinline__ float ex2(float x) { return __builtin_amdgcn_exp2f(x); }
__device__ __forceinline__ float silu_f(float z) { return z * __builtin_amdgcn_rcpf(1.f + ex2(-z * LOG2E)); }
__device__ __forceinline__ float sigmoid_f(float z) { return __builtin_amdgcn_rcpf(1.f + ex2(-z * LOG2E)); }

__device__ __forceinline__ int opq(int v) { asm volatile("" : "+v"(v)); return v; }
__device__ __forceinline__ int opqs(int v) { asm volatile("" : "+s"(v)); return v; }
#define TIDX opq(p.pad * 64 + (int)__lane_id())
#define BIDX opqs((int)blockIdx.x)
template <int N> __device__ __forceinline__ int dpp_ror_i(int v) { return __builtin_amdgcn_mov_dpp(v, 0x120 + N, 0xf, 0xf, false); }
template <int N> __device__ __forceinline__ float dpp_ror_f(float v) { return __builtin_bit_cast(float, __builtin_amdgcn_mov_dpp(__builtin_bit_cast(int, v), 0x120 + N, 0xf, 0xf, false)); }
__device__ __forceinline__ int dpp_xor1_i(int v) { return __builtin_amdgcn_mov_dpp(v, 0xB1, 0xf, 0xf, false); }
__device__ __forceinline__ int dpp_xor2_i(int v) { return __builtin_amdgcn_mov_dpp(v, 0x4E, 0xf, 0xf, false); }
#define MFMA(a, b, c) __builtin_amdgcn_mfma_f32_16x16x32_bf16((a), (b), (c), 0, 0, 0)

__device__ __forceinline__ void rms_rows(const Params& p, const float* __restrict__ x, const float* __restrict__ g, u16* __restrict__ h) {
  const int lane = TIDX & 63, wave = TIDX >> 6;
  for (int row = BIDX * NWAVE + wave; row < MTOK; row += gridDim.x * NWAVE) {
    const float4* xr = (const float4*)(x + (size_t)row * DM);
    float4 v[4];
    float ss = 0.f;
#pragma unroll
    for (int i = 0; i < 4; ++i) {
      v[i] = xr[lane + 64 * i];
      ss += v[i].x * v[i].x + v[i].y * v[i].y + v[i].z * v[i].z + v[i].w * v[i].w;
    }
#pragma unroll
    for (int o = 32; o >= 1; o >>= 1) ss += __shfl_xor(ss, o);
    const float rstd = rsqrtf(ss * (1.f / DM) + 1e-6f);
#pragma unroll
    for (int i = 0; i < 4; ++i) {
      float4 gg = ((const float4*)g)[lane + 64 * i];
      uint2 o;
      o.x = pack2(v[i].x * rstd * gg.x, v[i].y * rstd * gg.y);
      o.y = pack2(v[i].z * rstd * gg.z, v[i].w * rstd * gg.w);
      *(uint2*)(h + (size_t)row * DM + (lane + 64 * i) * 4) = o;
    }
  }
}

__device__ __forceinline__ void rms_rows_fl(const Params& p, float* ldsf) {
  const float* __restrict__ x = p.x; const float* __restrict__ g = p.e_ng;
  u16* __restrict__ h = (u16*)(p.ws + WS_HBF);
  float* __restrict__ fl = (float*)(p.ws + WS_FLOG);
  const int tid = TIDX, lane = tid & 63, wave = tid >> 6;
  for (int i = tid; i < 8 * DM; i += NTHR) { const int j = i >> 10, k = i & 1023; ldsf[i] = g[k] * p.e_win[(size_t)k * 4104 + 1536 + j]; }
  __syncthreads();
  for (int row = BIDX * NWAVE + wave; row < MTOK; row += gridDim.x * NWAVE) {
    const float4* xr = (const float4*)(x + (size_t)row * DM);
    float4 v[4];
    float ss = 0.f;
#pragma unroll
    for (int i = 0; i < 4; ++i) {
      v[i] = xr[lane + 64 * i];
      ss += v[i].x * v[i].x + v[i].y * v[i].y + v[i].z * v[i].z + v[i].w * v[i].w;
    }
#pragma unroll
    for (int o = 32; o >= 1; o >>= 1) ss += __shfl_xor(ss, o);
    const float rstd = rsqrtf(ss * (1.f / DM) + 1e-6f);
#pragma unroll
    for (int i = 0; i < 4; ++i) {
      float4 gg = ((const float4*)g)[lane + 64 * i];
      uint2 o;
      o.x = pack2(v[i].x * rstd * gg.x, v[i].y * rstd * gg.y);
      o.y = pack2(v[i].z * rstd * gg.z, v[i].w * rstd * gg.w);
      *(uint2*)(h + (size_t)row * DM + (lane + 64 * i) * 4) = o;
    }
    float myf = 0.f;
#pragma unroll
    for (int j = 0; j < 8; ++j) {
      float d = 0.f;
#pragma unroll
      for (int i = 0; i < 4; ++i) {
        const float4 w4 = *(const float4*)(ldsf + j * DM + (lane + 64 * i) * 4);
        d += v[i].x * w4.x + v[i].y * w4.y + v[i].z * w4.z + v[i].w * w4.w;
      }
#pragma unroll
      for (int o = 32; o >= 1; o >>= 1) d += __shfl_xor(d, o);
      if (lane == j) myf = d * rstd;
    }
    if (lane < 8) fl[(size_t)row * 8 + lane] = myf;
  }
}

__device__ __forceinline__ int map_col(int MAP, int n) {
  if (MAP == 0) {
    if (n < 1024) return n;
    if (n < 2048) return n + 520;
    if (n < 3072) return n + 1032;
    if (n < 3584) return n - 2048;
    if (n < 4096) return n - 1016;
    if (n < 4104) return n - 2560;
    return -1;
  } else if (MAP == 1) {
    if (n < 1792) return n;
    if (n < 2048) return n + 256;
    if (n < 3072) return n + 560;
    if (n < 3328) return n - 1280;
    if (n < 3584) return n - 1024;
    if (n < 3632) return n - 1024;
    return -1;
  } else if (MAP == 2) {
    return n;
  }
  return n;
}

__device__ __forceinline__ void conv_t(const Params& p, u16* __restrict__ dst, const float* __restrict__ src, int K, int nsrc, int ndst, int MAP) {
  const int total = ndst * (K >> 3);
  for (int id = BIDX * NTHR + TIDX; id < total; id += gridDim.x * NTHR) {
    const int n = id % ndst, kc = id / ndst;
    const int sc = map_col(MAP, n);
    const bool okc = (sc >= 0 && sc < nsrc);
    const int scc = okc ? sc : 0;
    float v[8];
#pragma unroll
    for (int i = 0; i < 8; ++i) v[i] = src[(size_t)(kc * 8 + i) * nsrc + scc];
#pragma unroll
    for (int i = 0; i < 8; ++i) v[i] = okc ? v[i] : 0.f;
    uint4 o;
    o.x = pack2(v[0], v[1]); o.y = pack2(v[2], v[3]); o.z = pack2(v[4], v[5]); o.w = pack2(v[6], v[7]);
    *(uint4*)(dst + (size_t)n * K + kc * 8) = o;
  }
}

__device__ __forceinline__ void pe_partial(const Params& p) {
  float* part = (float*)(p.ws + WS_PEP);
  for (int task = BIDX; task < 32; task += gridDim.x) {
    const int kv = task >> 4, kc = task & 15, n = TIDX;
    if (n >= 256) continue;
    const float* pe = kv ? p.o_pev : p.o_pek;
    const float* w1 = kv ? p.o_wv1 : p.o_wk1;
    float acc = 0.f;
#pragma unroll 16
    for (int k = kc * 128; k < kc * 128 + 128; ++k) acc += pe[k] * w1[(size_t)k * 256 + n];
    part[(kv * 16 + kc) * 256 + n] = acc;
  }
}

#define GST (512 * TS)
template <bool swapped>
__device__ __forceinline__ void gemm_compute(const u16* cur, f32x4 (&acc)[8][4], int wpa, int wpb, int l16, int gk) {
  const u16* sA = cur + (wpa * 128 + l16) * TS + gk * 8;
  const u16* sB = cur + (256 + wpb * 64 + l16) * TS + gk * 8;
#pragma unroll 1
  for (int kk = 0; kk < 2; ++kk) {
    bf16x8 fa[8], fb[4];
#pragma unroll
    for (int i = 0; i < 8; ++i) fa[i] = *(const bf16x8*)(sA + i * 16 * TS + kk * 32);
#pragma unroll
    for (int j = 0; j < 4; ++j) fb[j] = *(const bf16x8*)(sB + j * 16 * TS + kk * 32);
    if (swapped) {
#pragma unroll
      for (int i = 0; i < 8; ++i)
#pragma unroll
        for (int j = 0; j < 4; ++j) acc[i][j] = MFMA(fb[j], fa[i], acc[i][j]);
    } else {
#pragma unroll
      for (int i = 0; i < 8; ++i)
#pragma unroll
        for (int j = 0; j < 4; ++j) acc[i][j] = MFMA(fa[i], fb[j], acc[i][j]);
    }
  }
}
template <bool swapped>
__device__ __forceinline__ void gemm_mainloop(const Params& p, const u16* __restrict__ Ab, const uint32_t (&pa)[4], const u16* __restrict__ Bb,
                                              const uint32_t (&pb)[4], int a_kstride, int nk,
                                              u16* lds, f32x4 (&acc)[8][4],
                                              bool primed = false, const u16* __restrict__ Abn = nullptr, const u16* __restrict__ Bbn = nullptr) {
  const int tid = TIDX, lane = tid & 63, wave = tid >> 6;
  const int l16 = lane & 15, gk = lane >> 4;
  const int wpa = wave >> 2, wpb = wave & 3;
  const int woff = (tid >> 3) * TS + (tid & 7) * 8;
  uint4 ra0, ra1, ra2, ra3, rb0, rb1, rb2, rb3;
#define G_LD(kidx) { const u16* Ap_ = Ab + (size_t)(kidx) * a_kstride; const u16* Bp_ = Bb + (size_t)(kidx) * 64;   \
    ra0 = *(const uint4*)(Ap_ + pa[0]); ra1 = *(const uint4*)(Ap_ + pa[1]); ra2 = *(const uint4*)(Ap_ + pa[2]); ra3 = *(const uint4*)(Ap_ + pa[3]); \
    rb0 = *(const uint4*)(Bp_ + pb[0]); rb1 = *(const uint4*)(Bp_ + pb[1]); rb2 = *(const uint4*)(Bp_ + pb[2]); rb3 = *(const uint4*)(Bp_ + pb[3]); }
#define G_ST(D) { u16* D_ = (D) + woff;                                                                               \
    *(uint4*)(D_) = ra0; *(uint4*)(D_ + 64 * TS) = ra1; *(uint4*)(D_ + 128 * TS) = ra2; *(uint4*)(D_ + 192 * TS) = ra3;  \
    *(uint4*)(D_ + 256 * TS) = rb0; *(uint4*)(D_ + 320 * TS) = rb1; *(uint4*)(D_ + 384 * TS) = rb2; *(uint4*)(D_ + 448 * TS) = rb3; }
  if (!primed) {
    G_LD(0)
    __syncthreads();
    G_ST(lds)
    __syncthreads();
  }
#pragma unroll
  for (int i = 0; i < 8; ++i)
#pragma unroll
    for (int j = 0; j < 4; ++j) acc[i][j] = (f32x4){0.f, 0.f, 0.f, 0.f};
#pragma unroll 1
  for (int ks = 0; ks < nk; ++ks) {
    const bool last = (ks + 1 == nk);
    const bool more = !last || (Abn != nullptr);
    if (more) {
      if (!last) G_LD(ks + 1)
      else { const u16* Ab = Abn; const u16* Bb = Bbn; G_LD(0) }
    }
    gemm_compute<swapped>(lds + (ks & 1) * GST, acc, wpa, wpb, l16, gk);
    if (more) G_ST(lds + ((ks + 1) & 1) * GST)
    __syncthreads();
  }
#undef G_LD
#undef G_ST
}
#define GEMM_OFFS(rowstrideA, rowstrideB)                                   \
  uint32_t pa[4], pb[4];                                                    \
  _Pragma("unroll") for (int i = 0; i < 4; ++i) {                           \
    pa[i] = (uint32_t)((tid >> 3) + 64 * i) * (rowstrideA) + (tid & 7) * 8; \
    pb[i] = (uint32_t)((tid >> 3) + 64 * i) * (rowstrideB) + (tid & 7) * 8; \
  }

__device__ __forceinline__ void gemm_inproj(const Params& p, int layer, u16* lds, int part) {
  const u16* A = (const u16*)(p.ws + WS_HBF);
  const u16* Bt = (const u16*)(p.ws + (layer ? WS_WT1 : WS_WT0));
  u16* QK = (u16*)(p.ws + WS_QK);
  u16* VT = (u16*)(p.ws + WS_VT);
  float* F = (float*)(p.ws + (layer ? WS_GL : WS_FLOG));
  const int NT = layer ? 14 : 16;
  const int seg_trans_end = layer ? 28 : 32;
  const int nvalidF = layer ? 48 : 8, ldf = layer ? 48 : 8;
  const int tid = TIDX, lane = tid & 63, wave = tid >> 6, l16 = lane & 15, gk = lane >> 4;
  const int wpa = wave >> 2, wpb = wave & 3;
  const int bid = BIDX;
  int xcd = bid & 7, nloc = (int)gridDim.x >> 3, lrank = bid >> 3;
  { const uint4 cw = *(const uint4*)((const unsigned char*)lds + 147456);
    const int c0 = __builtin_amdgcn_readfirstlane((int)cw.x), c1 = __builtin_amdgcn_readfirstlane((int)cw.y);
    const int c2 = __builtin_amdgcn_readfirstlane((int)cw.z), c3 = __builtin_amdgcn_readfirstlane((int)cw.w);
    if (c1 == 8 && c0 * 8 == (int)gridDim.x) { xcd = c3; lrank = c2; } }
  const int qbeg = part ? bid - 64 : lrank, qend = part ? (bid >= 64 ? 128 : -(1 << 20)) : 16 * NT, qstep = part ? (int)gridDim.x - 64 : nloc;
  bool primed = false;
  for (int q = qbeg; q < qend; q += qstep) {
    const int mt = part ? q : xcd * 16 + q / NT, nt = part ? NT : q % NT;
    const int m0 = mt * 256, n0 = nt * 256;
    const int qn = q + qstep;
    const bool has_next = (part == 0) && (qn < qend);
    const u16* Abn = has_next ? A + (size_t)((xcd * 16 + qn / NT) * 256) * DM : nullptr;
    const u16* Bbn = has_next ? Bt + (size_t)((qn % NT) * 256) * DM : nullptr;
    const int mw = m0 + wpa * 128, nw = n0 + wpb * 64;
    const int seg = nw >> 7;
    int mode;
    if (seg < 24) mode = (layer == 0 && seg >= 12 && seg < 16) ? 2 : 0;
    else if (seg < seg_trans_end) mode = 1;
    else if (seg == seg_trans_end) mode = 3;
    else mode = 4;
    const int seg0 = nt * 2;
    const bool swapped = !((seg0 >= 24 && seg0 < seg_trans_end) || (layer == 0 && seg0 >= 12 && seg0 < 16));
    GEMM_OFFS(DM, DM)
    f32x4 acc[8][4];
    if (swapped) gemm_mainloop<true>(p, A + (size_t)m0 * DM, pa, Bt + (size_t)n0 * DM, pb, 64, 16, lds, acc, primed, Abn, Bbn);
    else gemm_mainloop<false>(p, A + (size_t)m0 * DM, pa, Bt + (size_t)n0 * DM, pb, 64, 16, lds, acc, primed, Abn, Bbn);
    primed = has_next;
    const float* ssq_g = (const float*)(p.ws + WS_SSQ);
    const bool tile_normal = (nt < 12) && !(layer == 0 && nt >= 6 && nt < 8);
    if (tile_normal) {
      u16* stg = lds + GST;
      const int ES = 264;
#pragma unroll 1
      for (int half = 0; half < 2; ++half) {
        __syncthreads();
        if (wpa == half) {
#pragma unroll
          for (int i = 0; i < 8; ++i) {
            const float rs = layer ? rsqrtf(ssq_g[mw + i * 16 + l16] * (1.f / DM) + 1e-6f) : 1.f;
#pragma unroll
            for (int j = 0; j < 4; ++j) {
              uint2 o; o.x = pack2(acc[i][j][0] * rs, acc[i][j][1] * rs); o.y = pack2(acc[i][j][2] * rs, acc[i][j][3] * rs);
              *(uint2*)(stg + (i * 16 + l16) * ES + wpb * 64 + j * 16 + gk * 4) = o;
            }
          }
        }
        __syncthreads();
#pragma unroll
        for (int c = 0; c < 8; ++c) {
          const int idx = tid + NTHR * c, row = idx >> 5, ch = idx & 31;
          const uint4 v = *(const uint4*)(stg + row * ES + ch * 8);
          *(uint4*)(QK + (size_t)(m0 + half * 128 + row) * LDQ + n0 + ch * 8) = v;
        }
      }
      __syncthreads();
    } else if (mode == 0 || mode == 3) {
#pragma unroll
      for (int i = 0; i < 8; ++i) {
        const int m = mw + i * 16 + l16;
        const float rs = layer ? rsqrtf(ssq_g[m] * (1.f / DM) + 1e-6f) : 1.f;
#pragma unroll
        for (int j = 0; j < 4; ++j) {
          const int n = nw + j * 16 + gk * 4;
          const float a0 = acc[i][j][0] * rs, a1 = acc[i][j][1] * rs, a2 = acc[i][j][2] * rs, a3 = acc[i][j][3] * rs;
          if (mode == 0) {
            uint2 o; o.x = pack2(a0, a1); o.y = pack2(a2, a3);
            *(uint2*)(QK + (size_t)m * LDQ + n) = o;
          } else {
            const int nn = n - seg * 128;
            if (nn < nvalidF) *(float4*)(F + (size_t)m * ldf + nn) = (float4){a0, a1, a2, a3};
          }
        }
      }
    } else if (mode == 1 || mode == 2) {
#pragma unroll
      for (int i = 0; i < 8; ++i) {
        const int m = mw + i * 16 + gk * 4;
        float rs0 = 1.f, rs1 = 1.f, rs2 = 1.f, rs3 = 1.f;
        if (layer) {
          const float4 q4 = *(const float4*)(ssq_g + m);
          rs0 = rsqrtf(q4.x * (1.f / DM) + 1e-6f); rs1 = rsqrtf(q4.y * (1.f / DM) + 1e-6f);
          rs2 = rsqrtf(q4.z * (1.f / DM) + 1e-6f); rs3 = rsqrtf(q4.w * (1.f / DM) + 1e-6f);
        }
#pragma unroll
        for (int j = 0; j < 4; ++j) {
          const int n = nw + j * 16 + l16;
          const float a0 = acc[i][j][0] * rs0, a1 = acc[i][j][1] * rs1, a2 = acc[i][j][2] * rs2, a3 = acc[i][j][3] * rs3;
          if (mode == 1) {
            const int trow = n - 3072;
            uint2 o; o.x = pack2(a0, a1); o.y = pack2(a2, a3);
            *(uint2*)(VT + (size_t)trow * MTOK + m) = o;
          } else {
            const int trow = n - 512;
            const int h = (nw - 1536) >> 6;
            const float lg2 = log1pf(-exp2f(-5.f - (float)h)) * LOG2E;
            const float lane_dec = 0.125f * ex2(lg2 * (float)(127 - gk * 4));
            QK[(size_t)(m + 0) * LDQ + n] = f2bf(a0); QK[(size_t)(m + 1) * LDQ + n] = f2bf(a1);
            QK[(size_t)(m + 2) * LDQ + n] = f2bf(a2); QK[(size_t)(m + 3) * LDQ + n] = f2bf(a3);
            const float s0 = a0 * lane_dec * ex2(lg2 * (float)(-(i * 16 + 0))), s1 = a1 * lane_dec * ex2(lg2 * (float)(-(i * 16 + 1)));
            const float s2 = a2 * lane_dec * ex2(lg2 * (float)(-(i * 16 + 2))), s3 = a3 * lane_dec * ex2(lg2 * (float)(-(i * 16 + 3)));
            uint2 o; o.x = pack2(s0, s1); o.y = pack2(s2, s3);
            *(uint2*)(VT + (size_t)trow * MTOK + m) = o;
          }
        }
      }
    }
  }
}

__device__ __forceinline__ void gemm_outproj(const Params& p, int layer, u16* lds) {
  const u16* A = (const u16*)(p.ws + WS_Y);
  const u16* Bt = (const u16*)(p.ws + (layer ? WS_WO1 : WS_WO0));
  const float* res = layer ? p.out : p.x;
  float* out = p.out;
  u16* hb_out = (u16*)(p.ws + WS_HBF);
  float* ssq_g = (float*)(p.ws + WS_SSQ);
  const int tid = TIDX, lane = tid & 63, wave = tid >> 6, l16 = lane & 15, gk = lane >> 4;
  const int wpa = wave >> 2, wpb = wave & 3;
  const int bid = BIDX;
  int xcd = bid & 7, nloc = (int)gridDim.x >> 3, lrank = bid >> 3;
  { const uint4 cw = *(const uint4*)((const unsigned char*)lds + 147456);
    const int c0 = __builtin_amdgcn_readfirstlane((int)cw.x), c1 = __builtin_amdgcn_readfirstlane((int)cw.y);
    const int c2 = __builtin_amdgcn_readfirstlane((int)cw.z), c3 = __builtin_amdgcn_readfirstlane((int)cw.w);
    if (c1 == 8 && c0 * 8 == (int)gridDim.x) { xcd = c3; lrank = c2; } }
  bool primed = false;
  for (int q = lrank; q < 16 * 4; q += nloc) {
    const int mt = xcd * 16 + (q >> 2), nt = q & 3;
    const int m0 = mt * 256, n0 = nt * 256;
    const int qn = q + nloc;
    const bool has_next = qn < 16 * 4;
    const u16* Abn = has_next ? A + (size_t)((xcd * 16 + (qn >> 2)) * 256) * DM : nullptr;
    const u16* Bbn = has_next ? Bt + (size_t)((qn & 3) * 256) * DM : nullptr;
    GEMM_OFFS(DM, DM)
    f32x4 acc[8][4];
    gemm_mainloop<true>(p, A + (size_t)m0 * DM, pa, Bt + (size_t)n0 * DM, pb, 64, 16, lds, acc, primed, Abn, Bbn);
    primed = has_next;
    const int tid2 = TIDX, lane2 = tid2 & 63, wave2 = tid2 >> 6, l16b = lane2 & 15, gkb = lane2 >> 4;
    const int mw = m0 + (wave2 >> 2) * 128, nw = n0 + (wave2 & 3) * 64;
#pragma unroll
    for (int i = 0; i < 8; ++i) {
      const int m = mw + i * 16 + l16b;
      float sq = 0.f;
#pragma unroll
      for (int j = 0; j < 4; ++j) {
        const int n = nw + j * 16 + gkb * 4;
        const float4 r = *(const float4*)(res + (size_t)m * DM + n);
        const float4 v = (float4){r.x + acc[i][j][0], r.y + acc[i][j][1], r.z + acc[i][j][2], r.w + acc[i][j][3]};
        *(float4*)(out + (size_t)m * DM + n) = v;
        if (layer == 0) {
          const float4 gg = *(const float4*)(p.o_ng + n);
          uint2 hb; hb.x = pack2(v.x * gg.x, v.y * gg.y); hb.y = pack2(v.z * gg.z, v.w * gg.w);
          *(uint2*)(hb_out + (size_t)m * DM + n) = hb;
          sq += v.x * v.x + v.y * v.y + v.z * v.z + v.w * v.w;
        }
      }
      if (layer == 0) {
        sq += __shfl_xor(sq, 16); sq += __shfl_xor(sq, 32);
        if (gkb == 0) atomicAdd(ssq_g + m, sq);
      }
    }
  }
}

__device__ __forceinline__ void gemm_cmp2_tile(const Params& p, u16* lds, int kv, int mt) {
  const int tid = TIDX, lane = tid & 63, wave = tid >> 6, l16 = lane & 15, gk = lane >> 4;
  const int wpa = wave >> 2, wpb = wave & 3;
  {
    const int m0 = mt * 256;
    const u16* A = (const u16*)(p.ws + WS_HC) + (size_t)kv * 8192 * 256;
    const u16* Bt = (const u16*)(p.ws + (kv ? WS_W2V : WS_W2K));
    GEMM_OFFS(256, 256)
    f32x4 acc[8][4];
    const bool swapped = (kv == 0);
    if (swapped) gemm_mainloop<true>(p, A + (size_t)m0 * 256, pa, Bt, pb, 64, 4, lds, acc);
    else gemm_mainloop<false>(p, A + (size_t)m0 * 256, pa, Bt, pb, 64, 4, lds, acc);
    const int mw = m0 + wpa * 128, nw = wpb * 64;
    if (swapped) {
      u16* kc_ = (u16*)(p.ws + WS_KCMP);
#pragma unroll
      for (int i = 0; i < 8; ++i)
#pragma unroll
        for (int j = 0; j < 4; ++j) {
          const int n = nw + j * 16 + gk * 4;
          const int m = mw + i * 16 + l16;
          if (n < 64) {
            uint2 o; o.x = pack2(acc[i][j][0], acc[i][j][1]); o.y = pack2(acc[i][j][2], acc[i][j][3]);
            *(uint2*)(kc_ + (size_t)m * 64 + n) = o;
          }
        }
      if (wpb == 0) {
        float mxn = 0.f;
#pragma unroll
        for (int i = 0; i < 8; ++i) {
          float ss = 0.f;
#pragma unroll
          for (int j = 0; j < 4; ++j) ss += acc[i][j][0] * acc[i][j][0] + acc[i][j][1] * acc[i][j][1] + acc[i][j][2] * acc[i][j][2] + acc[i][j][3] * acc[i][j][3];
          ss += __shfl_xor(ss, 16); ss += __shfl_xor(ss, 32);
          mxn = fmaxf(mxn, ss);
        }
#pragma unroll
        for (int o2 = 1; o2 <= 8; o2 <<= 1) mxn = fmaxf(mxn, __shfl_xor(mxn, o2));
        if (lane == 0) atomicMax((uint32_t*)(p.ws + WS_KMAX) + 16 + ((mw >> 9) & 3), __float_as_uint(mxn));
      }
    } else {
      u16* vt = (u16*)(p.ws + WS_VCMPT);
#pragma unroll
      for (int i = 0; i < 8; ++i)
#pragma unroll
        for (int j = 0; j < 4; ++j) {
          const int m = mw + i * 16 + gk * 4;
          const int n = nw + j * 16 + l16;
          if (n < 64) {
            uint2 o; o.x = pack2(acc[i][j][0], acc[i][j][1]); o.y = pack2(acc[i][j][2], acc[i][j][3]);
            *(uint2*)(vt + (size_t)(m >> 9) * 32768 + (size_t)n * 512 + (m & 511)) = o;
          }
        }
    }
  }
}

__device__ __forceinline__ void gemm_cmp1(const Params& p, u16* lds) {
  const u16* U = (const u16*)(p.ws + WS_QK);
  const float* peb = (const float*)(p.ws + WS_PEB);
  const int tid = TIDX, lane = tid & 63, wave = tid >> 6, l16 = lane & 15, gk = lane >> 4;
  const int wpa = wave >> 2, wpb = wave & 3;
  for (int tile = BIDX; tile < 64; tile += gridDim.x) {
    const int kv = tile >> 5, mt = tile & 31;
    const int m0 = mt * 256;
    const u16* Bt = (const u16*)(p.ws + (kv ? WS_W1V : WS_W1K));
    u16* Hc = (u16*)(p.ws + WS_HC) + (size_t)kv * 8192 * 256;
    uint32_t pa[4], pb[4];
#pragma unroll
    for (int i = 0; i < 4; ++i) {
      const int row = (tid >> 3) + 64 * i, kc = tid & 7;
      const int r = m0 + row, bg = r >> 9, cc = r & 511, b = bg >> 2, g = bg & 3;
      int tok0 = cc * 16; if (tok0 > SEQ - 32) tok0 = SEQ - 32;
      pa[i] = (uint32_t)(b * SEQ + tok0) * LDQ + 1024 + kv * 256 + g * 64 + kc * 8;
      pb[i] = (uint32_t)row * 2048 + kc * 8;
    }
    f32x4 acc[8][4];
    gemm_mainloop<true>(p, U, pa, Bt, pb, LDQ, 32, lds, acc);
    const int tid2 = TIDX, lane2 = tid2 & 63, wave2 = tid2 >> 6;
    const int mw = m0 + (wave2 >> 2) * 128, nw = (wave2 & 3) * 64;
#pragma unroll
    for (int i = 0; i < 8; ++i)
#pragma unroll
      for (int j = 0; j < 4; ++j) {
        const int n = nw + j * 16 + (lane2 >> 4) * 4;
        const int m = mw + i * 16 + (lane2 & 15);
        const float4 bb = *(const float4*)(peb + kv * 256 + n);
        float v0 = silu_f(acc[i][j][0] + bb.x), v1 = silu_f(acc[i][j][1] + bb.y);
        float v2 = silu_f(acc[i][j][2] + bb.z), v3 = silu_f(acc[i][j][3] + bb.w);
        if ((m & 511) == 511) { v0 = v1 = v2 = v3 = 0.f; }
        uint2 o; o.x = pack2(v0, v1); o.y = pack2(v2, v3);
        *(uint2*)(Hc + (size_t)m * 256 + n) = o;
      }
    __threadfence_block();
    __syncthreads();
    gemm_cmp2_tile(p, lds, kv, mt);
  }
}

#define TILE_LD(R, src, stride) { R##0 = *(const uint4*)((src) + (long)(tid >> 3) * (stride) + (tid & 7) * 8); }
#define TILE_ST(dst, R) { *(uint4*)((dst) + (tid >> 3) * TS + (tid & 7) * 8) = R##0; }
#define VPOS(c) ((((c) >> 2) * 32) + ((2 * ((c) & 1)) * 8) + ((((c) & 3) >> 1) * 4))
#define TILE_STV_(dst, val) { const int c_ = tid & 7; u16* d_ = (dst) + (tid >> 3) * TS + VPOS(c_); \
    *(uint2*)(d_) = make_uint2((val).x, (val).y); *(uint2*)(d_ + 8) = make_uint2((val).z, (val).w); }
#define TILE_STV(dst, R) TILE_STV_(dst, R##0)
__device__ __forceinline__ void qk_tile(const u16* sK, const bf16x8 (&q)[2], f32x4 (&s)[4], int l16, int gk) {
#pragma unroll
  for (int kt = 0; kt < 4; ++kt) s[kt] = (f32x4){0.f, 0.f, 0.f, 0.f};
#pragma unroll
  for (int ks = 0; ks < 2; ++ks)
#pragma unroll
    for (int kt = 0; kt < 4; ++kt) {
      bf16x8 kf = *(const bf16x8*)(sK + (kt * 16 + l16) * TS + ks * 32 + gk * 8);
      s[kt] = MFMA(kf, q[ks], s[kt]);
    }
}
__device__ __forceinline__ void pv_tile(const u16* sV, const float (&pp)[4][4], f32x4 (&o)[4], int l16, int gk) {
  bf16x8 pf[2];
#pragma unroll
  for (int ks2 = 0; ks2 < 2; ++ks2) {
    uint4 t;
    t.x = pack2(pp[2 * ks2][0], pp[2 * ks2][1]); t.y = pack2(pp[2 * ks2][2], pp[2 * ks2][3]);
    t.z = pack2(pp[2 * ks2 + 1][0], pp[2 * ks2 + 1][1]); t.w = pack2(pp[2 * ks2 + 1][2], pp[2 * ks2 + 1][3]);
    pf[ks2] = *(bf16x8*)&t;
  }
#pragma unroll
  for (int dt = 0; dt < 4; ++dt)
#pragma unroll
    for (int ks2 = 0; ks2 < 2; ++ks2) {
      const bf16x8 vf = *(const bf16x8*)(sV + (dt * 16 + l16) * TS + ks2 * 32 + gk * 8);
      o[dt] = MFMA(vf, pf[ks2], o[dt]);
    }
}

__device__ __forceinline__ void fox_phase(const Params& p, u16* lds) {
  const u16* QK = (const u16*)(p.ws + WS_QK);
  const u16* VT = (const u16*)(p.ws + WS_VT);
  const float* cf = (const float*)(p.ws + WS_CFOX);
  u16* Y = (u16*)(p.ws + WS_Y);
  const int tid = TIDX, lane = tid & 63, w = tid >> 6, l16 = lane & 15, gk = lane >> 4;
  const float scale2 = 0.125f * LOG2E;
  for (int unit = BIDX; unit < 2048; unit += gridDim.x) {
    const int bh = unit & 31, qblk = 63 - (unit >> 5), b = bh >> 3, h = bh & 7;
    const int tq0 = qblk * 128 + w * 16;
    const int t = tq0 + l16;
    const float* cfr = cf + (size_t)bh * SEQ;
    bf16x8 q[2];
#pragma unroll
    for (int ks = 0; ks < 2; ++ks) q[ks] = *(const bf16x8*)(QK + (size_t)(b * SEQ + t) * LDQ + h * 64 + ks * 32 + gk * 8);
    const float cq2 = cfr[t] * LOG2E;
    f32x4 o[4];
    float m = -1e30f, l = 0.f;
#pragma unroll
    for (int dt = 0; dt < 4; ++dt) o[dt] = (f32x4){0.f, 0.f, 0.f, 0.f};
    const int ntiles = qblk * 2 + 2;
    const int iw = qblk * 2 + (w >> 2);
    const u16* ksrc = QK + (size_t)(b * SEQ) * LDQ + 512 + h * 64;
    const u16* vsrc = VT + (size_t)(h * 64) * MTOK + (size_t)b * SEQ;
    float qs = 0.f;
#pragma unroll
    for (int ks = 0; ks < 2; ++ks)
#pragma unroll
      for (int e = 0; e < 8; ++e) { const float v = bf2f((u16)q[ks][e]); qs += v * v; }
    qs += __shfl_xor(qs, 16); qs += __shfl_xor(qs, 32);
#pragma unroll
    for (int o2 = 1; o2 <= 8; o2 <<= 1) qs = fmaxf(qs, __shfl_xor(qs, o2));
    float* red = (float*)(lds + 256 * TS);
    if (lane == 0) red[w] = qs;
    __syncthreads();
    float qmax2 = red[0];
#pragma unroll
    for (int i = 1; i < NWAVE; ++i) qmax2 = fmaxf(qmax2, red[i]);
    const float kmax2 = __uint_as_float(((const uint32_t*)(p.ws + WS_KMAX))[h]);
    const float T2 = 2.f * scale2 * sqrtf(qmax2 * kmax2) * 1.001f + 48.f;
    const float cfirst2 = cfr[qblk * 128] * LOG2E;
    int i_lo = 0;
    for (int base = qblk * 2 - 1; base >= 0; base -= 64) {
      const int ti = base - lane;
      bool skip = false;
      if (ti >= 0) skip = (cfirst2 - cfr[ti * 64 + 63] * LOG2E) < -T2;
      const unsigned long long bal = __ballot(skip);
      if (bal) { i_lo = base - (int)__builtin_ctzll(bal) + 1; break; }
    }
    uint4 rk0, rv0;
    TILE_LD(rk, ksrc + (size_t)i_lo * 64 * LDQ, LDQ); TILE_LD(rv, vsrc + i_lo * 64, MTOK);
    TILE_ST(lds + (i_lo & 1) * (128 * TS), rk); TILE_STV(lds + (i_lo & 1) * (128 * TS) + 64 * TS, rv);
    __syncthreads();
    for (int i = i_lo; i < ntiles; ++i) {
      u16* cur = lds + (i & 1) * (128 * TS);
      const bool more = (i + 1 < ntiles);
      if (more) { TILE_LD(rk, ksrc + (size_t)(i + 1) * 64 * LDQ, LDQ); TILE_LD(rv, vsrc + (i + 1) * 64, MTOK); }
      if (i <= iw) {
        const int s0 = i * 64;
        const bool diag = (i == iw);
        f32x4 s[4];
        qk_tile(cur, q, s, l16, gk);
        float xv[4][4];
        float mx = -1e30f;
#pragma unroll
        for (int kt = 0; kt < 4; ++kt) {
          const float4 c4 = *(const float4*)(cfr + s0 + kt * 16 + gk * 4);
          const float ck[4] = {c4.x, c4.y, c4.z, c4.w};
#pragma unroll
          for (int r = 0; r < 4; ++r) {
            float v = fmaf(s[kt][r], scale2, cq2 - ck[r] * LOG2E);
            if (diag && (s0 + kt * 16 + gk * 4 + r > t)) v = -1e30f;
            xv[kt][r] = v; mx = fmaxf(mx, v);
          }
        }
        mx = fmaxf(mx, __shfl_xor(mx, 16)); mx = fmaxf(mx, __shfl_xor(mx, 32));
        const float mnew = fmaxf(m, mx);
        const float alpha = ex2(m - mnew);
        m = mnew;
        const float muse = fmaxf(mnew, -1e20f);
        float rs = 0.f;
#pragma unroll
        for (int kt = 0; kt < 4; ++kt)
#pragma unroll
          for (int r = 0; r < 4; ++r) { xv[kt][r] = ex2(xv[kt][r] - muse); rs += xv[kt][r]; }
        l = l * alpha + rs;
#pragma unroll
        for (int dt = 0; dt < 4; ++dt) o[dt] *= alpha;
        pv_tile(cur + 64 * TS, xv, o, l16, gk);
      }
      if (more) { u16* nxt = lds + ((i + 1) & 1) * (128 * TS); TILE_ST(nxt, rk); TILE_STV(nxt + 64 * TS, rv); }
      __syncthreads();
    }
    {
      float lt = l; lt += __shfl_xor(lt, 16); lt += __shfl_xor(lt, 32);
      const float inv = lt > 0.f ? 1.f / lt : 0.f;
      const size_t mrow = (size_t)(b * SEQ + t);
#pragma unroll
      for (int dt = 0; dt < 4; ++dt) {
        const int col = h * 64 + dt * 16 + gk * 4;
        const uint2 zz = *(const uint2*)(QK + mrow * LDQ + 2048 + col);
        const float z0 = bf2f(zz.x & 0xffff), z1 = bf2f(zz.x >> 16), z2 = bf2f(zz.y & 0xffff), z3 = bf2f(zz.y >> 16);
        uint2 ov;
        ov.x = pack2(o[dt][0] * inv * silu_f(z0), o[dt][1] * inv * silu_f(z1));
        ov.y = pack2(o[dt][2] * inv * silu_f(z2), o[dt][3] * inv * silu_f(z3));
        *(uint2*)(Y + mrow * DM + col) = ov;
      }
    }
  }
}

__device__ __forceinline__ void fox_knorm(const Params& p) {
  const u16* QK = (const u16*)(p.ws + WS_QK);
  uint32_t* km = (uint32_t*)(p.ws + WS_KMAX);
  const int tid = TIDX, lane = tid & 63, wave = tid >> 6;
  float mx = 0.f;
  for (int row = BIDX * NWAVE + wave; row < MTOK; row += gridDim.x * NWAVE) {
    const uint4 v = *(const uint4*)(QK + (size_t)row * LDQ + 512 + lane * 8);
    const float a0 = bf2f(v.x & 0xffff), a1 = bf2f(v.x >> 16), a2 = bf2f(v.y & 0xffff), a3 = bf2f(v.y >> 16);
    const float a4 = bf2f(v.z & 0xffff), a5 = bf2f(v.z >> 16), a6 = bf2f(v.w & 0xffff), a7 = bf2f(v.w >> 16);
    float ss = a0 * a0 + a1 * a1 + a2 * a2 + a3 * a3 + a4 * a4 + a5 * a5 + a6 * a6 + a7 * a7;
    ss += __shfl_xor(ss, 1); ss += __shfl_xor(ss, 2); ss += __shfl_xor(ss, 4);
    mx = fmaxf(mx, ss);
  }
  if ((lane & 7) == 0) atomicMax(&km[lane >> 3], __float_as_uint(mx));
}

__device__ __forceinline__ void fox_scan(const Params& p, float* ldsf) {
  const float* fl = (const float*)(p.ws + WS_FLOG);
  float* cf = (float*)(p.ws + WS_CFOX);
  double* sd = (double*)ldsf;
  const int tid = TIDX;
  for (int bh = BIDX; bh < 32; bh += gridDim.x) {
    const int b = bh >> 3, h = bh & 7;
    const float bf = p.e_bf[h];
    float ls[16];
    double sum = 0.0;
#pragma unroll
    for (int i = 0; i < 16; ++i) {
      const float xx = fl[(size_t)(b * SEQ + tid * 16 + i) * 8 + h] + bf;
      ls[i] = fminf(xx, 0.f) - log1pf(__expf(-fabsf(xx)));
      sum += (double)ls[i];
    }
    __syncthreads();
    sd[tid] = sum;
    __syncthreads();
    double pre = 0.0;
    for (int j = 0; j < tid; ++j) pre += sd[j];
#pragma unroll
    for (int i = 0; i < 16; ++i) { pre += (double)ls[i]; cf[(size_t)bh * SEQ + tid * 16 + i] = (float)pre; }
  }
}

__device__ __forceinline__ void ret_stepA(const Params& p) {
  const u16* VT = (const u16*)(p.ws + WS_VT);
  float* dS = (float*)(p.ws + WS_DS);
  const int tid_ = TIDX, lane = tid_ & 63, w8 = tid_ >> 6, w = w8 & 3, l16 = lane & 15, gk = lane >> 4;
  for (int u2 = BIDX; u2 < 1024; u2 += gridDim.x) {
    const int u = u2 * 2 + (w8 >> 2);
    const int bh = u >> 6, n = u & 63, b = bh >> 3, h = bh & 7;
    const size_t mcol = (size_t)b * SEQ + n * 128;
    f32x4 acc[4];
#pragma unroll
    for (int dt = 0; dt < 4; ++dt) acc[dt] = (f32x4){0.f, 0.f, 0.f, 0.f};
#pragma unroll
    for (int ks = 0; ks < 4; ++ks) {
      bf16x8 af = *(const bf16x8*)(VT + (size_t)(512 + h * 64 + w * 16 + l16) * MTOK + mcol + ks * 32 + gk * 8);
#pragma unroll
      for (int dt = 0; dt < 4; ++dt) {
        bf16x8 bfr = *(const bf16x8*)(VT + (size_t)(1024 + h * 64 + dt * 16 + l16) * MTOK + mcol + ks * 32 + gk * 8);
        acc[dt] = MFMA(af, bfr, acc[dt]);
      }
    }
#pragma unroll
    for (int dt = 0; dt < 4; ++dt)
#pragma unroll
      for (int r = 0; r < 4; ++r) dS[(size_t)u * 4096 + (w * 16 + gk * 4 + r) * 64 + dt * 16 + l16] = acc[dt][r];
  }
}
__device__ __forceinline__ void ret_stepB(const Params& p) {
  const float* dS = (const float*)(p.ws + WS_DS);
  u16* st = (u16*)(p.ws + WS_ST);
  for (int idx = BIDX * NTHR + TIDX; idx < 32 * 4096; idx += gridDim.x * NTHR) {
    const int bh = idx >> 12, ed = idx & 4095, h = bh & 7;
    const float cdec = __expf(log1pf(-exp2f(-5.f - (float)h)) * 128.f);
    float s = 0.f;
#pragma unroll 1
    for (int n0 = 0; n0 < 64; n0 += 16) {
      float d[16];
#pragma unroll
      for (int k = 0; k < 16; ++k) d[k] = dS[(size_t)(bh * 64 + n0 + k) * 4096 + ed];
#pragma unroll
      for (int k = 0; k < 16; ++k) {
        st[(size_t)(bh * 64 + n0 + k) * 4096 + ed] = f2bf(s);
        s = s * cdec + d[k];
      }
    }
  }
}
__device__ __forceinline__ void ret_stepC(const Params& p, u16* lds) {
  const u16* QK = (const u16*)(p.ws + WS_QK);
  const u16* VT = (const u16*)(p.ws + WS_VT);
  const u16* st = (const u16*)(p.ws + WS_ST);
  u16* Y = (u16*)(p.ws + WS_Y);
  const int tid = TIDX, lane = tid & 63, w = tid >> 6, l16 = lane & 15, gk = lane >> 4;
  for (int u = BIDX; u < 2048; u += gridDim.x) {
    const int bh = u >> 6, n = u & 63, b = bh >> 3, h = bh & 7;
    const size_t m0 = (size_t)b * SEQ + n * 128;
    const float lg2 = log1pf(-exp2f(-5.f - (float)h)) * LOG2E;
    __syncthreads();
    {
      uint4 r0;
      TILE_LD(r, QK + m0 * LDQ + 1536 + h * 64, LDQ); TILE_ST(lds, r);
      TILE_LD(r, VT + (size_t)(512 + h * 64) * MTOK + m0, MTOK); TILE_STV(lds + 64 * TS, r);
      TILE_LD(r, QK + (m0 + 64) * LDQ + 1536 + h * 64, LDQ); TILE_ST(lds + 128 * TS, r);
      TILE_LD(r, VT + (size_t)(512 + h * 64) * MTOK + m0 + 64, MTOK); TILE_STV(lds + 192 * TS, r);
      TILE_LD(r, st + (size_t)u * 4096, 64); TILE_ST(lds + 256 * TS, r);
    }
    __syncthreads();
    const int iq = 16 * w + l16;
    const size_t mrow = m0 + iq;
    bf16x8 q[2];
#pragma unroll
    for (int ks = 0; ks < 2; ++ks) q[ks] = *(const bf16x8*)(QK + mrow * LDQ + 1024 + h * 64 + ks * 32 + gk * 8);
    f32x4 o[4];
#pragma unroll
    for (int dt = 0; dt < 4; ++dt) o[dt] = (f32x4){0.f, 0.f, 0.f, 0.f};
#pragma unroll
    for (int dt = 0; dt < 4; ++dt)
#pragma unroll
      for (int ks = 0; ks < 2; ++ks) {
        bf16x8 sf = *(const bf16x8*)(lds + 256 * TS + (dt * 16 + l16) * TS + ks * 32 + gk * 8);
        o[dt] = MFMA(sf, q[ks], o[dt]);
      }
    const float cross = ex2(lg2 * (float)(iq + 1));
#pragma unroll
    for (int dt = 0; dt < 4; ++dt) o[dt] *= cross;
#pragma unroll
    for (int k64 = 0; k64 < 2; ++k64) {
      if (k64 * 64 <= 16 * w + 15) {
        f32x4 s[4];
        qk_tile(lds + k64 * 128 * TS, q, s, l16, gk);
        float pp[4][4];
#pragma unroll
        for (int kt = 0; kt < 4; ++kt)
#pragma unroll
          for (int r = 0; r < 4; ++r) {
            const int j = k64 * 64 + kt * 16 + gk * 4 + r;
            pp[kt][r] = (j <= iq) ? s[kt][r] * 0.125f * ex2(lg2 * (float)(iq - j)) : 0.f;
          }
        pv_tile(lds + k64 * 128 * TS + 64 * TS, pp, o, l16, gk);
      }
    }
    float sm = 0.f;
#pragma unroll
    for (int dt = 0; dt < 4; ++dt) sm += o[dt][0] + o[dt][1] + o[dt][2] + o[dt][3];
    sm += __shfl_xor(sm, 16); sm += __shfl_xor(sm, 32);
    const float mu = sm * (1.f / 64.f);
    float vs = 0.f;
#pragma unroll
    for (int dt = 0; dt < 4; ++dt)
#pragma unroll
      for (int r = 0; r < 4; ++r) { const float d = o[dt][r] - mu; vs += d * d; }
    vs += __shfl_xor(vs, 16); vs += __shfl_xor(vs, 32);
    const float rstd = rsqrtf(vs * (1.f / 64.f) + 1e-5f);
#pragma unroll
    for (int dt = 0; dt < 4; ++dt) {
      const int col = h * 64 + dt * 16 + gk * 4;
      const float4 gg = *(const float4*)(p.e_gn + col);
      const uint2 zz = *(const uint2*)(QK + mrow * LDQ + 2048 + 512 + col);
      const float z0 = bf2f(zz.x & 0xffff), z1 = bf2f(zz.x >> 16), z2 = bf2f(zz.y & 0xffff), z3 = bf2f(zz.y >> 16);
      uint2 ov;
      ov.x = pack2((o[dt][0] - mu) * rstd * gg.x * silu_f(z0), (o[dt][1] - mu) * rstd * gg.y * silu_f(z1));
      ov.y = pack2((o[dt][2] - mu) * rstd * gg.z * silu_f(z2), (o[dt][3] - mu) * rstd * gg.w * silu_f(z3));
      *(uint2*)(Y + mrow * DM + 512 + col) = ov;
    }
  }
}

__device__ __forceinline__ void nsa_tile_interior(const u16* sK, const u16* sV, const bf16x8 (&q)[2], f32x4 (&acc)[4],
                                                  float& m, float& l, float slope2, const float (&sk)[16],
                                                  int t, int pos0, bool lanesel, int lane, bool fixm) {
  const int l16 = lane & 15, gk = lane >> 4;
  const float scale2 = 0.125f * LOG2E;
  f32x4 s[4];
  qk_tile(sK, q, s, l16, gk);
  const float c0 = fmaf(-slope2, (float)(t - pos0 - gk * 4), lanesel ? 0.f : -1e30f);
  float xv[4][4];
  float mx = -1e30f;
#pragma unroll
  for (int kt = 0; kt < 4; ++kt)
#pragma unroll
    for (int r = 0; r < 4; ++r) { xv[kt][r] = fmaf(s[kt][r], scale2, sk[kt * 4 + r]); mx = fmaxf(mx, xv[kt][r]); }
  if (fixm) {
    const float offf = c0 - m;
    float rsf = 0.f;
#pragma unroll
    for (int kt = 0; kt < 4; ++kt)
#pragma unroll
      for (int r = 0; r < 4; ++r) { xv[kt][r] = ex2(xv[kt][r] + offf); rsf += xv[kt][r]; }
    l += rsf;
    pv_tile(sV, xv, acc, l16, gk);
    return;
  }
  mx += c0;
  mx = fmaxf(mx, __shfl_xor(mx, 16)); mx = fmaxf(mx, __shfl_xor(mx, 32));
  const float mnew = fmaxf(m, mx);
  const float alpha = ex2(m - mnew);
  m = mnew;
  const float off = c0 - fmaxf(mnew, -1e20f);
  float rs = 0.f;
#pragma unroll
  for (int kt = 0; kt < 4; ++kt)
#pragma unroll
    for (int r = 0; r < 4; ++r) { xv[kt][r] = ex2(xv[kt][r] + off); rs += xv[kt][r]; }
  l = l * alpha + rs;
  if (__any(alpha != 1.f)) {
#pragma unroll
    for (int dt = 0; dt < 4; ++dt) acc[dt] *= alpha;
  }
  pv_tile(sV, xv, acc, l16, gk);
}
template <int BR>
__device__ __forceinline__ void nsa_tile(const u16* sK, const u16* sV, const bf16x8 (&q)[2], f32x4 (&acc)[4],
                                         float& m, float& l, float slope2, float gmul,
                                         int t, int pos0, int pstride, int wl, bool lanesel,
                                         float* imp_row, int jbase, float& carry, int lane, float* imp_scale = nullptr, bool fixm = false) {
  const int l16 = lane & 15, gk = lane >> 4;
  const float scale2 = 0.125f * LOG2E;
  const unsigned wle = lanesel ? (unsigned)wl : 0u;
  f32x4 s[4];
  qk_tile(sK, q, s, l16, gk);
  float xv[4][4];
  float mx = -1e30f;
#pragma unroll
  for (int kt = 0; kt < 4; ++kt)
#pragma unroll
    for (int r = 0; r < 4; ++r) {
      const int dist = t - (pos0 + (kt * 16 + gk * 4 + r) * pstride);
      const float pen = ((unsigned)dist < wle) ? 0.f : -1e30f;
      const float v = fmaf(s[kt][r], scale2, fmaf(-slope2, (float)dist, pen));
      xv[kt][r] = v; mx = fmaxf(mx, v);
    }
  if (BR == 2 && fixm) {
    float rsf = 0.f;
#pragma unroll
    for (int kt = 0; kt < 4; ++kt)
#pragma unroll
      for (int r = 0; r < 4; ++r) { xv[kt][r] = ex2(xv[kt][r] - m); rsf += xv[kt][r]; }
    l += rsf;
    pv_tile(sV, xv, acc, l16, gk);
    return;
  }
  if (BR != 1) {
    mx = fmaxf(mx, __shfl_xor(mx, 16)); mx = fmaxf(mx, __shfl_xor(mx, 32));
    const float mnew = fmaxf(m, mx);
    const float alpha = ex2(m - mnew);
    m = mnew;
    const float muse = fmaxf(mnew, -1e20f);
    float rs = 0.f;
#pragma unroll
    for (int kt = 0; kt < 4; ++kt)
#pragma unroll
      for (int r = 0; r < 4; ++r) { xv[kt][r] = ex2(xv[kt][r] - muse); rs += xv[kt][r]; }
    l = l * alpha + rs;
    if (BR == 2 || BR == 3) {
#pragma unroll
      for (int dt = 0; dt < 4; ++dt) acc[dt] *= alpha;
    }
    if (BR == 3) {
      float p3[4];
#pragma unroll
      for (int kt = 0; kt < 4; ++kt) {
        p3[kt] = xv[kt][3];
        imp_row[jbase + kt * 4 + gk] = 2.f * (xv[kt][0] + xv[kt][1] + xv[kt][2]) + xv[kt][3];
      }
      const int srcl = (lane + 48) & 63;
      const float carry_s = carry * alpha;
#pragma unroll
      for (int kt = 0; kt < 4; ++kt) {
        const float same = __shfl(p3[kt], srcl);
        const float prev = __shfl(kt > 0 ? p3[kt > 0 ? kt - 1 : 0] : carry_s, srcl);
        imp_row[jbase + kt * 4 + gk] += (gk == 0) ? prev : same;
      }
      carry = p3[3];
      if (gk == 0) *imp_scale = mnew;
    }
    if (BR == 2 || BR == 3) pv_tile(sV, xv, acc, l16, gk);
  } else {
    const float muse = fmaxf(m, -1e20f);
    float p3[4];
#pragma unroll
    for (int kt = 0; kt < 4; ++kt) {
      float pn[4];
#pragma unroll
      for (int r = 0; r < 4; ++r) { pn[r] = ex2(xv[kt][r] - muse) * l; xv[kt][r] = pn[r] * gmul; }
      p3[kt] = pn[3];
      xv[kt][0] = xv[kt][0];
      imp_row[jbase + kt * 4 + gk] = 2.f * (pn[0] + pn[1] + pn[2]) + pn[3];
    }
    const int srcl = (lane + 48) & 63;
#pragma unroll
    for (int kt = 0; kt < 4; ++kt) {
      const float same = __shfl(p3[kt], srcl);
      const float prev = __shfl(kt > 0 ? p3[kt > 0 ? kt - 1 : 0] : carry, srcl);
      imp_row[jbase + kt * 4 + gk] += (gk == 0) ? prev : same;
    }
    carry = p3[3];
    pv_tile(sV, xv, acc, l16, gk);
  }
}

__device__ __forceinline__ void nsa_phase(const Params& p, u16* lds) {
  const u16* U = (const u16*)(p.ws + WS_QK);
  const u16* VT = (const u16*)(p.ws + WS_VT);
  const u16* KC = (const u16*)(p.ws + WS_KCMP);
  const u16* VC = (const u16*)(p.ws + WS_VCMPT);
  const float* GL = (const float*)(p.ws + WS_GL);
  u16* Y = (u16*)(p.ws + WS_Y);
  float* imp = (float*)(lds + 512 * TS);
  uint32_t* umask = (uint32_t*)(imp + 128 * IMPS);
  int* ulist = (int*)(umask + 4);
  const int tid = TIDX, lane = tid & 63, w = tid >> 6, l16 = lane & 15, gk = lane >> 4;
  const int qt = w & 1, hd = w >> 1;
  uint2* totl = (uint2*)imp + 128 + (size_t)w * 256 + lane;
  const int BIG = 1 << 30;
  int* uslot = ulist + 128;
  unsigned* uctr = (unsigned*)(p.ws + WS_KMAX) + 24;
  for (;;) {
    __syncthreads();
    if (tid == 0) uslot[0] = (int)atomicAdd(uctr, 1u);
    __syncthreads();
    const int unit = uslot[0];
    if (unit >= 4096) break;
    const int bg = unit & 15, qh = 255 - (unit >> 4), b = bg >> 2, g = bg & 3;
    const int t0 = qh * 32, qb = t0 >> 6, t = t0 + 16 * qt + l16;
    const size_t mrow = (size_t)b * SEQ + t;
    const int h = g * 4 + hd;
    bf16x8 q[2];
#pragma unroll
    for (int ks = 0; ks < 2; ++ks) q[ks] = *(const bf16x8*)(U + mrow * LDQ + h * 64 + ks * 32 + gk * 8);
    const float slope2 = exp2f(-0.5f * (float)(h + 1)) * LOG2E;
    const float g1 = sigmoid_f(GL[mrow * 48 + h * 3] + p.o_bg[h * 3]);
    float sk[16];
#pragma unroll
    for (int i = 0; i < 16; ++i) sk[i] = slope2 * (float)((i >> 2) * 16 + (i & 3));
    float qn2 = 0.f;
#pragma unroll
    for (int ks = 0; ks < 2; ++ks)
#pragma unroll
      for (int e = 0; e < 8; ++e) { const float v = bf2f((u16)q[ks][e]); qn2 += v * v; }
    qn2 += __shfl_xor(qn2, 16); qn2 += __shfl_xor(qn2, 32);
#pragma unroll
    for (int o2 = 1; o2 <= 8; o2 <<= 1) qn2 = fmaxf(qn2, __shfl_xor(qn2, o2));
    const uint32_t* kmx = (const uint32_t*)(p.ws + WS_KMAX);
    const float sc2 = 0.125f * LOG2E;
    const float T_slc = 2.02f * sc2 * sqrtf(qn2 * __uint_as_float(kmx[8 + g])) + 48.f;
    const float T_win = 2.02f * sc2 * sqrtf(qn2 * __uint_as_float(kmx[12 + g])) + 48.f;
    const float T_cmp = 2.05f * sc2 * sqrtf(qn2 * __uint_as_float(kmx[16 + g])) + 16.f * slope2 + 48.f;
    const int tq0w = t0 + 16 * qt;
    const float mfix_slc = 1.01f * sc2 * sqrtf(qn2 * __uint_as_float(kmx[8 + g])), mfix_win = 1.01f * sc2 * sqrtf(qn2 * __uint_as_float(kmx[12 + g]));
    f32x4 acc[4];
    float m = -1e30f, l = 0.f;
#pragma unroll
    for (int dt = 0; dt < 4; ++dt) acc[dt] = (f32x4){0.f, 0.f, 0.f, 0.f};
    __syncthreads();
    for (int i = tid; i < 128 * IMPS; i += NTHR) imp[i] = 0.f;
    if (tid < 4) umask[tid] = 0u;
    float* imp_row = imp + (hd * 32 + 16 * qt + l16) * IMPS;
    float carry = 0.f;
    uint4 rk0, rk1, rk2, rk3, rv0, rv1, rv2, rv3;
    u16* impbase_unused = nullptr; (void)impbase_unused;
#define SLOT(k) (lds + (k) * (128 * TS))
#define LD1(k, kp, ks_, vp, vs_) { rk##k = *(const uint4*)((kp) + (long)(tid >> 3) * (ks_) + (tid & 7) * 8); rv##k = *(const uint4*)((vp) + (long)(tid >> 3) * (vs_) + (tid & 7) * 8); }
#define ST1(k) { *(uint4*)(SLOT(k) + (tid >> 3) * TS + (tid & 7) * 8) = rk##k; TILE_STV_(SLOT(k) + 64 * TS, rv##k) }
    const int ntc = ((t0 >> 4) >> 6) + 1;
    const u16* kcs = KC + (size_t)bg * 512 * 64;
    const u16* vcs = VC + (size_t)bg * 32768;
#define CMP_LD(k, i) if ((i) < ntc) LD1(k, kcs + (size_t)(i) * 64 * 64, 64, vcs + (i) * 64, 512)
    float* mrec = (float*)(uslot + 4) + (w * 16 + l16) * 8;
    {
      const int ngrp = (ntc + 3) >> 2;
      CMP_LD(0, 0) CMP_LD(1, 1) CMP_LD(2, 2) CMP_LD(3, 3)
#pragma unroll 1
      for (int gi = 0; gi < ngrp; ++gi) {
        const int ib = gi * 4;
        __syncthreads();
        if (ib < ntc) ST1(0) if (ib + 1 < ntc) ST1(1) if (ib + 2 < ntc) ST1(2) if (ib + 3 < ntc) ST1(3)
        __syncthreads();
        if (gi + 1 < ngrp) { CMP_LD(0, ib + 4) CMP_LD(1, ib + 5) CMP_LD(2, ib + 6) CMP_LD(3, ib + 7) }
#pragma unroll 1
        for (int k = 0; k < 4; ++k) {
          const int i = ib + k;
          if (i < ntc) {
            const int dmin = tq0w - (16 * (64 * i + 63) + 31);
            if (dmin > 0 && slope2 * (float)dmin > T_cmp) { carry = 0.f; if (gk == 0) mrec[i] = -1e30f; continue; }
            nsa_tile<3>(SLOT(k), SLOT(k) + 64 * TS, q, acc, m, l, slope2, g1, t, 16 * (64 * i) + 31, 16, BIG, true, imp_row, 16 * i, carry, lane, mrec + i);
          }
        }
      }
      float lt = l; lt += __shfl_xor(lt, 16); lt += __shfl_xor(lt, 32);
      const float inv = lt > 0.f ? 1.f / lt : 0.f;
      const float mfin = fmaxf(m, -1e20f);
#pragma unroll 1
      for (int i = 0; i < ntc; ++i) {
        const float f = ex2(fmaxf(mrec[i], -1e20f) - mfin) * inv;
#pragma unroll
        for (int kt = 0; kt < 4; ++kt) imp_row[16 * i + kt * 4 + gk] *= f;
      }
      const float og = g1 * inv;
#pragma unroll
      for (int dt = 0; dt < 4; ++dt) acc[dt] *= og;
    }
    __syncthreads();
    {
      const int qi = w * 4 + gk;
      const int c8 = l16 * 8;
      uint32_t selb = 0u;
      if (qb < 16) {
#pragma unroll
        for (int i = 0; i < 8; ++i) if (c8 + i <= qb) selb |= (1u << i);
      } else {
        float val[8];
        const float* ra = imp + qi * IMPS + c8;
#pragma unroll
        for (int i4 = 0; i4 < 2; ++i4) {
          const float4 v0 = *(const float4*)(ra + 4 * i4);
          const float4 v1 = *(const float4*)(ra + 32 * IMPS + 4 * i4);
          const float4 v2 = *(const float4*)(ra + 64 * IMPS + 4 * i4);
          const float4 v3 = *(const float4*)(ra + 96 * IMPS + 4 * i4);
          val[4 * i4] = ((v0.x + v1.x) + v2.x) + v3.x; val[4 * i4 + 1] = ((v0.y + v1.y) + v2.y) + v3.y;
          val[4 * i4 + 2] = ((v0.z + v1.z) + v2.z) + v3.z; val[4 * i4 + 3] = ((v0.w + v1.w) + v2.w) + v3.w;
        }
#pragma unroll
        for (int i = 0; i < 8; ++i) {
          const int j = c8 + i;
          const bool forced = (j == 0) || (j == qb) || (j == qb - 1);
          if (forced) selb |= (1u << i);
          if (forced || j > qb) val[i] = -1.f;
        }
#pragma unroll 1
        for (int it = 0; it < 13; ++it) {
          float best = -2.f; int bj = 0;
#pragma unroll
          for (int i = 0; i < 8; ++i) {
            const float v = ((selb >> i) & 1u) ? -1.f : val[i];
            if (v > best) { best = v; bj = c8 + i; }
          }
#define TOPK_STEP(N) { const float ov = dpp_ror_f<N>(best); const int oj = dpp_ror_i<N>(bj); if (ov > best || (ov == best && oj < bj)) { best = ov; bj = oj; } }
          TOPK_STEP(1) TOPK_STEP(2) TOPK_STEP(4) TOPK_STEP(8)
#undef TOPK_STEP
          if ((bj >> 3) == l16) selb |= (1u << (bj & 7));
        }
      }
      uint32_t wd = selb << ((l16 & 3) * 8);
      wd |= (uint32_t)dpp_xor1_i((int)wd); wd |= (uint32_t)dpp_xor2_i((int)wd);
      __syncthreads();
      uint32_t* selw = (uint32_t*)imp;
      if ((l16 & 3) == 0) selw[qi * 4 + (l16 >> 2)] = wd;
      uint32_t uq = wd; uq |= __shfl_xor(uq, 16); uq |= __shfl_xor(uq, 32);
      if (gk == 0 && (l16 & 3) == 0) atomicOr(&umask[l16 >> 2], uq);
    }
    __syncthreads();
    const uint32_t* selq = (const uint32_t*)imp + (16 * qt + l16) * 4;
    const uint32_t sel0 = selq[0], sel1 = selq[1], sel2 = selq[2], sel3 = selq[3];
    uint32_t wun0 = sel0, wun1 = sel1, wun2 = sel2, wun3 = sel3;
#define OR_ROW(N) { wun0 |= (uint32_t)dpp_ror_i<N>((int)wun0); wun1 |= (uint32_t)dpp_ror_i<N>((int)wun1); wun2 |= (uint32_t)dpp_ror_i<N>((int)wun2); wun3 |= (uint32_t)dpp_ror_i<N>((int)wun3); }
    OR_ROW(1) OR_ROW(2) OR_ROW(4) OR_ROW(8)
#undef OR_ROW
    int nsl = 0;
    {
      const uint32_t u0 = umask[0], u1 = umask[1], u2 = umask[2], u3 = umask[3];
      nsl = __popc(u0) + __popc(u1) + __popc(u2) + __popc(u3);
      if (tid < 128) {
        const uint32_t uw = tid < 32 ? u0 : tid < 64 ? u1 : tid < 96 ? u2 : u3;
        if ((uw >> (tid & 31)) & 1u) {
          int pos = __popc(uw & ((1u << (tid & 31)) - 1u));
          if (tid >= 32) pos += __popc(u0);
          if (tid >= 64) pos += __popc(u1);
          if (tid >= 96) pos += __popc(u2);
          ulist[pos] = tid;
        }
      }
    }
    __syncthreads();
#pragma unroll
    for (int dt = 0; dt < 4; ++dt) {
      uint2 o2; o2.x = pack2(acc[dt][0], acc[dt][1]); o2.y = pack2(acc[dt][2], acc[dt][3]);
      totl[dt * 64] = o2;
    }
#pragma unroll 1
    for (int br = 1; br < 3; ++br) {
      const float mfix = (br == 1) ? mfix_slc : mfix_win;
      const bool fixm = mfix < 50.f;
      m = fixm ? mfix : -1e30f; l = 0.f;
#pragma unroll
      for (int dt = 0; dt < 4; ++dt) acc[dt] = (f32x4){0.f, 0.f, 0.f, 0.f};
      int wfirst = ((t0 - 511) >> 6) << 6; if (wfirst < 0) wfirst = 0;
      const int nt = (br == 1) ? nsl : ((qb * 64 - wfirst) >> 6) + 1;
      const int ngrp = (nt + 3) >> 2;
      const u16* kb = U + (size_t)b * SEQ * LDQ + (br == 1 ? 1536 : 1792) + g * 64;
      const u16* vb = VT + (size_t)((br == 1 ? 0 : 256) + g * 64) * MTOK + (size_t)b * SEQ;
#define SRC_S0(i) ((br == 1) ? ulist[nt - 1 - (i)] * 64 : wfirst + 64 * (nt - 1 - (i)))
#define BR_LD(k, i) if ((i) < nt) { const int s_ = SRC_S0(i); LD1(k, kb + (size_t)s_ * LDQ, LDQ, vb + s_, MTOK) }
      BR_LD(0, 0) BR_LD(1, 1) BR_LD(2, 2) BR_LD(3, 3)
#pragma unroll 1
      for (int gi = 0; gi < ngrp; ++gi) {
        const int ib = gi * 4;
        __syncthreads();
        if (ib < nt) ST1(0) if (ib + 1 < nt) ST1(1) if (ib + 2 < nt) ST1(2) if (ib + 3 < nt) ST1(3)
        __syncthreads();
        if (gi + 1 < ngrp) { BR_LD(0, ib + 4) BR_LD(1, ib + 5) BR_LD(2, ib + 6) BR_LD(3, ib + 7) }
#pragma unroll 1
        for (int k = 0; k < 4; ++k) {
          const int i = ib + k;
          if (i < nt) {
            const int s0 = SRC_S0(i);
            bool wsel = true, ls = true;
            int wl = 512;
            if (br == 1) {
              const int j = s0 >> 6, jw = j >> 5, jb = j & 31;
              const uint32_t ww = jw == 0 ? wun0 : jw == 1 ? wun1 : jw == 2 ? wun2 : wun3;
              const uint32_t sw = jw == 0 ? sel0 : jw == 1 ? sel1 : jw == 2 ? sel2 : sel3;
              wsel = (ww >> jb) & 1u; ls = (sw >> jb) & 1u; wl = BIG;
            }
            if (wsel) {
              const int dminw = tq0w - (s0 + 63);
              if (dminw > 0 && slope2 * (float)dminw > (br == 1 ? T_slc : T_win)) wsel = false;
            }
            if (wsel) {
              const int tq0 = t0 + 16 * qt;
              const bool interior = (s0 + 63 <= tq0) && (br == 1 || s0 + 512 > tq0 + 15);
              if (interior) nsa_tile_interior(SLOT(k), SLOT(k) + 64 * TS, q, acc, m, l, slope2, sk, t, s0, ls, lane, fixm);
              else nsa_tile<2>(SLOT(k), SLOT(k) + 64 * TS, q, acc, m, l, slope2, g1, t, s0, 1, wl, ls, imp_row, 0, carry, lane, nullptr, fixm);
            }
          }
        }
      }
      {
        float lt = l; lt += __shfl_xor(lt, 16); lt += __shfl_xor(lt, 32);
        const float gt = sigmoid_f(GL[mrow * 48 + h * 3 + br] + p.o_bg[h * 3 + br]);
        const float sc = lt > 0.f ? gt / lt : 0.f;
#pragma unroll
        for (int dt = 0; dt < 4; ++dt) {
          const uint2 pv = totl[dt * 64];
          const float r0 = bf2f(pv.x & 0xffff) + acc[dt][0] * sc, r1 = bf2f(pv.x >> 16) + acc[dt][1] * sc;
          const float r2 = bf2f(pv.y & 0xffff) + acc[dt][2] * sc, r3 = bf2f(pv.y >> 16) + acc[dt][3] * sc;
          if (br == 1) {
            uint2 o2; o2.x = pack2(r0, r1); o2.y = pack2(r2, r3);
            totl[dt * 64] = o2;
          } else {
            const int col = h * 64 + dt * 16 + gk * 4;
            const uint2 zz = *(const uint2*)(U + mrow * LDQ + 2048 + col);
            const float z0 = bf2f(zz.x & 0xffff), z1 = bf2f(zz.x >> 16), z2 = bf2f(zz.y & 0xffff), z3 = bf2f(zz.y >> 16);
            uint2 ov;
            ov.x = pack2(r0 * silu_f(z0), r1 * silu_f(z1));
            ov.y = pack2(r2 * silu_f(z2), r3 * silu_f(z3));
            *(uint2*)(Y + mrow * DM + col) = ov;
          }
        }
      }
    }
#undef SLOT
#undef LD1
#undef ST1
#undef CMP_LD
#undef SRC_S0
#undef BR_LD
  }
}

__device__ __forceinline__ void final_norm(const Params& p) {
  const int lane = TIDX & 63, wave = TIDX >> 6;
  const int nrw = gridDim.x * NWAVE;
  for (int row = BIDX * NWAVE + wave; row < MTOK; row += 2 * nrw) {
    const bool two = (row + nrw < MTOK);
    float4* xr0 = (float4*)(p.out + (size_t)row * DM);
    float4* xr1 = (float4*)(p.out + (size_t)(two ? row + nrw : row) * DM);
    float4 v0[4], v1[4];
    float s0 = 0.f, s1 = 0.f;
#pragma unroll
    for (int i = 0; i < 4; ++i) { v0[i] = xr0[lane + 64 * i]; v1[i] = xr1[lane + 64 * i]; }
#pragma unroll
    for (int i = 0; i < 4; ++i) {
      s0 += v0[i].x * v0[i].x + v0[i].y * v0[i].y + v0[i].z * v0[i].z + v0[i].w * v0[i].w;
      s1 += v1[i].x * v1[i].x + v1[i].y * v1[i].y + v1[i].z * v1[i].z + v1[i].w * v1[i].w;
    }
#pragma unroll
    for (int o = 32; o >= 1; o >>= 1) { s0 += __shfl_xor(s0, o); s1 += __shfl_xor(s1, o); }
    const float r0 = rsqrtf(s0 * (1.f / DM) + 1e-6f), r1 = rsqrtf(s1 * (1.f / DM) + 1e-6f);
#pragma unroll
    for (int i = 0; i < 4; ++i) {
      const float4 gg = ((const float4*)p.fin_g)[lane + 64 * i];
      xr0[lane + 64 * i] = (float4){v0[i].x * r0 * gg.x, v0[i].y * r0 * gg.y, v0[i].z * r0 * gg.z, v0[i].w * r0 * gg.w};
      if (two) xr1[lane + 64 * i] = (float4){v1[i].x * r1 * gg.x, v1[i].y * r1 * gg.y, v1[i].z * r1 * gg.z, v1[i].w * r1 * gg.w};
    }
  }
}

#define XB_XCNT(j)  (64 * (j))
#define XB_XSUB(j)  (1024 + 64 * (j))
#define XB_XGEN(j)  (2048 + 64 * (j))
#define XB_TOP      3072
#define XB_TOPGEN   3136
#define XB_WORDS    3200
#define LAS __attribute__((address_space(3)))
__device__ __forceinline__ unsigned xb_ld(unsigned* q) { return __hip_atomic_load(q, __ATOMIC_RELAXED, __HIP_MEMORY_SCOPE_AGENT); }
__device__ __forceinline__ unsigned xb_add(unsigned* q, unsigned v) { return __hip_atomic_fetch_add(q, v, __ATOMIC_RELAXED, __HIP_MEMORY_SCOPE_AGENT); }
__device__ __forceinline__ unsigned xb_xcc_id() { return (unsigned)__builtin_amdgcn_s_getreg((3 << 11) | 20) & 0xFu; }
__device__ __forceinline__ void grid_bar(const Params& p, unsigned xcc, volatile unsigned* st) {
  asm volatile("s_waitcnt vmcnt(0)" ::: "memory");
  __syncthreads();
  if (TIDX == 0) {
    unsigned* bar = (unsigned*)(p.ws + WS_BAR);
    __builtin_amdgcn_s_waitcnt(0);
    unsigned nloc = st[0], nx = st[1];
    if (nloc == 0u) {
      const unsigned G = gridDim.x;
      for (;;) {
        unsigned sum = 0u, cnt = 0u, mine = 0u, below = 0u;
#pragma unroll
        for (unsigned j = 0; j < 16; ++j) { const unsigned c = xb_ld(&bar[XB_XCNT(j)]); sum += c; cnt += (c > 0u) ? 1u : 0u; mine = (j == xcc) ? c : mine; below += (j < xcc && c > 0u) ? 1u : 0u; }
        nloc = mine; nx = cnt; st[3] = below;
        if (sum == G) break;
        __builtin_amdgcn_s_sleep(1);
      }
      st[0] = nloc; st[1] = nx;
    }
    const unsigned old = xb_add(&bar[XB_XSUB(xcc)], 1u);
    const unsigned gen = old / nloc;
    if (old + 1u == (gen + 1u) * nloc) {
      __builtin_amdgcn_fence(__ATOMIC_RELEASE, "agent");
      asm volatile("s_waitcnt vmcnt(0)" ::: "memory");
      const unsigned og = xb_add(&bar[XB_TOP], 1u);
      const unsigned tg = og / nx;
      if (og + 1u == (tg + 1u) * nx) xb_add(&bar[XB_TOPGEN], 1u);
      else while (xb_ld(&bar[XB_TOPGEN]) == tg) __builtin_amdgcn_s_sleep(1);
      __builtin_amdgcn_fence(__ATOMIC_ACQUIRE, "agent");
      xb_add(&bar[XB_XGEN(xcc)], 1u);
      asm volatile("s_waitcnt vmcnt(0)" ::: "memory");
    } else {
      while (xb_ld(&bar[XB_XGEN(xcc)]) == gen) __builtin_amdgcn_s_sleep(1);
      __builtin_amdgcn_fence(__ATOMIC_ACQUIRE, "agent");
      asm volatile("s_waitcnt vmcnt(0)" ::: "memory");
    }
  }
  __syncthreads();
}

__device__ __forceinline__ void nsa_knorm(const Params& p) {
  if (BIDX < 64) return;
  const u16* U = (const u16*)(p.ws + WS_QK);
  uint32_t* km = (uint32_t*)(p.ws + WS_KMAX);
  const int tid = TIDX, lane = tid & 63, wave = tid >> 6;
  float mx = 0.f;
  for (int row = (BIDX - 64) * NWAVE + wave; row < MTOK; row += (gridDim.x - 64) * NWAVE) {
    const uint4 v = *(const uint4*)(U + (size_t)row * LDQ + 1536 + lane * 8);
    const float a0 = bf2f(v.x & 0xffff), a1 = bf2f(v.x >> 16), a2 = bf2f(v.y & 0xffff), a3 = bf2f(v.y >> 16);
    const float a4 = bf2f(v.z & 0xffff), a5 = bf2f(v.z >> 16), a6 = bf2f(v.w & 0xffff), a7 = bf2f(v.w >> 16);
    float ss = a0 * a0 + a1 * a1 + a2 * a2 + a3 * a3 + a4 * a4 + a5 * a5 + a6 * a6 + a7 * a7;
    ss += __shfl_xor(ss, 1); ss += __shfl_xor(ss, 2); ss += __shfl_xor(ss, 4);
    mx = fmaxf(mx, ss);
  }
  if ((lane & 7) == 0) atomicMax(&km[8 + (lane >> 3)], __float_as_uint(mx));
}

__global__ void __launch_bounds__(NTHR, 2) mega(Params p_in) {
  Params p = p_in;
  p.pad = __builtin_amdgcn_readfirstlane((int)threadIdx.x >> 6);
  extern __shared__ __attribute__((aligned(16))) unsigned char lds_raw[];
  u16* lds = (u16*)lds_raw;
  const unsigned xcc = xb_xcc_id();
  volatile unsigned* bst = (volatile unsigned*)(lds_raw + 147456);
  if (threadIdx.x < 4) bst[threadIdx.x] = 0u;
  __syncthreads();
  if (p_in.coop && threadIdx.x == 0) bst[2] = xb_add((unsigned*)(p_in.ws + WS_BAR) + XB_XCNT(xcc), 1u);
  __syncthreads();
  cg::grid_group grid = cg::this_grid();
  if (p_in.coop == 2) grid.sync();
#define PH_ON(k) (p.ph_lo <= (k) && (k) <= p.ph_hi)
#define PH_SYNC(k) if (p.coop && p.ph_lo <= (k) && (k) < p.ph_hi) grid_bar(p, xcc, bst);
  if (PH_ON(0)) {
    rms_rows_fl(p, (float*)lds);
    conv_t(p, (u16*)(p.ws + WS_WT0), p.e_win, 1024, 4104, 4352, 0);
    conv_t(p, (u16*)(p.ws + WS_WT1), p.o_win, 1024, 3632, 3840, 1);
    conv_t(p, (u16*)(p.ws + WS_WO0), p.e_wout, 1024, 1024, 1024, 2);
    conv_t(p, (u16*)(p.ws + WS_WO1), p.o_wout, 1024, 1024, 1024, 2);
    conv_t(p, (u16*)(p.ws + WS_W1K), p.o_wk1, 2048, 256, 256, 2);
    conv_t(p, (u16*)(p.ws + WS_W1V), p.o_wv1, 2048, 256, 256, 2);
    conv_t(p, (u16*)(p.ws + WS_W2K), p.o_wk2, 256, 64, 256, 2);
    conv_t(p, (u16*)(p.ws + WS_W2V), p.o_wv2, 256, 64, 256, 2);
    pe_partial(p);
    if (BIDX == 0 && TIDX < 32) ((uint32_t*)(p.ws + WS_KMAX))[TIDX] = 0u;
    for (int i = BIDX * NTHR + TIDX; i < MTOK; i += gridDim.x * NTHR) ((float*)(p.ws + WS_SSQ))[i] = 0.f;
  }
  PH_SYNC(0)
  if (PH_ON(1)) gemm_inproj(p, 0, lds, 0);
  PH_SYNC(1)
  if (PH_ON(2)) {
    fox_scan(p, (float*)lds); ret_stepA(p); fox_knorm(p);
    if (BIDX == gridDim.x - 1) {
      for (int i = TIDX; i < 512; i += NTHR) {
        const float* part = (const float*)(p.ws + WS_PEP);
        float sum = 0.f;
        for (int kc = 0; kc < 16; ++kc) sum += part[((i >> 8) * 16 + kc) * 256 + (i & 255)];
        ((float*)(p.ws + WS_PEB))[i] = sum;
      }
    }
  }
  PH_SYNC(2)
  if (PH_ON(3)) { ret_stepB(p); fox_phase(p, lds); }
  PH_SYNC(3)
  if (PH_ON(4)) ret_stepC(p, lds);
  PH_SYNC(4)
  if (PH_ON(5)) gemm_outproj(p, 0, lds);
  PH_SYNC(5)
  if (PH_ON(7)) gemm_inproj(p, 1, lds, 0);
  PH_SYNC(7)
  if (PH_ON(8)) { gemm_cmp1(p, lds); gemm_inproj(p, 1, lds, 1); nsa_knorm(p); }
  PH_SYNC(8)
  if (PH_ON(10)) nsa_phase(p, lds);
  PH_SYNC(10)
  if (PH_ON(11)) gemm_outproj(p, 1, lds);
  PH_SYNC(11)
  if (PH_ON(12)) final_norm(p);
}

extern "C" void kernel_launch(void* const* d_in, const int* in_sizes, int n_in, void* d_out, int out_size, void* d_ws,
                              size_t ws_size, hipStream_t stream) {
  static int grid_blocks = 0;
  if (!grid_blocks) {
    int dev = 0, cus = 0, per_cu = 0;
    hipGetDevice(&dev);
    hipDeviceGetAttribute(&cus, hipDeviceAttributeMultiprocessorCount, dev);
    hipFuncSetAttribute((const void*)mega, hipFuncAttributeMaxDynamicSharedMemorySize, LDS_BYTES);
    hipOccupancyMaxActiveBlocksPerMultiprocessor(&per_cu, (const void*)mega, NTHR, LDS_BYTES);
    if (per_cu < 1) per_cu = 1;
    if (per_cu > 1) per_cu = 1;
    grid_blocks = cus * per_cu;
    (void)hipGetLastError();
  }
  Params p{};
  p.x = (const float*)d_in[0]; p.e_ng = (const float*)d_in[1]; p.e_win = (const float*)d_in[2];
  p.e_bf = (const float*)d_in[3]; p.e_gn = (const float*)d_in[4]; p.e_wout = (const float*)d_in[5];
  p.o_ng = (const float*)d_in[6]; p.o_win = (const float*)d_in[7]; p.o_bg = (const float*)d_in[8];
  p.o_pek = (const float*)d_in[9]; p.o_pev = (const float*)d_in[10]; p.o_wk1 = (const float*)d_in[11];
  p.o_wk2 = (const float*)d_in[12]; p.o_wv1 = (const float*)d_in[13]; p.o_wv2 = (const float*)d_in[14];
  p.o_wout = (const float*)d_in[15]; p.fin_g = (const float*)d_in[16];
  p.out = (float*)d_out; p.ws = (unsigned char*)d_ws;
#if ONE_LAUNCH
  p.ph_lo = 0; p.ph_hi = NPHASE - 1; p.coop = 1;
  (void)hipMemsetAsync((unsigned char*)d_ws + WS_BAR, 0, 16384, stream);
  void* args[] = {&p};
  hipError_t e = hipLaunchCooperativeKernel((const void*)mega, dim3(grid_blocks), dim3(NTHR), args, LDS_BYTES, stream);
  if (e != hipSuccess) fprintf(stderr, "cooperative launch failed: %s (grid %d)\n", hipGetErrorString(e), grid_blocks);
#else
  for (int ph = 0; ph < NPHASE; ++ph) {
    p.ph_lo = ph; p.ph_hi = ph; p.coop = 0;
    hipLaunchKernelGGL(mega, dim3(grid_blocks), dim3(NTHR), LDS_BYTES, stream, p);
  }
#endif
}
```

```cpp
#include <hip/hip_runtime.h>
#include <hip/hip_cooperative_groups.h>
#include <stdint.h>
#include <stdio.h>
namespace cg = cooperative_groups;

typedef unsigned short u16;
typedef short bf16x8 __attribute__((ext_vector_type(8)));
typedef short bf16x4 __attribute__((ext_vector_type(4)));
typedef float f32x4 __attribute__((ext_vector_type(4)));

#ifndef ONE_LAUNCH
#define ONE_LAUNCH 1
#endif

#define MTOK 32768
#define SEQ 8192
#define DM 1024
#define LDQ 3072
#define LOG2E 1.4426950408889634f
#define TS 72
#define IMPS 132
#define LDS_BYTES 147520
#define NTHR 512
#define NWAVE 8
#define NPHASE 13

#define MiB (1024ull * 1024ull)
#define WS_HBF   (0ull)
#define WS_DS    (0ull)
#define WS_ST    (32ull * MiB)
#define WS_QK    (64ull * MiB)
#define WS_VT    (256ull * MiB)
#define WS_Y     (352ull * MiB)
#define WS_WT0   (416ull * MiB)
#define WS_WT1   (WS_WT0 + 4352ull * 1024 * 2)
#define WS_WO0   (WS_WT1 + 3840ull * 1024 * 2)
#define WS_WO1   (WS_WO0 + 1024ull * 1024 * 2)
#define WS_W1K   (WS_WO1 + 1024ull * 1024 * 2)
#define WS_W1V   (WS_W1K + 256ull * 2048 * 2)
#define WS_W2K   (WS_W1V + 256ull * 2048 * 2)
#define WS_W2V   (WS_W2K + 256ull * 256 * 2)
#define WS_FLOG  (440ull * MiB)
#define WS_CFOX  (441ull * MiB)
#define WS_GL    (442ull * MiB)
#define WS_HC    (448ull * MiB)
#define WS_KCMP  (456ull * MiB)
#define WS_VCMPT (457ull * MiB)
#define WS_PEP   (458ull * MiB)
#define WS_PEB   (WS_PEP + 65536ull)
#define WS_KMAX  (WS_PEB + 4096ull)
#define WS_SSQ   (459ull * MiB)
#define WS_BAR   (460ull * MiB)

struct Params {
  const float *x, *e_ng, *e_win, *e_bf, *e_gn, *e_wout;
  const float *o_ng, *o_win, *o_bg, *o_pek, *o_pev, *o_wk1, *o_wk2, *o_wv1, *o_wv2, *o_wout, *fin_g;
  float* out;
  unsigned char* ws;
  int ph_lo, ph_hi, coop, pad;
};

typedef __bf16 bf16v2 __attribute__((ext_vector_type(2)));
typedef float f32v2 __attribute__((ext_vector_type(2)));
__device__ __forceinline__ uint32_t pack2(float a, float b) {
  f32v2 v = {a, b};
  bf16v2 r = __builtin_convertvector(v, bf16v2);
  return *(uint32_t*)&r;
}
__device__ __forceinline__ u16 f2bf(float f) { return (u16)(pack2(f, 0.f) & 0xffffu); }
__device__ __forceinline__ float bf2f(u16 h) { return __uint_as_float(((uint32_t)h) << 16); }
__device__ __forceinline__ float ex2(float x) { return __builtin_amdgcn_exp2f(x); }
__device__ __forceinline__ float silu_f(float z) { return z * __builtin_amdgcn_rcpf(1.f + ex2(-z * LOG2E)); }
__device__ __forceinline__ float sigmoid_f(float z) { return __builtin_amdgcn_rcpf(1.f + ex2(-z * LOG2E)); }

__device__ __forceinline__ int opq(int v) { asm volatile("" : "+v"(v)); return v; }
__device__ __forceinline__ int opqs(int v) { asm volatile("" : "+s"(v)); return v; }
#define TIDX opq(p.pad * 64 + (int)__lane_id())
#define BIDX opqs((int)blockIdx.x)
template <int N> __device__ __forceinline__ int dpp_ror_i(int v) { return __builtin_amdgcn_mov_dpp(v, 0x120 + N, 0xf, 0xf, false); }
template <int N> __device__ __forceinline__ float dpp_ror_f(float v) { return __builtin_bit_cast(float, __builtin_amdgcn_mov_dpp(__builtin_bit_cast(int, v), 0x120 + N, 0xf, 0xf, false)); }
__device__ __forceinline__ int dpp_xor1_i(int v) { return __builtin_amdgcn_mov_dpp(v, 0xB1, 0xf, 0xf, false); }
__device__ __forceinline__ int dpp_xor2_i(int v) { return __builtin_amdgcn_mov_dpp(v, 0x4E, 0xf, 0xf, false); }
#define MFMA(a, b, c) __builtin_amdgcn_mfma_f32_16x16x32_bf16((a), (b), (c), 0, 0, 0)

__device__ __forceinline__ void rms_rows(const Params& p, const float* __restrict__ x, const float* __restrict__ g, u16* __restrict__ h) {
  const int lane = TIDX & 63, wave = TIDX >> 6;
  for (int row = BIDX * NWAVE + wave; row < MTOK; row += gridDim.x * NWAVE) {
    const float4* xr = (const float4*)(x + (size_t)row * DM);
    float4 v[4];
    float ss = 0.f;
#pragma unroll
    for (int i = 0; i < 4; ++i) {
      v[i] = xr[lane + 64 * i];
      ss += v[i].x * v[i].x + v[i].y * v[i].y + v[i].z * v[i].z + v[i].w * v[i].w;
    }
#pragma unroll
    for (int o = 32; o >= 1; o >>= 1) ss += __shfl_xor(ss, o);
    const float rstd = rsqrtf(ss * (1.f / DM) + 1e-6f);
#pragma unroll
    for (int i = 0; i < 4; ++i) {
      float4 gg = ((const float4*)g)[lane + 64 * i];
      uint2 o;
      o.x = pack2(v[i].x * rstd * gg.x, v[i].y * rstd * gg.y);
      o.y = pack2(v[i].z * rstd * gg.z, v[i].w * rstd * gg.w);
      *(uint2*)(h + (size_t)row * DM + (lane + 64 * i) * 4) = o;
    }
  }
}

__device__ __forceinline__ void rms_rows_fl(const Params& p, float* ldsf) {
  const float* __restrict__ x = p.x; const float* __restrict__ g = p.e_ng;
  u16* __restrict__ h = (u16*)(p.ws + WS_HBF);
  float* __restrict__ fl = (float*)(p.ws + WS_FLOG);
  const int tid = TIDX, lane = tid & 63, wave = tid >> 6;
  for (int i = tid; i < 8 * DM; i += NTHR) { const int j = i >> 10, k = i & 1023; ldsf[i] = g[k] * p.e_win[(size_t)k * 4104 + 1536 + j]; }
  __syncthreads();
  for (int row = BIDX * NWAVE + wave; row < MTOK; row += gridDim.x * NWAVE) {
    const float4* xr = (const float4*)(x + (size_t)row * DM);
    float4 v[4];
    float ss = 0.f;
#pragma unroll
    for (int i = 0; i < 4; ++i) {
      v[i] = xr[lane + 64 * i];
      ss += v[i].x * v[i].x + v[i].y * v[i].y + v[i].z * v[i].z + v[i].w * v[i].w;
    }
#pragma unroll
    for (int o = 32; o >= 1; o >>= 1) ss += __shfl_xor(ss, o);
    const float rstd = rsqrtf(ss * (1.f / DM) + 1e-6f);
#pragma unroll
    for (int i = 0; i < 4; ++i) {
      float4 gg = ((const float4*)g)[lane + 64 * i];
      uint2 o;
      o.x = pack2(v[i].x * rstd * gg.x, v[i].y * rstd * gg.y);
      o.y = pack2(v[i].z * rstd * gg.z, v[i].w * rstd * gg.w);
      *(uint2*)(h + (size_t)row * DM + (lane + 64 * i) * 4) = o;
    }
    float myf = 0.f;
#pragma unroll
    for (int j = 0; j < 8; ++j) {
      float d = 0.f;
#pragma unroll
      for (int i = 0; i < 4; ++i) {
        const float4 w4 = *(const float4*)(ldsf + j * DM + (lane + 64 * i) * 4);
        d += v[i].x * w4.x + v[i].y * w4.y + v[i].z * w4.z + v[i].w * w4.w;
      }
#pragma unroll
      for (int o = 32; o >= 1; o >>= 1) d += __shfl_xor(d, o);
      if (lane == j) myf = d * rstd;
    }
    if (lane < 8) fl[(size_t)row * 8 + lane] = myf;
  }
}

__device__ __forceinline__ int map_col(int MAP, int n) {
  if (MAP == 0) {
    if (n < 1024) return n;
    if (n < 2048) return n + 520;
    if (n < 3072) return n + 1032;
    if (n < 3584) return n - 2048;
    if (n < 4096) return n - 1016;
    if (n < 4104) return n - 2560;
    return -1;
  } else if (MAP == 1) {
    if (n < 1792) return n;
    if (n < 2048) return n + 256;
    if (n < 3072) return n + 560;
    if (n < 3328) return n - 1280;
    if (n < 3584) return n - 1024;
    if (n < 3632) return n - 1024;
    return -1;
  } else if (MAP == 2) {
    return n;
  }
  return n;
}

__device__ __forceinline__ void conv_t(const Params& p, u16* __restrict__ dst, const float* __restrict__ src, int K, int nsrc, int ndst, int MAP) {
  const int total = ndst * (K >> 3);
  for (int id = BIDX * NTHR + TIDX; id < total; id += gridDim.x * NTHR) {
    const int n = id % ndst, kc = id / ndst;
    const int sc = map_col(MAP, n);
    const bool okc = (sc >= 0 && sc < nsrc);
    const int scc = okc ? sc : 0;
    float v[8];
#pragma unroll
    for (int i = 0; i < 8; ++i) v[i] = src[(size_t)(kc * 8 + i) * nsrc + scc];
#pragma unroll
    for (int i = 0; i < 8; ++i) v[i] = okc ? v[i] : 0.f;
    uint4 o;
    o.x = pack2(v[0], v[1]); o.y = pack2(v[2], v[3]); o.z = pack2(v[4], v[5]); o.w = pack2(v[6], v[7]);
    *(uint4*)(dst + (size_t)n * K + kc * 8) = o;
  }
}

__device__ __forceinline__ void pe_partial(const Params& p) {
  float* part = (float*)(p.ws + WS_PEP);
  for (int task = BIDX; task < 32; task += gridDim.x) {
    const int kv = task >> 4, kc = task & 15, n = TIDX;
    if (n >= 256) continue;
    const float* pe = kv ? p.o_pev : p.o_pek;
    const float* w1 = kv ? p.o_wv1 : p.o_wk1;
    float acc = 0.f;
#pragma unroll 16
    for (int k = kc * 128; k < kc * 128 + 128; ++k) acc += pe[k] * w1[(size_t)k * 256 + n];
    part[(kv * 16 + kc) * 256 + n] = acc;
  }
}

#define GST (512 * TS)
template <bool swapped>
__device__ __forceinline__ void gemm_compute(const u16* cur, f32x4 (&acc)[8][4], int wpa, int wpb, int l16, int gk) {
  const u16* sA = cur + (wpa * 128 + l16) * TS + gk * 8;
  const u16* sB = cur + (256 + wpb * 64 + l16) * TS + gk * 8;
#pragma unroll 1
  for (int kk = 0; kk < 2; ++kk) {
    bf16x8 fa[8], fb[4];
#pragma unroll
    for (int i = 0; i < 8; ++i) fa[i] = *(const bf16x8*)(sA + i * 16 * TS + kk * 32);
#pragma unroll
    for (int j = 0; j < 4; ++j) fb[j] = *(const bf16x8*)(sB + j * 16 * TS + kk * 32);
    if (swapped) {
#pragma unroll
      for (int i = 0; i < 8; ++i)
#pragma unroll
        for (int j = 0; j < 4; ++j) acc[i][j] = MFMA(fb[j], fa[i], acc[i][j]);
    } else {
#pragma unroll
      for (int i = 0; i < 8; ++i)
#pragma unroll
        for (int j = 0; j < 4; ++j) acc[i][j] = MFMA(fa[i], fb[j], acc[i][j]);
    }
  }
}
template <bool swapped>
__device__ __forceinline__ void gemm_mainloop(const Params& p, const u16* __restrict__ Ab, const uint32_t (&pa)[4], const u16* __restrict__ Bb,
                                              const uint32_t (&pb)[4], int a_kstride, int nk,
                                              u16* lds, f32x4 (&acc)[8][4],
                                              bool primed = false, const u16* __restrict__ Abn = nullptr, const u16* __restrict__ Bbn = nullptr) {
  const int tid = TIDX, lane = tid & 63, wave = tid >> 6;
  const int l16 = lane & 15, gk = lane >> 4;
  const int wpa = wave >> 2, wpb = wave & 3;
  const int woff = (tid >> 3) * TS + (tid & 7) * 8;
  uint4 ra0, ra1, ra2, ra3, rb0, rb1, rb2, rb3;
#define G_LD(kidx) { const u16* Ap_ = Ab + (size_t)(kidx) * a_kstride; const u16* Bp_ = Bb + (size_t)(kidx) * 64;   \
    ra0 = *(const uint4*)(Ap_ + pa[0]); ra1 = *(const uint4*)(Ap_ + pa[1]); ra2 = *(const uint4*)(Ap_ + pa[2]); ra3 = *(const uint4*)(Ap_ + pa[3]); \
    rb0 = *(const uint4*)(Bp_ + pb[0]); rb1 = *(const uint4*)(Bp_ + pb[1]); rb2 = *(const uint4*)(Bp_ + pb[2]); rb3 = *(const uint4*)(Bp_ + pb[3]); }
#define G_ST(D) { u16* D_ = (D) + woff;                                                                               \
    *(uint4*)(D_) = ra0; *(uint4*)(D_ + 64 * TS) = ra1; *(uint4*)(D_ + 128 * TS) = ra2; *(uint4*)(D_ + 192 * TS) = ra3;  \
    *(uint4*)(D_ + 256 * TS) = rb0; *(uint4*)(D_ + 320 * TS) = rb1; *(uint4*)(D_ + 384 * TS) = rb2; *(uint4*)(D_ + 448 * TS) = rb3; }
  if (!primed) {
    G_LD(0)
    __syncthreads();
    G_ST(lds)
    __syncthreads();
  }
#pragma unroll
  for (int i = 0; i < 8; ++i)
#pragma unroll
    for (int j = 0; j < 4; ++j) acc[i][j] = (f32x4){0.f, 0.f, 0.f, 0.f};
#pragma unroll 1
  for (int ks = 0; ks < nk; ++ks) {
    const bool last = (ks + 1 == nk);
    const bool more = !last || (Abn != nullptr);
    if (more) {
      if (!last) G_LD(ks + 1)
      else { const u16* Ab = Abn; const u16* Bb = Bbn; G_LD(0) }
    }
    gemm_compute<swapped>(lds + (ks & 1) * GST, acc, wpa, wpb, l16, gk);
    if (more) G_ST(lds + ((ks + 1) & 1) * GST)
    __syncthreads();
  }
#undef G_LD
#undef G_ST
}
#define GEMM_OFFS(rowstrideA, rowstrideB)                                   \
  uint32_t pa[4], pb[4];                                                    \
  _Pragma("unroll") for (int i = 0; i < 4; ++i) {                           \
    pa[i] = (uint32_t)((tid >> 3) + 64 * i) * (rowstrideA) + (tid & 7) * 8; \
    pb[i] = (uint32_t)((tid >> 3) + 64 * i) * (rowstrideB) + (tid & 7) * 8; \
  }

namespace pg8 {
#define PG8_LAS __attribute__((address_space(3)))
typedef unsigned short bf16_t;
typedef unsigned u32x4 __attribute__((ext_vector_type(4)));
constexpr int BM = 256, BK = 64, HALF = 128, HTB = HALF * BK * 2, STAGE_BYTES = 8 * HTB;
__device__ __forceinline__ int lds_byte(int r, int c) { const int st = (r >> 4) * 2 + (c >> 5), rr = r & 15, cc = c & 31, ob = rr * 64 + cc * 2; return st * 1024 + (ob ^ (((ob >> 9) & 1) << 5)); }
__device__ __forceinline__ void stage_rc(int b, int& R, int& C) { const int st = b / 1024, sb = b % 1024, swz = sb ^ (((sb >> 9) & 1) << 5); R = (st >> 1) * 16 + swz / 64; C = (st & 1) * 32 + (swz % 64) / 2; }
__device__ __forceinline__ int perm32(int rho) { const int n = rho >> 4, i = rho & 15; return 8 * (i >> 2) + 4 * n + (i & 3); }
struct Unit { int pm, pn; };
struct Gemm { const bf16_t* A; const bf16_t* Bt; int M, N, K; };
template <class Epi, class Sched>
__device__ __forceinline__ void gemm_phase(PG8_LAS unsigned char* lds, const Gemm g, const Sched& S, const Epi& E, const int tid) {
    const int wid = __builtin_amdgcn_readfirstlane(tid >> 6), lane = tid & 63, wr = wid >> 2, wc = wid & 3, fr = lane & 15, fq = lane >> 4;
    const int K = g.K, nt = K / BK;
    const int pA = S.pitchA(K), pB = S.pitchB(K);
    unsigned voffA[2], voffB[2];
#pragma unroll
    for (int i = 0; i < 2; ++i) { int R, C; stage_rc(tid * 16 + i * 8192, R, C); const int Rb = Epi::PERM ? ((R & ~31) + perm32(R & 31)) : R;
        voffA[i] = (unsigned)(R * pA + C) * 2u; voffB[i] = (unsigned)(Rb * pB + C) * 2u; }
    const size_t kstepA = S.kstepA(), kstepB = (size_t)(BK * 2);
    const size_t hstepA = (size_t)HALF * pA * 2, hstepB = (size_t)HALF * pB * 2;
    const unsigned ldsw = (unsigned)wid * 1024u;
    const int aoff = lds_byte(wr * 64 + fr, fq * 8), boff = lds_byte(wc * 32 + fr, fq * 8);
#define PG8_SA(b, h) (((b) * 2 + (h)) * HTB)
#define PG8_SB(b, h) ((4 + (b) * 2 + (h)) * HTB)
#define PG8_STAGE(bufoff, gbase, voff) do { _Pragma("unroll") for (int _i = 0; _i < 2; ++_i) \
        __builtin_amdgcn_global_load_lds((const unsigned*)((const char*)(gbase) + (voff)[_i]), (PG8_LAS unsigned*)(lds + (bufoff) + ldsw + _i * 8192), 16, 0, 0); } while (0)
#define PG8_LDA(dst, b, h) do { _Pragma("unroll") for (int m = 0; m < 4; ++m) _Pragma("unroll") for (int k = 0; k < 2; ++k) dst[m][k] = *(const PG8_LAS bf16x8*)(lds + PG8_SA(b, h) + aoff + m * 2048 + k * 1024); } while (0)
#define PG8_LDB(dst, b, h) do { _Pragma("unroll") for (int n = 0; n < 2; ++n) _Pragma("unroll") for (int k = 0; k < 2; ++k) dst[n][k] = *(const PG8_LAS bf16x8*)(lds + PG8_SB(b, h) + boff + n * 2048 + k * 1024); } while (0)
#define PG8_MMA(ai, bj, At, Bt) do { __builtin_amdgcn_s_setprio(1); _Pragma("unroll") for (int m = 0; m < 4; ++m) _Pragma("unroll") for (int n = 0; n < 2; ++n) _Pragma("unroll") for (int k = 0; k < 2; ++k) \
        acc[ai][bj][m][n] = __builtin_amdgcn_mfma_f32_16x16x32_bf16(Bt[n][k], At[m][k], acc[ai][bj][m][n], 0, 0, 0); __builtin_amdgcn_s_setprio(0); } while (0)
#define PG8_WAIT_V(n) asm volatile("s_waitcnt vmcnt(" #n ")" ::: "memory")
#define PG8_WAIT_L(n) asm volatile("s_waitcnt lgkmcnt(" #n ")" ::: "memory")
#define PG8_BAR __builtin_amdgcn_s_barrier()
#define PG8_SCHED __builtin_amdgcn_sched_barrier(0)
    Unit cur, nxt; int ui = 0;
    if (!S.next(0, cur)) return;
    f32x4 acc[2][2][4][2];
#pragma unroll
    for (int a = 0; a < 2; ++a)
#pragma unroll
        for (int b = 0; b < 2; ++b)
#pragma unroll
            for (int m = 0; m < 4; ++m)
#pragma unroll
                for (int n = 0; n < 2; ++n) acc[a][b][m][n] = (f32x4){0.f, 0.f, 0.f, 0.f};
    bf16x8 At[4][2], B0[2][2], B1[2][2];
    const char* cA = S.baseA(g, cur); const char* cB = S.baseB(g, cur);
    S.a_ready(cur);
    PG8_STAGE(PG8_SB(0, 0), cB, voffB); PG8_STAGE(PG8_SA(0, 0), cA, voffA); PG8_STAGE(PG8_SB(0, 1), cB + hstepB, voffB); PG8_STAGE(PG8_SA(0, 1), cA + hstepA, voffA);
    if (wr == 1) PG8_BAR;
    PG8_WAIT_V(4); PG8_BAR;
    PG8_STAGE(PG8_SB(1, 0), cB + kstepB, voffB); PG8_STAGE(PG8_SA(1, 0), cA + kstepA, voffA); PG8_STAGE(PG8_SB(1, 1), cB + hstepB + kstepB, voffB);
    PG8_WAIT_V(6); PG8_BAR;
    for (;;) {
        const bool has_next = S.next(ui + 1, nxt);
        const char* nA = has_next ? S.baseA(g, nxt) : cA; const char* nB = has_next ? S.baseB(g, nxt) : cB;
        for (int t = 0; t < nt; t += 2) {
            const bool last = (t == nt - 2);
            const char* a1 = cA + (size_t)(t + 1) * kstepA;
            const char* a2 = last ? nA : cA + (size_t)(t + 2) * kstepA; const char* b2 = last ? nB : cB + (size_t)(t + 2) * kstepB;
            const char* a3 = a2 + kstepA; const char* b3 = b2 + kstepB;
            if (last && has_next) S.a_ready(nxt);
            PG8_LDB(B0, 0, 0); PG8_SCHED; PG8_LDA(At, 0, 0); PG8_STAGE(PG8_SA(1, 1), a1 + hstepA, voffA);
            PG8_WAIT_L(8); PG8_BAR; PG8_WAIT_L(0); PG8_MMA(0, 0, At, B0); PG8_BAR; PG8_SCHED;
            PG8_LDB(B1, 0, 1); PG8_STAGE(PG8_SB(0, 0), b2, voffB);
            PG8_BAR; PG8_WAIT_L(0); PG8_MMA(0, 1, At, B1); PG8_BAR;
            PG8_LDA(At, 0, 1); PG8_STAGE(PG8_SA(0, 0), a2, voffA);
            PG8_BAR; PG8_WAIT_L(0); PG8_MMA(1, 0, At, B0); PG8_BAR; PG8_SCHED;
            PG8_STAGE(PG8_SB(0, 1), b2 + hstepB, voffB);
            PG8_WAIT_V(6); PG8_BAR; PG8_MMA(1, 1, At, B1); PG8_BAR;
            PG8_LDB(B0, 1, 0); PG8_SCHED; PG8_LDA(At, 1, 0); PG8_STAGE(PG8_SA(0, 1), a2 + hstepA, voffA);
            PG8_WAIT_L(8); PG8_BAR; PG8_WAIT_L(0); PG8_MMA(0, 0, At, B0); PG8_BAR; PG8_SCHED;
            PG8_LDB(B1, 1, 1); PG8_STAGE(PG8_SB(1, 0), b3, voffB);
            PG8_BAR; PG8_WAIT_L(0); PG8_MMA(0, 1, At, B1); PG8_BAR;
            PG8_LDA(At, 1, 1); PG8_STAGE(PG8_SA(1, 0), a3, voffA);
            PG8_BAR; PG8_WAIT_L(0); PG8_MMA(1, 0, At, B0); PG8_BAR; PG8_SCHED;
            PG8_STAGE(PG8_SB(1, 1), b3 + hstepB, voffB);
            PG8_WAIT_V(6); PG8_BAR; PG8_MMA(1, 1, At, B1); PG8_BAR;
        }
        if constexpr (!Epi::AFTER_DRAIN) { E(acc, cur, wr, wc, fr, fq); S.done(cur); }
        if (!has_next) break;
#pragma unroll
        for (int a = 0; a < 2; ++a)
#pragma unroll
            for (int b = 0; b < 2; ++b)
#pragma unroll
                for (int m = 0; m < 4; ++m)
#pragma unroll
                    for (int n = 0; n < 2; ++n) acc[a][b][m][n] = (f32x4){0.f, 0.f, 0.f, 0.f};
        cur = nxt; cA = nA; cB = nB; ++ui;
    }
    PG8_WAIT_V(0);
    if (wr == 0) PG8_BAR;
    PG8_BAR;
    if constexpr (Epi::AFTER_DRAIN) { E.fused(acc, cur, wr, wc, fr, fq, lds, wid, lane); S.done(cur); }
#undef PG8_SA
#undef PG8_SB
#undef PG8_STAGE
#undef PG8_LDA
#undef PG8_LDB
#undef PG8_MMA
#undef PG8_WAIT_V
#undef PG8_WAIT_L
#undef PG8_BAR
#undef PG8_SCHED
}
}

struct OrdTiles {
  int xcd, lrank, nloc, NTn, cmap;
  __device__ __forceinline__ int pitchA(int K) const { return K; }
  __device__ __forceinline__ int pitchB(int K) const { return K; }
  __device__ __forceinline__ size_t kstepA() const { return 128; }
  __device__ __forceinline__ const char* baseA(const pg8::Gemm& g, const pg8::Unit& u) const { return (const char*)g.A + (size_t)u.pm * 256 * g.K * 2; }
  __device__ __forceinline__ const char* baseB(const pg8::Gemm& g, const pg8::Unit& u) const { return (const char*)g.Bt + (size_t)u.pn * 256 * g.K * 2; }
  __device__ __forceinline__ bool next(int i, pg8::Unit& u) const {
    const int q = lrank + i * nloc; if (q >= 16 * NTn) return false;
    u.pm = xcd * 16 + q / NTn; const int j = q % NTn; u.pn = (cmap && j >= 6) ? j + 2 : j; return true;
  }
  __device__ __forceinline__ void a_ready(const pg8::Unit&) const {}
  __device__ __forceinline__ void done(const pg8::Unit&) const {}
};
struct EpiQK {
  static constexpr bool PERM = true, AFTER_DRAIN = false;
  u16* QK; const float* ssq; int layer;
  __device__ __forceinline__ void operator()(const f32x4 (&acc)[2][2][4][2], const pg8::Unit& u, int wr, int wc, int fr, int fq) const {
    const int row0 = u.pm * 256 + wr * 64 + fr, col0 = u.pn * 256 + wc * 32 + 8 * fq;
#pragma unroll
    for (int ai = 0; ai < 2; ++ai)
#pragma unroll
      for (int m = 0; m < 4; ++m) {
        const int row = row0 + ai * 128 + m * 16;
        const float rs = layer ? rsqrtf(ssq[row] * (1.f / DM) + 1e-6f) : 1.f;
        u16* rowp = QK + (size_t)row * LDQ + col0;
#pragma unroll
        for (int bj = 0; bj < 2; ++bj) {
          const f32x4 v0 = acc[ai][bj][m][0] * rs, v1 = acc[ai][bj][m][1] * rs;
          uint4 w; w.x = pack2(v0[0], v0[1]); w.y = pack2(v0[2], v0[3]); w.z = pack2(v1[0], v1[1]); w.w = pack2(v1[2], v1[3]);
          *(uint4*)(rowp + bj * 128) = w;
        }
      }
  }
};
struct OrdTilesT {
  int xcd, lrank, nloc, NTt, layer;
  __device__ __forceinline__ int pitchA(int K) const { return K; }
  __device__ __forceinline__ int pitchB(int K) const { return K; }
  __device__ __forceinline__ size_t kstepA() const { return 128; }
  __device__ __forceinline__ const char* baseA(const pg8::Gemm& g, const pg8::Unit& u) const { return (const char*)g.A + (size_t)u.pm * 256 * g.K * 2; }
  __device__ __forceinline__ const char* baseB(const pg8::Gemm& g, const pg8::Unit& u) const { return (const char*)g.Bt + (size_t)u.pn * 256 * g.K * 2; }
  __device__ __forceinline__ bool next(int i, pg8::Unit& u) const {
    const int q = lrank + i * nloc; if (q >= 16 * NTt) return false;
    u.pn = xcd * 16 + q / NTt; const int j = q % NTt;
    u.pm = layer ? 12 + j : (j < 4 ? 12 + j : 2 + j);
    return true;
  }
  __device__ __forceinline__ void a_ready(const pg8::Unit&) const {}
  __device__ __forceinline__ void done(const pg8::Unit&) const {}
};
struct EpiVT {
  static constexpr bool PERM = true, AFTER_DRAIN = false;
  u16* VT; const float* ssq; int layer;
  __device__ __forceinline__ void operator()(const f32x4 (&acc)[2][2][4][2], const pg8::Unit& u, int wr, int wc, int fr, int fq) const {
    const int n0 = u.pm * 256 + wr * 64 + fr, m0 = u.pn * 256 + wc * 32 + 8 * fq;
    const bool kr = (layer == 0) && (u.pm < 12);
#pragma unroll
    for (int ai = 0; ai < 2; ++ai)
#pragma unroll
      for (int m = 0; m < 4; ++m) {
        const int n = n0 + ai * 128 + m * 16;
        const int trow = kr ? n - 512 : n - 3072;
        const float lg2 = kr ? log1pf(-exp2f(-5.f - (float)((n - 1536) >> 6))) * LOG2E : 0.f;
        u16* rowp = VT + (size_t)trow * MTOK + m0;
#pragma unroll
        for (int bj = 0; bj < 2; ++bj) {
          const int mc = m0 + bj * 128;
          float sc[8];
          if (layer) {
            const float4 q0 = *(const float4*)(ssq + mc), q1 = *(const float4*)(ssq + mc + 4);
            sc[0] = rsqrtf(q0.x * (1.f / DM) + 1e-6f); sc[1] = rsqrtf(q0.y * (1.f / DM) + 1e-6f); sc[2] = rsqrtf(q0.z * (1.f / DM) + 1e-6f); sc[3] = rsqrtf(q0.w * (1.f / DM) + 1e-6f);
            sc[4] = rsqrtf(q1.x * (1.f / DM) + 1e-6f); sc[5] = rsqrtf(q1.y * (1.f / DM) + 1e-6f); sc[6] = rsqrtf(q1.z * (1.f / DM) + 1e-6f); sc[7] = rsqrtf(q1.w * (1.f / DM) + 1e-6f);
          } else {
#pragma unroll
            for (int e = 0; e < 8; ++e) sc[e] = kr ? 0.125f * ex2(lg2 * (float)(127 - ((mc + e) & 127))) : 1.f;
          }
          const f32x4 v0 = acc[ai][bj][m][0], v1 = acc[ai][bj][m][1];
          uint4 w; w.x = pack2(v0[0] * sc[0], v0[1] * sc[1]); w.y = pack2(v0[2] * sc[2], v0[3] * sc[3]);
          w.z = pack2(v1[0] * sc[4], v1[1] * sc[5]); w.w = pack2(v1[2] * sc[6], v1[3] * sc[7]);
          *(uint4*)(rowp + bj * 128) = w;
        }
      }
  }
};
struct OrdCmp {
  int bid; const u16* U; const u16* W1K; const u16* W1V;
  __device__ __forceinline__ bool next(int i, pg8::Unit& u) const { if (i > 0 || bid >= 64) return false; u.pm = bid & 31; u.pn = bid >> 5; return true; }
  __device__ __forceinline__ void a_ready(const pg8::Unit&) const {}
  __device__ __forceinline__ void done(const pg8::Unit&) const {}
  __device__ __forceinline__ int pitchA(int) const { return 16 * LDQ; }
  __device__ __forceinline__ int pitchB(int K) const { return K; }
  __device__ __forceinline__ size_t kstepA() const { return (size_t)LDQ * 2; }
  __device__ __forceinline__ const char* baseA(const pg8::Gemm&, const pg8::Unit& u) const {
    const int r0 = u.pm * 256, bg = r0 >> 9, c0 = r0 & 511, b = bg >> 2, g4 = bg & 3;
    return (const char*)(U + (size_t)(b * SEQ + c0 * 16) * LDQ + 1024 + u.pn * 256 + g4 * 64);
  }
  __device__ __forceinline__ const char* baseB(const pg8::Gemm&, const pg8::Unit& u) const { return (const char*)(u.pn ? W1V : W1K); }
};
struct EpiCmp1 {
  static constexpr bool PERM = true, AFTER_DRAIN = false;
  u16* Hc; const float* peb;
  __device__ __forceinline__ void operator()(const f32x4 (&acc)[2][2][4][2], const pg8::Unit& u, int wr, int wc, int fr, int fq) const {
    const int row0 = u.pm * 256 + wr * 64 + fr, col0 = wc * 32 + 8 * fq, kv = u.pn;
    u16* H = Hc + (size_t)kv * 8192 * 256;
#pragma unroll
    for (int bj = 0; bj < 2; ++bj) {
      const float4 b0 = *(const float4*)(peb + kv * 256 + col0 + bj * 128), b1 = *(const float4*)(peb + kv * 256 + col0 + bj * 128 + 4);
#pragma unroll
      for (int ai = 0; ai < 2; ++ai)
#pragma unroll
        for (int m = 0; m < 4; ++m) {
          const int row = row0 + ai * 128 + m * 16;
          const f32x4 v0 = acc[ai][bj][m][0], v1 = acc[ai][bj][m][1];
          float o[8] = {silu_f(v0[0] + b0.x), silu_f(v0[1] + b0.y), silu_f(v0[2] + b0.z), silu_f(v0[3] + b0.w),
                        silu_f(v1[0] + b1.x), silu_f(v1[1] + b1.y), silu_f(v1[2] + b1.z), silu_f(v1[3] + b1.w)};
          if ((row & 511) == 511) {
#pragma unroll
            for (int e = 0; e < 8; ++e) o[e] = 0.f;
          }
          uint4 w; w.x = pack2(o[0], o[1]); w.y = pack2(o[2], o[3]); w.z = pack2(o[4], o[5]); w.w = pack2(o[6], o[7]);
          *(uint4*)(H + (size_t)row * 256 + col0 + bj * 128) = w;
        }
    }
  }
};
struct OrdGL {
  int bid;
  __device__ __forceinline__ bool next(int i, pg8::Unit& u) const { if (i > 0 || bid < 64 || bid >= 192) return false; u.pm = bid - 64; u.pn = 14; return true; }
  __device__ __forceinline__ void a_ready(const pg8::Unit&) const {}
  __device__ __forceinline__ void done(const pg8::Unit&) const {}
  __device__ __forceinline__ int pitchA(int K) const { return K; }
  __device__ __forceinline__ int pitchB(int K) const { return K; }
  __device__ __forceinline__ size_t kstepA() const { return 128; }
  __device__ __forceinline__ const char* baseA(const pg8::Gemm& g, const pg8::Unit& u) const { return (const char*)g.A + (size_t)u.pm * 256 * g.K * 2; }
  __device__ __forceinline__ const char* baseB(const pg8::Gemm& g, const pg8::Unit& u) const { return (const char*)g.Bt + (size_t)u.pn * 256 * g.K * 2; }
};
struct EpiGL {
  static constexpr bool PERM = false, AFTER_DRAIN = false;
  float* F; const float* ssq;
  __device__ __forceinline__ void operator()(const f32x4 (&acc)[2][2][4][2], const pg8::Unit& u, int wr, int wc, int fr, int fq) const {
    const int row0 = u.pm * 256 + wr * 64 + fr, col0 = wc * 32 + 4 * fq;
#pragma unroll
    for (int ai = 0; ai < 2; ++ai)
#pragma unroll
      for (int m = 0; m < 4; ++m) {
        const int row = row0 + ai * 128 + m * 16;
        const float rs = rsqrtf(ssq[row] * (1.f / DM) + 1e-6f);
#pragma unroll
        for (int n = 0; n < 2; ++n) {
          const int col = col0 + n * 16;
          if (col < 48) { const f32x4 a = acc[ai][0][m][n] * rs; *(float4*)(F + (size_t)row * 48 + col) = (float4){a[0], a[1], a[2], a[3]}; }
        }
      }
  }
};
struct EpiRes {
  static constexpr bool PERM = false, AFTER_DRAIN = false;
  const float* res; float* out; u16* hb; float* ssq; const float* g; int layer;
  __device__ __forceinline__ void operator()(const f32x4 (&acc)[2][2][4][2], const pg8::Unit& u, int wr, int wc, int fr, int fq) const {
    const int row0 = u.pm * 256 + wr * 64 + fr, col0 = u.pn * 256 + wc * 32 + 4 * fq;
#pragma unroll
    for (int ai = 0; ai < 2; ++ai)
#pragma unroll
      for (int m = 0; m < 4; ++m) {
        const int row = row0 + ai * 128 + m * 16;
        float sq = 0.f;
#pragma unroll
        for (int bj = 0; bj < 2; ++bj)
#pragma unroll
          for (int n = 0; n < 2; ++n) {
            const int col = col0 + bj * 128 + n * 16;
            const float4 r = *(const float4*)(res + (size_t)row * DM + col);
            const f32x4 a = acc[ai][bj][m][n];
            const float4 v = (float4){r.x + a[0], r.y + a[1], r.z + a[2], r.w + a[3]};
            *(float4*)(out + (size_t)row * DM + col) = v;
            if (layer == 0) {
              const float4 gg = *(const float4*)(g + col);
              uint2 hv; hv.x = pack2(v.x * gg.x, v.y * gg.y); hv.y = pack2(v.z * gg.z, v.w * gg.w);
              *(uint2*)(hb + (size_t)row * DM + col) = hv;
              sq += v.x * v.x + v.y * v.y + v.z * v.z + v.w * v.w;
            }
          }
        if (layer == 0) {
          sq += __shfl_xor(sq, 16); sq += __shfl_xor(sq, 32);
          if (fq == 0) atomicAdd(ssq + row, sq);
        }
      }
  }
};

__device__ __forceinline__ void gemm_inproj(const Params& p, int layer, u16* lds, int part) {
  const u16* A = (const u16*)(p.ws + WS_HBF);
  const u16* Bt = (const u16*)(p.ws + (layer ? WS_WT1 : WS_WT0));
  u16* QK = (u16*)(p.ws + WS_QK);
  u16* VT = (u16*)(p.ws + WS_VT);
  float* F = (float*)(p.ws + (layer ? WS_GL : WS_FLOG));
  const int NT = layer ? 14 : 16;
  const int seg_trans_end = layer ? 28 : 32;
  const int nvalidF = layer ? 48 : 8, ldf = layer ? 48 : 8;
  const int tid = TIDX, lane = tid & 63, wave = tid >> 6, l16 = lane & 15, gk = lane >> 4;
  const int wpa = wave >> 2, wpb = wave & 3;
  const int bid = BIDX;
  int xcd = bid & 7, nloc = (int)gridDim.x >> 3, lrank = bid >> 3;
  { const uint4 cw = *(const uint4*)((const unsigned char*)lds + 147456);
    const int c0 = __builtin_amdgcn_readfirstlane((int)cw.x), c1 = __builtin_amdgcn_readfirstlane((int)cw.y);
    const int c2 = __builtin_amdgcn_readfirstlane((int)cw.z), c3 = __builtin_amdgcn_readfirstlane((int)cw.w);
    if (c1 == 8 && c0 * 8 == (int)gridDim.x) { xcd = c3; lrank = c2; } }
  if (part == 0) {
    const pg8::Gemm gg{(const pg8::bf16_t*)A, (const pg8::bf16_t*)Bt, MTOK, 0, DM};
    const OrdTiles ord{xcd, lrank, nloc, 12, 0};
    const EpiQK epi{QK, (const float*)(p.ws + WS_SSQ), layer};
    pg8::gemm_phase(( __attribute__((address_space(3))) unsigned char*)lds, gg, ord, epi, tid);
    const pg8::Gemm gt{(const pg8::bf16_t*)Bt, (const pg8::bf16_t*)A, 0, MTOK, DM};
    const OrdTilesT ordt{xcd, lrank, nloc, layer ? 2 : 6, layer};
    const EpiVT epit{VT, (const float*)(p.ws + WS_SSQ), layer};
    pg8::gemm_phase(( __attribute__((address_space(3))) unsigned char*)lds, gt, ordt, epit, tid);
    return;
  }
  const int NTs = layer ? 2 : 6;
#define SPEC_NT(j) (layer ? 12 + (j) : ((j) < 2 ? 6 + (j) : 10 + (j)))
  const int qbeg = part ? bid - 64 : lrank, qend = part ? (bid >= 64 ? 128 : -(1 << 20)) : 16 * NTs, qstep = part ? (int)gridDim.x - 64 : nloc;
  bool primed = false;
  for (int q = qbeg; q < qend; q += qstep) {
    const int mt = part ? q : xcd * 16 + q / NTs, nt = part ? NT : SPEC_NT(q % NTs);
    const int m0 = mt * 256, n0 = nt * 256;
    const int qn = q + qstep;
    const bool has_next = (part == 0) && (qn < qend);
    const u16* Abn = has_next ? A + (size_t)((xcd * 16 + qn / NTs) * 256) * DM : nullptr;
    const u16* Bbn = has_next ? Bt + (size_t)(SPEC_NT(qn % NTs) * 256) * DM : nullptr;
    const int mw = m0 + wpa * 128, nw = n0 + wpb * 64;
    const int seg = nw >> 7;
    int mode;
    if (seg < 24) mode = (layer == 0 && seg >= 12 && seg < 16) ? 2 : 0;
    else if (seg < seg_trans_end) mode = 1;
    else if (seg == seg_trans_end) mode = 3;
    else mode = 4;
    const int seg0 = nt * 2;
    const bool swapped = !((seg0 >= 24 && seg0 < seg_trans_end) || (layer == 0 && seg0 >= 12 && seg0 < 16));
    GEMM_OFFS(DM, DM)
    f32x4 acc[8][4];
    if (swapped) gemm_mainloop<true>(p, A + (size_t)m0 * DM, pa, Bt + (size_t)n0 * DM, pb, 64, 16, lds, acc, primed, Abn, Bbn);
    else gemm_mainloop<false>(p, A + (size_t)m0 * DM, pa, Bt + (size_t)n0 * DM, pb, 64, 16, lds, acc, primed, Abn, Bbn);
    primed = has_next;
    const float* ssq_g = (const float*)(p.ws + WS_SSQ);
    const bool tile_normal = (nt < 12) && !(layer == 0 && nt >= 6 && nt < 8);
    if (tile_normal) {
      u16* stg = lds + GST;
      const int ES = 264;
#pragma unroll 1
      for (int half = 0; half < 2; ++half) {
        __syncthreads();
        if (wpa == half) {
#pragma unroll
          for (int i = 0; i < 8; ++i) {
            const float rs = layer ? rsqrtf(ssq_g[mw + i * 16 + l16] * (1.f / DM) + 1e-6f) : 1.f;
#pragma unroll
            for (int j = 0; j < 4; ++j) {
              uint2 o; o.x = pack2(acc[i][j][0] * rs, acc[i][j][1] * rs); o.y = pack2(acc[i][j][2] * rs, acc[i][j][3] * rs);
              *(uint2*)(stg + (i * 16 + l16) * ES + wpb * 64 + j * 16 + gk * 4) = o;
            }
          }
        }
        __syncthreads();
#pragma unroll
        for (int c = 0; c < 8; ++c) {
          const int idx = tid + NTHR * c, row = idx >> 5, ch = idx & 31;
          const uint4 v = *(const uint4*)(stg + row * ES + ch * 8);
          *(uint4*)(QK + (size_t)(m0 + half * 128 + row) * LDQ + n0 + ch * 8) = v;
        }
      }
      __syncthreads();
    } else if (mode == 0 || mode == 3) {
#pragma unroll
      for (int i = 0; i < 8; ++i) {
        const int m = mw + i * 16 + l16;
        const float rs = layer ? rsqrtf(ssq_g[m] * (1.f / DM) + 1e-6f) : 1.f;
#pragma unroll
        for (int j = 0; j < 4; ++j) {
          const int n = nw + j * 16 + gk * 4;
          const float a0 = acc[i][j][0] * rs, a1 = acc[i][j][1] * rs, a2 = acc[i][j][2] * rs, a3 = acc[i][j][3] * rs;
          if (mode == 0) {
            uint2 o; o.x = pack2(a0, a1); o.y = pack2(a2, a3);
            *(uint2*)(QK + (size_t)m * LDQ + n) = o;
          } else {
            const int nn = n - seg * 128;
            if (nn < nvalidF) *(float4*)(F + (size_t)m * ldf + nn) = (float4){a0, a1, a2, a3};
          }
        }
      }
    } else if (mode == 1 || mode == 2) {
#pragma unroll
      for (int i = 0; i < 8; ++i) {
        const int m = mw + i * 16 + gk * 4;
        float rs0 = 1.f, rs1 = 1.f, rs2 = 1.f, rs3 = 1.f;
        if (layer) {
          const float4 q4 = *(const float4*)(ssq_g + m);
          rs0 = rsqrtf(q4.x * (1.f / DM) + 1e-6f); rs1 = rsqrtf(q4.y * (1.f / DM) + 1e-6f);
          rs2 = rsqrtf(q4.z * (1.f / DM) + 1e-6f); rs3 = rsqrtf(q4.w * (1.f / DM) + 1e-6f);
        }
#pragma unroll
        for (int j = 0; j < 4; ++j) {
          const int n = nw + j * 16 + l16;
          const float a0 = acc[i][j][0] * rs0, a1 = acc[i][j][1] * rs1, a2 = acc[i][j][2] * rs2, a3 = acc[i][j][3] * rs3;
          if (mode == 1) {
            const int trow = n - 3072;
            uint2 o; o.x = pack2(a0, a1); o.y = pack2(a2, a3);
            *(uint2*)(VT + (size_t)trow * MTOK + m) = o;
          } else {
            const int trow = n - 512;
            const int h = (nw - 1536) >> 6;
            const float lg2 = log1pf(-exp2f(-5.f - (float)h)) * LOG2E;
            const float lane_dec = 0.125f * ex2(lg2 * (float)(127 - gk * 4));
            QK[(size_t)(m + 0) * LDQ + n] = f2bf(a0); QK[(size_t)(m + 1) * LDQ + n] = f2bf(a1);
            QK[(size_t)(m + 2) * LDQ + n] = f2bf(a2); QK[(size_t)(m + 3) * LDQ + n] = f2bf(a3);
            const float s0 = a0 * lane_dec * ex2(lg2 * (float)(-(i * 16 + 0))), s1 = a1 * lane_dec * ex2(lg2 * (float)(-(i * 16 + 1)));
            const float s2 = a2 * lane_dec * ex2(lg2 * (float)(-(i * 16 + 2))), s3 = a3 * lane_dec * ex2(lg2 * (float)(-(i * 16 + 3)));
            uint2 o; o.x = pack2(s0, s1); o.y = pack2(s2, s3);
            *(uint2*)(VT + (size_t)trow * MTOK + m) = o;
          }
        }
      }
    }
  }
}

__device__ __forceinline__ void gemm_outproj(const Params& p, int layer, u16* lds) {
  const int tid = TIDX;
  const int bid = BIDX;
  int xcd = bid & 7, nloc = (int)gridDim.x >> 3, lrank = bid >> 3;
  { const uint4 cw = *(const uint4*)((const unsigned char*)lds + 147456);
    const int c0 = __builtin_amdgcn_readfirstlane((int)cw.x), c1 = __builtin_amdgcn_readfirstlane((int)cw.y);
    const int c2 = __builtin_amdgcn_readfirstlane((int)cw.z), c3 = __builtin_amdgcn_readfirstlane((int)cw.w);
    if (c1 == 8 && c0 * 8 == (int)gridDim.x) { xcd = c3; lrank = c2; } }
  const pg8::Gemm gg{(const pg8::bf16_t*)(p.ws + WS_Y), (const pg8::bf16_t*)(p.ws + (layer ? WS_WO1 : WS_WO0)), MTOK, DM, DM};
  const OrdTiles ord{xcd, lrank, nloc, 4, 0};
  const EpiRes epi{layer ? p.out : p.x, p.out, (u16*)(p.ws + WS_HBF), (float*)(p.ws + WS_SSQ), p.o_ng, layer};
  pg8::gemm_phase((__attribute__((address_space(3))) unsigned char*)lds, gg, ord, epi, tid);
}

__device__ __forceinline__ void gemm_cmp2_tile(const Params& p, u16* lds, int kv, int mt) {
  const int tid = TIDX, lane = tid & 63, wave = tid >> 6, l16 = lane & 15, gk = lane >> 4;
  const int wpa = wave >> 2, wpb = wave & 3;
  {
    const int m0 = mt * 256;
    const u16* A = (const u16*)(p.ws + WS_HC) + (size_t)kv * 8192 * 256;
    const u16* Bt = (const u16*)(p.ws + (kv ? WS_W2V : WS_W2K));
    GEMM_OFFS(256, 256)
    f32x4 acc[8][4];
    const bool swapped = (kv == 0);
    if (swapped) gemm_mainloop<true>(p, A + (size_t)m0 * 256, pa, Bt, pb, 64, 4, lds, acc);
    else gemm_mainloop<false>(p, A + (size_t)m0 * 256, pa, Bt, pb, 64, 4, lds, acc);
    const int mw = m0 + wpa * 128, nw = wpb * 64;
    if (swapped) {
      u16* kc_ = (u16*)(p.ws + WS_KCMP);
#pragma unroll
      for (int i = 0; i < 8; ++i)
#pragma unroll
        for (int j = 0; j < 4; ++j) {
          const int n = nw + j * 16 + gk * 4;
          const int m = mw + i * 16 + l16;
          if (n < 64) {
            uint2 o; o.x = pack2(acc[i][j][0], acc[i][j][1]); o.y = pack2(acc[i][j][2], acc[i][j][3]);
            *(uint2*)(kc_ + (size_t)m * 64 + n) = o;
          }
        }
      if (wpb == 0) {
        float mxn = 0.f;
#pragma unroll
        for (int i = 0; i < 8; ++i) {
          float ss = 0.f;
#pragma unroll
          for (int j = 0; j < 4; ++j) ss += acc[i][j][0] * acc[i][j][0] + acc[i][j][1] * acc[i][j][1] + acc[i][j][2] * acc[i][j][2] + acc[i][j][3] * acc[i][j][3];
          ss += __shfl_xor(ss, 16); ss += __shfl_xor(ss, 32);
          mxn = fmaxf(mxn, ss);
        }
#pragma unroll
        for (int o2 = 1; o2 <= 8; o2 <<= 1) mxn = fmaxf(mxn, __shfl_xor(mxn, o2));
        if (lane == 0) atomicMax((uint32_t*)(p.ws + WS_KMAX) + 16 + ((mw >> 9) & 3), __float_as_uint(mxn));
      }
    } else {
      u16* vt = (u16*)(p.ws + WS_VCMPT);
#pragma unroll
      for (int i = 0; i < 8; ++i)
#pragma unroll
        for (int j = 0; j < 4; ++j) {
          const int m = mw + i * 16 + gk * 4;
          const int n = nw + j * 16 + l16;
          if (n < 64) {
            uint2 o; o.x = pack2(acc[i][j][0], acc[i][j][1]); o.y = pack2(acc[i][j][2], acc[i][j][3]);
            *(uint2*)(vt + (size_t)(m >> 9) * 32768 + (size_t)n * 512 + (m & 511)) = o;
          }
        }
    }
  }
}

__device__ __forceinline__ void gemm_cmp1(const Params& p, u16* lds) {
  const int tid = TIDX, bid = BIDX;
  const pg8::Gemm gg{nullptr, nullptr, 8192, 256, 2048};
  const OrdCmp ord{bid, (const u16*)(p.ws + WS_QK), (const u16*)(p.ws + WS_W1K), (const u16*)(p.ws + WS_W1V)};
  const EpiCmp1 epi{(u16*)(p.ws + WS_HC), (const float*)(p.ws + WS_PEB)};
  pg8::gemm_phase((__attribute__((address_space(3))) unsigned char*)lds, gg, ord, epi, tid);
  if (bid < 64) {
    __threadfence_block();
    __syncthreads();
    gemm_cmp2_tile(p, lds, bid >> 5, bid & 31);
  }
}

#define TILE_LD(R, src, stride) { R##0 = *(const uint4*)((src) + (long)(tid >> 3) * (stride) + (tid & 7) * 8); }
#define TILE_ST(dst, R) { *(uint4*)((dst) + (tid >> 3) * TS + (tid & 7) * 8) = R##0; }
#define VPOS(c) ((((c) >> 2) * 32) + ((2 * ((c) & 1)) * 8) + ((((c) & 3) >> 1) * 4))
#define TILE_STV_(dst, val) { const int c_ = tid & 7; u16* d_ = (dst) + (tid >> 3) * TS + VPOS(c_); \
    *(uint2*)(d_) = make_uint2((val).x, (val).y); *(uint2*)(d_ + 8) = make_uint2((val).z, (val).w); }
#define TILE_STV(dst, R) TILE_STV_(dst, R##0)
__device__ __forceinline__ void qk_tile(const u16* sK, const bf16x8 (&q)[2], f32x4 (&s)[4], int l16, int gk) {
#pragma unroll
  for (int kt = 0; kt < 4; ++kt) s[kt] = (f32x4){0.f, 0.f, 0.f, 0.f};
  bf16x8 kf[2][4];
#pragma unroll
  for (int ks = 0; ks < 2; ++ks)
#pragma unroll
    for (int kt = 0; kt < 4; ++kt) kf[ks][kt] = *(const bf16x8*)(sK + (kt * 16 + l16) * TS + ks * 32 + gk * 8);
  __builtin_amdgcn_s_setprio(1);
#pragma unroll
  for (int ks = 0; ks < 2; ++ks)
#pragma unroll
    for (int kt = 0; kt < 4; ++kt) s[kt] = MFMA(kf[ks][kt], q[ks], s[kt]);
  __builtin_amdgcn_s_setprio(0);
}
__device__ __forceinline__ void pv_tile(const u16* sV, const float (&pp)[4][4], f32x4 (&o)[4], int l16, int gk) {
  bf16x8 pf[2];
#pragma unroll
  for (int ks2 = 0; ks2 < 2; ++ks2) {
    uint4 t;
    t.x = pack2(pp[2 * ks2][0], pp[2 * ks2][1]); t.y = pack2(pp[2 * ks2][2], pp[2 * ks2][3]);
    t.z = pack2(pp[2 * ks2 + 1][0], pp[2 * ks2 + 1][1]); t.w = pack2(pp[2 * ks2 + 1][2], pp[2 * ks2 + 1][3]);
    pf[ks2] = *(bf16x8*)&t;
  }
  bf16x8 vf[4][2];
#pragma unroll
  for (int dt = 0; dt < 4; ++dt)
#pragma unroll
    for (int ks2 = 0; ks2 < 2; ++ks2) vf[dt][ks2] = *(const bf16x8*)(sV + (dt * 16 + l16) * TS + ks2 * 32 + gk * 8);
  __builtin_amdgcn_s_setprio(1);
#pragma unroll
  for (int dt = 0; dt < 4; ++dt)
#pragma unroll
    for (int ks2 = 0; ks2 < 2; ++ks2) o[dt] = MFMA(vf[dt][ks2], pf[ks2], o[dt]);
  __builtin_amdgcn_s_setprio(0);
}

__device__ __forceinline__ void fox_phase(const Params& p, u16* lds) {
  const u16* QK = (const u16*)(p.ws + WS_QK);
  const u16* VT = (const u16*)(p.ws + WS_VT);
  const float* cf = (const float*)(p.ws + WS_CFOX);
  u16* Y = (u16*)(p.ws + WS_Y);
  const int tid = TIDX, lane = tid & 63, w = tid >> 6, l16 = lane & 15, gk = lane >> 4;
  const float scale2 = 0.125f * LOG2E;
  for (int unit = BIDX; unit < 2048; unit += gridDim.x) {
    const int bh = unit & 31, qblk = 63 - (unit >> 5), b = bh >> 3, h = bh & 7;
    const int tq0 = qblk * 128 + w * 16;
    const int t = tq0 + l16;
    const float* cfr = cf + (size_t)bh * SEQ;
    bf16x8 q[2];
#pragma unroll
    for (int ks = 0; ks < 2; ++ks) q[ks] = *(const bf16x8*)(QK + (size_t)(b * SEQ + t) * LDQ + h * 64 + ks * 32 + gk * 8);
    const float cq2 = cfr[t] * LOG2E;
    f32x4 o[4];
    float m = -1e30f, l = 0.f;
#pragma unroll
    for (int dt = 0; dt < 4; ++dt) o[dt] = (f32x4){0.f, 0.f, 0.f, 0.f};
    const int ntiles = qblk * 2 + 2;
    const int iw = qblk * 2 + (w >> 2);
    const u16* ksrc = QK + (size_t)(b * SEQ) * LDQ + 512 + h * 64;
    const u16* vsrc = VT + (size_t)(h * 64) * MTOK + (size_t)b * SEQ;
    float qs = 0.f;
#pragma unroll
    for (int ks = 0; ks < 2; ++ks)
#pragma unroll
      for (int e = 0; e < 8; ++e) { const float v = bf2f((u16)q[ks][e]); qs += v * v; }
    qs += __shfl_xor(qs, 16); qs += __shfl_xor(qs, 32);
#pragma unroll
    for (int o2 = 1; o2 <= 8; o2 <<= 1) qs = fmaxf(qs, __shfl_xor(qs, o2));
    float* red = (float*)(lds + 256 * TS);
    if (lane == 0) red[w] = qs;
    __syncthreads();
    float qmax2 = red[0];
#pragma unroll
    for (int i = 1; i < NWAVE; ++i) qmax2 = fmaxf(qmax2, red[i]);
    const float kmax2 = __uint_as_float(((const uint32_t*)(p.ws + WS_KMAX))[h]);
    const float T2 = 2.f * scale2 * sqrtf(qmax2 * kmax2) * 1.001f + 48.f;
    const float cfirst2 = cfr[qblk * 128] * LOG2E;
    int i_lo = 0;
    for (int base = qblk * 2 - 1; base >= 0; base -= 64) {
      const int ti = base - lane;
      bool skip = false;
      if (ti >= 0) skip = (cfirst2 - cfr[ti * 64 + 63] * LOG2E) < -T2;
      const unsigned long long bal = __ballot(skip);
      if (bal) { i_lo = base - (int)__builtin_ctzll(bal) + 1; break; }
    }
    uint4 rk0, rv0;
    TILE_LD(rk, ksrc + (size_t)i_lo * 64 * LDQ, LDQ); TILE_LD(rv, vsrc + i_lo * 64, MTOK);
    TILE_ST(lds + (i_lo & 1) * (128 * TS), rk); TILE_STV(lds + (i_lo & 1) * (128 * TS) + 64 * TS, rv);
    __syncthreads();
    for (int i = i_lo; i < ntiles; ++i) {
      u16* cur = lds + (i & 1) * (128 * TS);
      const bool more = (i + 1 < ntiles);
      if (more) { TILE_LD(rk, ksrc + (size_t)(i + 1) * 64 * LDQ, LDQ); TILE_LD(rv, vsrc + (i + 1) * 64, MTOK); }
      if (i <= iw) {
        const int s0 = i * 64;
        const bool diag = (i == iw);
        f32x4 s[4];
        qk_tile(cur, q, s, l16, gk);
        float xv[4][4];
        float mx = -1e30f;
#pragma unroll
        for (int kt = 0; kt < 4; ++kt) {
          const float4 c4 = *(const float4*)(cfr + s0 + kt * 16 + gk * 4);
          const float ck[4] = {c4.x, c4.y, c4.z, c4.w};
#pragma unroll
          for (int r = 0; r < 4; ++r) {
            float v = fmaf(s[kt][r], scale2, cq2 - ck[r] * LOG2E);
            if (diag && (s0 + kt * 16 + gk * 4 + r > t)) v = -1e30f;
            xv[kt][r] = v; mx = fmaxf(mx, v);
          }
        }
        mx = fmaxf(mx, __shfl_xor(mx, 16)); mx = fmaxf(mx, __shfl_xor(mx, 32));
        const float mnew = fmaxf(m, mx);
        const float alpha = ex2(m - mnew);
        m = mnew;
        const float muse = fmaxf(mnew, -1e20f);
        float rs = 0.f;
#pragma unroll
        for (int kt = 0; kt < 4; ++kt)
#pragma unroll
          for (int r = 0; r < 4; ++r) { xv[kt][r] = ex2(xv[kt][r] - muse); rs += xv[kt][r]; }
        l = l * alpha + rs;
#pragma unroll
        for (int dt = 0; dt < 4; ++dt) o[dt] *= alpha;
        pv_tile(cur + 64 * TS, xv, o, l16, gk);
      }
      if (more) { u16* nxt = lds + ((i + 1) & 1) * (128 * TS); TILE_ST(nxt, rk); TILE_STV(nxt + 64 * TS, rv); }
      __syncthreads();
    }
    {
      float lt = l; lt += __shfl_xor(lt, 16); lt += __shfl_xor(lt, 32);
      const float inv = lt > 0.f ? 1.f / lt : 0.f;
      const size_t mrow = (size_t)(b * SEQ + t);
#pragma unroll
      for (int dt = 0; dt < 4; ++dt) {
        const int col = h * 64 + dt * 16 + gk * 4;
        const uint2 zz = *(const uint2*)(QK + mrow * LDQ + 2048 + col);
        const float z0 = bf2f(zz.x & 0xffff), z1 = bf2f(zz.x >> 16), z2 = bf2f(zz.y & 0xffff), z3 = bf2f(zz.y >> 16);
        uint2 ov;
        ov.x = pack2(o[dt][0] * inv * silu_f(z0), o[dt][1] * inv * silu_f(z1));
        ov.y = pack2(o[dt][2] * inv * silu_f(z2), o[dt][3] * inv * silu_f(z3));
        *(uint2*)(Y + mrow * DM + col) = ov;
      }
    }
  }
}

__device__ __forceinline__ void fox_knorm(const Params& p) {
  const u16* QK = (const u16*)(p.ws + WS_QK);
  uint32_t* km = (uint32_t*)(p.ws + WS_KMAX);
  const int tid = TIDX, lane = tid & 63, wave = tid >> 6;
  float mx = 0.f;
  for (int row = BIDX * NWAVE + wave; row < MTOK; row += gridDim.x * NWAVE) {
    const uint4 v = *(const uint4*)(QK + (size_t)row * LDQ + 512 + lane * 8);
    const float a0 = bf2f(v.x & 0xffff), a1 = bf2f(v.x >> 16), a2 = bf2f(v.y & 0xffff), a3 = bf2f(v.y >> 16);
    const float a4 = bf2f(v.z & 0xffff), a5 = bf2f(v.z >> 16), a6 = bf2f(v.w & 0xffff), a7 = bf2f(v.w >> 16);
    float ss = a0 * a0 + a1 * a1 + a2 * a2 + a3 * a3 + a4 * a4 + a5 * a5 + a6 * a6 + a7 * a7;
    ss += __shfl_xor(ss, 1); ss += __shfl_xor(ss, 2); ss += __shfl_xor(ss, 4);
    mx = fmaxf(mx, ss);
  }
  if ((lane & 7) == 0) atomicMax(&km[lane >> 3], __float_as_uint(mx));
}

__device__ __forceinline__ void fox_scan(const Params& p, float* ldsf) {
  const float* fl = (const float*)(p.ws + WS_FLOG);
  float* cf = (float*)(p.ws + WS_CFOX);
  double* sd = (double*)ldsf;
  const int tid = TIDX;
  for (int bh = BIDX; bh < 32; bh += gridDim.x) {
    const int b = bh >> 3, h = bh & 7;
    const float bf = p.e_bf[h];
    float ls[16];
    double sum = 0.0;
#pragma unroll
    for (int i = 0; i < 16; ++i) {
      const float xx = fl[(size_t)(b * SEQ + tid * 16 + i) * 8 + h] + bf;
      ls[i] = fminf(xx, 0.f) - log1pf(__expf(-fabsf(xx)));
      sum += (double)ls[i];
    }
    __syncthreads();
    sd[tid] = sum;
    __syncthreads();
    double pre = 0.0;
    for (int j = 0; j < tid; ++j) pre += sd[j];
#pragma unroll
    for (int i = 0; i < 16; ++i) { pre += (double)ls[i]; cf[(size_t)bh * SEQ + tid * 16 + i] = (float)pre; }
  }
}

__device__ __forceinline__ void ret_stepA(const Params& p) {
  const u16* VT = (const u16*)(p.ws + WS_VT);
  float* dS = (float*)(p.ws + WS_DS);
  const int tid_ = TIDX, lane = tid_ & 63, w8 = tid_ >> 6, w = w8 & 3, l16 = lane & 15, gk = lane >> 4;
  for (int u2 = BIDX; u2 < 1024; u2 += gridDim.x) {
    const int u = u2 * 2 + (w8 >> 2);
    const int bh = u >> 6, n = u & 63, b = bh >> 3, h = bh & 7;
    const size_t mcol = (size_t)b * SEQ + n * 128;
    f32x4 acc[4];
#pragma unroll
    for (int dt = 0; dt < 4; ++dt) acc[dt] = (f32x4){0.f, 0.f, 0.f, 0.f};
#pragma unroll
    for (int ks = 0; ks < 4; ++ks) {
      bf16x8 af = *(const bf16x8*)(VT + (size_t)(512 + h * 64 + w * 16 + l16) * MTOK + mcol + ks * 32 + gk * 8);
#pragma unroll
      for (int dt = 0; dt < 4; ++dt) {
        bf16x8 bfr = *(const bf16x8*)(VT + (size_t)(1024 + h * 64 + dt * 16 + l16) * MTOK + mcol + ks * 32 + gk * 8);
        acc[dt] = MFMA(af, bfr, acc[dt]);
      }
    }
#pragma unroll
    for (int dt = 0; dt < 4; ++dt)
#pragma unroll
      for (int r = 0; r < 4; ++r) dS[(size_t)u * 4096 + (w * 16 + gk * 4 + r) * 64 + dt * 16 + l16] = acc[dt][r];
  }
}
__device__ __forceinline__ void ret_stepB(const Params& p) {
  const float* dS = (const float*)(p.ws + WS_DS);
  u16* st = (u16*)(p.ws + WS_ST);
  for (int idx = BIDX * NTHR + TIDX; idx < 32 * 4096; idx += gridDim.x * NTHR) {
    const int bh = idx >> 12, ed = idx & 4095, h = bh & 7;
    const float cdec = __expf(log1pf(-exp2f(-5.f - (float)h)) * 128.f);
    float s = 0.f;
#pragma unroll 1
    for (int n0 = 0; n0 < 64; n0 += 16) {
      float d[16];
#pragma unroll
      for (int k = 0; k < 16; ++k) d[k] = dS[(size_t)(bh * 64 + n0 + k) * 4096 + ed];
#pragma unroll
      for (int k = 0; k < 16; ++k) {
        st[(size_t)(bh * 64 + n0 + k) * 4096 + ed] = f2bf(s);
        s = s * cdec + d[k];
      }
    }
  }
}
__device__ __forceinline__ void ret_stepC(const Params& p, u16* lds) {
  const u16* QK = (const u16*)(p.ws + WS_QK);
  const u16* VT = (const u16*)(p.ws + WS_VT);
  const u16* st = (const u16*)(p.ws + WS_ST);
  u16* Y = (u16*)(p.ws + WS_Y);
  const int tid = TIDX, lane = tid & 63, w = tid >> 6, l16 = lane & 15, gk = lane >> 4;
  for (int u = BIDX; u < 2048; u += gridDim.x) {
    const int bh = u >> 6, n = u & 63, b = bh >> 3, h = bh & 7;
    const size_t m0 = (size_t)b * SEQ + n * 128;
    const float lg2 = log1pf(-exp2f(-5.f - (float)h)) * LOG2E;
    __syncthreads();
    {
      uint4 r0;
      TILE_LD(r, QK + m0 * LDQ + 1536 + h * 64, LDQ); TILE_ST(lds, r);
      TILE_LD(r, VT + (size_t)(512 + h * 64) * MTOK + m0, MTOK); TILE_STV(lds + 64 * TS, r);
      TILE_LD(r, QK + (m0 + 64) * LDQ + 1536 + h * 64, LDQ); TILE_ST(lds + 128 * TS, r);
      TILE_LD(r, VT + (size_t)(512 + h * 64) * MTOK + m0 + 64, MTOK); TILE_STV(lds + 192 * TS, r);
      TILE_LD(r, st + (size_t)u * 4096, 64); TILE_ST(lds + 256 * TS, r);
    }
    __syncthreads();
    const int iq = 16 * w + l16;
    const size_t mrow = m0 + iq;
    bf16x8 q[2];
#pragma unroll
    for (int ks = 0; ks < 2; ++ks) q[ks] = *(const bf16x8*)(QK + mrow * LDQ + 1024 + h * 64 + ks * 32 + gk * 8);
    f32x4 o[4];
#pragma unroll
    for (int dt = 0; dt < 4; ++dt) o[dt] = (f32x4){0.f, 0.f, 0.f, 0.f};
#pragma unroll
    for (int dt = 0; dt < 4; ++dt)
#pragma unroll
      for (int ks = 0; ks < 2; ++ks) {
        bf16x8 sf = *(const bf16x8*)(lds + 256 * TS + (dt * 16 + l16) * TS + ks * 32 + gk * 8);
        o[dt] = MFMA(sf, q[ks], o[dt]);
      }
    const float cross = ex2(lg2 * (float)(iq + 1));
#pragma unroll
    for (int dt = 0; dt < 4; ++dt) o[dt] *= cross;
#pragma unroll
    for (int k64 = 0; k64 < 2; ++k64) {
      if (k64 * 64 <= 16 * w + 15) {
        f32x4 s[4];
        qk_tile(lds + k64 * 128 * TS, q, s, l16, gk);
        float pp[4][4];
#pragma unroll
        for (int kt = 0; kt < 4; ++kt)
#pragma unroll
          for (int r = 0; r < 4; ++r) {
            const int j = k64 * 64 + kt * 16 + gk * 4 + r;
            pp[kt][r] = (j <= iq) ? s[kt][r] * 0.125f * ex2(lg2 * (float)(iq - j)) : 0.f;
          }
        pv_tile(lds + k64 * 128 * TS + 64 * TS, pp, o, l16, gk);
      }
    }
    float sm = 0.f;
#pragma unroll
    for (int dt = 0; dt < 4; ++dt) sm += o[dt][0] + o[dt][1] + o[dt][2] + o[dt][3];
    sm += __shfl_xor(sm, 16); sm += __shfl_xor(sm, 32);
    const float mu = sm * (1.f / 64.f);
    float vs = 0.f;
#pragma unroll
    for (int dt = 0; dt < 4; ++dt)
#pragma unroll
      for (int r = 0; r < 4; ++r) { const float d = o[dt][r] - mu; vs += d * d; }
    vs += __shfl_xor(vs, 16); vs += __shfl_xor(vs, 32);
    const float rstd = rsqrtf(vs * (1.f / 64.f) + 1e-5f);
#pragma unroll
    for (int dt = 0; dt < 4; ++dt) {
      const int col = h * 64 + dt * 16 + gk * 4;
      const float4 gg = *(const float4*)(p.e_gn + col);
      const uint2 zz = *(const uint2*)(QK + mrow * LDQ + 2048 + 512 + col);
      const float z0 = bf2f(zz.x & 0xffff), z1 = bf2f(zz.x >> 16), z2 = bf2f(zz.y & 0xffff), z3 = bf2f(zz.y >> 16);
      uint2 ov;
      ov.x = pack2((o[dt][0] - mu) * rstd * gg.x * silu_f(z0), (o[dt][1] - mu) * rstd * gg.y * silu_f(z1));
      ov.y = pack2((o[dt][2] - mu) * rstd * gg.z * silu_f(z2), (o[dt][3] - mu) * rstd * gg.w * silu_f(z3));
      *(uint2*)(Y + mrow * DM + 512 + col) = ov;
    }
  }
}

__device__ __forceinline__ void nsa_tile_interior(const u16* sK, const u16* sV, const bf16x8 (&q)[2], f32x4 (&acc)[4],
                                                  float& m, float& l, float slope2, const float (&sk)[16],
                                                  int t, int pos0, bool lanesel, int lane, bool fixm) {
  const int l16 = lane & 15, gk = lane >> 4;
  const float scale2 = 0.125f * LOG2E;
  f32x4 s[4];
  qk_tile(sK, q, s, l16, gk);
  const float c0 = fmaf(-slope2, (float)(t - pos0 - gk * 4), lanesel ? 0.f : -1e30f);
  float xv[4][4];
  float mx = -1e30f;
#pragma unroll
  for (int kt = 0; kt < 4; ++kt)
#pragma unroll
    for (int r = 0; r < 4; ++r) { xv[kt][r] = fmaf(s[kt][r], scale2, sk[kt * 4 + r]); mx = fmaxf(mx, xv[kt][r]); }
  if (fixm) {
    bf16x8 vf[4][2];
#pragma unroll
    for (int dt = 0; dt < 4; ++dt)
#pragma unroll
      for (int ks2 = 0; ks2 < 2; ++ks2) vf[dt][ks2] = *(const bf16x8*)(sV + (dt * 16 + l16) * TS + ks2 * 32 + gk * 8);
    __builtin_amdgcn_sched_barrier(0);
    const float offf = c0 - m;
    float rsf = 0.f;
#pragma unroll
    for (int kt = 0; kt < 4; ++kt)
#pragma unroll
      for (int r = 0; r < 4; ++r) { xv[kt][r] = ex2(xv[kt][r] + offf); rsf += xv[kt][r]; }
    l += rsf;
    bf16x8 pf[2];
#pragma unroll
    for (int ks2 = 0; ks2 < 2; ++ks2) {
      uint4 tt;
      tt.x = pack2(xv[2 * ks2][0], xv[2 * ks2][1]); tt.y = pack2(xv[2 * ks2][2], xv[2 * ks2][3]);
      tt.z = pack2(xv[2 * ks2 + 1][0], xv[2 * ks2 + 1][1]); tt.w = pack2(xv[2 * ks2 + 1][2], xv[2 * ks2 + 1][3]);
      pf[ks2] = *(bf16x8*)&tt;
    }
    __builtin_amdgcn_s_setprio(1);
#pragma unroll
    for (int dt = 0; dt < 4; ++dt)
#pragma unroll
      for (int ks2 = 0; ks2 < 2; ++ks2) acc[dt] = MFMA(vf[dt][ks2], pf[ks2], acc[dt]);
    __builtin_amdgcn_s_setprio(0);
    return;
  }
  mx += c0;
  mx = fmaxf(mx, __shfl_xor(mx, 16)); mx = fmaxf(mx, __shfl_xor(mx, 32));
  const float mnew = fmaxf(m, mx);
  const float alpha = ex2(m - mnew);
  m = mnew;
  const float off = c0 - fmaxf(mnew, -1e20f);
  float rs = 0.f;
#pragma unroll
  for (int kt = 0; kt < 4; ++kt)
#pragma unroll
    for (int r = 0; r < 4; ++r) { xv[kt][r] = ex2(xv[kt][r] + off); rs += xv[kt][r]; }
  l = l * alpha + rs;
  if (__any(alpha != 1.f)) {
#pragma unroll
    for (int dt = 0; dt < 4; ++dt) acc[dt] *= alpha;
  }
  pv_tile(sV, xv, acc, l16, gk);
}
template <int BR>
__device__ __forceinline__ void nsa_tile(const u16* sK, const u16* sV, const bf16x8 (&q)[2], f32x4 (&acc)[4],
                                         float& m, float& l, float slope2, float gmul,
                                         int t, int pos0, int pstride, int wl, bool lanesel,
                                         float* imp_row, int jbase, float& carry, int lane, float* imp_scale = nullptr, bool fixm = false) {
  const int l16 = lane & 15, gk = lane >> 4;
  const float scale2 = 0.125f * LOG2E;
  const unsigned wle = lanesel ? (unsigned)wl : 0u;
  f32x4 s[4];
  qk_tile(sK, q, s, l16, gk);
  float xv[4][4];
  float mx = -1e30f;
#pragma unroll
  for (int kt = 0; kt < 4; ++kt)
#pragma unroll
    for (int r = 0; r < 4; ++r) {
      const int dist = t - (pos0 + (kt * 16 + gk * 4 + r) * pstride);
      const float pen = ((unsigned)dist < wle) ? 0.f : -1e30f;
      const float v = fmaf(s[kt][r], scale2, fmaf(-slope2, (float)dist, pen));
      xv[kt][r] = v; mx = fmaxf(mx, v);
    }
  if (BR == 2 && fixm) {
    float rsf = 0.f;
#pragma unroll
    for (int kt = 0; kt < 4; ++kt)
#pragma unroll
      for (int r = 0; r < 4; ++r) { xv[kt][r] = ex2(xv[kt][r] - m); rsf += xv[kt][r]; }
    l += rsf;
    pv_tile(sV, xv, acc, l16, gk);
    return;
  }
  if (BR != 1) {
    mx = fmaxf(mx, __shfl_xor(mx, 16)); mx = fmaxf(mx, __shfl_xor(mx, 32));
    const float mnew = fmaxf(m, mx);
    const float alpha = ex2(m - mnew);
    m = mnew;
    const float muse = fmaxf(mnew, -1e20f);
    float rs = 0.f;
#pragma unroll
    for (int kt = 0; kt < 4; ++kt)
#pragma unroll
      for (int r = 0; r < 4; ++r) { xv[kt][r] = ex2(xv[kt][r] - muse); rs += xv[kt][r]; }
    l = l * alpha + rs;
    if (BR == 2 || BR == 3) {
#pragma unroll
      for (int dt = 0; dt < 4; ++dt) acc[dt] *= alpha;
    }
    if (BR == 3) {
      float p3[4];
#pragma unroll
      for (int kt = 0; kt < 4; ++kt) {
        p3[kt] = xv[kt][3];
        imp_row[jbase + kt * 4 + gk] = 2.f * (xv[kt][0] + xv[kt][1] + xv[kt][2]) + xv[kt][3];
      }
      const int srcl = (lane + 48) & 63;
      const float carry_s = carry * alpha;
#pragma unroll
      for (int kt = 0; kt < 4; ++kt) {
        const float same = __shfl(p3[kt], srcl);
        const float prev = __shfl(kt > 0 ? p3[kt > 0 ? kt - 1 : 0] : carry_s, srcl);
        imp_row[jbase + kt * 4 + gk] += (gk == 0) ? prev : same;
      }
      carry = p3[3];
      if (gk == 0) *imp_scale = mnew;
    }
    if (BR == 2 || BR == 3) pv_tile(sV, xv, acc, l16, gk);
  } else {
    const float muse = fmaxf(m, -1e20f);
    float p3[4];
#pragma unroll
    for (int kt = 0; kt < 4; ++kt) {
      float pn[4];
#pragma unroll
      for (int r = 0; r < 4; ++r) { pn[r] = ex2(xv[kt][r] - muse) * l; xv[kt][r] = pn[r] * gmul; }
      p3[kt] = pn[3];
      xv[kt][0] = xv[kt][0];
      imp_row[jbase + kt * 4 + gk] = 2.f * (pn[0] + pn[1] + pn[2]) + pn[3];
    }
    const int srcl = (lane + 48) & 63;
#pragma unroll
    for (int kt = 0; kt < 4; ++kt) {
      const float same = __shfl(p3[kt], srcl);
      const float prev = __shfl(kt > 0 ? p3[kt > 0 ? kt - 1 : 0] : carry, srcl);
      imp_row[jbase + kt * 4 + gk] += (gk == 0) ? prev : same;
    }
    carry = p3[3];
    pv_tile(sV, xv, acc, l16, gk);
  }
}

__device__ __forceinline__ void nsa_phase(const Params& p, u16* lds) {
  const u16* U = (const u16*)(p.ws + WS_QK);
  const u16* VT = (const u16*)(p.ws + WS_VT);
  const u16* KC = (const u16*)(p.ws + WS_KCMP);
  const u16* VC = (const u16*)(p.ws + WS_VCMPT);
  const float* GL = (const float*)(p.ws + WS_GL);
  u16* Y = (u16*)(p.ws + WS_Y);
  float* imp = (float*)(lds + 512 * TS);
  uint32_t* umask = (uint32_t*)(imp + 128 * IMPS);
  int* ulist = (int*)(umask + 4);
  const int tid = TIDX, lane = tid & 63, w = tid >> 6, l16 = lane & 15, gk = lane >> 4;
  const int qt = w & 1, hd = w >> 1;
  uint2* totl = (uint2*)imp + 128 + (size_t)w * 256 + lane;
  const int BIG = 1 << 30;
  int* uslot = ulist + 128;
  unsigned* uctr = (unsigned*)(p.ws + WS_KMAX) + 24;
  for (int tick = 0;; ++tick) {
    if ((tick & 1) == 0) {
      __syncthreads();
      if (tid == 0) uslot[0] = (int)atomicAdd(uctr, 2u);
      __syncthreads();
    }
    const int unit = uslot[0] + (tick & 1);
    if (unit >= 4096) break;
    const int bg = unit & 15, qh = 255 - (unit >> 4), b = bg >> 2, g = bg & 3;
    const int t0 = qh * 32, qb = t0 >> 6, t = t0 + 16 * qt + l16;
    const size_t mrow = (size_t)b * SEQ + t;
    const int h = g * 4 + hd;
    bf16x8 q[2];
#pragma unroll
    for (int ks = 0; ks < 2; ++ks) q[ks] = *(const bf16x8*)(U + mrow * LDQ + h * 64 + ks * 32 + gk * 8);
    const float slope2 = exp2f(-0.5f * (float)(h + 1)) * LOG2E;
    const float g1 = sigmoid_f(GL[mrow * 48 + h * 3] + p.o_bg[h * 3]);
    float sk[16];
#pragma unroll
    for (int i = 0; i < 16; ++i) sk[i] = slope2 * (float)((i >> 2) * 16 + (i & 3));
    float qn2 = 0.f;
#pragma unroll
    for (int ks = 0; ks < 2; ++ks)
#pragma unroll
      for (int e = 0; e < 8; ++e) { const float v = bf2f((u16)q[ks][e]); qn2 += v * v; }
    qn2 += __shfl_xor(qn2, 16); qn2 += __shfl_xor(qn2, 32);
#pragma unroll
    for (int o2 = 1; o2 <= 8; o2 <<= 1) qn2 = fmaxf(qn2, __shfl_xor(qn2, o2));
    const uint32_t* kmx = (const uint32_t*)(p.ws + WS_KMAX);
    const float sc2 = 0.125f * LOG2E;
    const float T_slc = 2.02f * sc2 * sqrtf(qn2 * __uint_as_float(kmx[8 + g])) + 48.f;
    const float T_win = 2.02f * sc2 * sqrtf(qn2 * __uint_as_float(kmx[12 + g])) + 48.f;
    const float T_cmp = 2.05f * sc2 * sqrtf(qn2 * __uint_as_float(kmx[16 + g])) + 16.f * slope2 + 48.f;
    const int tq0w = t0 + 16 * qt;
    const float mfix_slc = 1.01f * sc2 * sqrtf(qn2 * __uint_as_float(kmx[8 + g])), mfix_win = 1.01f * sc2 * sqrtf(qn2 * __uint_as_float(kmx[12 + g]));
    f32x4 acc[4];
    float m = -1e30f, l = 0.f;
#pragma unroll
    for (int dt = 0; dt < 4; ++dt) acc[dt] = (f32x4){0.f, 0.f, 0.f, 0.f};
    __syncthreads();
    for (int i = tid; i < 128 * IMPS; i += NTHR) imp[i] = 0.f;
    if (tid < 4) umask[tid] = 0u;
    float* imp_row = imp + (hd * 32 + 16 * qt + l16) * IMPS;
    float carry = 0.f;
    uint4 rk0, rk1, rk2, rk3, rv0, rv1, rv2, rv3;
#define SLOT(k) (lds + (k) * (128 * TS))
#define LD1(k, kp, ks_, vp, vs_) { rk##k = *(const uint4*)((kp) + (long)(tid >> 3) * (ks_) + (tid & 7) * 8); rv##k = *(const uint4*)((vp) + (long)(tid >> 3) * (vs_) + (tid & 7) * 8); }
#define ST1(k) { *(uint4*)(SLOT(k) + (tid >> 3) * TS + (tid & 7) * 8) = rk##k; TILE_STV_(SLOT(k) + 64 * TS, rv##k) }
    const int ntc = ((t0 >> 4) >> 6) + 1;
    const u16* kcs = KC + (size_t)bg * 512 * 64;
    const u16* vcs = VC + (size_t)bg * 32768;
#define CMP_LD(k, i) if ((i) < ntc) LD1(k, kcs + (size_t)(i) * 64 * 64, 64, vcs + (i) * 64, 512)
    float* mrec = (float*)(uslot + 4) + (w * 16 + l16) * 8;
    {
      const int ngrp = (ntc + 3) >> 2;
      CMP_LD(0, 0) CMP_LD(1, 1) CMP_LD(2, 2) CMP_LD(3, 3)
#pragma unroll 1
      for (int gi = 0; gi < ngrp; ++gi) {
        const int ib = gi * 4;
        __syncthreads();
        if (ib < ntc) ST1(0) if (ib + 1 < ntc) ST1(1) if (ib + 2 < ntc) ST1(2) if (ib + 3 < ntc) ST1(3)
        __syncthreads();
        if (gi + 1 < ngrp) { CMP_LD(0, ib + 4) CMP_LD(1, ib + 5) CMP_LD(2, ib + 6) CMP_LD(3, ib + 7) }
#pragma unroll 1
        for (int k = 0; k < 4; ++k) {
          const int i = ib + k;
          if (i < ntc) {
            const int dmin = tq0w - (16 * (64 * i + 63) + 31);
            if (dmin > 0 && slope2 * (float)dmin > T_cmp) { carry = 0.f; if (gk == 0) mrec[i] = -1e30f; continue; }
            nsa_tile<3>(SLOT(k), SLOT(k) + 64 * TS, q, acc, m, l, slope2, g1, t, 16 * (64 * i) + 31, 16, BIG, true, imp_row, 16 * i, carry, lane, mrec + i);
          }
        }
      }
      float lt = l; lt += __shfl_xor(lt, 16); lt += __shfl_xor(lt, 32);
      const float inv = lt > 0.f ? 1.f / lt : 0.f;
      const float mfin = fmaxf(m, -1e20f);
#pragma unroll 1
      for (int i = 0; i < ntc; ++i) {
        const float f = ex2(fmaxf(mrec[i], -1e20f) - mfin) * inv;
#pragma unroll
        for (int kt = 0; kt < 4; ++kt) imp_row[16 * i + kt * 4 + gk] *= f;
      }
      const float og = g1 * inv;
#pragma unroll
      for (int dt = 0; dt < 4; ++dt) acc[dt] *= og;
    }
    __syncthreads();
    {
      const int qi = w * 4 + gk;
      const int c8 = l16 * 8;
      uint32_t selb = 0u;
      if (qb < 16) {
#pragma unroll
        for (int i = 0; i < 8; ++i) if (c8 + i <= qb) selb |= (1u << i);
      } else {
        float val[8];
        const float* ra = imp + qi * IMPS + c8;
#pragma unroll
        for (int i4 = 0; i4 < 2; ++i4) {
          const float4 v0 = *(const float4*)(ra + 4 * i4);
          const float4 v1 = *(const float4*)(ra + 32 * IMPS + 4 * i4);
          const float4 v2 = *(const float4*)(ra + 64 * IMPS + 4 * i4);
          const float4 v3 = *(const float4*)(ra + 96 * IMPS + 4 * i4);
          val[4 * i4] = ((v0.x + v1.x) + v2.x) + v3.x; val[4 * i4 + 1] = ((v0.y + v1.y) + v2.y) + v3.y;
          val[4 * i4 + 2] = ((v0.z + v1.z) + v2.z) + v3.z; val[4 * i4 + 3] = ((v0.w + v1.w) + v2.w) + v3.w;
        }
#pragma unroll
        for (int i = 0; i < 8; ++i) {
          const int j = c8 + i;
          const bool forced = (j == 0) || (j == qb) || (j == qb - 1);
          if (forced) selb |= (1u << i);
          if (forced || j > qb) val[i] = -1.f;
        }
#pragma unroll 1
        for (int it = 0; it < 13; ++it) {
          float best = -2.f; int bj = 0;
#pragma unroll
          for (int i = 0; i < 8; ++i) {
            const float v = ((selb >> i) & 1u) ? -1.f : val[i];
            if (v > best) { best = v; bj = c8 + i; }
          }
#define TOPK_STEP(N) { const float ov = dpp_ror_f<N>(best); const int oj = dpp_ror_i<N>(bj); if (ov > best || (ov == best && oj < bj)) { best = ov; bj = oj; } }
          TOPK_STEP(1) TOPK_STEP(2) TOPK_STEP(4) TOPK_STEP(8)
#undef TOPK_STEP
          if ((bj >> 3) == l16) selb |= (1u << (bj & 7));
        }
      }
      uint32_t wd = selb << ((l16 & 3) * 8);
      wd |= (uint32_t)dpp_xor1_i((int)wd); wd |= (uint32_t)dpp_xor2_i((int)wd);
      __syncthreads();
      uint32_t* selw = (uint32_t*)imp;
      if ((l16 & 3) == 0) selw[qi * 4 + (l16 >> 2)] = wd;
      uint32_t uq = wd; uq |= __shfl_xor(uq, 16); uq |= __shfl_xor(uq, 32);
      if (gk == 0 && (l16 & 3) == 0) atomicOr(&umask[l16 >> 2], uq);
    }
    __syncthreads();
    const uint32_t* selq = (const uint32_t*)imp + (16 * qt + l16) * 4;
    const uint32_t sel0 = selq[0], sel1 = selq[1], sel2 = selq[2], sel3 = selq[3];
    uint32_t wun0 = sel0, wun1 = sel1, wun2 = sel2, wun3 = sel3;
#define OR_ROW(N) { wun0 |= (uint32_t)dpp_ror_i<N>((int)wun0); wun1 |= (uint32_t)dpp_ror_i<N>((int)wun1); wun2 |= (uint32_t)dpp_ror_i<N>((int)wun2); wun3 |= (uint32_t)dpp_ror_i<N>((int)wun3); }
    OR_ROW(1) OR_ROW(2) OR_ROW(4) OR_ROW(8)
#undef OR_ROW
    int nsl = 0;
    {
      const uint32_t u0 = umask[0], u1 = umask[1], u2 = umask[2], u3 = umask[3];
      nsl = __popc(u0) + __popc(u1) + __popc(u2) + __popc(u3);
      if (tid < 128) {
        const uint32_t uw = tid < 32 ? u0 : tid < 64 ? u1 : tid < 96 ? u2 : u3;
        if ((uw >> (tid & 31)) & 1u) {
          int pos = __popc(uw & ((1u << (tid & 31)) - 1u));
          if (tid >= 32) pos += __popc(u0);
          if (tid >= 64) pos += __popc(u1);
          if (tid >= 96) pos += __popc(u2);
          ulist[pos] = tid;
        }
      }
    }
    __syncthreads();
#pragma unroll
    for (int dt = 0; dt < 4; ++dt) {
      uint2 o2; o2.x = pack2(acc[dt][0], acc[dt][1]); o2.y = pack2(acc[dt][2], acc[dt][3]);
      totl[dt * 64] = o2;
    }
#pragma unroll 1
    for (int br = 1; br < 3; ++br) {
      const float mfix = (br == 1) ? mfix_slc : mfix_win;
      const bool fixm = mfix < 50.f;
      m = fixm ? mfix : -1e30f; l = 0.f;
#pragma unroll
      for (int dt = 0; dt < 4; ++dt) acc[dt] = (f32x4){0.f, 0.f, 0.f, 0.f};
      int wfirst = ((t0 - 511) >> 6) << 6; if (wfirst < 0) wfirst = 0;
      const int nt = (br == 1) ? nsl : ((qb * 64 - wfirst) >> 6) + 1;
      const int ngrp = (nt + 3) >> 2;
      const u16* kb = U + (size_t)b * SEQ * LDQ + (br == 1 ? 1536 : 1792) + g * 64;
      const u16* vb = VT + (size_t)((br == 1 ? 0 : 256) + g * 64) * MTOK + (size_t)b * SEQ;
#define SRC_S0(i) ((br == 1) ? ulist[nt - 1 - (i)] * 64 : wfirst + 64 * (nt - 1 - (i)))
#define BR_LD(k, i) if ((i) < nt) { const int s_ = SRC_S0(i); LD1(k, kb + (size_t)s_ * LDQ, LDQ, vb + s_, MTOK) }
      BR_LD(0, 0) BR_LD(1, 1) BR_LD(2, 2) BR_LD(3, 3)
#pragma unroll 1
      for (int gi = 0; gi < ngrp; ++gi) {
        const int ib = gi * 4;
        __syncthreads();
        if (ib < nt) ST1(0) if (ib + 1 < nt) ST1(1) if (ib + 2 < nt) ST1(2) if (ib + 3 < nt) ST1(3)
        __syncthreads();
        if (gi + 1 < ngrp) { BR_LD(0, ib + 4) BR_LD(1, ib + 5) BR_LD(2, ib + 6) BR_LD(3, ib + 7) }
#pragma unroll 1
        for (int k = 0; k < 4; ++k) {
          const int i = ib + k;
          if (i < nt) {
            const int s0 = SRC_S0(i);
            bool wsel = true, ls = true;
            int wl = 512;
            if (br == 1) {
              const int j = s0 >> 6, jw = j >> 5, jb = j & 31;
              const uint32_t ww = jw == 0 ? wun0 : jw == 1 ? wun1 : jw == 2 ? wun2 : wun3;
              const uint32_t sw = jw == 0 ? sel0 : jw == 1 ? sel1 : jw == 2 ? sel2 : sel3;
              wsel = (ww >> jb) & 1u; ls = (sw >> jb) & 1u; wl = BIG;
            }
            if (wsel) {
              const int dminw = tq0w - (s0 + 63);
              if (dminw > 0 && slope2 * (float)dminw > (br == 1 ? T_slc : T_win)) wsel = false;
            }
            if (wsel) {
              const int tq0 = t0 + 16 * qt;
              const bool interior = (s0 + 63 <= tq0) && (br == 1 || s0 + 512 > tq0 + 15);
              if (interior) nsa_tile_interior(SLOT(k), SLOT(k) + 64 * TS, q, acc, m, l, slope2, sk, t, s0, ls, lane, fixm);
              else nsa_tile<2>(SLOT(k), SLOT(k) + 64 * TS, q, acc, m, l, slope2, g1, t, s0, 1, wl, ls, imp_row, 0, carry, lane, nullptr, fixm);
            }
          }
        }
      }
      {
        float lt = l; lt += __shfl_xor(lt, 16); lt += __shfl_xor(lt, 32);
        const float gt = sigmoid_f(GL[mrow * 48 + h * 3 + br] + p.o_bg[h * 3 + br]);
        const float sc = lt > 0.f ? gt / lt : 0.f;
#pragma unroll
        for (int dt = 0; dt < 4; ++dt) {
          const uint2 pv = totl[dt * 64];
          const float r0 = bf2f(pv.x & 0xffff) + acc[dt][0] * sc, r1 = bf2f(pv.x >> 16) + acc[dt][1] * sc;
          const float r2 = bf2f(pv.y & 0xffff) + acc[dt][2] * sc, r3 = bf2f(pv.y >> 16) + acc[dt][3] * sc;
          if (br == 1) {
            uint2 o2; o2.x = pack2(r0, r1); o2.y = pack2(r2, r3);
            totl[dt * 64] = o2;
          } else {
            const int col = h * 64 + dt * 16 + gk * 4;
            const uint2 zz = *(const uint2*)(U + mrow * LDQ + 2048 + col);
            const float z0 = bf2f(zz.x & 0xffff), z1 = bf2f(zz.x >> 16), z2 = bf2f(zz.y & 0xffff), z3 = bf2f(zz.y >> 16);
            uint2 ov;
            ov.x = pack2(r0 * silu_f(z0), r1 * silu_f(z1));
            ov.y = pack2(r2 * silu_f(z2), r3 * silu_f(z3));
            *(uint2*)(Y + mrow * DM + col) = ov;
          }
        }
      }
    }
#undef SLOT
#undef LD1
#undef ST1
#undef CMP_LD
#undef SRC_S0
#undef BR_LD
  }
}

__device__ __forceinline__ void final_norm(const Params& p) {
  const int lane = TIDX & 63, wave = TIDX >> 6;
  const int nrw = gridDim.x * NWAVE;
  for (int row = BIDX * NWAVE + wave; row < MTOK; row += 2 * nrw) {
    const bool two = (row + nrw < MTOK);
    float4* xr0 = (float4*)(p.out + (size_t)row * DM);
    float4* xr1 = (float4*)(p.out + (size_t)(two ? row + nrw : row) * DM);
    float4 v0[4], v1[4];
    float s0 = 0.f, s1 = 0.f;
#pragma unroll
    for (int i = 0; i < 4; ++i) { v0[i] = xr0[lane + 64 * i]; v1[i] = xr1[lane + 64 * i]; }
#pragma unroll
    for (int i = 0; i < 4; ++i) {
      s0 += v0[i].x * v0[i].x + v0[i].y * v0[i].y + v0[i].z * v0[i].z + v0[i].w * v0[i].w;
      s1 += v1[i].x * v1[i].x + v1[i].y * v1[i].y + v1[i].z * v1[i].z + v1[i].w * v1[i].w;
    }
#pragma unroll
    for (int o = 32; o >= 1; o >>= 1) { s0 += __shfl_xor(s0, o); s1 += __shfl_xor(s1, o); }
    const float r0 = rsqrtf(s0 * (1.f / DM) + 1e-6f), r1 = rsqrtf(s1 * (1.f / DM) + 1e-6f);
#pragma unroll
    for (int i = 0; i < 4; ++i) {
      const float4 gg = ((const float4*)p.fin_g)[lane + 64 * i];
      xr0[lane + 64 * i] = (float4){v0[i].x * r0 * gg.x, v0[i].y * r0 * gg.y, v0[i].z * r0 * gg.z, v0[i].w * r0 * gg.w};
      if (two) xr1[lane + 64 * i] = (float4){v1[i].x * r1 * gg.x, v1[i].y * r1 * gg.y, v1[i].z * r1 * gg.z, v1[i].w * r1 * gg.w};
    }
  }
}

#define XB_XCNT(j)  (64 * (j))
#define XB_XSUB(j)  (1024 + 64 * (j))
#define XB_XGEN(j)  (2048 + 64 * (j))
#define XB_TOP      3072
#define XB_TOPGEN   3136
#define XB_WORDS    3200
#define LAS __attribute__((address_space(3)))
__device__ __forceinline__ unsigned xb_ld(unsigned* q) { return __hip_atomic_load(q, __ATOMIC_RELAXED, __HIP_MEMORY_SCOPE_AGENT); }
__device__ __forceinline__ unsigned xb_add(unsigned* q, unsigned v) { return __hip_atomic_fetch_add(q, v, __ATOMIC_RELAXED, __HIP_MEMORY_SCOPE_AGENT); }
__device__ __forceinline__ unsigned xb_xcc_id() { return (unsigned)__builtin_amdgcn_s_getreg((3 << 11) | 20) & 0xFu; }
__device__ __forceinline__ void grid_bar(const Params& p, unsigned xcc, volatile unsigned* st) {
  asm volatile("s_waitcnt vmcnt(0)" ::: "memory");
  __syncthreads();
  if (TIDX == 0) {
    unsigned* bar = (unsigned*)(p.ws + WS_BAR);
    __builtin_amdgcn_s_waitcnt(0);
    unsigned nloc = st[0], nx = st[1];
    if (nloc == 0u) {
      const unsigned G = gridDim.x;
      for (;;) {
        unsigned sum = 0u, cnt = 0u, mine = 0u, below = 0u;
#pragma unroll
        for (unsigned j = 0; j < 16; ++j) { const unsigned c = xb_ld(&bar[XB_XCNT(j)]); sum += c; cnt += (c > 0u) ? 1u : 0u; mine = (j == xcc) ? c : mine; below += (j < xcc && c > 0u) ? 1u : 0u; }
        nloc = mine; nx = cnt; st[3] = below;
        if (sum == G) break;
        __builtin_amdgcn_s_sleep(1);
      }
      st[0] = nloc; st[1] = nx;
    }
    const unsigned old = xb_add(&bar[XB_XSUB(xcc)], 1u);
    const unsigned gen = old / nloc;
    if (old + 1u == (gen + 1u) * nloc) {
      __builtin_amdgcn_fence(__ATOMIC_RELEASE, "agent");
      asm volatile("s_waitcnt vmcnt(0)" ::: "memory");
      const unsigned og = xb_add(&bar[XB_TOP], 1u);
      const unsigned tg = og / nx;
      if (og + 1u == (tg + 1u) * nx) xb_add(&bar[XB_TOPGEN], 1u);
      else while (xb_ld(&bar[XB_TOPGEN]) == tg) __builtin_amdgcn_s_sleep(1);
      __builtin_amdgcn_fence(__ATOMIC_ACQUIRE, "agent");
      xb_add(&bar[XB_XGEN(xcc)], 1u);
      asm volatile("s_waitcnt vmcnt(0)" ::: "memory");
    } else {
      while (xb_ld(&bar[XB_XGEN(xcc)]) == gen) __builtin_amdgcn_s_sleep(1);
      __builtin_amdgcn_fence(__ATOMIC_ACQUIRE, "agent");
      asm volatile("s_waitcnt vmcnt(0)" ::: "memory");
    }
  }
  __syncthreads();
}

__device__ __forceinline__ void nsa_knorm(const Params& p) {
  if (BIDX < 64) return;
  const u16* U = (const u16*)(p.ws + WS_QK);
  uint32_t* km = (uint32_t*)(p.ws + WS_KMAX);
  const int tid = TIDX, lane = tid & 63, wave = tid >> 6;
  float mx = 0.f;
  for (int row = (BIDX - 64) * NWAVE + wave; row < MTOK; row += (gridDim.x - 64) * NWAVE) {
    const uint4 v = *(const uint4*)(U + (size_t)row * LDQ + 1536 + lane * 8);
    const float a0 = bf2f(v.x & 0xffff), a1 = bf2f(v.x >> 16), a2 = bf2f(v.y & 0xffff), a3 = bf2f(v.y >> 16);
    const float a4 = bf2f(v.z & 0xffff), a5 = bf2f(v.z >> 16), a6 = bf2f(v.w & 0xffff), a7 = bf2f(v.w >> 16);
    float ss = a0 * a0 + a1 * a1 + a2 * a2 + a3 * a3 + a4 * a4 + a5 * a5 + a6 * a6 + a7 * a7;
    ss += __shfl_xor(ss, 1); ss += __shfl_xor(ss, 2); ss += __shfl_xor(ss, 4);
    mx = fmaxf(mx, ss);
  }
  if ((lane & 7) == 0) atomicMax(&km[8 + (lane >> 3)], __float_as_uint(mx));
}

__global__ void __launch_bounds__(NTHR, 2) mega(Params p_in) {
  Params p = p_in;
  p.pad = __builtin_amdgcn_readfirstlane((int)threadIdx.x >> 6);
  extern __shared__ __attribute__((aligned(16))) unsigned char lds_raw[];
  u16* lds = (u16*)lds_raw;
  const unsigned xcc = xb_xcc_id();
  volatile unsigned* bst = (volatile unsigned*)(lds_raw + 147456);
  if (threadIdx.x < 4) bst[threadIdx.x] = 0u;
  __syncthreads();
  if (p_in.coop && threadIdx.x == 0) bst[2] = xb_add((unsigned*)(p_in.ws + WS_BAR) + XB_XCNT(xcc), 1u);
  __syncthreads();
  cg::grid_group grid = cg::this_grid();
  if (p_in.coop == 2) grid.sync();
#define PH_ON(k) (p.ph_lo <= (k) && (k) <= p.ph_hi)
#define PH_SYNC(k) if (p.coop && p.ph_lo <= (k) && (k) < p.ph_hi) grid_bar(p, xcc, bst);
  if (PH_ON(0)) {
    rms_rows_fl(p, (float*)lds);
    conv_t(p, (u16*)(p.ws + WS_WT0), p.e_win, 1024, 4104, 4352, 0);
    conv_t(p, (u16*)(p.ws + WS_WT1), p.o_win, 1024, 3632, 3840, 1);
    conv_t(p, (u16*)(p.ws + WS_WO0), p.e_wout, 1024, 1024, 1024, 2);
    conv_t(p, (u16*)(p.ws + WS_WO1), p.o_wout, 1024, 1024, 1024, 2);
    conv_t(p, (u16*)(p.ws + WS_W1K), p.o_wk1, 2048, 256, 256, 2);
    conv_t(p, (u16*)(p.ws + WS_W1V), p.o_wv1, 2048, 256, 256, 2);
    conv_t(p, (u16*)(p.ws + WS_W2K), p.o_wk2, 256, 64, 256, 2);
    conv_t(p, (u16*)(p.ws + WS_W2V), p.o_wv2, 256, 64, 256, 2);
    pe_partial(p);
    if (BIDX == 0 && TIDX < 32) ((uint32_t*)(p.ws + WS_KMAX))[TIDX] = 0u;
    for (int i = BIDX * NTHR + TIDX; i < MTOK; i += gridDim.x * NTHR) ((float*)(p.ws + WS_SSQ))[i] = 0.f;
  }
  PH_SYNC(0)
  if (PH_ON(1)) gemm_inproj(p, 0, lds, 0);
  PH_SYNC(1)
  if (PH_ON(2)) {
    fox_scan(p, (float*)lds); ret_stepA(p); fox_knorm(p);
    if (BIDX == gridDim.x - 1) {
      for (int i = TIDX; i < 512; i += NTHR) {
        const float* part = (const float*)(p.ws + WS_PEP);
        float sum = 0.f;
        for (int kc = 0; kc < 16; ++kc) sum += part[((i >> 8) * 16 + kc) * 256 + (i & 255)];
        ((float*)(p.ws + WS_PEB))[i] = sum;
      }
    }
  }
  PH_SYNC(2)
  if (PH_ON(3)) { ret_stepB(p); fox_phase(p, lds); }
  PH_SYNC(3)
  if (PH_ON(4)) ret_stepC(p, lds);
  PH_SYNC(4)
  if (PH_ON(5)) gemm_outproj(p, 0, lds);
  PH_SYNC(5)
  if (PH_ON(7)) gemm_inproj(p, 1, lds, 0);
  PH_SYNC(7)
  if (PH_ON(8)) {
    gemm_cmp1(p, lds);
    {
      const pg8::Gemm gg{(const pg8::bf16_t*)(p.ws + WS_HBF), (const pg8::bf16_t*)(p.ws + WS_WT1), MTOK, 0, DM};
      const OrdGL ord{(int)BIDX};
      const EpiGL epi{(float*)(p.ws + WS_GL), (const float*)(p.ws + WS_SSQ)};
      pg8::gemm_phase((__attribute__((address_space(3))) unsigned char*)lds, gg, ord, epi, TIDX);
    }
    nsa_knorm(p);
  }
  PH_SYNC(8)
  if (PH_ON(10)) nsa_phase(p, lds);
  PH_SYNC(10)
  if (PH_ON(11)) gemm_outproj(p, 1, lds);
  PH_SYNC(11)
  if (PH_ON(12)) final_norm(p);
}

extern "C" void kernel_launch(void* const* d_in, const int* in_sizes, int n_in, void* d_out, int out_size, void* d_ws,
                              size_t ws_size, hipStream_t stream) {
  static int grid_blocks = 0;
  if (!grid_blocks) {
    int dev = 0, cus = 0, per_cu = 0;
    hipGetDevice(&dev);
    hipDeviceGetAttribute(&cus, hipDeviceAttributeMultiprocessorCount, dev);
    hipFuncSetAttribute((const void*)mega, hipFuncAttributeMaxDynamicSharedMemorySize, LDS_BYTES);
    hipOccupancyMaxActiveBlocksPerMultiprocessor(&per_cu, (const void*)mega, NTHR, LDS_BYTES);
    if (per_cu < 1) per_cu = 1;
    if (per_cu > 1) per_cu = 1;
    grid_blocks = cus * per_cu;
    (void)hipGetLastError();
  }
  Params p{};
  p.x = (const float*)d_in[0]; p.e_ng = (const float*)d_in[1]; p.e_win = (const float*)d_in[2];
  p.e_bf = (const float*)d_in[3]; p.e_gn = (const float*)d_in[4]; p.e_wout = (const float*)d_in[5];
  p.o_ng = (const float*)d_in[6]; p.o_win = (const float*)d_in[7]; p.o_bg = (const float*)d_in[8];
  p.o_pek = (const float*)d_in[9]; p.o_pev = (const float*)d_in[10]; p.o_wk1 = (const float*)d_in[11];
  p.o_wk2 = (const float*)d_in[12]; p.o_wv1 = (const float*)d_in[13]; p.o_wv2 = (const float*)d_in[14];
  p.o_wout = (const float*)d_in[15]; p.fin_g = (const float*)d_in[16];
  p.out = (float*)d_out; p.ws = (unsigned char*)d_ws;
#if ONE_LAUNCH
  p.ph_lo = 0; p.ph_hi = NPHASE - 1; p.coop = 1;
  (void)hipMemsetAsync((unsigned char*)d_ws + WS_BAR, 0, 16384, stream);
  void* args[] = {&p};
  hipError_t e = hipLaunchCooperativeKernel((const void*)mega, dim3(grid_blocks), dim3(NTHR), args, LDS_BYTES, stream);
  if (e != hipSuccess) fprintf(stderr, "cooperative launch failed: %s (grid %d)\n", hipGetErrorString(e), grid_blocks);
#else
  for (int ph = 0; ph < NPHASE; ++ph) {
    p.ph_lo = ph; p.ph_hi = ph; p.coop = 0;
    hipLaunchKernelGGL(mega, dim3(grid_blocks), dim3(NTHR), LDS_BYTES, stream, p);
  }
#endif
}
```

```cpp
#include <hip/hip_runtime.h>
#include <hip/hip_cooperative_groups.h>
#include <stdint.h>
#include <stdio.h>
namespace cg = cooperative_groups;

typedef unsigned short u16;
typedef short bf16x8 __attribute__((ext_vector_type(8)));
typedef short bf16x4 __attribute__((ext_vector_type(4)));
typedef float f32x4 __attribute__((ext_vector_type(4)));

#ifndef ONE_LAUNCH
#define ONE_LAUNCH 1
#endif

#define MTOK 32768
#define SEQ 8192
#define DM 1024
#define LDQ 3072
#define LOG2E 1.4426950408889634f
#define TS 72
#define IMPS 132
#define LDS_BYTES 147520
#define NTHR 512
#define NWAVE 8
#define NPHASE 13

#define MiB (1024ull * 1024ull)
#define WS_HBF   (0ull)
#define WS_DS    (0ull)
#define WS_ST    (32ull * MiB)
#define WS_QK    (64ull * MiB)
#define WS_VT    (256ull * MiB)
#define WS_Y     (352ull * MiB)
#define WS_WT0   (416ull * MiB)
#define WS_WT1   (WS_WT0 + 4352ull * 1024 * 2)
#define WS_WO0   (WS_WT1 + 3840ull * 1024 * 2)
#define WS_WO1   (WS_WO0 + 1024ull * 1024 * 2)
#define WS_W1K   (WS_WO1 + 1024ull * 1024 * 2)
#define WS_W1V   (WS_W1K + 256ull * 2048 * 2)
#define WS_W2K   (WS_W1V + 256ull * 2048 * 2)
#define WS_W2V   (WS_W2K + 256ull * 256 * 2)
#define WS_FLOG  (440ull * MiB)
#define WS_CFOX  (441ull * MiB)
#define WS_GL    (442ull * MiB)
#define WS_HC    (448ull * MiB)
#define WS_KCMP  (456ull * MiB)
#define WS_VCMPT (457ull * MiB)
#define WS_PEP   (458ull * MiB)
#define WS_PEB   (WS_PEP + 65536ull)
#define WS_KMAX  (WS_PEB + 4096ull)
#define WS_SSQ   (459ull * MiB)
#define WS_BAR   (460ull * MiB)

struct Params {
  const float *x, *e_ng, *e_win, *e_bf, *e_gn, *e_wout;
  const float *o_ng, *o_win, *o_bg, *o_pek, *o_pev, *o_wk1, *o_wk2, *o_wv1, *o_wv2, *o_wout, *fin_g;
  float* out;
  unsigned char* ws;
  int ph_lo, ph_hi, coop, pad;
};

typedef __bf16 bf16v2 __attribute__((ext_vector_type(2)));
typedef float f32v2 __attribute__((ext_vector_type(2)));
__device__ __forceinline__ uint32_t pack2(float a, float b) {
  f32v2 v = {a, b};
  bf16v2 r = __builtin_convertvector(v, bf16v2);
  return *(uint32_t*)&r;
}
__device__ __forceinline__ u16 f2bf(float f) { return (u16)(pack2(f, 0.f) & 0xffffu); }
__device__ __forceinline__ float bf2f(u16 h) { return __uint_as_float(((uint32_t)h) << 16); }
__device__ __forceinline__ float ex2(float x) { return __builtin_amdgcn_exp2f(x); }
__device__ __forceinline__ float silu_f(float z) { return z * __builtin_amdgcn_rcpf(1.f + ex2(-z * LOG2E)); }
__device__ __forceinline__ float sigmoid_f(float z) { return __builtin_amdgcn_rcpf(1.f + ex2(-z * LOG2E)); }

__device__ __forceinline__ int opq(int v) { asm volatile("" : "+v"(v)); return v; }
__device__ __forceinline__ int opqs(int v) { asm volatile("" : "+s"(v)); return v; }
#define TIDX opq(p.pad * 64 + (int)__lane_id())
#define BIDX opqs((int)blockIdx.x)
template <int N> __device__ __forceinline__ int dpp_ror_i(int v) { return __builtin_amdgcn_mov_dpp(v, 0x120 + N, 0xf, 0xf, false); }
template <int N> __device__ __forceinline__ float dpp_ror_f(float v) { return __builtin_bit_cast(float, __builtin_amdgcn_mov_dpp(__builtin_bit_cast(int, v), 0x120 + N, 0xf, 0xf, false)); }
__device__ __forceinline__ int dpp_xor1_i(int v) { return __builtin_amdgcn_mov_dpp(v, 0xB1, 0xf, 0xf, false); }
__device__ __forceinline__ int dpp_xor2_i(int v) { return __builtin_amdgcn_mov_dpp(v, 0x4E, 0xf, 0xf, false); }
#define MFMA(a, b, c) __builtin_amdgcn_mfma_f32_16x16x32_bf16((a), (b), (c), 0, 0, 0)

__device__ __forceinline__ void rms_rows(const Params& p, const float* __restrict__ x, const float* __restrict__ g, u16* __restrict__ h) {
  const int lane = TIDX & 63, wave = TIDX >> 6;
  for (int row = BIDX * NWAVE + wave; row < MTOK; row += gridDim.x * NWAVE) {
    const float4* xr = (const float4*)(x + (size_t)row * DM);
    float4 v[4];
    float ss = 0.f;
#pragma unroll
    for (int i = 0; i < 4; ++i) {
      v[i] = xr[lane + 64 * i];
      ss += v[i].x * v[i].x + v[i].y * v[i].y + v[i].z * v[i].z + v[i].w * v[i].w;
    }
#pragma unroll
    for (int o = 32; o >= 1; o >>= 1) ss += __shfl_xor(ss, o);
    const float rstd = rsqrtf(ss * (1.f / DM) + 1e-6f);
#pragma unroll
    for (int i = 0; i < 4; ++i) {
      float4 gg = ((const float4*)g)[lane + 64 * i];
      uint2 o;
      o.x = pack2(v[i].x * rstd * gg.x, v[i].y * rstd * gg.y);
      o.y = pack2(v[i].z * rstd * gg.z, v[i].w * rstd * gg.w);
      *(uint2*)(h + (size_t)row * DM + (lane + 64 * i) * 4) = o;
    }
  }
}

__device__ __forceinline__ void rms_rows_fl(const Params& p, float* ldsf) {
  const float* __restrict__ x = p.x; const float* __restrict__ g = p.e_ng;
  u16* __restrict__ h = (u16*)(p.ws + WS_HBF);
  float* __restrict__ fl = (float*)(p.ws + WS_FLOG);
  const int tid = TIDX, lane = tid & 63, wave = tid >> 6;
  for (int i = tid; i < 8 * DM; i += NTHR) { const int j = i >> 10, k = i & 1023; ldsf[i] = g[k] * p.e_win[(size_t)k * 4104 + 1536 + j]; }
  __syncthreads();
  for (int row = BIDX * NWAVE + wave; row < MTOK; row += gridDim.x * NWAVE) {
    const float4* xr = (const float4*)(x + (size_t)row * DM);
    float4 v[4];
    float ss = 0.f;
#pragma unroll
    for (int i = 0; i < 4; ++i) {
      v[i] = xr[lane + 64 * i];
      ss += v[i].x * v[i].x + v[i].y * v[i].y + v[i].z * v[i].z + v[i].w * v[i].w;
    }
#pragma unroll
    for (int o = 32; o >= 1; o >>= 1) ss += __shfl_xor(ss, o);
    const float rstd = rsqrtf(ss * (1.f / DM) + 1e-6f);
#pragma unroll
    for (int i = 0; i < 4; ++i) {
      float4 gg = ((const float4*)g)[lane + 64 * i];
      uint2 o;
      o.x = pack2(v[i].x * rstd * gg.x, v[i].y * rstd * gg.y);
      o.y = pack2(v[i].z * rstd * gg.z, v[i].w * rstd * gg.w);
      *(uint2*)(h + (size_t)row * DM + (lane + 64 * i) * 4) = o;
    }
    float myf = 0.f;
#pragma unroll
    for (int j = 0; j < 8; ++j) {
      float d = 0.f;
#pragma unroll
      for (int i = 0; i < 4; ++i) {
        const float4 w4 = *(const float4*)(ldsf + j * DM + (lane + 64 * i) * 4);
        d += v[i].x * w4.x + v[i].y * w4.y + v[i].z * w4.z + v[i].w * w4.w;
      }
#pragma unroll
      for (int o = 32; o >= 1; o >>= 1) d += __shfl_xor(d, o);
      if (lane == j) myf = d * rstd;
    }
    if (lane < 8) fl[(size_t)row * 8 + lane] = myf;
  }
}

__device__ __forceinline__ int map_col(int MAP, int n) {
  if (MAP == 0) {
    if (n < 1024) return n;
    if (n < 2048) return n + 520;
    if (n < 3072) return n + 1032;
    if (n < 3584) return n - 2048;
    if (n < 4096) return n - 1016;
    if (n < 4104) return n - 2560;
    return -1;
  } else if (MAP == 1) {
    if (n < 1792) return n;
    if (n < 2048) return n + 256;
    if (n < 3072) return n + 560;
    if (n < 3328) return n - 1280;
    if (n < 3584) return n - 1024;
    if (n < 3632) return n - 1024;
    return -1;
  } else if (MAP == 2) {
    return n;
  }
  return n;
}

__device__ __forceinline__ void conv_t(const Params& p, u16* __restrict__ dst, const float* __restrict__ src, int K, int nsrc, int ndst, int MAP) {
  const int total = ndst * (K >> 3);
  for (int id = BIDX * NTHR + TIDX; id < total; id += gridDim.x * NTHR) {
    const int n = id % ndst, kc = id / ndst;
    const int sc = map_col(MAP, n);
    const bool okc = (sc >= 0 && sc < nsrc);
    const int scc = okc ? sc : 0;
    float v[8];
#pragma unroll
    for (int i = 0; i < 8; ++i) v[i] = src[(size_t)(kc * 8 + i) * nsrc + scc];
#pragma unroll
    for (int i = 0; i < 8; ++i) v[i] = okc ? v[i] : 0.f;
    uint4 o;
    o.x = pack2(v[0], v[1]); o.y = pack2(v[2], v[3]); o.z = pack2(v[4], v[5]); o.w = pack2(v[6], v[7]);
    *(uint4*)(dst + (size_t)n * K + kc * 8) = o;
  }
}

__device__ __forceinline__ void pe_partial(const Params& p) {
  float* part = (float*)(p.ws + WS_PEP);
  for (int task = BIDX; task < 32; task += gridDim.x) {
    const int kv = task >> 4, kc = task & 15, n = TIDX;
    if (n >= 256) continue;
    const float* pe = kv ? p.o_pev : p.o_pek;
    const float* w1 = kv ? p.o_wv1 : p.o_wk1;
    float acc = 0.f;
#pragma unroll 16
    for (int k = kc * 128; k < kc * 128 + 128; ++k) acc += pe[k] * w1[(size_t)k * 256 + n];
    part[(kv * 16 + kc) * 256 + n] = acc;
  }
}

#define GST (512 * TS)
template <bool swapped>
__device__ __forceinline__ void gemm_compute(const u16* cur, f32x4 (&acc)[8][4], int wpa, int wpb, int l16, int gk) {
  const u16* sA = cur + (wpa * 128 + l16) * TS + gk * 8;
  const u16* sB = cur + (256 + wpb * 64 + l16) * TS + gk * 8;
#pragma unroll 1
  for (int kk = 0; kk < 2; ++kk) {
    bf16x8 fa[8], fb[4];
#pragma unroll
    for (int i = 0; i < 8; ++i) fa[i] = *(const bf16x8*)(sA + i * 16 * TS + kk * 32);
#pragma unroll
    for (int j = 0; j < 4; ++j) fb[j] = *(const bf16x8*)(sB + j * 16 * TS + kk * 32);
    if (swapped) {
#pragma unroll
      for (int i = 0; i < 8; ++i)
#pragma unroll
        for (int j = 0; j < 4; ++j) acc[i][j] = MFMA(fb[j], fa[i], acc[i][j]);
    } else {
#pragma unroll
      for (int i = 0; i < 8; ++i)
#pragma unroll
        for (int j = 0; j < 4; ++j) acc[i][j] = MFMA(fa[i], fb[j], acc[i][j]);
    }
  }
}
template <bool swapped>
__device__ __forceinline__ void gemm_mainloop(const Params& p, const u16* __restrict__ Ab, const uint32_t (&pa)[4], const u16* __restrict__ Bb,
                                              const uint32_t (&pb)[4], int a_kstride, int nk,
                                              u16* lds, f32x4 (&acc)[8][4],
                                              bool primed = false, const u16* __restrict__ Abn = nullptr, const u16* __restrict__ Bbn = nullptr) {
  const int tid = TIDX, lane = tid & 63, wave = tid >> 6;
  const int l16 = lane & 15, gk = lane >> 4;
  const int wpa = wave >> 2, wpb = wave & 3;
  const int woff = (tid >> 3) * TS + (tid & 7) * 8;
  uint4 ra0, ra1, ra2, ra3, rb0, rb1, rb2, rb3;
#define G_LD(kidx) { const u16* Ap_ = Ab + (size_t)(kidx) * a_kstride; const u16* Bp_ = Bb + (size_t)(kidx) * 64;   \
    ra0 = *(const uint4*)(Ap_ + pa[0]); ra1 = *(const uint4*)(Ap_ + pa[1]); ra2 = *(const uint4*)(Ap_ + pa[2]); ra3 = *(const uint4*)(Ap_ + pa[3]); \
    rb0 = *(const uint4*)(Bp_ + pb[0]); rb1 = *(const uint4*)(Bp_ + pb[1]); rb2 = *(const uint4*)(Bp_ + pb[2]); rb3 = *(const uint4*)(Bp_ + pb[3]); }
#define G_ST(D) { u16* D_ = (D) + woff;                                                                               \
    *(uint4*)(D_) = ra0; *(uint4*)(D_ + 64 * TS) = ra1; *(uint4*)(D_ + 128 * TS) = ra2; *(uint4*)(D_ + 192 * TS) = ra3;  \
    *(uint4*)(D_ + 256 * TS) = rb0; *(uint4*)(D_ + 320 * TS) = rb1; *(uint4*)(D_ + 384 * TS) = rb2; *(uint4*)(D_ + 448 * TS) = rb3; }
  if (!primed) {
    G_LD(0)
    __syncthreads();
    G_ST(lds)
    __syncthreads();
  }
#pragma unroll
  for (int i = 0; i < 8; ++i)
#pragma unroll
    for (int j = 0; j < 4; ++j) acc[i][j] = (f32x4){0.f, 0.f, 0.f, 0.f};
#pragma unroll 1
  for (int ks = 0; ks < nk; ++ks) {
    const bool last = (ks + 1 == nk);
    const bool more = !last || (Abn != nullptr);
    if (more) {
      if (!last) G_LD(ks + 1)
      else { const u16* Ab = Abn; const u16* Bb = Bbn; G_LD(0) }
    }
    gemm_compute<swapped>(lds + (ks & 1) * GST, acc, wpa, wpb, l16, gk);
    if (more) G_ST(lds + ((ks + 1) & 1) * GST)
    __syncthreads();
  }
#undef G_LD
#undef G_ST
}
#define GEMM_OFFS(rowstrideA, rowstrideB)                                   \
  uint32_t pa[4], pb[4];                                                    \
  _Pragma("unroll") for (int i = 0; i < 4; ++i) {                           \
    pa[i] = (uint32_t)((tid >> 3) + 64 * i) * (rowstrideA) + (tid & 7) * 8; \
    pb[i] = (uint32_t)((tid >> 3) + 64 * i) * (rowstrideB) + (tid & 7) * 8; \
  }

namespace pg8 {
#define PG8_LAS __attribute__((address_space(3)))
typedef unsigned short bf16_t;
typedef unsigned u32x4 __attribute__((ext_vector_type(4)));
constexpr int BM = 256, BK = 64, HALF = 128, HTB = HALF * BK * 2, STAGE_BYTES = 8 * HTB;
__device__ __forceinline__ int lds_byte(int r, int c) { const int st = (r >> 4) * 2 + (c >> 5), rr = r & 15, cc = c & 31, ob = rr * 64 + cc * 2; return st * 1024 + (ob ^ (((ob >> 9) & 1) << 5)); }
__device__ __forceinline__ void stage_rc(int b, int& R, int& C) { const int st = b / 1024, sb = b % 1024, swz = sb ^ (((sb >> 9) & 1) << 5); R = (st >> 1) * 16 + swz / 64; C = (st & 1) * 32 + (swz % 64) / 2; }
__device__ __forceinline__ int perm32(int rho) { const int n = rho >> 4, i = rho & 15; return 8 * (i >> 2) + 4 * n + (i & 3); }
struct Unit { int pm, pn; };
struct Gemm { const bf16_t* A; const bf16_t* Bt; int M, N, K; };
template <class Epi, class Sched>
__device__ __forceinline__ void gemm_phase(PG8_LAS unsigned char* lds, const Gemm g, const Sched& S, const Epi& E, const int tid) {
    const int wid = __builtin_amdgcn_readfirstlane(tid >> 6), lane = tid & 63, wr = wid >> 2, wc = wid & 3, fr = lane & 15, fq = lane >> 4;
    const int K = g.K, nt = K / BK;
    const int pA = S.pitchA(K), pB = S.pitchB(K);
    unsigned voffA[2], voffB[2];
#pragma unroll
    for (int i = 0; i < 2; ++i) { int R, C; stage_rc(tid * 16 + i * 8192, R, C); const int Rb = Epi::PERM ? ((R & ~31) + perm32(R & 31)) : R;
        voffA[i] = (unsigned)(R * pA + C) * 2u; voffB[i] = (unsigned)(Rb * pB + C) * 2u; }
    const size_t kstepA = S.kstepA(), kstepB = (size_t)(BK * 2);
    const size_t hstepA = (size_t)HALF * pA * 2, hstepB = (size_t)HALF * pB * 2;
    const unsigned ldsw = (unsigned)wid * 1024u;
    const int aoff = lds_byte(wr * 64 + fr, fq * 8), boff = lds_byte(wc * 32 + fr, fq * 8);
#define PG8_SA(b, h) (((b) * 2 + (h)) * HTB)
#define PG8_SB(b, h) ((4 + (b) * 2 + (h)) * HTB)
#define PG8_STAGE(bufoff, gbase, voff) do { _Pragma("unroll") for (int _i = 0; _i < 2; ++_i) \
        __builtin_amdgcn_global_load_lds((const unsigned*)((const char*)(gbase) + (voff)[_i]), (PG8_LAS unsigned*)(lds + (bufoff) + ldsw + _i * 8192), 16, 0, 0); } while (0)
#define PG8_LDA(dst, b, h) do { _Pragma("unroll") for (int m = 0; m < 4; ++m) _Pragma("unroll") for (int k = 0; k < 2; ++k) dst[m][k] = *(const PG8_LAS bf16x8*)(lds + PG8_SA(b, h) + aoff + m * 2048 + k * 1024); } while (0)
#define PG8_LDB(dst, b, h) do { _Pragma("unroll") for (int n = 0; n < 2; ++n) _Pragma("unroll") for (int k = 0; k < 2; ++k) dst[n][k] = *(const PG8_LAS bf16x8*)(lds + PG8_SB(b, h) + boff + n * 2048 + k * 1024); } while (0)
#define PG8_MMA(ai, bj, At, Bt) do { __builtin_amdgcn_s_setprio(1); _Pragma("unroll") for (int m = 0; m < 4; ++m) _Pragma("unroll") for (int n = 0; n < 2; ++n) _Pragma("unroll") for (int k = 0; k < 2; ++k) \
        acc[ai][bj][m][n] = __builtin_amdgcn_mfma_f32_16x16x32_bf16(Bt[n][k], At[m][k], acc[ai][bj][m][n], 0, 0, 0); __builtin_amdgcn_s_setprio(0); } while (0)
#define PG8_WAIT_V(n) asm volatile("s_waitcnt vmcnt(" #n ")" ::: "memory")
#define PG8_WAIT_L(n) asm volatile("s_waitcnt lgkmcnt(" #n ")" ::: "memory")
#define PG8_BAR __builtin_amdgcn_s_barrier()
#define PG8_SCHED __builtin_amdgcn_sched_barrier(0)
    Unit cur, nxt; int ui = 0;
    if (!S.next(0, cur)) return;
    f32x4 acc[2][2][4][2];
#pragma unroll
    for (int a = 0; a < 2; ++a)
#pragma unroll
        for (int b = 0; b < 2; ++b)
#pragma unroll
            for (int m = 0; m < 4; ++m)
#pragma unroll
                for (int n = 0; n < 2; ++n) acc[a][b][m][n] = (f32x4){0.f, 0.f, 0.f, 0.f};
    bf16x8 At[4][2], B0[2][2], B1[2][2];
    const char* cA = S.baseA(g, cur); const char* cB = S.baseB(g, cur);
    S.a_ready(cur);
    PG8_STAGE(PG8_SB(0, 0), cB, voffB); PG8_STAGE(PG8_SA(0, 0), cA, voffA); PG8_STAGE(PG8_SB(0, 1), cB + hstepB, voffB); PG8_STAGE(PG8_SA(0, 1), cA + hstepA, voffA);
    if (wr == 1) PG8_BAR;
    PG8_WAIT_V(4); PG8_BAR;
    PG8_STAGE(PG8_SB(1, 0), cB + kstepB, voffB); PG8_STAGE(PG8_SA(1, 0), cA + kstepA, voffA); PG8_STAGE(PG8_SB(1, 1), cB + hstepB + kstepB, voffB);
    PG8_WAIT_V(6); PG8_BAR;
    for (;;) {
        const bool has_next = S.next(ui + 1, nxt);
        const char* nA = has_next ? S.baseA(g, nxt) : cA; const char* nB = has_next ? S.baseB(g, nxt) : cB;
        for (int t = 0; t < nt; t += 2) {
            const bool last = (t == nt - 2);
            const char* a1 = cA + (size_t)(t + 1) * kstepA;
            const char* a2 = last ? nA : cA + (size_t)(t + 2) * kstepA; const char* b2 = last ? nB : cB + (size_t)(t + 2) * kstepB;
            const char* a3 = a2 + kstepA; const char* b3 = b2 + kstepB;
            if (last && has_next) S.a_ready(nxt);
            PG8_LDB(B0, 0, 0); PG8_SCHED; PG8_LDA(At, 0, 0); PG8_STAGE(PG8_SA(1, 1), a1 + hstepA, voffA);
            PG8_WAIT_L(8); PG8_BAR; PG8_WAIT_L(0); PG8_MMA(0, 0, At, B0); PG8_BAR; PG8_SCHED;
            PG8_LDB(B1, 0, 1); PG8_STAGE(PG8_SB(0, 0), b2, voffB);
            PG8_BAR; PG8_WAIT_L(0); PG8_MMA(0, 1, At, B1); PG8_BAR;
            PG8_LDA(At, 0, 1); PG8_STAGE(PG8_SA(0, 0), a2, voffA);
            PG8_BAR; PG8_WAIT_L(0); PG8_MMA(1, 0, At, B0); PG8_BAR; PG8_SCHED;
            PG8_STAGE(PG8_SB(0, 1), b2 + hstepB, voffB);
            PG8_WAIT_V(6); PG8_BAR; PG8_MMA(1, 1, At, B1); PG8_BAR;
            PG8_LDB(B0, 1, 0); PG8_SCHED; PG8_LDA(At, 1, 0); PG8_STAGE(PG8_SA(0, 1), a2 + hstepA, voffA);
            PG8_WAIT_L(8); PG8_BAR; PG8_WAIT_L(0); PG8_MMA(0, 0, At, B0); PG8_BAR; PG8_SCHED;
            PG8_LDB(B1, 1, 1); PG8_STAGE(PG8_SB(1, 0), b3, voffB);
            PG8_BAR; PG8_WAIT_L(0); PG8_MMA(0, 1, At, B1); PG8_BAR;
            PG8_LDA(At, 1, 1); PG8_STAGE(PG8_SA(1, 0), a3, voffA);
            PG8_BAR; PG8_WAIT_L(0); PG8_MMA(1, 0, At, B0); PG8_BAR; PG8_SCHED;
            PG8_STAGE(PG8_SB(1, 1), b3 + hstepB, voffB);
            PG8_WAIT_V(6); PG8_BAR; PG8_MMA(1, 1, At, B1); PG8_BAR;
        }
        if constexpr (!Epi::AFTER_DRAIN) { E(acc, cur, wr, wc, fr, fq); S.done(cur); }
        if (!has_next) break;
#pragma unroll
        for (int a = 0; a < 2; ++a)
#pragma unroll
            for (int b = 0; b < 2; ++b)
#pragma unroll
                for (int m = 0; m < 4; ++m)
#pragma unroll
                    for (int n = 0; n < 2; ++n) acc[a][b][m][n] = (f32x4){0.f, 0.f, 0.f, 0.f};
        cur = nxt; cA = nA; cB = nB; ++ui;
    }
    PG8_WAIT_V(0);
    if (wr == 0) PG8_BAR;
    PG8_BAR;
    if constexpr (Epi::AFTER_DRAIN) { E.fused(acc, cur, wr, wc, fr, fq, lds, wid, lane); S.done(cur); }
#undef PG8_SA
#undef PG8_SB
#undef PG8_STAGE
#undef PG8_LDA
#undef PG8_LDB
#undef PG8_MMA
#undef PG8_WAIT_V
#undef PG8_WAIT_L
#undef PG8_BAR
#undef PG8_SCHED
}
}

struct OrdTiles {
  int xcd, lrank, nloc, NTn, cmap;
  __device__ __forceinline__ int pitchA(int K) const { return K; }
  __device__ __forceinline__ int pitchB(int K) const { return K; }
  __device__ __forceinline__ size_t kstepA() const { return 128; }
  __device__ __forceinline__ const char* baseA(const pg8::Gemm& g, const pg8::Unit& u) const { return (const char*)g.A + (size_t)u.pm * 256 * g.K * 2; }
  __device__ __forceinline__ const char* baseB(const pg8::Gemm& g, const pg8::Unit& u) const { return (const char*)g.Bt + (size_t)u.pn * 256 * g.K * 2; }
  __device__ __forceinline__ bool next(int i, pg8::Unit& u) const {
    const int q = lrank + i * nloc; if (q >= 16 * NTn) return false;
    u.pm = xcd * 16 + q / NTn; const int j = q % NTn; u.pn = (cmap && j >= 6) ? j + 2 : j; return true;
  }
  __device__ __forceinline__ void a_ready(const pg8::Unit&) const {}
  __device__ __forceinline__ void done(const pg8::Unit&) const {}
};
struct EpiQK {
  static constexpr bool PERM = true, AFTER_DRAIN = false;
  u16* QK; const float* ssq; int layer;
  __device__ __forceinline__ void operator()(const f32x4 (&acc)[2][2][4][2], const pg8::Unit& u, int wr, int wc, int fr, int fq) const {
    const int row0 = u.pm * 256 + wr * 64 + fr, col0 = u.pn * 256 + wc * 32 + 8 * fq;
#pragma unroll
    for (int ai = 0; ai < 2; ++ai)
#pragma unroll
      for (int m = 0; m < 4; ++m) {
        const int row = row0 + ai * 128 + m * 16;
        const float rs = layer ? rsqrtf(ssq[row] * (1.f / DM) + 1e-6f) : 1.f;
        u16* rowp = QK + (size_t)row * LDQ + col0;
#pragma unroll
        for (int bj = 0; bj < 2; ++bj) {
          const f32x4 v0 = acc[ai][bj][m][0] * rs, v1 = acc[ai][bj][m][1] * rs;
          uint4 w; w.x = pack2(v0[0], v0[1]); w.y = pack2(v0[2], v0[3]); w.z = pack2(v1[0], v1[1]); w.w = pack2(v1[2], v1[3]);
          *(uint4*)(rowp + bj * 128) = w;
        }
      }
  }
};
struct OrdTilesT {
  int xcd, lrank, nloc, NTt, layer;
  __device__ __forceinline__ int pitchA(int K) const { return K; }
  __device__ __forceinline__ int pitchB(int K) const { return K; }
  __device__ __forceinline__ size_t kstepA() const { return 128; }
  __device__ __forceinline__ const char* baseA(const pg8::Gemm& g, const pg8::Unit& u) const { return (const char*)g.A + (size_t)u.pm * 256 * g.K * 2; }
  __device__ __forceinline__ const char* baseB(const pg8::Gemm& g, const pg8::Unit& u) const { return (const char*)g.Bt + (size_t)u.pn * 256 * g.K * 2; }
  __device__ __forceinline__ bool next(int i, pg8::Unit& u) const {
    const int q = lrank + i * nloc; if (q >= 16 * NTt) return false;
    u.pn = xcd * 16 + q / NTt; const int j = q % NTt;
    u.pm = layer ? 12 + j : (j < 4 ? 12 + j : 2 + j);
    return true;
  }
  __device__ __forceinline__ void a_ready(const pg8::Unit&) const {}
  __device__ __forceinline__ void done(const pg8::Unit&) const {}
};
struct EpiVT {
  static constexpr bool PERM = true, AFTER_DRAIN = false;
  u16* VT; const float* ssq; int layer;
  __device__ __forceinline__ void operator()(const f32x4 (&acc)[2][2][4][2], const pg8::Unit& u, int wr, int wc, int fr, int fq) const {
    const int n0 = u.pm * 256 + wr * 64 + fr, m0 = u.pn * 256 + wc * 32 + 8 * fq;
    const bool kr = (layer == 0) && (u.pm < 12);
#pragma unroll
    for (int ai = 0; ai < 2; ++ai)
#pragma unroll
      for (int m = 0; m < 4; ++m) {
        const int n = n0 + ai * 128 + m * 16;
        const int trow = kr ? n - 512 : n - 3072;
        const float lg2 = kr ? log1pf(-exp2f(-5.f - (float)((n - 1536) >> 6))) * LOG2E : 0.f;
        u16* rowp = VT + (size_t)trow * MTOK + m0;
#pragma unroll
        for (int bj = 0; bj < 2; ++bj) {
          const int mc = m0 + bj * 128;
          float sc[8];
          if (layer) {
            const float4 q0 = *(const float4*)(ssq + mc), q1 = *(const float4*)(ssq + mc + 4);
            sc[0] = rsqrtf(q0.x * (1.f / DM) + 1e-6f); sc[1] = rsqrtf(q0.y * (1.f / DM) + 1e-6f); sc[2] = rsqrtf(q0.z * (1.f / DM) + 1e-6f); sc[3] = rsqrtf(q0.w * (1.f / DM) + 1e-6f);
            sc[4] = rsqrtf(q1.x * (1.f / DM) + 1e-6f); sc[5] = rsqrtf(q1.y * (1.f / DM) + 1e-6f); sc[6] = rsqrtf(q1.z * (1.f / DM) + 1e-6f); sc[7] = rsqrtf(q1.w * (1.f / DM) + 1e-6f);
          } else {
#pragma unroll
            for (int e = 0; e < 8; ++e) sc[e] = kr ? 0.125f * ex2(lg2 * (float)(127 - ((mc + e) & 127))) : 1.f;
          }
          const f32x4 v0 = acc[ai][bj][m][0], v1 = acc[ai][bj][m][1];
          uint4 w; w.x = pack2(v0[0] * sc[0], v0[1] * sc[1]); w.y = pack2(v0[2] * sc[2], v0[3] * sc[3]);
          w.z = pack2(v1[0] * sc[4], v1[1] * sc[5]); w.w = pack2(v1[2] * sc[6], v1[3] * sc[7]);
          *(uint4*)(rowp + bj * 128) = w;
        }
      }
  }
};
struct OrdCmp {
  int bid; const u16* U; const u16* W1K; const u16* W1V;
  __device__ __forceinline__ bool next(int i, pg8::Unit& u) const { if (i > 0 || bid >= 64) return false; u.pm = bid & 31; u.pn = bid >> 5; return true; }
  __device__ __forceinline__ void a_ready(const pg8::Unit&) const {}
  __device__ __forceinline__ void done(const pg8::Unit&) const {}
  __device__ __forceinline__ int pitchA(int) const { return 16 * LDQ; }
  __device__ __forceinline__ int pitchB(int K) const { return K; }
  __device__ __forceinline__ size_t kstepA() const { return (size_t)LDQ * 2; }
  __device__ __forceinline__ const char* baseA(const pg8::Gemm&, const pg8::Unit& u) const {
    const int r0 = u.pm * 256, bg = r0 >> 9, c0 = r0 & 511, b = bg >> 2, g4 = bg & 3;
    return (const char*)(U + (size_t)(b * SEQ + c0 * 16) * LDQ + 1024 + u.pn * 256 + g4 * 64);
  }
  __device__ __forceinline__ const char* baseB(const pg8::Gemm&, const pg8::Unit& u) const { return (const char*)(u.pn ? W1V : W1K); }
};
struct EpiCmp1 {
  static constexpr bool PERM = true, AFTER_DRAIN = false;
  u16* Hc; const float* peb;
  __device__ __forceinline__ void operator()(const f32x4 (&acc)[2][2][4][2], const pg8::Unit& u, int wr, int wc, int fr, int fq) const {
    const int row0 = u.pm * 256 + wr * 64 + fr, col0 = wc * 32 + 8 * fq, kv = u.pn;
    u16* H = Hc + (size_t)kv * 8192 * 256;
#pragma unroll
    for (int bj = 0; bj < 2; ++bj) {
      const float4 b0 = *(const float4*)(peb + kv * 256 + col0 + bj * 128), b1 = *(const float4*)(peb + kv * 256 + col0 + bj * 128 + 4);
#pragma unroll
      for (int ai = 0; ai < 2; ++ai)
#pragma unroll
        for (int m = 0; m < 4; ++m) {
          const int row = row0 + ai * 128 + m * 16;
          const f32x4 v0 = acc[ai][bj][m][0], v1 = acc[ai][bj][m][1];
          float o[8] = {silu_f(v0[0] + b0.x), silu_f(v0[1] + b0.y), silu_f(v0[2] + b0.z), silu_f(v0[3] + b0.w),
                        silu_f(v1[0] + b1.x), silu_f(v1[1] + b1.y), silu_f(v1[2] + b1.z), silu_f(v1[3] + b1.w)};
          if ((row & 511) == 511) {
#pragma unroll
            for (int e = 0; e < 8; ++e) o[e] = 0.f;
          }
          uint4 w; w.x = pack2(o[0], o[1]); w.y = pack2(o[2], o[3]); w.z = pack2(o[4], o[5]); w.w = pack2(o[6], o[7]);
          *(uint4*)(H + (size_t)row * 256 + col0 + bj * 128) = w;
        }
    }
  }
};
struct EpiRes {
  static constexpr bool PERM = false, AFTER_DRAIN = false;
  const float* res; float* out; u16* hb; float* ssq; const float* g; int layer;
  __device__ __forceinline__ void operator()(const f32x4 (&acc)[2][2][4][2], const pg8::Unit& u, int wr, int wc, int fr, int fq) const {
    const int row0 = u.pm * 256 + wr * 64 + fr, col0 = u.pn * 256 + wc * 32 + 4 * fq;
#pragma unroll
    for (int ai = 0; ai < 2; ++ai)
#pragma unroll
      for (int m = 0; m < 4; ++m) {
        const int row = row0 + ai * 128 + m * 16;
        float sq = 0.f;
#pragma unroll
        for (int bj = 0; bj < 2; ++bj)
#pragma unroll
          for (int n = 0; n < 2; ++n) {
            const int col = col0 + bj * 128 + n * 16;
            const float4 r = *(const float4*)(res + (size_t)row * DM + col);
            const f32x4 a = acc[ai][bj][m][n];
            const float4 v = (float4){r.x + a[0], r.y + a[1], r.z + a[2], r.w + a[3]};
            *(float4*)(out + (size_t)row * DM + col) = v;
            if (layer == 0) {
              const float4 gg = *(const float4*)(g + col);
              uint2 hv; hv.x = pack2(v.x * gg.x, v.y * gg.y); hv.y = pack2(v.z * gg.z, v.w * gg.w);
              *(uint2*)(hb + (size_t)row * DM + col) = hv;
            }
            sq += v.x * v.x + v.y * v.y + v.z * v.z + v.w * v.w;
          }
        sq += __shfl_xor(sq, 16); sq += __shfl_xor(sq, 32);
        if (fq == 0) atomicAdd(ssq + row, sq);
      }
  }
};

__device__ __forceinline__ void gemm_inproj(const Params& p, int layer, u16* lds, int part) {
  const u16* A = (const u16*)(p.ws + WS_HBF);
  const u16* Bt = (const u16*)(p.ws + (layer ? WS_WT1 : WS_WT0));
  u16* QK = (u16*)(p.ws + WS_QK);
  u16* VT = (u16*)(p.ws + WS_VT);
  float* F = (float*)(p.ws + (layer ? WS_GL : WS_FLOG));
  const int NT = layer ? 14 : 16;
  const int seg_trans_end = layer ? 28 : 32;
  const int nvalidF = layer ? 48 : 8, ldf = layer ? 48 : 8;
  const int tid = TIDX, lane = tid & 63, wave = tid >> 6, l16 = lane & 15, gk = lane >> 4;
  const int wpa = wave >> 2, wpb = wave & 3;
  const int bid = BIDX;
  int xcd = bid & 7, nloc = (int)gridDim.x >> 3, lrank = bid >> 3;
  { const uint4 cw = *(const uint4*)((const unsigned char*)lds + 147456);
    const int c0 = __builtin_amdgcn_readfirstlane((int)cw.x), c1 = __builtin_amdgcn_readfirstlane((int)cw.y);
    const int c2 = __builtin_amdgcn_readfirstlane((int)cw.z), c3 = __builtin_amdgcn_readfirstlane((int)cw.w);
    if (c1 == 8 && c0 * 8 == (int)gridDim.x) { xcd = c3; lrank = c2; } }
  if (part == 0) {
    const pg8::Gemm gg{(const pg8::bf16_t*)A, (const pg8::bf16_t*)Bt, MTOK, 0, DM};
    const OrdTiles ord{xcd, lrank, nloc, 12, 0};
    const EpiQK epi{QK, (const float*)(p.ws + WS_SSQ), layer};
    pg8::gemm_phase(( __attribute__((address_space(3))) unsigned char*)lds, gg, ord, epi, tid);
    const pg8::Gemm gt{(const pg8::bf16_t*)Bt, (const pg8::bf16_t*)A, 0, MTOK, DM};
    const OrdTilesT ordt{xcd, lrank, nloc, layer ? 2 : 6, layer};
    const EpiVT epit{VT, (const float*)(p.ws + WS_SSQ), layer};
    pg8::gemm_phase(( __attribute__((address_space(3))) unsigned char*)lds, gt, ordt, epit, tid);
    return;
  }
  const int NTs = layer ? 2 : 6;
#define SPEC_NT(j) (layer ? 12 + (j) : ((j) < 2 ? 6 + (j) : 10 + (j)))
  const int qbeg = part ? bid - 64 : lrank, qend = part ? (bid >= 64 ? 128 : -(1 << 20)) : 16 * NTs, qstep = part ? (int)gridDim.x - 64 : nloc;
  bool primed = false;
  for (int q = qbeg; q < qend; q += qstep) {
    const int mt = part ? q : xcd * 16 + q / NTs, nt = part ? NT : SPEC_NT(q % NTs);
    const int m0 = mt * 256, n0 = nt * 256;
    const int qn = q + qstep;
    const bool has_next = (part == 0) && (qn < qend);
    const u16* Abn = has_next ? A + (size_t)((xcd * 16 + qn / NTs) * 256) * DM : nullptr;
    const u16* Bbn = has_next ? Bt + (size_t)(SPEC_NT(qn % NTs) * 256) * DM : nullptr;
    const int mw = m0 + wpa * 128, nw = n0 + wpb * 64;
    const int seg = nw >> 7;
    int mode;
    if (seg < 24) mode = (layer == 0 && seg >= 12 && seg < 16) ? 2 : 0;
    else if (seg < seg_trans_end) mode = 1;
    else if (seg == seg_trans_end) mode = 3;
    else mode = 4;
    const int seg0 = nt * 2;
    const bool swapped = !((seg0 >= 24 && seg0 < seg_trans_end) || (layer == 0 && seg0 >= 12 && seg0 < 16));
    GEMM_OFFS(DM, DM)
    f32x4 acc[8][4];
    if (swapped) gemm_mainloop<true>(p, A + (size_t)m0 * DM, pa, Bt + (size_t)n0 * DM, pb, 64, 16, lds, acc, primed, Abn, Bbn);
    else gemm_mainloop<false>(p, A + (size_t)m0 * DM, pa, Bt + (size_t)n0 * DM, pb, 64, 16, lds, acc, primed, Abn, Bbn);
    primed = has_next;
    const float* ssq_g = (const float*)(p.ws + WS_SSQ);
    const bool tile_normal = (nt < 12) && !(layer == 0 && nt >= 6 && nt < 8);
    if (tile_normal) {
      u16* stg = lds + GST;
      const int ES = 264;
#pragma unroll 1
      for (int half = 0; half < 2; ++half) {
        __syncthreads();
        if (wpa == half) {
#pragma unroll
          for (int i = 0; i < 8; ++i) {
            const float rs = layer ? rsqrtf(ssq_g[mw + i * 16 + l16] * (1.f / DM) + 1e-6f) : 1.f;
#pragma unroll
            for (int j = 0; j < 4; ++j) {
              uint2 o; o.x = pack2(acc[i][j][0] * rs, acc[i][j][1] * rs); o.y = pack2(acc[i][j][2] * rs, acc[i][j][3] * rs);
              *(uint2*)(stg + (i * 16 + l16) * ES + wpb * 64 + j * 16 + gk * 4) = o;
            }
          }
        }
        __syncthreads();
#pragma unroll
        for (int c = 0; c < 8; ++c) {
          const int idx = tid + NTHR * c, row = idx >> 5, ch = idx & 31;
          const uint4 v = *(const uint4*)(stg + row * ES + ch * 8);
          *(uint4*)(QK + (size_t)(m0 + half * 128 + row) * LDQ + n0 + ch * 8) = v;
        }
      }
      __syncthreads();
    } else if (mode == 0 || mode == 3) {
#pragma unroll
      for (int i = 0; i < 8; ++i) {
        const int m = mw + i * 16 + l16;
        const float rs = layer ? rsqrtf(ssq_g[m] * (1.f / DM) + 1e-6f) : 1.f;
#pragma unroll
        for (int j = 0; j < 4; ++j) {
          const int n = nw + j * 16 + gk * 4;
          const float a0 = acc[i][j][0] * rs, a1 = acc[i][j][1] * rs, a2 = acc[i][j][2] * rs, a3 = acc[i][j][3] * rs;
          if (mode == 0) {
            uint2 o; o.x = pack2(a0, a1); o.y = pack2(a2, a3);
            *(uint2*)(QK + (size_t)m * LDQ + n) = o;
          } else {
            const int nn = n - seg * 128;
            if (nn < nvalidF) *(float4*)(F + (size_t)m * ldf + nn) = (float4){a0, a1, a2, a3};
          }
        }
      }
    } else if (mode == 1 || mode == 2) {
#pragma unroll
      for (int i = 0; i < 8; ++i) {
        const int m = mw + i * 16 + gk * 4;
        float rs0 = 1.f, rs1 = 1.f, rs2 = 1.f, rs3 = 1.f;
        if (layer) {
          const float4 q4 = *(const float4*)(ssq_g + m);
          rs0 = rsqrtf(q4.x * (1.f / DM) + 1e-6f); rs1 = rsqrtf(q4.y * (1.f / DM) + 1e-6f);
          rs2 = rsqrtf(q4.z * (1.f / DM) + 1e-6f); rs3 = rsqrtf(q4.w * (1.f / DM) + 1e-6f);
        }
#pragma unroll
        for (int j = 0; j < 4; ++j) {
          const int n = nw + j * 16 + l16;
          const float a0 = acc[i][j][0] * rs0, a1 = acc[i][j][1] * rs1, a2 = acc[i][j][2] * rs2, a3 = acc[i][j][3] * rs3;
          if (mode == 1) {
            const int trow = n - 3072;
            uint2 o; o.x = pack2(a0, a1); o.y = pack2(a2, a3);
            *(uint2*)(VT + (size_t)trow * MTOK + m) = o;
          } else {
            const int trow = n - 512;
            const int h = (nw - 1536) >> 6;
            const float lg2 = log1pf(-exp2f(-5.f - (float)h)) * LOG2E;
            const float lane_dec = 0.125f * ex2(lg2 * (float)(127 - gk * 4));
            QK[(size_t)(m + 0) * LDQ + n] = f2bf(a0); QK[(size_t)(m + 1) * LDQ + n] = f2bf(a1);
            QK[(size_t)(m + 2) * LDQ + n] = f2bf(a2); QK[(size_t)(m + 3) * LDQ + n] = f2bf(a3);
            const float s0 = a0 * lane_dec * ex2(lg2 * (float)(-(i * 16 + 0))), s1 = a1 * lane_dec * ex2(lg2 * (float)(-(i * 16 + 1)));
            const float s2 = a2 * lane_dec * ex2(lg2 * (float)(-(i * 16 + 2))), s3 = a3 * lane_dec * ex2(lg2 * (float)(-(i * 16 + 3)));
            uint2 o; o.x = pack2(s0, s1); o.y = pack2(s2, s3);
            *(uint2*)(VT + (size_t)trow * MTOK + m) = o;
          }
        }
      }
    }
  }
}

__device__ __forceinline__ void gemm_outproj(const Params& p, int layer, u16* lds) {
  const int tid = TIDX;
  const int bid = BIDX;
  int xcd = bid & 7, nloc = (int)gridDim.x >> 3, lrank = bid >> 3;
  { const uint4 cw = *(const uint4*)((const unsigned char*)lds + 147456);
    const int c0 = __builtin_amdgcn_readfirstlane((int)cw.x), c1 = __builtin_amdgcn_readfirstlane((int)cw.y);
    const int c2 = __builtin_amdgcn_readfirstlane((int)cw.z), c3 = __builtin_amdgcn_readfirstlane((int)cw.w);
    if (c1 == 8 && c0 * 8 == (int)gridDim.x) { xcd = c3; lrank = c2; } }
  const pg8::Gemm gg{(const pg8::bf16_t*)(p.ws + WS_Y), (const pg8::bf16_t*)(p.ws + (layer ? WS_WO1 : WS_WO0)), MTOK, DM, DM};
  const OrdTiles ord{xcd, lrank, nloc, 4, 0};
  const EpiRes epi{layer ? p.out : p.x, p.out, (u16*)(p.ws + WS_HBF), (float*)(p.ws + WS_SSQ) + (layer ? MTOK : 0), p.o_ng, layer};
  pg8::gemm_phase((__attribute__((address_space(3))) unsigned char*)lds, gg, ord, epi, tid);
}

__device__ __forceinline__ void gemm_cmp2_tile(const Params& p, u16* lds, int kv, int mt) {
  const int tid = TIDX, lane = tid & 63, wave = tid >> 6, l16 = lane & 15, gk = lane >> 4;
  const int wpa = wave >> 2, wpb = wave & 3;
  {
    const int m0 = mt * 256;
    const u16* A = (const u16*)(p.ws + WS_HC) + (size_t)kv * 8192 * 256;
    const u16* Bt = (const u16*)(p.ws + (kv ? WS_W2V : WS_W2K));
    GEMM_OFFS(256, 256)
    f32x4 acc[8][4];
    const bool swapped = (kv == 0);
    if (swapped) gemm_mainloop<true>(p, A + (size_t)m0 * 256, pa, Bt, pb, 64, 4, lds, acc);
    else gemm_mainloop<false>(p, A + (size_t)m0 * 256, pa, Bt, pb, 64, 4, lds, acc);
    const int mw = m0 + wpa * 128, nw = wpb * 64;
    if (swapped) {
      u16* kc_ = (u16*)(p.ws + WS_KCMP);
#pragma unroll
      for (int i = 0; i < 8; ++i)
#pragma unroll
        for (int j = 0; j < 4; ++j) {
          const int n = nw + j * 16 + gk * 4;
          const int m = mw + i * 16 + l16;
          if (n < 64) {
            uint2 o; o.x = pack2(acc[i][j][0], acc[i][j][1]); o.y = pack2(acc[i][j][2], acc[i][j][3]);
            *(uint2*)(kc_ + (size_t)m * 64 + n) = o;
          }
        }
      if (wpb == 0) {
        float mxn = 0.f;
#pragma unroll
        for (int i = 0; i < 8; ++i) {
          float ss = 0.f;
#pragma unroll
          for (int j = 0; j < 4; ++j) ss += acc[i][j][0] * acc[i][j][0] + acc[i][j][1] * acc[i][j][1] + acc[i][j][2] * acc[i][j][2] + acc[i][j][3] * acc[i][j][3];
          ss += __shfl_xor(ss, 16); ss += __shfl_xor(ss, 32);
          mxn = fmaxf(mxn, ss);
        }
#pragma unroll
        for (int o2 = 1; o2 <= 8; o2 <<= 1) mxn = fmaxf(mxn, __shfl_xor(mxn, o2));
        if (lane == 0) atomicMax((uint32_t*)(p.ws + WS_KMAX) + 16 + ((mw >> 9) & 3), __float_as_uint(mxn));
      }
    } else {
      u16* vt = (u16*)(p.ws + WS_VCMPT);
#pragma unroll
      for (int i = 0; i < 8; ++i)
#pragma unroll
        for (int j = 0; j < 4; ++j) {
          const int m = mw + i * 16 + gk * 4;
          const int n = nw + j * 16 + l16;
          if (n < 64) {
            uint2 o; o.x = pack2(acc[i][j][0], acc[i][j][1]); o.y = pack2(acc[i][j][2], acc[i][j][3]);
            *(uint2*)(vt + (size_t)(m >> 9) * 32768 + (size_t)n * 512 + (m & 511)) = o;
          }
        }
    }
  }
}

__device__ __forceinline__ void gemm_cmp1(const Params& p, u16* lds) {
  const int tid = TIDX, bid = BIDX;
  const pg8::Gemm gg{nullptr, nullptr, 8192, 256, 2048};
  const OrdCmp ord{bid, (const u16*)(p.ws + WS_QK), (const u16*)(p.ws + WS_W1K), (const u16*)(p.ws + WS_W1V)};
  const EpiCmp1 epi{(u16*)(p.ws + WS_HC), (const float*)(p.ws + WS_PEB)};
  pg8::gemm_phase((__attribute__((address_space(3))) unsigned char*)lds, gg, ord, epi, tid);
  if (bid < 64) {
    __threadfence_block();
    __syncthreads();
    gemm_cmp2_tile(p, lds, bid >> 5, bid & 31);
  }
}

#define TILE_LD(R, src, stride) { R##0 = *(const uint4*)((src) + (long)(tid >> 3) * (stride) + (tid & 7) * 8); }
#define TILE_ST(dst, R) { *(uint4*)((dst) + (tid >> 3) * TS + (tid & 7) * 8) = R##0; }
#define VPOS(c) ((((c) >> 2) * 32) + ((2 * ((c) & 1)) * 8) + ((((c) & 3) >> 1) * 4))
#define TILE_STV_(dst, val) { const int c_ = tid & 7; u16* d_ = (dst) + (tid >> 3) * TS + VPOS(c_); \
    *(uint2*)(d_) = make_uint2((val).x, (val).y); *(uint2*)(d_ + 8) = make_uint2((val).z, (val).w); }
#define TILE_STV(dst, R) TILE_STV_(dst, R##0)
__device__ __forceinline__ void qk_tile(const u16* sK, const bf16x8 (&q)[2], f32x4 (&s)[4], int l16, int gk) {
#pragma unroll
  for (int kt = 0; kt < 4; ++kt) s[kt] = (f32x4){0.f, 0.f, 0.f, 0.f};
  bf16x8 kf[2][4];
#pragma unroll
  for (int ks = 0; ks < 2; ++ks)
#pragma unroll
    for (int kt = 0; kt < 4; ++kt) kf[ks][kt] = *(const bf16x8*)(sK + (kt * 16 + l16) * TS + ks * 32 + gk * 8);
  __builtin_amdgcn_s_setprio(1);
#pragma unroll
  for (int ks = 0; ks < 2; ++ks)
#pragma unroll
    for (int kt = 0; kt < 4; ++kt) s[kt] = MFMA(kf[ks][kt], q[ks], s[kt]);
  __builtin_amdgcn_s_setprio(0);
}
__device__ __forceinline__ void pv_tile(const u16* sV, const float (&pp)[4][4], f32x4 (&o)[4], int l16, int gk) {
  bf16x8 pf[2];
#pragma unroll
  for (int ks2 = 0; ks2 < 2; ++ks2) {
    uint4 t;
    t.x = pack2(pp[2 * ks2][0], pp[2 * ks2][1]); t.y = pack2(pp[2 * ks2][2], pp[2 * ks2][3]);
    t.z = pack2(pp[2 * ks2 + 1][0], pp[2 * ks2 + 1][1]); t.w = pack2(pp[2 * ks2 + 1][2], pp[2 * ks2 + 1][3]);
    pf[ks2] = *(bf16x8*)&t;
  }
  bf16x8 vf[4][2];
#pragma unroll
  for (int dt = 0; dt < 4; ++dt)
#pragma unroll
    for (int ks2 = 0; ks2 < 2; ++ks2) vf[dt][ks2] = *(const bf16x8*)(sV + (dt * 16 + l16) * TS + ks2 * 32 + gk * 8);
  __builtin_amdgcn_s_setprio(1);
#pragma unroll
  for (int dt = 0; dt < 4; ++dt)
#pragma unroll
    for (int ks2 = 0; ks2 < 2; ++ks2) o[dt] = MFMA(vf[dt][ks2], pf[ks2], o[dt]);
  __builtin_amdgcn_s_setprio(0);
}

__device__ __forceinline__ void fox_phase(const Params& p, u16* lds) {
  const u16* QK = (const u16*)(p.ws + WS_QK);
  const u16* VT = (const u16*)(p.ws + WS_VT);
  const float* cf = (const float*)(p.ws + WS_CFOX);
  u16* Y = (u16*)(p.ws + WS_Y);
  const int tid = TIDX, lane = tid & 63, w = tid >> 6, l16 = lane & 15, gk = lane >> 4;
  const float scale2 = 0.125f * LOG2E;
  for (int unit = BIDX; unit < 2048; unit += gridDim.x) {
    const int bh = unit & 31, qblk = 63 - (unit >> 5), b = bh >> 3, h = bh & 7;
    const int tq0 = qblk * 128 + w * 16;
    const int t = tq0 + l16;
    const float* cfr = cf + (size_t)bh * SEQ;
    bf16x8 q[2];
#pragma unroll
    for (int ks = 0; ks < 2; ++ks) q[ks] = *(const bf16x8*)(QK + (size_t)(b * SEQ + t) * LDQ + h * 64 + ks * 32 + gk * 8);
    const float cq2 = cfr[t] * LOG2E;
    f32x4 o[4];
    float m = -1e30f, l = 0.f;
#pragma unroll
    for (int dt = 0; dt < 4; ++dt) o[dt] = (f32x4){0.f, 0.f, 0.f, 0.f};
    const int ntiles = qblk * 2 + 2;
    const int iw = qblk * 2 + (w >> 2);
    const u16* ksrc = QK + (size_t)(b * SEQ) * LDQ + 512 + h * 64;
    const u16* vsrc = VT + (size_t)(h * 64) * MTOK + (size_t)b * SEQ;
    float qs = 0.f;
#pragma unroll
    for (int ks = 0; ks < 2; ++ks)
#pragma unroll
      for (int e = 0; e < 8; ++e) { const float v = bf2f((u16)q[ks][e]); qs += v * v; }
    qs += __shfl_xor(qs, 16); qs += __shfl_xor(qs, 32);
#pragma unroll
    for (int o2 = 1; o2 <= 8; o2 <<= 1) qs = fmaxf(qs, __shfl_xor(qs, o2));
    float* red = (float*)(lds + 256 * TS);
    if (lane == 0) red[w] = qs;
    __syncthreads();
    float qmax2 = red[0];
#pragma unroll
    for (int i = 1; i < NWAVE; ++i) qmax2 = fmaxf(qmax2, red[i]);
    const float kmax2 = __uint_as_float(((const uint32_t*)(p.ws + WS_KMAX))[h]);
    const float T2 = 2.f * scale2 * sqrtf(qmax2 * kmax2) * 1.001f + 48.f;
    const float cfirst2 = cfr[qblk * 128] * LOG2E;
    int i_lo = 0;
    for (int base = qblk * 2 - 1; base >= 0; base -= 64) {
      const int ti = base - lane;
      bool skip = false;
      if (ti >= 0) skip = (cfirst2 - cfr[ti * 64 + 63] * LOG2E) < -T2;
      const unsigned long long bal = __ballot(skip);
      if (bal) { i_lo = base - (int)__builtin_ctzll(bal) + 1; break; }
    }
    uint4 rk0, rv0;
    TILE_LD(rk, ksrc + (size_t)i_lo * 64 * LDQ, LDQ); TILE_LD(rv, vsrc + i_lo * 64, MTOK);
    TILE_ST(lds + (i_lo & 1) * (128 * TS), rk); TILE_STV(lds + (i_lo & 1) * (128 * TS) + 64 * TS, rv);
    __syncthreads();
    for (int i = i_lo; i < ntiles; ++i) {
      u16* cur = lds + (i & 1) * (128 * TS);
      const bool more = (i + 1 < ntiles);
      if (more) { TILE_LD(rk, ksrc + (size_t)(i + 1) * 64 * LDQ, LDQ); TILE_LD(rv, vsrc + (i + 1) * 64, MTOK); }
      if (i <= iw) {
        const int s0 = i * 64;
        const bool diag = (i == iw);
        f32x4 s[4];
        qk_tile(cur, q, s, l16, gk);
        float xv[4][4];
        float mx = -1e30f;
#pragma unroll
        for (int kt = 0; kt < 4; ++kt) {
          const float4 c4 = *(const float4*)(cfr + s0 + kt * 16 + gk * 4);
          const float ck[4] = {c4.x, c4.y, c4.z, c4.w};
#pragma unroll
          for (int r = 0; r < 4; ++r) {
            float v = fmaf(s[kt][r], scale2, cq2 - ck[r] * LOG2E);
            if (diag && (s0 + kt * 16 + gk * 4 + r > t)) v = -1e30f;
            xv[kt][r] = v; mx = fmaxf(mx, v);
          }
        }
        mx = fmaxf(mx, __shfl_xor(mx, 16)); mx = fmaxf(mx, __shfl_xor(mx, 32));
        const float mnew = fmaxf(m, mx);
        const float alpha = ex2(m - mnew);
        m = mnew;
        const float muse = fmaxf(mnew, -1e20f);
        float rs = 0.f;
#pragma unroll
        for (int kt = 0; kt < 4; ++kt)
#pragma unroll
          for (int r = 0; r < 4; ++r) { xv[kt][r] = ex2(xv[kt][r] - muse); rs += xv[kt][r]; }
        l = l * alpha + rs;
#pragma unroll
        for (int dt = 0; dt < 4; ++dt) o[dt] *= alpha;
        pv_tile(cur + 64 * TS, xv, o, l16, gk);
      }
      if (more) { u16* nxt = lds + ((i + 1) & 1) * (128 * TS); TILE_ST(nxt, rk); TILE_STV(nxt + 64 * TS, rv); }
      __syncthreads();
    }
    {
      float lt = l; lt += __shfl_xor(lt, 16); lt += __shfl_xor(lt, 32);
      const float inv = lt > 0.f ? 1.f / lt : 0.f;
      const size_t mrow = (size_t)(b * SEQ + t);
#pragma unroll
      for (int dt = 0; dt < 4; ++dt) {
        const int col = h * 64 + dt * 16 + gk * 4;
        const uint2 zz = *(const uint2*)(QK + mrow * LDQ + 2048 + col);
        const float z0 = bf2f(zz.x & 0xffff), z1 = bf2f(zz.x >> 16), z2 = bf2f(zz.y & 0xffff), z3 = bf2f(zz.y >> 16);
        uint2 ov;
        ov.x = pack2(o[dt][0] * inv * silu_f(z0), o[dt][1] * inv * silu_f(z1));
        ov.y = pack2(o[dt][2] * inv * silu_f(z2), o[dt][3] * inv * silu_f(z3));
        *(uint2*)(Y + mrow * DM + col) = ov;
      }
    }
  }
}

__device__ __forceinline__ void fox_knorm(const Params& p) {
  const u16* QK = (const u16*)(p.ws + WS_QK);
  uint32_t* km = (uint32_t*)(p.ws + WS_KMAX);
  const int tid = TIDX, lane = tid & 63, wave = tid >> 6;
  float mx = 0.f;
  for (int row = BIDX * NWAVE + wave; row < MTOK; row += gridDim.x * NWAVE) {
    const uint4 v = *(const uint4*)(QK + (size_t)row * LDQ + 512 + lane * 8);
    const float a0 = bf2f(v.x & 0xffff), a1 = bf2f(v.x >> 16), a2 = bf2f(v.y & 0xffff), a3 = bf2f(v.y >> 16);
    const float a4 = bf2f(v.z & 0xffff), a5 = bf2f(v.z >> 16), a6 = bf2f(v.w & 0xffff), a7 = bf2f(v.w >> 16);
    float ss = a0 * a0 + a1 * a1 + a2 * a2 + a3 * a3 + a4 * a4 + a5 * a5 + a6 * a6 + a7 * a7;
    ss += __shfl_xor(ss, 1); ss += __shfl_xor(ss, 2); ss += __shfl_xor(ss, 4);
    mx = fmaxf(mx, ss);
  }
  if ((lane & 7) == 0) atomicMax(&km[lane >> 3], __float_as_uint(mx));
}

__device__ __forceinline__ void fox_scan(const Params& p, float* ldsf) {
  const float* fl = (const float*)(p.ws + WS_FLOG);
  float* cf = (float*)(p.ws + WS_CFOX);
  double* sd = (double*)ldsf;
  const int tid = TIDX;
  for (int bh = BIDX; bh < 32; bh += gridDim.x) {
    const int b = bh >> 3, h = bh & 7;
    const float bf = p.e_bf[h];
    float ls[16];
    double sum = 0.0;
#pragma unroll
    for (int i = 0; i < 16; ++i) {
      const float xx = fl[(size_t)(b * SEQ + tid * 16 + i) * 8 + h] + bf;
      ls[i] = fminf(xx, 0.f) - log1pf(__expf(-fabsf(xx)));
      sum += (double)ls[i];
    }
    __syncthreads();
    sd[tid] = sum;
    __syncthreads();
    double pre = 0.0;
    for (int j = 0; j < tid; ++j) pre += sd[j];
#pragma unroll
    for (int i = 0; i < 16; ++i) { pre += (double)ls[i]; cf[(size_t)bh * SEQ + tid * 16 + i] = (float)pre; }
  }
}

__device__ __forceinline__ void ret_stepA(const Params& p) {
  const u16* VT = (const u16*)(p.ws + WS_VT);
  float* dS = (float*)(p.ws + WS_DS);
  const int tid_ = TIDX, lane = tid_ & 63, w8 = tid_ >> 6, w = w8 & 3, l16 = lane & 15, gk = lane >> 4;
  for (int u2 = BIDX; u2 < 1024; u2 += gridDim.x) {
    const int u = u2 * 2 + (w8 >> 2);
    const int bh = u >> 6, n = u & 63, b = bh >> 3, h = bh & 7;
    const size_t mcol = (size_t)b * SEQ + n * 128;
    f32x4 acc[4];
#pragma unroll
    for (int dt = 0; dt < 4; ++dt) acc[dt] = (f32x4){0.f, 0.f, 0.f, 0.f};
#pragma unroll
    for (int ks = 0; ks < 4; ++ks) {
      bf16x8 af = *(const bf16x8*)(VT + (size_t)(512 + h * 64 + w * 16 + l16) * MTOK + mcol + ks * 32 + gk * 8);
#pragma unroll
      for (int dt = 0; dt < 4; ++dt) {
        bf16x8 bfr = *(const bf16x8*)(VT + (size_t)(1024 + h * 64 + dt * 16 + l16) * MTOK + mcol + ks * 32 + gk * 8);
        acc[dt] = MFMA(af, bfr, acc[dt]);
      }
    }
#pragma unroll
    for (int dt = 0; dt < 4; ++dt)
#pragma unroll
      for (int r = 0; r < 4; ++r) dS[(size_t)u * 4096 + (w * 16 + gk * 4 + r) * 64 + dt * 16 + l16] = acc[dt][r];
  }
}
__device__ __forceinline__ void ret_stepB(const Params& p) {
  const float* dS = (const float*)(p.ws + WS_DS);
  u16* st = (u16*)(p.ws + WS_ST);
  for (int idx = BIDX * NTHR + TIDX; idx < 32 * 4096; idx += gridDim.x * NTHR) {
    const int bh = idx >> 12, ed = idx & 4095, h = bh & 7;
    const float cdec = __expf(log1pf(-exp2f(-5.f - (float)h)) * 128.f);
    float s = 0.f;
#pragma unroll 1
    for (int n0 = 0; n0 < 64; n0 += 16) {
      float d[16];
#pragma unroll
      for (int k = 0; k < 16; ++k) d[k] = dS[(size_t)(bh * 64 + n0 + k) * 4096 + ed];
#pragma unroll
      for (int k = 0; k < 16; ++k) {
        st[(size_t)(bh * 64 + n0 + k) * 4096 + ed] = f2bf(s);
        s = s * cdec + d[k];
      }
    }
  }
}
__device__ __forceinline__ void ret_stepC(const Params& p, u16* lds) {
  const u16* QK = (const u16*)(p.ws + WS_QK);
  const u16* VT = (const u16*)(p.ws + WS_VT);
  const u16* st = (const u16*)(p.ws + WS_ST);
  u16* Y = (u16*)(p.ws + WS_Y);
  const int tid = TIDX, lane = tid & 63, w = tid >> 6, l16 = lane & 15, gk = lane >> 4;
  for (int u = BIDX; u < 2048; u += gridDim.x) {
    const int bh = u >> 6, n = u & 63, b = bh >> 3, h = bh & 7;
    const size_t m0 = (size_t)b * SEQ + n * 128;
    const float lg2 = log1pf(-exp2f(-5.f - (float)h)) * LOG2E;
    __syncthreads();
    {
      uint4 r0;
      TILE_LD(r, QK + m0 * LDQ + 1536 + h * 64, LDQ); TILE_ST(lds, r);
      TILE_LD(r, VT + (size_t)(512 + h * 64) * MTOK + m0, MTOK); TILE_STV(lds + 64 * TS, r);
      TILE_LD(r, QK + (m0 + 64) * LDQ + 1536 + h * 64, LDQ); TILE_ST(lds + 128 * TS, r);
      TILE_LD(r, VT + (size_t)(512 + h * 64) * MTOK + m0 + 64, MTOK); TILE_STV(lds + 192 * TS, r);
      TILE_LD(r, st + (size_t)u * 4096, 64); TILE_ST(lds + 256 * TS, r);
    }
    __syncthreads();
    const int iq = 16 * w + l16;
    const size_t mrow = m0 + iq;
    bf16x8 q[2];
#pragma unroll
    for (int ks = 0; ks < 2; ++ks) q[ks] = *(const bf16x8*)(QK + mrow * LDQ + 1024 + h * 64 + ks * 32 + gk * 8);
    f32x4 o[4];
#pragma unroll
    for (int dt = 0; dt < 4; ++dt) o[dt] = (f32x4){0.f, 0.f, 0.f, 0.f};
#pragma unroll
    for (int dt = 0; dt < 4; ++dt)
#pragma unroll
      for (int ks = 0; ks < 2; ++ks) {
        bf16x8 sf = *(const bf16x8*)(lds + 256 * TS + (dt * 16 + l16) * TS + ks * 32 + gk * 8);
        o[dt] = MFMA(sf, q[ks], o[dt]);
      }
    const float cross = ex2(lg2 * (float)(iq + 1));
#pragma unroll
    for (int dt = 0; dt < 4; ++dt) o[dt] *= cross;
#pragma unroll
    for (int k64 = 0; k64 < 2; ++k64) {
      if (k64 * 64 <= 16 * w + 15) {
        f32x4 s[4];
        qk_tile(lds + k64 * 128 * TS, q, s, l16, gk);
        float pp[4][4];
#pragma unroll
        for (int kt = 0; kt < 4; ++kt)
#pragma unroll
          for (int r = 0; r < 4; ++r) {
            const int j = k64 * 64 + kt * 16 + gk * 4 + r;
            pp[kt][r] = (j <= iq) ? s[kt][r] * 0.125f * ex2(lg2 * (float)(iq - j)) : 0.f;
          }
        pv_tile(lds + k64 * 128 * TS + 64 * TS, pp, o, l16, gk);
      }
    }
    float sm = 0.f;
#pragma unroll
    for (int dt = 0; dt < 4; ++dt) sm += o[dt][0] + o[dt][1] + o[dt][2] + o[dt][3];
    sm += __shfl_xor(sm, 16); sm += __shfl_xor(sm, 32);
    const float mu = sm * (1.f / 64.f);
    float vs = 0.f;
#pragma unroll
    for (int dt = 0; dt < 4; ++dt)
#pragma unroll
      for (int r = 0; r < 4; ++r) { const float d = o[dt][r] - mu; vs += d * d; }
    vs += __shfl_xor(vs, 16); vs += __shfl_xor(vs, 32);
    const float rstd = rsqrtf(vs * (1.f / 64.f) + 1e-5f);
#pragma unroll
    for (int dt = 0; dt < 4; ++dt) {
      const int col = h * 64 + dt * 16 + gk * 4;
      const float4 gg = *(const float4*)(p.e_gn + col);
      const uint2 zz = *(const uint2*)(QK + mrow * LDQ + 2048 + 512 + col);
      const float z0 = bf2f(zz.x & 0xffff), z1 = bf2f(zz.x >> 16), z2 = bf2f(zz.y & 0xffff), z3 = bf2f(zz.y >> 16);
      uint2 ov;
      ov.x = pack2((o[dt][0] - mu) * rstd * gg.x * silu_f(z0), (o[dt][1] - mu) * rstd * gg.y * silu_f(z1));
      ov.y = pack2((o[dt][2] - mu) * rstd * gg.z * silu_f(z2), (o[dt][3] - mu) * rstd * gg.w * silu_f(z3));
      *(uint2*)(Y + mrow * DM + 512 + col) = ov;
    }
  }
}

__device__ __forceinline__ void nsa_tile_interior(const u16* sK, const u16* sV, const bf16x8 (&q)[2], f32x4 (&acc)[4],
                                                  float& m, float& l, float slope2, const float (&sk)[16],
                                                  int t, int pos0, bool lanesel, int lane, bool fixm) {
  const int l16 = lane & 15, gk = lane >> 4;
  const float scale2 = 0.125f * LOG2E;
  f32x4 s[4];
  qk_tile(sK, q, s, l16, gk);
  const float c0 = fmaf(-slope2, (float)(t - pos0 - gk * 4), lanesel ? 0.f : -1e30f);
  float xv[4][4];
  float mx = -1e30f;
#pragma unroll
  for (int kt = 0; kt < 4; ++kt)
#pragma unroll
    for (int r = 0; r < 4; ++r) { xv[kt][r] = fmaf(s[kt][r], scale2, sk[kt * 4 + r]); mx = fmaxf(mx, xv[kt][r]); }
  if (fixm) {
    bf16x8 vf[4][2];
#pragma unroll
    for (int dt = 0; dt < 4; ++dt)
#pragma unroll
      for (int ks2 = 0; ks2 < 2; ++ks2) vf[dt][ks2] = *(const bf16x8*)(sV + (dt * 16 + l16) * TS + ks2 * 32 + gk * 8);
    __builtin_amdgcn_sched_barrier(0);
    const float offf = c0 - m;
    float rsf = 0.f;
#pragma unroll
    for (int kt = 0; kt < 4; ++kt)
#pragma unroll
      for (int r = 0; r < 4; ++r) { xv[kt][r] = ex2(xv[kt][r] + offf); rsf += xv[kt][r]; }
    l += rsf;
    bf16x8 pf[2];
#pragma unroll
    for (int ks2 = 0; ks2 < 2; ++ks2) {
      uint4 tt;
      tt.x = pack2(xv[2 * ks2][0], xv[2 * ks2][1]); tt.y = pack2(xv[2 * ks2][2], xv[2 * ks2][3]);
      tt.z = pack2(xv[2 * ks2 + 1][0], xv[2 * ks2 + 1][1]); tt.w = pack2(xv[2 * ks2 + 1][2], xv[2 * ks2 + 1][3]);
      pf[ks2] = *(bf16x8*)&tt;
    }
    __builtin_amdgcn_s_setprio(1);
#pragma unroll
    for (int dt = 0; dt < 4; ++dt)
#pragma unroll
      for (int ks2 = 0; ks2 < 2; ++ks2) acc[dt] = MFMA(vf[dt][ks2], pf[ks2], acc[dt]);
    __builtin_amdgcn_s_setprio(0);
    return;
  }
  mx += c0;
  mx = fmaxf(mx, __shfl_xor(mx, 16)); mx = fmaxf(mx, __shfl_xor(mx, 32));
  const float mnew = fmaxf(m, mx);
  const float alpha = ex2(m - mnew);
  m = mnew;
  const float off = c0 - fmaxf(mnew, -1e20f);
  float rs = 0.f;
#pragma unroll
  for (int kt = 0; kt < 4; ++kt)
#pragma unroll
    for (int r = 0; r < 4; ++r) { xv[kt][r] = ex2(xv[kt][r] + off); rs += xv[kt][r]; }
  l = l * alpha + rs;
  if (__any(alpha != 1.f)) {
#pragma unroll
    for (int dt = 0; dt < 4; ++dt) acc[dt] *= alpha;
  }
  pv_tile(sV, xv, acc, l16, gk);
}
template <int BR>
__device__ __forceinline__ void nsa_tile(const u16* sK, const u16* sV, const bf16x8 (&q)[2], f32x4 (&acc)[4],
                                         float& m, float& l, float slope2, float gmul,
                                         int t, int pos0, int pstride, int wl, bool lanesel,
                                         float* imp_row, int jbase, float& carry, int lane, float* imp_scale = nullptr, bool fixm = false) {
  const int l16 = lane & 15, gk = lane >> 4;
  const float scale2 = 0.125f * LOG2E;
  const unsigned wle = lanesel ? (unsigned)wl : 0u;
  f32x4 s[4];
  qk_tile(sK, q, s, l16, gk);
  float xv[4][4];
  float mx = -1e30f;
#pragma unroll
  for (int kt = 0; kt < 4; ++kt)
#pragma unroll
    for (int r = 0; r < 4; ++r) {
      const int dist = t - (pos0 + (kt * 16 + gk * 4 + r) * pstride);
      const float pen = ((unsigned)dist < wle) ? 0.f : -1e30f;
      const float v = fmaf(s[kt][r], scale2, fmaf(-slope2, (float)dist, pen));
      xv[kt][r] = v; mx = fmaxf(mx, v);
    }
  if (BR == 2 && fixm) {
    float rsf = 0.f;
#pragma unroll
    for (int kt = 0; kt < 4; ++kt)
#pragma unroll
      for (int r = 0; r < 4; ++r) { xv[kt][r] = ex2(xv[kt][r] - m); rsf += xv[kt][r]; }
    l += rsf;
    pv_tile(sV, xv, acc, l16, gk);
    return;
  }
  if (BR != 1) {
    mx = fmaxf(mx, __shfl_xor(mx, 16)); mx = fmaxf(mx, __shfl_xor(mx, 32));
    const float mnew = fmaxf(m, mx);
    const float alpha = ex2(m - mnew);
    m = mnew;
    const float muse = fmaxf(mnew, -1e20f);
    float rs = 0.f;
#pragma unroll
    for (int kt = 0; kt < 4; ++kt)
#pragma unroll
      for (int r = 0; r < 4; ++r) { xv[kt][r] = ex2(xv[kt][r] - muse); rs += xv[kt][r]; }
    l = l * alpha + rs;
    if (BR == 2 || BR == 3) {
#pragma unroll
      for (int dt = 0; dt < 4; ++dt) acc[dt] *= alpha;
    }
    if (BR == 3) {
      float p3[4];
#pragma unroll
      for (int kt = 0; kt < 4; ++kt) {
        p3[kt] = xv[kt][3];
        imp_row[jbase + kt * 4 + gk] = 2.f * (xv[kt][0] + xv[kt][1] + xv[kt][2]) + xv[kt][3];
      }
      const int srcl = (lane + 48) & 63;
      const float carry_s = carry * alpha;
#pragma unroll
      for (int kt = 0; kt < 4; ++kt) {
        const float same = __shfl(p3[kt], srcl);
        const float prev = __shfl(kt > 0 ? p3[kt > 0 ? kt - 1 : 0] : carry_s, srcl);
        imp_row[jbase + kt * 4 + gk] += (gk == 0) ? prev : same;
      }
      carry = p3[3];
      if (gk == 0) *imp_scale = mnew;
    }
    if (BR == 2 || BR == 3) pv_tile(sV, xv, acc, l16, gk);
  } else {
    const float muse = fmaxf(m, -1e20f);
    float p3[4];
#pragma unroll
    for (int kt = 0; kt < 4; ++kt) {
      float pn[4];
#pragma unroll
      for (int r = 0; r < 4; ++r) { pn[r] = ex2(xv[kt][r] - muse) * l; xv[kt][r] = pn[r] * gmul; }
      p3[kt] = pn[3];
      xv[kt][0] = xv[kt][0];
      imp_row[jbase + kt * 4 + gk] = 2.f * (pn[0] + pn[1] + pn[2]) + pn[3];
    }
    const int srcl = (lane + 48) & 63;
#pragma unroll
    for (int kt = 0; kt < 4; ++kt) {
      const float same = __shfl(p3[kt], srcl);
      const float prev = __shfl(kt > 0 ? p3[kt > 0 ? kt - 1 : 0] : carry, srcl);
      imp_row[jbase + kt * 4 + gk] += (gk == 0) ? prev : same;
    }
    carry = p3[3];
    pv_tile(sV, xv, acc, l16, gk);
  }
}

__device__ __forceinline__ void nsa_phase(const Params& p, u16* lds) {
  const u16* U = (const u16*)(p.ws + WS_QK);
  const u16* VT = (const u16*)(p.ws + WS_VT);
  const u16* KC = (const u16*)(p.ws + WS_KCMP);
  const u16* VC = (const u16*)(p.ws + WS_VCMPT);
  const float* GL = (const float*)(p.ws + WS_GL);
  u16* Y = (u16*)(p.ws + WS_Y);
  float* imp = (float*)(lds + 512 * TS);
  uint32_t* umask = (uint32_t*)(imp + 128 * IMPS);
  int* ulist = (int*)(umask + 4);
  const int tid = TIDX, lane = tid & 63, w = tid >> 6, l16 = lane & 15, gk = lane >> 4;
  const int qt = w & 1, hd = w >> 1;
  uint2* totl = (uint2*)imp + 128 + (size_t)w * 256 + lane;
  const int BIG = 1 << 30;
  int* uslot = ulist + 128;
  unsigned* uctr = (unsigned*)(p.ws + WS_KMAX) + 24;
  for (int tick = 0;; ++tick) {
    if ((tick & 1) == 0) {
      __syncthreads();
      if (tid == 0) uslot[0] = (int)atomicAdd(uctr, 2u);
      __syncthreads();
    }
    const int unit = uslot[0] + (tick & 1);
    if (unit >= 4096) break;
    const int bg = unit & 15, qh = 255 - (unit >> 4), b = bg >> 2, g = bg & 3;
    const int t0 = qh * 32, qb = t0 >> 6, t = t0 + 16 * qt + l16;
    const size_t mrow = (size_t)b * SEQ + t;
    const int h = g * 4 + hd;
    bf16x8 q[2];
#pragma unroll
    for (int ks = 0; ks < 2; ++ks) q[ks] = *(const bf16x8*)(U + mrow * LDQ + h * 64 + ks * 32 + gk * 8);
    const float slope2 = exp2f(-0.5f * (float)(h + 1)) * LOG2E;
    const float g1 = sigmoid_f(GL[mrow * 48 + h * 3] + p.o_bg[h * 3]);
    float sk[16];
#pragma unroll
    for (int i = 0; i < 16; ++i) sk[i] = slope2 * (float)((i >> 2) * 16 + (i & 3));
    float qn2 = 0.f;
#pragma unroll
    for (int ks = 0; ks < 2; ++ks)
#pragma unroll
      for (int e = 0; e < 8; ++e) { const float v = bf2f((u16)q[ks][e]); qn2 += v * v; }
    qn2 += __shfl_xor(qn2, 16); qn2 += __shfl_xor(qn2, 32);
#pragma unroll
    for (int o2 = 1; o2 <= 8; o2 <<= 1) qn2 = fmaxf(qn2, __shfl_xor(qn2, o2));
    const uint32_t* kmx = (const uint32_t*)(p.ws + WS_KMAX);
    const float sc2 = 0.125f * LOG2E;
    const float T_slc = 2.02f * sc2 * sqrtf(qn2 * __uint_as_float(kmx[8 + g])) + 48.f;
    const float T_win = 2.02f * sc2 * sqrtf(qn2 * __uint_as_float(kmx[12 + g])) + 48.f;
    const float T_cmp = 2.05f * sc2 * sqrtf(qn2 * __uint_as_float(kmx[16 + g])) + 16.f * slope2 + 48.f;
    const int tq0w = t0 + 16 * qt;
    const float mfix_slc = 1.01f * sc2 * sqrtf(qn2 * __uint_as_float(kmx[8 + g])), mfix_win = 1.01f * sc2 * sqrtf(qn2 * __uint_as_float(kmx[12 + g]));
    f32x4 acc[4];
    float m = -1e30f, l = 0.f;
#pragma unroll
    for (int dt = 0; dt < 4; ++dt) acc[dt] = (f32x4){0.f, 0.f, 0.f, 0.f};
    __syncthreads();
    for (int i = tid; i < 128 * IMPS; i += NTHR) imp[i] = 0.f;
    if (tid < 4) umask[tid] = 0u;
    float* imp_row = imp + (hd * 32 + 16 * qt + l16) * IMPS;
    float carry = 0.f;
    uint4 rk0, rk1, rk2, rk3, rv0, rv1, rv2, rv3;
#define SLOT(k) (lds + (k) * (128 * TS))
#define LD1(k, kp, ks_, vp, vs_) { rk##k = *(const uint4*)((kp) + (long)(tid >> 3) * (ks_) + (tid & 7) * 8); rv##k = *(const uint4*)((vp) + (long)(tid >> 3) * (vs_) + (tid & 7) * 8); }
#define ST1(k) { *(uint4*)(SLOT(k) + (tid >> 3) * TS + (tid & 7) * 8) = rk##k; TILE_STV_(SLOT(k) + 64 * TS, rv##k) }
    const int ntc = ((t0 >> 4) >> 6) + 1;
    const u16* kcs = KC + (size_t)bg * 512 * 64;
    const u16* vcs = VC + (size_t)bg * 32768;
#define CMP_LD(k, i) if ((i) < ntc) LD1(k, kcs + (size_t)(i) * 64 * 64, 64, vcs + (i) * 64, 512)
    float* mrec = (float*)(uslot + 4) + (w * 16 + l16) * 8;
    {
      const int ngrp = (ntc + 3) >> 2;
      CMP_LD(0, 0) CMP_LD(1, 1) CMP_LD(2, 2) CMP_LD(3, 3)
#pragma unroll 1
      for (int gi = 0; gi < ngrp; ++gi) {
        const int ib = gi * 4;
        __syncthreads();
        if (ib < ntc) ST1(0) if (ib + 1 < ntc) ST1(1) if (ib + 2 < ntc) ST1(2) if (ib + 3 < ntc) ST1(3)
        __syncthreads();
        if (gi + 1 < ngrp) { CMP_LD(0, ib + 4) CMP_LD(1, ib + 5) CMP_LD(2, ib + 6) CMP_LD(3, ib + 7) }
#pragma unroll 1
        for (int k = 0; k < 4; ++k) {
          const int i = ib + k;
          if (i < ntc) {
            const int dmin = tq0w - (16 * (64 * i + 63) + 31);
            if (dmin > 0 && slope2 * (float)dmin > T_cmp) { carry = 0.f; if (gk == 0) mrec[i] = -1e30f; continue; }
            nsa_tile<3>(SLOT(k), SLOT(k) + 64 * TS, q, acc, m, l, slope2, g1, t, 16 * (64 * i) + 31, 16, BIG, true, imp_row, 16 * i, carry, lane, mrec + i);
          }
        }
      }
      float lt = l; lt += __shfl_xor(lt, 16); lt += __shfl_xor(lt, 32);
      const float inv = lt > 0.f ? 1.f / lt : 0.f;
      const float mfin = fmaxf(m, -1e20f);
#pragma unroll 1
      for (int i = 0; i < ntc; ++i) {
        const float f = ex2(fmaxf(mrec[i], -1e20f) - mfin) * inv;
#pragma unroll
        for (int kt = 0; kt < 4; ++kt) imp_row[16 * i + kt * 4 + gk] *= f;
      }
      const float og = g1 * inv;
#pragma unroll
      for (int dt = 0; dt < 4; ++dt) acc[dt] *= og;
    }
    __syncthreads();
    {
      const int qi = w * 4 + gk;
      const int c8 = l16 * 8;
      uint32_t selb = 0u;
      if (qb < 16) {
#pragma unroll
        for (int i = 0; i < 8; ++i) if (c8 + i <= qb) selb |= (1u << i);
      } else {
        float val[8];
        const float* ra = imp + qi * IMPS + c8;
#pragma unroll
        for (int i4 = 0; i4 < 2; ++i4) {
          const float4 v0 = *(const float4*)(ra + 4 * i4);
          const float4 v1 = *(const float4*)(ra + 32 * IMPS + 4 * i4);
          const float4 v2 = *(const float4*)(ra + 64 * IMPS + 4 * i4);
          const float4 v3 = *(const float4*)(ra + 96 * IMPS + 4 * i4);
          val[4 * i4] = ((v0.x + v1.x) + v2.x) + v3.x; val[4 * i4 + 1] = ((v0.y + v1.y) + v2.y) + v3.y;
          val[4 * i4 + 2] = ((v0.z + v1.z) + v2.z) + v3.z; val[4 * i4 + 3] = ((v0.w + v1.w) + v2.w) + v3.w;
        }
#pragma unroll
        for (int i = 0; i < 8; ++i) {
          const int j = c8 + i;
          const bool forced = (j == 0) || (j == qb) || (j == qb - 1);
          if (forced) selb |= (1u << i);
          if (forced || j > qb) val[i] = -1.f;
        }
#pragma unroll 1
        for (int it = 0; it < 13; ++it) {
          float best = -2.f; int bj = 0;
#pragma unroll
          for (int i = 0; i < 8; ++i) {
            const float v = ((selb >> i) & 1u) ? -1.f : val[i];
            if (v > best) { best = v; bj = c8 + i; }
          }
#define TOPK_STEP(N) { const float ov = dpp_ror_f<N>(best); const int oj = dpp_ror_i<N>(bj); if (ov > best || (ov == best && oj < bj)) { best = ov; bj = oj; } }
          TOPK_STEP(1) TOPK_STEP(2) TOPK_STEP(4) TOPK_STEP(8)
#undef TOPK_STEP
          if ((bj >> 3) == l16) selb |= (1u << (bj & 7));
        }
      }
      uint32_t wd = selb << ((l16 & 3) * 8);
      wd |= (uint32_t)dpp_xor1_i((int)wd); wd |= (uint32_t)dpp_xor2_i((int)wd);
      __syncthreads();
      uint32_t* selw = (uint32_t*)imp;
      if ((l16 & 3) == 0) selw[qi * 4 + (l16 >> 2)] = wd;
      uint32_t uq = wd; uq |= __shfl_xor(uq, 16); uq |= __shfl_xor(uq, 32);
      if (gk == 0 && (l16 & 3) == 0) atomicOr(&umask[l16 >> 2], uq);
    }
    __syncthreads();
    const uint32_t* selq = (const uint32_t*)imp + (16 * qt + l16) * 4;
    const uint32_t sel0 = selq[0], sel1 = selq[1], sel2 = selq[2], sel3 = selq[3];
    uint32_t wun0 = sel0, wun1 = sel1, wun2 = sel2, wun3 = sel3;
#define OR_ROW(N) { wun0 |= (uint32_t)dpp_ror_i<N>((int)wun0); wun1 |= (uint32_t)dpp_ror_i<N>((int)wun1); wun2 |= (uint32_t)dpp_ror_i<N>((int)wun2); wun3 |= (uint32_t)dpp_ror_i<N>((int)wun3); }
    OR_ROW(1) OR_ROW(2) OR_ROW(4) OR_ROW(8)
#undef OR_ROW
    int nsl = 0;
    {
      const uint32_t u0 = umask[0], u1 = umask[1], u2 = umask[2], u3 = umask[3];
      nsl = __popc(u0) + __popc(u1) + __popc(u2) + __popc(u3);
      if (tid < 128) {
        const uint32_t uw = tid < 32 ? u0 : tid < 64 ? u1 : tid < 96 ? u2 : u3;
        if ((uw >> (tid & 31)) & 1u) {
          int pos = __popc(uw & ((1u << (tid & 31)) - 1u));
          if (tid >= 32) pos += __popc(u0);
          if (tid >= 64) pos += __popc(u1);
          if (tid >= 96) pos += __popc(u2);
          ulist[pos] = tid;
        }
      }
    }
    __syncthreads();
#pragma unroll
    for (int dt = 0; dt < 4; ++dt) {
      uint2 o2; o2.x = pack2(acc[dt][0], acc[dt][1]); o2.y = pack2(acc[dt][2], acc[dt][3]);
      totl[dt * 64] = o2;
    }
#pragma unroll 1
    for (int br = 1; br < 3; ++br) {
      const float mfix = (br == 1) ? mfix_slc : mfix_win;
      const bool fixm = mfix < 50.f;
      m = fixm ? mfix : -1e30f; l = 0.f;
#pragma unroll
      for (int dt = 0; dt < 4; ++dt) acc[dt] = (f32x4){0.f, 0.f, 0.f, 0.f};
      int wfirst = ((t0 - 511) >> 6) << 6; if (wfirst < 0) wfirst = 0;
      const int nt = (br == 1) ? nsl : ((qb * 64 - wfirst) >> 6) + 1;
      const int ngrp = (nt + 3) >> 2;
      const u16* kb = U + (size_t)b * SEQ * LDQ + (br == 1 ? 1536 : 1792) + g * 64;
      const u16* vb = VT + (size_t)((br == 1 ? 0 : 256) + g * 64) * MTOK + (size_t)b * SEQ;
#define SRC_S0(i) ((br == 1) ? ulist[nt - 1 - (i)] * 64 : wfirst + 64 * (nt - 1 - (i)))
#define BR_LD(k, i) if ((i) < nt) { const int s_ = SRC_S0(i); LD1(k, kb + (size_t)s_ * LDQ, LDQ, vb + s_, MTOK) }
      BR_LD(0, 0) BR_LD(1, 1) BR_LD(2, 2) BR_LD(3, 3)
#pragma unroll 1
      for (int gi = 0; gi < ngrp; ++gi) {
        const int ib = gi * 4;
        __syncthreads();
        if (ib < nt) ST1(0) if (ib + 1 < nt) ST1(1) if (ib + 2 < nt) ST1(2) if (ib + 3 < nt) ST1(3)
        __syncthreads();
        if (gi + 1 < ngrp) { BR_LD(0, ib + 4) BR_LD(1, ib + 5) BR_LD(2, ib + 6) BR_LD(3, ib + 7) }
#pragma unroll 1
        for (int k = 0; k < 4; ++k) {
          const int i = ib + k;
          if (i < nt) {
            const int s0 = SRC_S0(i);
            bool wsel = true, ls = true;
            int wl = 512;
            if (br == 1) {
              const int j = s0 >> 6, jw = j >> 5, jb = j & 31;
              const uint32_t ww = jw == 0 ? wun0 : jw == 1 ? wun1 : jw == 2 ? wun2 : wun3;
              const uint32_t sw = jw == 0 ? sel0 : jw == 1 ? sel1 : jw == 2 ? sel2 : sel3;
              wsel = (ww >> jb) & 1u; ls = (sw >> jb) & 1u; wl = BIG;
            }
            if (wsel) {
              const int dminw = tq0w - (s0 + 63);
              if (dminw > 0 && slope2 * (float)dminw > (br == 1 ? T_slc : T_win)) wsel = false;
            }
            if (wsel) {
              const int tq0 = t0 + 16 * qt;
              const bool interior = (s0 + 63 <= tq0) && (br == 1 || s0 + 512 > tq0 + 15);
              if (interior) nsa_tile_interior(SLOT(k), SLOT(k) + 64 * TS, q, acc, m, l, slope2, sk, t, s0, ls, lane, fixm);
              else nsa_tile<2>(SLOT(k), SLOT(k) + 64 * TS, q, acc, m, l, slope2, g1, t, s0, 1, wl, ls, imp_row, 0, carry, lane, nullptr, fixm);
            }
          }
        }
      }
      {
        float lt = l; lt += __shfl_xor(lt, 16); lt += __shfl_xor(lt, 32);
        const float gt = sigmoid_f(GL[mrow * 48 + h * 3 + br] + p.o_bg[h * 3 + br]);
        const float sc = lt > 0.f ? gt / lt : 0.f;
#pragma unroll
        for (int dt = 0; dt < 4; ++dt) {
          const uint2 pv = totl[dt * 64];
          const float r0 = bf2f(pv.x & 0xffff) + acc[dt][0] * sc, r1 = bf2f(pv.x >> 16) + acc[dt][1] * sc;
          const float r2 = bf2f(pv.y & 0xffff) + acc[dt][2] * sc, r3 = bf2f(pv.y >> 16) + acc[dt][3] * sc;
          if (br == 1) {
            uint2 o2; o2.x = pack2(r0, r1); o2.y = pack2(r2, r3);
            totl[dt * 64] = o2;
          } else {
            const int col = h * 64 + dt * 16 + gk * 4;
            const uint2 zz = *(const uint2*)(U + mrow * LDQ + 2048 + col);
            const float z0 = bf2f(zz.x & 0xffff), z1 = bf2f(zz.x >> 16), z2 = bf2f(zz.y & 0xffff), z3 = bf2f(zz.y >> 16);
            uint2 ov;
            ov.x = pack2(r0 * silu_f(z0), r1 * silu_f(z1));
            ov.y = pack2(r2 * silu_f(z2), r3 * silu_f(z3));
            *(uint2*)(Y + mrow * DM + col) = ov;
          }
        }
      }
    }
#undef SLOT
#undef LD1
#undef ST1
#undef CMP_LD
#undef SRC_S0
#undef BR_LD
  }
}

__device__ __forceinline__ void final_norm(const Params& p) {
  const float* ssq2 = (const float*)(p.ws + WS_SSQ) + MTOK;
  const int lane = TIDX & 63, wave = TIDX >> 6;
  const int nrw = gridDim.x * NWAVE;
  for (int row = BIDX * NWAVE + wave; row < MTOK; row += 2 * nrw) {
    const bool two = (row + nrw < MTOK);
    const int row1 = two ? row + nrw : row;
    float4* xr0 = (float4*)(p.out + (size_t)row * DM);
    float4* xr1 = (float4*)(p.out + (size_t)row1 * DM);
    float4 v0[4], v1[4];
#pragma unroll
    for (int i = 0; i < 4; ++i) { v0[i] = xr0[lane + 64 * i]; v1[i] = xr1[lane + 64 * i]; }
    const float r0 = rsqrtf(ssq2[row] * (1.f / DM) + 1e-6f), r1 = rsqrtf(ssq2[row1] * (1.f / DM) + 1e-6f);
#pragma unroll
    for (int i = 0; i < 4; ++i) {
      const float4 gg = ((const float4*)p.fin_g)[lane + 64 * i];
      xr0[lane + 64 * i] = (float4){v0[i].x * r0 * gg.x, v0[i].y * r0 * gg.y, v0[i].z * r0 * gg.z, v0[i].w * r0 * gg.w};
      if (two) xr1[lane + 64 * i] = (float4){v1[i].x * r1 * gg.x, v1[i].y * r1 * gg.y, v1[i].z * r1 * gg.z, v1[i].w * r1 * gg.w};
    }
  }
}

#define XB_XCNT(j)  (64 * (j))
#define XB_XSUB(j)  (1024 + 64 * (j))
#define XB_XGEN(j)  (2048 + 64 * (j))
#define XB_TOP      3072
#define XB_TOPGEN   3136
#define XB_WORDS    3200
#define LAS __attribute__((address_space(3)))
__device__ __forceinline__ unsigned xb_ld(unsigned* q) { return __hip_atomic_load(q, __ATOMIC_RELAXED, __HIP_MEMORY_SCOPE_AGENT); }
__device__ __forceinline__ unsigned xb_add(unsigned* q, unsigned v) { return __hip_atomic_fetch_add(q, v, __ATOMIC_RELAXED, __HIP_MEMORY_SCOPE_AGENT); }
__device__ __forceinline__ unsigned xb_xcc_id() { return (unsigned)__builtin_amdgcn_s_getreg((3 << 11) | 20) & 0xFu; }
__device__ __forceinline__ void grid_bar(const Params& p, unsigned xcc, volatile unsigned* st) {
  asm volatile("s_waitcnt vmcnt(0)" ::: "memory");
  __syncthreads();
  if (TIDX == 0) {
    unsigned* bar = (unsigned*)(p.ws + WS_BAR);
    __builtin_amdgcn_s_waitcnt(0);
    unsigned nloc = st[0], nx = st[1];
    if (nloc == 0u) {
      const unsigned G = gridDim.x;
      for (;;) {
        unsigned sum = 0u, cnt = 0u, mine = 0u, below = 0u;
#pragma unroll
        for (unsigned j = 0; j < 16; ++j) { const unsigned c = xb_ld(&bar[XB_XCNT(j)]); sum += c; cnt += (c > 0u) ? 1u : 0u; mine = (j == xcc) ? c : mine; below += (j < xcc && c > 0u) ? 1u : 0u; }
        nloc = mine; nx = cnt; st[3] = below;
        if (sum == G) break;
        __builtin_amdgcn_s_sleep(1);
      }
      st[0] = nloc; st[1] = nx;
    }
    const unsigned old = xb_add(&bar[XB_XSUB(xcc)], 1u);
    const unsigned gen = old / nloc;
    if (old + 1u == (gen + 1u) * nloc) {
      __builtin_amdgcn_fence(__ATOMIC_RELEASE, "agent");
      asm volatile("s_waitcnt vmcnt(0)" ::: "memory");
      const unsigned og = xb_add(&bar[XB_TOP], 1u);
      const unsigned tg = og / nx;
      if (og + 1u == (tg + 1u) * nx) xb_add(&bar[XB_TOPGEN], 1u);
      else while (xb_ld(&bar[XB_TOPGEN]) == tg) __builtin_amdgcn_s_sleep(1);
      __builtin_amdgcn_fence(__ATOMIC_ACQUIRE, "agent");
      xb_add(&bar[XB_XGEN(xcc)], 1u);
      asm volatile("s_waitcnt vmcnt(0)" ::: "memory");
    } else {
      while (xb_ld(&bar[XB_XGEN(xcc)]) == gen) __builtin_amdgcn_s_sleep(1);
      __builtin_amdgcn_fence(__ATOMIC_ACQUIRE, "agent");
      asm volatile("s_waitcnt vmcnt(0)" ::: "memory");
    }
  }
  __syncthreads();
}

__device__ __forceinline__ void nsa_knorm(const Params& p) {
  if (BIDX < 64) return;
  const u16* U = (const u16*)(p.ws + WS_QK);
  uint32_t* km = (uint32_t*)(p.ws + WS_KMAX);
  const int tid = TIDX, lane = tid & 63, wave = tid >> 6;
  float mx = 0.f;
  for (int row = (BIDX - 64) * NWAVE + wave; row < MTOK; row += (gridDim.x - 64) * NWAVE) {
    const uint4 v = *(const uint4*)(U + (size_t)row * LDQ + 1536 + lane * 8);
    const float a0 = bf2f(v.x & 0xffff), a1 = bf2f(v.x >> 16), a2 = bf2f(v.y & 0xffff), a3 = bf2f(v.y >> 16);
    const float a4 = bf2f(v.z & 0xffff), a5 = bf2f(v.z >> 16), a6 = bf2f(v.w & 0xffff), a7 = bf2f(v.w >> 16);
    float ss = a0 * a0 + a1 * a1 + a2 * a2 + a3 * a3 + a4 * a4 + a5 * a5 + a6 * a6 + a7 * a7;
    ss += __shfl_xor(ss, 1); ss += __shfl_xor(ss, 2); ss += __shfl_xor(ss, 4);
    mx = fmaxf(mx, ss);
  }
  if ((lane & 7) == 0) atomicMax(&km[8 + (lane >> 3)], __float_as_uint(mx));
}

__global__ void __launch_bounds__(NTHR, 2) mega(Params p_in) {
  Params p = p_in;
  p.pad = __builtin_amdgcn_readfirstlane((int)threadIdx.x >> 6);
  extern __shared__ __attribute__((aligned(16))) unsigned char lds_raw[];
  u16* lds = (u16*)lds_raw;
  const unsigned xcc = xb_xcc_id();
  volatile unsigned* bst = (volatile unsigned*)(lds_raw + 147456);
  if (threadIdx.x < 4) bst[threadIdx.x] = 0u;
  __syncthreads();
  if (p_in.coop && threadIdx.x == 0) bst[2] = xb_add((unsigned*)(p_in.ws + WS_BAR) + XB_XCNT(xcc), 1u);
  __syncthreads();
  cg::grid_group grid = cg::this_grid();
  if (p_in.coop == 2) grid.sync();
#define PH_ON(k) (p.ph_lo <= (k) && (k) <= p.ph_hi)
#define PH_SYNC(k) if (p.coop && p.ph_lo <= (k) && (k) < p.ph_hi) grid_bar(p, xcc, bst);
  if (PH_ON(0)) {
    rms_rows_fl(p, (float*)lds);
    conv_t(p, (u16*)(p.ws + WS_WT0), p.e_win, 1024, 4104, 4352, 0);
    conv_t(p, (u16*)(p.ws + WS_WT1), p.o_win, 1024, 3632, 3840, 1);
    conv_t(p, (u16*)(p.ws + WS_WO0), p.e_wout, 1024, 1024, 1024, 2);
    conv_t(p, (u16*)(p.ws + WS_WO1), p.o_wout, 1024, 1024, 1024, 2);
    conv_t(p, (u16*)(p.ws + WS_W1K), p.o_wk1, 2048, 256, 256, 2);
    conv_t(p, (u16*)(p.ws + WS_W1V), p.o_wv1, 2048, 256, 256, 2);
    conv_t(p, (u16*)(p.ws + WS_W2K), p.o_wk2, 256, 64, 256, 2);
    conv_t(p, (u16*)(p.ws + WS_W2V), p.o_wv2, 256, 64, 256, 2);
    pe_partial(p);
    if (BIDX == 0 && TIDX < 32) ((uint32_t*)(p.ws + WS_KMAX))[TIDX] = 0u;
    for (int i = BIDX * NTHR + TIDX; i < 2 * MTOK; i += gridDim.x * NTHR) ((float*)(p.ws + WS_SSQ))[i] = 0.f;
  }
  PH_SYNC(0)
  if (PH_ON(1)) gemm_inproj(p, 0, lds, 0);
  PH_SYNC(1)
  if (PH_ON(2)) {
    fox_scan(p, (float*)lds); ret_stepA(p); fox_knorm(p);
    if (BIDX == gridDim.x - 1) {
      for (int i = TIDX; i < 512; i += NTHR) {
        const float* part = (const float*)(p.ws + WS_PEP);
        float sum = 0.f;
        for (int kc = 0; kc < 16; ++kc) sum += part[((i >> 8) * 16 + kc) * 256 + (i & 255)];
        ((float*)(p.ws + WS_PEB))[i] = sum;
      }
    }
  }
  PH_SYNC(2)
  if (PH_ON(3)) { ret_stepB(p); fox_phase(p, lds); }
  PH_SYNC(3)
  if (PH_ON(4)) ret_stepC(p, lds);
  PH_SYNC(4)
  if (PH_ON(5)) gemm_outproj(p, 0, lds);
  PH_SYNC(5)
  if (PH_ON(7)) gemm_inproj(p, 1, lds, 0);
  PH_SYNC(7)
  if (PH_ON(8)) { gemm_cmp1(p, lds); gemm_inproj(p, 1, lds, 1); nsa_knorm(p); }
  PH_SYNC(8)
  if (PH_ON(10)) nsa_phase(p, lds);
  PH_SYNC(10)
  if (PH_ON(11)) gemm_outproj(p, 1, lds);
  PH_SYNC(11)
  if (PH_ON(12)) final_norm(p);
}

extern "C" void kernel_launch(void* const* d_in, const int* in_sizes, int n_in, void* d_out, int out_size, void* d_ws,
                              size_t ws_size, hipStream_t stream) {
  static int grid_blocks = 0;
  if (!grid_blocks) {
    int dev = 0, cus = 0, per_cu = 0;
    hipGetDevice(&dev);
    hipDeviceGetAttribute(&cus, hipDeviceAttributeMultiprocessorCount, dev);
    hipFuncSetAttribute((const void*)mega, hipFuncAttributeMaxDynamicSharedMemorySize, LDS_BYTES);
    hipOccupancyMaxActiveBlocksPerMultiprocessor(&per_cu, (const void*)mega, NTHR, LDS_BYTES);
    if (per_cu < 1) per_cu = 1;
    if (per_cu > 1) per_cu = 1;
    grid_blocks = cus * per_cu;
    (void)hipGetLastError();
  }
  Params p{};
  p.x = (const float*)d_in[0]; p.e_ng = (const float*)d_in[1]; p.e_win = (const float*)d_in[2];
  p.e_bf = (const float*)d_in[3]; p.e_gn = (const float*)d_in[4]; p.e_wout = (const float*)d_in[5];
  p.o_ng = (const float*)d_in[6]; p.o_win = (const float*)d_in[7]; p.o_bg = (const float*)d_in[8];
  p.o_pek = (const float*)d_in[9]; p.o_pev = (const float*)d_in[10]; p.o_wk1 = (const float*)d_in[11];
  p.o_wk2 = (const float*)d_in[12]; p.o_wv1 = (const float*)d_in[13]; p.o_wv2 = (const float*)d_in[14];
  p.o_wout = (const float*)d_in[15]; p.fin_g = (const float*)d_in[16];
  p.out = (float*)d_out; p.ws = (unsigned char*)d_ws;
#if ONE_LAUNCH
  p.ph_lo = 0; p.ph_hi = NPHASE - 1; p.coop = 1;
  (void)hipMemsetAsync((unsigned char*)d_ws + WS_BAR, 0, 16384, stream);
  void* args[] = {&p};
  hipError_t e = hipLaunchCooperativeKernel((const void*)mega, dim3(grid_blocks), dim3(NTHR), args, LDS_BYTES, stream);
  if (e != hipSuccess) fprintf(stderr, "cooperative launch failed: %s (grid %d)\n", hipGetErrorString(e), grid_blocks);
#else
  for (int ph = 0; ph < NPHASE; ++ph) {
    p.ph_lo = ph; p.ph_hi = ph; p.coop = 0;
    hipLaunchKernelGGL(mega, dim3(grid_blocks), dim3(NTHR), LDS_BYTES, stream, p);
  }
#endif
}
```
